# Optimizing an MI355X kernel written in HIP

```python
import jax
import jax.numpy as jnp
from jax import lax
import numpy as np


D_MODEL = 1024
BATCH = 16
SEQ = 2048
DEPTH = 1

GRID_W = 64
CTX_LEN = 256
NA_HEADS = 8
NA_HEAD_DIM = 64
NA_WIDTH = NA_HEADS * NA_HEAD_DIM
NA_KH = 8
NA_KW = 16
NA_QBW = 16
NA_KBW = NA_QBW + NA_KW
ROPE_AXIS_DIM = NA_HEAD_DIM // 2
ROPE_BASE = 10000.0
HG_HEADS = 4
HG_DK = 128
HG_DV = 128
HG_WIDTH = HG_HEADS * HG_DK
HG_CHUNK = 64
MIX_WIDTH = NA_WIDTH + HG_WIDTH
SEG_WIDTHS = (NA_WIDTH, NA_WIDTH, NA_WIDTH, HG_WIDTH, HG_WIDTH, HG_WIDTH, HG_WIDTH, HG_WIDTH)
IN_COLS = 3 * NA_WIDTH + 5 * HG_WIDTH
N_GROUPS = 4
EXPERTS_PER_GROUP = 4
N_EXPERTS = N_GROUPS * EXPERTS_PER_GROUP
TOP_K = 2
D_EXPERT = 512
EPS = 1e-6
F32 = jnp.float32

kernel_name = 'hybrid_na_hgrn2_hmoe_dit_layer'


def _rms(x, g):
    xf = x.astype(F32)
    y = xf * lax.rsqrt(jnp.mean(xf * xf, axis=-1, keepdims=True) + EPS)
    return (y * g.astype(F32)).astype(x.dtype)


def _seg(w, i):
    start = sum(SEG_WIDTHS[:i])
    return w[:, start:start + SEG_WIDTHS[i]]


def _axial_rope(n_tok):
    t = jnp.arange(n_tok)
    pos = jnp.stack([t // GRID_W, t % GRID_W], axis=-1).astype(F32)
    inv = ROPE_BASE ** (-jnp.arange(0, ROPE_AXIS_DIM, 2, dtype=F32) / ROPE_AXIS_DIM)
    ang = pos[:, :, None] * inv
    return jnp.cos(ang), jnp.sin(ang)


def _rope(x, cos, sin):
    xr = x.astype(F32).reshape(*x.shape[:-1], 2, ROPE_AXIS_DIM)
    half = ROPE_AXIS_DIM // 2
    x1, x2 = xr[..., :half], xr[..., half:]
    cs, sn = cos[None, :, None], sin[None, :, None]
    out = jnp.concatenate([x1 * cs - x2 * sn, x2 * cs + x1 * sn], axis=-1)
    return out.reshape(x.shape).astype(x.dtype)


def _na_column_tables():
    n_cb = GRID_W // NA_QBW
    j = np.arange(n_cb)
    kb_start = np.clip(j * NA_QBW - NA_KW // 2, 0, GRID_W - NA_KBW)
    key_cols = kb_start[:, None] + np.arange(NA_KBW)
    q_cols = j[:, None] * NA_QBW + np.arange(NA_QBW)
    cs = np.clip(q_cols - NA_KW // 2, 0, GRID_W - NA_KW)[..., None]
    kc = key_cols[:, None, :]
    valid = (kc >= cs) & (kc < cs + NA_KW)
    col_off = np.clip(kc - q_cols[..., None] + NA_KW - 1, 0, 2 * NA_KW - 2)
    return key_cols, valid, col_off


def _na_latent(q_rot, k_rot, v, q_raw, kc, vc, rpb):
    B, S, H, Dh = v.shape
    rows = S // GRID_W
    kh = min(NA_KH, rows)
    key_cols, valid, col_off = _na_column_tables()
    n_cb = key_cols.shape[0]
    grid = lambda t: t.reshape(B, rows, GRID_W, H, Dh)
    qg, kg, vg, qrg = grid(q_rot), grid(k_rot), grid(v), grid(q_raw)
    scale = Dh ** -0.5
    mask = jnp.asarray(valid)[None, None, :, :, None, :]

    def one_row(r):
        rs = jnp.clip(r - kh // 2, 0, rows - kh)
        k_blk = lax.dynamic_slice_in_dim(kg, rs, kh, axis=1)[:, :, key_cols]
        v_blk = lax.dynamic_slice_in_dim(vg, rs, kh, axis=1)[:, :, key_cols]
        qb = lax.dynamic_index_in_dim(qg, r, axis=1, keepdims=False).reshape(B, n_cb, NA_QBW, H, Dh)
        qrb = lax.dynamic_index_in_dim(qrg, r, axis=1, keepdims=False).reshape(B, n_cb, NA_QBW, H, Dh)
        s_loc = jnp.einsum('bjqhd,bijkhd->bhjqik', qb, k_blk).astype(F32) * scale
        row_off = rs + jnp.arange(kh) - r + NA_KH - 1
        bias = rpb[:, row_off][:, :, col_off].transpose(0, 2, 3, 1, 4)
        s_loc = jnp.where(mask, s_loc + bias[None].astype(F32), -jnp.inf)
        s_loc = s_loc.reshape(B, H, n_cb, NA_QBW, kh * NA_KBW)
        s_ctx = jnp.einsum('bjqhd,bchd->bhjqc', qrb, kc).astype(F32) * scale
        p = jax.nn.softmax(jnp.concatenate([s_loc, s_ctx], axis=-1), axis=-1).astype(v.dtype)
        p_loc = p[..., :kh * NA_KBW].reshape(B, H, n_cb, NA_QBW, kh, NA_KBW)
        p_ctx = p[..., kh * NA_KBW:]
        o = (jnp.einsum('bhjqik,bijkhd->bjqhd', p_loc, v_blk)
             + jnp.einsum('bhjqc,bchd->bjqhd', p_ctx, vc))
        return o.reshape(B, GRID_W, H, Dh)

    out = lax.map(one_row, jnp.arange(rows))
    return out.transpose(1, 0, 2, 3, 4).reshape(B, S, H * Dh)


def _ctx_attn(q, k, v):
    B, L, H, Dh = q.shape
    s = jnp.einsum('bqhd,bkhd->bhqk', q, k).astype(F32) * (Dh ** -0.5)
    p = jax.nn.softmax(s, axis=-1).astype(v.dtype)
    return jnp.einsum('bhqk,bkhd->bqhd', p, v).reshape(B, L, H * Dh)


def _hg_heads(t):
    B, L, _ = t.shape
    return t.astype(F32).reshape(B, L, HG_HEADS, -1).transpose(0, 2, 1, 3)


def _hg_forget(f_pre, lb):
    f = lb + (1.0 - lb) * jax.nn.sigmoid(f_pre.astype(F32))
    return _hg_heads(1.0 - f), _hg_heads(jnp.log(f))


def _flip(t):
    return jnp.flip(t, axis=2)


def _hg_scan(q, k, v, logf, s0):
    B, H, L, DK = q.shape
    n = L // HG_CHUNK
    chunks = lambda t: jnp.moveaxis(t.reshape(B, H, n, HG_CHUNK, t.shape[-1]), 2, 0)
    incl = jnp.tril(jnp.ones((HG_CHUNK, HG_CHUNK), dtype=bool))[:, :, None]

    def step(S, inp):
        qc, kc, vc, gc = inp
        b = jnp.cumsum(gc, axis=2)
        diff = b[:, :, :, None, :] - b[:, :, None, :, :]
        decay = jnp.exp(jnp.where(incl, diff, -jnp.inf))
        attn = jnp.einsum('bhtd,bhsd,bhtsd->bhts', qc, kc, decay)
        o = (jnp.einsum('bhtd,bhdv->bhtv', qc * jnp.exp(b), S)
             + jnp.einsum('bhts,bhsv->bhtv', attn, vc))
        b_end = b[:, :, -1:, :]
        S = (jnp.exp(b_end[:, :, 0, :])[..., None] * S
             + jnp.einsum('bhsd,bhsv->bhdv', kc * jnp.exp(b_end - b), vc))
        return S, o

    S, o = lax.scan(step, s0, (chunks(q), chunks(k), chunks(v), chunks(logf)))
    return jnp.moveaxis(o, 0, 2).reshape(B, H, L, v.shape[-1]), S


def _hg_final_state(k, v, logf):
    b = jnp.cumsum(logf, axis=2)
    return jnp.einsum('bhsd,bhsv->bhdv', k * jnp.exp(b[:, :, -1:, :] - b), v)


def _hg_output(o, g_pre, gain):
    o = o.transpose(0, 2, 1, 3)
    y = o * lax.rsqrt(jnp.mean(o * o, axis=-1, keepdims=True) + EPS) * gain.astype(F32)
    g = g_pre.astype(F32).reshape(*g_pre.shape[:-1], HG_HEADS, HG_DV)
    B, L = g_pre.shape[:2]
    return (y * jax.nn.silu(g)).reshape(B, L, HG_WIDTH).astype(g_pre.dtype)


def _hier_moe(h, w_grp, b_grp, w_exp, b_exp, w1, w3, w2):
    B, L, D = h.shape
    t = h.reshape(B * L, D)
    g_logits = (t @ w_grp + b_grp).astype(F32)
    g_prob = jax.nn.softmax(g_logits, axis=-1)
    g_sel = jnp.argmax(g_logits, axis=-1)
    g_w = jnp.take_along_axis(g_prob, g_sel[:, None], axis=-1)
    e_logits = (t @ w_exp + b_exp).astype(F32).reshape(-1, N_GROUPS, EXPERTS_PER_GROUP)
    e_in = jnp.take_along_axis(e_logits, g_sel[:, None, None], axis=1)[:, 0]
    top_v, top_i = lax.top_k(e_in, TOP_K)
    w_top = jax.nn.softmax(top_v, axis=-1) * g_w
    e_id = g_sel[:, None] * EXPERTS_PER_GROUP + top_i
    gate = jnp.sum(jax.nn.one_hot(e_id, N_EXPERTS, dtype=F32) * w_top[..., None], axis=1).astype(h.dtype)
    out = jnp.zeros_like(t)
    for e in range(N_EXPERTS):
        y = (jax.nn.silu(t @ w1[e]) * (t @ w3[e])) @ w2[e]
        out = out + gate[:, e:e + 1] * y
    return out.reshape(B, L, D)


def setup_inputs(seed: int = 0) -> dict:
    key = jax.random.key(seed)
    ks = jax.random.split(key, 22)
    nrm = lambda k, shape, s: jax.random.normal(k, shape, F32) * s
    D = D_MODEL
    return {
        'x': nrm(ks[0], (BATCH, SEQ, D), 1.0),
        'c': nrm(ks[1], (BATCH, D), 1.0),
        'ctx': nrm(ks[2], (BATCH, CTX_LEN, D), 1.0),
        'c_ctx': nrm(ks[3], (D,), 1.0),
        'w_mod': nrm(ks[4], (DEPTH, D, 6 * D), 0.5 * D ** -0.5),
        'b_mod': nrm(ks[5], (DEPTH, 6 * D), 0.01),
        'norm_mix': 1.0 + nrm(ks[6], (DEPTH, D), 0.05),
        'norm_ffn': 1.0 + nrm(ks[7], (DEPTH, D), 0.05),
        'w_in': nrm(ks[8], (DEPTH, D, IN_COLS), D ** -0.5),
        'w_out': nrm(ks[9], (DEPTH, MIX_WIDTH, D), MIX_WIDTH ** -0.5),
        'na_rpb': nrm(ks[10], (DEPTH, NA_HEADS, 2 * NA_KH - 1, 2 * NA_KW - 1), 0.5),
        'hg_lb': nrm(ks[11], (DEPTH + 1, 2, HG_WIDTH), 0.5),
        'hg_norm': 1.0 + nrm(ks[12], (DEPTH, HG_DV), 0.05),
        'w_grp': nrm(ks[13], (DEPTH, D, N_GROUPS), D ** -0.5),
        'b_grp': nrm(ks[14], (DEPTH, N_GROUPS), 0.01),
        'w_exp': nrm(ks[15], (DEPTH, D, N_EXPERTS), D ** -0.5),
        'b_exp': nrm(ks[16], (DEPTH, N_EXPERTS), 0.01),
        'w1': nrm(ks[17], (DEPTH, N_EXPERTS, D, D_EXPERT), D ** -0.5),
        'w3': nrm(ks[18], (DEPTH, N_EXPERTS, D, D_EXPERT), D ** -0.5),
        'w2': nrm(ks[19], (DEPTH, N_EXPERTS, D_EXPERT, D), D_EXPERT ** -0.5),
        'norm_final': 1.0 + nrm(ks[20], (D,), 0.05),
    }


def reference(x, c, ctx, c_ctx, w_mod, b_mod, norm_mix, norm_ffn, w_in, w_out, na_rpb,
              hg_lb, hg_norm, w_grp, b_grp, w_exp, b_exp, w1, w3, w2, norm_final):
    B, S, _ = x.shape
    cos, sin = _axial_rope(S)
    lb_all = jnp.cumsum(jax.nn.softmax(hg_lb.astype(F32), axis=0), axis=0)
    splits = [int(s) for s in np.cumsum(SEG_WIDTHS)[:-1]]
    na_heads = lambda t: t.reshape(*t.shape[:-1], NA_HEADS, NA_HEAD_DIM)
    xc = ctx
    for l in range(DEPTH):
        last = l == DEPTH - 1
        mod = jax.nn.silu(c) @ w_mod[l] + b_mod[l]
        sh_a, sc_a, ga_a, sh_f, sc_f, ga_f = jnp.split(mod[:, None, :], 6, axis=-1)
        mod_c = jax.nn.silu(c_ctx) @ w_mod[l] + b_mod[l]
        csh_a, csc_a, cga_a, csh_f, csc_f, cga_f = jnp.split(mod_c, 6)

        h = _rms(x, norm_mix[l]) * (1.0 + sc_a) + sh_a
        hc = _rms(xc, norm_mix[l]) * (1.0 + csc_a) + csh_a
        na_q, na_k, na_v, hg_q, hg_i, hg_ff, hg_fb, hg_g = jnp.split(h @ w_in[l], splits, axis=-1)
        if last:
            c_k, c_v, c_i, c_ff, c_fb = [hc @ _seg(w_in[l], i) for i in (1, 2, 4, 5, 6)]
        else:
            c_q, c_k, c_v, c_hq, c_i, c_ff, c_fb, c_g = jnp.split(hc @ w_in[l], splits, axis=-1)

        q_a = na_heads(na_q)
        na_out = _na_latent(_rope(q_a, cos, sin), _rope(na_heads(na_k), cos, sin), na_heads(na_v),
                            q_a, na_heads(c_k), na_heads(c_v), na_rpb[l])

        lb_f, lb_b = lb_all[l, 0], lb_all[l, 1]
        lq, li = _hg_heads(jax.nn.silu(hg_q)), _hg_heads(hg_i)
        lkf, lgf = _hg_forget(hg_ff, lb_f)
        lkb, lgb = _hg_forget(hg_fb, lb_b)
        ci = _hg_heads(c_i)
        ckf, cgf = _hg_forget(c_ff, lb_f)
        ckb, cgb = _hg_forget(c_fb, lb_b)
        if last:
            s_f = _hg_final_state(ckf, ci, cgf)
            s_b = _hg_final_state(_flip(ckb), _flip(ci), _flip(cgb))
        else:
            cq = _hg_heads(jax.nn.silu(c_hq))
            zero = jnp.zeros((B, HG_HEADS, HG_DK, HG_DV), F32)
            co_f, s_f = _hg_scan(cq, ckf, ci, cgf, zero)
            co_b, s_b = _hg_scan(_flip(cq), _flip(ckb), _flip(ci), _flip(cgb), zero)
        o_f, _ = _hg_scan(lq, lkf, li, lgf, s_f)
        o_b, _ = _hg_scan(_flip(lq), _flip(lkb), _flip(li), _flip(lgb), s_b)
        hg_out = _hg_output(o_f + _flip(o_b), hg_g, hg_norm[l])

        x = x + ga_a * (jnp.concatenate([na_out, hg_out], axis=-1) @ w_out[l])
        if not last:
            ctx_na = _ctx_attn(na_heads(c_q), na_heads(c_k), na_heads(c_v))
            ctx_hg = _hg_output(co_f + _flip(co_b), c_g, hg_norm[l])
            xc = xc + cga_a * (jnp.concatenate([ctx_na, ctx_hg], axis=-1) @ w_out[l])

        h = _rms(x, norm_ffn[l]) * (1.0 + sc_f) + sh_f
        x = x + ga_f * _hier_moe(h, w_grp[l], b_grp[l], w_exp[l], b_exp[l], w1[l], w3[l], w2[l])
        if not last:
            hc = _rms(xc, norm_ffn[l]) * (1.0 + csc_f) + csh_f
            xc = xc + cga_f * _hier_moe(hc, w_grp[l], b_grp[l], w_exp[l], b_exp[l], w1[l], w3[l], w2[l])

    return _rms(x, norm_final)
```

```cpp
#include <hip/hip_runtime.h>
#include <cstdio>
#include <cstdint>

#define GAS __attribute__((address_space(1)))
#define LAS __attribute__((address_space(3)))
typedef unsigned short bf16;
typedef unsigned short bf16_t;
typedef unsigned v4u __attribute__((ext_vector_type(4)));
typedef unsigned v2u __attribute__((ext_vector_type(2)));
typedef float f32x4 __attribute__((ext_vector_type(4)));
typedef float f32x2 __attribute__((ext_vector_type(2)));
typedef short bf16x8 __attribute__((ext_vector_type(8)));
typedef unsigned u32x4 __attribute__((ext_vector_type(4)));
typedef GAS unsigned gu32;
#define RLX_AGENT __ATOMIC_RELAXED, __HIP_MEMORY_SCOPE_AGENT
#define LDS_WAIT() asm volatile("s_waitcnt lgkmcnt(0)" ::: "memory")
#define VM_WAIT() asm volatile("s_waitcnt vmcnt(0)" ::: "memory")

constexpr int NB = 16, SEQ = 2048, D = 1024, T = NB * SEQ, LC = 256, TC = NB * LC, MROWS = T + TC;
constexpr int GW = 64, NROWS = SEQ / GW;
constexpr int INCOLS = 4096, SEGW = 512;
constexpr int NAH = 8, NAD = 64, HGH = 4, HGD = 128;
constexpr int NE = 16, DE = 512, ECAP = T;
constexpr float EPS = 1e-6f;
constexpr int NWAVES = 8, NTHR = 512;

constexpr size_t MiB = 1u << 20;
constexpr size_t WS_CTL = 0, CTL_ZERO_BYTES = 1 * MiB;
constexpr size_t WS_MOD = 1 * MiB;
constexpr size_t WS_ROPE = WS_MOD + 512 * 1024, WS_LBT = WS_MOD + 520 * 1024;
constexpr size_t WS_ELIST = 2 * MiB, WS_EWT = 4 * MiB;
constexpr size_t WS_WINT = 8 * MiB, WS_WOUTT = 16 * MiB, WS_W13T = 18 * MiB, WS_W2T = 50 * MiB;
constexpr size_t WS_XN = 66 * MiB;
constexpr size_t WS_Q = 138 * MiB, WS_K = 170 * MiB, WS_V = 206 * MiB, WS_HQ = 242 * MiB, WS_HI = 274 * MiB, WS_LF = 310 * MiB, WS_LB = 346 * MiB, WS_G = 382 * MiB;
constexpr size_t WS_OF = 414 * MiB, WS_OB = 446 * MiB, WS_END = 478 * MiB;
constexpr size_t WS_MIX = WS_XN, WS_XN2 = WS_XN, WS_X1 = 138 * MiB, WS_H = 274 * MiB, WS_Y = 346 * MiB;
constexpr int CW_CNT = 64;
constexpr int CW_BAR = 4096;

constexpr int RING_OFF = 0, RING_BYTES = 131072;
constexpr int LDSCTL_OFF = RING_BYTES, MISC_OFF = LDSCTL_OFF + 320, MOE_OFF = LDSCTL_OFF + 1024;
constexpr int LDS_BYTES = 147456;

__device__ __forceinline__ unsigned f2bf(float f) { unsigned u = __builtin_bit_cast(unsigned, f); return (u + 0x7fffu + ((u >> 16) & 1u)) >> 16; }
__device__ __forceinline__ unsigned pk2(float lo, float hi) { return f2bf(lo) | (f2bf(hi) << 16); }
__device__ __forceinline__ float bf2f(unsigned short b) { return __builtin_bit_cast(float, (unsigned)b << 16); }
__device__ __forceinline__ float bflo(unsigned u) { return __builtin_bit_cast(float, u << 16); }
__device__ __forceinline__ float bfhi(unsigned u) { return __builtin_bit_cast(float, u & 0xffff0000u); }
__device__ __forceinline__ unsigned pkh2(float lo, float hi) { _Float16 a = (_Float16)lo, b = (_Float16)hi; return (unsigned)__builtin_bit_cast(unsigned short, a) | ((unsigned)__builtin_bit_cast(unsigned short, b) << 16); }
__device__ __forceinline__ float h2f(unsigned short h) { return (float)__builtin_bit_cast(_Float16, h); }
__device__ __forceinline__ float silu_f(float v) { return v / (1.f + __expf(-v)); }
__device__ __forceinline__ float wave_sum(float v) {
#pragma unroll
    for (int o = 1; o < 64; o <<= 1) v += __shfl_xor(v, o);
    return v;
}
__device__ __forceinline__ float wave_max(float v) {
#pragma unroll
    for (int o = 1; o < 64; o <<= 1) v = fmaxf(v, __shfl_xor(v, o));
    return v;
}

namespace pg8 {
constexpr int BM = 256, BK = 64, HALF = 128, HTB = HALF * BK * 2, STAGE_BYTES = 8 * HTB, NXCD = 8, WGM = 8;
__host__ __device__ __forceinline__ int lds_byte(int r, int c) { const int st = (r >> 4) * 2 + (c >> 5), rr = r & 15, cc = c & 31, ob = rr * 64 + cc * 2; return st * 1024 + (ob ^ (((ob >> 9) & 1) << 5)); }
__host__ __device__ __forceinline__ void stage_rc(int b, int& R, int& C) { const int st = b / 1024, sb = b % 1024, swz = sb ^ (((sb >> 9) & 1) << 5); R = (st >> 1) * 16 + swz / 64; C = (st & 1) * 32 + (swz % 64) / 2; }
__host__ __device__ __forceinline__ int perm32(int rho) { const int n = rho >> 4, i = rho & 15; return 8 * (i >> 2) + 4 * n + (i & 3); }

struct Unit { int pm, pn, e, tm, cnt; };

__device__ __forceinline__ unsigned cvt_pk_bf16(float lo, float hi) { unsigned r; asm volatile("v_cvt_pk_bf16_f32 %0, %1, %2" : "=v"(r) : "v"(lo), "v"(hi)); return r; }

struct DenseOrder {
    static constexpr bool GATHER = false;
    int nM, nN, nwg, G, c;
    __device__ void init(int M, int N, int G_, int c_) { nM = M / BM; nN = N / BM; nwg = nM * nN; G = G_; c = c_; }
    __device__ bool next(int i, Unit& u) const {
        const long L = (long)i * G + c; if (L >= nwg) return false;
        int wgid = (int)L; { const int q = nwg / NXCD, r = nwg % NXCD, xcd = wgid % NXCD, off = wgid / NXCD; wgid = (xcd < r ? xcd * (q + 1) : r * (q + 1) + (xcd - r) * q) + off; }
        const int nig = WGM * nN, gid = wgid / nig, fm = gid * WGM, gsz = (nM - fm) < WGM ? (nM - fm) : WGM;
        u.pm = fm + ((wgid % nig) % gsz); u.pn = (wgid % nig) / gsz; u.e = 0; u.tm = 0; u.cnt = 0; return true;
    }
    __device__ __forceinline__ int a_row0(const Unit& u) const { return u.pm * BM; }
    __device__ __forceinline__ int a_row(const Unit& u, int r) const { return u.pm * BM + r; }
    __device__ __forceinline__ int b_row0(const Unit& u) const { return u.pn * BM; }
};

template <class Epi, class Sched>
__device__ __forceinline__ void gemm_phase(LAS unsigned char* lds, const bf16_t* Aptr, const bf16_t* Btptr, const int K, const Sched& S, const Epi& E) {
    const int tid = threadIdx.x, wid = __builtin_amdgcn_readfirstlane(tid >> 6), lane = tid & 63, wr = wid >> 2, wc = wid & 3, fr = lane & 15, fq = lane >> 4;
    const int nt = K / BK;
    int sR[2], sC[2];
    unsigned voffA[2], voffB[2];
#pragma unroll
    for (int i = 0; i < 2; ++i) { int R, C; stage_rc(tid * 16 + i * 8192, R, C); const int Rb = Epi::PERM ? ((R & ~31) + perm32(R & 31)) : R;
        sR[i] = R; sC[i] = C; voffA[i] = (unsigned)(R * K + C) * 2u; voffB[i] = (unsigned)(Rb * K + C) * 2u; }
    const size_t kstep = (size_t)(BK * 2);
    const size_t hstep = (size_t)HALF * K * 2;
    const size_t rowb = (size_t)K * 2;
    const unsigned ldsw = (unsigned)wid * 1024u;
    const int aoff = lds_byte(wr * 64 + fr, fq * 8), boff = lds_byte(wc * 32 + fr, fq * 8);
    const char* Ab = (const char*)Aptr;
#define PG8_SA(b, h) (((b) * 2 + (h)) * HTB)
#define PG8_SB(b, h) ((4 + (b) * 2 + (h)) * HTB)
#define PG8_STAGE(bufoff, gbase, voff) do { _Pragma("unroll") for (int _i = 0; _i < 2; ++_i) \
        __builtin_amdgcn_global_load_lds((const unsigned*)((const char*)(gbase) + (voff)[_i]), (LAS unsigned*)(lds + (bufoff) + ldsw + _i * 8192), 16, 0, 0); } while (0)
#define PG8_LDA(dst, b, h) do { _Pragma("unroll") for (int m = 0; m < 4; ++m) _Pragma("unroll") for (int k = 0; k < 2; ++k) dst[m][k] = *(const LAS bf16x8*)(lds + PG8_SA(b, h) + aoff + m * 2048 + k * 1024); } while (0)
#define PG8_LDB(dst, b, h) do { _Pragma("unroll") for (int n = 0; n < 2; ++n) _Pragma("unroll") for (int k = 0; k < 2; ++k) dst[n][k] = *(const LAS bf16x8*)(lds + PG8_SB(b, h) + boff + n * 2048 + k * 1024); } while (0)
#define PG8_MMA(ai, bj, At, Bt) do { __builtin_amdgcn_s_setprio(1); _Pragma("unroll") for (int m = 0; m < 4; ++m) _Pragma("unroll") for (int n = 0; n < 2; ++n) _Pragma("unroll") for (int k = 0; k < 2; ++k) \
        acc[ai][bj][m][n] = __builtin_amdgcn_mfma_f32_16x16x32_bf16(Bt[n][k], At[m][k], acc[ai][bj][m][n], 0, 0, 0); __builtin_amdgcn_s_setprio(0); } while (0)
#define PG8_WAIT_V(n) asm volatile("s_waitcnt vmcnt(" #n ")" ::: "memory")
#define PG8_WAIT_L(n) asm volatile("s_waitcnt lgkmcnt(" #n ")" ::: "memory")
#define PG8_BAR __builtin_amdgcn_s_barrier()
#define PG8_SCHED __builtin_amdgcn_sched_barrier(0)
    Unit cur, nxt; int ui = 0;
    if (!S.next(0, cur)) return;
    f32x4 acc[2][2][4][2];
#pragma unroll
    for (int a = 0; a < 2; ++a)
#pragma unroll
        for (int b = 0; b < 2; ++b)
#pragma unroll
            for (int m = 0; m < 4; ++m)
#pragma unroll
                for (int n = 0; n < 2; ++n) acc[a][b][m][n] = (f32x4){0.f, 0.f, 0.f, 0.f};
    bf16x8 At[4][2], B0[2][2], B1[2][2];
    const char* cA = Ab; unsigned cG[2][2];
    if constexpr (Sched::GATHER) {
#pragma unroll
        for (int h = 0; h < 2; ++h)
#pragma unroll
            for (int i = 0; i < 2; ++i) cG[h][i] = (unsigned)((size_t)S.a_row(cur, h * HALF + sR[i]) * rowb) + (unsigned)sC[i] * 2u;
    } else { cA = Ab + (size_t)S.a_row0(cur) * rowb; cG[0][0] = cG[0][1] = cG[1][0] = cG[1][1] = 0u; }
    const char* cB = (const char*)Btptr + (size_t)S.b_row0(cur) * rowb;
#define PG8_STAGEA(bufoff, h, dbase, goffs, kb) do { if constexpr (Sched::GATHER) { PG8_STAGE(bufoff, Ab + (kb), (goffs)[h]); } else { PG8_STAGE(bufoff, (dbase) + (h) * hstep + (kb), voffA); } } while (0)
    PG8_STAGE(PG8_SB(0, 0), cB, voffB); PG8_STAGE(PG8_SB(0, 1), cB + hstep, voffB); PG8_STAGEA(PG8_SA(0, 0), 0, cA, cG, 0); PG8_STAGEA(PG8_SA(0, 1), 1, cA, cG, 0);
    if (wr == 1) PG8_BAR;
    PG8_WAIT_V(2); PG8_BAR;
    PG8_STAGE(PG8_SB(1, 0), cB + kstep, voffB); PG8_STAGEA(PG8_SA(1, 0), 0, cA, cG, kstep); PG8_STAGE(PG8_SB(1, 1), cB + hstep + kstep, voffB);
    PG8_WAIT_V(6); PG8_BAR;
    for (;;) {
        const bool has_next = S.next(ui + 1, nxt);
        const char* nA = cA; const char* nB = cB; unsigned nG[2][2];
#pragma unroll
        for (int h = 0; h < 2; ++h)
#pragma unroll
            for (int i = 0; i < 2; ++i) nG[h][i] = cG[h][i];
        if (has_next) {
            nB = (const char*)Btptr + (size_t)S.b_row0(nxt) * rowb;
            if constexpr (Sched::GATHER) {
#pragma unroll
                for (int h = 0; h < 2; ++h)
#pragma unroll
                    for (int i = 0; i < 2; ++i) nG[h][i] = (unsigned)((size_t)S.a_row(nxt, h * HALF + sR[i]) * rowb) + (unsigned)sC[i] * 2u;
            } else nA = Ab + (size_t)S.a_row0(nxt) * rowb;
        }
        for (int t = 0; t < nt; t += 2) {
            const bool last = (t == nt - 2);
            const size_t kb1 = (size_t)(t + 1) * kstep;
            const size_t kb2 = last ? 0 : (size_t)(t + 2) * kstep, kb3 = kb2 + kstep;
            const char* a2 = last ? nA : cA; const char* b2 = last ? nB : cB + (size_t)(t + 2) * kstep; const char* b3 = b2 + kstep;
            unsigned g2[2][2];
#pragma unroll
            for (int h = 0; h < 2; ++h)
#pragma unroll
                for (int i = 0; i < 2; ++i) g2[h][i] = last ? nG[h][i] : cG[h][i];
            PG8_LDB(B0, 0, 0); PG8_LDB(B1, 0, 1); PG8_SCHED; PG8_LDA(At, 0, 0); PG8_STAGEA(PG8_SA(1, 1), 1, cA, cG, kb1);
            PG8_WAIT_V(8); PG8_WAIT_L(0); PG8_BAR; PG8_MMA(0, 0, At, B0); PG8_MMA(0, 1, At, B1); PG8_BAR; PG8_SCHED;
            PG8_LDA(At, 0, 1); PG8_STAGE(PG8_SB(0, 0), b2, voffB); PG8_STAGE(PG8_SB(0, 1), b2 + hstep, voffB); PG8_STAGEA(PG8_SA(0, 0), 0, a2, g2, kb2);
            PG8_WAIT_V(8); PG8_WAIT_L(0); PG8_BAR; PG8_MMA(1, 0, At, B0); PG8_MMA(1, 1, At, B1); PG8_BAR; PG8_SCHED;
            PG8_LDB(B0, 1, 0); PG8_LDB(B1, 1, 1); PG8_SCHED; PG8_LDA(At, 1, 0); PG8_STAGEA(PG8_SA(0, 1), 1, a2, g2, kb2);
            PG8_WAIT_V(8); PG8_WAIT_L(0); PG8_BAR; PG8_MMA(0, 0, At, B0); PG8_MMA(0, 1, At, B1); PG8_BAR; PG8_SCHED;
            PG8_LDA(At, 1, 1); PG8_STAGE(PG8_SB(1, 0), b3, voffB); PG8_STAGE(PG8_SB(1, 1), b3 + hstep, voffB); PG8_STAGEA(PG8_SA(1, 0), 0, a2, g2, kb3);
            PG8_WAIT_V(8); PG8_WAIT_L(0); PG8_BAR; PG8_MMA(1, 0, At, B0); PG8_MMA(1, 1, At, B1); PG8_BAR; PG8_SCHED;
        }
        if (wr == 0) PG8_BAR;
        E(acc, cur, wr, wc, fr, fq);
        if (!has_next) break;
#pragma unroll
        for (int a = 0; a < 2; ++a)
#pragma unroll
            for (int b = 0; b < 2; ++b)
#pragma unroll
                for (int m = 0; m < 4; ++m)
#pragma unroll
                    for (int n = 0; n < 2; ++n) acc[a][b][m][n] = (f32x4){0.f, 0.f, 0.f, 0.f};
        cur = nxt; cA = nA; cB = nB; ++ui;
#pragma unroll
        for (int h = 0; h < 2; ++h)
#pragma unroll
            for (int i = 0; i < 2; ++i) cG[h][i] = nG[h][i];
        if (wr == 1) PG8_BAR;
    }
    PG8_WAIT_V(0);
    PG8_BAR;
#undef PG8_SA
#undef PG8_SB
#undef PG8_STAGE
#undef PG8_STAGEA
#undef PG8_LDA
#undef PG8_LDB
#undef PG8_MMA
#undef PG8_WAIT_V
#undef PG8_WAIT_L
#undef PG8_BAR
#undef PG8_SCHED
}
}

#define XB_TMO      128
#define XB_XCNT(j)  (256  + 64 * (j))
#define XB_XSUB(j)  (1280 + 64 * (j))
#define XB_XGEN(j)  (2304 + 64 * (j))
#define XB_TOP      3328
#define XB_TOPGEN   3392
#define XCD_BAR_WORDS 3456
#define XB_SPIN_CAP (1u << 18)
__device__ __forceinline__ unsigned xb_ld(unsigned* p)              { return __hip_atomic_load(p, __ATOMIC_RELAXED, __HIP_MEMORY_SCOPE_AGENT); }
__device__ __forceinline__ unsigned xb_add(unsigned* p, unsigned v) { return __hip_atomic_fetch_add(p, v, __ATOMIC_RELAXED, __HIP_MEMORY_SCOPE_AGENT); }
__device__ __forceinline__ unsigned xb_xcc_id() { return (unsigned)__builtin_amdgcn_s_getreg((3 << 11) | 20) & 0xFu; }
#define XB_SPIN(cond, bar) do { unsigned _sp = 0; while (cond) { __builtin_amdgcn_s_sleep(1); \
    if ((++_sp & 255u) == 0u) { if (xb_ld(&(bar)[XB_TMO])) break; if (_sp > XB_SPIN_CAP) { atomicAdd(&(bar)[XB_TMO], 1u); break; } } } } while (0)
struct XcdBarrier { unsigned* bar; unsigned x; volatile LAS unsigned* st; };
__device__ __forceinline__ XcdBarrier xcd_barrier_post(unsigned* bar, volatile LAS unsigned* st) {
    XcdBarrier b; b.bar = bar; b.x = xb_xcc_id(); b.st = st;
    if (threadIdx.x == 0) (void)xb_add(&bar[XB_XCNT(b.x)], 1u);
    return b;
}
__device__ __forceinline__ void xcd_barrier_complete(unsigned* bar, unsigned x, unsigned& nloc, unsigned& nx) {
    const unsigned G = gridDim.x * gridDim.y * gridDim.z;
    unsigned sum, cnt, mine, sp = 0u;
    for (;;) {
        sum = 0u; cnt = 0u; mine = 0u;
#pragma unroll
        for (unsigned j = 0; j < 16; ++j) { const unsigned c = xb_ld(&bar[XB_XCNT(j)]); sum += c; cnt += (c > 0u) ? 1u : 0u; mine = (j == x) ? c : mine; }
        if (sum == G) break;
        __builtin_amdgcn_s_sleep(1);
        if ((++sp & 255u) == 0u) { if (xb_ld(&bar[XB_TMO])) break; if (sp > XB_SPIN_CAP) { atomicAdd(&bar[XB_TMO], 1u); break; } }
    }
    nloc = mine > 0u ? mine : 1u; nx = cnt > 0u ? cnt : 1u;
}
__device__ __forceinline__ void xcd_barrier(const XcdBarrier& b) {
    asm volatile("s_waitcnt vmcnt(0)" ::: "memory");
    __syncthreads();
    if (threadIdx.x == 0) {
        unsigned* bar = b.bar;
        __builtin_amdgcn_s_waitcnt(0);
        unsigned nloc = b.st[0], nx = b.st[1];
        if (nloc == 0u) { xcd_barrier_complete(bar, b.x, nloc, nx); b.st[0] = nloc; b.st[1] = nx; }
        const unsigned old = xb_add(&bar[XB_XSUB(b.x)], 1u);
        const unsigned gen = old / nloc;
        if (old + 1u == (gen + 1u) * nloc) {
            __builtin_amdgcn_fence(__ATOMIC_RELEASE, "agent");
            asm volatile("s_waitcnt vmcnt(0)" ::: "memory");
            const unsigned og = xb_add(&bar[XB_TOP], 1u);
            const unsigned tg = og / nx;
            if (og + 1u == (tg + 1u) * nx) xb_add(&bar[XB_TOPGEN], 1u);
            else XB_SPIN(xb_ld(&bar[XB_TOPGEN]) == tg, bar);
            __builtin_amdgcn_fence(__ATOMIC_ACQUIRE, "agent");
            xb_add(&bar[XB_XGEN(b.x)], 1u);
            asm volatile("s_waitcnt vmcnt(0)" ::: "memory");
        } else {
            XB_SPIN(xb_ld(&bar[XB_XGEN(b.x)]) == gen, bar);
            __builtin_amdgcn_fence(__ATOMIC_ACQUIRE, "agent");
            asm volatile("s_waitcnt vmcnt(0)" ::: "memory");
        }
    }
    __syncthreads();
}

using pg8::Unit;
typedef f32x4 acc_t[2][2][4][2];

struct EpiProj {
    static constexpr bool PERM = false;
    unsigned char* ws;
    __device__ __forceinline__ void operator()(const acc_t& acc, const Unit& u, int wr, int wc, int fr, int fq) const {
        const int seg = u.pn >> 1; const bool latent = u.pm < (T / 256);
        if (!latent && (seg == 0 || seg == 3 || seg == 7)) return;
        const int lc0 = (u.pn & 1) * 256 + wc * 32 + 4 * fq;
        const size_t segoff[8] = {WS_Q, WS_K, WS_V, WS_HQ, WS_HI, WS_LF, WS_LB, WS_G};
        size_t so = segoff[0];
#pragma unroll
        for (int s = 1; s < 8; ++s) so = (seg == s) ? segoff[s] : so;
        bf16* dst = (bf16*)(ws + so);
        const int row0 = u.pm * 256 + wr * 64 + fr;
        if (seg == 1 && latent) {
            const float* rope = (const float*)(ws + WS_ROPE);
#pragma unroll
            for (int ai = 0; ai < 2; ++ai)
#pragma unroll
                for (int m = 0; m < 4; ++m) { const int row = row0 + ai * 128 + m * 16, s = row & (SEQ - 1); const int pos = (wc & 1) ? (s & 63) : (s >> 6);
                    const f32x4 cs0 = *(const f32x4*)(rope + (pos * 16 + 4 * fq) * 2), cs1 = *(const f32x4*)(rope + (pos * 16 + 4 * fq) * 2 + 4);
                    const float cc[4] = {cs0[0], cs0[2], cs1[0], cs1[2]}, sn[4] = {cs0[1], cs0[3], cs1[1], cs1[3]};
#pragma unroll
                    for (int bj = 0; bj < 2; ++bj) { const f32x4 x1 = acc[ai][bj][m][0], x2 = acc[ai][bj][m][1]; float o1[4], o2[4];
#pragma unroll
                        for (int j = 0; j < 4; ++j) { o1[j] = x1[j] * cc[j] - x2[j] * sn[j]; o2[j] = x2[j] * cc[j] + x1[j] * sn[j]; }
                        bf16* p = dst + (size_t)row * SEGW + lc0 + bj * 128;
                        *(v2u*)p = (v2u){pg8::cvt_pk_bf16(o1[0], o1[1]), pg8::cvt_pk_bf16(o1[2], o1[3])};
                        *(v2u*)(p + 16) = (v2u){pg8::cvt_pk_bf16(o2[0], o2[1]), pg8::cvt_pk_bf16(o2[2], o2[3])}; } }
            return;
        }
        if (seg == 5 || seg == 6) {
            const float* lbt = (const float*)(ws + WS_LBT) + (seg - 5) * 512;
#pragma unroll
            for (int bj = 0; bj < 2; ++bj)
#pragma unroll
                for (int n = 0; n < 2; ++n) { const int lc = lc0 + bj * 128 + n * 16; const f32x4 lb = *(const f32x4*)(lbt + lc);
#pragma unroll
                    for (int ai = 0; ai < 2; ++ai)
#pragma unroll
                        for (int m = 0; m < 4; ++m) { const int row = row0 + ai * 128 + m * 16; const f32x4 x = acc[ai][bj][m][n]; float lf[4];
#pragma unroll
                            for (int j = 0; j < 4; ++j) { const float sg = 1.f / (1.f + __expf(-x[j])); lf[j] = __logf(lb[j] + (1.f - lb[j]) * sg); }
                            *(v2u*)(dst + (size_t)row * SEGW + lc) = (v2u){pkh2(lf[0], lf[1]), pkh2(lf[2], lf[3])}; } }
            return;
        }
        const bool act = (seg == 3 || seg == 7);
#pragma unroll
        for (int ai = 0; ai < 2; ++ai)
#pragma unroll
            for (int m = 0; m < 4; ++m) { const int row = row0 + ai * 128 + m * 16;
#pragma unroll
                for (int bj = 0; bj < 2; ++bj)
#pragma unroll
                    for (int n = 0; n < 2; ++n) { f32x4 x = acc[ai][bj][m][n];
                        if (act) {
#pragma unroll
                            for (int j = 0; j < 4; ++j) x[j] = silu_f(x[j]); }
                        *(v2u*)(dst + (size_t)row * SEGW + lc0 + bj * 128 + n * 16) = (v2u){pg8::cvt_pk_bf16(x[0], x[1]), pg8::cvt_pk_bf16(x[2], x[3])}; } }
    }
};
struct EpiRes {
    static constexpr bool PERM = false;
    const float* x; float* x1; const float* mod;
    __device__ __forceinline__ void operator()(const acc_t& acc, const Unit& u, int wr, int wc, int fr, int fq) const {
        const int b = u.pm >> 3; const int col0 = u.pn * 256 + wc * 32 + 4 * fq; const int row0 = u.pm * 256 + wr * 64 + fr;
#pragma unroll
        for (int bj = 0; bj < 2; ++bj)
#pragma unroll
            for (int n = 0; n < 2; ++n) { const int col = col0 + bj * 128 + n * 16; const f32x4 ga = *(const f32x4*)(mod + b * 6144 + 2048 + col);
#pragma unroll
                for (int ai = 0; ai < 2; ++ai)
#pragma unroll
                    for (int m = 0; m < 4; ++m) { const size_t off = (size_t)(row0 + ai * 128 + m * 16) * D + col;
                        const f32x4 xv = *(const f32x4*)(x + off); *(f32x4*)(x1 + off) = xv + ga * acc[ai][bj][m][n]; } }
    }
};
struct EpiSwiGLU {
    static constexpr bool PERM = true;
    bf16* H;
    __device__ __forceinline__ void operator()(const acc_t& acc, const Unit& u, int wr, int wc, int fr, int fq) const {
        const int hc = u.pn * 128 + wc * 32 + 8 * fq; const int row0 = u.pm * 256 + wr * 64 + fr;
#pragma unroll
        for (int ai = 0; ai < 2; ++ai)
#pragma unroll
            for (int m = 0; m < 4; ++m) { float h[8];
#pragma unroll
                for (int n = 0; n < 2; ++n)
#pragma unroll
                    for (int j = 0; j < 4; ++j) h[n * 4 + j] = silu_f(acc[ai][0][m][n][j]) * acc[ai][1][m][n][j];
                u32x4 w; w.x = pg8::cvt_pk_bf16(h[0], h[1]); w.y = pg8::cvt_pk_bf16(h[2], h[3]); w.z = pg8::cvt_pk_bf16(h[4], h[5]); w.w = pg8::cvt_pk_bf16(h[6], h[7]);
                *(u32x4*)(H + (size_t)(row0 + ai * 128 + m * 16) * DE + hc) = w; }
    }
};
struct EpiMoeOut {
    static constexpr bool PERM = true;
    bf16* Y; const int* elist; const float* ewt;
    __device__ __forceinline__ void operator()(const acc_t& acc, const Unit& u, int wr, int wc, int fr, int fq) const {
        const int col0 = u.pn * 256 + wc * 32 + 8 * fq;
#pragma unroll
        for (int ai = 0; ai < 2; ++ai)
#pragma unroll
            for (int m = 0; m < 4; ++m) { const int rank = u.tm * 256 + ai * 128 + wr * 64 + m * 16 + fr;
                if (rank < u.cnt) { const int tk = elist[u.e * ECAP + rank]; const float w = ewt[u.e * ECAP + rank];
#pragma unroll
                    for (int bj = 0; bj < 2; ++bj) { const f32x4 v0 = acc[ai][bj][m][0] * w, v1 = acc[ai][bj][m][1] * w; u32x4 o;
                        o.x = pg8::cvt_pk_bf16(v0[0], v0[1]); o.y = pg8::cvt_pk_bf16(v0[2], v0[3]); o.z = pg8::cvt_pk_bf16(v1[0], v1[1]); o.w = pg8::cvt_pk_bf16(v1[2], v1[3]);
                        *(u32x4*)(Y + (size_t)tk * D + col0 + bj * 128) = o; } } }
    }
};
template <bool GATHER_> struct MoeOrder {
    static constexpr bool GATHER = GATHER_;
    const LAS int* tp; const int* elist; int G, c, nwg;
    __device__ bool next(int i, Unit& u) const {
        const long L = (long)i * G + c; if (L >= nwg) return false;
        int wgid = (int)L; { const int q = nwg / 8, r = nwg % 8, xcd = wgid % 8, off = wgid / 8; wgid = (xcd < r ? xcd * (q + 1) : r * (q + 1) + (xcd - r) * q) + off; }
        const int gt = wgid >> 2; int e = 0;
#pragma unroll
        for (int k = 1; k < 16; ++k) e = (gt >= tp[k]) ? k : e;
        u.pm = gt; u.pn = wgid & 3; u.e = e; u.tm = gt - tp[e]; u.cnt = tp[17 + e]; return true;
    }
    __device__ __forceinline__ int a_row0(const Unit& u) const { return u.pm * 256; }
    __device__ __forceinline__ int a_row(const Unit& u, int r) const {
        if constexpr (GATHER_) { int rank = u.tm * 256 + r; rank = rank < u.cnt ? rank : u.cnt - 1; return elist[u.e * ECAP + rank] >> 1; }
        else return u.pm * 256 + r;
    }
    __device__ __forceinline__ int b_row0(const Unit& u) const { return u.e * 1024 + u.pn * 256; }
};

__device__ __forceinline__ void transpose_item(const float* W, int ldw, int k0, int n0, bf16* WT, int ldk, int drow0, LAS float* scr, int lane) {
#pragma unroll 8
    for (int i = 0; i < 32; ++i) { const int kk = 2 * i + (lane >> 5); scr[kk * 33 + (lane & 31)] = W[(size_t)(k0 + kk) * ldw + n0 + (lane & 31)]; }
    LDS_WAIT(); asm volatile("" ::: "memory");
    const int c = lane & 7;
#pragma unroll
    for (int j = 0; j < 4; ++j) { const int n = (lane >> 3) + 8 * j; const LAS float* s = scr + (8 * c) * 33 + n;
        v4u o; o.x = pk2(s[0 * 33], s[1 * 33]); o.y = pk2(s[2 * 33], s[3 * 33]); o.z = pk2(s[4 * 33], s[5 * 33]); o.w = pk2(s[6 * 33], s[7 * 33]);
        *(GAS v4u*)(WT + (size_t)(drow0 + n) * ldk + k0 + 8 * c) = o; }
    LDS_WAIT(); asm volatile("" ::: "memory");
}

struct Args { const float* in[21]; float* out; unsigned char* ws; int ph_lo, ph_hi, li, pad; };

__global__ void __launch_bounds__(NTHR, 2) fwd_mega(Args args) {
    extern __shared__ __attribute__((aligned(16))) unsigned char lds_raw[];
    LAS unsigned char* lds = (LAS unsigned char*)lds_raw;
    volatile LAS unsigned* MISC = (volatile LAS unsigned*)(lds + MISC_OFF);
    const int tid = threadIdx.x, lane = tid & 63, wave = __builtin_amdgcn_readfirstlane(tid >> 6);
    const int G = gridDim.x; const int bx = blockIdx.x; const int vcu = (G % 8 == 0) ? (bx % 8) * (G / 8) + bx / 8 : bx;
    gu32* ctl0 = (gu32*)(args.ws + WS_CTL);
    const int gw = vcu * NWAVES + wave, NGW = G * NWAVES;
    for (int u = tid; u < (LDS_BYTES - LDSCTL_OFF) / 4; u += NTHR) ((LAS unsigned*)(lds + LDSCTL_OFF))[u] = 0u;
    __syncthreads();
    XcdBarrier bar = xcd_barrier_post((unsigned*)(ctl0 + CW_BAR) + args.li * XCD_BAR_WORDS, MISC + 8);
    const int lo = args.ph_lo, hi = args.ph_hi;
#ifndef PHMASK
#define PHMASK 0xFFFF
#endif
#define IN(k) (((PHMASK >> (k)) & 1) && lo <= (k) && (k) < hi)
#define SEAM(k) do { if (IN(k) && IN((k) + 1)) xcd_barrier(bar); } while (0)

#define KA(i) ({ const __attribute__((address_space(4))) Args* _p = (const __attribute__((address_space(4))) Args*)__builtin_amdgcn_kernarg_segment_ptr(); asm volatile("" : "+s"(_p)); _p->in[i]; })
#define WSP() ({ const __attribute__((address_space(4))) Args* _p = (const __attribute__((address_space(4))) Args*)__builtin_amdgcn_kernarg_segment_ptr(); asm volatile("" : "+s"(_p)); _p->ws; })
#define PHASE_PTRS unsigned char* ws = WSP(); float* MOD = (float*)(ws + WS_MOD); float* ROPE = (float*)(ws + WS_ROPE); float* LBT = (float*)(ws + WS_LBT); \
    bf16* WinT = (bf16*)(ws + WS_WINT); bf16* WoutT = (bf16*)(ws + WS_WOUTT); bf16* W13T = (bf16*)(ws + WS_W13T); bf16* W2T = (bf16*)(ws + WS_W2T); \
    bf16* XN = (bf16*)(ws + WS_XN); bf16* MIX = (bf16*)(ws + WS_MIX); bf16* XN2 = (bf16*)(ws + WS_XN2); \
    float* X1 = (float*)(ws + WS_X1); bf16* Hb = (bf16*)(ws + WS_H); bf16* Yb = (bf16*)(ws + WS_Y); \
    int* ELIST = (int*)(ws + WS_ELIST); float* EWT = (float*)(ws + WS_EWT); gu32* ctl = (gu32*)(ws + WS_CTL); \
    (void)MOD; (void)ROPE; (void)LBT; (void)WinT; (void)WoutT; (void)W13T; (void)W2T; (void)XN; (void)MIX; (void)XN2; (void)X1; (void)Hb; (void)Yb; (void)ELIST; (void)EWT; (void)ctl;
    if (IN(0)) {
        PHASE_PTRS
        const float* cvec = KA(1); const float* c_ctx = KA(3); const float* w_mod = KA(4); const float* b_mod = KA(5); const float* w_in = KA(8); const float* w_out = KA(9);
        const float* hg_lb = KA(11); const float* w1 = KA(17); const float* w3 = KA(18); const float* w2 = KA(19);
        if (bx == G - 1) {
            for (int idx = tid; idx < 1024; idx += NTHR) { const int pos = idx >> 4, i = idx & 15;
                double th = 1.0; for (int k = 0; k < i; ++k) th *= 0.5623413251903491;
                const double t2 = th * th; double c = 1.0, s = th, tc = 1.0, ts = th;
                for (int n = 1; n <= 12; ++n) { tc *= -t2 / (double)((2 * n - 1) * (2 * n)); c += tc; ts *= -t2 / (double)((2 * n) * (2 * n + 1)); s += ts; }
                double cr = 1.0, ci = 0.0; for (int p = 0; p < pos; ++p) { const double nr = cr * c - ci * s; ci = cr * s + ci * c; cr = nr; }
                ROPE[idx * 2] = (float)cr; ROPE[idx * 2 + 1] = (float)ci; }
            for (int idx = tid; idx < 1024; idx += NTHR) { const float h0 = hg_lb[idx], h1 = hg_lb[1024 + idx]; LBT[idx] = 1.f / (1.f + expf(h1 - h0)); }
        }
        if (bx < 96) {
            LAS float* sc = (LAS float*)lds;
            for (int idx = tid; idx < 17 * 1024; idx += NTHR) { const int r = idx >> 10, k = idx & 1023; const float cv = r < 16 ? cvec[r * 1024 + k] : c_ctx[k]; sc[idx] = cv / (1.f + expf(-cv)); }
            __syncthreads();
            const int col = 64 * bx + lane, k0 = 128 * wave;
            float acc[17];
#pragma unroll
            for (int r = 0; r < 17; ++r) acc[r] = 0.f;
            for (int kk = 0; kk < 128; kk += 4) {
                const float w0 = w_mod[(size_t)(k0 + kk) * 6144 + col], w1v = w_mod[(size_t)(k0 + kk + 1) * 6144 + col], w2v = w_mod[(size_t)(k0 + kk + 2) * 6144 + col], w3v = w_mod[(size_t)(k0 + kk + 3) * 6144 + col];
#pragma unroll
                for (int r = 0; r < 17; ++r) { const f32x4 a = *(const LAS f32x4*)(sc + r * 1024 + k0 + kk); acc[r] += a[0] * w0 + a[1] * w1v + a[2] * w2v + a[3] * w3v; }
            }
            LAS float* red = (LAS float*)(lds + 17 * 1024 * 4);
#pragma unroll
            for (int r = 0; r < 17; ++r) red[(wave * 17 + r) * 64 + lane] = acc[r];
            __syncthreads();
            for (int idx = tid; idx < 17 * 64; idx += NTHR) { const int r = idx >> 6, l = idx & 63; float s = 0.f;
#pragma unroll
                for (int w = 0; w < 8; ++w) s += red[(w * 17 + r) * 64 + l];
                MOD[r * 6144 + 64 * bx + l] = s + b_mod[64 * bx + l]; }
            __syncthreads();
        }
        {
            LAS float* scr = (LAS float*)(lds + wave * 16384);
            constexpr int I_IN = 16 * 128, I_OUT = 16 * 32, I_13 = 16 * 2 * 256, I_2 = 16 * 256, NIT = I_IN + I_OUT + I_13 + I_2;
            for (int it = gw; it < NIT; it += NGW) {
                int r = it;
                if (r < I_IN) { const int kb = r / 128, nb = r % 128; transpose_item(w_in, INCOLS, 64 * kb, 32 * nb, WinT, 1024, 32 * nb, scr, lane); continue; } r -= I_IN;
                if (r < I_OUT) { const int kb = r / 32, nb = r % 32; transpose_item(w_out, 1024, 64 * kb, 32 * nb, WoutT, 1024, 32 * nb, scr, lane); continue; } r -= I_OUT;
                if (r < I_13) { const int e = r / 512, rem = r % 512, s = rem / 256, r2 = rem % 256, kb = r2 / 16, nb = r2 % 16, n0 = 32 * nb;
                    transpose_item((s ? w3 : w1) + (size_t)e * 1024 * 512, 512, 64 * kb, n0, W13T, 1024, e * 1024 + 256 * (n0 / 128) + 128 * s + (n0 % 128), scr, lane); continue; } r -= I_13;
                { const int e = r / 256, r2 = r % 256, kb = r2 / 32, nb = r2 % 32; transpose_item(w2 + (size_t)e * 512 * 1024, 1024, 64 * kb, 32 * nb, W2T, 512, e * 1024 + 32 * nb, scr, lane); }
            }
        }
    }
    SEAM(0);

    if (IN(1)) {
        PHASE_PTRS
        const float* x = KA(0); const float* ctx = KA(2); const float* norm_mix = KA(6);
        for (int row = gw; row < MROWS; row += NGW) {
            const float* xr = row < T ? x + (size_t)row * D : ctx + (size_t)(row - T) * D; const int mb = row < T ? (row >> 11) : 16;
            f32x4 v[4]; float s = 0.f;
#pragma unroll
            for (int j = 0; j < 4; ++j) { v[j] = *(const f32x4*)(xr + 4 * lane + 256 * j); s += (v[j][0] * v[j][0] + v[j][1] * v[j][1]) + (v[j][2] * v[j][2] + v[j][3] * v[j][3]); }
            const float rstd = 1.f / sqrtf(wave_sum(s) * (1.f / D) + EPS);
#pragma unroll
            for (int j = 0; j < 4; ++j) { const int col = 4 * lane + 256 * j; const f32x4 g = *(const f32x4*)(norm_mix + col), sh = *(const f32x4*)(MOD + mb * 6144 + col), sc = *(const f32x4*)(MOD + mb * 6144 + 1024 + col);
                const f32x4 y = v[j] * rstd * g * (1.f + sc) + sh;
                *(v2u*)(XN + (size_t)row * D + col) = (v2u){pk2(y[0], y[1]), pk2(y[2], y[3])}; }
        }
    }
    SEAM(1);

    if (IN(2)) {
        PHASE_PTRS
        pg8::DenseOrder S; S.init(MROWS, INCOLS, G, bx);
        EpiProj E{ws};
        pg8::gemm_phase<EpiProj, pg8::DenseOrder>(lds + RING_OFF, XN, WinT, D, S, E);
    }
    SEAM(2);

    if (IN(3)) {
        PHASE_PTRS
        const bf16* Qb = (const bf16*)(ws + WS_Q); const bf16* Kb = (const bf16*)(ws + WS_K); const bf16* Vb = (const bf16*)(ws + WS_V);
        const bf16* HQ = (const bf16*)(ws + WS_HQ); const bf16* HI = (const bf16*)(ws + WS_HI);
        const float* rope = (const float*)ROPE; const float* na_rpb = KA(10);
        if (bx < 128) {
            const int b = bx >> 3, h = (bx >> 1) & 3, dir = bx & 1;
            const unsigned short* LG = (const unsigned short*)(ws + (dir ? WS_LB : WS_LF));
            bf16* OUT = (bf16*)(ws + (dir ? WS_OB : WS_OF));
            const int dv = tid & 127, kg = tid >> 7;
            float St[32];
#pragma unroll
            for (int i = 0; i < 32; ++i) St[i] = 0.f;
            LAS float* sq = (LAS float*)lds;
            LAS float* sk = sq + 16 * 128;
            LAS float* sf = sk + 16 * 128;
            LAS float* sv = sf + 16 * 128;
            LAS float* so = sv + 16 * 128;
            constexpr int NSTEP = LC + SEQ;
            for (int j0 = 0; j0 < NSTEP; j0 += 16) {
                const bool isctx = j0 < LC;
                { const int st = tid >> 5, c4 = (tid & 31) * 4, j = j0 + st;
                  int row; if (j < LC) row = T + b * LC + (dir ? (LC - 1 - j) : j); else row = b * SEQ + (dir ? (SEQ - 1 - (j - LC)) : (j - LC));
                  const size_t off = (size_t)row * SEGW + h * HGD + c4;
                  const v2u lg = *(const v2u*)(LG + off), vi = *(const v2u*)(HI + off);
                  float f0 = __expf(h2f((unsigned short)(lg.x & 0xffff))), f1 = __expf(h2f((unsigned short)(lg.x >> 16))), f2 = __expf(h2f((unsigned short)(lg.y & 0xffff))), f3 = __expf(h2f((unsigned short)(lg.y >> 16)));
                  *(LAS f32x4*)(sf + st * 128 + c4) = (f32x4){f0, f1, f2, f3};
                  *(LAS f32x4*)(sk + st * 128 + c4) = (f32x4){1.f - f0, 1.f - f1, 1.f - f2, 1.f - f3};
                  *(LAS f32x4*)(sv + st * 128 + c4) = (f32x4){bflo(vi.x), bfhi(vi.x), bflo(vi.y), bfhi(vi.y)};
                  if (!isctx) { const v2u qq = *(const v2u*)(HQ + off); *(LAS f32x4*)(sq + st * 128 + c4) = (f32x4){bflo(qq.x), bfhi(qq.x), bflo(qq.y), bfhi(qq.y)}; }
                }
                __syncthreads();
                for (int st = 0; st < 16; ++st) {
                    const float vv = sv[st * 128 + dv]; float o = 0.f;
#pragma unroll
                    for (int i = 0; i < 32; i += 4) {
                        const f32x4 f4 = *(const LAS f32x4*)(sf + st * 128 + kg * 32 + i), k4 = *(const LAS f32x4*)(sk + st * 128 + kg * 32 + i), q4 = *(const LAS f32x4*)(sq + st * 128 + kg * 32 + i);
#pragma unroll
                        for (int jj = 0; jj < 4; ++jj) { St[i + jj] = f4[jj] * St[i + jj] + k4[jj] * vv; o += St[i + jj] * q4[jj]; }
                    }
                    so[(st * 4 + kg) * 128 + dv] = o;
                }
                __syncthreads();
                if (!isctx) {
                    for (int idx = tid; idx < 16 * 128; idx += NTHR) { const int st = idx >> 7, d = idx & 127, j = j0 + st;
                        const float o = (so[(st * 4 + 0) * 128 + d] + so[(st * 4 + 1) * 128 + d]) + (so[(st * 4 + 2) * 128 + d] + so[(st * 4 + 3) * 128 + d]);
                        const int row = b * SEQ + (dir ? (SEQ - 1 - (j - LC)) : (j - LC));
                        OUT[(size_t)row * SEGW + h * HGD + d] = (bf16)f2bf(o); }
                }
                __syncthreads();
            }
        } else {
            const int nwv = (G - 128) * NWAVES; const int wv = (bx - 128) * NWAVES + wave;
            for (int unit = wv; unit < T * NAH; unit += nwv) {
                const int hh = unit & 7, tok = unit >> 3, b = tok >> 11, s = tok & (SEQ - 1), r = s >> 6, qc = s & 63;
                const float qraw = bf2f(Qb[(size_t)tok * SEGW + hh * NAD + lane]);
                const float qpart = __shfl_xor(qraw, 16);
                const int pos = (lane < 32) ? r : qc; const int fi = lane & 15;
                const float cs = rope[(pos * 16 + fi) * 2], sn = rope[(pos * 16 + fi) * 2 + 1];
                const float qrot = ((lane & 31) < 16) ? (qraw * cs - qpart * sn) : (qraw * cs + qpart * sn);
                int rs = r - 4; rs = rs < 0 ? 0 : (rs > NROWS - 8 ? NROWS - 8 : rs);
                int c0 = qc - 8; c0 = c0 < 0 ? 0 : (c0 > GW - 16 ? GW - 16 : c0);
                float sc[6];
#pragma unroll
                for (int t = 0; t < 6; ++t) {
                    const int kk = lane + 64 * t; int krow; float bias = 0.f;
                    if (t < 2) { const int i = kk >> 4, cc = kk & 15; const int kr = rs + i, kc = c0 + cc; krow = b * SEQ + kr * GW + kc;
                        int co = kc - qc + 15; co = co < 0 ? 0 : (co > 30 ? 30 : co);
                        bias = na_rpb[(hh * 15 + (kr - r + 7)) * 31 + co]; }
                    else krow = T + b * LC + (kk - 128);
                    const bf16* kp = Kb + (size_t)krow * SEGW + hh * NAD;
                    float dot = 0.f;
#pragma unroll
                    for (int d8 = 0; d8 < 8; ++d8) { const v4u kv = *(const v4u*)(kp + d8 * 8);
#pragma unroll
                        for (int e = 0; e < 4; ++e) { const unsigned wv2 = kv[e]; const int d = d8 * 8 + e * 2;
                            const float q0 = __shfl(t < 2 ? qrot : qraw, d), q1 = __shfl(t < 2 ? qrot : qraw, d + 1);
                            dot += q0 * bflo(wv2) + q1 * bfhi(wv2); } }
                    sc[t] = dot * 0.125f + bias;
                }
                float mx = sc[0];
#pragma unroll
                for (int t = 1; t < 6; ++t) mx = fmaxf(mx, sc[t]);
                mx = wave_max(mx);
                float sum = 0.f;
#pragma unroll
                for (int t = 0; t < 6; ++t) { sc[t] = __expf(sc[t] - mx); sum += sc[t]; }
                sum = wave_sum(sum); const float inv = 1.f / sum;
                float o = 0.f;
#pragma unroll
                for (int t = 0; t < 6; ++t) {
                    for (int l = 0; l < 64; ++l) {
                        const int kk = l + 64 * t; int krow;
                        if (t < 2) { const int i = kk >> 4, cc = kk & 15; krow = b * SEQ + (rs + i) * GW + c0 + cc; } else krow = T + b * LC + (kk - 128);
                        const float p = __shfl(sc[t], l);
                        o += p * bf2f(Vb[(size_t)krow * SEGW + hh * NAD + lane]);
                    }
                }
                MIX[(size_t)tok * D + hh * NAD + lane] = (bf16)f2bf(o * inv);
            }
        }
    }
    SEAM(3);

    if (IN(4)) {
        PHASE_PTRS
        const float* hg_norm = KA(12);
        const bf16* OF = (const bf16*)(ws + WS_OF); const bf16* OB = (const bf16*)(ws + WS_OB); const bf16* Gb = (const bf16*)(ws + WS_G);
        for (int tok = gw; tok < T; tok += NGW) {
            const size_t off = (size_t)tok * SEGW + lane * 8;
            const v4u a = *(const v4u*)(OF + off), bb = *(const v4u*)(OB + off), g = *(const v4u*)(Gb + off);
            float o[8]; float ss = 0.f;
#pragma unroll
            for (int e = 0; e < 4; ++e) { o[2 * e] = bflo(a[e]) + bflo(bb[e]); o[2 * e + 1] = bfhi(a[e]) + bfhi(bb[e]); ss += o[2 * e] * o[2 * e] + o[2 * e + 1] * o[2 * e + 1]; }
            ss += __shfl_xor(ss, 1); ss += __shfl_xor(ss, 2); ss += __shfl_xor(ss, 4); ss += __shfl_xor(ss, 8);
            const float rstd = 1.f / sqrtf(ss * (1.f / HGD) + EPS);
            const int dv0 = (lane & 15) * 8;
            const f32x4 g0 = *(const f32x4*)(hg_norm + dv0), g1 = *(const f32x4*)(hg_norm + dv0 + 4);
            const float gg[8] = {g0[0], g0[1], g0[2], g0[3], g1[0], g1[1], g1[2], g1[3]};
            float y[8];
#pragma unroll
            for (int e = 0; e < 4; ++e) { y[2 * e] = o[2 * e] * rstd * gg[2 * e] * bflo(g[e]); y[2 * e + 1] = o[2 * e + 1] * rstd * gg[2 * e + 1] * bfhi(g[e]); }
            *(v4u*)(MIX + (size_t)tok * D + 512 + lane * 8) = (v4u){pk2(y[0], y[1]), pk2(y[2], y[3]), pk2(y[4], y[5]), pk2(y[6], y[7])};
        }
    }
    SEAM(4);

    if (IN(5)) {
        PHASE_PTRS
        pg8::DenseOrder S; S.init(T, D, G, bx);
        EpiRes E{KA(0), X1, MOD};
        pg8::gemm_phase<EpiRes, pg8::DenseOrder>(lds + RING_OFF, MIX, WoutT, D, S, E);
    }
    SEAM(5);

    if (IN(6)) {
        PHASE_PTRS
        const float* norm_ffn = KA(7); const float* w_grp = KA(13); const float* b_grp = KA(14); const float* w_exp = KA(15); const float* b_exp = KA(16);
        LAS f32x4* wl = (LAS f32x4*)lds;
        for (int idx = tid; idx < 5 * 1024; idx += NTHR) { const int quad = idx >> 10, col = idx & 1023; const int l = (col & 255) >> 2, q = col & 3, j = col >> 8;
            const f32x4 w = quad == 0 ? *(const f32x4*)(w_grp + col * 4) : *(const f32x4*)(w_exp + col * 16 + (quad - 1) * 4);
            wl[((quad * 4 + q) * 4 + j) * 64 + l] = w; }
        LAS int* lcnt = (LAS int*)(lds + 81920);
        LAS int* tmpe = (LAS int*)(lds + 81920 + 256);
        if (tid < 32) lcnt[tid] = 0;
        __syncthreads();
        const int rowbase = bx * 128 + wave * 16;
#pragma unroll 1
        for (int i = 0; i < 16; ++i) {
            asm volatile("" ::: "memory");
            const int row = rowbase + i; const int mb = row >> 11;
            const float* xr = X1 + (size_t)row * D;
            f32x4 v[4]; float s = 0.f;
#pragma unroll
            for (int j = 0; j < 4; ++j) { v[j] = *(const f32x4*)(xr + 4 * lane + 256 * j); s += (v[j][0] * v[j][0] + v[j][1] * v[j][1]) + (v[j][2] * v[j][2] + v[j][3] * v[j][3]); }
            const float rstd = 1.f / sqrtf(wave_sum(s) * (1.f / D) + EPS);
            float lg[20];
#pragma unroll
            for (int k = 0; k < 20; ++k) lg[k] = 0.f;
#pragma unroll
            for (int j = 0; j < 4; ++j) { const int col = 4 * lane + 256 * j; const f32x4 g = *(const f32x4*)(norm_ffn + col), sh = *(const f32x4*)(MOD + mb * 6144 + 3072 + col), sc = *(const f32x4*)(MOD + mb * 6144 + 4096 + col);
                const f32x4 y = v[j] * rstd * g * (1.f + sc) + sh;
                asm volatile("" ::: "memory");
                *(v2u*)(XN2 + (size_t)row * D + col) = (v2u){pk2(y[0], y[1]), pk2(y[2], y[3])};
#pragma unroll
                for (int q = 0; q < 4; ++q)
#pragma unroll
                    for (int quad = 0; quad < 5; ++quad) { const f32x4 w = wl[((quad * 4 + q) * 4 + j) * 64 + lane];
                        lg[quad * 4 + 0] += y[q] * w[0]; lg[quad * 4 + 1] += y[q] * w[1]; lg[quad * 4 + 2] += y[q] * w[2]; lg[quad * 4 + 3] += y[q] * w[3]; } }
#pragma unroll
            for (int k = 0; k < 20; ++k) lg[k] = wave_sum(lg[k]);
            if (lane == 0) {
                float gl[4];
#pragma unroll
                for (int k = 0; k < 4; ++k) gl[k] = lg[k] + b_grp[k];
                int gs = 0; float gm = gl[0];
#pragma unroll
                for (int k = 1; k < 4; ++k) if (gl[k] > gm) { gm = gl[k]; gs = k; }
                float den = 0.f;
#pragma unroll
                for (int k = 0; k < 4; ++k) den += __expf(gl[k] - gm);
                const float g_w = 1.f / den;
                float ev[4];
#pragma unroll
                for (int k = 0; k < 4; ++k) { float a = lg[4 + k] + b_exp[k];
#pragma unroll
                    for (int g2 = 1; g2 < 4; ++g2) a = (gs == g2) ? (lg[4 + g2 * 4 + k] + b_exp[g2 * 4 + k]) : a;
                    ev[k] = a; }
                int i0 = 0; float v0 = ev[0];
#pragma unroll
                for (int k = 1; k < 4; ++k) if (ev[k] > v0) { v0 = ev[k]; i0 = k; }
                int i1 = -1; float v1 = -INFINITY;
#pragma unroll
                for (int k = 0; k < 4; ++k) if (k != i0 && ev[k] > v1) { v1 = ev[k]; i1 = k; }
                const float e1 = __expf(v1 - v0); const float w0 = g_w / (1.f + e1), w1w = g_w * e1 / (1.f + e1);
                const int ea = gs * 4 + i0, eb = gs * 4 + i1;
                const int ra = __hip_atomic_fetch_add(&lcnt[ea], 1, __ATOMIC_RELAXED, __HIP_MEMORY_SCOPE_WORKGROUP), rb = __hip_atomic_fetch_add(&lcnt[eb], 1, __ATOMIC_RELAXED, __HIP_MEMORY_SCOPE_WORKGROUP);
                const int lr = (wave * 16 + i) * 2;
                tmpe[lr] = ea; tmpe[256 + lr] = ra; tmpe[512 + lr] = __builtin_bit_cast(int, w0);
                tmpe[lr + 1] = eb; tmpe[256 + lr + 1] = rb; tmpe[512 + lr + 1] = __builtin_bit_cast(int, w1w);
            }
        }
        __syncthreads();
        if (tid < 16) lcnt[16 + tid] = (int)__hip_atomic_fetch_add(ctl + CW_CNT + tid, (unsigned)lcnt[tid], RLX_AGENT);
        __syncthreads();
        if (tid < 256) { const int e = tmpe[tid], pos = lcnt[16 + e] + tmpe[256 + tid]; const int tok = bx * 128 + (tid >> 1);
            ELIST[e * ECAP + pos] = tok * 2 + (tid & 1); EWT[e * ECAP + pos] = __builtin_bit_cast(float, tmpe[512 + tid]); }
        __syncthreads();
    }
    SEAM(6);

    if (IN(7) || IN(8)) {
        PHASE_PTRS
        LAS int* tp = (LAS int*)(lds + MOE_OFF);
        if (tid == 0) { int acc = 0;
            for (int e = 0; e < 16; ++e) { const int c = (int)__hip_atomic_load(ctl + CW_CNT + e, RLX_AGENT); tp[e] = acc; tp[17 + e] = c; acc += (c + 255) >> 8; }
            tp[16] = acc; }
        __syncthreads();
    }
    if (IN(7)) {
        PHASE_PTRS
        const LAS int* tp = (const LAS int*)(lds + MOE_OFF);
        MoeOrder<true> S{tp, ELIST, G, bx, tp[16] * 4};
        EpiSwiGLU E{Hb};
        pg8::gemm_phase<EpiSwiGLU, MoeOrder<true>>(lds + RING_OFF, XN2, W13T, D, S, E);
    }
    SEAM(7);
    if (IN(8)) {
        PHASE_PTRS
        const LAS int* tp = (const LAS int*)(lds + MOE_OFF);
        MoeOrder<false> S{tp, ELIST, G, bx, tp[16] * 4};
        EpiMoeOut E{Yb, ELIST, EWT};
        pg8::gemm_phase<EpiMoeOut, MoeOrder<false>>(lds + RING_OFF, Hb, W2T, DE, S, E);
    }
    SEAM(8);

    if (IN(9)) {
        PHASE_PTRS
        const float* norm_final = KA(20); float* outp = ({ const __attribute__((address_space(4))) Args* _p = (const __attribute__((address_space(4))) Args*)__builtin_amdgcn_kernarg_segment_ptr(); asm volatile("" : "+s"(_p)); _p->out; });
        for (int row = gw; row < T; row += NGW) {
            const int mb = row >> 11; f32x4 v[4]; float s = 0.f;
#pragma unroll
            for (int j = 0; j < 4; ++j) { const int col = 4 * lane + 256 * j; const f32x4 xv = *(const f32x4*)(X1 + (size_t)row * D + col), ga = *(const f32x4*)(MOD + mb * 6144 + 5120 + col);
                const v2u y0 = *(const v2u*)(Yb + (size_t)(2 * row) * D + col), y1 = *(const v2u*)(Yb + (size_t)(2 * row + 1) * D + col);
                const f32x4 ys = (f32x4){bflo(y0.x) + bflo(y1.x), bfhi(y0.x) + bfhi(y1.x), bflo(y0.y) + bflo(y1.y), bfhi(y0.y) + bfhi(y1.y)};
                v[j] = xv + ga * ys; s += (v[j][0] * v[j][0] + v[j][1] * v[j][1]) + (v[j][2] * v[j][2] + v[j][3] * v[j][3]); }
            const float rstd = 1.f / sqrtf(wave_sum(s) * (1.f / D) + EPS);
#pragma unroll
            for (int j = 0; j < 4; ++j) { const int col = 4 * lane + 256 * j; const f32x4 g = *(const f32x4*)(norm_final + col);
                *(f32x4*)(outp + (size_t)row * D + col) = v[j] * rstd * g; }
        }
    }
#undef IN
#undef SEAM
}

#ifndef MK_N_LAUNCHES
#define MK_N_LAUNCHES 1
#endif
constexpr int NPHASE = 10;
extern "C" void kernel_launch(void* const* d_in, const int* in_sizes, int n_in, void* d_out, int out_size, void* d_ws, size_t ws_size, hipStream_t stream) {
    static int grid = 0;
    if (grid == 0) {
        if (n_in != 21 || in_sizes[0] != T * D || out_size != T * D || ws_size < WS_END) { fprintf(stderr, "kernel_launch: unexpected shapes (n_in %d, in0 %d, out %d, ws %zu)\n", n_in, n_in > 0 ? in_sizes[0] : -1, out_size, ws_size); grid = -1; return; }
        int dev = 0, cus = 0, per_cu = 0;
        if (hipGetDevice(&dev) != hipSuccess || hipDeviceGetAttribute(&cus, hipDeviceAttributeMultiprocessorCount, dev) != hipSuccess) { grid = -1; return; }
        if (hipFuncSetAttribute((const void*)fwd_mega, hipFuncAttributeMaxDynamicSharedMemorySize, LDS_BYTES) != hipSuccess) { fprintf(stderr, "kernel_launch: hipFuncSetAttribute failed\n"); grid = -1; return; }
        if (hipOccupancyMaxActiveBlocksPerMultiprocessor(&per_cu, (const void*)fwd_mega, NTHR, LDS_BYTES) != hipSuccess || per_cu < 1) fprintf(stderr, "kernel_launch: occupancy query reports %d\n", per_cu);
        (void)hipGetLastError();
        grid = cus;
        if (grid != 256) fprintf(stderr, "kernel_launch: %d CUs (built for 256)\n", grid);
    }
    if (grid < 0) return;
    (void)hipMemsetAsync((char*)d_ws + WS_CTL, 0, CTL_ZERO_BYTES, stream);
    Args a{};
    for (int i = 0; i < 21; ++i) a.in[i] = (const float*)d_in[i];
    a.out = (float*)d_out; a.ws = (unsigned char*)d_ws;
    if (MK_N_LAUNCHES == 1) {
        a.ph_lo = 0; a.ph_hi = NPHASE; a.li = 0;
        hipLaunchKernelGGL(fwd_mega, dim3(grid), dim3(NTHR), LDS_BYTES, stream, a);
    } else {
        for (int li = 0; li < NPHASE; ++li) { a.ph_lo = li; a.ph_hi = li + 1; a.li = 0; hipLaunchKernelGGL(fwd_mega, dim3(grid), dim3(NTHR), LDS_BYTES, stream, a); }
    }
}
```

```cpp
#include <hip/hip_runtime.h>
#include <cstdio>
#include <cstdint>

#define GAS __attribute__((address_space(1)))
#define LAS __attribute__((address_space(3)))
typedef unsigned short bf16;
typedef unsigned short bf16_t;
typedef unsigned v4u __attribute__((ext_vector_type(4)));
typedef unsigned v2u __attribute__((ext_vector_type(2)));
typedef float f32x4 __attribute__((ext_vector_type(4)));
typedef float f32x2 __attribute__((ext_vector_type(2)));
typedef short bf16x8 __attribute__((ext_vector_type(8)));
typedef unsigned u32x4 __attribute__((ext_vector_type(4)));
typedef GAS unsigned gu32;
#define RLX_AGENT __ATOMIC_RELAXED, __HIP_MEMORY_SCOPE_AGENT
#define LDS_WAIT() asm volatile("s_waitcnt lgkmcnt(0)" ::: "memory")
#define VM_WAIT() asm volatile("s_waitcnt vmcnt(0)" ::: "memory")

constexpr int NB = 16, SEQ = 2048, D = 1024, T = NB * SEQ, LC = 256, TC = NB * LC, MROWS = T + TC;
constexpr int GW = 64, NROWS = SEQ / GW;
constexpr int INCOLS = 4096, SEGW = 512;
constexpr int NAH = 8, NAD = 64, HGH = 4, HGD = 128;
constexpr int NE = 16, DE = 512, ECAP = T;
constexpr float EPS = 1e-6f;
constexpr int NWAVES = 8, NTHR = 512;

constexpr size_t MiB = 1u << 20;
constexpr size_t WS_CTL = 0, CTL_ZERO_BYTES = 1 * MiB;
constexpr size_t WS_MOD = 1 * MiB;
constexpr size_t WS_ROPE = WS_MOD + 512 * 1024, WS_LBT = WS_MOD + 520 * 1024;
constexpr size_t WS_ELIST = 2 * MiB, WS_EWT = 4 * MiB;
constexpr size_t WS_WINT = 8 * MiB, WS_WOUTT = 16 * MiB, WS_W13T = 18 * MiB, WS_W2T = 50 * MiB;
constexpr size_t WS_XN = 66 * MiB;
constexpr size_t WS_Q = 138 * MiB, WS_K = 170 * MiB, WS_V = 206 * MiB, WS_HQ = 242 * MiB, WS_HI = 274 * MiB, WS_LF = 310 * MiB, WS_LB = 346 * MiB, WS_G = 382 * MiB;
constexpr size_t WS_OF = 414 * MiB, WS_OB = 446 * MiB, WS_QR = 478 * MiB, WS_END = 510 * MiB;
constexpr size_t WS_MIX = WS_XN, WS_XN2 = WS_XN, WS_X1 = 138 * MiB, WS_H = 274 * MiB, WS_Y = 346 * MiB;
constexpr int CW_CNT = 64;
constexpr int CW_BAR = 4096;

constexpr int RING_OFF = 0, RING_BYTES = 131072;
constexpr int LDSCTL_OFF = RING_BYTES, MISC_OFF = LDSCTL_OFF + 320, MOE_OFF = LDSCTL_OFF + 1024;
constexpr int LDS_BYTES = 147456;

__device__ __forceinline__ unsigned f2bf(float f) { unsigned u = __builtin_bit_cast(unsigned, f); return (u + 0x7fffu + ((u >> 16) & 1u)) >> 16; }
__device__ __forceinline__ unsigned pk2(float lo, float hi) { return f2bf(lo) | (f2bf(hi) << 16); }
__device__ __forceinline__ float bf2f(unsigned short b) { return __builtin_bit_cast(float, (unsigned)b << 16); }
__device__ __forceinline__ float bflo(unsigned u) { return __builtin_bit_cast(float, u << 16); }
__device__ __forceinline__ float bfhi(unsigned u) { return __builtin_bit_cast(float, u & 0xffff0000u); }
__device__ __forceinline__ unsigned pkh2(float lo, float hi) { _Float16 a = (_Float16)lo, b = (_Float16)hi; return (unsigned)__builtin_bit_cast(unsigned short, a) | ((unsigned)__builtin_bit_cast(unsigned short, b) << 16); }
__device__ __forceinline__ float h2f(unsigned short h) { return (float)__builtin_bit_cast(_Float16, h); }
__device__ __forceinline__ float silu_f(float v) { return v / (1.f + __expf(-v)); }
__device__ __forceinline__ float wave_sum(float v) {
#pragma unroll
    for (int o = 1; o < 64; o <<= 1) v += __shfl_xor(v, o);
    return v;
}
__device__ __forceinline__ float wave_max(float v) {
#pragma unroll
    for (int o = 1; o < 64; o <<= 1) v = fmaxf(v, __shfl_xor(v, o));
    return v;
}

namespace pg8 {
constexpr int BM = 256, BK = 64, HALF = 128, HTB = HALF * BK * 2, STAGE_BYTES = 8 * HTB, NXCD = 8, WGM = 8;
__host__ __device__ __forceinline__ int lds_byte(int r, int c) { const int st = (r >> 4) * 2 + (c >> 5), rr = r & 15, cc = c & 31, ob = rr * 64 + cc * 2; return st * 1024 + (ob ^ (((ob >> 9) & 1) << 5)); }
__host__ __device__ __forceinline__ void stage_rc(int b, int& R, int& C) { const int st = b / 1024, sb = b % 1024, swz = sb ^ (((sb >> 9) & 1) << 5); R = (st >> 1) * 16 + swz / 64; C = (st & 1) * 32 + (swz % 64) / 2; }
__host__ __device__ __forceinline__ int perm32(int rho) { const int n = rho >> 4, i = rho & 15; return 8 * (i >> 2) + 4 * n + (i & 3); }

struct Unit { int pm, pn, e, tm, cnt; };

__device__ __forceinline__ unsigned cvt_pk_bf16(float lo, float hi) { unsigned r; asm volatile("v_cvt_pk_bf16_f32 %0, %1, %2" : "=v"(r) : "v"(lo), "v"(hi)); return r; }

struct DenseOrder {
    static constexpr bool GATHER = false;
    int nM, nN, nwg, G, c;
    __device__ void init(int M, int N, int G_, int c_) { nM = M / BM; nN = N / BM; nwg = nM * nN; G = G_; c = c_; }
    __device__ bool next(int i, Unit& u) const {
        const long L = (long)i * G + c; if (L >= nwg) return false;
        int wgid = (int)L; { const int q = nwg / NXCD, r = nwg % NXCD, xcd = wgid % NXCD, off = wgid / NXCD; wgid = (xcd < r ? xcd * (q + 1) : r * (q + 1) + (xcd - r) * q) + off; }
        const int nig = WGM * nN, gid = wgid / nig, fm = gid * WGM, gsz = (nM - fm) < WGM ? (nM - fm) : WGM;
        u.pm = fm + ((wgid % nig) % gsz); u.pn = (wgid % nig) / gsz; u.e = 0; u.tm = 0; u.cnt = 0; return true;
    }
    __device__ __forceinline__ int a_row0(const Unit& u) const { return u.pm * BM; }
    __device__ __forceinline__ int a_row(const Unit& u, int r) const { return u.pm * BM + r; }
    __device__ __forceinline__ int b_row0(const Unit& u) const { return u.pn * BM; }
};

template <class Epi, class Sched>
__device__ __forceinline__ void gemm_phase(LAS unsigned char* lds, const bf16_t* Aptr, const bf16_t* Btptr, const int K, const Sched& S, const Epi& E) {
    const int tid = threadIdx.x, wid = __builtin_amdgcn_readfirstlane(tid >> 6), lane = tid & 63, wr = wid >> 2, wc = wid & 3, fr = lane & 15, fq = lane >> 4;
    const int nt = K / BK;
    int sR[2], sC[2];
    unsigned voffA[2], voffB[2];
#pragma unroll
    for (int i = 0; i < 2; ++i) { int R, C; stage_rc(tid * 16 + i * 8192, R, C); const int Rb = Epi::PERM ? ((R & ~31) + perm32(R & 31)) : R;
        sR[i] = R; sC[i] = C; voffA[i] = (unsigned)(R * K + C) * 2u; voffB[i] = (unsigned)(Rb * K + C) * 2u; }
    const size_t kstep = (size_t)(BK * 2);
    const size_t hstep = (size_t)HALF * K * 2;
    const size_t rowb = (size_t)K * 2;
    const unsigned ldsw = (unsigned)wid * 1024u;
    const int aoff = lds_byte(wr * 64 + fr, fq * 8), boff = lds_byte(wc * 32 + fr, fq * 8);
    const char* Ab = (const char*)Aptr;
#define PG8_SA(b, h) (((b) * 2 + (h)) * HTB)
#define PG8_SB(b, h) ((4 + (b) * 2 + (h)) * HTB)
#define PG8_STAGE(bufoff, gbase, voff) do { _Pragma("unroll") for (int _i = 0; _i < 2; ++_i) \
        __builtin_amdgcn_global_load_lds((const unsigned*)((const char*)(gbase) + (voff)[_i]), (LAS unsigned*)(lds + (bufoff) + ldsw + _i * 8192), 16, 0, 0); } while (0)
#define PG8_LDA(dst, b, h) do { _Pragma("unroll") for (int m = 0; m < 4; ++m) _Pragma("unroll") for (int k = 0; k < 2; ++k) dst[m][k] = *(const LAS bf16x8*)(lds + PG8_SA(b, h) + aoff + m * 2048 + k * 1024); } while (0)
#define PG8_LDB(dst, b, h) do { _Pragma("unroll") for (int n = 0; n < 2; ++n) _Pragma("unroll") for (int k = 0; k < 2; ++k) dst[n][k] = *(const LAS bf16x8*)(lds + PG8_SB(b, h) + boff + n * 2048 + k * 1024); } while (0)
#define PG8_MMA(ai, bj, At, Bt) do { __builtin_amdgcn_s_setprio(1); _Pragma("unroll") for (int m = 0; m < 4; ++m) _Pragma("unroll") for (int n = 0; n < 2; ++n) _Pragma("unroll") for (int k = 0; k < 2; ++k) \
        acc[ai][bj][m][n] = __builtin_amdgcn_mfma_f32_16x16x32_bf16(Bt[n][k], At[m][k], acc[ai][bj][m][n], 0, 0, 0); __builtin_amdgcn_s_setprio(0); } while (0)
#define PG8_WAIT_V(n) asm volatile("s_waitcnt vmcnt(" #n ")" ::: "memory")
#define PG8_WAIT_L(n) asm volatile("s_waitcnt lgkmcnt(" #n ")" ::: "memory")
#define PG8_BAR __builtin_amdgcn_s_barrier()
#define PG8_SCHED __builtin_amdgcn_sched_barrier(0)
    Unit cur, nxt; int ui = 0;
    if (!S.next(0, cur)) return;
    f32x4 acc[2][2][4][2];
#pragma unroll
    for (int a = 0; a < 2; ++a)
#pragma unroll
        for (int b = 0; b < 2; ++b)
#pragma unroll
            for (int m = 0; m < 4; ++m)
#pragma unroll
                for (int n = 0; n < 2; ++n) acc[a][b][m][n] = (f32x4){0.f, 0.f, 0.f, 0.f};
    bf16x8 At[4][2], B0[2][2], B1[2][2];
    const char* cA = Ab; unsigned cG[2][2];
    if constexpr (Sched::GATHER) {
#pragma unroll
        for (int h = 0; h < 2; ++h)
#pragma unroll
            for (int i = 0; i < 2; ++i) cG[h][i] = (unsigned)((size_t)S.a_row(cur, h * HALF + sR[i]) * rowb) + (unsigned)sC[i] * 2u;
    } else { cA = Ab + (ptrdiff_t)S.a_row0(cur) * (ptrdiff_t)rowb; cG[0][0] = cG[0][1] = cG[1][0] = cG[1][1] = 0u; }
    const char* cB = (const char*)Btptr + (ptrdiff_t)S.b_row0(cur) * (ptrdiff_t)rowb;
#define PG8_STAGEA(bufoff, h, dbase, goffs, kb) do { if constexpr (Sched::GATHER) { PG8_STAGE(bufoff, Ab + (kb), (goffs)[h]); } else { PG8_STAGE(bufoff, (dbase) + (h) * hstep + (kb), voffA); } } while (0)
    PG8_STAGE(PG8_SB(0, 0), cB, voffB); PG8_STAGE(PG8_SB(0, 1), cB + hstep, voffB); PG8_STAGEA(PG8_SA(0, 0), 0, cA, cG, 0); PG8_STAGEA(PG8_SA(0, 1), 1, cA, cG, 0);
    if (wr == 1) PG8_BAR;
    PG8_WAIT_V(2); PG8_BAR;
    PG8_STAGE(PG8_SB(1, 0), cB + kstep, voffB); PG8_STAGEA(PG8_SA(1, 0), 0, cA, cG, kstep); PG8_STAGE(PG8_SB(1, 1), cB + hstep + kstep, voffB);
    PG8_WAIT_V(6); PG8_BAR;
    for (;;) {
        const bool has_next = S.next(ui + 1, nxt);
        const char* nA = cA; const char* nB = cB; unsigned nG[2][2];
#pragma unroll
        for (int h = 0; h < 2; ++h)
#pragma unroll
            for (int i = 0; i < 2; ++i) nG[h][i] = cG[h][i];
        if (has_next) {
            nB = (const char*)Btptr + (ptrdiff_t)S.b_row0(nxt) * (ptrdiff_t)rowb;
            if constexpr (Sched::GATHER) {
#pragma unroll
                for (int h = 0; h < 2; ++h)
#pragma unroll
                    for (int i = 0; i < 2; ++i) nG[h][i] = (unsigned)((size_t)S.a_row(nxt, h * HALF + sR[i]) * rowb) + (unsigned)sC[i] * 2u;
            } else nA = Ab + (ptrdiff_t)S.a_row0(nxt) * (ptrdiff_t)rowb;
        }
        for (int t = 0; t < nt; t += 2) {
            const bool last = (t == nt - 2);
            const size_t kb1 = (size_t)(t + 1) * kstep;
            const size_t kb2 = last ? 0 : (size_t)(t + 2) * kstep, kb3 = kb2 + kstep;
            const char* a2 = last ? nA : cA; const char* b2 = last ? nB : cB + (size_t)(t + 2) * kstep; const char* b3 = b2 + kstep;
            unsigned g2[2][2];
#pragma unroll
            for (int h = 0; h < 2; ++h)
#pragma unroll
                for (int i = 0; i < 2; ++i) g2[h][i] = last ? nG[h][i] : cG[h][i];
            PG8_LDB(B0, 0, 0); PG8_LDB(B1, 0, 1); PG8_SCHED; PG8_LDA(At, 0, 0); PG8_STAGEA(PG8_SA(1, 1), 1, cA, cG, kb1);
            PG8_WAIT_V(8); PG8_WAIT_L(0); PG8_BAR; PG8_MMA(0, 0, At, B0); PG8_MMA(0, 1, At, B1); PG8_BAR; PG8_SCHED;
            PG8_LDA(At, 0, 1); PG8_STAGE(PG8_SB(0, 0), b2, voffB); PG8_STAGE(PG8_SB(0, 1), b2 + hstep, voffB); PG8_STAGEA(PG8_SA(0, 0), 0, a2, g2, kb2);
            PG8_WAIT_V(8); PG8_WAIT_L(0); PG8_BAR; PG8_MMA(1, 0, At, B0); PG8_MMA(1, 1, At, B1); PG8_BAR; PG8_SCHED;
            PG8_LDB(B0, 1, 0); PG8_LDB(B1, 1, 1); PG8_SCHED; PG8_LDA(At, 1, 0); PG8_STAGEA(PG8_SA(0, 1), 1, a2, g2, kb2);
            PG8_WAIT_V(8); PG8_WAIT_L(0); PG8_BAR; PG8_MMA(0, 0, At, B0); PG8_MMA(0, 1, At, B1); PG8_BAR; PG8_SCHED;
            PG8_LDA(At, 1, 1); PG8_STAGE(PG8_SB(1, 0), b3, voffB); PG8_STAGE(PG8_SB(1, 1), b3 + hstep, voffB); PG8_STAGEA(PG8_SA(1, 0), 0, a2, g2, kb3);
            PG8_WAIT_V(8); PG8_WAIT_L(0); PG8_BAR; PG8_MMA(1, 0, At, B0); PG8_MMA(1, 1, At, B1); PG8_BAR; PG8_SCHED;
        }
        if (wr == 0) PG8_BAR;
        E(acc, cur, wr, wc, fr, fq);
        if (!has_next) break;
#pragma unroll
        for (int a = 0; a < 2; ++a)
#pragma unroll
            for (int b = 0; b < 2; ++b)
#pragma unroll
                for (int m = 0; m < 4; ++m)
#pragma unroll
                    for (int n = 0; n < 2; ++n) acc[a][b][m][n] = (f32x4){0.f, 0.f, 0.f, 0.f};
        cur = nxt; cA = nA; cB = nB; ++ui;
#pragma unroll
        for (int h = 0; h < 2; ++h)
#pragma unroll
            for (int i = 0; i < 2; ++i) cG[h][i] = nG[h][i];
        if (wr == 1) PG8_BAR;
    }
    PG8_WAIT_V(0);
    PG8_BAR;
#undef PG8_SA
#undef PG8_SB
#undef PG8_STAGE
#undef PG8_STAGEA
#undef PG8_LDA
#undef PG8_LDB
#undef PG8_MMA
#undef PG8_WAIT_V
#undef PG8_WAIT_L
#undef PG8_BAR
#undef PG8_SCHED
}
}

#define XB_TMO      128
#define XB_XCNT(j)  (256  + 64 * (j))
#define XB_XSUB(j)  (1280 + 64 * (j))
#define XB_XGEN(j)  (2304 + 64 * (j))
#define XB_TOP      3328
#define XB_TOPGEN   3392
#define XCD_BAR_WORDS 3456
#define XB_SPIN_CAP (1u << 18)
__device__ __forceinline__ unsigned xb_ld(unsigned* p)              { return __hip_atomic_load(p, __ATOMIC_RELAXED, __HIP_MEMORY_SCOPE_AGENT); }
__device__ __forceinline__ unsigned xb_add(unsigned* p, unsigned v) { return __hip_atomic_fetch_add(p, v, __ATOMIC_RELAXED, __HIP_MEMORY_SCOPE_AGENT); }
__device__ __forceinline__ unsigned xb_xcc_id() { return (unsigned)__builtin_amdgcn_s_getreg((3 << 11) | 20) & 0xFu; }
#define XB_SPIN(cond, bar) do { unsigned _sp = 0; while (cond) { __builtin_amdgcn_s_sleep(1); \
    if ((++_sp & 255u) == 0u) { if (xb_ld(&(bar)[XB_TMO])) break; if (_sp > XB_SPIN_CAP) { atomicAdd(&(bar)[XB_TMO], 1u); break; } } } } while (0)
struct XcdBarrier { unsigned* bar; unsigned x; volatile LAS unsigned* st; };
__device__ __forceinline__ XcdBarrier xcd_barrier_post(unsigned* bar, volatile LAS unsigned* st) {
    XcdBarrier b; b.bar = bar; b.x = xb_xcc_id(); b.st = st;
    if (threadIdx.x == 0) (void)xb_add(&bar[XB_XCNT(b.x)], 1u);
    return b;
}
__device__ __forceinline__ void xcd_barrier_complete(unsigned* bar, unsigned x, unsigned& nloc, unsigned& nx) {
    const unsigned G = gridDim.x * gridDim.y * gridDim.z;
    unsigned sum, cnt, mine, sp = 0u;
    for (;;) {
        sum = 0u; cnt = 0u; mine = 0u;
#pragma unroll
        for (unsigned j = 0; j < 16; ++j) { const unsigned c = xb_ld(&bar[XB_XCNT(j)]); sum += c; cnt += (c > 0u) ? 1u : 0u; mine = (j == x) ? c : mine; }
        if (sum == G) break;
        __builtin_amdgcn_s_sleep(1);
        if ((++sp & 255u) == 0u) { if (xb_ld(&bar[XB_TMO])) break; if (sp > XB_SPIN_CAP) { atomicAdd(&bar[XB_TMO], 1u); break; } }
    }
    nloc = mine > 0u ? mine : 1u; nx = cnt > 0u ? cnt : 1u;
}
__device__ __forceinline__ void xcd_barrier(const XcdBarrier& b) {
    asm volatile("s_waitcnt vmcnt(0)" ::: "memory");
    __syncthreads();
    if (threadIdx.x == 0) {
        unsigned* bar = b.bar;
        __builtin_amdgcn_s_waitcnt(0);
        unsigned nloc = b.st[0], nx = b.st[1];
        if (nloc == 0u) { xcd_barrier_complete(bar, b.x, nloc, nx); b.st[0] = nloc; b.st[1] = nx; }
        const unsigned old = xb_add(&bar[XB_XSUB(b.x)], 1u);
        const unsigned gen = old / nloc;
        if (old + 1u == (gen + 1u) * nloc) {
            __builtin_amdgcn_fence(__ATOMIC_RELEASE, "agent");
            asm volatile("s_waitcnt vmcnt(0)" ::: "memory");
            const unsigned og = xb_add(&bar[XB_TOP], 1u);
            const unsigned tg = og / nx;
            if (og + 1u == (tg + 1u) * nx) xb_add(&bar[XB_TOPGEN], 1u);
            else XB_SPIN(xb_ld(&bar[XB_TOPGEN]) == tg, bar);
            __builtin_amdgcn_fence(__ATOMIC_ACQUIRE, "agent");
            xb_add(&bar[XB_XGEN(b.x)], 1u);
            asm volatile("s_waitcnt vmcnt(0)" ::: "memory");
        } else {
            XB_SPIN(xb_ld(&bar[XB_XGEN(b.x)]) == gen, bar);
            __builtin_amdgcn_fence(__ATOMIC_ACQUIRE, "agent");
            asm volatile("s_waitcnt vmcnt(0)" ::: "memory");
        }
    }
    __syncthreads();
}

using pg8::Unit;
typedef f32x4 acc_t[2][2][4][2];

struct EpiProj {
    static constexpr bool PERM = false;
    unsigned char* ws;
    __device__ __forceinline__ void operator()(const acc_t& acc, const Unit& u, int wr, int wc, int fr, int fq) const {
        const int seg = u.pn >> 1; const bool latent = u.pm < (T / 256);
        if (!latent && (seg == 0 || seg == 3 || seg == 7)) return;
        if (u.e) {
            bf16* dT = (bf16*)(ws + WS_V);
            const int wrow0 = (u.pn & 1) * 256 + wr * 64 + fr, tcol0 = u.pm * 256 + wc * 32 + 4 * fq;
#pragma unroll
            for (int ai = 0; ai < 2; ++ai)
#pragma unroll
                for (int m = 0; m < 4; ++m)
#pragma unroll
                    for (int bj = 0; bj < 2; ++bj)
#pragma unroll
                        for (int n = 0; n < 2; ++n) { const f32x4 x = acc[ai][bj][m][n];
                            *(v2u*)(dT + (size_t)(wrow0 + ai * 128 + m * 16) * MROWS + tcol0 + bj * 128 + n * 16) = (v2u){pg8::cvt_pk_bf16(x[0], x[1]), pg8::cvt_pk_bf16(x[2], x[3])}; }
            return;
        }
        const int lc0 = (u.pn & 1) * 256 + wc * 32 + 4 * fq;
        const size_t segoff[8] = {WS_Q, WS_K, WS_V, WS_HQ, WS_HI, WS_LF, WS_LB, WS_G};
        size_t so = segoff[0];
#pragma unroll
        for (int s = 1; s < 8; ++s) so = (seg == s) ? segoff[s] : so;
        bf16* dst = (bf16*)(ws + so);
        const int row0 = u.pm * 256 + wr * 64 + fr;
        if ((seg == 1 || seg == 0) && latent) {
            const float* rope = (const float*)(ws + WS_ROPE);
#pragma unroll
            for (int ai = 0; ai < 2; ++ai)
#pragma unroll
                for (int m = 0; m < 4; ++m) { const int row = row0 + ai * 128 + m * 16, s = row & (SEQ - 1); const int pos = (wc & 1) ? (s & 63) : (s >> 6);
                    const f32x4 cs0 = *(const f32x4*)(rope + (pos * 16 + 4 * fq) * 2), cs1 = *(const f32x4*)(rope + (pos * 16 + 4 * fq) * 2 + 4);
                    const float cc[4] = {cs0[0], cs0[2], cs1[0], cs1[2]}, sn[4] = {cs0[1], cs0[3], cs1[1], cs1[3]};
#pragma unroll
                    for (int bj = 0; bj < 2; ++bj) { const f32x4 x1 = acc[ai][bj][m][0], x2 = acc[ai][bj][m][1]; float o1[4], o2[4];
#pragma unroll
                        for (int j = 0; j < 4; ++j) { o1[j] = x1[j] * cc[j] - x2[j] * sn[j]; o2[j] = x2[j] * cc[j] + x1[j] * sn[j]; }
                        bf16* p = (seg == 0 ? (bf16*)(ws + WS_QR) : dst) + (size_t)row * SEGW + lc0 + bj * 128;
                        if (seg == 0) { bf16* pr = dst + (size_t)row * SEGW + lc0 + bj * 128;
                            *(v2u*)pr = (v2u){pg8::cvt_pk_bf16(x1[0], x1[1]), pg8::cvt_pk_bf16(x1[2], x1[3])}; *(v2u*)(pr + 16) = (v2u){pg8::cvt_pk_bf16(x2[0], x2[1]), pg8::cvt_pk_bf16(x2[2], x2[3])}; }
                        *(v2u*)p = (v2u){pg8::cvt_pk_bf16(o1[0], o1[1]), pg8::cvt_pk_bf16(o1[2], o1[3])};
                        *(v2u*)(p + 16) = (v2u){pg8::cvt_pk_bf16(o2[0], o2[1]), pg8::cvt_pk_bf16(o2[2], o2[3])}; } }
            return;
        }
        if (seg == 5 || seg == 6) {
            const float* lbt = (const float*)(ws + WS_LBT) + (seg - 5) * 512;
#pragma unroll
            for (int bj = 0; bj < 2; ++bj)
#pragma unroll
                for (int n = 0; n < 2; ++n) { const int lc = lc0 + bj * 128 + n * 16; const f32x4 lb = *(const f32x4*)(lbt + lc);
#pragma unroll
                    for (int ai = 0; ai < 2; ++ai)
#pragma unroll
                        for (int m = 0; m < 4; ++m) { const int row = row0 + ai * 128 + m * 16; const f32x4 x = acc[ai][bj][m][n]; float lf[4];
#pragma unroll
                            for (int j = 0; j < 4; ++j) { const float sg = 1.f / (1.f + __expf(-x[j])); lf[j] = __logf(lb[j] + (1.f - lb[j]) * sg); }
                            *(v2u*)(dst + (size_t)row * SEGW + lc) = (v2u){pkh2(lf[0], lf[1]), pkh2(lf[2], lf[3])}; } }
            return;
        }
        const bool act = (seg == 3 || seg == 7);
#pragma unroll
        for (int ai = 0; ai < 2; ++ai)
#pragma unroll
            for (int m = 0; m < 4; ++m) { const int row = row0 + ai * 128 + m * 16;
#pragma unroll
                for (int bj = 0; bj < 2; ++bj)
#pragma unroll
                    for (int n = 0; n < 2; ++n) { f32x4 x = acc[ai][bj][m][n];
                        if (act) {
#pragma unroll
                            for (int j = 0; j < 4; ++j) x[j] = silu_f(x[j]); }
                        *(v2u*)(dst + (size_t)row * SEGW + lc0 + bj * 128 + n * 16) = (v2u){pg8::cvt_pk_bf16(x[0], x[1]), pg8::cvt_pk_bf16(x[2], x[3])}; } }
    }
};
struct EpiRes {
    static constexpr bool PERM = false;
    const float* x; float* x1; const float* mod;
    __device__ __forceinline__ void operator()(const acc_t& acc, const Unit& u, int wr, int wc, int fr, int fq) const {
        const int b = u.pm >> 3; const int col0 = u.pn * 256 + wc * 32 + 4 * fq; const int row0 = u.pm * 256 + wr * 64 + fr;
#pragma unroll
        for (int bj = 0; bj < 2; ++bj)
#pragma unroll
            for (int n = 0; n < 2; ++n) { const int col = col0 + bj * 128 + n * 16; const f32x4 ga = *(const f32x4*)(mod + b * 6144 + 2048 + col);
#pragma unroll
                for (int ai = 0; ai < 2; ++ai)
#pragma unroll
                    for (int m = 0; m < 4; ++m) { const size_t off = (size_t)(row0 + ai * 128 + m * 16) * D + col;
                        const f32x4 xv = *(const f32x4*)(x + off); *(f32x4*)(x1 + off) = xv + ga * acc[ai][bj][m][n]; } }
    }
};
struct EpiSwiGLU {
    static constexpr bool PERM = true;
    bf16* H;
    __device__ __forceinline__ void operator()(const acc_t& acc, const Unit& u, int wr, int wc, int fr, int fq) const {
        const int hc = u.pn * 128 + wc * 32 + 8 * fq; const int row0 = u.pm * 256 + wr * 64 + fr;
#pragma unroll
        for (int ai = 0; ai < 2; ++ai)
#pragma unroll
            for (int m = 0; m < 4; ++m) { float h[8];
#pragma unroll
                for (int n = 0; n < 2; ++n)
#pragma unroll
                    for (int j = 0; j < 4; ++j) h[n * 4 + j] = silu_f(acc[ai][0][m][n][j]) * acc[ai][1][m][n][j];
                u32x4 w; w.x = pg8::cvt_pk_bf16(h[0], h[1]); w.y = pg8::cvt_pk_bf16(h[2], h[3]); w.z = pg8::cvt_pk_bf16(h[4], h[5]); w.w = pg8::cvt_pk_bf16(h[6], h[7]);
                *(u32x4*)(H + (size_t)(row0 + ai * 128 + m * 16) * DE + hc) = w; }
    }
};
struct EpiMoeOut {
    static constexpr bool PERM = true;
    bf16* Y; const int* elist; const float* ewt;
    __device__ __forceinline__ void operator()(const acc_t& acc, const Unit& u, int wr, int wc, int fr, int fq) const {
        const int col0 = u.pn * 256 + wc * 32 + 8 * fq;
#pragma unroll
        for (int ai = 0; ai < 2; ++ai)
#pragma unroll
            for (int m = 0; m < 4; ++m) { const int rank = u.tm * 256 + ai * 128 + wr * 64 + m * 16 + fr;
                if (rank < u.cnt) { const int tk = elist[u.e * ECAP + rank]; const float w = ewt[u.e * ECAP + rank];
#pragma unroll
                    for (int bj = 0; bj < 2; ++bj) { const f32x4 v0 = acc[ai][bj][m][0] * w, v1 = acc[ai][bj][m][1] * w; u32x4 o;
                        o.x = pg8::cvt_pk_bf16(v0[0], v0[1]); o.y = pg8::cvt_pk_bf16(v0[2], v0[3]); o.z = pg8::cvt_pk_bf16(v1[0], v1[1]); o.w = pg8::cvt_pk_bf16(v1[2], v1[3]);
                        *(u32x4*)(Y + (size_t)tk * D + col0 + bj * 128) = o; } } }
    }
};
template <bool GATHER_> struct MoeOrder {
    static constexpr bool GATHER = GATHER_;
    const LAS int* tp; const int* elist; int G, c, nwg;
    __device__ bool next(int i, Unit& u) const {
        const long L = (long)i * G + c; if (L >= nwg) return false;
        int wgid = (int)L; { const int q = nwg / 8, r = nwg % 8, xcd = wgid % 8, off = wgid / 8; wgid = (xcd < r ? xcd * (q + 1) : r * (q + 1) + (xcd - r) * q) + off; }
        const int gt = wgid >> 2; int e = 0;
#pragma unroll
        for (int k = 1; k < 16; ++k) e = (gt >= tp[k]) ? k : e;
        u.pm = gt; u.pn = wgid & 3; u.e = e; u.tm = gt - tp[e]; u.cnt = tp[17 + e]; return true;
    }
    __device__ __forceinline__ int a_row0(const Unit& u) const { return u.pm * 256; }
    __device__ __forceinline__ int a_row(const Unit& u, int r) const {
        if constexpr (GATHER_) { int rank = u.tm * 256 + r; rank = rank < u.cnt ? rank : u.cnt - 1; return elist[u.e * ECAP + rank] >> 1; }
        else return u.pm * 256 + r;
    }
    __device__ __forceinline__ int b_row0(const Unit& u) const { return u.e * 1024 + u.pn * 256; }
};


constexpr int SWMASK = 0x04;
constexpr int W_REL_XN = (int)(((long long)WS_WINT - (long long)WS_XN) / 2048);
struct ProjOrder {
    static constexpr bool GATHER = false;
    pg8::DenseOrder d;
    __device__ void init(int G_, int c_) { d.init(MROWS, INCOLS, G_, c_); }
    __device__ bool next(int i, Unit& u) const { if (!d.next(i, u)) return false; u.e = (SWMASK >> (u.pn >> 1)) & 1; return true; }
    __device__ __forceinline__ int a_row0(const Unit& u) const { return u.e ? W_REL_XN + u.pn * 256 : u.pm * 256; }
    __device__ __forceinline__ int a_row(const Unit& u, int r) const { return a_row0(u) + r; }
    __device__ __forceinline__ int b_row0(const Unit& u) const { return u.e ? -W_REL_XN + u.pm * 256 : u.pn * 256; }
};


__device__ __forceinline__ bf16x8 pack8(const f32x4& a, const f32x4& b) {
    u32x4 w; w.x = pg8::cvt_pk_bf16(a[0], a[1]); w.y = pg8::cvt_pk_bf16(a[2], a[3]); w.z = pg8::cvt_pk_bf16(b[0], b[1]); w.w = pg8::cvt_pk_bf16(b[2], b[3]);
    return __builtin_bit_cast(bf16x8, w);
}
typedef unsigned bu4 __attribute__((__vector_size__(16)));
__device__ __forceinline__ bf16x8 bload16(__amdgpu_buffer_rsrc_t r, unsigned voff, unsigned soff) { return __builtin_bit_cast(bf16x8, __builtin_amdgcn_raw_buffer_load_b128(r, (int)voff, (int)soff, 0)); }
#define NA_SB() __builtin_amdgcn_sched_barrier(0)
template <bool LOCAL>
__device__ __forceinline__ void na_chunk(f32x4 (&o)[4], float& m_run, float& l_run, const bf16x8 q0, const bf16x8 q1, __amdgpu_buffer_rsrc_t srdK, __amdgpu_buffer_rsrc_t srdV,
                                         unsigned klane, unsigned vlane, unsigned ksoff, unsigned vsoff, const LAS float* bpl, int lo) {
    constexpr float SC = 0.125f * 1.44269504f; const float NEG = -1e30f;
    constexpr unsigned KROW = LOCAL ? GW * SEGW * 2 : 32 * SEGW * 2;
    constexpr unsigned VROW = LOCAL ? GW * 2 : 32 * 2;
    f32x4 s[16];
    bf16x8 kf[2][4][2];
#define NA_KLOAD(buf, bt) do { _Pragma("unroll") for (int tt = 0; tt < 4; ++tt) { const int t = 4 * (bt) + tt; const unsigned so = ksoff + (unsigned)(t >> 1) * KROW + (unsigned)(t & 1) * (4 * SEGW * 2); \
        kf[buf][tt][0] = bload16(srdK, klane, so); kf[buf][tt][1] = bload16(srdK, klane, so + 64); } } while (0)
    NA_KLOAD(0, 0); NA_SB();
#pragma unroll
    for (int bt = 0; bt < 4; ++bt) {
        if (bt < 3) { if (bt & 1) NA_KLOAD(0, bt + 1); else NA_KLOAD(1, bt + 1); }
        NA_SB();
#pragma unroll
        for (int tt = 0; tt < 4; ++tt) { const int t = 4 * bt + tt;
            s[t] = __builtin_amdgcn_mfma_f32_16x16x32_bf16(kf[bt & 1][tt][0], q0, (f32x4){0.f, 0.f, 0.f, 0.f}, 0, 0, 0);
            s[t] = __builtin_amdgcn_mfma_f32_16x16x32_bf16(kf[bt & 1][tt][1], q1, s[t], 0, 0, 0); }
        asm volatile("" : "+v"(s[4 * bt]), "+v"(s[4 * bt + 1]), "+v"(s[4 * bt + 2]), "+v"(s[4 * bt + 3]));
        NA_SB();
    }
#undef NA_KLOAD
    bf16x8 vf[2][2][4];
#define NA_VLOAD(buf, kp) do { _Pragma("unroll") for (int kk = 0; kk < 2; ++kk) _Pragma("unroll") for (int dt = 0; dt < 4; ++dt) \
        vf[buf][kk][dt] = bload16(srdV, vlane, vsoff + (unsigned)(2 * (kp) + kk) * VROW + (unsigned)dt * (16 * MROWS * 2)); } while (0)
    NA_VLOAD(0, 0); NA_SB();
    float mx = NEG;
#pragma unroll
    for (int t = 0; t < 16; ++t)
#pragma unroll
        for (int e = 0; e < 4; ++e) { float v;
            if (LOCAL) { const int c = 4 * (t & 1) + e; const bool valid = (c >= lo) && (c < lo + 16); v = valid ? s[t][e] * SC + bpl[(t >> 1) * 64 + c] : NEG; }
            else v = s[t][e] * SC;
            s[t][e] = v; mx = fmaxf(mx, v); }
    mx = fmaxf(mx, __shfl_xor(mx, 16)); mx = fmaxf(mx, __shfl_xor(mx, 32));
    float mnew = mx;
    if (!LOCAL) { mnew = fmaxf(m_run, mx); const float alpha = __builtin_amdgcn_exp2f(m_run - mnew); l_run *= alpha;
#pragma unroll
        for (int dt = 0; dt < 4; ++dt) o[dt] = o[dt] * alpha; }
    float sum = 0.f; bf16x8 Bp[8];
#pragma unroll
    for (int ks = 0; ks < 8; ++ks) { f32x4 pa, pb;
#pragma unroll
        for (int e = 0; e < 4; ++e) { pa[e] = __builtin_amdgcn_exp2f(s[2 * ks][e] - mnew); pb[e] = __builtin_amdgcn_exp2f(s[2 * ks + 1][e] - mnew); sum += pa[e] + pb[e]; }
        Bp[ks] = pack8(pa, pb); }
    sum += __shfl_xor(sum, 16); sum += __shfl_xor(sum, 32);
    m_run = mnew; l_run = LOCAL ? sum : l_run + sum;
    NA_SB();
#pragma unroll
    for (int kp = 0; kp < 4; ++kp) {
        if (kp < 3) { if (kp & 1) NA_VLOAD(0, kp + 1); else NA_VLOAD(1, kp + 1); }
        NA_SB();
#pragma unroll
        for (int kk = 0; kk < 2; ++kk) { const int ks = 2 * kp + kk;
#pragma unroll
            for (int dt = 0; dt < 4; ++dt) o[dt] = __builtin_amdgcn_mfma_f32_16x16x32_bf16(vf[kp & 1][kk][dt], Bp[ks], o[dt], 0, 0, 0); }
        asm volatile("" : "+v"(o[0]), "+v"(o[1]), "+v"(o[2]), "+v"(o[3]));
        NA_SB();
    }
#undef NA_VLOAD
}
__device__ __forceinline__ void na_unit(int b, int h, int r, int jb, const bf16* Q, const bf16* QR, __amdgpu_buffer_rsrc_t srdK, __amdgpu_buffer_rsrc_t srdV, bf16* MIX, const LAS float* rpbL, int lane) {
    const int qi = lane & 15, g = lane >> 4;
    const int qc = 16 * jb + qi, tokq = b * SEQ + r * GW + qc;
    int rs = r - 4; rs = rs < 0 ? 0 : (rs > NROWS - 8 ? NROWS - 8 : rs);
    int kb = 16 * jb - 8; kb = kb < 0 ? 0 : (kb > GW - 32 ? GW - 32 : kb);
    int cs = qc - 8; cs = cs < 0 ? 0 : (cs > GW - 16 ? GW - 16 : cs);
    const bf16* qp = Q + (size_t)tokq * SEGW + h * NAD + 8 * g; const bf16* qrp = QR + (size_t)tokq * SEGW + h * NAD + 8 * g;
    const bf16x8 qraw0 = *(const bf16x8*)qp, qraw1 = *(const bf16x8*)(qp + 32), qrot0 = *(const bf16x8*)qrp, qrot1 = *(const bf16x8*)(qrp + 32);
    const unsigned klane = (unsigned)((8 * (qi >> 2) + (qi & 3)) * SEGW + 8 * g) * 2u;
    const unsigned vlane = (unsigned)(qi * MROWS + 8 * g) * 2u;
    const unsigned ksl = (unsigned)((b * SEQ + rs * GW + kb) * SEGW + h * NAD) * 2u, ksc = (unsigned)((T + b * LC) * SEGW + h * NAD) * 2u;
    const unsigned vsl = (unsigned)(h * NAD * MROWS + b * SEQ + rs * GW + kb) * 2u, vsc = (unsigned)(h * NAD * MROWS + T + b * LC) * 2u;
    const LAS float* bpl = rpbL + (h * 15 + rs - r + 7) * 64 + (kb + 8 * g - qc + 31);
    const int lo = cs - kb - 8 * g;
    f32x4 o[4];
#pragma unroll
    for (int dt = 0; dt < 4; ++dt) o[dt] = (f32x4){0.f, 0.f, 0.f, 0.f};
    float m_run = 0.f, l_run = 0.f;
    na_chunk<true>(o, m_run, l_run, qrot0, qrot1, srdK, srdV, klane, vlane, ksl, vsl, bpl, lo);
    na_chunk<false>(o, m_run, l_run, qraw0, qraw1, srdK, srdV, klane, vlane, ksc, vsc, bpl, lo);
    const float inv = 1.f / l_run;
    bf16* op = MIX + (size_t)tokq * D + h * NAD + 4 * g;
#pragma unroll
    for (int dt = 0; dt < 4; ++dt) { const f32x4 v = o[dt] * inv; *(v2u*)(op + 16 * dt) = (v2u){pg8::cvt_pk_bf16(v[0], v[1]), pg8::cvt_pk_bf16(v[2], v[3])}; }
}

__device__ __forceinline__ void transpose_item(const float* W, int ldw, int k0, int n0, bf16* WT, int ldk, int drow0, LAS float* scr, int lane) {
#pragma unroll 8
    for (int i = 0; i < 32; ++i) { const int kk = 2 * i + (lane >> 5); scr[kk * 33 + (lane & 31)] = W[(size_t)(k0 + kk) * ldw + n0 + (lane & 31)]; }
    LDS_WAIT(); asm volatile("" ::: "memory");
    const int c = lane & 7;
#pragma unroll
    for (int j = 0; j < 4; ++j) { const int n = (lane >> 3) + 8 * j; const LAS float* s = scr + (8 * c) * 33 + n;
        v4u o; o.x = pk2(s[0 * 33], s[1 * 33]); o.y = pk2(s[2 * 33], s[3 * 33]); o.z = pk2(s[4 * 33], s[5 * 33]); o.w = pk2(s[6 * 33], s[7 * 33]);
        *(GAS v4u*)(WT + (size_t)(drow0 + n) * ldk + k0 + 8 * c) = o; }
    LDS_WAIT(); asm volatile("" ::: "memory");
}

struct Args { const float* in[21]; float* out; unsigned char* ws; int ph_lo, ph_hi, li, pad; };

__global__ void __launch_bounds__(NTHR, 2) fwd_mega(Args args) {
    extern __shared__ __attribute__((aligned(16))) unsigned char lds_raw[];
    LAS unsigned char* lds = (LAS unsigned char*)lds_raw;
    volatile LAS unsigned* MISC = (volatile LAS unsigned*)(lds + MISC_OFF);
    const int tid = threadIdx.x, lane = tid & 63, wave = __builtin_amdgcn_readfirstlane(tid >> 6);
    const int G = gridDim.x; const int bx = blockIdx.x; const int vcu = (G % 8 == 0) ? (bx % 8) * (G / 8) + bx / 8 : bx;
    gu32* ctl0 = (gu32*)(args.ws + WS_CTL);
    const int gw = vcu * NWAVES + wave, NGW = G * NWAVES;
    for (int u = tid; u < (LDS_BYTES - LDSCTL_OFF) / 4; u += NTHR) ((LAS unsigned*)(lds + LDSCTL_OFF))[u] = 0u;
    __syncthreads();
    XcdBarrier bar = xcd_barrier_post((unsigned*)(ctl0 + CW_BAR) + args.li * XCD_BAR_WORDS, MISC + 8);
    const int lo = args.ph_lo, hi = args.ph_hi;
#ifndef PHMASK
#define PHMASK 0xFFFF
#endif
#define IN(k) (((PHMASK >> (k)) & 1) && lo <= (k) && (k) < hi)
#define SEAM(k) do { if (IN(k) && IN((k) + 1)) xcd_barrier(bar); } while (0)

#define KA(i) ({ const __attribute__((address_space(4))) Args* _p = (const __attribute__((address_space(4))) Args*)__builtin_amdgcn_kernarg_segment_ptr(); asm volatile("" : "+s"(_p)); _p->in[i]; })
#define WSP() ({ const __attribute__((address_space(4))) Args* _p = (const __attribute__((address_space(4))) Args*)__builtin_amdgcn_kernarg_segment_ptr(); asm volatile("" : "+s"(_p)); _p->ws; })
#define PHASE_PTRS unsigned char* ws = WSP(); float* MOD = (float*)(ws + WS_MOD); float* ROPE = (float*)(ws + WS_ROPE); float* LBT = (float*)(ws + WS_LBT); \
    bf16* WinT = (bf16*)(ws + WS_WINT); bf16* WoutT = (bf16*)(ws + WS_WOUTT); bf16* W13T = (bf16*)(ws + WS_W13T); bf16* W2T = (bf16*)(ws + WS_W2T); \
    bf16* XN = (bf16*)(ws + WS_XN); bf16* MIX = (bf16*)(ws + WS_MIX); bf16* XN2 = (bf16*)(ws + WS_XN2); \
    float* X1 = (float*)(ws + WS_X1); bf16* Hb = (bf16*)(ws + WS_H); bf16* Yb = (bf16*)(ws + WS_Y); \
    int* ELIST = (int*)(ws + WS_ELIST); float* EWT = (float*)(ws + WS_EWT); gu32* ctl = (gu32*)(ws + WS_CTL); \
    (void)MOD; (void)ROPE; (void)LBT; (void)WinT; (void)WoutT; (void)W13T; (void)W2T; (void)XN; (void)MIX; (void)XN2; (void)X1; (void)Hb; (void)Yb; (void)ELIST; (void)EWT; (void)ctl;
    if (IN(0)) {
        PHASE_PTRS
        const float* cvec = KA(1); const float* c_ctx = KA(3); const float* w_mod = KA(4); const float* b_mod = KA(5); const float* w_in = KA(8); const float* w_out = KA(9);
        const float* hg_lb = KA(11); const float* w1 = KA(17); const float* w3 = KA(18); const float* w2 = KA(19);
        if (bx == G - 1) {
            for (int idx = tid; idx < 1024; idx += NTHR) { const int pos = idx >> 4, i = idx & 15;
                double th = 1.0; for (int k = 0; k < i; ++k) th *= 0.5623413251903491;
                const double t2 = th * th; double c = 1.0, s = th, tc = 1.0, ts = th;
                for (int n = 1; n <= 12; ++n) { tc *= -t2 / (double)((2 * n - 1) * (2 * n)); c += tc; ts *= -t2 / (double)((2 * n) * (2 * n + 1)); s += ts; }
                double cr = 1.0, ci = 0.0; for (int p = 0; p < pos; ++p) { const double nr = cr * c - ci * s; ci = cr * s + ci * c; cr = nr; }
                ROPE[idx * 2] = (float)cr; ROPE[idx * 2 + 1] = (float)ci; }
            for (int idx = tid; idx < 1024; idx += NTHR) { const float h0 = hg_lb[idx], h1 = hg_lb[1024 + idx]; LBT[idx] = 1.f / (1.f + expf(h1 - h0)); }
        }
        if (bx < 96) {
            LAS float* sc = (LAS float*)lds;
            for (int idx = tid; idx < 17 * 1024; idx += NTHR) { const int r = idx >> 10, k = idx & 1023; const float cv = r < 16 ? cvec[r * 1024 + k] : c_ctx[k]; sc[idx] = cv / (1.f + expf(-cv)); }
            __syncthreads();
            const int col = 64 * bx + lane, k0 = 128 * wave;
            float acc[17];
#pragma unroll
            for (int r = 0; r < 17; ++r) acc[r] = 0.f;
            for (int kk = 0; kk < 128; kk += 4) {
                const float w0 = w_mod[(size_t)(k0 + kk) * 6144 + col], w1v = w_mod[(size_t)(k0 + kk + 1) * 6144 + col], w2v = w_mod[(size_t)(k0 + kk + 2) * 6144 + col], w3v = w_mod[(size_t)(k0 + kk + 3) * 6144 + col];
#pragma unroll
                for (int r = 0; r < 17; ++r) { const f32x4 a = *(const LAS f32x4*)(sc + r * 1024 + k0 + kk); acc[r] += a[0] * w0 + a[1] * w1v + a[2] * w2v + a[3] * w3v; }
            }
            LAS float* red = (LAS float*)(lds + 17 * 1024 * 4);
#pragma unroll
            for (int r = 0; r < 17; ++r) red[(wave * 17 + r) * 64 + lane] = acc[r];
            __syncthreads();
            for (int idx = tid; idx < 17 * 64; idx += NTHR) { const int r = idx >> 6, l = idx & 63; float s = 0.f;
#pragma unroll
                for (int w = 0; w < 8; ++w) s += red[(w * 17 + r) * 64 + l];
                MOD[r * 6144 + 64 * bx + l] = s + b_mod[64 * bx + l]; }
            __syncthreads();
        }
        {
            LAS float* scr = (LAS float*)(lds + wave * 16384);
            constexpr int I_IN = 16 * 128, I_OUT = 16 * 32, I_13 = 16 * 2 * 256, I_2 = 16 * 256, NIT = I_IN + I_OUT + I_13 + I_2;
            for (int it = gw; it < NIT; it += NGW) {
                int r = it;
                if (r < I_IN) { const int kb = r / 128, nb = r % 128; transpose_item(w_in, INCOLS, 64 * kb, 32 * nb, WinT, 1024, 32 * nb, scr, lane); continue; } r -= I_IN;
                if (r < I_OUT) { const int kb = r / 32, nb = r % 32; transpose_item(w_out, 1024, 64 * kb, 32 * nb, WoutT, 1024, 32 * nb, scr, lane); continue; } r -= I_OUT;
                if (r < I_13) { const int e = r / 512, rem = r % 512, s = rem / 256, r2 = rem % 256, kb = r2 / 16, nb = r2 % 16, n0 = 32 * nb;
                    transpose_item((s ? w3 : w1) + (size_t)e * 1024 * 512, 512, 64 * kb, n0, W13T, 1024, e * 1024 + 256 * (n0 / 128) + 128 * s + (n0 % 128), scr, lane); continue; } r -= I_13;
                { const int e = r / 256, r2 = r % 256, kb = r2 / 32, nb = r2 % 32; transpose_item(w2 + (size_t)e * 512 * 1024, 1024, 64 * kb, 32 * nb, W2T, 512, e * 1024 + 32 * nb, scr, lane); }
            }
        }
    }
    SEAM(0);

    if (IN(1)) {
        PHASE_PTRS
        const float* x = KA(0); const float* ctx = KA(2); const float* norm_mix = KA(6);
        for (int row = gw; row < MROWS; row += NGW) {
            const float* xr = row < T ? x + (size_t)row * D : ctx + (size_t)(row - T) * D; const int mb = row < T ? (row >> 11) : 16;
            f32x4 v[4]; float s = 0.f;
#pragma unroll
            for (int j = 0; j < 4; ++j) { v[j] = *(const f32x4*)(xr + 4 * lane + 256 * j); s += (v[j][0] * v[j][0] + v[j][1] * v[j][1]) + (v[j][2] * v[j][2] + v[j][3] * v[j][3]); }
            const float rstd = 1.f / sqrtf(wave_sum(s) * (1.f / D) + EPS);
#pragma unroll
            for (int j = 0; j < 4; ++j) { const int col = 4 * lane + 256 * j; const f32x4 g = *(const f32x4*)(norm_mix + col), sh = *(const f32x4*)(MOD + mb * 6144 + col), sc = *(const f32x4*)(MOD + mb * 6144 + 1024 + col);
                const f32x4 y = v[j] * rstd * g * (1.f + sc) + sh;
                *(v2u*)(XN + (size_t)row * D + col) = (v2u){pk2(y[0], y[1]), pk2(y[2], y[3])}; }
        }
    }
    SEAM(1);

    if (IN(2)) {
        PHASE_PTRS
        ProjOrder S; S.init(G, bx);
        EpiProj E{ws};
        pg8::gemm_phase<EpiProj, ProjOrder>(lds + RING_OFF, XN, WinT, D, S, E);
    }
    SEAM(2);

    if (IN(3)) {
        PHASE_PTRS
        const bf16* Qb = (const bf16*)(ws + WS_Q); const bf16* Kb = (const bf16*)(ws + WS_K); const bf16* Vb = (const bf16*)(ws + WS_V);
        const bf16* HQ = (const bf16*)(ws + WS_HQ); const bf16* HI = (const bf16*)(ws + WS_HI);
        const float* rope = (const float*)ROPE; const float* na_rpb = KA(10);
#ifndef NO_SCAN
        if (bx < 128) {
            const int b = bx >> 3, h = (bx >> 1) & 3, dir = bx & 1;
            const unsigned short* LG = (const unsigned short*)(ws + (dir ? WS_LB : WS_LF));
            bf16* OUT = (bf16*)(ws + (dir ? WS_OB : WS_OF));
            const int dv = tid & 127, kg = tid >> 7;
            float St[32];
#pragma unroll
            for (int i = 0; i < 32; ++i) St[i] = 0.f;
            LAS float* sq = (LAS float*)lds;
            LAS float* sk = sq + 16 * 128;
            LAS float* sf = sk + 16 * 128;
            LAS float* sv = sf + 16 * 128;
            LAS float* so = sv + 16 * 128;
            constexpr int NSTEP = LC + SEQ;
            for (int j0 = 0; j0 < NSTEP; j0 += 16) {
                const bool isctx = j0 < LC;
                { const int st = tid >> 5, c4 = (tid & 31) * 4, j = j0 + st;
                  int row; if (j < LC) row = T + b * LC + (dir ? (LC - 1 - j) : j); else row = b * SEQ + (dir ? (SEQ - 1 - (j - LC)) : (j - LC));
                  const size_t off = (size_t)row * SEGW + h * HGD + c4;
                  const v2u lg = *(const v2u*)(LG + off), vi = *(const v2u*)(HI + off);
                  float f0 = __expf(h2f((unsigned short)(lg.x & 0xffff))), f1 = __expf(h2f((unsigned short)(lg.x >> 16))), f2 = __expf(h2f((unsigned short)(lg.y & 0xffff))), f3 = __expf(h2f((unsigned short)(lg.y >> 16)));
                  *(LAS f32x4*)(sf + st * 128 + c4) = (f32x4){f0, f1, f2, f3};
                  *(LAS f32x4*)(sk + st * 128 + c4) = (f32x4){1.f - f0, 1.f - f1, 1.f - f2, 1.f - f3};
                  *(LAS f32x4*)(sv + st * 128 + c4) = (f32x4){bflo(vi.x), bfhi(vi.x), bflo(vi.y), bfhi(vi.y)};
                  if (!isctx) { const v2u qq = *(const v2u*)(HQ + off); *(LAS f32x4*)(sq + st * 128 + c4) = (f32x4){bflo(qq.x), bfhi(qq.x), bflo(qq.y), bfhi(qq.y)}; }
                }
                __syncthreads();
                for (int st = 0; st < 16; ++st) {
                    const float vv = sv[st * 128 + dv]; float o = 0.f;
#pragma unroll
                    for (int i = 0; i < 32; i += 4) {
                        const f32x4 f4 = *(const LAS f32x4*)(sf + st * 128 + kg * 32 + i), k4 = *(const LAS f32x4*)(sk + st * 128 + kg * 32 + i), q4 = *(const LAS f32x4*)(sq + st * 128 + kg * 32 + i);
#pragma unroll
                        for (int jj = 0; jj < 4; ++jj) { St[i + jj] = f4[jj] * St[i + jj] + k4[jj] * vv; o += St[i + jj] * q4[jj]; }
                    }
                    so[(st * 4 + kg) * 128 + dv] = o;
                }
                __syncthreads();
                if (!isctx) {
                    for (int idx = tid; idx < 16 * 128; idx += NTHR) { const int st = idx >> 7, d = idx & 127, j = j0 + st;
                        const float o = (so[(st * 4 + 0) * 128 + d] + so[(st * 4 + 1) * 128 + d]) + (so[(st * 4 + 2) * 128 + d] + so[(st * 4 + 3) * 128 + d]);
                        const int row = b * SEQ + (dir ? (SEQ - 1 - (j - LC)) : (j - LC));
                        OUT[(size_t)row * SEGW + h * HGD + d] = (bf16)f2bf(o); }
                }
                __syncthreads();
            }
        } else
#endif
        {
            LAS float* rpbL = (LAS float*)lds;
            for (int idx = tid; idx < 8 * 15 * 64; idx += NTHR) { const int co = (idx & 63) - 16, hr = idx >> 6; rpbL[idx] = (co >= 0 && co < 31) ? na_rpb[hr * 31 + co] * 1.44269504f : 0.f; }
            __syncthreads();
            const int nwv = (G - 128) * NWAVES; const int wv = (bx - 128) * NWAVES + wave;
            const __amdgpu_buffer_rsrc_t srdK = __builtin_amdgcn_make_buffer_rsrc((void*)Kb, (short)0, MROWS * SEGW * 2, 0x00020000), srdV = __builtin_amdgcn_make_buffer_rsrc((void*)Vb, (short)0, MROWS * SEGW * 2, 0x00020000);
#pragma unroll 1
            for (int unit = wv; unit < NB * NAH * NROWS * 4; unit += nwv)
                na_unit(unit >> 10, (unit >> 7) & 7, (unit >> 2) & 31, unit & 3, Qb, (const bf16*)(ws + WS_QR), srdK, srdV, MIX, rpbL, lane);
        }
    }
    SEAM(3);

    if (IN(4)) {
        PHASE_PTRS
        const float* hg_norm = KA(12);
        const bf16* OF = (const bf16*)(ws + WS_OF); const bf16* OB = (const bf16*)(ws + WS_OB); const bf16* Gb = (const bf16*)(ws + WS_G);
        for (int tok = gw; tok < T; tok += NGW) {
            const size_t off = (size_t)tok * SEGW + lane * 8;
            const v4u a = *(const v4u*)(OF + off), bb = *(const v4u*)(OB + off), g = *(const v4u*)(Gb + off);
            float o[8]; float ss = 0.f;
#pragma unroll
            for (int e = 0; e < 4; ++e) { o[2 * e] = bflo(a[e]) + bflo(bb[e]); o[2 * e + 1] = bfhi(a[e]) + bfhi(bb[e]); ss += o[2 * e] * o[2 * e] + o[2 * e + 1] * o[2 * e + 1]; }
            ss += __shfl_xor(ss, 1); ss += __shfl_xor(ss, 2); ss += __shfl_xor(ss, 4); ss += __shfl_xor(ss, 8);
            const float rstd = 1.f / sqrtf(ss * (1.f / HGD) + EPS);
            const int dv0 = (lane & 15) * 8;
            const f32x4 g0 = *(const f32x4*)(hg_norm + dv0), g1 = *(const f32x4*)(hg_norm + dv0 + 4);
            const float gg[8] = {g0[0], g0[1], g0[2], g0[3], g1[0], g1[1], g1[2], g1[3]};
            float y[8];
#pragma unroll
            for (int e = 0; e < 4; ++e) { y[2 * e] = o[2 * e] * rstd * gg[2 * e] * bflo(g[e]); y[2 * e + 1] = o[2 * e + 1] * rstd * gg[2 * e + 1] * bfhi(g[e]); }
            *(v4u*)(MIX + (size_t)tok * D + 512 + lane * 8) = (v4u){pk2(y[0], y[1]), pk2(y[2], y[3]), pk2(y[4], y[5]), pk2(y[6], y[7])};
        }
    }
    SEAM(4);

    if (IN(5)) {
        PHASE_PTRS
        pg8::DenseOrder S; S.init(T, D, G, bx);
        EpiRes E{KA(0), X1, MOD};
        pg8::gemm_phase<EpiRes, pg8::DenseOrder>(lds + RING_OFF, MIX, WoutT, D, S, E);
    }
    SEAM(5);

    if (IN(6)) {
        PHASE_PTRS
        const float* norm_ffn = KA(7); const float* w_grp = KA(13); const float* b_grp = KA(14); const float* w_exp = KA(15); const float* b_exp = KA(16);
        LAS f32x4* wl = (LAS f32x4*)lds;
        for (int idx = tid; idx < 5 * 1024; idx += NTHR) { const int quad = idx >> 10, col = idx & 1023; const int l = (col & 255) >> 2, q = col & 3, j = col >> 8;
            const f32x4 w = quad == 0 ? *(const f32x4*)(w_grp + col * 4) : *(const f32x4*)(w_exp + col * 16 + (quad - 1) * 4);
            wl[((quad * 4 + q) * 4 + j) * 64 + l] = w; }
        LAS int* lcnt = (LAS int*)(lds + 81920);
        LAS int* tmpe = (LAS int*)(lds + 81920 + 256);
        if (tid < 32) lcnt[tid] = 0;
        __syncthreads();
        const int rowbase = bx * 128 + wave * 16;
#pragma unroll 1
        for (int i = 0; i < 16; ++i) {
            asm volatile("" ::: "memory");
            const int row = rowbase + i; const int mb = row >> 11;
            const float* xr = X1 + (size_t)row * D;
            f32x4 v[4]; float s = 0.f;
#pragma unroll
            for (int j = 0; j < 4; ++j) { v[j] = *(const f32x4*)(xr + 4 * lane + 256 * j); s += (v[j][0] * v[j][0] + v[j][1] * v[j][1]) + (v[j][2] * v[j][2] + v[j][3] * v[j][3]); }
            const float rstd = 1.f / sqrtf(wave_sum(s) * (1.f / D) + EPS);
            float lg[20];
#pragma unroll
            for (int k = 0; k < 20; ++k) lg[k] = 0.f;
#pragma unroll
            for (int j = 0; j < 4; ++j) { const int col = 4 * lane + 256 * j; const f32x4 g = *(const f32x4*)(norm_ffn + col), sh = *(const f32x4*)(MOD + mb * 6144 + 3072 + col), sc = *(const f32x4*)(MOD + mb * 6144 + 4096 + col);
                const f32x4 y = v[j] * rstd * g * (1.f + sc) + sh;
                asm volatile("" ::: "memory");
                *(v2u*)(XN2 + (size_t)row * D + col) = (v2u){pk2(y[0], y[1]), pk2(y[2], y[3])};
#pragma unroll
                for (int q = 0; q < 4; ++q)
#pragma unroll
                    for (int quad = 0; quad < 5; ++quad) { const f32x4 w = wl[((quad * 4 + q) * 4 + j) * 64 + lane];
                        lg[quad * 4 + 0] += y[q] * w[0]; lg[quad * 4 + 1] += y[q] * w[1]; lg[quad * 4 + 2] += y[q] * w[2]; lg[quad * 4 + 3] += y[q] * w[3]; } }
#pragma unroll
            for (int k = 0; k < 20; ++k) lg[k] = wave_sum(lg[k]);
            if (lane == 0) {
                float gl[4];
#pragma unroll
                for (int k = 0; k < 4; ++k) gl[k] = lg[k] + b_grp[k];
                int gs = 0; float gm = gl[0];
#pragma unroll
                for (int k = 1; k < 4; ++k) if (gl[k] > gm) { gm = gl[k]; gs = k; }
                float den = 0.f;
#pragma unroll
                for (int k = 0; k < 4; ++k) den += __expf(gl[k] - gm);
                const float g_w = 1.f / den;
                float ev[4];
#pragma unroll
                for (int k = 0; k < 4; ++k) { float a = lg[4 + k] + b_exp[k];
#pragma unroll
                    for (int g2 = 1; g2 < 4; ++g2) a = (gs == g2) ? (lg[4 + g2 * 4 + k] + b_exp[g2 * 4 + k]) : a;
                    ev[k] = a; }
                int i0 = 0; float v0 = ev[0];
#pragma unroll
                for (int k = 1; k < 4; ++k) if (ev[k] > v0) { v0 = ev[k]; i0 = k; }
                int i1 = -1; float v1 = -INFINITY;
#pragma unroll
                for (int k = 0; k < 4; ++k) if (k != i0 && ev[k] > v1) { v1 = ev[k]; i1 = k; }
                const float e1 = __expf(v1 - v0); const float w0 = g_w / (1.f + e1), w1w = g_w * e1 / (1.f + e1);
                const int ea = gs * 4 + i0, eb = gs * 4 + i1;
                const int ra = __hip_atomic_fetch_add(&lcnt[ea], 1, __ATOMIC_RELAXED, __HIP_MEMORY_SCOPE_WORKGROUP), rb = __hip_atomic_fetch_add(&lcnt[eb], 1, __ATOMIC_RELAXED, __HIP_MEMORY_SCOPE_WORKGROUP);
                const int lr = (wave * 16 + i) * 2;
                tmpe[lr] = ea; tmpe[256 + lr] = ra; tmpe[512 + lr] = __builtin_bit_cast(int, w0);
                tmpe[lr + 1] = eb; tmpe[256 + lr + 1] = rb; tmpe[512 + lr + 1] = __builtin_bit_cast(int, w1w);
            }
        }
        __syncthreads();
        if (tid < 16) lcnt[16 + tid] = (int)__hip_atomic_fetch_add(ctl + CW_CNT + tid, (unsigned)lcnt[tid], RLX_AGENT);
        __syncthreads();
        if (tid < 256) { const int e = tmpe[tid], pos = lcnt[16 + e] + tmpe[256 + tid]; const int tok = bx * 128 + (tid >> 1);
            ELIST[e * ECAP + pos] = tok * 2 + (tid & 1); EWT[e * ECAP + pos] = __builtin_bit_cast(float, tmpe[512 + tid]); }
        __syncthreads();
    }
    SEAM(6);

    if (IN(7) || IN(8)) {
        PHASE_PTRS
        LAS int* tp = (LAS int*)(lds + MOE_OFF);
        if (tid == 0) { int acc = 0;
            for (int e = 0; e < 16; ++e) { const int c = (int)__hip_atomic_load(ctl + CW_CNT + e, RLX_AGENT); tp[e] = acc; tp[17 + e] = c; acc += (c + 255) >> 8; }
            tp[16] = acc; }
        __syncthreads();
    }
    if (IN(7)) {
        PHASE_PTRS
        const LAS int* tp = (const LAS int*)(lds + MOE_OFF);
        MoeOrder<true> S{tp, ELIST, G, bx, tp[16] * 4};
        EpiSwiGLU E{Hb};
        pg8::gemm_phase<EpiSwiGLU, MoeOrder<true>>(lds + RING_OFF, XN2, W13T, D, S, E);
    }
    SEAM(7);
    if (IN(8)) {
        PHASE_PTRS
        const LAS int* tp = (const LAS int*)(lds + MOE_OFF);
        MoeOrder<false> S{tp, ELIST, G, bx, tp[16] * 4};
        EpiMoeOut E{Yb, ELIST, EWT};
        pg8::gemm_phase<EpiMoeOut, MoeOrder<false>>(lds + RING_OFF, Hb, W2T, DE, S, E);
    }
    SEAM(8);

    if (IN(9)) {
        PHASE_PTRS
        const float* norm_final = KA(20); float* outp = ({ const __attribute__((address_space(4))) Args* _p = (const __attribute__((address_space(4))) Args*)__builtin_amdgcn_kernarg_segment_ptr(); asm volatile("" : "+s"(_p)); _p->out; });
        for (int row = gw; row < T; row += NGW) {
            const int mb = row >> 11; f32x4 v[4]; float s = 0.f;
#pragma unroll
            for (int j = 0; j < 4; ++j) { const int col = 4 * lane + 256 * j; const f32x4 xv = *(const f32x4*)(X1 + (size_t)row * D + col), ga = *(const f32x4*)(MOD + mb * 6144 + 5120 + col);
                const v2u y0 = *(const v2u*)(Yb + (size_t)(2 * row) * D + col), y1 = *(const v2u*)(Yb + (size_t)(2 * row + 1) * D + col);
                const f32x4 ys = (f32x4){bflo(y0.x) + bflo(y1.x), bfhi(y0.x) + bfhi(y1.x), bflo(y0.y) + bflo(y1.y), bfhi(y0.y) + bfhi(y1.y)};
                v[j] = xv + ga * ys; s += (v[j][0] * v[j][0] + v[j][1] * v[j][1]) + (v[j][2] * v[j][2] + v[j][3] * v[j][3]); }
            const float rstd = 1.f / sqrtf(wave_sum(s) * (1.f / D) + EPS);
#pragma unroll
            for (int j = 0; j < 4; ++j) { const int col = 4 * lane + 256 * j; const f32x4 g = *(const f32x4*)(norm_final + col);
                *(f32x4*)(outp + (size_t)row * D + col) = v[j] * rstd * g; }
        }
    }
#undef IN
#undef SEAM
}

#ifndef MK_N_LAUNCHES
#define MK_N_LAUNCHES 1
#endif
constexpr int NPHASE = 10;
extern "C" void kernel_launch(void* const* d_in, const int* in_sizes, int n_in, void* d_out, int out_size, void* d_ws, size_t ws_size, hipStream_t stream) {
    static int grid = 0;
    if (grid == 0) {
        if (n_in != 21 || in_sizes[0] != T * D || out_size != T * D || ws_size < WS_END) { fprintf(stderr, "kernel_launch: unexpected shapes (n_in %d, in0 %d, out %d, ws %zu)\n", n_in, n_in > 0 ? in_sizes[0] : -1, out_size, ws_size); grid = -1; return; }
        int dev = 0, cus = 0, per_cu = 0;
        if (hipGetDevice(&dev) != hipSuccess || hipDeviceGetAttribute(&cus, hipDeviceAttributeMultiprocessorCount, dev) != hipSuccess) { grid = -1; return; }
        if (hipFuncSetAttribute((const void*)fwd_mega, hipFuncAttributeMaxDynamicSharedMemorySize, LDS_BYTES) != hipSuccess) { fprintf(stderr, "kernel_launch: hipFuncSetAttribute failed\n"); grid = -1; return; }
        if (hipOccupancyMaxActiveBlocksPerMultiprocessor(&per_cu, (const void*)fwd_mega, NTHR, LDS_BYTES) != hipSuccess || per_cu < 1) fprintf(stderr, "kernel_launch: occupancy query reports %d\n", per_cu);
        (void)hipGetLastError();
        grid = cus;
        if (grid != 256) fprintf(stderr, "kernel_launch: %d CUs (built for 256)\n", grid);
    }
    if (grid < 0) return;
    (void)hipMemsetAsync((char*)d_ws + WS_CTL, 0, CTL_ZERO_BYTES, stream);
    Args a{};
    for (int i = 0; i < 21; ++i) a.in[i] = (const float*)d_in[i];
    a.out = (float*)d_out; a.ws = (unsigned char*)d_ws;
    if (MK_N_LAUNCHES == 1) {
        a.ph_lo = 0; a.ph_hi = NPHASE; a.li = 0;
        hipLaunchKernelGGL(fwd_mega, dim3(grid), dim3(NTHR), LDS_BYTES, stream, a);
    } else {
        for (int li = 0; li < NPHASE; ++li) { a.ph_lo = li; a.ph_hi = li + 1; a.li = 0; hipLaunchKernelGGL(fwd_mega, dim3(grid), dim3(NTHR), LDS_BYTES, stream, a); }
    }
}
```

```cpp
#include <hip/hip_runtime.h>
#include <cstdio>
#include <cstdint>

#define GAS __attribute__((address_space(1)))
#define LAS __attribute__((address_space(3)))
typedef unsigned short bf16;
typedef unsigned short bf16_t;
typedef unsigned v4u __attribute__((ext_vector_type(4)));
typedef unsigned v2u __attribute__((ext_vector_type(2)));
typedef float f32x4 __attribute__((ext_vector_type(4)));
typedef float f32x2 __attribute__((ext_vector_type(2)));
typedef short bf16x8 __attribute__((ext_vector_type(8)));
typedef unsigned u32x4 __attribute__((ext_vector_type(4)));
typedef GAS unsigned gu32;
#define RLX_AGENT __ATOMIC_RELAXED, __HIP_MEMORY_SCOPE_AGENT
#define LDS_WAIT() asm volatile("s_waitcnt lgkmcnt(0)" ::: "memory")
#define VM_WAIT() asm volatile("s_waitcnt vmcnt(0)" ::: "memory")

constexpr int NB = 16, SEQ = 2048, D = 1024, T = NB * SEQ, LC = 256, TC = NB * LC, MROWS = T + TC;
constexpr int GW = 64, NROWS = SEQ / GW;
constexpr int INCOLS = 4096, SEGW = 512;
constexpr int NAH = 8, NAD = 64, HGH = 4, HGD = 128;
constexpr int NE = 16, DE = 512, ECAP = T;
constexpr float EPS = 1e-6f;
constexpr int NWAVES = 8, NTHR = 512;

constexpr size_t MiB = 1u << 20;
constexpr size_t WS_CTL = 0, CTL_ZERO_BYTES = 1 * MiB;
constexpr size_t WS_MOD = 1 * MiB;
constexpr size_t WS_ROPE = WS_MOD + 512 * 1024, WS_LBT = WS_MOD + 520 * 1024;
constexpr size_t WS_ELIST = 2 * MiB, WS_EWT = 4 * MiB;
constexpr size_t WS_WINT = 8 * MiB, WS_WOUTT = 16 * MiB, WS_W13T = 18 * MiB, WS_W2T = 50 * MiB;
constexpr size_t WS_XN = 66 * MiB;
constexpr size_t WS_Q = 138 * MiB, WS_K = 170 * MiB, WS_V = 206 * MiB, WS_HQ = 242 * MiB, WS_HI = 274 * MiB, WS_LF = 310 * MiB, WS_LB = 346 * MiB, WS_G = 382 * MiB;
constexpr size_t WS_OF = 414 * MiB, WS_OB = 446 * MiB, WS_QR = 478 * MiB, WS_END = 510 * MiB;
constexpr size_t WS_MIX = WS_XN, WS_XN2 = WS_XN, WS_X1 = 138 * MiB, WS_H = 274 * MiB, WS_Y = 346 * MiB;
constexpr int CW_CNT = 64;
constexpr int CW_BAR = 4096;

constexpr int RING_OFF = 0, RING_BYTES = 131072;
constexpr int LDSCTL_OFF = RING_BYTES, MISC_OFF = LDSCTL_OFF + 320, MOE_OFF = LDSCTL_OFF + 1024;
constexpr int LDS_BYTES = 147456;

__device__ __forceinline__ unsigned f2bf(float f) { unsigned u = __builtin_bit_cast(unsigned, f); return (u + 0x7fffu + ((u >> 16) & 1u)) >> 16; }
__device__ __forceinline__ unsigned pk2(float lo, float hi) { return f2bf(lo) | (f2bf(hi) << 16); }
__device__ __forceinline__ float bf2f(unsigned short b) { return __builtin_bit_cast(float, (unsigned)b << 16); }
__device__ __forceinline__ float bflo(unsigned u) { return __builtin_bit_cast(float, u << 16); }
__device__ __forceinline__ float bfhi(unsigned u) { return __builtin_bit_cast(float, u & 0xffff0000u); }
__device__ __forceinline__ unsigned pkh2(float lo, float hi) { _Float16 a = (_Float16)lo, b = (_Float16)hi; return (unsigned)__builtin_bit_cast(unsigned short, a) | ((unsigned)__builtin_bit_cast(unsigned short, b) << 16); }
__device__ __forceinline__ float h2f(unsigned short h) { return (float)__builtin_bit_cast(_Float16, h); }
__device__ __forceinline__ float silu_f(float v) { return v / (1.f + __expf(-v)); }
__device__ __forceinline__ float wave_sum(float v) {
#pragma unroll
    for (int o = 1; o < 64; o <<= 1) v += __shfl_xor(v, o);
    return v;
}
__device__ __forceinline__ float wave_max(float v) {
#pragma unroll
    for (int o = 1; o < 64; o <<= 1) v = fmaxf(v, __shfl_xor(v, o));
    return v;
}

namespace pg8 {
constexpr int BM = 256, BK = 64, HALF = 128, HTB = HALF * BK * 2, STAGE_BYTES = 8 * HTB, NXCD = 8, WGM = 8;
__host__ __device__ __forceinline__ int lds_byte(int r, int c) { const int st = (r >> 4) * 2 + (c >> 5), rr = r & 15, cc = c & 31, ob = rr * 64 + cc * 2; return st * 1024 + (ob ^ (((ob >> 9) & 1) << 5)); }
__host__ __device__ __forceinline__ void stage_rc(int b, int& R, int& C) { const int st = b / 1024, sb = b % 1024, swz = sb ^ (((sb >> 9) & 1) << 5); R = (st >> 1) * 16 + swz / 64; C = (st & 1) * 32 + (swz % 64) / 2; }
__host__ __device__ __forceinline__ int perm32(int rho) { const int n = rho >> 4, i = rho & 15; return 8 * (i >> 2) + 4 * n + (i & 3); }

struct Unit { int pm, pn, e, tm, cnt; };

typedef float f32x2_t __attribute__((ext_vector_type(2))); typedef __bf16 bf16x2_t __attribute__((ext_vector_type(2)));
__device__ __forceinline__ unsigned cvt_pk_bf16(float lo, float hi) { f32x2_t v = {lo, hi}; bf16x2_t b = __builtin_convertvector(v, bf16x2_t); return __builtin_bit_cast(unsigned, b); }

struct DenseOrder {
    static constexpr bool GATHER = false;
    int nM, nN, nwg, G, c;
    __device__ void init(int M, int N, int G_, int c_) { nM = M / BM; nN = N / BM; nwg = nM * nN; G = G_; c = c_; }
    __device__ bool next(int i, Unit& u) const {
        const long L = (long)i * G + c; if (L >= nwg) return false;
        int wgid = (int)L; { const int q = nwg / NXCD, r = nwg % NXCD, xcd = wgid % NXCD, off = wgid / NXCD; wgid = (xcd < r ? xcd * (q + 1) : r * (q + 1) + (xcd - r) * q) + off; }
        const int nig = WGM * nN, gid = wgid / nig, fm = gid * WGM, gsz = (nM - fm) < WGM ? (nM - fm) : WGM;
        u.pm = fm + ((wgid % nig) % gsz); u.pn = (wgid % nig) / gsz; u.e = 0; u.tm = 0; u.cnt = 0; return true;
    }
    __device__ __forceinline__ int a_row0(const Unit& u) const { return u.pm * BM; }
    __device__ __forceinline__ int a_row(const Unit& u, int r) const { return u.pm * BM + r; }
    __device__ __forceinline__ int b_row0(const Unit& u) const { return u.pn * BM; }
};

template <class Epi, class Sched>
__device__ __forceinline__ void gemm_phase(LAS unsigned char* lds, const bf16_t* Aptr, const bf16_t* Btptr, const int K, const Sched& S, const Epi& E) {
    const int tid = threadIdx.x, wid = __builtin_amdgcn_readfirstlane(tid >> 6), lane = tid & 63, wr = wid >> 2, wc = wid & 3, fr = lane & 15, fq = lane >> 4;
    const int nt = K / BK;
    int sR[2], sC[2];
    unsigned voffA[2], voffB[2];
#pragma unroll
    for (int i = 0; i < 2; ++i) { int R, C; stage_rc(tid * 16 + i * 8192, R, C); const int Rb = Epi::PERM ? ((R & ~31) + perm32(R & 31)) : R;
        sR[i] = R; sC[i] = C; voffA[i] = (unsigned)(R * K + C) * 2u; voffB[i] = (unsigned)(Rb * K + C) * 2u; }
    const size_t kstep = (size_t)(BK * 2);
    const size_t hstep = (size_t)HALF * K * 2;
    const size_t rowb = (size_t)K * 2;
    const unsigned ldsw = (unsigned)wid * 1024u;
    const int aoff = lds_byte(wr * 64 + fr, fq * 8), boff = lds_byte(wc * 32 + fr, fq * 8);
    const char* Ab = (const char*)Aptr;
#define PG8_SA(b, h) (((b) * 2 + (h)) * HTB)
#define PG8_SB(b, h) ((4 + (b) * 2 + (h)) * HTB)
#define PG8_STAGE(bufoff, gbase, voff) do { _Pragma("unroll") for (int _i = 0; _i < 2; ++_i) \
        __builtin_amdgcn_global_load_lds((const unsigned*)((const char*)(gbase) + (voff)[_i]), (LAS unsigned*)(lds + (bufoff) + ldsw + _i * 8192), 16, 0, 0); } while (0)
#define PG8_LDA(dst, b, h) do { _Pragma("unroll") for (int m = 0; m < 4; ++m) _Pragma("unroll") for (int k = 0; k < 2; ++k) dst[m][k] = *(const LAS bf16x8*)(lds + PG8_SA(b, h) + aoff + m * 2048 + k * 1024); } while (0)
#define PG8_LDB(dst, b, h) do { _Pragma("unroll") for (int n = 0; n < 2; ++n) _Pragma("unroll") for (int k = 0; k < 2; ++k) dst[n][k] = *(const LAS bf16x8*)(lds + PG8_SB(b, h) + boff + n * 2048 + k * 1024); } while (0)
#define PG8_MMA(ai, bj, At, Bt) do { __builtin_amdgcn_s_setprio(1); _Pragma("unroll") for (int m = 0; m < 4; ++m) _Pragma("unroll") for (int n = 0; n < 2; ++n) _Pragma("unroll") for (int k = 0; k < 2; ++k) \
        acc[ai][bj][m][n] = __builtin_amdgcn_mfma_f32_16x16x32_bf16(Bt[n][k], At[m][k], acc[ai][bj][m][n], 0, 0, 0); __builtin_amdgcn_s_setprio(0); } while (0)
#define PG8_WAIT_V(n) asm volatile("s_waitcnt vmcnt(" #n ")" ::: "memory")
#define PG8_WAIT_L(n) asm volatile("s_waitcnt lgkmcnt(" #n ")" ::: "memory")
#define PG8_BAR __builtin_amdgcn_s_barrier()
#define PG8_SCHED __builtin_amdgcn_sched_barrier(0)
    Unit cur, nxt; int ui = 0;
    if (!S.next(0, cur)) return;
    f32x4 acc[2][2][4][2];
#pragma unroll
    for (int a = 0; a < 2; ++a)
#pragma unroll
        for (int b = 0; b < 2; ++b)
#pragma unroll
            for (int m = 0; m < 4; ++m)
#pragma unroll
                for (int n = 0; n < 2; ++n) acc[a][b][m][n] = (f32x4){0.f, 0.f, 0.f, 0.f};
    bf16x8 At[4][2], B0[2][2], B1[2][2];
    const char* cA = Ab; unsigned cG[2][2];
    if constexpr (Sched::GATHER) {
#pragma unroll
        for (int h = 0; h < 2; ++h)
#pragma unroll
            for (int i = 0; i < 2; ++i) cG[h][i] = (unsigned)((size_t)S.a_row(cur, h * HALF + sR[i]) * rowb) + (unsigned)sC[i] * 2u;
    } else { cA = Ab + (ptrdiff_t)S.a_row0(cur) * (ptrdiff_t)rowb; cG[0][0] = cG[0][1] = cG[1][0] = cG[1][1] = 0u; }
    const char* cB = (const char*)Btptr + (ptrdiff_t)S.b_row0(cur) * (ptrdiff_t)rowb;
#define PG8_STAGEA(bufoff, h, dbase, goffs, kb) do { if constexpr (Sched::GATHER) { PG8_STAGE(bufoff, Ab + (kb), (goffs)[h]); } else { PG8_STAGE(bufoff, (dbase) + (h) * hstep + (kb), voffA); } } while (0)
    PG8_STAGE(PG8_SB(0, 0), cB, voffB); PG8_STAGE(PG8_SB(0, 1), cB + hstep, voffB); PG8_STAGEA(PG8_SA(0, 0), 0, cA, cG, 0); PG8_STAGEA(PG8_SA(0, 1), 1, cA, cG, 0);
    if (wr == 1) PG8_BAR;
    PG8_WAIT_V(2); PG8_BAR;
    PG8_STAGE(PG8_SB(1, 0), cB + kstep, voffB); PG8_STAGEA(PG8_SA(1, 0), 0, cA, cG, kstep); PG8_STAGE(PG8_SB(1, 1), cB + hstep + kstep, voffB);
    PG8_WAIT_V(6); PG8_BAR;
    for (;;) {
        const bool has_next = S.next(ui + 1, nxt);
        const char* nA = cA; const char* nB = cB; unsigned nG[2][2];
#pragma unroll
        for (int h = 0; h < 2; ++h)
#pragma unroll
            for (int i = 0; i < 2; ++i) nG[h][i] = cG[h][i];
        if (has_next) {
            nB = (const char*)Btptr + (ptrdiff_t)S.b_row0(nxt) * (ptrdiff_t)rowb;
            if constexpr (Sched::GATHER) {
#pragma unroll
                for (int h = 0; h < 2; ++h)
#pragma unroll
                    for (int i = 0; i < 2; ++i) nG[h][i] = (unsigned)((size_t)S.a_row(nxt, h * HALF + sR[i]) * rowb) + (unsigned)sC[i] * 2u;
            } else nA = Ab + (ptrdiff_t)S.a_row0(nxt) * (ptrdiff_t)rowb;
        }
        for (int t = 0; t < nt; t += 2) {
            const bool last = (t == nt - 2);
            const size_t kb1 = (size_t)(t + 1) * kstep;
            const size_t kb2 = last ? 0 : (size_t)(t + 2) * kstep, kb3 = kb2 + kstep;
            const char* a2 = last ? nA : cA; const char* b2 = last ? nB : cB + (size_t)(t + 2) * kstep; const char* b3 = b2 + kstep;
            unsigned g2[2][2];
#pragma unroll
            for (int h = 0; h < 2; ++h)
#pragma unroll
                for (int i = 0; i < 2; ++i) g2[h][i] = last ? nG[h][i] : cG[h][i];
            PG8_LDB(B0, 0, 0); PG8_LDB(B1, 0, 1); PG8_SCHED; PG8_LDA(At, 0, 0); PG8_STAGEA(PG8_SA(1, 1), 1, cA, cG, kb1);
            PG8_WAIT_V(8); PG8_WAIT_L(0); PG8_BAR; PG8_MMA(0, 0, At, B0); PG8_MMA(0, 1, At, B1); PG8_BAR; PG8_SCHED;
            PG8_LDA(At, 0, 1); PG8_STAGE(PG8_SB(0, 0), b2, voffB); PG8_STAGE(PG8_SB(0, 1), b2 + hstep, voffB); PG8_STAGEA(PG8_SA(0, 0), 0, a2, g2, kb2);
            PG8_WAIT_V(8); PG8_WAIT_L(0); PG8_BAR; PG8_MMA(1, 0, At, B0); PG8_MMA(1, 1, At, B1); PG8_BAR; PG8_SCHED;
            PG8_LDB(B0, 1, 0); PG8_LDB(B1, 1, 1); PG8_SCHED; PG8_LDA(At, 1, 0); PG8_STAGEA(PG8_SA(0, 1), 1, a2, g2, kb2);
            PG8_WAIT_V(8); PG8_WAIT_L(0); PG8_BAR; PG8_MMA(0, 0, At, B0); PG8_MMA(0, 1, At, B1); PG8_BAR; PG8_SCHED;
            PG8_LDA(At, 1, 1); PG8_STAGE(PG8_SB(1, 0), b3, voffB); PG8_STAGE(PG8_SB(1, 1), b3 + hstep, voffB); PG8_STAGEA(PG8_SA(1, 0), 0, a2, g2, kb3);
            PG8_WAIT_V(8); PG8_WAIT_L(0); PG8_BAR; PG8_MMA(1, 0, At, B0); PG8_MMA(1, 1, At, B1); PG8_BAR; PG8_SCHED;
        }
        if (wr == 0) PG8_BAR;
        E(acc, cur, wr, wc, fr, fq);
        if (!has_next) break;
#pragma unroll
        for (int a = 0; a < 2; ++a)
#pragma unroll
            for (int b = 0; b < 2; ++b)
#pragma unroll
                for (int m = 0; m < 4; ++m)
#pragma unroll
                    for (int n = 0; n < 2; ++n) acc[a][b][m][n] = (f32x4){0.f, 0.f, 0.f, 0.f};
        cur = nxt; cA = nA; cB = nB; ++ui;
#pragma unroll
        for (int h = 0; h < 2; ++h)
#pragma unroll
            for (int i = 0; i < 2; ++i) cG[h][i] = nG[h][i];
        if (wr == 1) PG8_BAR;
    }
    PG8_WAIT_V(0);
    PG8_BAR;
#undef PG8_SA
#undef PG8_SB
#undef PG8_STAGE
#undef PG8_STAGEA
#undef PG8_LDA
#undef PG8_LDB
#undef PG8_MMA
#undef PG8_WAIT_V
#undef PG8_WAIT_L
#undef PG8_BAR
#undef PG8_SCHED
}
}

#define XB_TMO      128
#define XB_XCNT(j)  (256  + 64 * (j))
#define XB_XSUB(j)  (1280 + 64 * (j))
#define XB_XGEN(j)  (2304 + 64 * (j))
#define XB_TOP      3328
#define XB_TOPGEN   3392
#define XCD_BAR_WORDS 3456
#define XB_SPIN_CAP (1u << 18)
__device__ __forceinline__ unsigned xb_ld(unsigned* p)              { return __hip_atomic_load(p, __ATOMIC_RELAXED, __HIP_MEMORY_SCOPE_AGENT); }
__device__ __forceinline__ unsigned xb_add(unsigned* p, unsigned v) { return __hip_atomic_fetch_add(p, v, __ATOMIC_RELAXED, __HIP_MEMORY_SCOPE_AGENT); }
__device__ __forceinline__ unsigned xb_xcc_id() { return (unsigned)__builtin_amdgcn_s_getreg((3 << 11) | 20) & 0xFu; }
#define XB_SPIN(cond, bar) do { unsigned _sp = 0; while (cond) { __builtin_amdgcn_s_sleep(1); \
    if ((++_sp & 255u) == 0u) { if (xb_ld(&(bar)[XB_TMO])) break; if (_sp > XB_SPIN_CAP) { atomicAdd(&(bar)[XB_TMO], 1u); break; } } } } while (0)
struct XcdBarrier { unsigned* bar; unsigned x; volatile LAS unsigned* st; };
__device__ __forceinline__ XcdBarrier xcd_barrier_post(unsigned* bar, volatile LAS unsigned* st) {
    XcdBarrier b; b.bar = bar; b.x = xb_xcc_id(); b.st = st;
    if (threadIdx.x == 0) (void)xb_add(&bar[XB_XCNT(b.x)], 1u);
    return b;
}
__device__ __forceinline__ void xcd_barrier_complete(unsigned* bar, unsigned x, unsigned& nloc, unsigned& nx) {
    const unsigned G = gridDim.x * gridDim.y * gridDim.z;
    unsigned sum, cnt, mine, sp = 0u;
    for (;;) {
        sum = 0u; cnt = 0u; mine = 0u;
#pragma unroll
        for (unsigned j = 0; j < 16; ++j) { const unsigned c = xb_ld(&bar[XB_XCNT(j)]); sum += c; cnt += (c > 0u) ? 1u : 0u; mine = (j == x) ? c : mine; }
        if (sum == G) break;
        __builtin_amdgcn_s_sleep(1);
        if ((++sp & 255u) == 0u) { if (xb_ld(&bar[XB_TMO])) break; if (sp > XB_SPIN_CAP) { atomicAdd(&bar[XB_TMO], 1u); break; } }
    }
    nloc = mine > 0u ? mine : 1u; nx = cnt > 0u ? cnt : 1u;
}
__device__ __forceinline__ void xcd_barrier(const XcdBarrier& b) {
    asm volatile("s_waitcnt vmcnt(0)" ::: "memory");
    __syncthreads();
    if (threadIdx.x == 0) {
        unsigned* bar = b.bar;
        __builtin_amdgcn_s_waitcnt(0);
        unsigned nloc = b.st[0], nx = b.st[1];
        if (nloc == 0u) { xcd_barrier_complete(bar, b.x, nloc, nx); b.st[0] = nloc; b.st[1] = nx; }
        const unsigned old = xb_add(&bar[XB_XSUB(b.x)], 1u);
        const unsigned gen = old / nloc;
        if (old + 1u == (gen + 1u) * nloc) {
            __builtin_amdgcn_fence(__ATOMIC_RELEASE, "agent");
            asm volatile("s_waitcnt vmcnt(0)" ::: "memory");
            const unsigned og = xb_add(&bar[XB_TOP], 1u);
            const unsigned tg = og / nx;
            if (og + 1u == (tg + 1u) * nx) xb_add(&bar[XB_TOPGEN], 1u);
            else XB_SPIN(xb_ld(&bar[XB_TOPGEN]) == tg, bar);
            __builtin_amdgcn_fence(__ATOMIC_ACQUIRE, "agent");
            xb_add(&bar[XB_XGEN(b.x)], 1u);
            asm volatile("s_waitcnt vmcnt(0)" ::: "memory");
        } else {
            XB_SPIN(xb_ld(&bar[XB_XGEN(b.x)]) == gen, bar);
            __builtin_amdgcn_fence(__ATOMIC_ACQUIRE, "agent");
            asm volatile("s_waitcnt vmcnt(0)" ::: "memory");
        }
    }
    __syncthreads();
}

using pg8::Unit;
typedef f32x4 acc_t[2][2][4][2];

struct EpiProj {
    static constexpr bool PERM = false;
    unsigned char* ws;
    __device__ __forceinline__ void operator()(const acc_t& acc, const Unit& u, int wr, int wc, int fr, int fq) const {
        const int seg = u.pn >> 1; const bool latent = u.pm < (T / 256);
        if (!latent && (seg == 0 || seg == 3 || seg == 7)) return;
        if (u.e) {
            const size_t soff[8] = {0, 0, WS_V, WS_HQ, WS_HI, WS_LF, WS_LB, 0};
            size_t so2 = soff[2];
#pragma unroll
            for (int q = 3; q < 7; ++q) so2 = (seg == q) ? soff[q] : so2;
            bf16* dT = (bf16*)(ws + so2);
            const int ldt = (seg == 3) ? T : MROWS;
            const int wrow0 = (u.pn & 1) * 256 + wr * 64 + fr, tcol0 = u.pm * 256 + wc * 32 + 4 * fq;
            const float* lbt = (const float*)(ws + WS_LBT) + (seg == 6 ? 512 : 0);
#pragma unroll
            for (int ai = 0; ai < 2; ++ai)
#pragma unroll
                for (int m = 0; m < 4; ++m) { const int wrow = wrow0 + ai * 128 + m * 16; const float lb = (seg >= 5) ? lbt[wrow] : 0.f;
#pragma unroll
                    for (int bj = 0; bj < 2; ++bj)
#pragma unroll
                        for (int n = 0; n < 2; ++n) { f32x4 x = acc[ai][bj][m][n]; v2u w;
                            if (seg >= 5) { float lf[4];
#pragma unroll
                                for (int j = 0; j < 4; ++j) { const float sg = 1.f / (1.f + __expf(-x[j])); lf[j] = __log2f(lb + (1.f - lb) * sg); }
                                w = (v2u){pkh2(lf[0], lf[1]), pkh2(lf[2], lf[3])}; }
                            else { if (seg == 3) {
#pragma unroll
                                    for (int j = 0; j < 4; ++j) x[j] = silu_f(x[j]); }
                                w = (v2u){pg8::cvt_pk_bf16(x[0], x[1]), pg8::cvt_pk_bf16(x[2], x[3])}; }
                            *(v2u*)(dT + (size_t)wrow * ldt + tcol0 + bj * 128 + n * 16) = w; } }
            return;
        }
        const int lc0 = (u.pn & 1) * 256 + wc * 32 + 4 * fq;
        const size_t segoff[8] = {WS_Q, WS_K, WS_V, WS_HQ, WS_HI, WS_LF, WS_LB, WS_G};
        size_t so = segoff[0];
#pragma unroll
        for (int s = 1; s < 8; ++s) so = (seg == s) ? segoff[s] : so;
        bf16* dst = (bf16*)(ws + so);
        const int row0 = u.pm * 256 + wr * 64 + fr;
        if ((seg == 1 || seg == 0) && latent) {
            const float* rope = (const float*)(ws + WS_ROPE);
#pragma unroll
            for (int ai = 0; ai < 2; ++ai)
#pragma unroll
                for (int m = 0; m < 4; ++m) { const int row = row0 + ai * 128 + m * 16, s = row & (SEQ - 1); const int pos = (wc & 1) ? (s & 63) : (s >> 6);
                    const f32x4 cs0 = *(const f32x4*)(rope + (pos * 16 + 4 * fq) * 2), cs1 = *(const f32x4*)(rope + (pos * 16 + 4 * fq) * 2 + 4);
                    const float cc[4] = {cs0[0], cs0[2], cs1[0], cs1[2]}, sn[4] = {cs0[1], cs0[3], cs1[1], cs1[3]};
#pragma unroll
                    for (int bj = 0; bj < 2; ++bj) { const f32x4 x1 = acc[ai][bj][m][0], x2 = acc[ai][bj][m][1]; float o1[4], o2[4];
#pragma unroll
                        for (int j = 0; j < 4; ++j) { o1[j] = x1[j] * cc[j] - x2[j] * sn[j]; o2[j] = x2[j] * cc[j] + x1[j] * sn[j]; }
                        bf16* p = (seg == 0 ? (bf16*)(ws + WS_QR) : dst) + (size_t)row * SEGW + lc0 + bj * 128;
                        if (seg == 0) { bf16* pr = dst + (size_t)row * SEGW + lc0 + bj * 128;
                            *(v2u*)pr = (v2u){pg8::cvt_pk_bf16(x1[0], x1[1]), pg8::cvt_pk_bf16(x1[2], x1[3])}; *(v2u*)(pr + 16) = (v2u){pg8::cvt_pk_bf16(x2[0], x2[1]), pg8::cvt_pk_bf16(x2[2], x2[3])}; }
                        *(v2u*)p = (v2u){pg8::cvt_pk_bf16(o1[0], o1[1]), pg8::cvt_pk_bf16(o1[2], o1[3])};
                        *(v2u*)(p + 16) = (v2u){pg8::cvt_pk_bf16(o2[0], o2[1]), pg8::cvt_pk_bf16(o2[2], o2[3])}; } }
            return;
        }
        const bool act = (seg == 3 || seg == 7);
#pragma unroll
        for (int ai = 0; ai < 2; ++ai)
#pragma unroll
            for (int m = 0; m < 4; ++m) { const int row = row0 + ai * 128 + m * 16;
#pragma unroll
                for (int bj = 0; bj < 2; ++bj)
#pragma unroll
                    for (int n = 0; n < 2; ++n) { f32x4 x = acc[ai][bj][m][n];
                        if (act) {
#pragma unroll
                            for (int j = 0; j < 4; ++j) x[j] = silu_f(x[j]); }
                        *(v2u*)(dst + (size_t)row * SEGW + lc0 + bj * 128 + n * 16) = (v2u){pg8::cvt_pk_bf16(x[0], x[1]), pg8::cvt_pk_bf16(x[2], x[3])}; } }
    }
};
struct EpiRes {
    static constexpr bool PERM = false;
    const float* x; float* x1; const float* mod;
    __device__ __forceinline__ void operator()(const acc_t& acc, const Unit& u, int wr, int wc, int fr, int fq) const {
        const int b = u.pm >> 3; const int col0 = u.pn * 256 + wc * 32 + 4 * fq; const int row0 = u.pm * 256 + wr * 64 + fr;
#pragma unroll
        for (int bj = 0; bj < 2; ++bj)
#pragma unroll
            for (int n = 0; n < 2; ++n) { const int col = col0 + bj * 128 + n * 16; const f32x4 ga = *(const f32x4*)(mod + b * 6144 + 2048 + col);
#pragma unroll
                for (int ai = 0; ai < 2; ++ai)
#pragma unroll
                    for (int m = 0; m < 4; ++m) { const size_t off = (size_t)(row0 + ai * 128 + m * 16) * D + col;
                        const f32x4 xv = *(const f32x4*)(x + off); *(f32x4*)(x1 + off) = xv + ga * acc[ai][bj][m][n]; } }
    }
};
struct EpiSwiGLU {
    static constexpr bool PERM = true;
    bf16* H;
    __device__ __forceinline__ void operator()(const acc_t& acc, const Unit& u, int wr, int wc, int fr, int fq) const {
        const int hc = u.pn * 128 + wc * 32 + 8 * fq; const int row0 = u.pm * 256 + wr * 64 + fr;
#pragma unroll
        for (int ai = 0; ai < 2; ++ai)
#pragma unroll
            for (int m = 0; m < 4; ++m) { float h[8];
#pragma unroll
                for (int n = 0; n < 2; ++n)
#pragma unroll
                    for (int j = 0; j < 4; ++j) h[n * 4 + j] = silu_f(acc[ai][0][m][n][j]) * acc[ai][1][m][n][j];
                u32x4 w; w.x = pg8::cvt_pk_bf16(h[0], h[1]); w.y = pg8::cvt_pk_bf16(h[2], h[3]); w.z = pg8::cvt_pk_bf16(h[4], h[5]); w.w = pg8::cvt_pk_bf16(h[6], h[7]);
                *(u32x4*)(H + (size_t)(row0 + ai * 128 + m * 16) * DE + hc) = w; }
    }
};
struct EpiMoeOut {
    static constexpr bool PERM = true;
    bf16* Y; const int* elist; const float* ewt;
    __device__ __forceinline__ void operator()(const acc_t& acc, const Unit& u, int wr, int wc, int fr, int fq) const {
        const int col0 = u.pn * 256 + wc * 32 + 8 * fq;
#pragma unroll
        for (int ai = 0; ai < 2; ++ai)
#pragma unroll
            for (int m = 0; m < 4; ++m) { const int rank = u.tm * 256 + ai * 128 + wr * 64 + m * 16 + fr;
                if (rank < u.cnt) { const int tk = elist[u.e * ECAP + rank]; const float w = ewt[u.e * ECAP + rank];
#pragma unroll
                    for (int bj = 0; bj < 2; ++bj) { const f32x4 v0 = acc[ai][bj][m][0] * w, v1 = acc[ai][bj][m][1] * w; u32x4 o;
                        o.x = pg8::cvt_pk_bf16(v0[0], v0[1]); o.y = pg8::cvt_pk_bf16(v0[2], v0[3]); o.z = pg8::cvt_pk_bf16(v1[0], v1[1]); o.w = pg8::cvt_pk_bf16(v1[2], v1[3]);
                        *(u32x4*)(Y + (size_t)tk * D + col0 + bj * 128) = o; } } }
    }
};
template <bool GATHER_> struct MoeOrder {
    static constexpr bool GATHER = GATHER_;
    const LAS int* tp; const int* elist; int G, c, nwg;
    __device__ bool next(int i, Unit& u) const {
        const long L = (long)i * G + c; if (L >= nwg) return false;
        int wgid = (int)L; { const int q = nwg / 8, r = nwg % 8, xcd = wgid % 8, off = wgid / 8; wgid = (xcd < r ? xcd * (q + 1) : r * (q + 1) + (xcd - r) * q) + off; }
        const int gt = wgid >> 2; int e = 0;
#pragma unroll
        for (int k = 1; k < 16; ++k) e = (gt >= tp[k]) ? k : e;
        u.pm = gt; u.pn = wgid & 3; u.e = e; u.tm = gt - tp[e]; u.cnt = tp[17 + e]; return true;
    }
    __device__ __forceinline__ int a_row0(const Unit& u) const { return u.pm * 256; }
    __device__ __forceinline__ int a_row(const Unit& u, int r) const {
        if constexpr (GATHER_) { int rank = u.tm * 256 + r; rank = rank < u.cnt ? rank : u.cnt - 1; return elist[u.e * ECAP + rank] >> 1; }
        else return u.pm * 256 + r;
    }
    __device__ __forceinline__ int b_row0(const Unit& u) const { return u.e * 1024 + u.pn * 256; }
};


constexpr int SWMASK = 0x7C;
constexpr int W_REL_XN = (int)(((long long)WS_WINT - (long long)WS_XN) / 2048);
struct ProjOrder {
    static constexpr bool GATHER = false;
    pg8::DenseOrder d;
    __device__ void init(int G_, int c_) { d.init(MROWS, INCOLS, G_, c_); }
    __device__ bool next(int i, Unit& u) const { if (!d.next(i, u)) return false; u.e = (SWMASK >> (u.pn >> 1)) & 1; return true; }
    __device__ __forceinline__ int a_row0(const Unit& u) const { return u.e ? W_REL_XN + u.pn * 256 : u.pm * 256; }
    __device__ __forceinline__ int a_row(const Unit& u, int r) const { return a_row0(u) + r; }
    __device__ __forceinline__ int b_row0(const Unit& u) const { return u.e ? -W_REL_XN + u.pm * 256 : u.pn * 256; }
};


__device__ __forceinline__ bf16x8 pack8(const f32x4& a, const f32x4& b) {
    u32x4 w; w.x = pg8::cvt_pk_bf16(a[0], a[1]); w.y = pg8::cvt_pk_bf16(a[2], a[3]); w.z = pg8::cvt_pk_bf16(b[0], b[1]); w.w = pg8::cvt_pk_bf16(b[2], b[3]);
    return __builtin_bit_cast(bf16x8, w);
}
typedef unsigned bu4 __attribute__((__vector_size__(16)));
__device__ __forceinline__ bf16x8 bload16(__amdgpu_buffer_rsrc_t r, unsigned voff, unsigned soff) { return __builtin_bit_cast(bf16x8, __builtin_amdgcn_raw_buffer_load_b128(r, (int)voff, (int)soff, 0)); }
#define NA_SB() __builtin_amdgcn_sched_barrier(0)
template <bool LOCAL>
__device__ __forceinline__ void na_chunk(f32x4 (&o)[4], float& m_run, float& l_run, const bf16x8 q0, const bf16x8 q1, __amdgpu_buffer_rsrc_t srdK, __amdgpu_buffer_rsrc_t srdV,
                                         unsigned klane, unsigned vlane, unsigned ksoff, unsigned vsoff, const LAS float* bpl, int lo) {
    constexpr float SC = 0.125f * 1.44269504f; const float NEG = -1e30f;
    constexpr unsigned KROW = LOCAL ? GW * SEGW * 2 : 32 * SEGW * 2;
    constexpr unsigned VROW = LOCAL ? GW * 2 : 32 * 2;
    f32x4 s[16];
    bf16x8 kf[2][4][2];
#define NA_KLOAD(buf, bt) do { _Pragma("unroll") for (int tt = 0; tt < 4; ++tt) { const int t = 4 * (bt) + tt; const unsigned so = ksoff + (unsigned)(t >> 1) * KROW + (unsigned)(t & 1) * (4 * SEGW * 2); \
        kf[buf][tt][0] = bload16(srdK, klane, so); kf[buf][tt][1] = bload16(srdK, klane, so + 64); } } while (0)
    NA_KLOAD(0, 0); NA_SB();
#pragma unroll
    for (int bt = 0; bt < 4; ++bt) {
        if (bt < 3) { if (bt & 1) NA_KLOAD(0, bt + 1); else NA_KLOAD(1, bt + 1); }
        NA_SB();
#pragma unroll
        for (int tt = 0; tt < 4; ++tt) { const int t = 4 * bt + tt;
            s[t] = __builtin_amdgcn_mfma_f32_16x16x32_bf16(kf[bt & 1][tt][0], q0, (f32x4){0.f, 0.f, 0.f, 0.f}, 0, 0, 0);
            s[t] = __builtin_amdgcn_mfma_f32_16x16x32_bf16(kf[bt & 1][tt][1], q1, s[t], 0, 0, 0); }
        asm volatile("" : "+v"(s[4 * bt]), "+v"(s[4 * bt + 1]), "+v"(s[4 * bt + 2]), "+v"(s[4 * bt + 3]));
        NA_SB();
    }
#undef NA_KLOAD
    bf16x8 vf[2][2][4];
#define NA_VLOAD(buf, kp) do { _Pragma("unroll") for (int kk = 0; kk < 2; ++kk) _Pragma("unroll") for (int dt = 0; dt < 4; ++dt) \
        vf[buf][kk][dt] = bload16(srdV, vlane, vsoff + (unsigned)(2 * (kp) + kk) * VROW + (unsigned)dt * (16 * MROWS * 2)); } while (0)
    NA_VLOAD(0, 0); NA_SB();
    float mx = NEG;
#pragma unroll
    for (int t = 0; t < 16; ++t)
#pragma unroll
        for (int e = 0; e < 4; ++e) { float v;
            if (LOCAL) { const int c = 4 * (t & 1) + e; const bool valid = (c >= lo) && (c < lo + 16); v = valid ? s[t][e] * SC + bpl[(t >> 1) * 64 + c] : NEG; }
            else v = s[t][e] * SC;
            s[t][e] = v; mx = fmaxf(mx, v); }
    mx = fmaxf(mx, __shfl_xor(mx, 16)); mx = fmaxf(mx, __shfl_xor(mx, 32));
    float mnew = mx;
    if (!LOCAL) { mnew = fmaxf(m_run, mx); const float alpha = __builtin_amdgcn_exp2f(m_run - mnew); l_run *= alpha;
#pragma unroll
        for (int dt = 0; dt < 4; ++dt) o[dt] = o[dt] * alpha; }
    float sum = 0.f; bf16x8 Bp[8];
#pragma unroll
    for (int ks = 0; ks < 8; ++ks) { f32x4 pa, pb;
#pragma unroll
        for (int e = 0; e < 4; ++e) { pa[e] = __builtin_amdgcn_exp2f(s[2 * ks][e] - mnew); pb[e] = __builtin_amdgcn_exp2f(s[2 * ks + 1][e] - mnew); sum += pa[e] + pb[e]; }
        Bp[ks] = pack8(pa, pb); }
    sum += __shfl_xor(sum, 16); sum += __shfl_xor(sum, 32);
    m_run = mnew; l_run = LOCAL ? sum : l_run + sum;
    NA_SB();
#pragma unroll
    for (int kp = 0; kp < 4; ++kp) {
        if (kp < 3) { if (kp & 1) NA_VLOAD(0, kp + 1); else NA_VLOAD(1, kp + 1); }
        NA_SB();
#pragma unroll
        for (int kk = 0; kk < 2; ++kk) { const int ks = 2 * kp + kk;
#pragma unroll
            for (int dt = 0; dt < 4; ++dt) o[dt] = __builtin_amdgcn_mfma_f32_16x16x32_bf16(vf[kp & 1][kk][dt], Bp[ks], o[dt], 0, 0, 0); }
        asm volatile("" : "+v"(o[0]), "+v"(o[1]), "+v"(o[2]), "+v"(o[3]));
        NA_SB();
    }
#undef NA_VLOAD
}
__device__ __forceinline__ void na_unit(int b, int h, int r, int jb, const bf16* Q, const bf16* QR, __amdgpu_buffer_rsrc_t srdK, __amdgpu_buffer_rsrc_t srdV, bf16* MIX, const LAS float* rpbL, int lane) {
    const int qi = lane & 15, g = lane >> 4;
    const int qc = 16 * jb + qi, tokq = b * SEQ + r * GW + qc;
    int rs = r - 4; rs = rs < 0 ? 0 : (rs > NROWS - 8 ? NROWS - 8 : rs);
    int kb = 16 * jb - 8; kb = kb < 0 ? 0 : (kb > GW - 32 ? GW - 32 : kb);
    int cs = qc - 8; cs = cs < 0 ? 0 : (cs > GW - 16 ? GW - 16 : cs);
    const bf16* qp = Q + (size_t)tokq * SEGW + h * NAD + 8 * g; const bf16* qrp = QR + (size_t)tokq * SEGW + h * NAD + 8 * g;
    const bf16x8 qraw0 = *(const bf16x8*)qp, qraw1 = *(const bf16x8*)(qp + 32), qrot0 = *(const bf16x8*)qrp, qrot1 = *(const bf16x8*)(qrp + 32);
    const unsigned klane = (unsigned)((8 * (qi >> 2) + (qi & 3)) * SEGW + 8 * g) * 2u;
    const unsigned vlane = (unsigned)(qi * MROWS + 8 * g) * 2u;
    const unsigned ksl = (unsigned)((b * SEQ + rs * GW + kb) * SEGW + h * NAD) * 2u, ksc = (unsigned)((T + b * LC) * SEGW + h * NAD) * 2u;
    const unsigned vsl = (unsigned)(h * NAD * MROWS + b * SEQ + rs * GW + kb) * 2u, vsc = (unsigned)(h * NAD * MROWS + T + b * LC) * 2u;
    const LAS float* bpl = rpbL + (h * 15 + rs - r + 7) * 64 + (kb + 8 * g - qc + 31);
    const int lo = cs - kb - 8 * g;
    f32x4 o[4];
#pragma unroll
    for (int dt = 0; dt < 4; ++dt) o[dt] = (f32x4){0.f, 0.f, 0.f, 0.f};
    float m_run = 0.f, l_run = 0.f;
    na_chunk<true>(o, m_run, l_run, qrot0, qrot1, srdK, srdV, klane, vlane, ksl, vsl, bpl, lo);
    na_chunk<false>(o, m_run, l_run, qraw0, qraw1, srdK, srdV, klane, vlane, ksc, vsc, bpl, lo);
    const float inv = 1.f / l_run;
    bf16* op = MIX + (size_t)tokq * D + h * NAD + 4 * g;
#pragma unroll
    for (int dt = 0; dt < 4; ++dt) { const f32x4 v = o[dt] * inv; *(v2u*)(op + 16 * dt) = (v2u){pg8::cvt_pk_bf16(v[0], v[1]), pg8::cvt_pk_bf16(v[2], v[3])}; }
}


typedef float f32x16 __attribute__((ext_vector_type(16)));
constexpr int SC_Q1 = 0, SC_K1 = SC_Q1 + 64 * 272, SC_K1T = SC_K1 + 64 * 272, SC_VT = SC_K1T + 128 * 144, SC_AB = SC_VT + 128 * 144, SC_ST = SC_AB + 64 * 144, SC_TOT = SC_ST + 128 * 272, SC_END = SC_TOT + 2 * 4 * 128 * 4;
static_assert(SC_END <= RING_BYTES, "scan LDS");
#define SCAN_MFMA(a, b, c) __builtin_amdgcn_mfma_f32_32x32x16_bf16(a, b, c, 0, 0, 0)
__device__ __forceinline__ void scan_unit(LAS unsigned char* lds, int b, int h, int dir, const unsigned short* LGT, const bf16* HQT, const bf16* HIT, bf16* OUT, int tid) {
    const int lane = tid & 63, w = __builtin_amdgcn_readfirstlane(tid >> 6), r = lane & 31, hh = lane >> 5;
    const int d = tid & 127, tq = tid >> 7;
    const int ti = w >> 2, ovi = w & 3;
    const int di = w >> 1, svi = 2 * (w & 1);
    f32x16 S0, S1;
#pragma unroll
    for (int i = 0; i < 16; ++i) { S0[i] = 0.f; S1[i] = 0.f; }
    const size_t chrow = (size_t)(h * HGD + d);
    constexpr int NCH = (LC + SEQ) / 64;
    auto col_of = [&](int c) -> int { return c < 4 ? (T + b * LC + 64 * (dir ? 3 - c : c)) : (b * SEQ + (dir ? SEQ - 64 * (c - 3) : 64 * (c - 4))); };
    u32x4 lgr[2], vr[2], qr[2];
    { const int c0 = col_of(0) + 16 * tq; lgr[0] = *(const u32x4*)(LGT + chrow * MROWS + c0); lgr[1] = *(const u32x4*)(LGT + chrow * MROWS + c0 + 8);
      vr[0] = *(const u32x4*)(HIT + chrow * MROWS + c0); vr[1] = *(const u32x4*)(HIT + chrow * MROWS + c0 + 8); qr[0] = qr[1] = (u32x4){0u, 0u, 0u, 0u}; }
#pragma unroll 1
    for (int c = 0; c < NCH; ++c) {
        const bool lat = c >= 4; const int par = c & 1;
        LAS float* tot = (LAS float*)(lds + SC_TOT) + par * 512;
        float P[16];
#pragma unroll
        for (int i = 0; i < 8; ++i) { const unsigned u2 = lgr[i >> 2][i & 3]; P[2 * i] = h2f((unsigned short)(u2 & 0xffff)); P[2 * i + 1] = h2f((unsigned short)(u2 >> 16)); }
        float kk[16];
#pragma unroll
        for (int i = 0; i < 16; ++i) kk[i] = 1.f - __builtin_amdgcn_exp2f(P[i]);
        if (!dir) {
#pragma unroll
            for (int i = 1; i < 16; ++i) P[i] += P[i - 1];
            tot[tq * 128 + d] = P[15];
        } else {
#pragma unroll
            for (int i = 14; i >= 0; --i) P[i] += P[i + 1];
            tot[tq * 128 + d] = P[0];
        }
        const u32x4 vcur0 = vr[0], vcur1 = vr[1], qcur0 = qr[0], qcur1 = qr[1];
        if (c + 1 < NCH) { const int c1 = col_of(c + 1) + 16 * tq;
            lgr[0] = *(const u32x4*)(LGT + chrow * MROWS + c1); lgr[1] = *(const u32x4*)(LGT + chrow * MROWS + c1 + 8);
            vr[0] = *(const u32x4*)(HIT + chrow * MROWS + c1); vr[1] = *(const u32x4*)(HIT + chrow * MROWS + c1 + 8);
            if (c + 1 >= 4) { qr[0] = *(const u32x4*)(HQT + chrow * T + c1); qr[1] = *(const u32x4*)(HQT + chrow * T + c1 + 8); } }
        __syncthreads();
        {
            const float t0 = tot[d], t1 = tot[128 + d], t2 = tot[256 + d], t3 = tot[384 + d];
            const float Bm = dir ? (t2 + t3) : (t0 + t1);
            float offs; if (!dir) offs = (tq > 0 ? t0 : 0.f) + (tq > 1 ? t1 : 0.f) + (tq > 2 ? t2 : 0.f); else offs = (tq < 3 ? t3 : 0.f) + (tq < 2 ? t2 : 0.f) + (tq < 1 ? t1 : 0.f);
            const float sh = offs - Bm;
            unsigned kt[8];
            LAS bf16* q1 = (LAS bf16*)(lds + SC_Q1) + (16 * tq) * 136 + d; LAS bf16* k1 = (LAS bf16*)(lds + SC_K1) + (16 * tq) * 136 + d;
#pragma unroll
            for (int i = 0; i < 16; i += 2) {
                const float x0 = fminf(fmaxf(P[i] + sh, -120.f), 120.f), x1 = fminf(fmaxf(P[i + 1] + sh, -120.f), 120.f);
                const float e0 = __builtin_amdgcn_exp2f(x0), e1 = __builtin_amdgcn_exp2f(x1);
                const float k0 = kk[i] * __builtin_amdgcn_exp2f(-x0), k1v = kk[i + 1] * __builtin_amdgcn_exp2f(-x1);
                kt[i >> 1] = pg8::cvt_pk_bf16(k0, k1v);
                if (lat) { const unsigned qq = (i < 8 ? qcur0 : qcur1)[(i >> 1) & 3];
                    q1[i * 136] = (bf16)f2bf(bflo(qq) * e0); q1[(i + 1) * 136] = (bf16)f2bf(bfhi(qq) * e1);
                    k1[i * 136] = (bf16)(kt[i >> 1] & 0xffff); k1[(i + 1) * 136] = (bf16)(kt[i >> 1] >> 16); }
            }
            LAS unsigned char* k1t = lds + SC_K1T + d * 144 + 32 * tq;
            *(LAS u32x4*)k1t = (u32x4){kt[0], kt[1], kt[2], kt[3]}; *(LAS u32x4*)(k1t + 16) = (u32x4){kt[4], kt[5], kt[6], kt[7]};
            LAS unsigned char* vt = lds + SC_VT + d * 144 + 32 * tq;
            *(LAS u32x4*)vt = vcur0; *(LAS u32x4*)(vt + 16) = vcur1;
        }
        if (lat) {
#pragma unroll
            for (int rg = 0; rg < 4; ++rg) { const int dd = 32 * di + 8 * rg + 4 * hh;
                const f32x4 a0 = *(const LAS f32x4*)(tot + dd), a1 = *(const LAS f32x4*)(tot + 128 + dd), a2 = *(const LAS f32x4*)(tot + 256 + dd), a3 = *(const LAS f32x4*)(tot + 384 + dd);
                const f32x4 bm = dir ? (a2 + a3) : (a0 + a1); float eb[4];
#pragma unroll
                for (int j = 0; j < 4; ++j) eb[j] = __builtin_amdgcn_exp2f(bm[j]);
                *(LAS v2u*)(lds + SC_ST + ((32 * svi + r) * 136 + dd) * 2) = (v2u){pg8::cvt_pk_bf16(S0[4 * rg] * eb[0], S0[4 * rg + 1] * eb[1]), pg8::cvt_pk_bf16(S0[4 * rg + 2] * eb[2], S0[4 * rg + 3] * eb[3])};
                *(LAS v2u*)(lds + SC_ST + ((32 * (svi + 1) + r) * 136 + dd) * 2) = (v2u){pg8::cvt_pk_bf16(S1[4 * rg] * eb[0], S1[4 * rg + 1] * eb[1]), pg8::cvt_pk_bf16(S1[4 * rg + 2] * eb[2], S1[4 * rg + 3] * eb[3])}; }
        }
        __syncthreads();
        f32x16 dS0, dS1, O;
#pragma unroll
        for (int i = 0; i < 16; ++i) { dS0[i] = 0.f; dS1[i] = 0.f; O[i] = 0.f; }
#pragma unroll
        for (int ks = 0; ks < 4; ++ks) {
            const bf16x8 a = *(const LAS bf16x8*)(lds + SC_K1T + ((32 * di + r) * 72 + 16 * ks + 8 * hh) * 2);
            const bf16x8 b0 = *(const LAS bf16x8*)(lds + SC_VT + ((32 * svi + r) * 72 + 16 * ks + 8 * hh) * 2), b1 = *(const LAS bf16x8*)(lds + SC_VT + ((32 * (svi + 1) + r) * 72 + 16 * ks + 8 * hh) * 2);
            dS0 = SCAN_MFMA(a, b0, dS0); dS1 = SCAN_MFMA(a, b1, dS1);
        }
        if (lat) {
#pragma unroll
            for (int ks = 0; ks < 8; ++ks) {
                const bf16x8 a = *(const LAS bf16x8*)(lds + SC_ST + ((32 * ovi + r) * 136 + 16 * ks + 8 * hh) * 2);
                const bf16x8 bq = *(const LAS bf16x8*)(lds + SC_Q1 + ((32 * ti + r) * 136 + 16 * ks + 8 * hh) * 2);
                O = SCAN_MFMA(a, bq, O);
            }
            if (w < 4) {
                const int asi = (w == 0) ? 0 : (w == 1) ? 1 : (w == 2) ? (dir ? 1 : 0) : (dir ? 0 : 1);
                const int ati = (w == 0) ? 0 : (w == 1) ? 1 : (w == 2) ? (dir ? 0 : 1) : (dir ? 1 : 0);
                f32x16 At;
#pragma unroll
                for (int i = 0; i < 16; ++i) At[i] = 0.f;
                if (w < 3) {
#pragma unroll
                    for (int ks = 0; ks < 8; ++ks) {
                        const bf16x8 a = *(const LAS bf16x8*)(lds + SC_K1 + ((32 * asi + r) * 136 + 16 * ks + 8 * hh) * 2);
                        const bf16x8 bq = *(const LAS bf16x8*)(lds + SC_Q1 + ((32 * ati + r) * 136 + 16 * ks + 8 * hh) * 2);
                        At = SCAN_MFMA(a, bq, At);
                    }
                }
                const int tt = 32 * ati + r;
#pragma unroll
                for (int rg = 0; rg < 4; ++rg) { const int s0 = 32 * asi + 8 * rg + 4 * hh; float v[4];
#pragma unroll
                    for (int j = 0; j < 4; ++j) { const int ss = s0 + j; const bool keep = dir ? (ss >= tt) : (ss <= tt); v[j] = keep ? At[4 * rg + j] : 0.f; }
                    *(LAS v2u*)(lds + SC_AB + (tt * 72 + s0) * 2) = (v2u){pg8::cvt_pk_bf16(v[0], v[1]), pg8::cvt_pk_bf16(v[2], v[3])}; }
            }
            __syncthreads();
#pragma unroll
            for (int ks = 0; ks < 4; ++ks) {
                const bf16x8 a = *(const LAS bf16x8*)(lds + SC_VT + ((32 * ovi + r) * 72 + 16 * ks + 8 * hh) * 2);
                const bf16x8 bq = *(const LAS bf16x8*)(lds + SC_AB + ((32 * ti + r) * 72 + 16 * ks + 8 * hh) * 2);
                O = SCAN_MFMA(a, bq, O);
            }
            bf16* op = OUT + (size_t)(col_of(c) + 32 * ti + r) * SEGW + h * HGD + 32 * ovi + 4 * hh;
#pragma unroll
            for (int rg = 0; rg < 4; ++rg) *(v2u*)(op + 8 * rg) = (v2u){pg8::cvt_pk_bf16(O[4 * rg], O[4 * rg + 1]), pg8::cvt_pk_bf16(O[4 * rg + 2], O[4 * rg + 3])};
        }
#pragma unroll
        for (int rg = 0; rg < 4; ++rg) { const int dd = 32 * di + 8 * rg + 4 * hh;
            const f32x4 a0 = *(const LAS f32x4*)(tot + dd), a1 = *(const LAS f32x4*)(tot + 128 + dd), a2 = *(const LAS f32x4*)(tot + 256 + dd), a3 = *(const LAS f32x4*)(tot + 384 + dd);
            const f32x4 be = (a0 + a1) + (a2 + a3), bm = dir ? (a2 + a3) : (a0 + a1);
#pragma unroll
            for (int j = 0; j < 4; ++j) { const float ee = __builtin_amdgcn_exp2f(be[j]), em = __builtin_amdgcn_exp2f(be[j] - bm[j]);
                S0[4 * rg + j] = ee * S0[4 * rg + j] + em * dS0[4 * rg + j]; S1[4 * rg + j] = ee * S1[4 * rg + j] + em * dS1[4 * rg + j]; } }
    }
}


#ifdef DBG_NAIVE
__device__ __forceinline__ void scan_naive(LAS unsigned char* lds, int b, int h, int dir, const unsigned short* LGT, const bf16* HQT, const bf16* HIT, bf16* OUT, int tid) {
    const int dv = tid & 127, kg = tid >> 7;
    float St[32];
#pragma unroll
    for (int i = 0; i < 32; ++i) St[i] = 0.f;
    LAS float* sq = (LAS float*)lds; LAS float* sk = sq + 16 * 128; LAS float* sf = sk + 16 * 128; LAS float* sv = sf + 16 * 128; LAS float* so = sv + 16 * 128;
    constexpr int NSTEP = LC + SEQ;
    for (int j0 = 0; j0 < NSTEP; j0 += 16) {
        const bool isctx = j0 < LC;
        for (int idx = tid; idx < 16 * 128; idx += NTHR) { const int st = idx >> 7, ch = idx & 127, j = j0 + st;
            int col; if (j < LC) col = T + b * LC + (dir ? (LC - 1 - j) : j); else col = b * SEQ + (dir ? (SEQ - 1 - (j - LC)) : (j - LC));
            const size_t cr = (size_t)(h * HGD + ch);
            const float f = __builtin_amdgcn_exp2f(h2f(LGT[cr * MROWS + col]));
            sf[st * 128 + ch] = f; sk[st * 128 + ch] = 1.f - f; sv[st * 128 + ch] = bf2f(HIT[cr * MROWS + col]);
            if (!isctx) sq[st * 128 + ch] = bf2f(HQT[cr * T + col]); }
        __syncthreads();
        for (int st = 0; st < 16; ++st) {
            const float vv = sv[st * 128 + dv]; float o = 0.f;
#pragma unroll
            for (int i = 0; i < 32; ++i) { St[i] = sf[st * 128 + kg * 32 + i] * St[i] + sk[st * 128 + kg * 32 + i] * vv; o += St[i] * sq[st * 128 + kg * 32 + i]; }
            so[(st * 4 + kg) * 128 + dv] = o;
        }
        __syncthreads();
        if (!isctx) {
            for (int idx = tid; idx < 16 * 128; idx += NTHR) { const int st = idx >> 7, dd = idx & 127, j = j0 + st;
                const float o = (so[(st * 4 + 0) * 128 + dd] + so[(st * 4 + 1) * 128 + dd]) + (so[(st * 4 + 2) * 128 + dd] + so[(st * 4 + 3) * 128 + dd]);
                const int row = b * SEQ + (dir ? (SEQ - 1 - (j - LC)) : (j - LC));
                OUT[(size_t)row * SEGW + h * HGD + dd] = (bf16)f2bf(o); }
        }
        __syncthreads();
    }
}
#endif

__device__ __forceinline__ void transpose_item(const float* W, int ldw, int k0, int n0, bf16* WT, int ldk, int drow0, LAS float* scr, int lane) {
#pragma unroll 8
    for (int i = 0; i < 32; ++i) { const int kk = 2 * i + (lane >> 5); scr[kk * 33 + (lane & 31)] = W[(size_t)(k0 + kk) * ldw + n0 + (lane & 31)]; }
    LDS_WAIT(); asm volatile("" ::: "memory");
    const int c = lane & 7;
#pragma unroll
    for (int j = 0; j < 4; ++j) { const int n = (lane >> 3) + 8 * j; const LAS float* s = scr + (8 * c) * 33 + n;
        v4u o; o.x = pk2(s[0 * 33], s[1 * 33]); o.y = pk2(s[2 * 33], s[3 * 33]); o.z = pk2(s[4 * 33], s[5 * 33]); o.w = pk2(s[6 * 33], s[7 * 33]);
        *(GAS v4u*)(WT + (size_t)(drow0 + n) * ldk + k0 + 8 * c) = o; }
    LDS_WAIT(); asm volatile("" ::: "memory");
}

#ifndef REP1
#define REP1 1
#endif
#ifndef REP2
#define REP2 1
#endif
#ifndef REP3
#define REP3 1
#endif
#ifndef REP4
#define REP4 1
#endif
#ifndef REP5
#define REP5 1
#endif
#ifndef REP7
#define REP7 1
#endif
#ifndef REP8
#define REP8 1
#endif
#ifndef REP9
#define REP9 1
#endif
struct Args { const float* in[21]; float* out; unsigned char* ws; int ph_lo, ph_hi, li, pad; };

__global__ void __launch_bounds__(NTHR, 2) fwd_mega(Args args) {
    extern __shared__ __attribute__((aligned(16))) unsigned char lds_raw[];
    LAS unsigned char* lds = (LAS unsigned char*)lds_raw;
    volatile LAS unsigned* MISC = (volatile LAS unsigned*)(lds + MISC_OFF);
    const int tid = threadIdx.x, lane = tid & 63, wave = __builtin_amdgcn_readfirstlane(tid >> 6);
    const int G = gridDim.x; const int bx = blockIdx.x; const int vcu = (G % 8 == 0) ? (bx % 8) * (G / 8) + bx / 8 : bx;
    gu32* ctl0 = (gu32*)(args.ws + WS_CTL);
    const int gw = vcu * NWAVES + wave, NGW = G * NWAVES;
    for (int u = tid; u < (LDS_BYTES - LDSCTL_OFF) / 4; u += NTHR) ((LAS unsigned*)(lds + LDSCTL_OFF))[u] = 0u;
    __syncthreads();
    XcdBarrier bar = xcd_barrier_post((unsigned*)(ctl0 + CW_BAR) + args.li * XCD_BAR_WORDS, MISC + 8);
    const int lo = args.ph_lo, hi = args.ph_hi;
#ifndef PHMASK
#define PHMASK 0xFFFF
#endif
#define IN(k) (((PHMASK >> (k)) & 1) && lo <= (k) && (k) < hi)
#define SEAM(k) do { if (IN(k) && IN((k) + 1)) xcd_barrier(bar); } while (0)

#define KA(i) ({ const __attribute__((address_space(4))) Args* _p = (const __attribute__((address_space(4))) Args*)__builtin_amdgcn_kernarg_segment_ptr(); asm volatile("" : "+s"(_p)); _p->in[i]; })
#define WSP() ({ const __attribute__((address_space(4))) Args* _p = (const __attribute__((address_space(4))) Args*)__builtin_amdgcn_kernarg_segment_ptr(); asm volatile("" : "+s"(_p)); _p->ws; })
#define PHASE_PTRS unsigned char* ws = WSP(); float* MOD = (float*)(ws + WS_MOD); float* ROPE = (float*)(ws + WS_ROPE); float* LBT = (float*)(ws + WS_LBT); \
    bf16* WinT = (bf16*)(ws + WS_WINT); bf16* WoutT = (bf16*)(ws + WS_WOUTT); bf16* W13T = (bf16*)(ws + WS_W13T); bf16* W2T = (bf16*)(ws + WS_W2T); \
    bf16* XN = (bf16*)(ws + WS_XN); bf16* MIX = (bf16*)(ws + WS_MIX); bf16* XN2 = (bf16*)(ws + WS_XN2); \
    float* X1 = (float*)(ws + WS_X1); bf16* Hb = (bf16*)(ws + WS_H); bf16* Yb = (bf16*)(ws + WS_Y); \
    int* ELIST = (int*)(ws + WS_ELIST); float* EWT = (float*)(ws + WS_EWT); gu32* ctl = (gu32*)(ws + WS_CTL); \
    (void)MOD; (void)ROPE; (void)LBT; (void)WinT; (void)WoutT; (void)W13T; (void)W2T; (void)XN; (void)MIX; (void)XN2; (void)X1; (void)Hb; (void)Yb; (void)ELIST; (void)EWT; (void)ctl;
    if (IN(0)) {
        PHASE_PTRS
        const float* cvec = KA(1); const float* c_ctx = KA(3); const float* w_mod = KA(4); const float* b_mod = KA(5); const float* w_in = KA(8); const float* w_out = KA(9);
        const float* hg_lb = KA(11); const float* w1 = KA(17); const float* w3 = KA(18); const float* w2 = KA(19);
        if (bx == G - 1) {
            for (int idx = tid; idx < 1024; idx += NTHR) { const int pos = idx >> 4, i = idx & 15;
                double th = 1.0; for (int k = 0; k < i; ++k) th *= 0.5623413251903491;
                const double t2 = th * th; double c = 1.0, s = th, tc = 1.0, ts = th;
                for (int n = 1; n <= 12; ++n) { tc *= -t2 / (double)((2 * n - 1) * (2 * n)); c += tc; ts *= -t2 / (double)((2 * n) * (2 * n + 1)); s += ts; }
                double cr = 1.0, ci = 0.0; for (int p = 0; p < pos; ++p) { const double nr = cr * c - ci * s; ci = cr * s + ci * c; cr = nr; }
                ROPE[idx * 2] = (float)cr; ROPE[idx * 2 + 1] = (float)ci; }
            for (int idx = tid; idx < 1024; idx += NTHR) { const float h0 = hg_lb[idx], h1 = hg_lb[1024 + idx]; LBT[idx] = 1.f / (1.f + expf(h1 - h0)); }
        }
        if (bx < 96) {
            LAS float* sc = (LAS float*)lds;
            for (int idx = tid; idx < 17 * 1024; idx += NTHR) { const int r = idx >> 10, k = idx & 1023; const float cv = r < 16 ? cvec[r * 1024 + k] : c_ctx[k]; sc[idx] = cv / (1.f + expf(-cv)); }
            __syncthreads();
            const int col = 64 * bx + lane, k0 = 128 * wave;
            float acc[17];
#pragma unroll
            for (int r = 0; r < 17; ++r) acc[r] = 0.f;
            for (int kk = 0; kk < 128; kk += 4) {
                const float w0 = w_mod[(size_t)(k0 + kk) * 6144 + col], w1v = w_mod[(size_t)(k0 + kk + 1) * 6144 + col], w2v = w_mod[(size_t)(k0 + kk + 2) * 6144 + col], w3v = w_mod[(size_t)(k0 + kk + 3) * 6144 + col];
#pragma unroll
                for (int r = 0; r < 17; ++r) { const f32x4 a = *(const LAS f32x4*)(sc + r * 1024 + k0 + kk); acc[r] += a[0] * w0 + a[1] * w1v + a[2] * w2v + a[3] * w3v; }
            }
            LAS float* red = (LAS float*)(lds + 17 * 1024 * 4);
#pragma unroll
            for (int r = 0; r < 17; ++r) red[(wave * 17 + r) * 64 + lane] = acc[r];
            __syncthreads();
            for (int idx = tid; idx < 17 * 64; idx += NTHR) { const int r = idx >> 6, l = idx & 63; float s = 0.f;
#pragma unroll
                for (int w = 0; w < 8; ++w) s += red[(w * 17 + r) * 64 + l];
                MOD[r * 6144 + 64 * bx + l] = s + b_mod[64 * bx + l]; }
            __syncthreads();
        }
        {
            LAS float* scr = (LAS float*)(lds + wave * 16384);
            constexpr int I_IN = 16 * 128, I_OUT = 16 * 32, I_13 = 16 * 2 * 256, I_2 = 16 * 256, NIT = I_IN + I_OUT + I_13 + I_2;
            for (int it = gw; it < NIT; it += NGW) {
                int r = it;
                if (r < I_IN) { const int kb = r / 128, nb = r % 128; transpose_item(w_in, INCOLS, 64 * kb, 32 * nb, WinT, 1024, 32 * nb, scr, lane); continue; } r -= I_IN;
                if (r < I_OUT) { const int kb = r / 32, nb = r % 32; transpose_item(w_out, 1024, 64 * kb, 32 * nb, WoutT, 1024, 32 * nb, scr, lane); continue; } r -= I_OUT;
                if (r < I_13) { const int e = r / 512, rem = r % 512, s = rem / 256, r2 = rem % 256, kb = r2 / 16, nb = r2 % 16, n0 = 32 * nb;
                    transpose_item((s ? w3 : w1) + (size_t)e * 1024 * 512, 512, 64 * kb, n0, W13T, 1024, e * 1024 + 256 * (n0 / 128) + 128 * s + (n0 % 128), scr, lane); continue; } r -= I_13;
                { const int e = r / 256, r2 = r % 256, kb = r2 / 32, nb = r2 % 32; transpose_item(w2 + (size_t)e * 512 * 1024, 1024, 64 * kb, 32 * nb, W2T, 512, e * 1024 + 32 * nb, scr, lane); }
            }
        }
    }
    SEAM(0);

#pragma unroll 1
    for (int rep = 0; rep < (IN(1) ? REP1 : 0); ++rep) {
        PHASE_PTRS
        const float* x = KA(0); const float* ctx = KA(2); const float* norm_mix = KA(6);
        for (int row = gw; row < MROWS; row += NGW) {
            const float* xr = row < T ? x + (size_t)row * D : ctx + (size_t)(row - T) * D; const int mb = row < T ? (row >> 11) : 16;
            f32x4 v[4]; float s = 0.f;
#pragma unroll
            for (int j = 0; j < 4; ++j) { v[j] = *(const f32x4*)(xr + 4 * lane + 256 * j); s += (v[j][0] * v[j][0] + v[j][1] * v[j][1]) + (v[j][2] * v[j][2] + v[j][3] * v[j][3]); }
            const float rstd = 1.f / sqrtf(wave_sum(s) * (1.f / D) + EPS);
#pragma unroll
            for (int j = 0; j < 4; ++j) { const int col = 4 * lane + 256 * j; const f32x4 g = *(const f32x4*)(norm_mix + col), sh = *(const f32x4*)(MOD + mb * 6144 + col), sc = *(const f32x4*)(MOD + mb * 6144 + 1024 + col);
                const f32x4 y = v[j] * rstd * g * (1.f + sc) + sh;
                *(v2u*)(XN + (size_t)row * D + col) = (v2u){pk2(y[0], y[1]), pk2(y[2], y[3])}; }
        }
    }
    SEAM(1);

#pragma unroll 1
    for (int rep = 0; rep < (IN(2) ? REP2 : 0); ++rep) {
        PHASE_PTRS
        ProjOrder S; S.init(G, bx);
        EpiProj E{ws};
        pg8::gemm_phase<EpiProj, ProjOrder>(lds + RING_OFF, XN, WinT, D, S, E);
    }
    SEAM(2);

#pragma unroll 1
    for (int rep = 0; rep < (IN(3) ? REP3 : 0); ++rep) {
        PHASE_PTRS
        const bf16* Qb = (const bf16*)(ws + WS_Q); const bf16* Kb = (const bf16*)(ws + WS_K); const bf16* Vb = (const bf16*)(ws + WS_V);
        const float* na_rpb = KA(10);
#ifndef NO_SCAN
        if (bx < 128) {
            const int dir = bx & 1;
#ifdef DBG_NAIVE
            if (DBG_NAIVE & (1 << dir)) scan_naive(lds, bx >> 3, (bx >> 1) & 3, dir, (const unsigned short*)(ws + (dir ? WS_LB : WS_LF)), (const bf16*)(ws + WS_HQ), (const bf16*)(ws + WS_HI), (bf16*)(ws + (dir ? WS_OB : WS_OF)), tid);
            else
#endif
            scan_unit(lds, bx >> 3, (bx >> 1) & 3, dir, (const unsigned short*)(ws + (dir ? WS_LB : WS_LF)), (const bf16*)(ws + WS_HQ), (const bf16*)(ws + WS_HI), (bf16*)(ws + (dir ? WS_OB : WS_OF)), tid);
        } else
#endif
        {
            LAS float* rpbL = (LAS float*)lds;
            for (int idx = tid; idx < 8 * 15 * 64; idx += NTHR) { const int co = (idx & 63) - 16, hr = idx >> 6; rpbL[idx] = (co >= 0 && co < 31) ? na_rpb[hr * 31 + co] * 1.44269504f : 0.f; }
            __syncthreads();
            const int nwv = (G - 128) * NWAVES; const int wv = (bx - 128) * NWAVES + wave;
            const __amdgpu_buffer_rsrc_t srdK = __builtin_amdgcn_make_buffer_rsrc((void*)Kb, (short)0, MROWS * SEGW * 2, 0x00020000), srdV = __builtin_amdgcn_make_buffer_rsrc((void*)Vb, (short)0, MROWS * SEGW * 2, 0x00020000);
#pragma unroll 1
            for (int unit = wv; unit < NB * NAH * NROWS * 4; unit += nwv)
                na_unit(unit >> 10, (unit >> 7) & 7, (unit >> 2) & 31, unit & 3, Qb, (const bf16*)(ws + WS_QR), srdK, srdV, MIX, rpbL, lane);
        }
    }
    SEAM(3);

#pragma unroll 1
    for (int rep = 0; rep < (IN(4) ? REP4 : 0); ++rep) {
        PHASE_PTRS
        const float* hg_norm = KA(12);
        const bf16* OF = (const bf16*)(ws + WS_OF); const bf16* OB = (const bf16*)(ws + WS_OB); const bf16* Gb = (const bf16*)(ws + WS_G);
        for (int tok = gw; tok < T; tok += NGW) {
            const size_t off = (size_t)tok * SEGW + lane * 8;
            const v4u a = *(const v4u*)(OF + off), bb = *(const v4u*)(OB + off), g = *(const v4u*)(Gb + off);
            float o[8]; float ss = 0.f;
#pragma unroll
            for (int e = 0; e < 4; ++e) { o[2 * e] = bflo(a[e]) + bflo(bb[e]); o[2 * e + 1] = bfhi(a[e]) + bfhi(bb[e]);
#ifdef DBG_SANITIZE
                if (!(fabsf(o[2 * e]) < 1e30f)) o[2 * e] = 0.f; if (!(fabsf(o[2 * e + 1]) < 1e30f)) o[2 * e + 1] = 0.f;
#endif
                ss += o[2 * e] * o[2 * e] + o[2 * e + 1] * o[2 * e + 1]; }
            ss += __shfl_xor(ss, 1); ss += __shfl_xor(ss, 2); ss += __shfl_xor(ss, 4); ss += __shfl_xor(ss, 8);
            const float rstd = 1.f / sqrtf(ss * (1.f / HGD) + EPS);
            const int dv0 = (lane & 15) * 8;
            const f32x4 g0 = *(const f32x4*)(hg_norm + dv0), g1 = *(const f32x4*)(hg_norm + dv0 + 4);
            const float gg[8] = {g0[0], g0[1], g0[2], g0[3], g1[0], g1[1], g1[2], g1[3]};
            float y[8];
#pragma unroll
            for (int e = 0; e < 4; ++e) { y[2 * e] = o[2 * e] * rstd * gg[2 * e] * bflo(g[e]); y[2 * e + 1] = o[2 * e + 1] * rstd * gg[2 * e + 1] * bfhi(g[e]); }
            *(v4u*)(MIX + (size_t)tok * D + 512 + lane * 8) = (v4u){pk2(y[0], y[1]), pk2(y[2], y[3]), pk2(y[4], y[5]), pk2(y[6], y[7])};
        }
    }
    SEAM(4);

#pragma unroll 1
    for (int rep = 0; rep < (IN(5) ? REP5 : 0); ++rep) {
        PHASE_PTRS
        pg8::DenseOrder S; S.init(T, D, G, bx);
        EpiRes E{KA(0), X1, MOD};
        pg8::gemm_phase<EpiRes, pg8::DenseOrder>(lds + RING_OFF, MIX, WoutT, D, S, E);
    }
    SEAM(5);

    if (IN(6)) {
        PHASE_PTRS
        const float* norm_ffn = KA(7); const float* w_grp = KA(13); const float* b_grp = KA(14); const float* w_exp = KA(15); const float* b_exp = KA(16);
        LAS f32x4* wl = (LAS f32x4*)lds;
        for (int idx = tid; idx < 5 * 1024; idx += NTHR) { const int quad = idx >> 10, col = idx & 1023; const int l = (col & 255) >> 2, q = col & 3, j = col >> 8;
            const f32x4 w = quad == 0 ? *(const f32x4*)(w_grp + col * 4) : *(const f32x4*)(w_exp + col * 16 + (quad - 1) * 4);
            wl[((quad * 4 + q) * 4 + j) * 64 + l] = w; }
        LAS int* lcnt = (LAS int*)(lds + 81920);
        LAS int* tmpe = (LAS int*)(lds + 81920 + 256);
        if (tid < 32) lcnt[tid] = 0;
        __syncthreads();
        const int rowbase = bx * 128 + wave * 16;
#pragma unroll 1
        for (int i = 0; i < 16; ++i) {
            asm volatile("" ::: "memory");
            const int row = rowbase + i; const int mb = row >> 11;
            const float* xr = X1 + (size_t)row * D;
            f32x4 v[4]; float s = 0.f;
#pragma unroll
            for (int j = 0; j < 4; ++j) { v[j] = *(const f32x4*)(xr + 4 * lane + 256 * j); s += (v[j][0] * v[j][0] + v[j][1] * v[j][1]) + (v[j][2] * v[j][2] + v[j][3] * v[j][3]); }
            const float rstd = 1.f / sqrtf(wave_sum(s) * (1.f / D) + EPS);
            float lg[20];
#pragma unroll
            for (int k = 0; k < 20; ++k) lg[k] = 0.f;
#pragma unroll
            for (int j = 0; j < 4; ++j) { const int col = 4 * lane + 256 * j; const f32x4 g = *(const f32x4*)(norm_ffn + col), sh = *(const f32x4*)(MOD + mb * 6144 + 3072 + col), sc = *(const f32x4*)(MOD + mb * 6144 + 4096 + col);
                const f32x4 y = v[j] * rstd * g * (1.f + sc) + sh;
                asm volatile("" ::: "memory");
                *(v2u*)(XN2 + (size_t)row * D + col) = (v2u){pk2(y[0], y[1]), pk2(y[2], y[3])};
#pragma unroll
                for (int q = 0; q < 4; ++q)
#pragma unroll
                    for (int quad = 0; quad < 5; ++quad) { const f32x4 w = wl[((quad * 4 + q) * 4 + j) * 64 + lane];
                        lg[quad * 4 + 0] += y[q] * w[0]; lg[quad * 4 + 1] += y[q] * w[1]; lg[quad * 4 + 2] += y[q] * w[2]; lg[quad * 4 + 3] += y[q] * w[3]; } }
#pragma unroll
            for (int k = 0; k < 20; ++k) lg[k] = wave_sum(lg[k]);
            if (lane == 0) {
                float gl[4];
#pragma unroll
                for (int k = 0; k < 4; ++k) gl[k] = lg[k] + b_grp[k];
                int gs = 0; float gm = gl[0];
#pragma unroll
                for (int k = 1; k < 4; ++k) if (gl[k] > gm) { gm = gl[k]; gs = k; }
                float den = 0.f;
#pragma unroll
                for (int k = 0; k < 4; ++k) den += __expf(gl[k] - gm);
                const float g_w = 1.f / den;
                float ev[4];
#pragma unroll
                for (int k = 0; k < 4; ++k) { float a = lg[4 + k] + b_exp[k];
#pragma unroll
                    for (int g2 = 1; g2 < 4; ++g2) a = (gs == g2) ? (lg[4 + g2 * 4 + k] + b_exp[g2 * 4 + k]) : a;
                    ev[k] = a; }
                int i0 = 0; float v0 = ev[0];
#pragma unroll
                for (int k = 1; k < 4; ++k) if (ev[k] > v0) { v0 = ev[k]; i0 = k; }
                int i1 = -1; float v1 = -INFINITY;
#pragma unroll
                for (int k = 0; k < 4; ++k) if (k != i0 && ev[k] > v1) { v1 = ev[k]; i1 = k; }
                if (i1 < 0) { i1 = (i0 + 1) & 3; v1 = v0; }
                const float e1 = __expf(v1 - v0); const float w0 = g_w / (1.f + e1), w1w = g_w * e1 / (1.f + e1);
                const int ea = gs * 4 + i0, eb = gs * 4 + i1;
                const int ra = __hip_atomic_fetch_add(&lcnt[ea], 1, __ATOMIC_RELAXED, __HIP_MEMORY_SCOPE_WORKGROUP), rb = __hip_atomic_fetch_add(&lcnt[eb], 1, __ATOMIC_RELAXED, __HIP_MEMORY_SCOPE_WORKGROUP);
                const int lr = (wave * 16 + i) * 2;
                tmpe[lr] = ea; tmpe[256 + lr] = ra; tmpe[512 + lr] = __builtin_bit_cast(int, w0);
                tmpe[lr + 1] = eb; tmpe[256 + lr + 1] = rb; tmpe[512 + lr + 1] = __builtin_bit_cast(int, w1w);
            }
        }
        __syncthreads();
        if (tid < 16) lcnt[16 + tid] = (int)__hip_atomic_fetch_add(ctl + CW_CNT + tid, (unsigned)lcnt[tid], RLX_AGENT);
        __syncthreads();
        if (tid < 256) { const int e = tmpe[tid], pos = lcnt[16 + e] + tmpe[256 + tid]; const int tok = bx * 128 + (tid >> 1);
            ELIST[e * ECAP + pos] = tok * 2 + (tid & 1); EWT[e * ECAP + pos] = __builtin_bit_cast(float, tmpe[512 + tid]); }
        __syncthreads();
    }
    SEAM(6);

    if (IN(7) || IN(8)) {
        PHASE_PTRS
        LAS int* tp = (LAS int*)(lds + MOE_OFF);
        if (tid == 0) { int acc = 0;
            for (int e = 0; e < 16; ++e) { const int c = (int)__hip_atomic_load(ctl + CW_CNT + e, RLX_AGENT); tp[e] = acc; tp[17 + e] = c; acc += (c + 255) >> 8; }
            tp[16] = acc; }
        __syncthreads();
    }
#pragma unroll 1
    for (int rep = 0; rep < (IN(7) ? REP7 : 0); ++rep) {
        PHASE_PTRS
        const LAS int* tp = (const LAS int*)(lds + MOE_OFF);
        MoeOrder<true> S{tp, ELIST, G, bx, tp[16] * 4};
        EpiSwiGLU E{Hb};
        pg8::gemm_phase<EpiSwiGLU, MoeOrder<true>>(lds + RING_OFF, XN2, W13T, D, S, E);
    }
    SEAM(7);
#pragma unroll 1
    for (int rep = 0; rep < (IN(8) ? REP8 : 0); ++rep) {
        PHASE_PTRS
        const LAS int* tp = (const LAS int*)(lds + MOE_OFF);
        MoeOrder<false> S{tp, ELIST, G, bx, tp[16] * 4};
        EpiMoeOut E{Yb, ELIST, EWT};
        pg8::gemm_phase<EpiMoeOut, MoeOrder<false>>(lds + RING_OFF, Hb, W2T, DE, S, E);
    }
    SEAM(8);

#pragma unroll 1
    for (int rep = 0; rep < (IN(9) ? REP9 : 0); ++rep) {
        PHASE_PTRS
        const float* norm_final = KA(20); float* outp = ({ const __attribute__((address_space(4))) Args* _p = (const __attribute__((address_space(4))) Args*)__builtin_amdgcn_kernarg_segment_ptr(); asm volatile("" : "+s"(_p)); _p->out; });
        for (int row = gw; row < T; row += NGW) {
            const int mb = row >> 11; f32x4 v[4]; float s = 0.f;
#pragma unroll
            for (int j = 0; j < 4; ++j) { const int col = 4 * lane + 256 * j; const f32x4 xv = *(const f32x4*)(X1 + (size_t)row * D + col), ga = *(const f32x4*)(MOD + mb * 6144 + 5120 + col);
                const v2u y0 = *(const v2u*)(Yb + (size_t)(2 * row) * D + col), y1 = *(const v2u*)(Yb + (size_t)(2 * row + 1) * D + col);
                const f32x4 ys = (f32x4){bflo(y0.x) + bflo(y1.x), bfhi(y0.x) + bfhi(y1.x), bflo(y0.y) + bflo(y1.y), bfhi(y0.y) + bfhi(y1.y)};
                v[j] = xv + ga * ys; s += (v[j][0] * v[j][0] + v[j][1] * v[j][1]) + (v[j][2] * v[j][2] + v[j][3] * v[j][3]); }
            const float rstd = 1.f / sqrtf(wave_sum(s) * (1.f / D) + EPS);
#pragma unroll
            for (int j = 0; j < 4; ++j) { const int col = 4 * lane + 256 * j; const f32x4 g = *(const f32x4*)(norm_final + col);
                *(f32x4*)(outp + (size_t)row * D + col) = v[j] * rstd * g; }
        }
    }
#undef IN
#undef SEAM
}

#ifndef MK_N_LAUNCHES
#define MK_N_LAUNCHES 1
#endif
constexpr int NPHASE = 10;
extern "C" void kernel_launch(void* const* d_in, const int* in_sizes, int n_in, void* d_out, int out_size, void* d_ws, size_t ws_size, hipStream_t stream) {
    static int grid = 0;
    if (grid == 0) {
        if (n_in != 21 || in_sizes[0] != T * D || out_size != T * D || ws_size < WS_END) { fprintf(stderr, "kernel_launch: unexpected shapes (n_in %d, in0 %d, out %d, ws %zu)\n", n_in, n_in > 0 ? in_sizes[0] : -1, out_size, ws_size); grid = -1; return; }
        int dev = 0, cus = 0, per_cu = 0;
        if (hipGetDevice(&dev) != hipSuccess || hipDeviceGetAttribute(&cus, hipDeviceAttributeMultiprocessorCount, dev) != hipSuccess) { grid = -1; return; }
        if (hipFuncSetAttribute((const void*)fwd_mega, hipFuncAttributeMaxDynamicSharedMemorySize, LDS_BYTES) != hipSuccess) { fprintf(stderr, "kernel_launch: hipFuncSetAttribute failed\n"); grid = -1; return; }
        if (hipOccupancyMaxActiveBlocksPerMultiprocessor(&per_cu, (const void*)fwd_mega, NTHR, LDS_BYTES) != hipSuccess || per_cu < 1) fprintf(stderr, "kernel_launch: occupancy query reports %d\n", per_cu);
        (void)hipGetLastError();
        grid = cus;
        if (grid != 256) fprintf(stderr, "kernel_launch: %d CUs (built for 256)\n", grid);
    }
    if (grid < 0) return;
    (void)hipMemsetAsync((char*)d_ws + WS_CTL, 0, CTL_ZERO_BYTES, stream);
    Args a{};
    for (int i = 0; i < 21; ++i) a.in[i] = (const float*)d_in[i];
    a.out = (float*)d_out; a.ws = (unsigned char*)d_ws;
    if (MK_N_LAUNCHES == 1) {
        a.ph_lo = 0; a.ph_hi = NPHASE; a.li = 0;
        hipLaunchKernelGGL(fwd_mega, dim3(grid), dim3(NTHR), LDS_BYTES, stream, a);
    } else {
        for (int li = 0; li < NPHASE; ++li) { a.ph_lo = li; a.ph_hi = li + 1; a.li = 0; hipLaunchKernelGGL(fwd_mega, dim3(grid), dim3(NTHR), LDS_BYTES, stream, a); }
    }
}
```

```cpp
#include <hip/hip_runtime.h>
#include <cstdio>
#include <cstdint>

#define GAS __attribute__((address_space(1)))
#define LAS __attribute__((address_space(3)))
typedef unsigned short bf16;
typedef unsigned short bf16_t;
typedef unsigned v4u __attribute__((ext_vector_type(4)));
typedef unsigned v2u __attribute__((ext_vector_type(2)));
typedef float f32x4 __attribute__((ext_vector_type(4)));
typedef float f32x2 __attribute__((ext_vector_type(2)));
typedef short bf16x8 __attribute__((ext_vector_type(8)));
typedef unsigned u32x4 __attribute__((ext_vector_type(4)));
typedef GAS unsigned gu32;
#define RLX_AGENT __ATOMIC_RELAXED, __HIP_MEMORY_SCOPE_AGENT
#define LDS_WAIT() asm volatile("s_waitcnt lgkmcnt(0)" ::: "memory")
#define VM_WAIT() asm volatile("s_waitcnt vmcnt(0)" ::: "memory")

constexpr int NB = 16, SEQ = 2048, D = 1024, T = NB * SEQ, LC = 256, TC = NB * LC, MROWS = T + TC;
constexpr int GW = 64, NROWS = SEQ / GW;
constexpr int INCOLS = 4096, SEGW = 512;
constexpr int NAH = 8, NAD = 64, HGH = 4, HGD = 128;
constexpr int NE = 16, DE = 512, ECAP = T;
constexpr float EPS = 1e-6f;
constexpr int NWAVES = 8, NTHR = 512;

constexpr size_t MiB = 1u << 20;
constexpr size_t WS_CTL = 0, CTL_ZERO_BYTES = 1 * MiB;
constexpr size_t WS_MOD = 1 * MiB;
constexpr size_t WS_ROPE = WS_MOD + 512 * 1024, WS_LBT = WS_MOD + 520 * 1024;
constexpr size_t WS_ELIST = 2 * MiB, WS_EWT = 4 * MiB;
constexpr size_t WS_WINT = 8 * MiB, WS_WOUTT = 16 * MiB, WS_W13T = 18 * MiB, WS_W2T = 50 * MiB;
constexpr size_t WS_XN = 66 * MiB;
constexpr size_t WS_Q = 138 * MiB, WS_K = 170 * MiB, WS_V = 206 * MiB, WS_HQ = 242 * MiB, WS_HI = 274 * MiB, WS_LF = 310 * MiB, WS_LB = 346 * MiB, WS_G = 382 * MiB;
constexpr size_t WS_OF = 414 * MiB, WS_OB = 446 * MiB, WS_QR = 478 * MiB, WS_END = 510 * MiB;
constexpr size_t WS_MIX = WS_XN, WS_XN2 = WS_XN, WS_X1 = 138 * MiB, WS_H = 274 * MiB, WS_Y = 346 * MiB;
constexpr int CW_CNT = 64;
constexpr int CW_BAR = 4096;

constexpr int RING_OFF = 0, RING_BYTES = 131072;
constexpr int LDSCTL_OFF = RING_BYTES, MISC_OFF = LDSCTL_OFF + 320, MOE_OFF = LDSCTL_OFF + 1024;
constexpr int LDS_BYTES = 147456;

__device__ __forceinline__ unsigned f2bf(float f) { unsigned u = __builtin_bit_cast(unsigned, f); return (u + 0x7fffu + ((u >> 16) & 1u)) >> 16; }
__device__ __forceinline__ unsigned pk2(float lo, float hi) { return f2bf(lo) | (f2bf(hi) << 16); }
__device__ __forceinline__ float bf2f(unsigned short b) { return __builtin_bit_cast(float, (unsigned)b << 16); }
__device__ __forceinline__ float bflo(unsigned u) { return __builtin_bit_cast(float, u << 16); }
__device__ __forceinline__ float bfhi(unsigned u) { return __builtin_bit_cast(float, u & 0xffff0000u); }
__device__ __forceinline__ unsigned pkh2(float lo, float hi) { _Float16 a = (_Float16)lo, b = (_Float16)hi; return (unsigned)__builtin_bit_cast(unsigned short, a) | ((unsigned)__builtin_bit_cast(unsigned short, b) << 16); }
__device__ __forceinline__ float h2f(unsigned short h) { return (float)__builtin_bit_cast(_Float16, h); }
__device__ __forceinline__ float silu_f(float v) { return v / (1.f + __expf(-v)); }
__device__ __forceinline__ float wave_sum(float v) {
#pragma unroll
    for (int o = 1; o < 64; o <<= 1) v += __shfl_xor(v, o);
    return v;
}
__device__ __forceinline__ float wave_max(float v) {
#pragma unroll
    for (int o = 1; o < 64; o <<= 1) v = fmaxf(v, __shfl_xor(v, o));
    return v;
}

namespace pg8 {
constexpr int BM = 256, BK = 64, HALF = 128, HTB = HALF * BK * 2, STAGE_BYTES = 8 * HTB, NXCD = 8, WGM = 8;
__host__ __device__ __forceinline__ int lds_byte(int r, int c) { const int st = (r >> 4) * 2 + (c >> 5), rr = r & 15, cc = c & 31, ob = rr * 64 + cc * 2; return st * 1024 + (ob ^ (((ob >> 9) & 1) << 5)); }
__host__ __device__ __forceinline__ void stage_rc(int b, int& R, int& C) { const int st = b / 1024, sb = b % 1024, swz = sb ^ (((sb >> 9) & 1) << 5); R = (st >> 1) * 16 + swz / 64; C = (st & 1) * 32 + (swz % 64) / 2; }
__host__ __device__ __forceinline__ int perm32(int rho) { const int n = rho >> 4, i = rho & 15; return 8 * (i >> 2) + 4 * n + (i & 3); }

struct Unit { int pm, pn, e, tm, cnt; };

typedef float f32x2_t __attribute__((ext_vector_type(2))); typedef __bf16 bf16x2_t __attribute__((ext_vector_type(2)));
__device__ __forceinline__ unsigned cvt_pk_bf16(float lo, float hi) { f32x2_t v = {lo, hi}; bf16x2_t b = __builtin_convertvector(v, bf16x2_t); return __builtin_bit_cast(unsigned, b); }

struct DenseOrder {
    static constexpr bool GATHER = false;
    int nM, nN, nwg, G, c;
    __device__ void init(int M, int N, int G_, int c_) { nM = M / BM; nN = N / BM; nwg = nM * nN; G = G_; c = c_; }
    __device__ bool next(int i, Unit& u) const {
        const long L = (long)i * G + c; if (L >= nwg) return false;
        int wgid = (int)L; { const int q = nwg / NXCD, r = nwg % NXCD, xcd = wgid % NXCD, off = wgid / NXCD; wgid = (xcd < r ? xcd * (q + 1) : r * (q + 1) + (xcd - r) * q) + off; }
        const int nig = WGM * nN, gid = wgid / nig, fm = gid * WGM, gsz = (nM - fm) < WGM ? (nM - fm) : WGM;
        u.pm = fm + ((wgid % nig) % gsz); u.pn = (wgid % nig) / gsz; u.e = 0; u.tm = 0; u.cnt = 0; return true;
    }
    __device__ __forceinline__ int a_row0(const Unit& u) const { return u.pm * BM; }
    __device__ __forceinline__ int a_row(const Unit& u, int r) const { return u.pm * BM + r; }
    __device__ __forceinline__ int b_row0(const Unit& u) const { return u.pn * BM; }
};

template <class Epi, class Sched>
__device__ __forceinline__ void gemm_phase(LAS unsigned char* lds, const bf16_t* Aptr, const bf16_t* Btptr, const int K, const Sched& S, const Epi& E) {
    const int tid = threadIdx.x, wid = __builtin_amdgcn_readfirstlane(tid >> 6), lane = tid & 63, wr = wid >> 2, wc = wid & 3, fr = lane & 15, fq = lane >> 4;
    const int nt = K / BK;
    int sR[2], sC[2];
    unsigned voffA[2], voffB[2];
#pragma unroll
    for (int i = 0; i < 2; ++i) { int R, C; stage_rc(tid * 16 + i * 8192, R, C); const int Rb = Epi::PERM ? ((R & ~31) + perm32(R & 31)) : R;
        sR[i] = R; sC[i] = C; voffA[i] = (unsigned)(R * K + C) * 2u; voffB[i] = (unsigned)(Rb * K + C) * 2u; }
    const size_t kstep = (size_t)(BK * 2);
    const size_t hstep = (size_t)HALF * K * 2;
    const size_t rowb = (size_t)K * 2;
    const unsigned ldsw = (unsigned)wid * 1024u;
    const int aoff = lds_byte(wr * 64 + fr, fq * 8), boff = lds_byte(wc * 32 + fr, fq * 8);
    const char* Ab = (const char*)Aptr;
#define PG8_SA(b, h) (((b) * 2 + (h)) * HTB)
#define PG8_SB(b, h) ((4 + (b) * 2 + (h)) * HTB)
#define PG8_STAGE(bufoff, gbase, voff) do { _Pragma("unroll") for (int _i = 0; _i < 2; ++_i) \
        __builtin_amdgcn_global_load_lds((const unsigned*)((const char*)(gbase) + (voff)[_i]), (LAS unsigned*)(lds + (bufoff) + ldsw + _i * 8192), 16, 0, 0); } while (0)
#define PG8_LDA(dst, b, h) do { _Pragma("unroll") for (int m = 0; m < 4; ++m) _Pragma("unroll") for (int k = 0; k < 2; ++k) dst[m][k] = *(const LAS bf16x8*)(lds + PG8_SA(b, h) + aoff + m * 2048 + k * 1024); } while (0)
#define PG8_LDB(dst, b, h) do { _Pragma("unroll") for (int n = 0; n < 2; ++n) _Pragma("unroll") for (int k = 0; k < 2; ++k) dst[n][k] = *(const LAS bf16x8*)(lds + PG8_SB(b, h) + boff + n * 2048 + k * 1024); } while (0)
#define PG8_MMA(ai, bj, At, Bt) do { __builtin_amdgcn_s_setprio(1); _Pragma("unroll") for (int m = 0; m < 4; ++m) _Pragma("unroll") for (int n = 0; n < 2; ++n) _Pragma("unroll") for (int k = 0; k < 2; ++k) \
        acc[ai][bj][m][n] = __builtin_amdgcn_mfma_f32_16x16x32_bf16(Bt[n][k], At[m][k], acc[ai][bj][m][n], 0, 0, 0); __builtin_amdgcn_s_setprio(0); } while (0)
#define PG8_WAIT_V(n) asm volatile("s_waitcnt vmcnt(" #n ")" ::: "memory")
#define PG8_WAIT_L(n) asm volatile("s_waitcnt lgkmcnt(" #n ")" ::: "memory")
#define PG8_BAR __builtin_amdgcn_s_barrier()
#define PG8_SCHED __builtin_amdgcn_sched_barrier(0)
    Unit cur, nxt; int ui = 0;
    if (!S.next(0, cur)) return;
    f32x4 acc[2][2][4][2];
#pragma unroll
    for (int a = 0; a < 2; ++a)
#pragma unroll
        for (int b = 0; b < 2; ++b)
#pragma unroll
            for (int m = 0; m < 4; ++m)
#pragma unroll
                for (int n = 0; n < 2; ++n) acc[a][b][m][n] = (f32x4){0.f, 0.f, 0.f, 0.f};
    bf16x8 At[4][2], B0[2][2], B1[2][2];
    const char* cA = Ab; unsigned cG[2][2];
    if constexpr (Sched::GATHER) {
#pragma unroll
        for (int h = 0; h < 2; ++h)
#pragma unroll
            for (int i = 0; i < 2; ++i) cG[h][i] = (unsigned)((size_t)S.a_row(cur, h * HALF + sR[i]) * rowb) + (unsigned)sC[i] * 2u;
    } else { cA = Ab + (ptrdiff_t)S.a_row0(cur) * (ptrdiff_t)rowb; cG[0][0] = cG[0][1] = cG[1][0] = cG[1][1] = 0u; }
    const char* cB = (const char*)Btptr + (ptrdiff_t)S.b_row0(cur) * (ptrdiff_t)rowb;
#define PG8_STAGEA(bufoff, h, dbase, goffs, kb) do { if constexpr (Sched::GATHER) { PG8_STAGE(bufoff, Ab + (kb), (goffs)[h]); } else { PG8_STAGE(bufoff, (dbase) + (h) * hstep + (kb), voffA); } } while (0)
    PG8_STAGE(PG8_SB(0, 0), cB, voffB); PG8_STAGE(PG8_SB(0, 1), cB + hstep, voffB); PG8_STAGEA(PG8_SA(0, 0), 0, cA, cG, 0); PG8_STAGEA(PG8_SA(0, 1), 1, cA, cG, 0);
    if (wr == 1) PG8_BAR;
    PG8_WAIT_V(2); PG8_BAR;
    PG8_STAGE(PG8_SB(1, 0), cB + kstep, voffB); PG8_STAGEA(PG8_SA(1, 0), 0, cA, cG, kstep); PG8_STAGE(PG8_SB(1, 1), cB + hstep + kstep, voffB);
    PG8_WAIT_V(6); PG8_BAR;
    for (;;) {
        const bool has_next = S.next(ui + 1, nxt);
        const char* nA = cA; const char* nB = cB; unsigned nG[2][2];
#pragma unroll
        for (int h = 0; h < 2; ++h)
#pragma unroll
            for (int i = 0; i < 2; ++i) nG[h][i] = cG[h][i];
        if (has_next) {
            nB = (const char*)Btptr + (ptrdiff_t)S.b_row0(nxt) * (ptrdiff_t)rowb;
            if constexpr (Sched::GATHER) {
#pragma unroll
                for (int h = 0; h < 2; ++h)
#pragma unroll
                    for (int i = 0; i < 2; ++i) nG[h][i] = (unsigned)((size_t)S.a_row(nxt, h * HALF + sR[i]) * rowb) + (unsigned)sC[i] * 2u;
            } else nA = Ab + (ptrdiff_t)S.a_row0(nxt) * (ptrdiff_t)rowb;
        }
        for (int t = 0; t < nt; t += 2) {
            const bool last = (t == nt - 2);
            const size_t kb1 = (size_t)(t + 1) * kstep;
            const size_t kb2 = last ? 0 : (size_t)(t + 2) * kstep, kb3 = kb2 + kstep;
            const char* a2 = last ? nA : cA; const char* b2 = last ? nB : cB + (size_t)(t + 2) * kstep; const char* b3 = b2 + kstep;
            unsigned g2[2][2];
#pragma unroll
            for (int h = 0; h < 2; ++h)
#pragma unroll
                for (int i = 0; i < 2; ++i) g2[h][i] = last ? nG[h][i] : cG[h][i];
            PG8_LDB(B0, 0, 0); PG8_LDB(B1, 0, 1); PG8_SCHED; PG8_LDA(At, 0, 0); PG8_STAGEA(PG8_SA(1, 1), 1, cA, cG, kb1);
            PG8_WAIT_V(8); PG8_WAIT_L(0); PG8_BAR; PG8_MMA(0, 0, At, B0); PG8_MMA(0, 1, At, B1); PG8_BAR; PG8_SCHED;
            PG8_LDA(At, 0, 1); PG8_STAGE(PG8_SB(0, 0), b2, voffB); PG8_STAGE(PG8_SB(0, 1), b2 + hstep, voffB); PG8_STAGEA(PG8_SA(0, 0), 0, a2, g2, kb2);
            PG8_WAIT_V(8); PG8_WAIT_L(0); PG8_BAR; PG8_MMA(1, 0, At, B0); PG8_MMA(1, 1, At, B1); PG8_BAR; PG8_SCHED;
            PG8_LDB(B0, 1, 0); PG8_LDB(B1, 1, 1); PG8_SCHED; PG8_LDA(At, 1, 0); PG8_STAGEA(PG8_SA(0, 1), 1, a2, g2, kb2);
            PG8_WAIT_V(8); PG8_WAIT_L(0); PG8_BAR; PG8_MMA(0, 0, At, B0); PG8_MMA(0, 1, At, B1); PG8_BAR; PG8_SCHED;
            PG8_LDA(At, 1, 1); PG8_STAGE(PG8_SB(1, 0), b3, voffB); PG8_STAGE(PG8_SB(1, 1), b3 + hstep, voffB); PG8_STAGEA(PG8_SA(1, 0), 0, a2, g2, kb3);
            PG8_WAIT_V(8); PG8_WAIT_L(0); PG8_BAR; PG8_MMA(1, 0, At, B0); PG8_MMA(1, 1, At, B1); PG8_BAR; PG8_SCHED;
        }
        if (wr == 0) PG8_BAR;
        E(acc, cur, wr, wc, fr, fq);
        if (!has_next) break;
#pragma unroll
        for (int a = 0; a < 2; ++a)
#pragma unroll
            for (int b = 0; b < 2; ++b)
#pragma unroll
                for (int m = 0; m < 4; ++m)
#pragma unroll
                    for (int n = 0; n < 2; ++n) acc[a][b][m][n] = (f32x4){0.f, 0.f, 0.f, 0.f};
        cur = nxt; cA = nA; cB = nB; ++ui;
#pragma unroll
        for (int h = 0; h < 2; ++h)
#pragma unroll
            for (int i = 0; i < 2; ++i) cG[h][i] = nG[h][i];
        if (wr == 1) PG8_BAR;
    }
    PG8_WAIT_V(0);
    PG8_BAR;
#undef PG8_SA
#undef PG8_SB
#undef PG8_STAGE
#undef PG8_STAGEA
#undef PG8_LDA
#undef PG8_LDB
#undef PG8_MMA
#undef PG8_WAIT_V
#undef PG8_WAIT_L
#undef PG8_BAR
#undef PG8_SCHED
}
}

#define XB_TMO      128
#define XB_XCNT(j)  (256  + 64 * (j))
#define XB_XSUB(j)  (1280 + 64 * (j))
#define XB_XGEN(j)  (2304 + 64 * (j))
#define XB_TOP      3328
#define XB_TOPGEN   3392
#define XCD_BAR_WORDS 3456
#define XB_SPIN_CAP (1u << 18)
__device__ __forceinline__ unsigned xb_ld(unsigned* p)              { return __hip_atomic_load(p, __ATOMIC_RELAXED, __HIP_MEMORY_SCOPE_AGENT); }
__device__ __forceinline__ unsigned xb_add(unsigned* p, unsigned v) { return __hip_atomic_fetch_add(p, v, __ATOMIC_RELAXED, __HIP_MEMORY_SCOPE_AGENT); }
__device__ __forceinline__ unsigned xb_xcc_id() { return (unsigned)__builtin_amdgcn_s_getreg((3 << 11) | 20) & 0xFu; }
#define XB_SPIN(cond, bar) do { unsigned _sp = 0; while (cond) { __builtin_amdgcn_s_sleep(1); \
    if ((++_sp & 255u) == 0u) { if (xb_ld(&(bar)[XB_TMO])) break; if (_sp > XB_SPIN_CAP) { atomicAdd(&(bar)[XB_TMO], 1u); break; } } } } while (0)
struct XcdBarrier { unsigned* bar; unsigned x; volatile LAS unsigned* st; };
__device__ __forceinline__ XcdBarrier xcd_barrier_post(unsigned* bar, volatile LAS unsigned* st) {
    XcdBarrier b; b.bar = bar; b.x = xb_xcc_id(); b.st = st;
    if (threadIdx.x == 0) (void)xb_add(&bar[XB_XCNT(b.x)], 1u);
    return b;
}
__device__ __forceinline__ void xcd_barrier_complete(unsigned* bar, unsigned x, unsigned& nloc, unsigned& nx) {
    const unsigned G = gridDim.x * gridDim.y * gridDim.z;
    unsigned sum, cnt, mine, sp = 0u;
    for (;;) {
        sum = 0u; cnt = 0u; mine = 0u;
#pragma unroll
        for (unsigned j = 0; j < 16; ++j) { const unsigned c = xb_ld(&bar[XB_XCNT(j)]); sum += c; cnt += (c > 0u) ? 1u : 0u; mine = (j == x) ? c : mine; }
        if (sum == G) break;
        __builtin_amdgcn_s_sleep(1);
        if ((++sp & 255u) == 0u) { if (xb_ld(&bar[XB_TMO])) break; if (sp > XB_SPIN_CAP) { atomicAdd(&bar[XB_TMO], 1u); break; } }
    }
    nloc = mine > 0u ? mine : 1u; nx = cnt > 0u ? cnt : 1u;
}
__device__ __forceinline__ void xcd_barrier(const XcdBarrier& b) {
    asm volatile("s_waitcnt vmcnt(0)" ::: "memory");
    __syncthreads();
    if (threadIdx.x == 0) {
        unsigned* bar = b.bar;
        __builtin_amdgcn_s_waitcnt(0);
        unsigned nloc = b.st[0], nx = b.st[1];
        if (nloc == 0u) { xcd_barrier_complete(bar, b.x, nloc, nx); b.st[0] = nloc; b.st[1] = nx; }
        const unsigned old = xb_add(&bar[XB_XSUB(b.x)], 1u);
        const unsigned gen = old / nloc;
        if (old + 1u == (gen + 1u) * nloc) {
            __builtin_amdgcn_fence(__ATOMIC_RELEASE, "agent");
            asm volatile("s_waitcnt vmcnt(0)" ::: "memory");
            const unsigned og = xb_add(&bar[XB_TOP], 1u);
            const unsigned tg = og / nx;
            if (og + 1u == (tg + 1u) * nx) xb_add(&bar[XB_TOPGEN], 1u);
            else XB_SPIN(xb_ld(&bar[XB_TOPGEN]) == tg, bar);
            __builtin_amdgcn_fence(__ATOMIC_ACQUIRE, "agent");
            xb_add(&bar[XB_XGEN(b.x)], 1u);
            asm volatile("s_waitcnt vmcnt(0)" ::: "memory");
        } else {
            XB_SPIN(xb_ld(&bar[XB_XGEN(b.x)]) == gen, bar);
            __builtin_amdgcn_fence(__ATOMIC_ACQUIRE, "agent");
            asm volatile("s_waitcnt vmcnt(0)" ::: "memory");
        }
    }
    __syncthreads();
}

using pg8::Unit;
typedef f32x4 acc_t[2][2][4][2];

struct EpiProj {
    static constexpr bool PERM = false;
    unsigned char* ws;
    __device__ __forceinline__ void operator()(const acc_t& acc, const Unit& u, int wr, int wc, int fr, int fq) const {
        const int seg = u.pn >> 1; const bool latent = u.pm < (T / 256);
        if (!latent && (seg == 0 || seg == 3 || seg == 7)) return;
        if (u.e) {
            const size_t soff[8] = {0, 0, WS_V, WS_HQ, WS_HI, WS_LF, WS_LB, 0};
            size_t so2 = soff[2];
#pragma unroll
            for (int q = 3; q < 7; ++q) so2 = (seg == q) ? soff[q] : so2;
            bf16* dT = (bf16*)(ws + so2);
            const int ldt = (seg == 3) ? T : MROWS;
            const int wrow0 = (u.pn & 1) * 256 + wr * 64 + fr, tcol0 = u.pm * 256 + wc * 32 + 4 * fq;
            const float* lbt = (const float*)(ws + WS_LBT) + (seg == 6 ? 512 : 0);
#pragma unroll
            for (int ai = 0; ai < 2; ++ai)
#pragma unroll
                for (int m = 0; m < 4; ++m) { const int wrow = wrow0 + ai * 128 + m * 16; const float lb = (seg >= 5) ? lbt[wrow] : 0.f;
#pragma unroll
                    for (int bj = 0; bj < 2; ++bj)
#pragma unroll
                        for (int n = 0; n < 2; ++n) { f32x4 x = acc[ai][bj][m][n]; v2u w;
                            if (seg >= 5) { float lf[4];
#pragma unroll
                                for (int j = 0; j < 4; ++j) { const float sg = 1.f / (1.f + __expf(-x[j])); lf[j] = __log2f(lb + (1.f - lb) * sg); }
                                w = (v2u){pkh2(lf[0], lf[1]), pkh2(lf[2], lf[3])}; }
                            else { if (seg == 3) {
#pragma unroll
                                    for (int j = 0; j < 4; ++j) x[j] = silu_f(x[j]); }
                                w = (v2u){pg8::cvt_pk_bf16(x[0], x[1]), pg8::cvt_pk_bf16(x[2], x[3])}; }
                            *(v2u*)(dT + (size_t)wrow * ldt + tcol0 + bj * 128 + n * 16) = w; } }
            return;
        }
        const int lc0 = (u.pn & 1) * 256 + wc * 32 + 4 * fq;
        const size_t segoff[8] = {WS_Q, WS_K, WS_V, WS_HQ, WS_HI, WS_LF, WS_LB, WS_G};
        size_t so = segoff[0];
#pragma unroll
        for (int s = 1; s < 8; ++s) so = (seg == s) ? segoff[s] : so;
        bf16* dst = (bf16*)(ws + so);
        const int row0 = u.pm * 256 + wr * 64 + fr;
        if ((seg == 1 || seg == 0) && latent) {
            const float* rope = (const float*)(ws + WS_ROPE);
#pragma unroll
            for (int ai = 0; ai < 2; ++ai)
#pragma unroll
                for (int m = 0; m < 4; ++m) { const int row = row0 + ai * 128 + m * 16, s = row & (SEQ - 1); const int pos = (wc & 1) ? (s & 63) : (s >> 6);
                    const f32x4 cs0 = *(const f32x4*)(rope + (pos * 16 + 4 * fq) * 2), cs1 = *(const f32x4*)(rope + (pos * 16 + 4 * fq) * 2 + 4);
                    const float cc[4] = {cs0[0], cs0[2], cs1[0], cs1[2]}, sn[4] = {cs0[1], cs0[3], cs1[1], cs1[3]};
#pragma unroll
                    for (int bj = 0; bj < 2; ++bj) { const f32x4 x1 = acc[ai][bj][m][0], x2 = acc[ai][bj][m][1]; float o1[4], o2[4];
#pragma unroll
                        for (int j = 0; j < 4; ++j) { o1[j] = x1[j] * cc[j] - x2[j] * sn[j]; o2[j] = x2[j] * cc[j] + x1[j] * sn[j]; }
                        bf16* p = (seg == 0 ? (bf16*)(ws + WS_QR) : dst) + (size_t)row * SEGW + lc0 + bj * 128;
                        if (seg == 0) { bf16* pr = dst + (size_t)row * SEGW + lc0 + bj * 128;
                            *(v2u*)pr = (v2u){pg8::cvt_pk_bf16(x1[0], x1[1]), pg8::cvt_pk_bf16(x1[2], x1[3])}; *(v2u*)(pr + 16) = (v2u){pg8::cvt_pk_bf16(x2[0], x2[1]), pg8::cvt_pk_bf16(x2[2], x2[3])}; }
                        *(v2u*)p = (v2u){pg8::cvt_pk_bf16(o1[0], o1[1]), pg8::cvt_pk_bf16(o1[2], o1[3])};
                        *(v2u*)(p + 16) = (v2u){pg8::cvt_pk_bf16(o2[0], o2[1]), pg8::cvt_pk_bf16(o2[2], o2[3])}; } }
            return;
        }
        const bool act = (seg == 3 || seg == 7);
#pragma unroll
        for (int ai = 0; ai < 2; ++ai)
#pragma unroll
            for (int m = 0; m < 4; ++m) { const int row = row0 + ai * 128 + m * 16;
#pragma unroll
                for (int bj = 0; bj < 2; ++bj)
#pragma unroll
                    for (int n = 0; n < 2; ++n) { f32x4 x = acc[ai][bj][m][n];
                        if (act) {
#pragma unroll
                            for (int j = 0; j < 4; ++j) x[j] = silu_f(x[j]); }
                        *(v2u*)(dst + (size_t)row * SEGW + lc0 + bj * 128 + n * 16) = (v2u){pg8::cvt_pk_bf16(x[0], x[1]), pg8::cvt_pk_bf16(x[2], x[3])}; } }
    }
};
struct EpiRes {
    static constexpr bool PERM = false;
    const float* x; float* x1; const float* mod;
    __device__ __forceinline__ void operator()(const acc_t& acc, const Unit& u, int wr, int wc, int fr, int fq) const {
        const int b = u.pm >> 3; const int col0 = u.pn * 256 + wc * 32 + 4 * fq; const int row0 = u.pm * 256 + wr * 64 + fr;
#pragma unroll
        for (int bj = 0; bj < 2; ++bj)
#pragma unroll
            for (int n = 0; n < 2; ++n) { const int col = col0 + bj * 128 + n * 16; const f32x4 ga = *(const f32x4*)(mod + b * 6144 + 2048 + col);
#pragma unroll
                for (int ai = 0; ai < 2; ++ai)
#pragma unroll
                    for (int m = 0; m < 4; ++m) { const size_t off = (size_t)(row0 + ai * 128 + m * 16) * D + col;
                        const f32x4 xv = *(const f32x4*)(x + off); *(f32x4*)(x1 + off) = xv + ga * acc[ai][bj][m][n]; } }
    }
};
struct EpiSwiGLU {
    static constexpr bool PERM = true;
    bf16* H;
    __device__ __forceinline__ void operator()(const acc_t& acc, const Unit& u, int wr, int wc, int fr, int fq) const {
        const int hc = u.pn * 128 + wc * 32 + 8 * fq; const int row0 = u.pm * 256 + wr * 64 + fr;
#pragma unroll
        for (int ai = 0; ai < 2; ++ai)
#pragma unroll
            for (int m = 0; m < 4; ++m) { float h[8];
#pragma unroll
                for (int n = 0; n < 2; ++n)
#pragma unroll
                    for (int j = 0; j < 4; ++j) h[n * 4 + j] = silu_f(acc[ai][0][m][n][j]) * acc[ai][1][m][n][j];
                u32x4 w; w.x = pg8::cvt_pk_bf16(h[0], h[1]); w.y = pg8::cvt_pk_bf16(h[2], h[3]); w.z = pg8::cvt_pk_bf16(h[4], h[5]); w.w = pg8::cvt_pk_bf16(h[6], h[7]);
                *(u32x4*)(H + (size_t)(row0 + ai * 128 + m * 16) * DE + hc) = w; }
    }
};
struct EpiMoeOut {
    static constexpr bool PERM = true;
    bf16* Y; const int* elist; const float* ewt;
    __device__ __forceinline__ void operator()(const acc_t& acc, const Unit& u, int wr, int wc, int fr, int fq) const {
        const int col0 = u.pn * 256 + wc * 32 + 8 * fq;
#pragma unroll
        for (int ai = 0; ai < 2; ++ai)
#pragma unroll
            for (int m = 0; m < 4; ++m) { const int rank = u.tm * 256 + ai * 128 + wr * 64 + m * 16 + fr;
                if (rank < u.cnt) { const int tk = elist[u.e * ECAP + rank]; const float w = ewt[u.e * ECAP + rank];
#pragma unroll
                    for (int bj = 0; bj < 2; ++bj) { const f32x4 v0 = acc[ai][bj][m][0] * w, v1 = acc[ai][bj][m][1] * w; u32x4 o;
                        o.x = pg8::cvt_pk_bf16(v0[0], v0[1]); o.y = pg8::cvt_pk_bf16(v0[2], v0[3]); o.z = pg8::cvt_pk_bf16(v1[0], v1[1]); o.w = pg8::cvt_pk_bf16(v1[2], v1[3]);
                        *(u32x4*)(Y + (size_t)tk * D + col0 + bj * 128) = o; } } }
    }
};
template <bool GATHER_> struct MoeOrder {
    static constexpr bool GATHER = GATHER_;
    const LAS int* tp; const int* elist; int G, c, nwg;
    __device__ bool next(int i, Unit& u) const {
        const long L = (long)i * G + c; if (L >= nwg) return false;
        int wgid = (int)L; { const int q = nwg / 8, r = nwg % 8, xcd = wgid % 8, off = wgid / 8; wgid = (xcd < r ? xcd * (q + 1) : r * (q + 1) + (xcd - r) * q) + off; }
        const int gt = wgid >> 2; int e = 0;
#pragma unroll
        for (int k = 1; k < 16; ++k) e = (gt >= tp[k]) ? k : e;
        u.pm = gt; u.pn = wgid & 3; u.e = e; u.tm = gt - tp[e]; u.cnt = tp[17 + e]; return true;
    }
    __device__ __forceinline__ int a_row0(const Unit& u) const { return u.pm * 256; }
    __device__ __forceinline__ int a_row(const Unit& u, int r) const {
        if constexpr (GATHER_) { int rank = u.tm * 256 + r; rank = rank < u.cnt ? rank : u.cnt - 1; return elist[u.e * ECAP + rank] >> 1; }
        else return u.pm * 256 + r;
    }
    __device__ __forceinline__ int b_row0(const Unit& u) const { return u.e * 1024 + u.pn * 256; }
};


constexpr int SWMASK = 0x7C;
constexpr int W_REL_XN = (int)(((long long)WS_WINT - (long long)WS_XN) / 2048);
struct ProjOrder {
    static constexpr bool GATHER = false;
    pg8::DenseOrder d;
    __device__ void init(int G_, int c_) { d.init(MROWS, INCOLS, G_, c_); }
    __device__ bool next(int i, Unit& u) const { if (!d.next(i, u)) return false; u.e = (SWMASK >> (u.pn >> 1)) & 1; return true; }
    __device__ __forceinline__ int a_row0(const Unit& u) const { return u.e ? W_REL_XN + u.pn * 256 : u.pm * 256; }
    __device__ __forceinline__ int a_row(const Unit& u, int r) const { return a_row0(u) + r; }
    __device__ __forceinline__ int b_row0(const Unit& u) const { return u.e ? -W_REL_XN + u.pm * 256 : u.pn * 256; }
};


__device__ __forceinline__ bf16x8 pack8(const f32x4& a, const f32x4& b) {
    u32x4 w; w.x = pg8::cvt_pk_bf16(a[0], a[1]); w.y = pg8::cvt_pk_bf16(a[2], a[3]); w.z = pg8::cvt_pk_bf16(b[0], b[1]); w.w = pg8::cvt_pk_bf16(b[2], b[3]);
    return __builtin_bit_cast(bf16x8, w);
}
typedef unsigned bu4 __attribute__((__vector_size__(16)));
__device__ __forceinline__ bf16x8 bload16(__amdgpu_buffer_rsrc_t r, unsigned voff, unsigned soff) { return __builtin_bit_cast(bf16x8, __builtin_amdgcn_raw_buffer_load_b128(r, (int)voff, (int)soff, 0)); }
#define NA_SB() __builtin_amdgcn_sched_barrier(0)
__device__ __forceinline__ bf16x8 sel8(bool c, const bf16x8 a, const bf16x8 b) { const u32x4 x = __builtin_bit_cast(u32x4, a), y = __builtin_bit_cast(u32x4, b); u32x4 r;
    r.x = c ? x.x : y.x; r.y = c ? x.y : y.y; r.z = c ? x.z : y.z; r.w = c ? x.w : y.w; return __builtin_bit_cast(bf16x8, r); }
__device__ __forceinline__ void na_row(int b, int h, int r, const bf16* Q, const bf16* QR, __amdgpu_buffer_rsrc_t srdK, __amdgpu_buffer_rsrc_t srdV, bf16* MIX, const LAS float* rpbL, int lane) {
    const int qi = lane & 15, g = lane >> 4, rg = qi >> 2;
    constexpr float SC = 0.125f * 1.44269504f; const float NEG = -1e30f;
    int rs = r - 4; rs = rs < 0 ? 0 : (rs > NROWS - 8 ? NROWS - 8 : rs);
    const int tok0 = b * SEQ + r * GW;
    const unsigned klane = (unsigned)((8 * rg + (qi & 3)) * SEGW + 8 * g) * 2u;
    const unsigned vlane = (unsigned)(qi * MROWS + 8 * g) * 2u;
    const bool selK1 = (rg == 0), selK2 = (rg != 3), selV1 = (g == 0), selV2 = (g != 3);
    int lo[4], bb[4];
#pragma unroll
    for (int j = 0; j < 4; ++j) { const int P0 = (j == 0) ? 0 : (j == 1) ? 1 : (j == 2) ? 3 : 4; const int p = P0 + ((g - P0) & 3); const int qc = 16 * j + qi;
        int cs = qc - 8; cs = cs < 0 ? 0 : (cs > GW - 16 ? GW - 16 : cs); lo[j] = cs - 8 * p; bb[j] = 8 * p - qc + 31; }
    f32x4 o[4][4]; float mref[4], lsum[4];
#pragma unroll
    for (int j = 0; j < 4; ++j) { mref[j] = 0.f; lsum[j] = 0.f;
#pragma unroll
        for (int dt = 0; dt < 4; ++dt) o[j][dt] = (f32x4){0.f, 0.f, 0.f, 0.f}; }
    bf16x8 q[4][2], kf[2][2][2], vf[2][4], Bp[4];
#pragma unroll
    for (int j = 0; j < 4; ++j) { const bf16* qp = QR + (size_t)(tok0 + 16 * j + qi) * SEGW + h * NAD + 8 * g; q[j][0] = *(const bf16x8*)qp; q[j][1] = *(const bf16x8*)(qp + 32); }
    const unsigned ks0 = (unsigned)((b * SEQ + rs * GW) * SEGW + h * NAD) * 2u, vs0 = (unsigned)(h * NAD * MROWS + b * SEQ + rs * GW) * 2u;
#define NA_KLD(so) do { _Pragma("unroll") for (int H = 0; H < 2; ++H) _Pragma("unroll") for (int m = 0; m < 2; ++m) _Pragma("unroll") for (int k = 0; k < 2; ++k) \
        kf[H][m][k] = bload16(srdK, klane, (so) + (unsigned)(H * 32 * SEGW * 2 + m * 4 * SEGW * 2 + k * 64)); } while (0)
#define NA_VLD(so) do { _Pragma("unroll") for (int H = 0; H < 2; ++H) _Pragma("unroll") for (int dt = 0; dt < 4; ++dt) \
        vf[H][dt] = bload16(srdV, vlane, (so) + (unsigned)(H * 64) + (unsigned)dt * (16 * MROWS * 2)); } while (0)
    NA_KLD(ks0); NA_VLD(vs0);
    const LAS float* bp0 = rpbL + (h * 15 + rs - r + 7) * 64;
#pragma unroll 1
    for (int i = 0; i < 8; ++i) {
        const LAS float* bpi = bp0 + i * 64;
        NA_SB();
#pragma unroll
        for (int j = 0; j < 4; ++j) {
            f32x4 s0, s1;
            { const bf16x8 a00 = (j == 0) ? kf[0][0][0] : (j == 3) ? kf[1][0][0] : sel8(j == 1 ? selK1 : selK2, kf[1][0][0], kf[0][0][0]);
              const bf16x8 a01 = (j == 0) ? kf[0][0][1] : (j == 3) ? kf[1][0][1] : sel8(j == 1 ? selK1 : selK2, kf[1][0][1], kf[0][0][1]);
              const bf16x8 a10 = (j == 0) ? kf[0][1][0] : (j == 3) ? kf[1][1][0] : sel8(j == 1 ? selK1 : selK2, kf[1][1][0], kf[0][1][0]);
              const bf16x8 a11 = (j == 0) ? kf[0][1][1] : (j == 3) ? kf[1][1][1] : sel8(j == 1 ? selK1 : selK2, kf[1][1][1], kf[0][1][1]);
              s0 = __builtin_amdgcn_mfma_f32_16x16x32_bf16(a00, q[j][0], (f32x4){0.f, 0.f, 0.f, 0.f}, 0, 0, 0); s0 = __builtin_amdgcn_mfma_f32_16x16x32_bf16(a01, q[j][1], s0, 0, 0, 0);
              s1 = __builtin_amdgcn_mfma_f32_16x16x32_bf16(a10, q[j][0], (f32x4){0.f, 0.f, 0.f, 0.f}, 0, 0, 0); s1 = __builtin_amdgcn_mfma_f32_16x16x32_bf16(a11, q[j][1], s1, 0, 0, 0); }
            const LAS float* bpj = bpi + bb[j];
#pragma unroll
            for (int e = 0; e < 4; ++e) { const bool v0 = (e >= lo[j]) && (e < lo[j] + 16), v1 = (4 + e >= lo[j]) && (4 + e < lo[j] + 16);
                s0[e] = v0 ? s0[e] * SC + bpj[e] : NEG; s1[e] = v1 ? s1[e] * SC + bpj[4 + e] : NEG; }
            if (i == 0) { float mx = fmaxf(fmaxf(fmaxf(s0[0], s0[1]), fmaxf(s0[2], s0[3])), fmaxf(fmaxf(s1[0], s1[1]), fmaxf(s1[2], s1[3])));
                mx = fmaxf(mx, __shfl_xor(mx, 16)); mx = fmaxf(mx, __shfl_xor(mx, 32)); mref[j] = mx; }
            float ps = 0.f;
#pragma unroll
            for (int e = 0; e < 4; ++e) { s0[e] = __builtin_amdgcn_exp2f(fminf(s0[e] - mref[j], 100.f)); s1[e] = __builtin_amdgcn_exp2f(fminf(s1[e] - mref[j], 100.f)); ps += s0[e] + s1[e]; }
            lsum[j] += ps; Bp[j] = pack8(s0, s1);
        }
        asm volatile("" : "+v"(Bp[0]), "+v"(Bp[1]), "+v"(Bp[2]), "+v"(Bp[3]));
        NA_SB();
        if (i < 7) NA_KLD(ks0 + (unsigned)(i + 1) * (GW * SEGW * 2));
        NA_SB();
#pragma unroll
        for (int j = 0; j < 4; ++j)
#pragma unroll
            for (int dt = 0; dt < 4; ++dt) { const bf16x8 A = (j == 0) ? vf[0][dt] : (j == 3) ? vf[1][dt] : sel8(j == 1 ? selV1 : selV2, vf[1][dt], vf[0][dt]);
                o[j][dt] = __builtin_amdgcn_mfma_f32_16x16x32_bf16(A, Bp[j], o[j][dt], 0, 0, 0); }
#pragma unroll
        for (int j = 0; j < 4; ++j) asm volatile("" : "+v"(o[j][0]), "+v"(o[j][1]), "+v"(o[j][2]), "+v"(o[j][3]));
        NA_SB();
        if (i < 7) NA_VLD(vs0 + (unsigned)(i + 1) * (GW * 2));
    }
#pragma unroll
    for (int j = 0; j < 4; ++j) { const bf16* qp = Q + (size_t)(tok0 + 16 * j + qi) * SEGW + h * NAD + 8 * g; q[j][0] = *(const bf16x8*)qp; q[j][1] = *(const bf16x8*)(qp + 32); }
    const unsigned kc0 = (unsigned)((T + b * LC) * SEGW + h * NAD) * 2u, vc0 = (unsigned)(h * NAD * MROWS + T + b * LC) * 2u;
#define NA_KLDC(so) do { _Pragma("unroll") for (int m = 0; m < 2; ++m) _Pragma("unroll") for (int k = 0; k < 2; ++k) kf[0][m][k] = bload16(srdK, klane, (so) + (unsigned)(m * 4 * SEGW * 2 + k * 64)); } while (0)
#define NA_VLDC(so) do { _Pragma("unroll") for (int dt = 0; dt < 4; ++dt) vf[0][dt] = bload16(srdV, vlane, (so) + (unsigned)dt * (16 * MROWS * 2)); } while (0)
    NA_KLDC(kc0); NA_VLDC(vc0);
#pragma unroll 1
    for (int i = 0; i < 8; ++i) {
        NA_SB();
#pragma unroll
        for (int j = 0; j < 4; ++j) {
            f32x4 s0 = __builtin_amdgcn_mfma_f32_16x16x32_bf16(kf[0][0][0], q[j][0], (f32x4){0.f, 0.f, 0.f, 0.f}, 0, 0, 0); s0 = __builtin_amdgcn_mfma_f32_16x16x32_bf16(kf[0][0][1], q[j][1], s0, 0, 0, 0);
            f32x4 s1 = __builtin_amdgcn_mfma_f32_16x16x32_bf16(kf[0][1][0], q[j][0], (f32x4){0.f, 0.f, 0.f, 0.f}, 0, 0, 0); s1 = __builtin_amdgcn_mfma_f32_16x16x32_bf16(kf[0][1][1], q[j][1], s1, 0, 0, 0);
            float ps = 0.f;
#pragma unroll
            for (int e = 0; e < 4; ++e) { s0[e] = __builtin_amdgcn_exp2f(fminf(s0[e] * SC - mref[j], 100.f)); s1[e] = __builtin_amdgcn_exp2f(fminf(s1[e] * SC - mref[j], 100.f)); ps += s0[e] + s1[e]; }
            lsum[j] += ps; Bp[j] = pack8(s0, s1);
        }
        asm volatile("" : "+v"(Bp[0]), "+v"(Bp[1]), "+v"(Bp[2]), "+v"(Bp[3]));
        NA_SB();
        if (i < 7) NA_KLDC(kc0 + (unsigned)(i + 1) * (32 * SEGW * 2));
        NA_SB();
#pragma unroll
        for (int j = 0; j < 4; ++j)
#pragma unroll
            for (int dt = 0; dt < 4; ++dt) o[j][dt] = __builtin_amdgcn_mfma_f32_16x16x32_bf16(vf[0][dt], Bp[j], o[j][dt], 0, 0, 0);
#pragma unroll
        for (int j = 0; j < 4; ++j) asm volatile("" : "+v"(o[j][0]), "+v"(o[j][1]), "+v"(o[j][2]), "+v"(o[j][3]));
        NA_SB();
        if (i < 7) NA_VLDC(vc0 + (unsigned)(i + 1) * (32 * 2));
    }
#undef NA_KLD
#undef NA_VLD
#undef NA_KLDC
#undef NA_VLDC
#pragma unroll
    for (int j = 0; j < 4; ++j) { float l = lsum[j]; l += __shfl_xor(l, 16); l += __shfl_xor(l, 32); const float inv = 1.f / l;
        bf16* op = MIX + (size_t)(tok0 + 16 * j + qi) * D + h * NAD + 4 * g;
#pragma unroll
        for (int dt = 0; dt < 4; ++dt) { const f32x4 v = o[j][dt] * inv; *(v2u*)(op + 16 * dt) = (v2u){pg8::cvt_pk_bf16(v[0], v[1]), pg8::cvt_pk_bf16(v[2], v[3])}; } }
}

typedef float f32x16 __attribute__((ext_vector_type(16)));
constexpr int SC_Q1 = 0, SC_K1 = SC_Q1 + 64 * 272, SC_K1T = SC_K1 + 64 * 272, SC_VT = SC_K1T + 128 * 144, SC_AB = SC_VT + 128 * 144, SC_ST = SC_AB + 64 * 144, SC_TOT = SC_ST + 128 * 272, SC_END = SC_TOT + 2 * 4 * 128 * 4;
static_assert(SC_END <= RING_BYTES, "scan LDS");
#define SCAN_MFMA(a, b, c) __builtin_amdgcn_mfma_f32_32x32x16_bf16(a, b, c, 0, 0, 0)
__device__ __forceinline__ void scan_unit(LAS unsigned char* lds, int b, int h, int dir, const unsigned short* LGT, const bf16* HQT, const bf16* HIT, bf16* OUT, int tid) {
    const int lane = tid & 63, w = __builtin_amdgcn_readfirstlane(tid >> 6), r = lane & 31, hh = lane >> 5;
    const int d = tid & 127, tq = tid >> 7;
    const int ti = w >> 2, ovi = w & 3;
    const int di = w >> 1, svi = 2 * (w & 1);
    f32x16 S0, S1;
#pragma unroll
    for (int i = 0; i < 16; ++i) { S0[i] = 0.f; S1[i] = 0.f; }
    const size_t chrow = (size_t)(h * HGD + d);
    constexpr int NCH = (LC + SEQ) / 64;
    auto col_of = [&](int c) -> int { return c < 4 ? (T + b * LC + 64 * (dir ? 3 - c : c)) : (b * SEQ + (dir ? SEQ - 64 * (c - 3) : 64 * (c - 4))); };
    u32x4 lgr[2], vr[2], qr[2];
    { const int c0 = col_of(0) + 16 * tq; lgr[0] = *(const u32x4*)(LGT + chrow * MROWS + c0); lgr[1] = *(const u32x4*)(LGT + chrow * MROWS + c0 + 8);
      vr[0] = *(const u32x4*)(HIT + chrow * MROWS + c0); vr[1] = *(const u32x4*)(HIT + chrow * MROWS + c0 + 8); qr[0] = qr[1] = (u32x4){0u, 0u, 0u, 0u}; }
#pragma unroll 1
    for (int c = 0; c < NCH; ++c) {
        const bool lat = c >= 4; const int par = c & 1;
        LAS float* tot = (LAS float*)(lds + SC_TOT) + par * 512;
        float P[16];
#pragma unroll
        for (int i = 0; i < 8; ++i) { const unsigned u2 = lgr[i >> 2][i & 3]; P[2 * i] = h2f((unsigned short)(u2 & 0xffff)); P[2 * i + 1] = h2f((unsigned short)(u2 >> 16)); }
        float kk[16];
#pragma unroll
        for (int i = 0; i < 16; ++i) kk[i] = 1.f - __builtin_amdgcn_exp2f(P[i]);
        if (!dir) {
#pragma unroll
            for (int i = 1; i < 16; ++i) P[i] += P[i - 1];
            tot[tq * 128 + d] = P[15];
        } else {
#pragma unroll
            for (int i = 14; i >= 0; --i) P[i] += P[i + 1];
            tot[tq * 128 + d] = P[0];
        }
        const u32x4 vcur0 = vr[0], vcur1 = vr[1], qcur0 = qr[0], qcur1 = qr[1];
        if (c + 1 < NCH) { const int c1 = col_of(c + 1) + 16 * tq;
            lgr[0] = *(const u32x4*)(LGT + chrow * MROWS + c1); lgr[1] = *(const u32x4*)(LGT + chrow * MROWS + c1 + 8);
            vr[0] = *(const u32x4*)(HIT + chrow * MROWS + c1); vr[1] = *(const u32x4*)(HIT + chrow * MROWS + c1 + 8);
            if (c + 1 >= 4) { qr[0] = *(const u32x4*)(HQT + chrow * T + c1); qr[1] = *(const u32x4*)(HQT + chrow * T + c1 + 8); } }
        __syncthreads();
        {
            const float t0 = tot[d], t1 = tot[128 + d], t2 = tot[256 + d], t3 = tot[384 + d];
            const float Bm = dir ? (t2 + t3) : (t0 + t1);
            float offs; if (!dir) offs = (tq > 0 ? t0 : 0.f) + (tq > 1 ? t1 : 0.f) + (tq > 2 ? t2 : 0.f); else offs = (tq < 3 ? t3 : 0.f) + (tq < 2 ? t2 : 0.f) + (tq < 1 ? t1 : 0.f);
            const float sh = offs - Bm;
            unsigned kt[8];
            LAS bf16* q1 = (LAS bf16*)(lds + SC_Q1) + (16 * tq) * 136 + d; LAS bf16* k1 = (LAS bf16*)(lds + SC_K1) + (16 * tq) * 136 + d;
#pragma unroll
            for (int i = 0; i < 16; i += 2) {
                const float x0 = fminf(fmaxf(P[i] + sh, -120.f), 120.f), x1 = fminf(fmaxf(P[i + 1] + sh, -120.f), 120.f);
                const float e0 = __builtin_amdgcn_exp2f(x0), e1 = __builtin_amdgcn_exp2f(x1);
                const float k0 = kk[i] * __builtin_amdgcn_exp2f(-x0), k1v = kk[i + 1] * __builtin_amdgcn_exp2f(-x1);
                kt[i >> 1] = pg8::cvt_pk_bf16(k0, k1v);
                if (lat) { const unsigned qq = (i < 8 ? qcur0 : qcur1)[(i >> 1) & 3];
                    q1[i * 136] = (bf16)f2bf(bflo(qq) * e0); q1[(i + 1) * 136] = (bf16)f2bf(bfhi(qq) * e1);
                    k1[i * 136] = (bf16)(kt[i >> 1] & 0xffff); k1[(i + 1) * 136] = (bf16)(kt[i >> 1] >> 16); }
            }
            LAS unsigned char* k1t = lds + SC_K1T + d * 144 + 32 * tq;
            *(LAS u32x4*)k1t = (u32x4){kt[0], kt[1], kt[2], kt[3]}; *(LAS u32x4*)(k1t + 16) = (u32x4){kt[4], kt[5], kt[6], kt[7]};
            LAS unsigned char* vt = lds + SC_VT + d * 144 + 32 * tq;
            *(LAS u32x4*)vt = vcur0; *(LAS u32x4*)(vt + 16) = vcur1;
        }
        if (lat) {
#pragma unroll
            for (int rg = 0; rg < 4; ++rg) { const int dd = 32 * di + 8 * rg + 4 * hh;
                const f32x4 a0 = *(const LAS f32x4*)(tot + dd), a1 = *(const LAS f32x4*)(tot + 128 + dd), a2 = *(const LAS f32x4*)(tot + 256 + dd), a3 = *(const LAS f32x4*)(tot + 384 + dd);
                const f32x4 bm = dir ? (a2 + a3) : (a0 + a1); float eb[4];
#pragma unroll
                for (int j = 0; j < 4; ++j) eb[j] = __builtin_amdgcn_exp2f(bm[j]);
                *(LAS v2u*)(lds + SC_ST + ((32 * svi + r) * 136 + dd) * 2) = (v2u){pg8::cvt_pk_bf16(S0[4 * rg] * eb[0], S0[4 * rg + 1] * eb[1]), pg8::cvt_pk_bf16(S0[4 * rg + 2] * eb[2], S0[4 * rg + 3] * eb[3])};
                *(LAS v2u*)(lds + SC_ST + ((32 * (svi + 1) + r) * 136 + dd) * 2) = (v2u){pg8::cvt_pk_bf16(S1[4 * rg] * eb[0], S1[4 * rg + 1] * eb[1]), pg8::cvt_pk_bf16(S1[4 * rg + 2] * eb[2], S1[4 * rg + 3] * eb[3])}; }
        }
        __syncthreads();
        f32x16 dS0, dS1, O;
#pragma unroll
        for (int i = 0; i < 16; ++i) { dS0[i] = 0.f; dS1[i] = 0.f; O[i] = 0.f; }
#pragma unroll
        for (int ks = 0; ks < 4; ++ks) {
            const bf16x8 a = *(const LAS bf16x8*)(lds + SC_K1T + ((32 * di + r) * 72 + 16 * ks + 8 * hh) * 2);
            const bf16x8 b0 = *(const LAS bf16x8*)(lds + SC_VT + ((32 * svi + r) * 72 + 16 * ks + 8 * hh) * 2), b1 = *(const LAS bf16x8*)(lds + SC_VT + ((32 * (svi + 1) + r) * 72 + 16 * ks + 8 * hh) * 2);
            dS0 = SCAN_MFMA(a, b0, dS0); dS1 = SCAN_MFMA(a, b1, dS1);
        }
        if (lat) {
#pragma unroll
            for (int ks = 0; ks < 8; ++ks) {
                const bf16x8 a = *(const LAS bf16x8*)(lds + SC_ST + ((32 * ovi + r) * 136 + 16 * ks + 8 * hh) * 2);
                const bf16x8 bq = *(const LAS bf16x8*)(lds + SC_Q1 + ((32 * ti + r) * 136 + 16 * ks + 8 * hh) * 2);
                O = SCAN_MFMA(a, bq, O);
            }
            if (w < 4) {
                const int asi = (w == 0) ? 0 : (w == 1) ? 1 : (w == 2) ? (dir ? 1 : 0) : (dir ? 0 : 1);
                const int ati = (w == 0) ? 0 : (w == 1) ? 1 : (w == 2) ? (dir ? 0 : 1) : (dir ? 1 : 0);
                f32x16 At;
#pragma unroll
                for (int i = 0; i < 16; ++i) At[i] = 0.f;
                if (w < 3) {
#pragma unroll
                    for (int ks = 0; ks < 8; ++ks) {
                        const bf16x8 a = *(const LAS bf16x8*)(lds + SC_K1 + ((32 * asi + r) * 136 + 16 * ks + 8 * hh) * 2);
                        const bf16x8 bq = *(const LAS bf16x8*)(lds + SC_Q1 + ((32 * ati + r) * 136 + 16 * ks + 8 * hh) * 2);
                        At = SCAN_MFMA(a, bq, At);
                    }
                }
                const int tt = 32 * ati + r;
#pragma unroll
                for (int rg = 0; rg < 4; ++rg) { const int s0 = 32 * asi + 8 * rg + 4 * hh; float v[4];
#pragma unroll
                    for (int j = 0; j < 4; ++j) { const int ss = s0 + j; const bool keep = dir ? (ss >= tt) : (ss <= tt); v[j] = keep ? At[4 * rg + j] : 0.f; }
                    *(LAS v2u*)(lds + SC_AB + (tt * 72 + s0) * 2) = (v2u){pg8::cvt_pk_bf16(v[0], v[1]), pg8::cvt_pk_bf16(v[2], v[3])}; }
            }
            __syncthreads();
#pragma unroll
            for (int ks = 0; ks < 4; ++ks) {
                const bf16x8 a = *(const LAS bf16x8*)(lds + SC_VT + ((32 * ovi + r) * 72 + 16 * ks + 8 * hh) * 2);
                const bf16x8 bq = *(const LAS bf16x8*)(lds + SC_AB + ((32 * ti + r) * 72 + 16 * ks + 8 * hh) * 2);
                O = SCAN_MFMA(a, bq, O);
            }
            bf16* op = OUT + (size_t)(col_of(c) + 32 * ti + r) * SEGW + h * HGD + 32 * ovi + 4 * hh;
#pragma unroll
            for (int rg = 0; rg < 4; ++rg) *(v2u*)(op + 8 * rg) = (v2u){pg8::cvt_pk_bf16(O[4 * rg], O[4 * rg + 1]), pg8::cvt_pk_bf16(O[4 * rg + 2], O[4 * rg + 3])};
        }
#pragma unroll
        for (int rg = 0; rg < 4; ++rg) { const int dd = 32 * di + 8 * rg + 4 * hh;
            const f32x4 a0 = *(const LAS f32x4*)(tot + dd), a1 = *(const LAS f32x4*)(tot + 128 + dd), a2 = *(const LAS f32x4*)(tot + 256 + dd), a3 = *(const LAS f32x4*)(tot + 384 + dd);
            const f32x4 be = (a0 + a1) + (a2 + a3), bm = dir ? (a2 + a3) : (a0 + a1);
#pragma unroll
            for (int j = 0; j < 4; ++j) { const float ee = __builtin_amdgcn_exp2f(be[j]), em = __builtin_amdgcn_exp2f(be[j] - bm[j]);
                S0[4 * rg + j] = ee * S0[4 * rg + j] + em * dS0[4 * rg + j]; S1[4 * rg + j] = ee * S1[4 * rg + j] + em * dS1[4 * rg + j]; } }
    }
}


#ifdef DBG_NAIVE
__device__ __forceinline__ void scan_naive(LAS unsigned char* lds, int b, int h, int dir, const unsigned short* LGT, const bf16* HQT, const bf16* HIT, bf16* OUT, int tid) {
    const int dv = tid & 127, kg = tid >> 7;
    float St[32];
#pragma unroll
    for (int i = 0; i < 32; ++i) St[i] = 0.f;
    LAS float* sq = (LAS float*)lds; LAS float* sk = sq + 16 * 128; LAS float* sf = sk + 16 * 128; LAS float* sv = sf + 16 * 128; LAS float* so = sv + 16 * 128;
    constexpr int NSTEP = LC + SEQ;
    for (int j0 = 0; j0 < NSTEP; j0 += 16) {
        const bool isctx = j0 < LC;
        for (int idx = tid; idx < 16 * 128; idx += NTHR) { const int st = idx >> 7, ch = idx & 127, j = j0 + st;
            int col; if (j < LC) col = T + b * LC + (dir ? (LC - 1 - j) : j); else col = b * SEQ + (dir ? (SEQ - 1 - (j - LC)) : (j - LC));
            const size_t cr = (size_t)(h * HGD + ch);
            const float f = __builtin_amdgcn_exp2f(h2f(LGT[cr * MROWS + col]));
            sf[st * 128 + ch] = f; sk[st * 128 + ch] = 1.f - f; sv[st * 128 + ch] = bf2f(HIT[cr * MROWS + col]);
            if (!isctx) sq[st * 128 + ch] = bf2f(HQT[cr * T + col]); }
        __syncthreads();
        for (int st = 0; st < 16; ++st) {
            const float vv = sv[st * 128 + dv]; float o = 0.f;
#pragma unroll
            for (int i = 0; i < 32; ++i) { St[i] = sf[st * 128 + kg * 32 + i] * St[i] + sk[st * 128 + kg * 32 + i] * vv; o += St[i] * sq[st * 128 + kg * 32 + i]; }
            so[(st * 4 + kg) * 128 + dv] = o;
        }
        __syncthreads();
        if (!isctx) {
            for (int idx = tid; idx < 16 * 128; idx += NTHR) { const int st = idx >> 7, dd = idx & 127, j = j0 + st;
                const float o = (so[(st * 4 + 0) * 128 + dd] + so[(st * 4 + 1) * 128 + dd]) + (so[(st * 4 + 2) * 128 + dd] + so[(st * 4 + 3) * 128 + dd]);
                const int row = b * SEQ + (dir ? (SEQ - 1 - (j - LC)) : (j - LC));
                OUT[(size_t)row * SEGW + h * HGD + dd] = (bf16)f2bf(o); }
        }
        __syncthreads();
    }
}
#endif

__device__ __forceinline__ void transpose_item(const float* W, int ldw, int k0, int n0, bf16* WT, int ldk, int drow0, LAS float* scr, int lane) {
#pragma unroll 8
    for (int i = 0; i < 32; ++i) { const int kk = 2 * i + (lane >> 5); scr[kk * 33 + (lane & 31)] = W[(size_t)(k0 + kk) * ldw + n0 + (lane & 31)]; }
    LDS_WAIT(); asm volatile("" ::: "memory");
    const int c = lane & 7;
#pragma unroll
    for (int j = 0; j < 4; ++j) { const int n = (lane >> 3) + 8 * j; const LAS float* s = scr + (8 * c) * 33 + n;
        v4u o; o.x = pk2(s[0 * 33], s[1 * 33]); o.y = pk2(s[2 * 33], s[3 * 33]); o.z = pk2(s[4 * 33], s[5 * 33]); o.w = pk2(s[6 * 33], s[7 * 33]);
        *(GAS v4u*)(WT + (size_t)(drow0 + n) * ldk + k0 + 8 * c) = o; }
    LDS_WAIT(); asm volatile("" ::: "memory");
}

struct Args { const float* in[21]; float* out; unsigned char* ws; int ph_lo, ph_hi, li, pad; };

__global__ void __launch_bounds__(NTHR, 2) fwd_mega(Args args) {
    extern __shared__ __attribute__((aligned(16))) unsigned char lds_raw[];
    LAS unsigned char* lds = (LAS unsigned char*)lds_raw;
    volatile LAS unsigned* MISC = (volatile LAS unsigned*)(lds + MISC_OFF);
    const int tid = threadIdx.x, lane = tid & 63, wave = __builtin_amdgcn_readfirstlane(tid >> 6);
    const int G = gridDim.x; const int bx = blockIdx.x; const int vcu = (G % 8 == 0) ? (bx % 8) * (G / 8) + bx / 8 : bx;
    gu32* ctl0 = (gu32*)(args.ws + WS_CTL);
    const int gw = vcu * NWAVES + wave, NGW = G * NWAVES;
    for (int u = tid; u < (LDS_BYTES - LDSCTL_OFF) / 4; u += NTHR) ((LAS unsigned*)(lds + LDSCTL_OFF))[u] = 0u;
    __syncthreads();
    XcdBarrier bar = xcd_barrier_post((unsigned*)(ctl0 + CW_BAR) + args.li * XCD_BAR_WORDS, MISC + 8);
    const int lo = args.ph_lo, hi = args.ph_hi;
#ifndef PHMASK
#define PHMASK 0xFFFF
#endif
#define IN(k) (((PHMASK >> (k)) & 1) && lo <= (k) && (k) < hi)
#define SEAM(k) do { if (IN(k) && IN((k) + 1)) xcd_barrier(bar); } while (0)

#define KA(i) ({ const __attribute__((address_space(4))) Args* _p = (const __attribute__((address_space(4))) Args*)__builtin_amdgcn_kernarg_segment_ptr(); asm volatile("" : "+s"(_p)); _p->in[i]; })
#define WSP() ({ const __attribute__((address_space(4))) Args* _p = (const __attribute__((address_space(4))) Args*)__builtin_amdgcn_kernarg_segment_ptr(); asm volatile("" : "+s"(_p)); _p->ws; })
#define PHASE_PTRS unsigned char* ws = WSP(); float* MOD = (float*)(ws + WS_MOD); float* ROPE = (float*)(ws + WS_ROPE); float* LBT = (float*)(ws + WS_LBT); \
    bf16* WinT = (bf16*)(ws + WS_WINT); bf16* WoutT = (bf16*)(ws + WS_WOUTT); bf16* W13T = (bf16*)(ws + WS_W13T); bf16* W2T = (bf16*)(ws + WS_W2T); \
    bf16* XN = (bf16*)(ws + WS_XN); bf16* MIX = (bf16*)(ws + WS_MIX); bf16* XN2 = (bf16*)(ws + WS_XN2); \
    float* X1 = (float*)(ws + WS_X1); bf16* Hb = (bf16*)(ws + WS_H); bf16* Yb = (bf16*)(ws + WS_Y); \
    int* ELIST = (int*)(ws + WS_ELIST); float* EWT = (float*)(ws + WS_EWT); gu32* ctl = (gu32*)(ws + WS_CTL); \
    (void)MOD; (void)ROPE; (void)LBT; (void)WinT; (void)WoutT; (void)W13T; (void)W2T; (void)XN; (void)MIX; (void)XN2; (void)X1; (void)Hb; (void)Yb; (void)ELIST; (void)EWT; (void)ctl;
    if (IN(0)) {
        PHASE_PTRS
        const float* cvec = KA(1); const float* c_ctx = KA(3); const float* w_mod = KA(4); const float* b_mod = KA(5); const float* w_in = KA(8); const float* w_out = KA(9);
        const float* hg_lb = KA(11); const float* w1 = KA(17); const float* w3 = KA(18); const float* w2 = KA(19);
        if (bx == G - 1) {
            for (int idx = tid; idx < 1024; idx += NTHR) { const int pos = idx >> 4, i = idx & 15;
                double th = 1.0; for (int k = 0; k < i; ++k) th *= 0.5623413251903491;
                const double t2 = th * th; double c = 1.0, s = th, tc = 1.0, ts = th;
                for (int n = 1; n <= 12; ++n) { tc *= -t2 / (double)((2 * n - 1) * (2 * n)); c += tc; ts *= -t2 / (double)((2 * n) * (2 * n + 1)); s += ts; }
                double cr = 1.0, ci = 0.0; for (int p = 0; p < pos; ++p) { const double nr = cr * c - ci * s; ci = cr * s + ci * c; cr = nr; }
                ROPE[idx * 2] = (float)cr; ROPE[idx * 2 + 1] = (float)ci; }
            for (int idx = tid; idx < 1024; idx += NTHR) { const float h0 = hg_lb[idx], h1 = hg_lb[1024 + idx]; LBT[idx] = 1.f / (1.f + expf(h1 - h0)); }
        }
        if (bx < 96) {
            LAS float* sc = (LAS float*)lds;
            for (int idx = tid; idx < 17 * 1024; idx += NTHR) { const int r = idx >> 10, k = idx & 1023; const float cv = r < 16 ? cvec[r * 1024 + k] : c_ctx[k]; sc[idx] = cv / (1.f + expf(-cv)); }
            __syncthreads();
            const int col = 64 * bx + lane, k0 = 128 * wave;
            float acc[17];
#pragma unroll
            for (int r = 0; r < 17; ++r) acc[r] = 0.f;
            for (int kk = 0; kk < 128; kk += 4) {
                const float w0 = w_mod[(size_t)(k0 + kk) * 6144 + col], w1v = w_mod[(size_t)(k0 + kk + 1) * 6144 + col], w2v = w_mod[(size_t)(k0 + kk + 2) * 6144 + col], w3v = w_mod[(size_t)(k0 + kk + 3) * 6144 + col];
#pragma unroll
                for (int r = 0; r < 17; ++r) { const f32x4 a = *(const LAS f32x4*)(sc + r * 1024 + k0 + kk); acc[r] += a[0] * w0 + a[1] * w1v + a[2] * w2v + a[3] * w3v; }
            }
            LAS float* red = (LAS float*)(lds + 17 * 1024 * 4);
#pragma unroll
            for (int r = 0; r < 17; ++r) red[(wave * 17 + r) * 64 + lane] = acc[r];
            __syncthreads();
            for (int idx = tid; idx < 17 * 64; idx += NTHR) { const int r = idx >> 6, l = idx & 63; float s = 0.f;
#pragma unroll
                for (int w = 0; w < 8; ++w) s += red[(w * 17 + r) * 64 + l];
                MOD[r * 6144 + 64 * bx + l] = s + b_mod[64 * bx + l]; }
            __syncthreads();
        }
        {
            LAS float* scr = (LAS float*)(lds + wave * 16384);
            constexpr int I_IN = 16 * 128, I_OUT = 16 * 32, I_13 = 16 * 2 * 256, I_2 = 16 * 256, NIT = I_IN + I_OUT + I_13 + I_2;
            for (int it = gw; it < NIT; it += NGW) {
                int r = it;
                if (r < I_IN) { const int kb = r / 128, nb = r % 128; transpose_item(w_in, INCOLS, 64 * kb, 32 * nb, WinT, 1024, 32 * nb, scr, lane); continue; } r -= I_IN;
                if (r < I_OUT) { const int kb = r / 32, nb = r % 32; transpose_item(w_out, 1024, 64 * kb, 32 * nb, WoutT, 1024, 32 * nb, scr, lane); continue; } r -= I_OUT;
                if (r < I_13) { const int e = r / 512, rem = r % 512, s = rem / 256, r2 = rem % 256, kb = r2 / 16, nb = r2 % 16, n0 = 32 * nb;
                    transpose_item((s ? w3 : w1) + (size_t)e * 1024 * 512, 512, 64 * kb, n0, W13T, 1024, e * 1024 + 256 * (n0 / 128) + 128 * s + (n0 % 128), scr, lane); continue; } r -= I_13;
                { const int e = r / 256, r2 = r % 256, kb = r2 / 32, nb = r2 % 32; transpose_item(w2 + (size_t)e * 512 * 1024, 1024, 64 * kb, 32 * nb, W2T, 512, e * 1024 + 32 * nb, scr, lane); }
            }
        }
    }
    SEAM(0);

    if (IN(1)) {
        PHASE_PTRS
        const float* x = KA(0); const float* ctx = KA(2); const float* norm_mix = KA(6);
        for (int row = gw; row < MROWS; row += NGW) {
            const float* xr = row < T ? x + (size_t)row * D : ctx + (size_t)(row - T) * D; const int mb = row < T ? (row >> 11) : 16;
            f32x4 v[4]; float s = 0.f;
#pragma unroll
            for (int j = 0; j < 4; ++j) { v[j] = *(const f32x4*)(xr + 4 * lane + 256 * j); s += (v[j][0] * v[j][0] + v[j][1] * v[j][1]) + (v[j][2] * v[j][2] + v[j][3] * v[j][3]); }
            const float rstd = 1.f / sqrtf(wave_sum(s) * (1.f / D) + EPS);
#pragma unroll
            for (int j = 0; j < 4; ++j) { const int col = 4 * lane + 256 * j; const f32x4 g = *(const f32x4*)(norm_mix + col), sh = *(const f32x4*)(MOD + mb * 6144 + col), sc = *(const f32x4*)(MOD + mb * 6144 + 1024 + col);
                const f32x4 y = v[j] * rstd * g * (1.f + sc) + sh;
                *(v2u*)(XN + (size_t)row * D + col) = (v2u){pk2(y[0], y[1]), pk2(y[2], y[3])}; }
        }
    }
    SEAM(1);

    if (IN(2)) {
        PHASE_PTRS
        ProjOrder S; S.init(G, bx);
        EpiProj E{ws};
        pg8::gemm_phase<EpiProj, ProjOrder>(lds + RING_OFF, XN, WinT, D, S, E);
    }
    SEAM(2);

    if (IN(3)) {
        PHASE_PTRS
        const bf16* Qb = (const bf16*)(ws + WS_Q); const bf16* Kb = (const bf16*)(ws + WS_K); const bf16* Vb = (const bf16*)(ws + WS_V);
        const float* na_rpb = KA(10);
        const int subph = ({ const __attribute__((address_space(4))) Args* _p = (const __attribute__((address_space(4))) Args*)__builtin_amdgcn_kernarg_segment_ptr(); asm volatile("" : "+s"(_p)); _p->pad; });
#ifndef NO_SCAN
        if (bx < 128) {
            const int dir = bx & 1;
#ifdef DBG_NAIVE
            if (DBG_NAIVE & (1 << dir)) scan_naive(lds, bx >> 3, (bx >> 1) & 3, dir, (const unsigned short*)(ws + (dir ? WS_LB : WS_LF)), (const bf16*)(ws + WS_HQ), (const bf16*)(ws + WS_HI), (bf16*)(ws + (dir ? WS_OB : WS_OF)), tid);
            else
#endif
            if (subph != 2) scan_unit(lds, bx >> 3, (bx >> 1) & 3, dir, (const unsigned short*)(ws + (dir ? WS_LB : WS_LF)), (const bf16*)(ws + WS_HQ), (const bf16*)(ws + WS_HI), (bf16*)(ws + (dir ? WS_OB : WS_OF)), tid);
        } else
#endif
        {
            LAS float* rpbL = (LAS float*)lds;
            for (int idx = tid; idx < 8 * 15 * 64; idx += NTHR) { const int co = (idx & 63) - 16, hr = idx >> 6; rpbL[idx] = (co >= 0 && co < 31) ? na_rpb[hr * 31 + co] * 1.44269504f : 0.f; }
            __syncthreads();
            const __amdgpu_buffer_rsrc_t srdK = __builtin_amdgcn_make_buffer_rsrc((void*)Kb, (short)0, MROWS * SEGW * 2, 0x00020000), srdV = __builtin_amdgcn_make_buffer_rsrc((void*)Vb, (short)0, MROWS * SEGW * 2, 0x00020000);
            const int hx = bx & 7, idx = ((bx - 128) >> 3) * NWAVES + wave;
#pragma unroll 1
            for (int it = (subph == 1 ? 4 : 0); it < 4; ++it)
                na_row(it * 4 + (idx >> 5), hx, idx & 31, Qb, (const bf16*)(ws + WS_QR), srdK, srdV, MIX, rpbL, lane);
        }
    }
    SEAM(3);

    if (IN(4)) {
        PHASE_PTRS
        const float* hg_norm = KA(12);
        const bf16* OF = (const bf16*)(ws + WS_OF); const bf16* OB = (const bf16*)(ws + WS_OB); const bf16* Gb = (const bf16*)(ws + WS_G);
        for (int tok = gw; tok < T; tok += NGW) {
            const size_t off = (size_t)tok * SEGW + lane * 8;
            const v4u a = *(const v4u*)(OF + off), bb = *(const v4u*)(OB + off), g = *(const v4u*)(Gb + off);
            float o[8]; float ss = 0.f;
#pragma unroll
            for (int e = 0; e < 4; ++e) { o[2 * e] = bflo(a[e]) + bflo(bb[e]); o[2 * e + 1] = bfhi(a[e]) + bfhi(bb[e]);
#ifdef DBG_SANITIZE
                if (!(fabsf(o[2 * e]) < 1e30f)) o[2 * e] = 0.f; if (!(fabsf(o[2 * e + 1]) < 1e30f)) o[2 * e + 1] = 0.f;
#endif
                ss += o[2 * e] * o[2 * e] + o[2 * e + 1] * o[2 * e + 1]; }
            ss += __shfl_xor(ss, 1); ss += __shfl_xor(ss, 2); ss += __shfl_xor(ss, 4); ss += __shfl_xor(ss, 8);
            const float rstd = 1.f / sqrtf(ss * (1.f / HGD) + EPS);
            const int dv0 = (lane & 15) * 8;
            const f32x4 g0 = *(const f32x4*)(hg_norm + dv0), g1 = *(const f32x4*)(hg_norm + dv0 + 4);
            const float gg[8] = {g0[0], g0[1], g0[2], g0[3], g1[0], g1[1], g1[2], g1[3]};
            float y[8];
#pragma unroll
            for (int e = 0; e < 4; ++e) { y[2 * e] = o[2 * e] * rstd * gg[2 * e] * bflo(g[e]); y[2 * e + 1] = o[2 * e + 1] * rstd * gg[2 * e + 1] * bfhi(g[e]); }
            *(v4u*)(MIX + (size_t)tok * D + 512 + lane * 8) = (v4u){pk2(y[0], y[1]), pk2(y[2], y[3]), pk2(y[4], y[5]), pk2(y[6], y[7])};
        }
    }
    SEAM(4);

    if (IN(5)) {
        PHASE_PTRS
        pg8::DenseOrder S; S.init(T, D, G, bx);
        EpiRes E{KA(0), X1, MOD};
        pg8::gemm_phase<EpiRes, pg8::DenseOrder>(lds + RING_OFF, MIX, WoutT, D, S, E);
    }
    SEAM(5);

    if (IN(6)) {
        PHASE_PTRS
        const float* norm_ffn = KA(7); const float* w_grp = KA(13); const float* b_grp = KA(14); const float* w_exp = KA(15); const float* b_exp = KA(16);
        LAS f32x4* wl = (LAS f32x4*)lds;
        for (int idx = tid; idx < 5 * 1024; idx += NTHR) { const int quad = idx >> 10, col = idx & 1023; const int l = (col & 255) >> 2, q = col & 3, j = col >> 8;
            const f32x4 w = quad == 0 ? *(const f32x4*)(w_grp + col * 4) : *(const f32x4*)(w_exp + col * 16 + (quad - 1) * 4);
            wl[((quad * 4 + q) * 4 + j) * 64 + l] = w; }
        LAS int* lcnt = (LAS int*)(lds + 81920);
        LAS int* tmpe = (LAS int*)(lds + 81920 + 256);
        if (tid < 32) lcnt[tid] = 0;
        __syncthreads();
        const int rowbase = bx * 128 + wave * 16;
#pragma unroll 1
        for (int i = 0; i < 16; ++i) {
            asm volatile("" ::: "memory");
            const int row = rowbase + i; const int mb = row >> 11;
            const float* xr = X1 + (size_t)row * D;
            f32x4 v[4]; float s = 0.f;
#pragma unroll
            for (int j = 0; j < 4; ++j) { v[j] = *(const f32x4*)(xr + 4 * lane + 256 * j); s += (v[j][0] * v[j][0] + v[j][1] * v[j][1]) + (v[j][2] * v[j][2] + v[j][3] * v[j][3]); }
            const float rstd = 1.f / sqrtf(wave_sum(s) * (1.f / D) + EPS);
            float lg[20];
#pragma unroll
            for (int k = 0; k < 20; ++k) lg[k] = 0.f;
#pragma unroll
            for (int j = 0; j < 4; ++j) { const int col = 4 * lane + 256 * j; const f32x4 g = *(const f32x4*)(norm_ffn + col), sh = *(const f32x4*)(MOD + mb * 6144 + 3072 + col), sc = *(const f32x4*)(MOD + mb * 6144 + 4096 + col);
                const f32x4 y = v[j] * rstd * g * (1.f + sc) + sh;
                asm volatile("" ::: "memory");
                *(v2u*)(XN2 + (size_t)row * D + col) = (v2u){pk2(y[0], y[1]), pk2(y[2], y[3])};
#pragma unroll
                for (int q = 0; q < 4; ++q)
#pragma unroll
                    for (int quad = 0; quad < 5; ++quad) { const f32x4 w = wl[((quad * 4 + q) * 4 + j) * 64 + lane];
                        lg[quad * 4 + 0] += y[q] * w[0]; lg[quad * 4 + 1] += y[q] * w[1]; lg[quad * 4 + 2] += y[q] * w[2]; lg[quad * 4 + 3] += y[q] * w[3]; } }
#pragma unroll
            for (int k = 0; k < 20; ++k) lg[k] = wave_sum(lg[k]);
            if (lane == 0) {
                float gl[4];
#pragma unroll
                for (int k = 0; k < 4; ++k) gl[k] = lg[k] + b_grp[k];
                int gs = 0; float gm = gl[0];
#pragma unroll
                for (int k = 1; k < 4; ++k) if (gl[k] > gm) { gm = gl[k]; gs = k; }
                float den = 0.f;
#pragma unroll
                for (int k = 0; k < 4; ++k) den += __expf(gl[k] - gm);
                const float g_w = 1.f / den;
                float ev[4];
#pragma unroll
                for (int k = 0; k < 4; ++k) { float a = lg[4 + k] + b_exp[k];
#pragma unroll
                    for (int g2 = 1; g2 < 4; ++g2) a = (gs == g2) ? (lg[4 + g2 * 4 + k] + b_exp[g2 * 4 + k]) : a;
                    ev[k] = a; }
                int i0 = 0; float v0 = ev[0];
#pragma unroll
                for (int k = 1; k < 4; ++k) if (ev[k] > v0) { v0 = ev[k]; i0 = k; }
                int i1 = -1; float v1 = -INFINITY;
#pragma unroll
                for (int k = 0; k < 4; ++k) if (k != i0 && ev[k] > v1) { v1 = ev[k]; i1 = k; }
                if (i1 < 0) { i1 = (i0 + 1) & 3; v1 = v0; }
                const float e1 = __expf(v1 - v0); const float w0 = g_w / (1.f + e1), w1w = g_w * e1 / (1.f + e1);
                const int ea = gs * 4 + i0, eb = gs * 4 + i1;
                const int ra = __hip_atomic_fetch_add(&lcnt[ea], 1, __ATOMIC_RELAXED, __HIP_MEMORY_SCOPE_WORKGROUP), rb = __hip_atomic_fetch_add(&lcnt[eb], 1, __ATOMIC_RELAXED, __HIP_MEMORY_SCOPE_WORKGROUP);
                const int lr = (wave * 16 + i) * 2;
                tmpe[lr] = ea; tmpe[256 + lr] = ra; tmpe[512 + lr] = __builtin_bit_cast(int, w0);
                tmpe[lr + 1] = eb; tmpe[256 + lr + 1] = rb; tmpe[512 + lr + 1] = __builtin_bit_cast(int, w1w);
            }
        }
        __syncthreads();
        if (tid < 16) lcnt[16 + tid] = (int)__hip_atomic_fetch_add(ctl + CW_CNT + tid, (unsigned)lcnt[tid], RLX_AGENT);
        __syncthreads();
        if (tid < 256) { const int e = tmpe[tid], pos = lcnt[16 + e] + tmpe[256 + tid]; const int tok = bx * 128 + (tid >> 1);
            ELIST[e * ECAP + pos] = tok * 2 + (tid & 1); EWT[e * ECAP + pos] = __builtin_bit_cast(float, tmpe[512 + tid]); }
        __syncthreads();
    }
    SEAM(6);

    if (IN(7) || IN(8)) {
        PHASE_PTRS
        LAS int* tp = (LAS int*)(lds + MOE_OFF);
        if (tid == 0) { int acc = 0;
            for (int e = 0; e < 16; ++e) { const int c = (int)__hip_atomic_load(ctl + CW_CNT + e, RLX_AGENT); tp[e] = acc; tp[17 + e] = c; acc += (c + 255) >> 8; }
            tp[16] = acc; }
        __syncthreads();
    }
    if (IN(7)) {
        PHASE_PTRS
        const LAS int* tp = (const LAS int*)(lds + MOE_OFF);
        MoeOrder<true> S{tp, ELIST, G, bx, tp[16] * 4};
        EpiSwiGLU E{Hb};
        pg8::gemm_phase<EpiSwiGLU, MoeOrder<true>>(lds + RING_OFF, XN2, W13T, D, S, E);
    }
    SEAM(7);
    if (IN(8)) {
        PHASE_PTRS
        const LAS int* tp = (const LAS int*)(lds + MOE_OFF);
        MoeOrder<false> S{tp, ELIST, G, bx, tp[16] * 4};
        EpiMoeOut E{Yb, ELIST, EWT};
        pg8::gemm_phase<EpiMoeOut, MoeOrder<false>>(lds + RING_OFF, Hb, W2T, DE, S, E);
    }
    SEAM(8);

    if (IN(9)) {
        PHASE_PTRS
        const float* norm_final = KA(20); float* outp = ({ const __attribute__((address_space(4))) Args* _p = (const __attribute__((address_space(4))) Args*)__builtin_amdgcn_kernarg_segment_ptr(); asm volatile("" : "+s"(_p)); _p->out; });
        for (int row = gw; row < T; row += NGW) {
            const int mb = row >> 11; f32x4 v[4]; float s = 0.f;
#pragma unroll
            for (int j = 0; j < 4; ++j) { const int col = 4 * lane + 256 * j; const f32x4 xv = *(const f32x4*)(X1 + (size_t)row * D + col), ga = *(const f32x4*)(MOD + mb * 6144 + 5120 + col);
                const v2u y0 = *(const v2u*)(Yb + (size_t)(2 * row) * D + col), y1 = *(const v2u*)(Yb + (size_t)(2 * row + 1) * D + col);
                const f32x4 ys = (f32x4){bflo(y0.x) + bflo(y1.x), bfhi(y0.x) + bfhi(y1.x), bflo(y0.y) + bflo(y1.y), bfhi(y0.y) + bfhi(y1.y)};
                v[j] = xv + ga * ys; s += (v[j][0] * v[j][0] + v[j][1] * v[j][1]) + (v[j][2] * v[j][2] + v[j][3] * v[j][3]); }
            const float rstd = 1.f / sqrtf(wave_sum(s) * (1.f / D) + EPS);
#pragma unroll
            for (int j = 0; j < 4; ++j) { const int col = 4 * lane + 256 * j; const f32x4 g = *(const f32x4*)(norm_final + col);
                *(f32x4*)(outp + (size_t)row * D + col) = v[j] * rstd * g; }
        }
    }
#undef IN
#undef SEAM
}

#ifndef MK_N_LAUNCHES
#define MK_N_LAUNCHES 1
#endif
constexpr int NPHASE = 10;
extern "C" void kernel_launch(void* const* d_in, const int* in_sizes, int n_in, void* d_out, int out_size, void* d_ws, size_t ws_size, hipStream_t stream) {
    static int grid = 0;
    if (grid == 0) {
        if (n_in != 21 || in_sizes[0] != T * D || out_size != T * D || ws_size < WS_END) { fprintf(stderr, "kernel_launch: unexpected shapes (n_in %d, in0 %d, out %d, ws %zu)\n", n_in, n_in > 0 ? in_sizes[0] : -1, out_size, ws_size); grid = -1; return; }
        int dev = 0, cus = 0, per_cu = 0;
        if (hipGetDevice(&dev) != hipSuccess || hipDeviceGetAttribute(&cus, hipDeviceAttributeMultiprocessorCount, dev) != hipSuccess) { grid = -1; return; }
        if (hipFuncSetAttribute((const void*)fwd_mega, hipFuncAttributeMaxDynamicSharedMemorySize, LDS_BYTES) != hipSuccess) { fprintf(stderr, "kernel_launch: hipFuncSetAttribute failed\n"); grid = -1; return; }
        if (hipOccupancyMaxActiveBlocksPerMultiprocessor(&per_cu, (const void*)fwd_mega, NTHR, LDS_BYTES) != hipSuccess || per_cu < 1) fprintf(stderr, "kernel_launch: occupancy query reports %d\n", per_cu);
        (void)hipGetLastError();
        grid = cus;
        if (grid != 256) fprintf(stderr, "kernel_launch: %d CUs (built for 256)\n", grid);
    }
    if (grid < 0) return;
    (void)hipMemsetAsync((char*)d_ws + WS_CTL, 0, CTL_ZERO_BYTES, stream);
    Args a{};
    for (int i = 0; i < 21; ++i) a.in[i] = (const float*)d_in[i];
    a.out = (float*)d_out; a.ws = (unsigned char*)d_ws;
    if (MK_N_LAUNCHES == 1) {
        a.ph_lo = 0; a.ph_hi = NPHASE; a.li = 0;
        hipLaunchKernelGGL(fwd_mega, dim3(grid), dim3(NTHR), LDS_BYTES, stream, a);
    } else {
        for (int li = 0; li < NPHASE; ++li) { a.ph_lo = li; a.ph_hi = li + 1; a.li = 0; hipLaunchKernelGGL(fwd_mega, dim3(grid), dim3(NTHR), LDS_BYTES, stream, a);
#ifdef PROBE_DUP
            if (li == PROBE_DUP) {
#ifdef PROBE_SUB
                a.pad = PROBE_SUB;
#endif
                hipLaunchKernelGGL(fwd_mega, dim3(grid), dim3(NTHR), LDS_BYTES, stream, a); a.pad = 0; }
#endif
        }
    }
}
```

```cpp
#include <hip/hip_runtime.h>
#include <cstdio>
#include <cstdint>

#define GAS __attribute__((address_space(1)))
#define LAS __attribute__((address_space(3)))
typedef unsigned short bf16;
typedef unsigned short bf16_t;
typedef unsigned v4u __attribute__((ext_vector_type(4)));
typedef unsigned v2u __attribute__((ext_vector_type(2)));
typedef float f32x4 __attribute__((ext_vector_type(4)));
typedef float f32x2 __attribute__((ext_vector_type(2)));
typedef short bf16x8 __attribute__((ext_vector_type(8)));
typedef unsigned u32x4 __attribute__((ext_vector_type(4)));
typedef GAS unsigned gu32;
#define RLX_AGENT __ATOMIC_RELAXED, __HIP_MEMORY_SCOPE_AGENT
#define LDS_WAIT() asm volatile("s_waitcnt lgkmcnt(0)" ::: "memory")
#define VM_WAIT() asm volatile("s_waitcnt vmcnt(0)" ::: "memory")

constexpr int NB = 16, SEQ = 2048, D = 1024, T = NB * SEQ, LC = 256, TC = NB * LC, MROWS = T + TC;
constexpr int GW = 64, NROWS = SEQ / GW;
constexpr int INCOLS = 4096, SEGW = 512;
constexpr int NAH = 8, NAD = 64, HGH = 4, HGD = 128;
constexpr int KTOK = SEQ + LC;
constexpr int NE = 16, DE = 512, ECAP = T;
constexpr float EPS = 1e-6f;
constexpr int NWAVES = 8, NTHR = 512;

constexpr size_t MiB = 1u << 20;
constexpr size_t WS_CTL = 0, CTL_ZERO_BYTES = 1 * MiB;
constexpr size_t WS_MOD = 1 * MiB;
constexpr size_t WS_ROPE = WS_MOD + 512 * 1024, WS_LBT = WS_MOD + 520 * 1024;
constexpr size_t WS_ELIST = 2 * MiB, WS_EWT = 4 * MiB;
constexpr size_t WS_WINT = 8 * MiB, WS_WOUTT = 16 * MiB, WS_W13T = 18 * MiB, WS_W2T = 50 * MiB;
constexpr size_t WS_XN = 66 * MiB;
constexpr size_t WS_Q = 138 * MiB, WS_K = 170 * MiB, WS_V = 206 * MiB, WS_HQ = 242 * MiB, WS_HI = 274 * MiB, WS_LF = 310 * MiB, WS_LB = 346 * MiB, WS_G = 382 * MiB;
constexpr size_t WS_OF = 414 * MiB, WS_OB = 446 * MiB, WS_QR = 478 * MiB, WS_END = 510 * MiB;
constexpr size_t WS_MIX = WS_XN, WS_XN2 = WS_XN, WS_X1 = 138 * MiB, WS_H = 274 * MiB, WS_Y = 346 * MiB;
constexpr int CW_CNT = 64;
constexpr int CW_BAR = 4096;

constexpr int RING_OFF = 0, RING_BYTES = 131072;
constexpr int LDSCTL_OFF = RING_BYTES, MISC_OFF = LDSCTL_OFF + 320, MOE_OFF = LDSCTL_OFF + 1024;
constexpr int TAB_OFF = LDSCTL_OFF + 2048;
constexpr int LDS_BYTES = 147456;

__device__ __forceinline__ unsigned f2bf(float f) { unsigned u = __builtin_bit_cast(unsigned, f); return (u + 0x7fffu + ((u >> 16) & 1u)) >> 16; }
__device__ __forceinline__ unsigned pk2(float lo, float hi) { return f2bf(lo) | (f2bf(hi) << 16); }
__device__ __forceinline__ float bf2f(unsigned short b) { return __builtin_bit_cast(float, (unsigned)b << 16); }
__device__ __forceinline__ float bflo(unsigned u) { return __builtin_bit_cast(float, u << 16); }
__device__ __forceinline__ float bfhi(unsigned u) { return __builtin_bit_cast(float, u & 0xffff0000u); }
__device__ __forceinline__ unsigned pkh2(float lo, float hi) { _Float16 a = (_Float16)lo, b = (_Float16)hi; return (unsigned)__builtin_bit_cast(unsigned short, a) | ((unsigned)__builtin_bit_cast(unsigned short, b) << 16); }
__device__ __forceinline__ float h2f(unsigned short h) { return (float)__builtin_bit_cast(_Float16, h); }
__device__ __forceinline__ float silu_f(float v) { return v * __builtin_amdgcn_rcpf(1.f + __expf(-v)); }
__device__ __forceinline__ float wave_sum(float v) {
#pragma unroll
    for (int o = 1; o < 64; o <<= 1) v += __shfl_xor(v, o);
    return v;
}
__device__ __forceinline__ float wave_max(float v) {
#pragma unroll
    for (int o = 1; o < 64; o <<= 1) v = fmaxf(v, __shfl_xor(v, o));
    return v;
}

namespace pg8 {
constexpr int BM = 256, BK = 64, HALF = 128, HTB = HALF * BK * 2, STAGE_BYTES = 8 * HTB, NXCD = 8, WGM = 8;
__host__ __device__ __forceinline__ int lds_byte(int r, int c) { const int st = (r >> 4) * 2 + (c >> 5), rr = r & 15, cc = c & 31, ob = rr * 64 + cc * 2; return st * 1024 + (ob ^ (((ob >> 9) & 1) << 5)); }
__host__ __device__ __forceinline__ void stage_rc(int b, int& R, int& C) { const int st = b / 1024, sb = b % 1024, swz = sb ^ (((sb >> 9) & 1) << 5); R = (st >> 1) * 16 + swz / 64; C = (st & 1) * 32 + (swz % 64) / 2; }
__host__ __device__ __forceinline__ int perm32(int rho) { const int n = rho >> 4, i = rho & 15; return 8 * (i >> 2) + 4 * n + (i & 3); }

struct Unit { int pm, pn, e, tm, cnt; };

typedef float f32x2_t __attribute__((ext_vector_type(2))); typedef __bf16 bf16x2_t __attribute__((ext_vector_type(2)));
__device__ __forceinline__ unsigned cvt_pk_bf16(float lo, float hi) { f32x2_t v = {lo, hi}; bf16x2_t b = __builtin_convertvector(v, bf16x2_t); return __builtin_bit_cast(unsigned, b); }

struct DenseOrder {
    static constexpr bool GATHER = false;
    int nM, nN, nwg, G, c;
    __device__ void init(int M, int N, int G_, int c_) { nM = M / BM; nN = N / BM; nwg = nM * nN; G = G_; c = c_; }
    __device__ bool next(int i, Unit& u) const {
        const long L = (long)i * G + c; if (L >= nwg) return false;
        int wgid = (int)L; { const int q = nwg / NXCD, r = nwg % NXCD, xcd = wgid % NXCD, off = wgid / NXCD; wgid = (xcd < r ? xcd * (q + 1) : r * (q + 1) + (xcd - r) * q) + off; }
        const int nig = WGM * nN, gid = wgid / nig, fm = gid * WGM, gsz = (nM - fm) < WGM ? (nM - fm) : WGM;
        u.pm = fm + ((wgid % nig) % gsz); u.pn = (wgid % nig) / gsz; u.e = 0; u.tm = 0; u.cnt = 0; return true;
    }
    __device__ __forceinline__ int a_row0(const Unit& u) const { return u.pm * BM; }
    __device__ __forceinline__ int a_row(const Unit& u, int r) const { return u.pm * BM + r; }
    __device__ __forceinline__ int b_row0(const Unit& u) const { return u.pn * BM; }
    __device__ __forceinline__ bool perm(const Unit&) const { return false; }
};

template <class Epi, class Sched>
__device__ __forceinline__ void gemm_phase(LAS unsigned char* lds, const bf16_t* Aptr, const bf16_t* Btptr, const int K, const Sched& S, const Epi& E) {
    const int tid = threadIdx.x, wid = __builtin_amdgcn_readfirstlane(tid >> 6), lane = tid & 63, wr = wid >> 2, wc = wid & 3, fr = lane & 15, fq = lane >> 4;
    const int nt = K / BK;
    int sR[2], sC[2];
    unsigned voffA[2], voffBn[2], voffBp[2], voffB[2], nvB[2];
#pragma unroll
    for (int i = 0; i < 2; ++i) { int R, C; stage_rc(tid * 16 + i * 8192, R, C); const int Rb = (R & ~31) + perm32(R & 31);
        sR[i] = R; sC[i] = C; voffA[i] = (unsigned)(R * K + C) * 2u; voffBn[i] = (unsigned)(R * K + C) * 2u; voffBp[i] = (unsigned)(Rb * K + C) * 2u; }
    const size_t kstep = (size_t)(BK * 2);
    const size_t hstep = (size_t)HALF * K * 2;
    const size_t rowb = (size_t)K * 2;
    const unsigned ldsw = (unsigned)wid * 1024u;
    const int aoff = lds_byte(wr * 64 + fr, fq * 8), boff = lds_byte(wc * 32 + fr, fq * 8);
    const char* Ab = (const char*)Aptr;
#define PG8_SA(b, h) (((b) * 2 + (h)) * HTB)
#define PG8_SB(b, h) ((4 + (b) * 2 + (h)) * HTB)
#define PG8_STAGE(bufoff, gbase, voff) do { _Pragma("unroll") for (int _i = 0; _i < 2; ++_i) \
        __builtin_amdgcn_global_load_lds((const unsigned*)((const char*)(gbase) + (voff)[_i]), (LAS unsigned*)(lds + (bufoff) + ldsw + _i * 8192), 16, 0, 0); } while (0)
#define PG8_LDA(dst, b, h) do { _Pragma("unroll") for (int m = 0; m < 4; ++m) _Pragma("unroll") for (int k = 0; k < 2; ++k) dst[m][k] = *(const LAS bf16x8*)(lds + PG8_SA(b, h) + aoff + m * 2048 + k * 1024); } while (0)
#define PG8_LDB(dst, b, h) do { _Pragma("unroll") for (int n = 0; n < 2; ++n) _Pragma("unroll") for (int k = 0; k < 2; ++k) dst[n][k] = *(const LAS bf16x8*)(lds + PG8_SB(b, h) + boff + n * 2048 + k * 1024); } while (0)
#define PG8_MMA(ai, bj, At, Bt) do { __builtin_amdgcn_s_setprio(1); _Pragma("unroll") for (int m = 0; m < 4; ++m) _Pragma("unroll") for (int n = 0; n < 2; ++n) _Pragma("unroll") for (int k = 0; k < 2; ++k) \
        acc[ai][bj][m][n] = __builtin_amdgcn_mfma_f32_16x16x32_bf16(Bt[n][k], At[m][k], acc[ai][bj][m][n], 0, 0, 0); __builtin_amdgcn_s_setprio(0); } while (0)
#define PG8_WAIT_V(n) asm volatile("s_waitcnt vmcnt(" #n ")" ::: "memory")
#define PG8_WAIT_L(n) asm volatile("s_waitcnt lgkmcnt(" #n ")" ::: "memory")
#define PG8_BAR __builtin_amdgcn_s_barrier()
#define PG8_SCHED __builtin_amdgcn_sched_barrier(0)
    Unit cur, nxt; int ui = 0;
    if (!S.next(0, cur)) return;
    f32x4 acc[2][2][4][2];
#pragma unroll
    for (int a = 0; a < 2; ++a)
#pragma unroll
        for (int b = 0; b < 2; ++b)
#pragma unroll
            for (int m = 0; m < 4; ++m)
#pragma unroll
                for (int n = 0; n < 2; ++n) acc[a][b][m][n] = (f32x4){0.f, 0.f, 0.f, 0.f};
    bf16x8 At[4][2], B0[2][2], B1[2][2];
    const char* cA = Ab; unsigned cG[2][2];
    if constexpr (Sched::GATHER) {
#pragma unroll
        for (int h = 0; h < 2; ++h)
#pragma unroll
            for (int i = 0; i < 2; ++i) cG[h][i] = (unsigned)((size_t)S.a_row(cur, h * HALF + sR[i]) * rowb) + (unsigned)sC[i] * 2u;
    } else { cA = Ab + (ptrdiff_t)S.a_row0(cur) * (ptrdiff_t)rowb; cG[0][0] = cG[0][1] = cG[1][0] = cG[1][1] = 0u; }
    const char* cB = (const char*)Btptr + (ptrdiff_t)S.b_row0(cur) * (ptrdiff_t)rowb;
    { const bool pc = S.perm(cur); voffB[0] = pc ? voffBp[0] : voffBn[0]; voffB[1] = pc ? voffBp[1] : voffBn[1]; }
#define PG8_STAGEA(bufoff, h, dbase, goffs, kb) do { if constexpr (Sched::GATHER) { PG8_STAGE(bufoff, Ab + (kb), (goffs)[h]); } else { PG8_STAGE(bufoff, (dbase) + (h) * hstep + (kb), voffA); } } while (0)
    PG8_STAGE(PG8_SB(0, 0), cB, voffB); PG8_STAGE(PG8_SB(0, 1), cB + hstep, voffB); PG8_STAGEA(PG8_SA(0, 0), 0, cA, cG, 0); PG8_STAGEA(PG8_SA(0, 1), 1, cA, cG, 0);
    if (wr == 1) PG8_BAR;
    PG8_WAIT_V(2); PG8_BAR;
    PG8_STAGE(PG8_SB(1, 0), cB + kstep, voffB); PG8_STAGEA(PG8_SA(1, 0), 0, cA, cG, kstep); PG8_STAGE(PG8_SB(1, 1), cB + hstep + kstep, voffB);
    PG8_WAIT_V(6); PG8_BAR;
    for (;;) {
        const bool has_next = S.next(ui + 1, nxt);
        const char* nA = cA; const char* nB = cB; unsigned nG[2][2];
#pragma unroll
        for (int h = 0; h < 2; ++h)
#pragma unroll
            for (int i = 0; i < 2; ++i) nG[h][i] = cG[h][i];
        nvB[0] = voffB[0]; nvB[1] = voffB[1];
        if (has_next) {
            nB = (const char*)Btptr + (ptrdiff_t)S.b_row0(nxt) * (ptrdiff_t)rowb;
            { const bool pn_ = S.perm(nxt); nvB[0] = pn_ ? voffBp[0] : voffBn[0]; nvB[1] = pn_ ? voffBp[1] : voffBn[1]; }
            if constexpr (Sched::GATHER) {
#pragma unroll
                for (int h = 0; h < 2; ++h)
#pragma unroll
                    for (int i = 0; i < 2; ++i) nG[h][i] = (unsigned)((size_t)S.a_row(nxt, h * HALF + sR[i]) * rowb) + (unsigned)sC[i] * 2u;
            } else nA = Ab + (ptrdiff_t)S.a_row0(nxt) * (ptrdiff_t)rowb;
        }
        for (int t = 0; t < nt; t += 2) {
            const bool last = (t == nt - 2);
            const size_t kb1 = (size_t)(t + 1) * kstep;
            const size_t kb2 = last ? 0 : (size_t)(t + 2) * kstep, kb3 = kb2 + kstep;
            const char* a2 = last ? nA : cA; const char* b2 = last ? nB : cB + (size_t)(t + 2) * kstep; const char* b3 = b2 + kstep;
            unsigned vB2[2]; vB2[0] = last ? nvB[0] : voffB[0]; vB2[1] = last ? nvB[1] : voffB[1];
            unsigned g2[2][2];
#pragma unroll
            for (int h = 0; h < 2; ++h)
#pragma unroll
                for (int i = 0; i < 2; ++i) g2[h][i] = last ? nG[h][i] : cG[h][i];
            PG8_LDB(B0, 0, 0); PG8_LDB(B1, 0, 1); PG8_SCHED; PG8_LDA(At, 0, 0); PG8_STAGEA(PG8_SA(1, 1), 1, cA, cG, kb1);
            PG8_WAIT_V(8); PG8_WAIT_L(0); PG8_BAR; PG8_MMA(0, 0, At, B0); PG8_MMA(0, 1, At, B1); PG8_BAR; PG8_SCHED;
            PG8_LDA(At, 0, 1); PG8_STAGE(PG8_SB(0, 0), b2, vB2); PG8_STAGE(PG8_SB(0, 1), b2 + hstep, vB2); PG8_STAGEA(PG8_SA(0, 0), 0, a2, g2, kb2);
            PG8_WAIT_V(8); PG8_WAIT_L(0); PG8_BAR; PG8_MMA(1, 0, At, B0); PG8_MMA(1, 1, At, B1); PG8_BAR; PG8_SCHED;
            PG8_LDB(B0, 1, 0); PG8_LDB(B1, 1, 1); PG8_SCHED; PG8_LDA(At, 1, 0); PG8_STAGEA(PG8_SA(0, 1), 1, a2, g2, kb2);
            PG8_WAIT_V(8); PG8_WAIT_L(0); PG8_BAR; PG8_MMA(0, 0, At, B0); PG8_MMA(0, 1, At, B1); PG8_BAR; PG8_SCHED;
            PG8_LDA(At, 1, 1); PG8_STAGE(PG8_SB(1, 0), b3, vB2); PG8_STAGE(PG8_SB(1, 1), b3 + hstep, vB2); PG8_STAGEA(PG8_SA(1, 0), 0, a2, g2, kb3);
            PG8_WAIT_V(8); PG8_WAIT_L(0); PG8_BAR; PG8_MMA(1, 0, At, B0); PG8_MMA(1, 1, At, B1); PG8_BAR; PG8_SCHED;
        }
        if (wr == 0) PG8_BAR;
        E(acc, cur, wr, wc, fr, fq);
        if (!has_next) break;
#pragma unroll
        for (int a = 0; a < 2; ++a)
#pragma unroll
            for (int b = 0; b < 2; ++b)
#pragma unroll
                for (int m = 0; m < 4; ++m)
#pragma unroll
                    for (int n = 0; n < 2; ++n) acc[a][b][m][n] = (f32x4){0.f, 0.f, 0.f, 0.f};
        cur = nxt; cA = nA; cB = nB; ++ui; voffB[0] = nvB[0]; voffB[1] = nvB[1];
#pragma unroll
        for (int h = 0; h < 2; ++h)
#pragma unroll
            for (int i = 0; i < 2; ++i) cG[h][i] = nG[h][i];
        if (wr == 1) PG8_BAR;
    }
    PG8_WAIT_V(0);
    PG8_BAR;
#undef PG8_SA
#undef PG8_SB
#undef PG8_STAGE
#undef PG8_STAGEA
#undef PG8_LDA
#undef PG8_LDB
#undef PG8_MMA
#undef PG8_WAIT_V
#undef PG8_WAIT_L
#undef PG8_BAR
#undef PG8_SCHED
}
}

#define XB_TMO      128
#define XB_XCNT(j)  (256  + 64 * (j))
#define XB_XSUB(j)  (1280 + 64 * (j))
#define XB_XGEN(j)  (2304 + 64 * (j))
#define XB_TOP      3328
#define XB_TOPGEN   3392
#define XCD_BAR_WORDS 3456
#define XB_SPIN_CAP (1u << 18)
__device__ __forceinline__ unsigned xb_ld(unsigned* p)              { return __hip_atomic_load(p, __ATOMIC_RELAXED, __HIP_MEMORY_SCOPE_AGENT); }
__device__ __forceinline__ unsigned xb_add(unsigned* p, unsigned v) { return __hip_atomic_fetch_add(p, v, __ATOMIC_RELAXED, __HIP_MEMORY_SCOPE_AGENT); }
__device__ __forceinline__ unsigned xb_xcc_id() { return (unsigned)__builtin_amdgcn_s_getreg((3 << 11) | 20) & 0xFu; }
#define XB_SPIN(cond, bar) do { unsigned _sp = 0; while (cond) { __builtin_amdgcn_s_sleep(1); \
    if ((++_sp & 255u) == 0u) { if (xb_ld(&(bar)[XB_TMO])) break; if (_sp > XB_SPIN_CAP) { atomicAdd(&(bar)[XB_TMO], 1u); break; } } } } while (0)
struct XcdBarrier { unsigned* bar; unsigned x; volatile LAS unsigned* st; };
__device__ __forceinline__ XcdBarrier xcd_barrier_post(unsigned* bar, volatile LAS unsigned* st) {
    XcdBarrier b; b.bar = bar; b.x = xb_xcc_id(); b.st = st;
    if (threadIdx.x == 0) (void)xb_add(&bar[XB_XCNT(b.x)], 1u);
    return b;
}
__device__ __forceinline__ void xcd_barrier_complete(unsigned* bar, unsigned x, unsigned& nloc, unsigned& nx) {
    const unsigned G = gridDim.x * gridDim.y * gridDim.z;
    unsigned sum, cnt, mine, sp = 0u;
    for (;;) {
        sum = 0u; cnt = 0u; mine = 0u;
#pragma unroll
        for (unsigned j = 0; j < 16; ++j) { const unsigned c = xb_ld(&bar[XB_XCNT(j)]); sum += c; cnt += (c > 0u) ? 1u : 0u; mine = (j == x) ? c : mine; }
        if (sum == G) break;
        __builtin_amdgcn_s_sleep(1);
        if ((++sp & 255u) == 0u) { if (xb_ld(&bar[XB_TMO])) break; if (sp > XB_SPIN_CAP) { atomicAdd(&bar[XB_TMO], 1u); break; } }
    }
    nloc = mine > 0u ? mine : 1u; nx = cnt > 0u ? cnt : 1u;
}
__device__ __forceinline__ void xcd_barrier(const XcdBarrier& b) {
    asm volatile("s_waitcnt vmcnt(0)" ::: "memory");
    __syncthreads();
    if (threadIdx.x == 0) {
        unsigned* bar = b.bar;
        __builtin_amdgcn_s_waitcnt(0);
        unsigned nloc = b.st[0], nx = b.st[1];
        if (nloc == 0u) { xcd_barrier_complete(bar, b.x, nloc, nx); b.st[0] = nloc; b.st[1] = nx; }
        const unsigned old = xb_add(&bar[XB_XSUB(b.x)], 1u);
        const unsigned gen = old / nloc;
        if (old + 1u == (gen + 1u) * nloc) {
            __builtin_amdgcn_fence(__ATOMIC_RELEASE, "agent");
            asm volatile("s_waitcnt vmcnt(0)" ::: "memory");
            const unsigned og = xb_add(&bar[XB_TOP], 1u);
            const unsigned tg = og / nx;
            if (og + 1u == (tg + 1u) * nx) xb_add(&bar[XB_TOPGEN], 1u);
            else XB_SPIN(xb_ld(&bar[XB_TOPGEN]) == tg, bar);
            __builtin_amdgcn_fence(__ATOMIC_ACQUIRE, "agent");
            xb_add(&bar[XB_XGEN(b.x)], 1u);
            asm volatile("s_waitcnt vmcnt(0)" ::: "memory");
        } else {
            XB_SPIN(xb_ld(&bar[XB_XGEN(b.x)]) == gen, bar);
            __builtin_amdgcn_fence(__ATOMIC_ACQUIRE, "agent");
            asm volatile("s_waitcnt vmcnt(0)" ::: "memory");
        }
    }
    __syncthreads();
}

using pg8::Unit;
typedef f32x4 acc_t[2][2][4][2];

struct EpiProj {
    static constexpr bool PERM = false;
    unsigned char* ws; const LAS float* ropeL; const LAS float* lbtL; int skip;
    __device__ __forceinline__ void operator()(const acc_t& acc, const Unit& u, int wr, int wc, int fr, int fq) const {
        const int seg = u.pn >> 1; const bool latent = u.pm < (T / 256);
        if (skip) return;
        if (!latent && (seg == 0 || seg == 3 || seg == 7)) return;
        if (u.e) {
            const size_t soff[8] = {0, 0, WS_V, WS_HQ, WS_HI, WS_LF, WS_LB, 0};
            size_t so2 = soff[2];
#pragma unroll
            for (int q = 3; q < 7; ++q) so2 = (seg == q) ? soff[q] : so2;
            bf16* dT = (bf16*)(ws + so2);
            const int ldt = (seg == 3) ? T : MROWS;
            const int wrow0 = (u.pn & 1) * 256 + wr * 64 + fr, tcol0 = u.pm * 256 + wc * 32 + 8 * fq;
            const LAS float* lbt = lbtL + (seg == 6 ? 512 : 0);
#pragma unroll
            for (int ai = 0; ai < 2; ++ai)
#pragma unroll
                for (int m = 0; m < 4; ++m) { const int wrow = wrow0 + ai * 128 + m * 16; const float lb = (seg >= 5) ? lbt[wrow] : 0.f;
#pragma unroll
                    for (int bj = 0; bj < 2; ++bj) { float x[8]; u32x4 w;
#pragma unroll
                        for (int j = 0; j < 4; ++j) { x[j] = acc[ai][bj][m][0][j]; x[4 + j] = acc[ai][bj][m][1][j]; }
                        if (seg >= 5) {
#pragma unroll
                            for (int j = 0; j < 8; ++j) { const float sg = __builtin_amdgcn_rcpf(1.f + __expf(-x[j])); x[j] = __log2f(lb + (1.f - lb) * sg); }
                            w = (u32x4){pkh2(x[0], x[1]), pkh2(x[2], x[3]), pkh2(x[4], x[5]), pkh2(x[6], x[7])}; }
                        else { if (seg == 3) {
#pragma unroll
                                for (int j = 0; j < 8; ++j) x[j] = silu_f(x[j]); }
                            w = (u32x4){pg8::cvt_pk_bf16(x[0], x[1]), pg8::cvt_pk_bf16(x[2], x[3]), pg8::cvt_pk_bf16(x[4], x[5]), pg8::cvt_pk_bf16(x[6], x[7])}; }
                        size_t off = (size_t)wrow * ldt + tcol0 + bj * 128;
                        if (seg == 2) { const int tc = tcol0 + bj * 128, bb_ = latent ? (tc >> 11) : ((tc - T) >> 8), tl = latent ? (tc & (SEQ - 1)) : (KTOK - LC + ((tc - T) & (LC - 1)));
                            off = ((((size_t)(bb_ * NAH + (wrow >> 6)) * (KTOK / 64) + (tl >> 6)) * NAD + (wrow & 63)) * 64) + (tl & 63); }
                        *(u32x4*)(dT + off) = w; } }
            return;
        }
        const int row0 = u.pm * 256 + wr * 64 + fr;
        const int lcp = (u.pn & 1) * 256 + wc * 32 + 8 * fq;
        if (seg <= 1) {
            bf16* dK = (bf16*)(ws + (seg == 0 ? WS_QR : WS_K)); bf16* dQ = (bf16*)(ws + WS_Q);
#pragma unroll
            for (int ai = 0; ai < 2; ++ai)
#pragma unroll
                for (int m = 0; m < 4; ++m) { const int row = row0 + ai * 128 + m * 16, sq = row & (SEQ - 1); const int pos = (wc & 1) ? (sq & 63) : (sq >> 6);
                    f32x4 cs0 = (f32x4){1.f, 0.f, 1.f, 0.f}, cs1 = cs0;
                    if (latent) { cs0 = *(const LAS f32x4*)(ropeL + (pos * 16 + 4 * fq) * 2); cs1 = *(const LAS f32x4*)(ropeL + (pos * 16 + 4 * fq) * 2 + 4); }
                    const float cc[4] = {cs0[0], cs0[2], cs1[0], cs1[2]}, sn[4] = {cs0[1], cs0[3], cs1[1], cs1[3]};
#pragma unroll
                    for (int bj = 0; bj < 2; ++bj) { const f32x4 x1 = acc[ai][bj][m][0], x2 = acc[ai][bj][m][1]; float o1[4], o2[4];
#pragma unroll
                        for (int j = 0; j < 4; ++j) { o1[j] = x1[j] * cc[j] - x2[j] * sn[j]; o2[j] = x2[j] * cc[j] + x1[j] * sn[j]; }
                        size_t off = (size_t)row * SEGW + lcp + bj * 128;
                        if (seg == 0) *(u32x4*)(dQ + off) = (u32x4){pg8::cvt_pk_bf16(x1[0], x1[1]), pg8::cvt_pk_bf16(x1[2], x1[3]), pg8::cvt_pk_bf16(x2[0], x2[1]), pg8::cvt_pk_bf16(x2[2], x2[3])};
                        else { const int cf = lcp + bj * 128, bb_ = latent ? (row >> 11) : ((row - T) >> 8), tl = latent ? sq : (KTOK - LC + ((row - T) & (LC - 1)));
                            off = ((size_t)(bb_ * NAH + (cf >> 6)) * KTOK + tl) * NAD + (cf & 63); }
                        *(u32x4*)(dK + off) = (u32x4){pg8::cvt_pk_bf16(o1[0], o1[1]), pg8::cvt_pk_bf16(o1[2], o1[3]), pg8::cvt_pk_bf16(o2[0], o2[1]), pg8::cvt_pk_bf16(o2[2], o2[3])}; } }
            return;
        }
        bf16* dG = (bf16*)(ws + WS_G);
#pragma unroll
        for (int ai = 0; ai < 2; ++ai)
#pragma unroll
            for (int m = 0; m < 4; ++m) { const int row = row0 + ai * 128 + m * 16;
#pragma unroll
                for (int bj = 0; bj < 2; ++bj) { float x[8];
#pragma unroll
                    for (int j = 0; j < 4; ++j) { x[j] = silu_f(acc[ai][bj][m][0][j]); x[4 + j] = silu_f(acc[ai][bj][m][1][j]); }
                    *(u32x4*)(dG + (size_t)row * SEGW + lcp + bj * 128) = (u32x4){pg8::cvt_pk_bf16(x[0], x[1]), pg8::cvt_pk_bf16(x[2], x[3]), pg8::cvt_pk_bf16(x[4], x[5]), pg8::cvt_pk_bf16(x[6], x[7])}; } }
    }
};
struct EpiRes {
    static constexpr bool PERM = false;
    const float* x; float* x1; const float* mod;
    __device__ __forceinline__ void operator()(const acc_t& acc, const Unit& u, int wr, int wc, int fr, int fq) const {
        const int b = u.pm >> 3; const int col0 = u.pn * 256 + wc * 32 + 4 * fq; const int row0 = u.pm * 256 + wr * 64 + fr;
#pragma unroll
        for (int bj = 0; bj < 2; ++bj)
#pragma unroll
            for (int n = 0; n < 2; ++n) { const int col = col0 + bj * 128 + n * 16; const f32x4 ga = *(const f32x4*)(mod + b * 6144 + 2048 + col);
#pragma unroll
                for (int ai = 0; ai < 2; ++ai)
#pragma unroll
                    for (int m = 0; m < 4; ++m) { const size_t off = (size_t)(row0 + ai * 128 + m * 16) * D + col;
                        const f32x4 xv = *(const f32x4*)(x + off); *(f32x4*)(x1 + off) = xv + ga * acc[ai][bj][m][n]; } }
    }
};
struct EpiSwiGLU {
    static constexpr bool PERM = true;
    bf16* H;
    __device__ __forceinline__ void operator()(const acc_t& acc, const Unit& u, int wr, int wc, int fr, int fq) const {
        const int hc = u.pn * 128 + wc * 32 + 8 * fq; const int row0 = u.pm * 256 + wr * 64 + fr;
#pragma unroll
        for (int ai = 0; ai < 2; ++ai)
#pragma unroll
            for (int m = 0; m < 4; ++m) { float h[8];
#pragma unroll
                for (int n = 0; n < 2; ++n)
#pragma unroll
                    for (int j = 0; j < 4; ++j) h[n * 4 + j] = silu_f(acc[ai][0][m][n][j]) * acc[ai][1][m][n][j];
                u32x4 w; w.x = pg8::cvt_pk_bf16(h[0], h[1]); w.y = pg8::cvt_pk_bf16(h[2], h[3]); w.z = pg8::cvt_pk_bf16(h[4], h[5]); w.w = pg8::cvt_pk_bf16(h[6], h[7]);
                *(u32x4*)(H + (size_t)(row0 + ai * 128 + m * 16) * DE + hc) = w; }
    }
};
struct EpiMoeOut {
    static constexpr bool PERM = true;
    bf16* Y; const int* elist; const float* ewt;
    __device__ __forceinline__ void operator()(const acc_t& acc, const Unit& u, int wr, int wc, int fr, int fq) const {
        const int col0 = u.pn * 256 + wc * 32 + 8 * fq;
#pragma unroll
        for (int ai = 0; ai < 2; ++ai)
#pragma unroll
            for (int m = 0; m < 4; ++m) { const int rank = u.tm * 256 + ai * 128 + wr * 64 + m * 16 + fr;
                if (rank < u.cnt) { const int tk = elist[u.e * ECAP + rank]; const float w = ewt[u.e * ECAP + rank];
#pragma unroll
                    for (int bj = 0; bj < 2; ++bj) { const f32x4 v0 = acc[ai][bj][m][0] * w, v1 = acc[ai][bj][m][1] * w; u32x4 o;
                        o.x = pg8::cvt_pk_bf16(v0[0], v0[1]); o.y = pg8::cvt_pk_bf16(v0[2], v0[3]); o.z = pg8::cvt_pk_bf16(v1[0], v1[1]); o.w = pg8::cvt_pk_bf16(v1[2], v1[3]);
                        *(u32x4*)(Y + (size_t)tk * D + col0 + bj * 128) = o; } } }
    }
};
template <bool GATHER_> struct MoeOrder {
    static constexpr bool GATHER = GATHER_;
    const LAS int* tp; const int* elist; int G, c, nwg;
    __device__ bool next(int i, Unit& u) const {
        const long L = (long)i * G + c; if (L >= nwg) return false;
        int wgid = (int)L; { const int q = nwg / 8, r = nwg % 8, xcd = wgid % 8, off = wgid / 8; wgid = (xcd < r ? xcd * (q + 1) : r * (q + 1) + (xcd - r) * q) + off; }
        const int gt = wgid >> 2; int e = 0;
#pragma unroll
        for (int k = 1; k < 16; ++k) e = (gt >= tp[k]) ? k : e;
        u.pm = gt; u.pn = wgid & 3; u.e = e; u.tm = gt - tp[e]; u.cnt = tp[17 + e]; return true;
    }
    __device__ __forceinline__ int a_row0(const Unit& u) const { return u.pm * 256; }
    __device__ __forceinline__ int a_row(const Unit& u, int r) const {
        if constexpr (GATHER_) { int rank = u.tm * 256 + r; rank = rank < u.cnt ? rank : u.cnt - 1; return elist[u.e * ECAP + rank] >> 1; }
        else return u.pm * 256 + r;
    }
    __device__ __forceinline__ int b_row0(const Unit& u) const { return u.e * 1024 + u.pn * 256; }
    __device__ __forceinline__ bool perm(const Unit&) const { return true; }
};


constexpr int SWMASK = 0x7C;
constexpr int W_REL_XN = (int)(((long long)WS_WINT - (long long)WS_XN) / 2048);
struct ProjOrder {
    static constexpr bool GATHER = false;
    pg8::DenseOrder d;
    __device__ void init(int G_, int c_) { d.init(MROWS, INCOLS, G_, c_); }
    __device__ bool next(int i, Unit& u) const { if (!d.next(i, u)) return false; u.e = (SWMASK >> (u.pn >> 1)) & 1; return true; }
    __device__ __forceinline__ int a_row0(const Unit& u) const { return u.e ? W_REL_XN + u.pn * 256 : u.pm * 256; }
    __device__ __forceinline__ int a_row(const Unit& u, int r) const { return a_row0(u) + r; }
    __device__ __forceinline__ int b_row0(const Unit& u) const { return u.e ? -W_REL_XN + u.pm * 256 : u.pn * 256; }
    __device__ __forceinline__ bool perm(const Unit& u) const { return (u.pn >> 1) >= 2; }
};


__device__ __forceinline__ bf16x8 pack8(const f32x4& a, const f32x4& b) {
    u32x4 w; w.x = pg8::cvt_pk_bf16(a[0], a[1]); w.y = pg8::cvt_pk_bf16(a[2], a[3]); w.z = pg8::cvt_pk_bf16(b[0], b[1]); w.w = pg8::cvt_pk_bf16(b[2], b[3]);
    return __builtin_bit_cast(bf16x8, w);
}
typedef unsigned bu4 __attribute__((__vector_size__(16)));
__device__ __forceinline__ bf16x8 bload16(__amdgpu_buffer_rsrc_t r, unsigned voff, unsigned soff) { return __builtin_bit_cast(bf16x8, __builtin_amdgcn_raw_buffer_load_b128(r, (int)voff, (int)soff, 0)); }
#define NA_SB() __builtin_amdgcn_sched_barrier(0)
__device__ __forceinline__ bf16x8 sel8(bool c, const bf16x8 a, const bf16x8 b) { const u32x4 x = __builtin_bit_cast(u32x4, a), y = __builtin_bit_cast(u32x4, b); u32x4 r;
    r.x = c ? x.x : y.x; r.y = c ? x.y : y.y; r.z = c ? x.z : y.z; r.w = c ? x.w : y.w; return __builtin_bit_cast(bf16x8, r); }
__device__ __forceinline__ void na_row(int b, int h, int r, const bf16* Q, const bf16* QR, __amdgpu_buffer_rsrc_t srdK, __amdgpu_buffer_rsrc_t srdV, bf16* MIX, const LAS float* rpbL, LAS unsigned char* qL, int lane) {
    const int qi = lane & 15, g = lane >> 4, rg = qi >> 2;
    constexpr float SC = 0.125f * 1.44269504f; const float NEG = -1e30f;
    int rs = r - 4; rs = rs < 0 ? 0 : (rs > NROWS - 8 ? NROWS - 8 : rs);
    const int tok0 = b * SEQ + r * GW;
    const unsigned klane = (unsigned)((8 * rg + (qi & 3)) * NAD + 8 * g) * 2u;
    const unsigned vlane = (unsigned)(qi * 64 + 8 * g) * 2u;
    const bool selK1 = (rg == 0), selK2 = (rg != 3), selV1 = (g == 0), selV2 = (g != 3);
#define NA_P0(j) ((j) == 0 ? 0 : (j) == 1 ? 1 : (j) == 2 ? 3 : 4)
#define NA_BB(j) (8 * (NA_P0(j) + ((g - NA_P0(j)) & 3)) - (16 * (j) + qi) + 31)
#define NA_LO(j) (((j) == 0 ? (qi < 8 ? 31 - qi : 23) : (j) == 3 ? (qi > 8 ? 31 - qi : 23) : 23) - NA_BB(j))
    f32x4 o[4][4]; float mref[4], lsum[4];
#pragma unroll
    for (int j = 0; j < 4; ++j) { mref[j] = 0.f; lsum[j] = 0.f;
#pragma unroll
        for (int dt = 0; dt < 4; ++dt) o[j][dt] = (f32x4){0.f, 0.f, 0.f, 0.f}; }
    bf16x8 kf[2][2][2], vf[2][4], Bp[4];
    LAS bf16x8* qs = (LAS bf16x8*)qL + lane;
#pragma unroll
    for (int j = 0; j < 4; ++j) { const bf16* qp = QR + (size_t)(tok0 + 16 * j + qi) * SEGW + h * NAD + 8 * g; qs[(2 * j) * 64] = *(const bf16x8*)qp; qs[(2 * j + 1) * 64] = *(const bf16x8*)(qp + 32); }
    const unsigned bh = (unsigned)(b * NAH + h);
    const unsigned ks0 = (bh * KTOK + (unsigned)(rs * GW)) * (NAD * 2u), vs0 = (bh * (KTOK / 64) + (unsigned)rs) * (NAD * 64 * 2u);
#define NA_KLD(so) do { _Pragma("unroll") for (int H = 0; H < 2; ++H) _Pragma("unroll") for (int m = 0; m < 2; ++m) _Pragma("unroll") for (int k = 0; k < 2; ++k) \
        kf[H][m][k] = bload16(srdK, klane, (so) + (unsigned)(H * 32 * NAD * 2 + m * 4 * NAD * 2 + k * 64)); } while (0)
#define NA_VLD(so) do { _Pragma("unroll") for (int H = 0; H < 2; ++H) _Pragma("unroll") for (int dt = 0; dt < 4; ++dt) \
        vf[H][dt] = bload16(srdV, vlane, (so) + (unsigned)(H * 64) + (unsigned)dt * (16 * 64 * 2)); } while (0)
    NA_KLD(ks0); NA_VLD(vs0);
    const LAS float* bp0 = rpbL + (h * 15 + rs - r + 7) * 64;
#pragma unroll 1
    for (int i = 0; i < 8; ++i) {
        const LAS float* bpi = bp0 + i * 64;
        NA_SB();
#pragma unroll
        for (int j = 0; j < 4; ++j) {
            f32x4 s0, s1; const bf16x8 q0 = qs[(2 * j) * 64], q1 = qs[(2 * j + 1) * 64];
            { const bf16x8 a00 = (j == 0) ? kf[0][0][0] : (j == 3) ? kf[1][0][0] : sel8(j == 1 ? selK1 : selK2, kf[1][0][0], kf[0][0][0]);
              const bf16x8 a01 = (j == 0) ? kf[0][0][1] : (j == 3) ? kf[1][0][1] : sel8(j == 1 ? selK1 : selK2, kf[1][0][1], kf[0][0][1]);
              const bf16x8 a10 = (j == 0) ? kf[0][1][0] : (j == 3) ? kf[1][1][0] : sel8(j == 1 ? selK1 : selK2, kf[1][1][0], kf[0][1][0]);
              const bf16x8 a11 = (j == 0) ? kf[0][1][1] : (j == 3) ? kf[1][1][1] : sel8(j == 1 ? selK1 : selK2, kf[1][1][1], kf[0][1][1]);
              s0 = __builtin_amdgcn_mfma_f32_16x16x32_bf16(a00, q0, (f32x4){0.f, 0.f, 0.f, 0.f}, 0, 0, 0); s0 = __builtin_amdgcn_mfma_f32_16x16x32_bf16(a01, q1, s0, 0, 0, 0);
              s1 = __builtin_amdgcn_mfma_f32_16x16x32_bf16(a10, q0, (f32x4){0.f, 0.f, 0.f, 0.f}, 0, 0, 0); s1 = __builtin_amdgcn_mfma_f32_16x16x32_bf16(a11, q1, s1, 0, 0, 0); }
            const int lo_j = NA_LO(j); const LAS float* bpj = bpi + NA_BB(j);
            { float b0 = bpj[0], b1 = bpj[1], b2 = bpj[2], b3 = bpj[3];
              asm volatile("" : "+v"(b0), "+v"(b1), "+v"(b2), "+v"(b3));
              const float bq[4] = {b0, b1, b2, b3};
#pragma unroll
              for (int e = 0; e < 4; ++e) { const float t0 = s0[e] * SC + bq[e]; s0[e] = ((unsigned)(e - lo_j) < 16u) ? t0 : NEG; } }
            { float b0 = bpj[4], b1 = bpj[5], b2 = bpj[6], b3 = bpj[7];
              asm volatile("" : "+v"(b0), "+v"(b1), "+v"(b2), "+v"(b3));
              const float bq[4] = {b0, b1, b2, b3};
#pragma unroll
              for (int e = 0; e < 4; ++e) { const float t1 = s1[e] * SC + bq[e]; s1[e] = ((unsigned)(4 + e - lo_j) < 16u) ? t1 : NEG; } }
            if (i == 0) { float mx = fmaxf(fmaxf(fmaxf(s0[0], s0[1]), fmaxf(s0[2], s0[3])), fmaxf(fmaxf(s1[0], s1[1]), fmaxf(s1[2], s1[3])));
                mx = fmaxf(mx, __shfl_xor(mx, 16)); mx = fmaxf(mx, __shfl_xor(mx, 32)); mref[j] = mx; }
            float ps = 0.f;
#pragma unroll
            for (int e = 0; e < 4; ++e) { s0[e] = __builtin_amdgcn_exp2f(fminf(s0[e] - mref[j], 100.f)); s1[e] = __builtin_amdgcn_exp2f(fminf(s1[e] - mref[j], 100.f)); ps += s0[e] + s1[e]; }
            lsum[j] += ps; Bp[j] = pack8(s0, s1);
            if (j == 1) { asm volatile("" : "+v"(Bp[0]), "+v"(Bp[1])); NA_SB(); }
        }
        asm volatile("" : "+v"(Bp[0]), "+v"(Bp[1]), "+v"(Bp[2]), "+v"(Bp[3]));
        NA_SB();
        if (i < 7) NA_KLD(ks0 + (unsigned)(i + 1) * (GW * NAD * 2));
        NA_SB();
#pragma unroll
        for (int j = 0; j < 4; ++j) {
#pragma unroll
            for (int dt = 0; dt < 4; ++dt) { const bf16x8 A = (j == 0) ? vf[0][dt] : (j == 3) ? vf[1][dt] : sel8(j == 1 ? selV1 : selV2, vf[1][dt], vf[0][dt]);
                o[j][dt] = __builtin_amdgcn_mfma_f32_16x16x32_bf16(A, Bp[j], o[j][dt], 0, 0, 0); }
            asm volatile("" : "+v"(o[j][0]), "+v"(o[j][1]), "+v"(o[j][2]), "+v"(o[j][3]));
            if (j == 1) NA_SB(); }
        NA_SB();
        if (i < 7) NA_VLD(vs0 + (unsigned)(i + 1) * (NAD * 64 * 2));
    }
#pragma unroll
    for (int j = 0; j < 4; ++j) { const bf16* qp = Q + (size_t)(tok0 + 16 * j + qi) * SEGW + h * NAD + 8 * g; qs[(2 * j) * 64] = *(const bf16x8*)qp; qs[(2 * j + 1) * 64] = *(const bf16x8*)(qp + 32); }
    const unsigned kc0 = (bh * KTOK + (unsigned)SEQ) * (NAD * 2u), vc0 = (bh * (KTOK / 64) + (unsigned)(SEQ / 64)) * (NAD * 64 * 2u);
#define NA_KLDC(so) do { _Pragma("unroll") for (int m = 0; m < 2; ++m) _Pragma("unroll") for (int k = 0; k < 2; ++k) kf[0][m][k] = bload16(srdK, klane, (so) + (unsigned)(m * 4 * NAD * 2 + k * 64)); } while (0)
#define NA_VLDC(so) do { _Pragma("unroll") for (int dt = 0; dt < 4; ++dt) vf[0][dt] = bload16(srdV, vlane, (so) + (unsigned)dt * (16 * 64 * 2)); } while (0)
    NA_KLDC(kc0); NA_VLDC(vc0);
#pragma unroll 1
    for (int i = 0; i < 8; ++i) {
        NA_SB();
#pragma unroll
        for (int j = 0; j < 4; ++j) {
            const bf16x8 q0 = qs[(2 * j) * 64], q1 = qs[(2 * j + 1) * 64];
            f32x4 s0 = __builtin_amdgcn_mfma_f32_16x16x32_bf16(kf[0][0][0], q0, (f32x4){0.f, 0.f, 0.f, 0.f}, 0, 0, 0); s0 = __builtin_amdgcn_mfma_f32_16x16x32_bf16(kf[0][0][1], q1, s0, 0, 0, 0);
            f32x4 s1 = __builtin_amdgcn_mfma_f32_16x16x32_bf16(kf[0][1][0], q0, (f32x4){0.f, 0.f, 0.f, 0.f}, 0, 0, 0); s1 = __builtin_amdgcn_mfma_f32_16x16x32_bf16(kf[0][1][1], q1, s1, 0, 0, 0);
            float ps = 0.f;
#pragma unroll
            for (int e = 0; e < 4; ++e) { s0[e] = __builtin_amdgcn_exp2f(fminf(s0[e] * SC - mref[j], 100.f)); s1[e] = __builtin_amdgcn_exp2f(fminf(s1[e] * SC - mref[j], 100.f)); ps += s0[e] + s1[e]; }
            lsum[j] += ps; Bp[j] = pack8(s0, s1);
        }
        asm volatile("" : "+v"(Bp[0]), "+v"(Bp[1]), "+v"(Bp[2]), "+v"(Bp[3]));
        NA_SB();
        if (i < 7) NA_KLDC(kc0 + (unsigned)(i + 1) * (32 * NAD * 2));
        NA_SB();
#pragma unroll
        for (int j = 0; j < 4; ++j)
#pragma unroll
            for (int dt = 0; dt < 4; ++dt) o[j][dt] = __builtin_amdgcn_mfma_f32_16x16x32_bf16(vf[0][dt], Bp[j], o[j][dt], 0, 0, 0);
#pragma unroll
        for (int j = 0; j < 4; ++j) asm volatile("" : "+v"(o[j][0]), "+v"(o[j][1]), "+v"(o[j][2]), "+v"(o[j][3]));
        NA_SB();
        if (i < 7) NA_VLDC(vc0 + (unsigned)(((i + 1) >> 1) * (NAD * 64 * 2) + ((i + 1) & 1) * 64));
    }
#undef NA_KLD
#undef NA_VLD
#undef NA_KLDC
#undef NA_VLDC
#pragma unroll
    for (int j = 0; j < 4; ++j) { float l = lsum[j]; l += __shfl_xor(l, 16); l += __shfl_xor(l, 32); const float inv = 1.f / l;
        bf16* op = MIX + (size_t)(tok0 + 16 * j + qi) * D + h * NAD + 4 * g;
#pragma unroll
        for (int dt = 0; dt < 4; ++dt) { const f32x4 v = o[j][dt] * inv; *(v2u*)(op + 16 * dt) = (v2u){pg8::cvt_pk_bf16(v[0], v[1]), pg8::cvt_pk_bf16(v[2], v[3])}; } }
}

typedef float f32x16 __attribute__((ext_vector_type(16)));
constexpr int SC_Q1 = 0, SC_K1 = SC_Q1 + 64 * 272, SC_K1T = SC_K1 + 64 * 272, SC_VT = SC_K1T + 128 * 144, SC_AB = SC_VT + 128 * 144, SC_ST = SC_AB + 64 * 144, SC_TOT = SC_ST + 128 * 272, SC_END = SC_TOT + 2 * 4 * 128 * 4;
static_assert(SC_END <= RING_BYTES, "scan LDS");
#define SCAN_MFMA(a, b, c) __builtin_amdgcn_mfma_f32_32x32x16_bf16(a, b, c, 0, 0, 0)
__device__ __forceinline__ void scan_unit(LAS unsigned char* lds, int b, int h, int dir, const unsigned short* LGT, const bf16* HQT, const bf16* HIT, bf16* OUT, int tid) {
    const int lane = tid & 63, w = __builtin_amdgcn_readfirstlane(tid >> 6), r = lane & 31, hh = lane >> 5;
    const int d = tid & 127, tq = tid >> 7;
    const int ti = w >> 2, ovi = w & 3;
    const int di = w >> 1, svi = 2 * (w & 1);
    f32x16 S0, S1;
#pragma unroll
    for (int i = 0; i < 16; ++i) { S0[i] = 0.f; S1[i] = 0.f; }
    const size_t chrow = (size_t)(h * HGD + d);
    constexpr int NCH = (LC + SEQ) / 64;
    auto col_of = [&](int c) -> int { return c < 4 ? (T + b * LC + 64 * (dir ? 3 - c : c)) : (b * SEQ + (dir ? SEQ - 64 * (c - 3) : 64 * (c - 4))); };
    u32x4 lgr[2], vr[2], qr[2];
    { const int c0 = col_of(0) + 16 * tq; lgr[0] = *(const u32x4*)(LGT + chrow * MROWS + c0); lgr[1] = *(const u32x4*)(LGT + chrow * MROWS + c0 + 8);
      vr[0] = *(const u32x4*)(HIT + chrow * MROWS + c0); vr[1] = *(const u32x4*)(HIT + chrow * MROWS + c0 + 8); qr[0] = qr[1] = (u32x4){0u, 0u, 0u, 0u}; }
#pragma unroll 1
    for (int c = 0; c < NCH; ++c) {
        const bool lat = c >= 4; const int par = c & 1;
        LAS float* tot = (LAS float*)(lds + SC_TOT) + par * 512;
        float P[16];
#pragma unroll
        for (int i = 0; i < 8; ++i) { const unsigned u2 = lgr[i >> 2][i & 3]; P[2 * i] = h2f((unsigned short)(u2 & 0xffff)); P[2 * i + 1] = h2f((unsigned short)(u2 >> 16)); }
        float kk[16];
#pragma unroll
        for (int i = 0; i < 16; ++i) kk[i] = 1.f - __builtin_amdgcn_exp2f(P[i]);
        if (!dir) {
#pragma unroll
            for (int i = 1; i < 16; ++i) P[i] += P[i - 1];
            tot[tq * 128 + d] = P[15];
        } else {
#pragma unroll
            for (int i = 14; i >= 0; --i) P[i] += P[i + 1];
            tot[tq * 128 + d] = P[0];
        }
        const u32x4 vcur0 = vr[0], vcur1 = vr[1], qcur0 = qr[0], qcur1 = qr[1];
        if (c + 1 < NCH) { const int c1 = col_of(c + 1) + 16 * tq;
            lgr[0] = *(const u32x4*)(LGT + chrow * MROWS + c1); lgr[1] = *(const u32x4*)(LGT + chrow * MROWS + c1 + 8);
            vr[0] = *(const u32x4*)(HIT + chrow * MROWS + c1); vr[1] = *(const u32x4*)(HIT + chrow * MROWS + c1 + 8);
            if (c + 1 >= 4) { qr[0] = *(const u32x4*)(HQT + chrow * T + c1); qr[1] = *(const u32x4*)(HQT + chrow * T + c1 + 8); } }
        __syncthreads();
        {
            const float t0 = tot[d], t1 = tot[128 + d], t2 = tot[256 + d], t3 = tot[384 + d];
            const float Bm = dir ? (t2 + t3) : (t0 + t1);
            float offs; if (!dir) offs = (tq > 0 ? t0 : 0.f) + (tq > 1 ? t1 : 0.f) + (tq > 2 ? t2 : 0.f); else offs = (tq < 3 ? t3 : 0.f) + (tq < 2 ? t2 : 0.f) + (tq < 1 ? t1 : 0.f);
            const float sh = offs - Bm;
            unsigned kt[8];
            LAS bf16* q1 = (LAS bf16*)(lds + SC_Q1) + (16 * tq) * 136 + d; LAS bf16* k1 = (LAS bf16*)(lds + SC_K1) + (16 * tq) * 136 + d;
#pragma unroll
            for (int i = 0; i < 16; i += 2) {
                const float x0 = fminf(fmaxf(P[i] + sh, -120.f), 120.f), x1 = fminf(fmaxf(P[i + 1] + sh, -120.f), 120.f);
                const float e0 = __builtin_amdgcn_exp2f(x0), e1 = __builtin_amdgcn_exp2f(x1);
                const float k0 = kk[i] * __builtin_amdgcn_exp2f(-x0), k1v = kk[i + 1] * __builtin_amdgcn_exp2f(-x1);
                kt[i >> 1] = pg8::cvt_pk_bf16(k0, k1v);
                if (lat) { const unsigned qq = (i < 8 ? qcur0 : qcur1)[(i >> 1) & 3];
                    const unsigned qp2 = pg8::cvt_pk_bf16(bflo(qq) * e0, bfhi(qq) * e1); q1[i * 136] = (bf16)(qp2 & 0xffff); q1[(i + 1) * 136] = (bf16)(qp2 >> 16);
                    k1[i * 136] = (bf16)(kt[i >> 1] & 0xffff); k1[(i + 1) * 136] = (bf16)(kt[i >> 1] >> 16); }
            }
            LAS unsigned char* k1t = lds + SC_K1T + d * 144 + 32 * tq;
            *(LAS u32x4*)k1t = (u32x4){kt[0], kt[1], kt[2], kt[3]}; *(LAS u32x4*)(k1t + 16) = (u32x4){kt[4], kt[5], kt[6], kt[7]};
            LAS unsigned char* vt = lds + SC_VT + d * 144 + 32 * tq;
            *(LAS u32x4*)vt = vcur0; *(LAS u32x4*)(vt + 16) = vcur1;
        }
        if (lat) {
#pragma unroll
            for (int rg = 0; rg < 4; ++rg) { const int dd = 32 * di + 8 * rg + 4 * hh;
                const f32x4 a0 = *(const LAS f32x4*)(tot + dd), a1 = *(const LAS f32x4*)(tot + 128 + dd), a2 = *(const LAS f32x4*)(tot + 256 + dd), a3 = *(const LAS f32x4*)(tot + 384 + dd);
                const f32x4 bm = dir ? (a2 + a3) : (a0 + a1); float eb[4];
#pragma unroll
                for (int j = 0; j < 4; ++j) eb[j] = __builtin_amdgcn_exp2f(bm[j]);
                *(LAS v2u*)(lds + SC_ST + ((32 * svi + r) * 136 + dd) * 2) = (v2u){pg8::cvt_pk_bf16(S0[4 * rg] * eb[0], S0[4 * rg + 1] * eb[1]), pg8::cvt_pk_bf16(S0[4 * rg + 2] * eb[2], S0[4 * rg + 3] * eb[3])};
                *(LAS v2u*)(lds + SC_ST + ((32 * (svi + 1) + r) * 136 + dd) * 2) = (v2u){pg8::cvt_pk_bf16(S1[4 * rg] * eb[0], S1[4 * rg + 1] * eb[1]), pg8::cvt_pk_bf16(S1[4 * rg + 2] * eb[2], S1[4 * rg + 3] * eb[3])}; }
        }
        __syncthreads();
        f32x16 dS0, dS1, O;
#pragma unroll
        for (int i = 0; i < 16; ++i) { dS0[i] = 0.f; dS1[i] = 0.f; O[i] = 0.f; }
#pragma unroll
        for (int ks = 0; ks < 4; ++ks) {
            const bf16x8 a = *(const LAS bf16x8*)(lds + SC_K1T + ((32 * di + r) * 72 + 16 * ks + 8 * hh) * 2);
            const bf16x8 b0 = *(const LAS bf16x8*)(lds + SC_VT + ((32 * svi + r) * 72 + 16 * ks + 8 * hh) * 2), b1 = *(const LAS bf16x8*)(lds + SC_VT + ((32 * (svi + 1) + r) * 72 + 16 * ks + 8 * hh) * 2);
            dS0 = SCAN_MFMA(a, b0, dS0); dS1 = SCAN_MFMA(a, b1, dS1);
        }
        if (lat) {
#pragma unroll
            for (int ks = 0; ks < 8; ++ks) {
                const bf16x8 a = *(const LAS bf16x8*)(lds + SC_ST + ((32 * ovi + r) * 136 + 16 * ks + 8 * hh) * 2);
                const bf16x8 bq = *(const LAS bf16x8*)(lds + SC_Q1 + ((32 * ti + r) * 136 + 16 * ks + 8 * hh) * 2);
                O = SCAN_MFMA(a, bq, O);
            }
            if (w < 4) {
                const int asi = (w == 0) ? 0 : (w == 1) ? 1 : (w == 2) ? (dir ? 1 : 0) : (dir ? 0 : 1);
                const int ati = (w == 0) ? 0 : (w == 1) ? 1 : (w == 2) ? (dir ? 0 : 1) : (dir ? 1 : 0);
                f32x16 At;
#pragma unroll
                for (int i = 0; i < 16; ++i) At[i] = 0.f;
                if (w < 3) {
#pragma unroll
                    for (int ks = 0; ks < 8; ++ks) {
                        const bf16x8 a = *(const LAS bf16x8*)(lds + SC_K1 + ((32 * asi + r) * 136 + 16 * ks + 8 * hh) * 2);
                        const bf16x8 bq = *(const LAS bf16x8*)(lds + SC_Q1 + ((32 * ati + r) * 136 + 16 * ks + 8 * hh) * 2);
                        At = SCAN_MFMA(a, bq, At);
                    }
                }
                const int tt = 32 * ati + r;
#pragma unroll
                for (int rg = 0; rg < 4; ++rg) { const int s0 = 32 * asi + 8 * rg + 4 * hh; float v[4];
#pragma unroll
                    for (int j = 0; j < 4; ++j) { const int ss = s0 + j; const bool keep = dir ? (ss >= tt) : (ss <= tt); v[j] = keep ? At[4 * rg + j] : 0.f; }
                    *(LAS v2u*)(lds + SC_AB + (tt * 72 + s0) * 2) = (v2u){pg8::cvt_pk_bf16(v[0], v[1]), pg8::cvt_pk_bf16(v[2], v[3])}; }
            }
            __syncthreads();
#pragma unroll
            for (int ks = 0; ks < 4; ++ks) {
                const bf16x8 a = *(const LAS bf16x8*)(lds + SC_VT + ((32 * ovi + r) * 72 + 16 * ks + 8 * hh) * 2);
                const bf16x8 bq = *(const LAS bf16x8*)(lds + SC_AB + ((32 * ti + r) * 72 + 16 * ks + 8 * hh) * 2);
                O = SCAN_MFMA(a, bq, O);
            }
            bf16* op = OUT + (size_t)(col_of(c) + 32 * ti + r) * SEGW + h * HGD + 32 * ovi + 4 * hh;
#pragma unroll
            for (int rg = 0; rg < 4; ++rg) *(v2u*)(op + 8 * rg) = (v2u){pg8::cvt_pk_bf16(O[4 * rg], O[4 * rg + 1]), pg8::cvt_pk_bf16(O[4 * rg + 2], O[4 * rg + 3])};
        }
#pragma unroll
        for (int rg = 0; rg < 4; ++rg) { const int dd = 32 * di + 8 * rg + 4 * hh;
            const f32x4 a0 = *(const LAS f32x4*)(tot + dd), a1 = *(const LAS f32x4*)(tot + 128 + dd), a2 = *(const LAS f32x4*)(tot + 256 + dd), a3 = *(const LAS f32x4*)(tot + 384 + dd);
            const f32x4 be = (a0 + a1) + (a2 + a3), bm = dir ? (a2 + a3) : (a0 + a1);
#pragma unroll
            for (int j = 0; j < 4; ++j) { const float ee = __builtin_amdgcn_exp2f(be[j]), em = __builtin_amdgcn_exp2f(be[j] - bm[j]);
                S0[4 * rg + j] = ee * S0[4 * rg + j] + em * dS0[4 * rg + j]; S1[4 * rg + j] = ee * S1[4 * rg + j] + em * dS1[4 * rg + j]; } }
    }
}


#ifdef DBG_NAIVE
__device__ __forceinline__ void scan_naive(LAS unsigned char* lds, int b, int h, int dir, const unsigned short* LGT, const bf16* HQT, const bf16* HIT, bf16* OUT, int tid) {
    const int dv = tid & 127, kg = tid >> 7;
    float St[32];
#pragma unroll
    for (int i = 0; i < 32; ++i) St[i] = 0.f;
    LAS float* sq = (LAS float*)lds; LAS float* sk = sq + 16 * 128; LAS float* sf = sk + 16 * 128; LAS float* sv = sf + 16 * 128; LAS float* so = sv + 16 * 128;
    constexpr int NSTEP = LC + SEQ;
    for (int j0 = 0; j0 < NSTEP; j0 += 16) {
        const bool isctx = j0 < LC;
        for (int idx = tid; idx < 16 * 128; idx += NTHR) { const int st = idx >> 7, ch = idx & 127, j = j0 + st;
            int col; if (j < LC) col = T + b * LC + (dir ? (LC - 1 - j) : j); else col = b * SEQ + (dir ? (SEQ - 1 - (j - LC)) : (j - LC));
            const size_t cr = (size_t)(h * HGD + ch);
            const float f = __builtin_amdgcn_exp2f(h2f(LGT[cr * MROWS + col]));
            sf[st * 128 + ch] = f; sk[st * 128 + ch] = 1.f - f; sv[st * 128 + ch] = bf2f(HIT[cr * MROWS + col]);
            if (!isctx) sq[st * 128 + ch] = bf2f(HQT[cr * T + col]); }
        __syncthreads();
        for (int st = 0; st < 16; ++st) {
            const float vv = sv[st * 128 + dv]; float o = 0.f;
#pragma unroll
            for (int i = 0; i < 32; ++i) { St[i] = sf[st * 128 + kg * 32 + i] * St[i] + sk[st * 128 + kg * 32 + i] * vv; o += St[i] * sq[st * 128 + kg * 32 + i]; }
            so[(st * 4 + kg) * 128 + dv] = o;
        }
        __syncthreads();
        if (!isctx) {
            for (int idx = tid; idx < 16 * 128; idx += NTHR) { const int st = idx >> 7, dd = idx & 127, j = j0 + st;
                const float o = (so[(st * 4 + 0) * 128 + dd] + so[(st * 4 + 1) * 128 + dd]) + (so[(st * 4 + 2) * 128 + dd] + so[(st * 4 + 3) * 128 + dd]);
                const int row = b * SEQ + (dir ? (SEQ - 1 - (j - LC)) : (j - LC));
                OUT[(size_t)row * SEGW + h * HGD + dd] = (bf16)f2bf(o); }
        }
        __syncthreads();
    }
}
#endif

__device__ __forceinline__ void transpose_item(const float* W, int ldw, int k0, int n0, bf16* WT, int ldk, int drow0, LAS float* scr, int lane) {
#pragma unroll 8
    for (int i = 0; i < 32; ++i) { const int kk = 2 * i + (lane >> 5); scr[kk * 33 + (lane & 31)] = W[(size_t)(k0 + kk) * ldw + n0 + (lane & 31)]; }
    LDS_WAIT(); asm volatile("" ::: "memory");
    const int c = lane & 7;
#pragma unroll
    for (int j = 0; j < 4; ++j) { const int n = (lane >> 3) + 8 * j; const LAS float* s = scr + (8 * c) * 33 + n;
        v4u o; o.x = pk2(s[0 * 33], s[1 * 33]); o.y = pk2(s[2 * 33], s[3 * 33]); o.z = pk2(s[4 * 33], s[5 * 33]); o.w = pk2(s[6 * 33], s[7 * 33]);
        *(GAS v4u*)(WT + (size_t)(drow0 + n) * ldk + k0 + 8 * c) = o; }
    LDS_WAIT(); asm volatile("" ::: "memory");
}

struct Args { const float* in[21]; float* out; unsigned char* ws; int ph_lo, ph_hi, li, pad; };

__global__ void __launch_bounds__(NTHR, 2) fwd_mega(Args args) {
    extern __shared__ __attribute__((aligned(16))) unsigned char lds_raw[];
    LAS unsigned char* lds = (LAS unsigned char*)lds_raw;
    volatile LAS unsigned* MISC = (volatile LAS unsigned*)(lds + MISC_OFF);
    const int tid = threadIdx.x, lane = tid & 63, wave = __builtin_amdgcn_readfirstlane(tid >> 6);
    const int G = gridDim.x; const int bx = blockIdx.x; const int vcu = (G % 8 == 0) ? (bx % 8) * (G / 8) + bx / 8 : bx;
    gu32* ctl0 = (gu32*)(args.ws + WS_CTL);
    const int gw = vcu * NWAVES + wave, NGW = G * NWAVES;
    for (int u = tid; u < (LDS_BYTES - LDSCTL_OFF) / 4; u += NTHR) ((LAS unsigned*)(lds + LDSCTL_OFF))[u] = 0u;
    __syncthreads();
    XcdBarrier bar = xcd_barrier_post((unsigned*)(ctl0 + CW_BAR) + args.li * XCD_BAR_WORDS, MISC + 8);
    const int lo = args.ph_lo, hi = args.ph_hi;
#ifndef PHMASK
#define PHMASK 0xFFFF
#endif
#define IN(k) (((PHMASK >> (k)) & 1) && lo <= (k) && (k) < hi)
#define SEAM(k) do { if (IN(k) && IN((k) + 1)) xcd_barrier(bar); } while (0)

#define KA(i) ({ const __attribute__((address_space(4))) Args* _p = (const __attribute__((address_space(4))) Args*)__builtin_amdgcn_kernarg_segment_ptr(); asm volatile("" : "+s"(_p)); _p->in[i]; })
#define WSP() ({ const __attribute__((address_space(4))) Args* _p = (const __attribute__((address_space(4))) Args*)__builtin_amdgcn_kernarg_segment_ptr(); asm volatile("" : "+s"(_p)); _p->ws; })
#define PHASE_PTRS unsigned char* ws = WSP(); float* MOD = (float*)(ws + WS_MOD); float* ROPE = (float*)(ws + WS_ROPE); float* LBT = (float*)(ws + WS_LBT); \
    bf16* WinT = (bf16*)(ws + WS_WINT); bf16* WoutT = (bf16*)(ws + WS_WOUTT); bf16* W13T = (bf16*)(ws + WS_W13T); bf16* W2T = (bf16*)(ws + WS_W2T); \
    bf16* XN = (bf16*)(ws + WS_XN); bf16* MIX = (bf16*)(ws + WS_MIX); bf16* XN2 = (bf16*)(ws + WS_XN2); \
    float* X1 = (float*)(ws + WS_X1); bf16* Hb = (bf16*)(ws + WS_H); bf16* Yb = (bf16*)(ws + WS_Y); \
    int* ELIST = (int*)(ws + WS_ELIST); float* EWT = (float*)(ws + WS_EWT); gu32* ctl = (gu32*)(ws + WS_CTL); \
    (void)MOD; (void)ROPE; (void)LBT; (void)WinT; (void)WoutT; (void)W13T; (void)W2T; (void)XN; (void)MIX; (void)XN2; (void)X1; (void)Hb; (void)Yb; (void)ELIST; (void)EWT; (void)ctl;
    if (IN(0)) {
        PHASE_PTRS
        const float* cvec = KA(1); const float* c_ctx = KA(3); const float* w_mod = KA(4); const float* b_mod = KA(5); const float* w_in = KA(8); const float* w_out = KA(9);
        const float* hg_lb = KA(11); const float* w1 = KA(17); const float* w3 = KA(18); const float* w2 = KA(19);
        if (bx == G - 1) {
            for (int idx = tid; idx < 1024; idx += NTHR) { const int pos = idx >> 4, i = idx & 15;
                double th = 1.0; for (int k = 0; k < i; ++k) th *= 0.5623413251903491;
                const double t2 = th * th; double c = 1.0, s = th, tc = 1.0, ts = th;
                for (int n = 1; n <= 12; ++n) { tc *= -t2 / (double)((2 * n - 1) * (2 * n)); c += tc; ts *= -t2 / (double)((2 * n) * (2 * n + 1)); s += ts; }
                double cr = 1.0, ci = 0.0; for (int p = 0; p < pos; ++p) { const double nr = cr * c - ci * s; ci = cr * s + ci * c; cr = nr; }
                ROPE[idx * 2] = (float)cr; ROPE[idx * 2 + 1] = (float)ci; }
            for (int idx = tid; idx < 1024; idx += NTHR) { const float h0 = hg_lb[idx], h1 = hg_lb[1024 + idx]; LBT[idx] = 1.f / (1.f + expf(h1 - h0)); }
        }
        if (bx < 96) {
            LAS float* sc = (LAS float*)lds;
            for (int idx = tid; idx < 17 * 1024; idx += NTHR) { const int r = idx >> 10, k = idx & 1023; const float cv = r < 16 ? cvec[r * 1024 + k] : c_ctx[k]; sc[idx] = cv / (1.f + expf(-cv)); }
            __syncthreads();
            const int col = 64 * bx + lane, k0 = 128 * wave;
            float acc[17];
#pragma unroll
            for (int r = 0; r < 17; ++r) acc[r] = 0.f;
            for (int kk = 0; kk < 128; kk += 4) {
                const float w0 = w_mod[(size_t)(k0 + kk) * 6144 + col], w1v = w_mod[(size_t)(k0 + kk + 1) * 6144 + col], w2v = w_mod[(size_t)(k0 + kk + 2) * 6144 + col], w3v = w_mod[(size_t)(k0 + kk + 3) * 6144 + col];
#pragma unroll
                for (int r = 0; r < 17; ++r) { const f32x4 a = *(const LAS f32x4*)(sc + r * 1024 + k0 + kk); acc[r] += a[0] * w0 + a[1] * w1v + a[2] * w2v + a[3] * w3v; }
            }
            LAS float* red = (LAS float*)(lds + 17 * 1024 * 4);
#pragma unroll
            for (int r = 0; r < 17; ++r) red[(wave * 17 + r) * 64 + lane] = acc[r];
            __syncthreads();
            for (int idx = tid; idx < 17 * 64; idx += NTHR) { const int r = idx >> 6, l = idx & 63; float s = 0.f;
#pragma unroll
                for (int w = 0; w < 8; ++w) s += red[(w * 17 + r) * 64 + l];
                MOD[r * 6144 + 64 * bx + l] = s + b_mod[64 * bx + l]; }
            __syncthreads();
        }
        {
            LAS float* scr = (LAS float*)(lds + wave * 16384);
            constexpr int I_IN = 16 * 128, I_OUT = 16 * 32, I_13 = 16 * 2 * 256, I_2 = 16 * 256, NIT = I_IN + I_OUT + I_13 + I_2;
            for (int it = gw; it < NIT; it += NGW) {
                int r = it;
                if (r < I_IN) { const int kb = r / 128, nb = r % 128; transpose_item(w_in, INCOLS, 64 * kb, 32 * nb, WinT, 1024, 32 * nb, scr, lane); continue; } r -= I_IN;
                if (r < I_OUT) { const int kb = r / 32, nb = r % 32; transpose_item(w_out, 1024, 64 * kb, 32 * nb, WoutT, 1024, 32 * nb, scr, lane); continue; } r -= I_OUT;
                if (r < I_13) { const int e = r / 512, rem = r % 512, s = rem / 256, r2 = rem % 256, kb = r2 / 16, nb = r2 % 16, n0 = 32 * nb;
                    transpose_item((s ? w3 : w1) + (size_t)e * 1024 * 512, 512, 64 * kb, n0, W13T, 1024, e * 1024 + 256 * (n0 / 128) + 128 * s + (n0 % 128), scr, lane); continue; } r -= I_13;
                { const int e = r / 256, r2 = r % 256, kb = r2 / 32, nb = r2 % 32; transpose_item(w2 + (size_t)e * 512 * 1024, 1024, 64 * kb, 32 * nb, W2T, 512, e * 1024 + 32 * nb, scr, lane); }
            }
        }
    }
    SEAM(0);

    if (IN(1)) {
        PHASE_PTRS
        const float* x = KA(0); const float* ctx = KA(2); const float* norm_mix = KA(6);
        for (int row = gw; row < MROWS; row += NGW) {
            const float* xr = row < T ? x + (size_t)row * D : ctx + (size_t)(row - T) * D; const int mb = row < T ? (row >> 11) : 16;
            f32x4 v[4]; float s = 0.f;
#pragma unroll
            for (int j = 0; j < 4; ++j) { v[j] = *(const f32x4*)(xr + 4 * lane + 256 * j); s += (v[j][0] * v[j][0] + v[j][1] * v[j][1]) + (v[j][2] * v[j][2] + v[j][3] * v[j][3]); }
            const float rstd = 1.f / sqrtf(wave_sum(s) * (1.f / D) + EPS);
#pragma unroll
            for (int j = 0; j < 4; ++j) { const int col = 4 * lane + 256 * j; const f32x4 g = *(const f32x4*)(norm_mix + col), sh = *(const f32x4*)(MOD + mb * 6144 + col), sc = *(const f32x4*)(MOD + mb * 6144 + 1024 + col);
                const f32x4 y = v[j] * rstd * g * (1.f + sc) + sh;
                *(v2u*)(XN + (size_t)row * D + col) = (v2u){pk2(y[0], y[1]), pk2(y[2], y[3])}; }
        }
    }
    SEAM(1);

    if (IN(2)) {
        PHASE_PTRS
        ProjOrder S; S.init(G, bx);
        LAS float* ropeL = (LAS float*)(lds + TAB_OFF); LAS float* lbtL = ropeL + 2048;
        for (int i = tid; i < 2048 + 1024; i += NTHR) ropeL[i] = i < 2048 ? ROPE[i] : LBT[i - 2048];
        __syncthreads();
        EpiProj E{ws, ropeL, lbtL, 0};
        pg8::gemm_phase<EpiProj, ProjOrder>(lds + RING_OFF, XN, WinT, D, S, E);
    }
    SEAM(2);

    if (IN(3)) {
        PHASE_PTRS
        const bf16* Qb = (const bf16*)(ws + WS_Q); const bf16* Kb = (const bf16*)(ws + WS_K); const bf16* Vb = (const bf16*)(ws + WS_V);
        const float* na_rpb = KA(10);
        const int subph = ({ const __attribute__((address_space(4))) Args* _p = (const __attribute__((address_space(4))) Args*)__builtin_amdgcn_kernarg_segment_ptr(); asm volatile("" : "+s"(_p)); _p->pad; });
#ifndef NO_SCAN
        if (bx < 128) {
            const int dir = bx & 1;
#ifdef DBG_NAIVE
            if (DBG_NAIVE & (1 << dir)) scan_naive(lds, bx >> 3, (bx >> 1) & 3, dir, (const unsigned short*)(ws + (dir ? WS_LB : WS_LF)), (const bf16*)(ws + WS_HQ), (const bf16*)(ws + WS_HI), (bf16*)(ws + (dir ? WS_OB : WS_OF)), tid);
            else
#endif
            if (subph != 2) scan_unit(lds, bx >> 3, (bx >> 1) & 3, dir, (const unsigned short*)(ws + (dir ? WS_LB : WS_LF)), (const bf16*)(ws + WS_HQ), (const bf16*)(ws + WS_HI), (bf16*)(ws + (dir ? WS_OB : WS_OF)), tid);
        } else
#endif
        {
            LAS float* rpbL = (LAS float*)lds;
            for (int idx = tid; idx < 8 * 15 * 64; idx += NTHR) { const int co = (idx & 63) - 16, hr = idx >> 6; rpbL[idx] = (co >= 0 && co < 31) ? na_rpb[hr * 31 + co] * 1.44269504f : 0.f; }
            __syncthreads();
            const __amdgpu_buffer_rsrc_t srdK = __builtin_amdgcn_make_buffer_rsrc((void*)Kb, (short)0, MROWS * SEGW * 2, 0x00020000), srdV = __builtin_amdgcn_make_buffer_rsrc((void*)Vb, (short)0, MROWS * SEGW * 2, 0x00020000);
            const int hx = bx & 7, idx = ((bx - 128) >> 3) * NWAVES + wave;
#pragma unroll 1
            for (int it = (subph == 1 ? 4 : 0); it < 4; ++it)
                na_row(it * 4 + (idx >> 5), hx, idx & 31, Qb, (const bf16*)(ws + WS_QR), srdK, srdV, MIX, rpbL, lds + 32768 + wave * 8192, lane);
        }
    }
    SEAM(3);

    if (IN(4)) {
        PHASE_PTRS
        const float* hg_norm = KA(12);
        const bf16* OF = (const bf16*)(ws + WS_OF); const bf16* OB = (const bf16*)(ws + WS_OB); const bf16* Gb = (const bf16*)(ws + WS_G);
        for (int tok = gw; tok < T; tok += NGW) {
            const size_t off = (size_t)tok * SEGW + lane * 8;
            const v4u a = *(const v4u*)(OF + off), bb = *(const v4u*)(OB + off), g = *(const v4u*)(Gb + off);
            float o[8]; float ss = 0.f;
#pragma unroll
            for (int e = 0; e < 4; ++e) { o[2 * e] = bflo(a[e]) + bflo(bb[e]); o[2 * e + 1] = bfhi(a[e]) + bfhi(bb[e]);
#ifdef DBG_SANITIZE
                if (!(fabsf(o[2 * e]) < 1e30f)) o[2 * e] = 0.f; if (!(fabsf(o[2 * e + 1]) < 1e30f)) o[2 * e + 1] = 0.f;
#endif
                ss += o[2 * e] * o[2 * e] + o[2 * e + 1] * o[2 * e + 1]; }
            ss += __shfl_xor(ss, 1); ss += __shfl_xor(ss, 2); ss += __shfl_xor(ss, 4); ss += __shfl_xor(ss, 8);
            const float rstd = 1.f / sqrtf(ss * (1.f / HGD) + EPS);
            const int dv0 = (lane & 15) * 8;
            const f32x4 g0 = *(const f32x4*)(hg_norm + dv0), g1 = *(const f32x4*)(hg_norm + dv0 + 4);
            const float gg[8] = {g0[0], g0[1], g0[2], g0[3], g1[0], g1[1], g1[2], g1[3]};
            float y[8];
#pragma unroll
            for (int e = 0; e < 4; ++e) { y[2 * e] = o[2 * e] * rstd * gg[2 * e] * bflo(g[e]); y[2 * e + 1] = o[2 * e + 1] * rstd * gg[2 * e + 1] * bfhi(g[e]); }
            *(v4u*)(MIX + (size_t)tok * D + 512 + lane * 8) = (v4u){pk2(y[0], y[1]), pk2(y[2], y[3]), pk2(y[4], y[5]), pk2(y[6], y[7])};
        }
    }
    SEAM(4);

    if (IN(5)) {
        PHASE_PTRS
        pg8::DenseOrder S; S.init(T, D, G, bx);
        EpiRes E{KA(0), X1, MOD};
        pg8::gemm_phase<EpiRes, pg8::DenseOrder>(lds + RING_OFF, MIX, WoutT, D, S, E);
    }
    SEAM(5);

    if (IN(6)) {
        PHASE_PTRS
        const float* norm_ffn = KA(7); const float* w_grp = KA(13); const float* b_grp = KA(14); const float* w_exp = KA(15); const float* b_exp = KA(16);
        LAS f32x4* wl = (LAS f32x4*)lds;
        for (int idx = tid; idx < 5 * 1024; idx += NTHR) { const int quad = idx >> 10, col = idx & 1023; const int l = (col & 255) >> 2, q = col & 3, j = col >> 8;
            const f32x4 w = quad == 0 ? *(const f32x4*)(w_grp + col * 4) : *(const f32x4*)(w_exp + col * 16 + (quad - 1) * 4);
            wl[((quad * 4 + q) * 4 + j) * 64 + l] = w; }
        LAS int* lcnt = (LAS int*)(lds + 81920);
        LAS int* tmpe = (LAS int*)(lds + 81920 + 256);
        if (tid < 32) lcnt[tid] = 0;
        __syncthreads();
        const int rowbase = bx * 128 + wave * 16;
#pragma unroll 1
        for (int i = 0; i < 16; ++i) {
            asm volatile("" ::: "memory");
            const int row = rowbase + i; const int mb = row >> 11;
            const float* xr = X1 + (size_t)row * D;
            f32x4 v[4]; float s = 0.f;
#pragma unroll
            for (int j = 0; j < 4; ++j) { v[j] = *(const f32x4*)(xr + 4 * lane + 256 * j); s += (v[j][0] * v[j][0] + v[j][1] * v[j][1]) + (v[j][2] * v[j][2] + v[j][3] * v[j][3]); }
            const float rstd = 1.f / sqrtf(wave_sum(s) * (1.f / D) + EPS);
            float lg[20];
#pragma unroll
            for (int k = 0; k < 20; ++k) lg[k] = 0.f;
#pragma unroll
            for (int j = 0; j < 4; ++j) { const int col = 4 * lane + 256 * j; const f32x4 g = *(const f32x4*)(norm_ffn + col), sh = *(const f32x4*)(MOD + mb * 6144 + 3072 + col), sc = *(const f32x4*)(MOD + mb * 6144 + 4096 + col);
                const f32x4 y = v[j] * rstd * g * (1.f + sc) + sh;
                asm volatile("" ::: "memory");
                *(v2u*)(XN2 + (size_t)row * D + col) = (v2u){pk2(y[0], y[1]), pk2(y[2], y[3])};
#pragma unroll
                for (int q = 0; q < 4; ++q)
#pragma unroll
                    for (int quad = 0; quad < 5; ++quad) { const f32x4 w = wl[((quad * 4 + q) * 4 + j) * 64 + lane];
                        lg[quad * 4 + 0] += y[q] * w[0]; lg[quad * 4 + 1] += y[q] * w[1]; lg[quad * 4 + 2] += y[q] * w[2]; lg[quad * 4 + 3] += y[q] * w[3]; } }
#pragma unroll
            for (int k = 0; k < 20; ++k) lg[k] = wave_sum(lg[k]);
            if (lane == 0) {
                float gl[4];
#pragma unroll
                for (int k = 0; k < 4; ++k) gl[k] = lg[k] + b_grp[k];
                int gs = 0; float gm = gl[0];
#pragma unroll
                for (int k = 1; k < 4; ++k) if (gl[k] > gm) { gm = gl[k]; gs = k; }
                float den = 0.f;
#pragma unroll
                for (int k = 0; k < 4; ++k) den += __expf(gl[k] - gm);
                const float g_w = 1.f / den;
                float ev[4];
#pragma unroll
                for (int k = 0; k < 4; ++k) { float a = lg[4 + k] + b_exp[k];
#pragma unroll
                    for (int g2 = 1; g2 < 4; ++g2) a = (gs == g2) ? (lg[4 + g2 * 4 + k] + b_exp[g2 * 4 + k]) : a;
                    ev[k] = a; }
                int i0 = 0; float v0 = ev[0];
#pragma unroll
                for (int k = 1; k < 4; ++k) if (ev[k] > v0) { v0 = ev[k]; i0 = k; }
                int i1 = -1; float v1 = -INFINITY;
#pragma unroll
                for (int k = 0; k < 4; ++k) if (k != i0 && ev[k] > v1) { v1 = ev[k]; i1 = k; }
                if (i1 < 0) { i1 = (i0 + 1) & 3; v1 = v0; }
                const float e1 = __expf(v1 - v0); const float w0 = g_w / (1.f + e1), w1w = g_w * e1 / (1.f + e1);
                const int ea = gs * 4 + i0, eb = gs * 4 + i1;
                const int ra = __hip_atomic_fetch_add(&lcnt[ea], 1, __ATOMIC_RELAXED, __HIP_MEMORY_SCOPE_WORKGROUP), rb = __hip_atomic_fetch_add(&lcnt[eb], 1, __ATOMIC_RELAXED, __HIP_MEMORY_SCOPE_WORKGROUP);
                const int lr = (wave * 16 + i) * 2;
                tmpe[lr] = ea; tmpe[256 + lr] = ra; tmpe[512 + lr] = __builtin_bit_cast(int, w0);
                tmpe[lr + 1] = eb; tmpe[256 + lr + 1] = rb; tmpe[512 + lr + 1] = __builtin_bit_cast(int, w1w);
            }
        }
        __syncthreads();
        if (tid < 16) lcnt[16 + tid] = (int)__hip_atomic_fetch_add(ctl + CW_CNT + tid, (unsigned)lcnt[tid], RLX_AGENT);
        __syncthreads();
        if (tid < 256) { const int e = tmpe[tid], pos = lcnt[16 + e] + tmpe[256 + tid]; const int tok = bx * 128 + (tid >> 1);
            ELIST[e * ECAP + pos] = tok * 2 + (tid & 1); EWT[e * ECAP + pos] = __builtin_bit_cast(float, tmpe[512 + tid]); }
        __syncthreads();
    }
    SEAM(6);

    if (IN(7) || IN(8)) {
        PHASE_PTRS
        LAS int* tp = (LAS int*)(lds + MOE_OFF);
        if (tid == 0) { int acc = 0;
            for (int e = 0; e < 16; ++e) { const int c = (int)__hip_atomic_load(ctl + CW_CNT + e, RLX_AGENT); tp[e] = acc; tp[17 + e] = c; acc += (c + 255) >> 8; }
            tp[16] = acc; }
        __syncthreads();
    }
    if (IN(7)) {
        PHASE_PTRS
        const LAS int* tp = (const LAS int*)(lds + MOE_OFF);
        MoeOrder<true> S{tp, ELIST, G, bx, tp[16] * 4};
        EpiSwiGLU E{Hb};
        pg8::gemm_phase<EpiSwiGLU, MoeOrder<true>>(lds + RING_OFF, XN2, W13T, D, S, E);
    }
    SEAM(7);
    if (IN(8)) {
        PHASE_PTRS
        const LAS int* tp = (const LAS int*)(lds + MOE_OFF);
        MoeOrder<false> S{tp, ELIST, G, bx, tp[16] * 4};
        EpiMoeOut E{Yb, ELIST, EWT};
        pg8::gemm_phase<EpiMoeOut, MoeOrder<false>>(lds + RING_OFF, Hb, W2T, DE, S, E);
    }
    SEAM(8);

    if (IN(9)) {
        PHASE_PTRS
        const float* norm_final = KA(20); float* outp = ({ const __attribute__((address_space(4))) Args* _p = (const __attribute__((address_space(4))) Args*)__builtin_amdgcn_kernarg_segment_ptr(); asm volatile("" : "+s"(_p)); _p->out; });
        for (int row = gw; row < T; row += NGW) {
            const int mb = row >> 11; f32x4 v[4]; float s = 0.f;
#pragma unroll
            for (int j = 0; j < 4; ++j) { const int col = 4 * lane + 256 * j; const f32x4 xv = *(const f32x4*)(X1 + (size_t)row * D + col), ga = *(const f32x4*)(MOD + mb * 6144 + 5120 + col);
                const v2u y0 = *(const v2u*)(Yb + (size_t)(2 * row) * D + col), y1 = *(const v2u*)(Yb + (size_t)(2 * row + 1) * D + col);
                const f32x4 ys = (f32x4){bflo(y0.x) + bflo(y1.x), bfhi(y0.x) + bfhi(y1.x), bflo(y0.y) + bflo(y1.y), bfhi(y0.y) + bfhi(y1.y)};
                v[j] = xv + ga * ys; s += (v[j][0] * v[j][0] + v[j][1] * v[j][1]) + (v[j][2] * v[j][2] + v[j][3] * v[j][3]); }
            const float rstd = 1.f / sqrtf(wave_sum(s) * (1.f / D) + EPS);
#pragma unroll
            for (int j = 0; j < 4; ++j) { const int col = 4 * lane + 256 * j; const f32x4 g = *(const f32x4*)(norm_final + col);
                *(f32x4*)(outp + (size_t)row * D + col) = v[j] * rstd * g; }
        }
    }
#undef IN
#undef SEAM
}

#ifndef MK_N_LAUNCHES
#define MK_N_LAUNCHES 1
#endif
constexpr int NPHASE = 10;
extern "C" void kernel_launch(void* const* d_in, const int* in_sizes, int n_in, void* d_out, int out_size, void* d_ws, size_t ws_size, hipStream_t stream) {
    static int grid = 0;
    if (grid == 0) {
        if (n_in != 21 || in_sizes[0] != T * D || out_size != T * D || ws_size < WS_END) { fprintf(stderr, "kernel_launch: unexpected shapes (n_in %d, in0 %d, out %d, ws %zu)\n", n_in, n_in > 0 ? in_sizes[0] : -1, out_size, ws_size); grid = -1; return; }
        int dev = 0, cus = 0, per_cu = 0;
        if (hipGetDevice(&dev) != hipSuccess || hipDeviceGetAttribute(&cus, hipDeviceAttributeMultiprocessorCount, dev) != hipSuccess) { grid = -1; return; }
        if (hipFuncSetAttribute((const void*)fwd_mega, hipFuncAttributeMaxDynamicSharedMemorySize, LDS_BYTES) != hipSuccess) { fprintf(stderr, "kernel_launch: hipFuncSetAttribute failed\n"); grid = -1; return; }
        if (hipOccupancyMaxActiveBlocksPerMultiprocessor(&per_cu, (const void*)fwd_mega, NTHR, LDS_BYTES) != hipSuccess || per_cu < 1) fprintf(stderr, "kernel_launch: occupancy query reports %d\n", per_cu);
        (void)hipGetLastError();
        grid = cus;
        if (grid != 256) fprintf(stderr, "kernel_launch: %d CUs (built for 256)\n", grid);
    }
    if (grid < 0) return;
    (void)hipMemsetAsync((char*)d_ws + WS_CTL, 0, CTL_ZERO_BYTES, stream);
    Args a{};
    for (int i = 0; i < 21; ++i) a.in[i] = (const float*)d_in[i];
    a.out = (float*)d_out; a.ws = (unsigned char*)d_ws;
    if (MK_N_LAUNCHES == 1) {
        a.ph_lo = 0; a.ph_hi = NPHASE; a.li = 0;
        hipLaunchKernelGGL(fwd_mega, dim3(grid), dim3(NTHR), LDS_BYTES, stream, a);
    } else {
        for (int li = 0; li < NPHASE; ++li) { a.ph_lo = li; a.ph_hi = li + 1; a.li = 0; hipLaunchKernelGGL(fwd_mega, dim3(grid), dim3(NTHR), LDS_BYTES, stream, a);
#ifdef PROBE_DUP
            if (li == PROBE_DUP) {
#ifdef PROBE_SUB
                a.pad = PROBE_SUB;
#endif
                hipLaunchKernelGGL(fwd_mega, dim3(grid), dim3(NTHR), LDS_BYTES, stream, a); a.pad = 0; }
#endif
        }
    }
}
```

```cpp
#include <hip/hip_runtime.h>
#include <cstdio>
#include <cstdint>

#define GAS __attribute__((address_space(1)))
#define LAS __attribute__((address_space(3)))
typedef unsigned short bf16;
typedef unsigned short bf16_t;
typedef unsigned v4u __attribute__((ext_vector_type(4)));
typedef unsigned v2u __attribute__((ext_vector_type(2)));
typedef float f32x4 __attribute__((ext_vector_type(4)));
typedef float f32x2 __attribute__((ext_vector_type(2)));
typedef short bf16x8 __attribute__((ext_vector_type(8)));
typedef unsigned u32x4 __attribute__((ext_vector_type(4)));
typedef GAS unsigned gu32;
#define RLX_AGENT __ATOMIC_RELAXED, __HIP_MEMORY_SCOPE_AGENT
#define LDS_WAIT() asm volatile("s_waitcnt lgkmcnt(0)" ::: "memory")
#define VM_WAIT() asm volatile("s_waitcnt vmcnt(0)" ::: "memory")

constexpr int NB = 16, SEQ = 2048, D = 1024, T = NB * SEQ, LC = 256, TC = NB * LC, MROWS = T + TC;
constexpr int GW = 64, NROWS = SEQ / GW;
constexpr int INCOLS = 4096, SEGW = 512;
constexpr int NAH = 8, NAD = 64, HGH = 4, HGD = 128;
constexpr int KTOK = SEQ + LC;
constexpr int NE = 16, DE = 512, ECAP = T;
constexpr float EPS = 1e-6f;
constexpr int NWAVES = 8, NTHR = 512;

constexpr size_t MiB = 1u << 20;
constexpr size_t WS_CTL = 0, CTL_ZERO_BYTES = 1 * MiB;
constexpr size_t WS_MOD = 1 * MiB;
constexpr size_t WS_ROPE = WS_MOD + 512 * 1024, WS_LBT = WS_MOD + 520 * 1024;
constexpr size_t WS_ELIST = 2 * MiB, WS_EWT = 4 * MiB;
constexpr size_t WS_WINT = 8 * MiB, WS_WOUTT = 16 * MiB, WS_W13T = 18 * MiB, WS_W2T = 50 * MiB;
constexpr size_t WS_XN = 66 * MiB;
constexpr size_t WS_Q = 138 * MiB, WS_K = 170 * MiB, WS_V = 206 * MiB, WS_HQ = 242 * MiB, WS_HI = 274 * MiB, WS_LF = 310 * MiB, WS_LB = 346 * MiB, WS_G = 382 * MiB;
constexpr size_t WS_OF = 414 * MiB, WS_OB = 446 * MiB, WS_QR = 478 * MiB, WS_END = 510 * MiB;
constexpr size_t WS_MIX = WS_XN, WS_XN2 = WS_XN, WS_X1 = 138 * MiB, WS_H = 274 * MiB, WS_Y = 346 * MiB;
constexpr int CW_CNT = 64;
constexpr int CW_BAR = 4096;

constexpr int RING_OFF = 0, RING_BYTES = 131072;
constexpr int LDSCTL_OFF = RING_BYTES, MISC_OFF = LDSCTL_OFF + 320, MOE_OFF = LDSCTL_OFF + 1024;
constexpr int TAB_OFF = LDSCTL_OFF + 2048;
constexpr int LDS_BYTES = 147456;

__device__ __forceinline__ unsigned f2bf(float f) { unsigned u = __builtin_bit_cast(unsigned, f); return (u + 0x7fffu + ((u >> 16) & 1u)) >> 16; }
__device__ __forceinline__ unsigned pk2(float lo, float hi) { return f2bf(lo) | (f2bf(hi) << 16); }
__device__ __forceinline__ float bf2f(unsigned short b) { return __builtin_bit_cast(float, (unsigned)b << 16); }
__device__ __forceinline__ float bflo(unsigned u) { return __builtin_bit_cast(float, u << 16); }
__device__ __forceinline__ float bfhi(unsigned u) { return __builtin_bit_cast(float, u & 0xffff0000u); }
__device__ __forceinline__ unsigned pkh2(float lo, float hi) { _Float16 a = (_Float16)lo, b = (_Float16)hi; return (unsigned)__builtin_bit_cast(unsigned short, a) | ((unsigned)__builtin_bit_cast(unsigned short, b) << 16); }
__device__ __forceinline__ float h2f(unsigned short h) { return (float)__builtin_bit_cast(_Float16, h); }
__device__ __forceinline__ float silu_f(float v) { return v * __builtin_amdgcn_rcpf(1.f + __expf(-v)); }
__device__ __forceinline__ float wave_sum(float v) {
#pragma unroll
    for (int o = 1; o < 64; o <<= 1) v += __shfl_xor(v, o);
    return v;
}
__device__ __forceinline__ float wave_max(float v) {
#pragma unroll
    for (int o = 1; o < 64; o <<= 1) v = fmaxf(v, __shfl_xor(v, o));
    return v;
}

namespace pg8 {
constexpr int BM = 256, BK = 64, HALF = 128, HTB = HALF * BK * 2, STAGE_BYTES = 8 * HTB, NXCD = 8, WGM = 8;
__host__ __device__ __forceinline__ int lds_byte(int r, int c) { const int st = (r >> 4) * 2 + (c >> 5), rr = r & 15, cc = c & 31, ob = rr * 64 + cc * 2; return st * 1024 + (ob ^ (((ob >> 9) & 1) << 5)); }
__host__ __device__ __forceinline__ void stage_rc(int b, int& R, int& C) { const int st = b / 1024, sb = b % 1024, swz = sb ^ (((sb >> 9) & 1) << 5); R = (st >> 1) * 16 + swz / 64; C = (st & 1) * 32 + (swz % 64) / 2; }
__host__ __device__ __forceinline__ int perm32(int rho) { const int n = rho >> 4, i = rho & 15; return 8 * (i >> 2) + 4 * n + (i & 3); }

struct Unit { int pm, pn, e, tm, cnt; };

typedef float f32x2_t __attribute__((ext_vector_type(2))); typedef __bf16 bf16x2_t __attribute__((ext_vector_type(2)));
__device__ __forceinline__ unsigned cvt_pk_bf16(float lo, float hi) { f32x2_t v = {lo, hi}; bf16x2_t b = __builtin_convertvector(v, bf16x2_t); return __builtin_bit_cast(unsigned, b); }

struct DenseOrder {
    static constexpr bool GATHER = false;
    int nM, nN, nwg, G, c; bool pf;
    __device__ void init(int M, int N, int G_, int c_, bool pf_ = false) { nM = M / BM; nN = N / BM; nwg = nM * nN; G = G_; c = c_; pf = pf_; }
    __device__ bool next(int i, Unit& u) const {
        const long L = (long)i * G + c; if (L >= nwg) return false;
        int wgid = (int)L; { const int q = nwg / NXCD, r = nwg % NXCD, xcd = wgid % NXCD, off = wgid / NXCD; wgid = (xcd < r ? xcd * (q + 1) : r * (q + 1) + (xcd - r) * q) + off; }
        const int nig = WGM * nN, gid = wgid / nig, fm = gid * WGM, gsz = (nM - fm) < WGM ? (nM - fm) : WGM;
        u.pm = fm + ((wgid % nig) % gsz); u.pn = (wgid % nig) / gsz; u.e = 0; u.tm = 0; u.cnt = 0; return true;
    }
    __device__ __forceinline__ int a_row0(const Unit& u) const { return u.pm * BM; }
    __device__ __forceinline__ int a_row(const Unit& u, int r) const { return u.pm * BM + r; }
    __device__ __forceinline__ int b_row0(const Unit& u) const { return u.pn * BM; }
    __device__ __forceinline__ bool perm(const Unit&) const { return pf; }
};

template <class Epi, class Sched>
__device__ __forceinline__ void gemm_phase(LAS unsigned char* lds, const bf16_t* Aptr, const bf16_t* Btptr, const int K, const Sched& S, const Epi& E) {
    const int tid = threadIdx.x, wid = __builtin_amdgcn_readfirstlane(tid >> 6), lane = tid & 63, wr = wid >> 2, wc = wid & 3, fr = lane & 15, fq = lane >> 4;
    const int nt = K / BK;
    int sR[2], sC[2];
    unsigned voffA[2], voffBn[2], voffBp[2], voffB[2], nvB[2];
#pragma unroll
    for (int i = 0; i < 2; ++i) { int R, C; stage_rc(tid * 16 + i * 8192, R, C); const int Rb = (R & ~31) + perm32(R & 31);
        sR[i] = R; sC[i] = C; voffA[i] = (unsigned)(R * K + C) * 2u; voffBn[i] = (unsigned)(R * K + C) * 2u; voffBp[i] = (unsigned)(Rb * K + C) * 2u; }
    const size_t kstep = (size_t)(BK * 2);
    const size_t hstep = (size_t)HALF * K * 2;
    const size_t rowb = (size_t)K * 2;
    const unsigned ldsw = (unsigned)wid * 1024u;
    const int aoff = lds_byte(wr * 64 + fr, fq * 8), boff = lds_byte(wc * 32 + fr, fq * 8);
    const char* Ab = (const char*)Aptr;
#define PG8_SA(b, h) (((b) * 2 + (h)) * HTB)
#define PG8_SB(b, h) ((4 + (b) * 2 + (h)) * HTB)
#define PG8_STAGE(bufoff, gbase, voff) do { _Pragma("unroll") for (int _i = 0; _i < 2; ++_i) \
        __builtin_amdgcn_global_load_lds((const unsigned*)((const char*)(gbase) + (voff)[_i]), (LAS unsigned*)(lds + (bufoff) + ldsw + _i * 8192), 16, 0, 0); } while (0)
#define PG8_LDA(dst, b, h) do { _Pragma("unroll") for (int m = 0; m < 4; ++m) _Pragma("unroll") for (int k = 0; k < 2; ++k) dst[m][k] = *(const LAS bf16x8*)(lds + PG8_SA(b, h) + aoff + m * 2048 + k * 1024); } while (0)
#define PG8_LDB(dst, b, h) do { _Pragma("unroll") for (int n = 0; n < 2; ++n) _Pragma("unroll") for (int k = 0; k < 2; ++k) dst[n][k] = *(const LAS bf16x8*)(lds + PG8_SB(b, h) + boff + n * 2048 + k * 1024); } while (0)
#define PG8_MMA(ai, bj, At, Bt) do { __builtin_amdgcn_s_setprio(1); _Pragma("unroll") for (int m = 0; m < 4; ++m) _Pragma("unroll") for (int n = 0; n < 2; ++n) _Pragma("unroll") for (int k = 0; k < 2; ++k) \
        acc[ai][bj][m][n] = __builtin_amdgcn_mfma_f32_16x16x32_bf16(Bt[n][k], At[m][k], acc[ai][bj][m][n], 0, 0, 0); __builtin_amdgcn_s_setprio(0); } while (0)
#define PG8_WAIT_V(n) asm volatile("s_waitcnt vmcnt(" #n ")" ::: "memory")
#define PG8_WAIT_L(n) asm volatile("s_waitcnt lgkmcnt(" #n ")" ::: "memory")
#define PG8_BAR __builtin_amdgcn_s_barrier()
#define PG8_SCHED __builtin_amdgcn_sched_barrier(0)
    Unit cur, nxt; int ui = 0;
    if (!S.next(0, cur)) return;
    f32x4 acc[2][2][4][2];
#pragma unroll
    for (int a = 0; a < 2; ++a)
#pragma unroll
        for (int b = 0; b < 2; ++b)
#pragma unroll
            for (int m = 0; m < 4; ++m)
#pragma unroll
                for (int n = 0; n < 2; ++n) acc[a][b][m][n] = (f32x4){0.f, 0.f, 0.f, 0.f};
    bf16x8 At[4][2], B0[2][2], B1[2][2];
    const char* cA = Ab; unsigned cG[2][2];
    if constexpr (Sched::GATHER) {
#pragma unroll
        for (int h = 0; h < 2; ++h)
#pragma unroll
            for (int i = 0; i < 2; ++i) cG[h][i] = (unsigned)((size_t)S.a_row(cur, h * HALF + sR[i]) * rowb) + (unsigned)sC[i] * 2u;
    } else { cA = Ab + (ptrdiff_t)S.a_row0(cur) * (ptrdiff_t)rowb; cG[0][0] = cG[0][1] = cG[1][0] = cG[1][1] = 0u; }
    const char* cB = (const char*)Btptr + (ptrdiff_t)S.b_row0(cur) * (ptrdiff_t)rowb;
    { const bool pc = S.perm(cur); voffB[0] = pc ? voffBp[0] : voffBn[0]; voffB[1] = pc ? voffBp[1] : voffBn[1]; }
#define PG8_STAGEA(bufoff, h, dbase, goffs, kb) do { if constexpr (Sched::GATHER) { PG8_STAGE(bufoff, Ab + (kb), (goffs)[h]); } else { PG8_STAGE(bufoff, (dbase) + (h) * hstep + (kb), voffA); } } while (0)
    PG8_STAGE(PG8_SB(0, 0), cB, voffB); PG8_STAGE(PG8_SB(0, 1), cB + hstep, voffB); PG8_STAGEA(PG8_SA(0, 0), 0, cA, cG, 0); PG8_STAGEA(PG8_SA(0, 1), 1, cA, cG, 0);
    if (wr == 1) PG8_BAR;
    PG8_WAIT_V(2); PG8_BAR;
    PG8_STAGE(PG8_SB(1, 0), cB + kstep, voffB); PG8_STAGEA(PG8_SA(1, 0), 0, cA, cG, kstep); PG8_STAGE(PG8_SB(1, 1), cB + hstep + kstep, voffB);
    PG8_WAIT_V(6); PG8_BAR;
    for (;;) {
        const bool has_next = S.next(ui + 1, nxt);
        const char* nA = cA; const char* nB = cB; unsigned nG[2][2];
#pragma unroll
        for (int h = 0; h < 2; ++h)
#pragma unroll
            for (int i = 0; i < 2; ++i) nG[h][i] = cG[h][i];
        nvB[0] = voffB[0]; nvB[1] = voffB[1];
        if (has_next) {
            nB = (const char*)Btptr + (ptrdiff_t)S.b_row0(nxt) * (ptrdiff_t)rowb;
            { const bool pn_ = S.perm(nxt); nvB[0] = pn_ ? voffBp[0] : voffBn[0]; nvB[1] = pn_ ? voffBp[1] : voffBn[1]; }
            if constexpr (Sched::GATHER) {
#pragma unroll
                for (int h = 0; h < 2; ++h)
#pragma unroll
                    for (int i = 0; i < 2; ++i) nG[h][i] = (unsigned)((size_t)S.a_row(nxt, h * HALF + sR[i]) * rowb) + (unsigned)sC[i] * 2u;
            } else nA = Ab + (ptrdiff_t)S.a_row0(nxt) * (ptrdiff_t)rowb;
        }
        for (int t = 0; t < nt; t += 2) {
            const bool last = (t == nt - 2);
            const size_t kb1 = (size_t)(t + 1) * kstep;
            const size_t kb2 = last ? 0 : (size_t)(t + 2) * kstep, kb3 = kb2 + kstep;
            const char* a2 = last ? nA : cA; const char* b2 = last ? nB : cB + (size_t)(t + 2) * kstep; const char* b3 = b2 + kstep;
            unsigned vB2[2]; vB2[0] = last ? nvB[0] : voffB[0]; vB2[1] = last ? nvB[1] : voffB[1];
            unsigned g2[2][2];
#pragma unroll
            for (int h = 0; h < 2; ++h)
#pragma unroll
                for (int i = 0; i < 2; ++i) g2[h][i] = last ? nG[h][i] : cG[h][i];
            PG8_LDB(B0, 0, 0); PG8_LDB(B1, 0, 1); PG8_SCHED; PG8_LDA(At, 0, 0); PG8_STAGEA(PG8_SA(1, 1), 1, cA, cG, kb1);
            PG8_WAIT_V(8); PG8_WAIT_L(0); PG8_BAR; PG8_MMA(0, 0, At, B0); PG8_MMA(0, 1, At, B1); PG8_BAR; PG8_SCHED;
            PG8_LDA(At, 0, 1); PG8_STAGE(PG8_SB(0, 0), b2, vB2); PG8_STAGE(PG8_SB(0, 1), b2 + hstep, vB2); PG8_STAGEA(PG8_SA(0, 0), 0, a2, g2, kb2);
            PG8_WAIT_V(8); PG8_WAIT_L(0); PG8_BAR; PG8_MMA(1, 0, At, B0); PG8_MMA(1, 1, At, B1); PG8_BAR; PG8_SCHED;
            PG8_LDB(B0, 1, 0); PG8_LDB(B1, 1, 1); PG8_SCHED; PG8_LDA(At, 1, 0); PG8_STAGEA(PG8_SA(0, 1), 1, a2, g2, kb2);
            PG8_WAIT_V(8); PG8_WAIT_L(0); PG8_BAR; PG8_MMA(0, 0, At, B0); PG8_MMA(0, 1, At, B1); PG8_BAR; PG8_SCHED;
            PG8_LDA(At, 1, 1); PG8_STAGE(PG8_SB(1, 0), b3, vB2); PG8_STAGE(PG8_SB(1, 1), b3 + hstep, vB2); PG8_STAGEA(PG8_SA(1, 0), 0, a2, g2, kb3);
            PG8_WAIT_V(8); PG8_WAIT_L(0); PG8_BAR; PG8_MMA(1, 0, At, B0); PG8_MMA(1, 1, At, B1); PG8_BAR; PG8_SCHED;
        }
        if (wr == 0) PG8_BAR;
        E(acc, cur, wr, wc, fr, fq);
        if (!has_next) break;
#pragma unroll
        for (int a = 0; a < 2; ++a)
#pragma unroll
            for (int b = 0; b < 2; ++b)
#pragma unroll
                for (int m = 0; m < 4; ++m)
#pragma unroll
                    for (int n = 0; n < 2; ++n) acc[a][b][m][n] = (f32x4){0.f, 0.f, 0.f, 0.f};
        cur = nxt; cA = nA; cB = nB; ++ui; voffB[0] = nvB[0]; voffB[1] = nvB[1];
#pragma unroll
        for (int h = 0; h < 2; ++h)
#pragma unroll
            for (int i = 0; i < 2; ++i) cG[h][i] = nG[h][i];
        if (wr == 1) PG8_BAR;
    }
    PG8_WAIT_V(0);
    PG8_BAR;
#undef PG8_SA
#undef PG8_SB
#undef PG8_STAGE
#undef PG8_STAGEA
#undef PG8_LDA
#undef PG8_LDB
#undef PG8_MMA
#undef PG8_WAIT_V
#undef PG8_WAIT_L
#undef PG8_BAR
#undef PG8_SCHED
}
}

#define XB_TMO      128
#define XB_XCNT(j)  (256  + 64 * (j))
#define XB_XSUB(j)  (1280 + 64 * (j))
#define XB_XGEN(j)  (2304 + 64 * (j))
#define XB_TOP      3328
#define XB_TOPGEN   3392
#define XCD_BAR_WORDS 3456
#define XB_SPIN_CAP (1u << 18)
__device__ __forceinline__ unsigned xb_ld(unsigned* p)              { return __hip_atomic_load(p, __ATOMIC_RELAXED, __HIP_MEMORY_SCOPE_AGENT); }
__device__ __forceinline__ unsigned xb_add(unsigned* p, unsigned v) { return __hip_atomic_fetch_add(p, v, __ATOMIC_RELAXED, __HIP_MEMORY_SCOPE_AGENT); }
__device__ __forceinline__ unsigned xb_xcc_id() { return (unsigned)__builtin_amdgcn_s_getreg((3 << 11) | 20) & 0xFu; }
#define XB_SPIN(cond, bar) do { unsigned _sp = 0; while (cond) { __builtin_amdgcn_s_sleep(1); \
    if ((++_sp & 255u) == 0u) { if (xb_ld(&(bar)[XB_TMO])) break; if (_sp > XB_SPIN_CAP) { atomicAdd(&(bar)[XB_TMO], 1u); break; } } } } while (0)
struct XcdBarrier { unsigned* bar; unsigned x; volatile LAS unsigned* st; };
__device__ __forceinline__ XcdBarrier xcd_barrier_post(unsigned* bar, volatile LAS unsigned* st) {
    XcdBarrier b; b.bar = bar; b.x = xb_xcc_id(); b.st = st;
    if (threadIdx.x == 0) (void)xb_add(&bar[XB_XCNT(b.x)], 1u);
    return b;
}
__device__ __forceinline__ void xcd_barrier_complete(unsigned* bar, unsigned x, unsigned& nloc, unsigned& nx) {
    const unsigned G = gridDim.x * gridDim.y * gridDim.z;
    unsigned sum, cnt, mine, sp = 0u;
    for (;;) {
        sum = 0u; cnt = 0u; mine = 0u;
#pragma unroll
        for (unsigned j = 0; j < 16; ++j) { const unsigned c = xb_ld(&bar[XB_XCNT(j)]); sum += c; cnt += (c > 0u) ? 1u : 0u; mine = (j == x) ? c : mine; }
        if (sum == G) break;
        __builtin_amdgcn_s_sleep(1);
        if ((++sp & 255u) == 0u) { if (xb_ld(&bar[XB_TMO])) break; if (sp > XB_SPIN_CAP) { atomicAdd(&bar[XB_TMO], 1u); break; } }
    }
    nloc = mine > 0u ? mine : 1u; nx = cnt > 0u ? cnt : 1u;
}
__device__ __forceinline__ void xcd_barrier(const XcdBarrier& b) {
    asm volatile("s_waitcnt vmcnt(0)" ::: "memory");
    __syncthreads();
    if (threadIdx.x == 0) {
        unsigned* bar = b.bar;
        __builtin_amdgcn_s_waitcnt(0);
        unsigned nloc = b.st[0], nx = b.st[1];
        if (nloc == 0u) { xcd_barrier_complete(bar, b.x, nloc, nx); b.st[0] = nloc; b.st[1] = nx; }
        const unsigned old = xb_add(&bar[XB_XSUB(b.x)], 1u);
        const unsigned gen = old / nloc;
        if (old + 1u == (gen + 1u) * nloc) {
            __builtin_amdgcn_fence(__ATOMIC_RELEASE, "agent");
            asm volatile("s_waitcnt vmcnt(0)" ::: "memory");
            const unsigned og = xb_add(&bar[XB_TOP], 1u);
            const unsigned tg = og / nx;
            if (og + 1u == (tg + 1u) * nx) xb_add(&bar[XB_TOPGEN], 1u);
            else XB_SPIN(xb_ld(&bar[XB_TOPGEN]) == tg, bar);
            __builtin_amdgcn_fence(__ATOMIC_ACQUIRE, "agent");
            xb_add(&bar[XB_XGEN(b.x)], 1u);
            asm volatile("s_waitcnt vmcnt(0)" ::: "memory");
        } else {
            XB_SPIN(xb_ld(&bar[XB_XGEN(b.x)]) == gen, bar);
            __builtin_amdgcn_fence(__ATOMIC_ACQUIRE, "agent");
            asm volatile("s_waitcnt vmcnt(0)" ::: "memory");
        }
    }
    __syncthreads();
}

using pg8::Unit;
typedef f32x4 acc_t[2][2][4][2];

struct EpiProj {
    static constexpr bool PERM = false;
    unsigned char* ws; const LAS float* ropeL; const LAS float* lbtL; int skip;
    __device__ __forceinline__ void operator()(const acc_t& acc, const Unit& u, int wr, int wc, int fr, int fq) const {
        const int seg = u.pn >> 1; const bool latent = u.pm < (T / 256);
        if (skip) return;
        if (!latent && (seg == 0 || seg == 3 || seg == 7)) return;
        if (u.e) {
            const size_t soff[8] = {0, 0, WS_V, WS_HQ, WS_HI, WS_LF, WS_LB, 0};
            size_t so2 = soff[2];
#pragma unroll
            for (int q = 3; q < 7; ++q) so2 = (seg == q) ? soff[q] : so2;
            bf16* dT = (bf16*)(ws + so2);
            const int ldt = (seg == 3) ? T : MROWS;
            const int wrow0 = (u.pn & 1) * 256 + wr * 64 + fr, tcol0 = u.pm * 256 + wc * 32 + 8 * fq;
            const LAS float* lbt = lbtL + (seg == 6 ? 512 : 0);
#pragma unroll
            for (int ai = 0; ai < 2; ++ai)
#pragma unroll
                for (int m = 0; m < 4; ++m) { const int wrow = wrow0 + ai * 128 + m * 16; const float lb = (seg >= 5) ? lbt[wrow] : 0.f;
#pragma unroll
                    for (int bj = 0; bj < 2; ++bj) { float x[8]; u32x4 w;
#pragma unroll
                        for (int j = 0; j < 4; ++j) { x[j] = acc[ai][bj][m][0][j]; x[4 + j] = acc[ai][bj][m][1][j]; }
                        if (seg >= 5) {
#pragma unroll
                            for (int j = 0; j < 8; ++j) { const float sg = __builtin_amdgcn_rcpf(1.f + __expf(-x[j])); x[j] = __log2f(lb + (1.f - lb) * sg); }
                            w = (u32x4){pkh2(x[0], x[1]), pkh2(x[2], x[3]), pkh2(x[4], x[5]), pkh2(x[6], x[7])}; }
                        else { if (seg == 3) {
#pragma unroll
                                for (int j = 0; j < 8; ++j) x[j] = silu_f(x[j]); }
                            w = (u32x4){pg8::cvt_pk_bf16(x[0], x[1]), pg8::cvt_pk_bf16(x[2], x[3]), pg8::cvt_pk_bf16(x[4], x[5]), pg8::cvt_pk_bf16(x[6], x[7])}; }
                        size_t off = (size_t)wrow * ldt + tcol0 + bj * 128;
                        if (seg == 2) { const int tc = tcol0 + bj * 128, bb_ = latent ? (tc >> 11) : ((tc - T) >> 8), tl = latent ? (tc & (SEQ - 1)) : (KTOK - LC + ((tc - T) & (LC - 1)));
                            off = ((((size_t)(bb_ * NAH + (wrow >> 6)) * (KTOK / 64) + (tl >> 6)) * NAD + (wrow & 63)) * 64) + (tl & 63); }
                        *(u32x4*)(dT + off) = w; } }
            return;
        }
        const int row0 = u.pm * 256 + wr * 64 + fr;
        const int lcp = (u.pn & 1) * 256 + wc * 32 + 8 * fq;
        if (seg <= 1) {
            bf16* dK = (bf16*)(ws + (seg == 0 ? WS_QR : WS_K)); bf16* dQ = (bf16*)(ws + WS_Q);
#pragma unroll
            for (int ai = 0; ai < 2; ++ai)
#pragma unroll
                for (int m = 0; m < 4; ++m) { const int row = row0 + ai * 128 + m * 16, sq = row & (SEQ - 1); const int pos = (wc & 1) ? (sq & 63) : (sq >> 6);
                    f32x4 cs0 = (f32x4){1.f, 0.f, 1.f, 0.f}, cs1 = cs0;
                    if (latent) { cs0 = *(const LAS f32x4*)(ropeL + (pos * 16 + 4 * fq) * 2); cs1 = *(const LAS f32x4*)(ropeL + (pos * 16 + 4 * fq) * 2 + 4); }
                    const float cc[4] = {cs0[0], cs0[2], cs1[0], cs1[2]}, sn[4] = {cs0[1], cs0[3], cs1[1], cs1[3]};
#pragma unroll
                    for (int bj = 0; bj < 2; ++bj) { const f32x4 x1 = acc[ai][bj][m][0], x2 = acc[ai][bj][m][1]; float o1[4], o2[4];
#pragma unroll
                        for (int j = 0; j < 4; ++j) { o1[j] = x1[j] * cc[j] - x2[j] * sn[j]; o2[j] = x2[j] * cc[j] + x1[j] * sn[j]; }
                        size_t off = (size_t)row * SEGW + lcp + bj * 128;
                        if (seg == 0) *(u32x4*)(dQ + off) = (u32x4){pg8::cvt_pk_bf16(x1[0], x1[1]), pg8::cvt_pk_bf16(x1[2], x1[3]), pg8::cvt_pk_bf16(x2[0], x2[1]), pg8::cvt_pk_bf16(x2[2], x2[3])};
                        else { const int cf = lcp + bj * 128, bb_ = latent ? (row >> 11) : ((row - T) >> 8), tl = latent ? sq : (KTOK - LC + ((row - T) & (LC - 1)));
                            off = ((size_t)(bb_ * NAH + (cf >> 6)) * KTOK + tl) * NAD + (cf & 63); }
                        *(u32x4*)(dK + off) = (u32x4){pg8::cvt_pk_bf16(o1[0], o1[1]), pg8::cvt_pk_bf16(o1[2], o1[3]), pg8::cvt_pk_bf16(o2[0], o2[1]), pg8::cvt_pk_bf16(o2[2], o2[3])}; } }
            return;
        }
        bf16* dG = (bf16*)(ws + WS_G);
#pragma unroll
        for (int ai = 0; ai < 2; ++ai)
#pragma unroll
            for (int m = 0; m < 4; ++m) { const int row = row0 + ai * 128 + m * 16;
#pragma unroll
                for (int bj = 0; bj < 2; ++bj) { float x[8];
#pragma unroll
                    for (int j = 0; j < 4; ++j) { x[j] = silu_f(acc[ai][bj][m][0][j]); x[4 + j] = silu_f(acc[ai][bj][m][1][j]); }
                    *(u32x4*)(dG + (size_t)row * SEGW + lcp + bj * 128) = (u32x4){pg8::cvt_pk_bf16(x[0], x[1]), pg8::cvt_pk_bf16(x[2], x[3]), pg8::cvt_pk_bf16(x[4], x[5]), pg8::cvt_pk_bf16(x[6], x[7])}; } }
    }
};
struct EpiP {
    static constexpr bool PERM = true;
    bf16* P;
    __device__ __forceinline__ void operator()(const acc_t& acc, const Unit& u, int wr, int wc, int fr, int fq) const {
        const int col0 = u.pn * 256 + wc * 32 + 8 * fq; const int row0 = u.pm * 256 + wr * 64 + fr;
#pragma unroll
        for (int ai = 0; ai < 2; ++ai)
#pragma unroll
            for (int m = 0; m < 4; ++m)
#pragma unroll
                for (int bj = 0; bj < 2; ++bj) { const f32x4 v0 = acc[ai][bj][m][0], v1 = acc[ai][bj][m][1];
                    *(u32x4*)(P + (size_t)(row0 + ai * 128 + m * 16) * D + col0 + bj * 128) = (u32x4){pg8::cvt_pk_bf16(v0[0], v0[1]), pg8::cvt_pk_bf16(v0[2], v0[3]), pg8::cvt_pk_bf16(v1[0], v1[1]), pg8::cvt_pk_bf16(v1[2], v1[3])}; }
    }
};
struct EpiSwiGLU {
    static constexpr bool PERM = true;
    bf16* H;
    __device__ __forceinline__ void operator()(const acc_t& acc, const Unit& u, int wr, int wc, int fr, int fq) const {
        const int hc = u.pn * 128 + wc * 32 + 8 * fq; const int row0 = u.pm * 256 + wr * 64 + fr;
#pragma unroll
        for (int ai = 0; ai < 2; ++ai)
#pragma unroll
            for (int m = 0; m < 4; ++m) { float h[8];
#pragma unroll
                for (int n = 0; n < 2; ++n)
#pragma unroll
                    for (int j = 0; j < 4; ++j) h[n * 4 + j] = silu_f(acc[ai][0][m][n][j]) * acc[ai][1][m][n][j];
                u32x4 w; w.x = pg8::cvt_pk_bf16(h[0], h[1]); w.y = pg8::cvt_pk_bf16(h[2], h[3]); w.z = pg8::cvt_pk_bf16(h[4], h[5]); w.w = pg8::cvt_pk_bf16(h[6], h[7]);
                *(u32x4*)(H + (size_t)(row0 + ai * 128 + m * 16) * DE + hc) = w; }
    }
};
struct EpiMoeOut {
    static constexpr bool PERM = true;
    bf16* Y; const int* elist; const float* ewt;
    __device__ __forceinline__ void operator()(const acc_t& acc, const Unit& u, int wr, int wc, int fr, int fq) const {
        const int col0 = u.pn * 256 + wc * 32 + 8 * fq;
#pragma unroll
        for (int ai = 0; ai < 2; ++ai)
#pragma unroll
            for (int m = 0; m < 4; ++m) { const int rank = u.tm * 256 + ai * 128 + wr * 64 + m * 16 + fr;
                if (rank < u.cnt) { const int tk = elist[u.e * ECAP + rank]; const float w = ewt[u.e * ECAP + rank];
#pragma unroll
                    for (int bj = 0; bj < 2; ++bj) { const f32x4 v0 = acc[ai][bj][m][0] * w, v1 = acc[ai][bj][m][1] * w; u32x4 o;
                        o.x = pg8::cvt_pk_bf16(v0[0], v0[1]); o.y = pg8::cvt_pk_bf16(v0[2], v0[3]); o.z = pg8::cvt_pk_bf16(v1[0], v1[1]); o.w = pg8::cvt_pk_bf16(v1[2], v1[3]);
                        *(u32x4*)(Y + (size_t)tk * D + col0 + bj * 128) = o; } } }
    }
};
template <bool GATHER_> struct MoeOrder {
    static constexpr bool GATHER = GATHER_;
    const LAS int* tp; const int* elist; int G, c, nwg;
    __device__ bool next(int i, Unit& u) const {
        const long L = (long)i * G + c; if (L >= nwg) return false;
        int wgid = (int)L; { const int q = nwg / 8, r = nwg % 8, xcd = wgid % 8, off = wgid / 8; wgid = (xcd < r ? xcd * (q + 1) : r * (q + 1) + (xcd - r) * q) + off; }
        const int gt = wgid >> 2; int e = 0;
#pragma unroll
        for (int k = 1; k < 16; ++k) e = (gt >= tp[k]) ? k : e;
        u.pm = gt; u.pn = wgid & 3; u.e = e; u.tm = gt - tp[e]; u.cnt = tp[17 + e]; return true;
    }
    __device__ __forceinline__ int a_row0(const Unit& u) const { return u.pm * 256; }
    __device__ __forceinline__ int a_row(const Unit& u, int r) const {
        if constexpr (GATHER_) { int rank = u.tm * 256 + r; rank = rank < u.cnt ? rank : u.cnt - 1; return elist[u.e * ECAP + rank] >> 1; }
        else return u.pm * 256 + r;
    }
    __device__ __forceinline__ int b_row0(const Unit& u) const { return u.e * 1024 + u.pn * 256; }
    __device__ __forceinline__ bool perm(const Unit&) const { return true; }
};


constexpr int SWMASK = 0x7C;
constexpr int W_REL_XN = (int)(((long long)WS_WINT - (long long)WS_XN) / 2048);
struct ProjOrder {
    static constexpr bool GATHER = false;
    pg8::DenseOrder d;
    __device__ void init(int G_, int c_) { d.init(MROWS, INCOLS, G_, c_); }
    __device__ bool next(int i, Unit& u) const { if (!d.next(i, u)) return false; u.e = (SWMASK >> (u.pn >> 1)) & 1; return true; }
    __device__ __forceinline__ int a_row0(const Unit& u) const { return u.e ? W_REL_XN + u.pn * 256 : u.pm * 256; }
    __device__ __forceinline__ int a_row(const Unit& u, int r) const { return a_row0(u) + r; }
    __device__ __forceinline__ int b_row0(const Unit& u) const { return u.e ? -W_REL_XN + u.pm * 256 : u.pn * 256; }
    __device__ __forceinline__ bool perm(const Unit& u) const { return (u.pn >> 1) >= 2; }
};


__device__ __forceinline__ bf16x8 pack8(const f32x4& a, const f32x4& b) {
    u32x4 w; w.x = pg8::cvt_pk_bf16(a[0], a[1]); w.y = pg8::cvt_pk_bf16(a[2], a[3]); w.z = pg8::cvt_pk_bf16(b[0], b[1]); w.w = pg8::cvt_pk_bf16(b[2], b[3]);
    return __builtin_bit_cast(bf16x8, w);
}
typedef unsigned bu4 __attribute__((__vector_size__(16)));
__device__ __forceinline__ bf16x8 bload16(__amdgpu_buffer_rsrc_t r, unsigned voff, unsigned soff) { return __builtin_bit_cast(bf16x8, __builtin_amdgcn_raw_buffer_load_b128(r, (int)voff, (int)soff, 0)); }
#define NA_SB() __builtin_amdgcn_sched_barrier(0)
__device__ __forceinline__ bf16x8 sel8(bool c, const bf16x8 a, const bf16x8 b) { const u32x4 x = __builtin_bit_cast(u32x4, a), y = __builtin_bit_cast(u32x4, b); u32x4 r;
    r.x = c ? x.x : y.x; r.y = c ? x.y : y.y; r.z = c ? x.z : y.z; r.w = c ? x.w : y.w; return __builtin_bit_cast(bf16x8, r); }
__device__ __forceinline__ void na_row(int b, int h, int r, const bf16* Q, const bf16* QR, __amdgpu_buffer_rsrc_t srdK, __amdgpu_buffer_rsrc_t srdV, bf16* MIX, const LAS float* rpbL, LAS unsigned char* qL, int lane) {
    const int qi = lane & 15, g = lane >> 4, rg = qi >> 2;
    constexpr float SC = 0.125f * 1.44269504f; const float NEG = -1e30f;
    int rs = r - 4; rs = rs < 0 ? 0 : (rs > NROWS - 8 ? NROWS - 8 : rs);
    const int tok0 = b * SEQ + r * GW;
    const unsigned klane = (unsigned)((8 * rg + (qi & 3)) * NAD + 8 * g) * 2u;
    const unsigned vlane = (unsigned)(qi * 64 + 8 * g) * 2u;
    const bool selK1 = (rg == 0), selK2 = (rg != 3), selV1 = (g == 0), selV2 = (g != 3);
#define NA_P0(j) ((j) == 0 ? 0 : (j) == 1 ? 1 : (j) == 2 ? 3 : 4)
#define NA_BB(j) (8 * (NA_P0(j) + ((g - NA_P0(j)) & 3)) - (16 * (j) + qi) + 31)
#define NA_LO(j) (((j) == 0 ? (qi < 8 ? 31 - qi : 23) : (j) == 3 ? (qi > 8 ? 31 - qi : 23) : 23) - NA_BB(j))
    f32x4 o[4][4]; float mref[4], lsum[4];
#pragma unroll
    for (int j = 0; j < 4; ++j) { mref[j] = 0.f; lsum[j] = 0.f;
#pragma unroll
        for (int dt = 0; dt < 4; ++dt) o[j][dt] = (f32x4){0.f, 0.f, 0.f, 0.f}; }
    bf16x8 kf[2][2][2], vf[2][4], Bp[4];
    LAS bf16x8* qs = (LAS bf16x8*)qL + lane;
#pragma unroll
    for (int j = 0; j < 4; ++j) { const bf16* qp = QR + (size_t)(tok0 + 16 * j + qi) * SEGW + h * NAD + 8 * g; qs[(2 * j) * 64] = *(const bf16x8*)qp; qs[(2 * j + 1) * 64] = *(const bf16x8*)(qp + 32); }
    const unsigned bh = (unsigned)(b * NAH + h);
    const unsigned ks0 = (bh * KTOK + (unsigned)(rs * GW)) * (NAD * 2u), vs0 = (bh * (KTOK / 64) + (unsigned)rs) * (NAD * 64 * 2u);
#define NA_KLD(so) do { _Pragma("unroll") for (int H = 0; H < 2; ++H) _Pragma("unroll") for (int m = 0; m < 2; ++m) _Pragma("unroll") for (int k = 0; k < 2; ++k) \
        kf[H][m][k] = bload16(srdK, klane, (so) + (unsigned)(H * 32 * NAD * 2 + m * 4 * NAD * 2 + k * 64)); } while (0)
#define NA_VLD(so) do { _Pragma("unroll") for (int H = 0; H < 2; ++H) _Pragma("unroll") for (int dt = 0; dt < 4; ++dt) \
        vf[H][dt] = bload16(srdV, vlane, (so) + (unsigned)(H * 64) + (unsigned)dt * (16 * 64 * 2)); } while (0)
    NA_KLD(ks0); NA_VLD(vs0);
    const LAS float* bp0 = rpbL + (h * 15 + rs - r + 7) * 64;
#pragma unroll 1
    for (int i = 0; i < 8; ++i) {
        const LAS float* bpi = bp0 + i * 64;
        NA_SB();
#pragma unroll
        for (int j = 0; j < 4; ++j) {
            f32x4 s0, s1; const bf16x8 q0 = qs[(2 * j) * 64], q1 = qs[(2 * j + 1) * 64];
            { const bf16x8 a00 = (j == 0) ? kf[0][0][0] : (j == 3) ? kf[1][0][0] : sel8(j == 1 ? selK1 : selK2, kf[1][0][0], kf[0][0][0]);
              const bf16x8 a01 = (j == 0) ? kf[0][0][1] : (j == 3) ? kf[1][0][1] : sel8(j == 1 ? selK1 : selK2, kf[1][0][1], kf[0][0][1]);
              const bf16x8 a10 = (j == 0) ? kf[0][1][0] : (j == 3) ? kf[1][1][0] : sel8(j == 1 ? selK1 : selK2, kf[1][1][0], kf[0][1][0]);
              const bf16x8 a11 = (j == 0) ? kf[0][1][1] : (j == 3) ? kf[1][1][1] : sel8(j == 1 ? selK1 : selK2, kf[1][1][1], kf[0][1][1]);
              s0 = __builtin_amdgcn_mfma_f32_16x16x32_bf16(a00, q0, (f32x4){0.f, 0.f, 0.f, 0.f}, 0, 0, 0); s0 = __builtin_amdgcn_mfma_f32_16x16x32_bf16(a01, q1, s0, 0, 0, 0);
              s1 = __builtin_amdgcn_mfma_f32_16x16x32_bf16(a10, q0, (f32x4){0.f, 0.f, 0.f, 0.f}, 0, 0, 0); s1 = __builtin_amdgcn_mfma_f32_16x16x32_bf16(a11, q1, s1, 0, 0, 0); }
            const int lo_j = NA_LO(j); const LAS float* bpj = bpi + NA_BB(j);
            { float b0 = bpj[0], b1 = bpj[1], b2 = bpj[2], b3 = bpj[3];
              asm volatile("" : "+v"(b0), "+v"(b1), "+v"(b2), "+v"(b3));
              const float bq[4] = {b0, b1, b2, b3};
#pragma unroll
              for (int e = 0; e < 4; ++e) { const float t0 = s0[e] * SC + bq[e]; s0[e] = ((unsigned)(e - lo_j) < 16u) ? t0 : NEG; } }
            { float b0 = bpj[4], b1 = bpj[5], b2 = bpj[6], b3 = bpj[7];
              asm volatile("" : "+v"(b0), "+v"(b1), "+v"(b2), "+v"(b3));
              const float bq[4] = {b0, b1, b2, b3};
#pragma unroll
              for (int e = 0; e < 4; ++e) { const float t1 = s1[e] * SC + bq[e]; s1[e] = ((unsigned)(4 + e - lo_j) < 16u) ? t1 : NEG; } }
            if (i == 0) { float mx = fmaxf(fmaxf(fmaxf(s0[0], s0[1]), fmaxf(s0[2], s0[3])), fmaxf(fmaxf(s1[0], s1[1]), fmaxf(s1[2], s1[3])));
                mx = fmaxf(mx, __shfl_xor(mx, 16)); mx = fmaxf(mx, __shfl_xor(mx, 32)); mref[j] = mx; }
            float ps = 0.f;
#pragma unroll
            for (int e = 0; e < 4; ++e) { s0[e] = __builtin_amdgcn_exp2f(fminf(s0[e] - mref[j], 100.f)); s1[e] = __builtin_amdgcn_exp2f(fminf(s1[e] - mref[j], 100.f)); ps += s0[e] + s1[e]; }
            lsum[j] += ps; Bp[j] = pack8(s0, s1);
            if (j == 1) { asm volatile("" : "+v"(Bp[0]), "+v"(Bp[1])); NA_SB(); }
        }
        asm volatile("" : "+v"(Bp[0]), "+v"(Bp[1]), "+v"(Bp[2]), "+v"(Bp[3]));
        NA_SB();
        if (i < 7) NA_KLD(ks0 + (unsigned)(i + 1) * (GW * NAD * 2));
        NA_SB();
#pragma unroll
        for (int j = 0; j < 4; ++j) {
#pragma unroll
            for (int dt = 0; dt < 4; ++dt) { const bf16x8 A = (j == 0) ? vf[0][dt] : (j == 3) ? vf[1][dt] : sel8(j == 1 ? selV1 : selV2, vf[1][dt], vf[0][dt]);
                o[j][dt] = __builtin_amdgcn_mfma_f32_16x16x32_bf16(A, Bp[j], o[j][dt], 0, 0, 0); }
            asm volatile("" : "+v"(o[j][0]), "+v"(o[j][1]), "+v"(o[j][2]), "+v"(o[j][3]));
            if (j == 1) NA_SB(); }
        NA_SB();
        if (i < 7) NA_VLD(vs0 + (unsigned)(i + 1) * (NAD * 64 * 2));
    }
#pragma unroll
    for (int j = 0; j < 4; ++j) { const bf16* qp = Q + (size_t)(tok0 + 16 * j + qi) * SEGW + h * NAD + 8 * g; qs[(2 * j) * 64] = *(const bf16x8*)qp; qs[(2 * j + 1) * 64] = *(const bf16x8*)(qp + 32); }
    const unsigned kc0 = (bh * KTOK + (unsigned)SEQ) * (NAD * 2u), vc0 = (bh * (KTOK / 64) + (unsigned)(SEQ / 64)) * (NAD * 64 * 2u);
#define NA_KLDC(so) do { _Pragma("unroll") for (int m = 0; m < 2; ++m) _Pragma("unroll") for (int k = 0; k < 2; ++k) kf[0][m][k] = bload16(srdK, klane, (so) + (unsigned)(m * 4 * NAD * 2 + k * 64)); } while (0)
#define NA_VLDC(so) do { _Pragma("unroll") for (int dt = 0; dt < 4; ++dt) vf[0][dt] = bload16(srdV, vlane, (so) + (unsigned)dt * (16 * 64 * 2)); } while (0)
    NA_KLDC(kc0); NA_VLDC(vc0);
#pragma unroll 1
    for (int i = 0; i < 8; ++i) {
        NA_SB();
#pragma unroll
        for (int j = 0; j < 4; ++j) {
            const bf16x8 q0 = qs[(2 * j) * 64], q1 = qs[(2 * j + 1) * 64];
            f32x4 s0 = __builtin_amdgcn_mfma_f32_16x16x32_bf16(kf[0][0][0], q0, (f32x4){0.f, 0.f, 0.f, 0.f}, 0, 0, 0); s0 = __builtin_amdgcn_mfma_f32_16x16x32_bf16(kf[0][0][1], q1, s0, 0, 0, 0);
            f32x4 s1 = __builtin_amdgcn_mfma_f32_16x16x32_bf16(kf[0][1][0], q0, (f32x4){0.f, 0.f, 0.f, 0.f}, 0, 0, 0); s1 = __builtin_amdgcn_mfma_f32_16x16x32_bf16(kf[0][1][1], q1, s1, 0, 0, 0);
            float ps = 0.f;
#pragma unroll
            for (int e = 0; e < 4; ++e) { s0[e] = __builtin_amdgcn_exp2f(fminf(s0[e] * SC - mref[j], 100.f)); s1[e] = __builtin_amdgcn_exp2f(fminf(s1[e] * SC - mref[j], 100.f)); ps += s0[e] + s1[e]; }
            lsum[j] += ps; Bp[j] = pack8(s0, s1);
        }
        asm volatile("" : "+v"(Bp[0]), "+v"(Bp[1]), "+v"(Bp[2]), "+v"(Bp[3]));
        NA_SB();
        if (i < 7) NA_KLDC(kc0 + (unsigned)(i + 1) * (32 * NAD * 2));
        NA_SB();
#pragma unroll
        for (int j = 0; j < 4; ++j)
#pragma unroll
            for (int dt = 0; dt < 4; ++dt) o[j][dt] = __builtin_amdgcn_mfma_f32_16x16x32_bf16(vf[0][dt], Bp[j], o[j][dt], 0, 0, 0);
#pragma unroll
        for (int j = 0; j < 4; ++j) asm volatile("" : "+v"(o[j][0]), "+v"(o[j][1]), "+v"(o[j][2]), "+v"(o[j][3]));
        NA_SB();
        if (i < 7) NA_VLDC(vc0 + (unsigned)(((i + 1) >> 1) * (NAD * 64 * 2) + ((i + 1) & 1) * 64));
    }
#undef NA_KLD
#undef NA_VLD
#undef NA_KLDC
#undef NA_VLDC
#pragma unroll
    for (int j = 0; j < 4; ++j) { float l = lsum[j]; l += __shfl_xor(l, 16); l += __shfl_xor(l, 32); const float inv = 1.f / l;
        bf16* op = MIX + (size_t)(tok0 + 16 * j + qi) * D + h * NAD + 4 * g;
#pragma unroll
        for (int dt = 0; dt < 4; ++dt) { const f32x4 v = o[j][dt] * inv; *(v2u*)(op + 16 * dt) = (v2u){pg8::cvt_pk_bf16(v[0], v[1]), pg8::cvt_pk_bf16(v[2], v[3])}; } }
}

typedef float f32x16 __attribute__((ext_vector_type(16)));
constexpr int SC_Q1 = 0, SC_K1 = SC_Q1 + 64 * 272, SC_K1T = SC_K1 + 64 * 272, SC_VT = SC_K1T + 128 * 144, SC_AB = SC_VT + 128 * 144, SC_ST = SC_AB + 64 * 144, SC_TOT = SC_ST + 128 * 272, SC_END = SC_TOT + 2 * 4 * 128 * 4;
static_assert(SC_END <= RING_BYTES, "scan LDS");
#define SCAN_MFMA(a, b, c) __builtin_amdgcn_mfma_f32_32x32x16_bf16(a, b, c, 0, 0, 0)
__device__ __forceinline__ void scan_unit(LAS unsigned char* lds, int b, int h, int dir, const unsigned short* LGT, const bf16* HQT, const bf16* HIT, bf16* OUT, int tid) {
    const int lane = tid & 63, w = __builtin_amdgcn_readfirstlane(tid >> 6), r = lane & 31, hh = lane >> 5;
    const int d = tid & 127, tq = tid >> 7;
    const int ti = w >> 2, ovi = w & 3;
    const int di = w >> 1, svi = 2 * (w & 1);
    f32x16 S0, S1;
#pragma unroll
    for (int i = 0; i < 16; ++i) { S0[i] = 0.f; S1[i] = 0.f; }
    const size_t chrow = (size_t)(h * HGD + d);
    constexpr int NCH = (LC + SEQ) / 64;
    auto col_of = [&](int c) -> int { return c < 4 ? (T + b * LC + 64 * (dir ? 3 - c : c)) : (b * SEQ + (dir ? SEQ - 64 * (c - 3) : 64 * (c - 4))); };
    u32x4 lgr[2], vr[2], qr[2];
    { const int c0 = col_of(0) + 16 * tq; lgr[0] = *(const u32x4*)(LGT + chrow * MROWS + c0); lgr[1] = *(const u32x4*)(LGT + chrow * MROWS + c0 + 8);
      vr[0] = *(const u32x4*)(HIT + chrow * MROWS + c0); vr[1] = *(const u32x4*)(HIT + chrow * MROWS + c0 + 8); qr[0] = qr[1] = (u32x4){0u, 0u, 0u, 0u}; }
#pragma unroll 1
    for (int c = 0; c < NCH; ++c) {
        const bool lat = c >= 4; const int par = c & 1;
        LAS float* tot = (LAS float*)(lds + SC_TOT) + par * 512;
        float P[16];
#pragma unroll
        for (int i = 0; i < 8; ++i) { const unsigned u2 = lgr[i >> 2][i & 3]; P[2 * i] = h2f((unsigned short)(u2 & 0xffff)); P[2 * i + 1] = h2f((unsigned short)(u2 >> 16)); }
        float kk[16];
#pragma unroll
        for (int i = 0; i < 16; ++i) kk[i] = 1.f - __builtin_amdgcn_exp2f(P[i]);
        if (!dir) {
#pragma unroll
            for (int i = 1; i < 16; ++i) P[i] += P[i - 1];
            tot[tq * 128 + d] = P[15];
        } else {
#pragma unroll
            for (int i = 14; i >= 0; --i) P[i] += P[i + 1];
            tot[tq * 128 + d] = P[0];
        }
        const u32x4 vcur0 = vr[0], vcur1 = vr[1], qcur0 = qr[0], qcur1 = qr[1];
        if (c + 1 < NCH) { const int c1 = col_of(c + 1) + 16 * tq;
            lgr[0] = *(const u32x4*)(LGT + chrow * MROWS + c1); lgr[1] = *(const u32x4*)(LGT + chrow * MROWS + c1 + 8);
            vr[0] = *(const u32x4*)(HIT + chrow * MROWS + c1); vr[1] = *(const u32x4*)(HIT + chrow * MROWS + c1 + 8);
            if (c + 1 >= 4) { qr[0] = *(const u32x4*)(HQT + chrow * T + c1); qr[1] = *(const u32x4*)(HQT + chrow * T + c1 + 8); } }
        __syncthreads();
        {
            const float t0 = tot[d], t1 = tot[128 + d], t2 = tot[256 + d], t3 = tot[384 + d];
            const float Bm = dir ? (t2 + t3) : (t0 + t1);
            float offs; if (!dir) offs = (tq > 0 ? t0 : 0.f) + (tq > 1 ? t1 : 0.f) + (tq > 2 ? t2 : 0.f); else offs = (tq < 3 ? t3 : 0.f) + (tq < 2 ? t2 : 0.f) + (tq < 1 ? t1 : 0.f);
            const float sh = offs - Bm;
            unsigned kt[8];
            LAS bf16* q1 = (LAS bf16*)(lds + SC_Q1) + (16 * tq) * 136 + d; LAS bf16* k1 = (LAS bf16*)(lds + SC_K1) + (16 * tq) * 136 + d;
#pragma unroll
            for (int i = 0; i < 16; i += 2) {
                const float x0 = fminf(fmaxf(P[i] + sh, -120.f), 120.f), x1 = fminf(fmaxf(P[i + 1] + sh, -120.f), 120.f);
                const float e0 = __builtin_amdgcn_exp2f(x0), e1 = __builtin_amdgcn_exp2f(x1);
                const float k0 = kk[i] * __builtin_amdgcn_exp2f(-x0), k1v = kk[i + 1] * __builtin_amdgcn_exp2f(-x1);
                kt[i >> 1] = pg8::cvt_pk_bf16(k0, k1v);
                if (lat) { const unsigned qq = (i < 8 ? qcur0 : qcur1)[(i >> 1) & 3];
                    const unsigned qp2 = pg8::cvt_pk_bf16(bflo(qq) * e0, bfhi(qq) * e1); q1[i * 136] = (bf16)(qp2 & 0xffff); q1[(i + 1) * 136] = (bf16)(qp2 >> 16);
                    k1[i * 136] = (bf16)(kt[i >> 1] & 0xffff); k1[(i + 1) * 136] = (bf16)(kt[i >> 1] >> 16); }
            }
            LAS unsigned char* k1t = lds + SC_K1T + d * 144 + 32 * tq;
            *(LAS u32x4*)k1t = (u32x4){kt[0], kt[1], kt[2], kt[3]}; *(LAS u32x4*)(k1t + 16) = (u32x4){kt[4], kt[5], kt[6], kt[7]};
            LAS unsigned char* vt = lds + SC_VT + d * 144 + 32 * tq;
            *(LAS u32x4*)vt = vcur0; *(LAS u32x4*)(vt + 16) = vcur1;
        }
        if (lat) {
#pragma unroll
            for (int rg = 0; rg < 4; ++rg) { const int dd = 32 * di + 8 * rg + 4 * hh;
                const f32x4 a0 = *(const LAS f32x4*)(tot + dd), a1 = *(const LAS f32x4*)(tot + 128 + dd), a2 = *(const LAS f32x4*)(tot + 256 + dd), a3 = *(const LAS f32x4*)(tot + 384 + dd);
                const f32x4 bm = dir ? (a2 + a3) : (a0 + a1); float eb[4];
#pragma unroll
                for (int j = 0; j < 4; ++j) eb[j] = __builtin_amdgcn_exp2f(bm[j]);
                *(LAS v2u*)(lds + SC_ST + ((32 * svi + r) * 136 + dd) * 2) = (v2u){pg8::cvt_pk_bf16(S0[4 * rg] * eb[0], S0[4 * rg + 1] * eb[1]), pg8::cvt_pk_bf16(S0[4 * rg + 2] * eb[2], S0[4 * rg + 3] * eb[3])};
                *(LAS v2u*)(lds + SC_ST + ((32 * (svi + 1) + r) * 136 + dd) * 2) = (v2u){pg8::cvt_pk_bf16(S1[4 * rg] * eb[0], S1[4 * rg + 1] * eb[1]), pg8::cvt_pk_bf16(S1[4 * rg + 2] * eb[2], S1[4 * rg + 3] * eb[3])}; }
        }
        __syncthreads();
        f32x16 dS0, dS1, O;
#pragma unroll
        for (int i = 0; i < 16; ++i) { dS0[i] = 0.f; dS1[i] = 0.f; O[i] = 0.f; }
#pragma unroll
        for (int ks = 0; ks < 4; ++ks) {
            const bf16x8 a = *(const LAS bf16x8*)(lds + SC_K1T + ((32 * di + r) * 72 + 16 * ks + 8 * hh) * 2);
            const bf16x8 b0 = *(const LAS bf16x8*)(lds + SC_VT + ((32 * svi + r) * 72 + 16 * ks + 8 * hh) * 2), b1 = *(const LAS bf16x8*)(lds + SC_VT + ((32 * (svi + 1) + r) * 72 + 16 * ks + 8 * hh) * 2);
            dS0 = SCAN_MFMA(a, b0, dS0); dS1 = SCAN_MFMA(a, b1, dS1);
        }
        if (lat) {
#pragma unroll
            for (int ks = 0; ks < 8; ++ks) {
                const bf16x8 a = *(const LAS bf16x8*)(lds + SC_ST + ((32 * ovi + r) * 136 + 16 * ks + 8 * hh) * 2);
                const bf16x8 bq = *(const LAS bf16x8*)(lds + SC_Q1 + ((32 * ti + r) * 136 + 16 * ks + 8 * hh) * 2);
                O = SCAN_MFMA(a, bq, O);
            }
            if (w < 4) {
                const int asi = (w == 0) ? 0 : (w == 1) ? 1 : (w == 2) ? (dir ? 1 : 0) : (dir ? 0 : 1);
                const int ati = (w == 0) ? 0 : (w == 1) ? 1 : (w == 2) ? (dir ? 0 : 1) : (dir ? 1 : 0);
                f32x16 At;
#pragma unroll
                for (int i = 0; i < 16; ++i) At[i] = 0.f;
                if (w < 3) {
#pragma unroll
                    for (int ks = 0; ks < 8; ++ks) {
                        const bf16x8 a = *(const LAS bf16x8*)(lds + SC_K1 + ((32 * asi + r) * 136 + 16 * ks + 8 * hh) * 2);
                        const bf16x8 bq = *(const LAS bf16x8*)(lds + SC_Q1 + ((32 * ati + r) * 136 + 16 * ks + 8 * hh) * 2);
                        At = SCAN_MFMA(a, bq, At);
                    }
                }
                const int tt = 32 * ati + r;
#pragma unroll
                for (int rg = 0; rg < 4; ++rg) { const int s0 = 32 * asi + 8 * rg + 4 * hh; float v[4];
#pragma unroll
                    for (int j = 0; j < 4; ++j) { const int ss = s0 + j; const bool keep = dir ? (ss >= tt) : (ss <= tt); v[j] = keep ? At[4 * rg + j] : 0.f; }
                    *(LAS v2u*)(lds + SC_AB + (tt * 72 + s0) * 2) = (v2u){pg8::cvt_pk_bf16(v[0], v[1]), pg8::cvt_pk_bf16(v[2], v[3])}; }
            }
            __syncthreads();
#pragma unroll
            for (int ks = 0; ks < 4; ++ks) {
                const bf16x8 a = *(const LAS bf16x8*)(lds + SC_VT + ((32 * ovi + r) * 72 + 16 * ks + 8 * hh) * 2);
                const bf16x8 bq = *(const LAS bf16x8*)(lds + SC_AB + ((32 * ti + r) * 72 + 16 * ks + 8 * hh) * 2);
                O = SCAN_MFMA(a, bq, O);
            }
            bf16* op = OUT + (size_t)(col_of(c) + 32 * ti + r) * SEGW + h * HGD + 32 * ovi + 4 * hh;
#pragma unroll
            for (int rg = 0; rg < 4; ++rg) *(v2u*)(op + 8 * rg) = (v2u){pg8::cvt_pk_bf16(O[4 * rg], O[4 * rg + 1]), pg8::cvt_pk_bf16(O[4 * rg + 2], O[4 * rg + 3])};
        }
#pragma unroll
        for (int rg = 0; rg < 4; ++rg) { const int dd = 32 * di + 8 * rg + 4 * hh;
            const f32x4 a0 = *(const LAS f32x4*)(tot + dd), a1 = *(const LAS f32x4*)(tot + 128 + dd), a2 = *(const LAS f32x4*)(tot + 256 + dd), a3 = *(const LAS f32x4*)(tot + 384 + dd);
            const f32x4 be = (a0 + a1) + (a2 + a3), bm = dir ? (a2 + a3) : (a0 + a1);
#pragma unroll
            for (int j = 0; j < 4; ++j) { const float ee = __builtin_amdgcn_exp2f(be[j]), em = __builtin_amdgcn_exp2f(be[j] - bm[j]);
                S0[4 * rg + j] = ee * S0[4 * rg + j] + em * dS0[4 * rg + j]; S1[4 * rg + j] = ee * S1[4 * rg + j] + em * dS1[4 * rg + j]; } }
    }
}


#ifdef DBG_NAIVE
__device__ __forceinline__ void scan_naive(LAS unsigned char* lds, int b, int h, int dir, const unsigned short* LGT, const bf16* HQT, const bf16* HIT, bf16* OUT, int tid) {
    const int dv = tid & 127, kg = tid >> 7;
    float St[32];
#pragma unroll
    for (int i = 0; i < 32; ++i) St[i] = 0.f;
    LAS float* sq = (LAS float*)lds; LAS float* sk = sq + 16 * 128; LAS float* sf = sk + 16 * 128; LAS float* sv = sf + 16 * 128; LAS float* so = sv + 16 * 128;
    constexpr int NSTEP = LC + SEQ;
    for (int j0 = 0; j0 < NSTEP; j0 += 16) {
        const bool isctx = j0 < LC;
        for (int idx = tid; idx < 16 * 128; idx += NTHR) { const int st = idx >> 7, ch = idx & 127, j = j0 + st;
            int col; if (j < LC) col = T + b * LC + (dir ? (LC - 1 - j) : j); else col = b * SEQ + (dir ? (SEQ - 1 - (j - LC)) : (j - LC));
            const size_t cr = (size_t)(h * HGD + ch);
            const float f = __builtin_amdgcn_exp2f(h2f(LGT[cr * MROWS + col]));
            sf[st * 128 + ch] = f; sk[st * 128 + ch] = 1.f - f; sv[st * 128 + ch] = bf2f(HIT[cr * MROWS + col]);
            if (!isctx) sq[st * 128 + ch] = bf2f(HQT[cr * T + col]); }
        __syncthreads();
        for (int st = 0; st < 16; ++st) {
            const float vv = sv[st * 128 + dv]; float o = 0.f;
#pragma unroll
            for (int i = 0; i < 32; ++i) { St[i] = sf[st * 128 + kg * 32 + i] * St[i] + sk[st * 128 + kg * 32 + i] * vv; o += St[i] * sq[st * 128 + kg * 32 + i]; }
            so[(st * 4 + kg) * 128 + dv] = o;
        }
        __syncthreads();
        if (!isctx) {
            for (int idx = tid; idx < 16 * 128; idx += NTHR) { const int st = idx >> 7, dd = idx & 127, j = j0 + st;
                const float o = (so[(st * 4 + 0) * 128 + dd] + so[(st * 4 + 1) * 128 + dd]) + (so[(st * 4 + 2) * 128 + dd] + so[(st * 4 + 3) * 128 + dd]);
                const int row = b * SEQ + (dir ? (SEQ - 1 - (j - LC)) : (j - LC));
                OUT[(size_t)row * SEGW + h * HGD + dd] = (bf16)f2bf(o); }
        }
        __syncthreads();
    }
}
#endif

__device__ __forceinline__ void transpose_item(const float* W, int ldw, int k0, int n0, bf16* WT, int ldk, int drow0, LAS float* scr, int lane) {
#pragma unroll 8
    for (int i = 0; i < 32; ++i) { const int kk = 2 * i + (lane >> 5); scr[kk * 33 + (lane & 31)] = W[(size_t)(k0 + kk) * ldw + n0 + (lane & 31)]; }
    LDS_WAIT(); asm volatile("" ::: "memory");
    const int c = lane & 7;
#pragma unroll
    for (int j = 0; j < 4; ++j) { const int n = (lane >> 3) + 8 * j; const LAS float* s = scr + (8 * c) * 33 + n;
        v4u o; o.x = pk2(s[0 * 33], s[1 * 33]); o.y = pk2(s[2 * 33], s[3 * 33]); o.z = pk2(s[4 * 33], s[5 * 33]); o.w = pk2(s[6 * 33], s[7 * 33]);
        *(GAS v4u*)(WT + (size_t)(drow0 + n) * ldk + k0 + 8 * c) = o; }
    LDS_WAIT(); asm volatile("" ::: "memory");
}

struct Args { const float* in[21]; float* out; unsigned char* ws; int ph_lo, ph_hi, li, pad; };

__global__ void __launch_bounds__(NTHR, 2) fwd_mega(Args args) {
    extern __shared__ __attribute__((aligned(16))) unsigned char lds_raw[];
    LAS unsigned char* lds = (LAS unsigned char*)lds_raw;
    volatile LAS unsigned* MISC = (volatile LAS unsigned*)(lds + MISC_OFF);
    const int tid = threadIdx.x, lane = tid & 63, wave = __builtin_amdgcn_readfirstlane(tid >> 6);
    const int G = gridDim.x; const int bx = blockIdx.x; const int vcu = (G % 8 == 0) ? (bx % 8) * (G / 8) + bx / 8 : bx;
    gu32* ctl0 = (gu32*)(args.ws + WS_CTL);
    const int gw = vcu * NWAVES + wave, NGW = G * NWAVES;
    for (int u = tid; u < (LDS_BYTES - LDSCTL_OFF) / 4; u += NTHR) ((LAS unsigned*)(lds + LDSCTL_OFF))[u] = 0u;
    __syncthreads();
    XcdBarrier bar = xcd_barrier_post((unsigned*)(ctl0 + CW_BAR) + args.li * XCD_BAR_WORDS, MISC + 8);
    const int lo = args.ph_lo, hi = args.ph_hi;
#ifndef PHMASK
#define PHMASK 0xFFFF
#endif
#define IN(k) (((PHMASK >> (k)) & 1) && lo <= (k) && (k) < hi)
#define SEAM(k) do { if (IN(k) && IN((k) + 1)) xcd_barrier(bar); } while (0)

#define KA(i) ({ const __attribute__((address_space(4))) Args* _p = (const __attribute__((address_space(4))) Args*)__builtin_amdgcn_kernarg_segment_ptr(); asm volatile("" : "+s"(_p)); _p->in[i]; })
#define WSP() ({ const __attribute__((address_space(4))) Args* _p = (const __attribute__((address_space(4))) Args*)__builtin_amdgcn_kernarg_segment_ptr(); asm volatile("" : "+s"(_p)); _p->ws; })
#define PHASE_PTRS unsigned char* ws = WSP(); float* MOD = (float*)(ws + WS_MOD); float* ROPE = (float*)(ws + WS_ROPE); float* LBT = (float*)(ws + WS_LBT); \
    bf16* WinT = (bf16*)(ws + WS_WINT); bf16* WoutT = (bf16*)(ws + WS_WOUTT); bf16* W13T = (bf16*)(ws + WS_W13T); bf16* W2T = (bf16*)(ws + WS_W2T); \
    bf16* XN = (bf16*)(ws + WS_XN); bf16* MIX = (bf16*)(ws + WS_MIX); bf16* XN2 = (bf16*)(ws + WS_XN2); \
    float* X1 = (float*)(ws + WS_X1); bf16* Hb = (bf16*)(ws + WS_H); bf16* Yb = (bf16*)(ws + WS_Y); \
    int* ELIST = (int*)(ws + WS_ELIST); float* EWT = (float*)(ws + WS_EWT); gu32* ctl = (gu32*)(ws + WS_CTL); \
    (void)MOD; (void)ROPE; (void)LBT; (void)WinT; (void)WoutT; (void)W13T; (void)W2T; (void)XN; (void)MIX; (void)XN2; (void)X1; (void)Hb; (void)Yb; (void)ELIST; (void)EWT; (void)ctl;
    if (IN(0)) {
        PHASE_PTRS
        const float* cvec = KA(1); const float* c_ctx = KA(3); const float* w_mod = KA(4); const float* b_mod = KA(5); const float* w_in = KA(8); const float* w_out = KA(9);
        const float* hg_lb = KA(11); const float* w1 = KA(17); const float* w3 = KA(18); const float* w2 = KA(19);
        if (bx == G - 1) {
            for (int idx = tid; idx < 1024; idx += NTHR) { const int pos = idx >> 4, i = idx & 15;
                double th = 1.0; for (int k = 0; k < i; ++k) th *= 0.5623413251903491;
                const double t2 = th * th; double c = 1.0, s = th, tc = 1.0, ts = th;
                for (int n = 1; n <= 12; ++n) { tc *= -t2 / (double)((2 * n - 1) * (2 * n)); c += tc; ts *= -t2 / (double)((2 * n) * (2 * n + 1)); s += ts; }
                double cr = 1.0, ci = 0.0; for (int p = 0; p < pos; ++p) { const double nr = cr * c - ci * s; ci = cr * s + ci * c; cr = nr; }
                ROPE[idx * 2] = (float)cr; ROPE[idx * 2 + 1] = (float)ci; }
            for (int idx = tid; idx < 1024; idx += NTHR) { const float h0 = hg_lb[idx], h1 = hg_lb[1024 + idx]; LBT[idx] = 1.f / (1.f + expf(h1 - h0)); }
        }
        if (bx < 96) {
            LAS float* sc = (LAS float*)lds;
            for (int idx = tid; idx < 17 * 1024; idx += NTHR) { const int r = idx >> 10, k = idx & 1023; const float cv = r < 16 ? cvec[r * 1024 + k] : c_ctx[k]; sc[idx] = cv / (1.f + expf(-cv)); }
            __syncthreads();
            const int col = 64 * bx + lane, k0 = 128 * wave;
            float acc[17];
#pragma unroll
            for (int r = 0; r < 17; ++r) acc[r] = 0.f;
            for (int kk = 0; kk < 128; kk += 4) {
                const float w0 = w_mod[(size_t)(k0 + kk) * 6144 + col], w1v = w_mod[(size_t)(k0 + kk + 1) * 6144 + col], w2v = w_mod[(size_t)(k0 + kk + 2) * 6144 + col], w3v = w_mod[(size_t)(k0 + kk + 3) * 6144 + col];
#pragma unroll
                for (int r = 0; r < 17; ++r) { const f32x4 a = *(const LAS f32x4*)(sc + r * 1024 + k0 + kk); acc[r] += a[0] * w0 + a[1] * w1v + a[2] * w2v + a[3] * w3v; }
            }
            LAS float* red = (LAS float*)(lds + 17 * 1024 * 4);
#pragma unroll
            for (int r = 0; r < 17; ++r) red[(wave * 17 + r) * 64 + lane] = acc[r];
            __syncthreads();
            for (int idx = tid; idx < 17 * 64; idx += NTHR) { const int r = idx >> 6, l = idx & 63; float s = 0.f;
#pragma unroll
                for (int w = 0; w < 8; ++w) s += red[(w * 17 + r) * 64 + l];
                MOD[r * 6144 + 64 * bx + l] = s + b_mod[64 * bx + l]; }
            __syncthreads();
        }
        {
            LAS float* scr = (LAS float*)(lds + wave * 16384);
            constexpr int I_IN = 16 * 128, I_OUT = 16 * 32, I_13 = 16 * 2 * 256, I_2 = 16 * 256, NIT = I_IN + I_OUT + I_13 + I_2;
            for (int it = gw; it < NIT; it += NGW) {
                int r = it;
                if (r < I_IN) { const int kb = r / 128, nb = r % 128; transpose_item(w_in, INCOLS, 64 * kb, 32 * nb, WinT, 1024, 32 * nb, scr, lane); continue; } r -= I_IN;
                if (r < I_OUT) { const int kb = r / 32, nb = r % 32; transpose_item(w_out, 1024, 64 * kb, 32 * nb, WoutT, 1024, 32 * nb, scr, lane); continue; } r -= I_OUT;
                if (r < I_13) { const int e = r / 512, rem = r % 512, s = rem / 256, r2 = rem % 256, kb = r2 / 16, nb = r2 % 16, n0 = 32 * nb;
                    transpose_item((s ? w3 : w1) + (size_t)e * 1024 * 512, 512, 64 * kb, n0, W13T, 1024, e * 1024 + 256 * (n0 / 128) + 128 * s + (n0 % 128), scr, lane); continue; } r -= I_13;
                { const int e = r / 256, r2 = r % 256, kb = r2 / 32, nb = r2 % 32; transpose_item(w2 + (size_t)e * 512 * 1024, 1024, 64 * kb, 32 * nb, W2T, 512, e * 1024 + 32 * nb, scr, lane); }
            }
        }
    }
    SEAM(0);

    if (IN(1)) {
        PHASE_PTRS
        const float* x = KA(0); const float* ctx = KA(2); const float* norm_mix = KA(6);
        for (int row = gw; row < MROWS; row += NGW) {
            const float* xr = row < T ? x + (size_t)row * D : ctx + (size_t)(row - T) * D; const int mb = row < T ? (row >> 11) : 16;
            f32x4 v[4]; float s = 0.f;
#pragma unroll
            for (int j = 0; j < 4; ++j) { v[j] = *(const f32x4*)(xr + 4 * lane + 256 * j); s += (v[j][0] * v[j][0] + v[j][1] * v[j][1]) + (v[j][2] * v[j][2] + v[j][3] * v[j][3]); }
            const float rstd = 1.f / sqrtf(wave_sum(s) * (1.f / D) + EPS);
#pragma unroll
            for (int j = 0; j < 4; ++j) { const int col = 4 * lane + 256 * j; const f32x4 g = *(const f32x4*)(norm_mix + col), sh = *(const f32x4*)(MOD + mb * 6144 + col), sc = *(const f32x4*)(MOD + mb * 6144 + 1024 + col);
                const f32x4 y = v[j] * rstd * g * (1.f + sc) + sh;
                *(v2u*)(XN + (size_t)row * D + col) = (v2u){pk2(y[0], y[1]), pk2(y[2], y[3])}; }
        }
    }
    SEAM(1);

    if (IN(2)) {
        PHASE_PTRS
        ProjOrder S; S.init(G, bx);
        LAS float* ropeL = (LAS float*)(lds + TAB_OFF); LAS float* lbtL = ropeL + 2048;
        for (int i = tid; i < 2048 + 1024; i += NTHR) ropeL[i] = i < 2048 ? ROPE[i] : LBT[i - 2048];
        __syncthreads();
        EpiProj E{ws, ropeL, lbtL, 0};
        pg8::gemm_phase<EpiProj, ProjOrder>(lds + RING_OFF, XN, WinT, D, S, E);
    }
    SEAM(2);

    if (IN(3)) {
        PHASE_PTRS
        const bf16* Qb = (const bf16*)(ws + WS_Q); const bf16* Kb = (const bf16*)(ws + WS_K); const bf16* Vb = (const bf16*)(ws + WS_V);
        const float* na_rpb = KA(10);
        const int subph = ({ const __attribute__((address_space(4))) Args* _p = (const __attribute__((address_space(4))) Args*)__builtin_amdgcn_kernarg_segment_ptr(); asm volatile("" : "+s"(_p)); _p->pad; });
#ifndef NO_SCAN
        if (bx < 128) {
            const int dir = bx & 1;
#ifdef DBG_NAIVE
            if (DBG_NAIVE & (1 << dir)) scan_naive(lds, bx >> 3, (bx >> 1) & 3, dir, (const unsigned short*)(ws + (dir ? WS_LB : WS_LF)), (const bf16*)(ws + WS_HQ), (const bf16*)(ws + WS_HI), (bf16*)(ws + (dir ? WS_OB : WS_OF)), tid);
            else
#endif
            if (subph != 2) scan_unit(lds, bx >> 3, (bx >> 1) & 3, dir, (const unsigned short*)(ws + (dir ? WS_LB : WS_LF)), (const bf16*)(ws + WS_HQ), (const bf16*)(ws + WS_HI), (bf16*)(ws + (dir ? WS_OB : WS_OF)), tid);
        } else
#endif
        {
            LAS float* rpbL = (LAS float*)lds;
            for (int idx = tid; idx < 8 * 15 * 64; idx += NTHR) { const int co = (idx & 63) - 16, hr = idx >> 6; rpbL[idx] = (co >= 0 && co < 31) ? na_rpb[hr * 31 + co] * 1.44269504f : 0.f; }
            __syncthreads();
            const __amdgpu_buffer_rsrc_t srdK = __builtin_amdgcn_make_buffer_rsrc((void*)Kb, (short)0, MROWS * SEGW * 2, 0x00020000), srdV = __builtin_amdgcn_make_buffer_rsrc((void*)Vb, (short)0, MROWS * SEGW * 2, 0x00020000);
            const int hx = bx & 7, idx = ((bx - 128) >> 3) * NWAVES + wave;
#pragma unroll 1
            for (int it = (subph == 1 ? 4 : 0); it < 4; ++it)
                na_row(it * 4 + (idx >> 5), hx, idx & 31, Qb, (const bf16*)(ws + WS_QR), srdK, srdV, MIX, rpbL, lds + 32768 + wave * 8192, lane);
        }
    }
    SEAM(3);

    if (IN(4)) {
        PHASE_PTRS
        const float* hg_norm = KA(12);
        const bf16* OF = (const bf16*)(ws + WS_OF); const bf16* OB = (const bf16*)(ws + WS_OB); const bf16* Gb = (const bf16*)(ws + WS_G);
        for (int tok = gw; tok < T; tok += NGW) {
            const size_t off = (size_t)tok * SEGW + lane * 8;
            const v4u a = *(const v4u*)(OF + off), bb = *(const v4u*)(OB + off), g = *(const v4u*)(Gb + off);
            float o[8]; float ss = 0.f;
#pragma unroll
            for (int e = 0; e < 4; ++e) { o[2 * e] = bflo(a[e]) + bflo(bb[e]); o[2 * e + 1] = bfhi(a[e]) + bfhi(bb[e]);
#ifdef DBG_SANITIZE
                if (!(fabsf(o[2 * e]) < 1e30f)) o[2 * e] = 0.f; if (!(fabsf(o[2 * e + 1]) < 1e30f)) o[2 * e + 1] = 0.f;
#endif
                ss += o[2 * e] * o[2 * e] + o[2 * e + 1] * o[2 * e + 1]; }
            ss += __shfl_xor(ss, 1); ss += __shfl_xor(ss, 2); ss += __shfl_xor(ss, 4); ss += __shfl_xor(ss, 8);
            const float rstd = 1.f / sqrtf(ss * (1.f / HGD) + EPS);
            const int dv0 = (lane & 15) * 8;
            const f32x4 g0 = *(const f32x4*)(hg_norm + dv0), g1 = *(const f32x4*)(hg_norm + dv0 + 4);
            const float gg[8] = {g0[0], g0[1], g0[2], g0[3], g1[0], g1[1], g1[2], g1[3]};
            float y[8];
#pragma unroll
            for (int e = 0; e < 4; ++e) { y[2 * e] = o[2 * e] * rstd * gg[2 * e] * bflo(g[e]); y[2 * e + 1] = o[2 * e + 1] * rstd * gg[2 * e + 1] * bfhi(g[e]); }
            *(v4u*)(MIX + (size_t)tok * D + 512 + lane * 8) = (v4u){pk2(y[0], y[1]), pk2(y[2], y[3]), pk2(y[4], y[5]), pk2(y[6], y[7])};
        }
    }
    SEAM(4);

    if (IN(5)) {
        PHASE_PTRS
        pg8::DenseOrder S; S.init(T, D, G, bx, true);
        EpiP E{(bf16*)X1};
        pg8::gemm_phase<EpiP, pg8::DenseOrder>(lds + RING_OFF, MIX, WoutT, D, S, E);
    }
    SEAM(5);

    if (IN(6)) {
        PHASE_PTRS
        const float* norm_ffn = KA(7); const float* w_grp = KA(13); const float* b_grp = KA(14); const float* w_exp = KA(15); const float* b_exp = KA(16);
        LAS f32x4* wl = (LAS f32x4*)lds;
        for (int idx = tid; idx < 5 * 1024; idx += NTHR) { const int quad = idx >> 10, col = idx & 1023; const int l = (col & 255) >> 2, q = col & 3, j = col >> 8;
            const f32x4 w = quad == 0 ? *(const f32x4*)(w_grp + col * 4) : *(const f32x4*)(w_exp + col * 16 + (quad - 1) * 4);
            wl[((quad * 4 + q) * 4 + j) * 64 + l] = w; }
        LAS int* lcnt = (LAS int*)(lds + 81920);
        LAS int* tmpe = (LAS int*)(lds + 81920 + 256);
        if (tid < 32) lcnt[tid] = 0;
        __syncthreads();
        const int rowbase = bx * 128 + wave * 16;
        const int mb = rowbase >> 11;
        f32x4 gsc[4], shv[4], gaa[4];
        const float* xin = KA(0); const bf16* Pb = (const bf16*)X1;
#pragma unroll
        for (int j = 0; j < 4; ++j) { const int col = 4 * lane + 256 * j; const f32x4 g = *(const f32x4*)(norm_ffn + col), sc = *(const f32x4*)(MOD + mb * 6144 + 4096 + col);
            gsc[j] = g * (1.f + sc); shv[j] = *(const f32x4*)(MOD + mb * 6144 + 3072 + col); gaa[j] = *(const f32x4*)(MOD + mb * 6144 + 2048 + col); }
        f32x4 vn[2][4]; v2u pn[2][4];
#pragma unroll
        for (int rr = 0; rr < 2; ++rr)
#pragma unroll
            for (int j = 0; j < 4; ++j) { const size_t o_ = (size_t)(rowbase + rr) * D + 4 * lane + 256 * j; vn[rr][j] = *(const f32x4*)(xin + o_); pn[rr][j] = *(const v2u*)(Pb + o_); }
#pragma unroll 1
        for (int ip = 0; ip < 8; ++ip) {
            asm volatile("" ::: "memory");
            f32x4 v[2][4];
#pragma unroll
            for (int rr = 0; rr < 2; ++rr)
#pragma unroll
                for (int j = 0; j < 4; ++j) v[rr][j] = vn[rr][j] + gaa[j] * (f32x4){bflo(pn[rr][j].x), bfhi(pn[rr][j].x), bflo(pn[rr][j].y), bfhi(pn[rr][j].y)};
            if (ip < 7) {
#pragma unroll
                for (int rr = 0; rr < 2; ++rr)
#pragma unroll
                    for (int j = 0; j < 4; ++j) { const size_t o_ = (size_t)(rowbase + 2 * ip + 2 + rr) * D + 4 * lane + 256 * j; vn[rr][j] = *(const f32x4*)(xin + o_); pn[rr][j] = *(const v2u*)(Pb + o_); } }
            float ss[2];
#pragma unroll
            for (int rr = 0; rr < 2; ++rr) { float s = 0.f;
#pragma unroll
                for (int j = 0; j < 4; ++j) s += (v[rr][j][0] * v[rr][j][0] + v[rr][j][1] * v[rr][j][1]) + (v[rr][j][2] * v[rr][j][2] + v[rr][j][3] * v[rr][j][3]);
                ss[rr] = s; }
#pragma unroll
            for (int o = 1; o < 64; o <<= 1) { ss[0] += __shfl_xor(ss[0], o); ss[1] += __shfl_xor(ss[1], o); }
            const float rstd0 = 1.f / sqrtf(ss[0] * (1.f / D) + EPS), rstd1 = 1.f / sqrtf(ss[1] * (1.f / D) + EPS);
            float lg[2][20];
#pragma unroll
            for (int k = 0; k < 20; ++k) { lg[0][k] = 0.f; lg[1][k] = 0.f; }
#pragma unroll
            for (int j = 0; j < 4; ++j) { const int col = 4 * lane + 256 * j;
                const f32x4 y0 = v[0][j] * rstd0 * gsc[j] + shv[j], y1 = v[1][j] * rstd1 * gsc[j] + shv[j];
                *(v2u*)(XN2 + (size_t)(rowbase + 2 * ip) * D + col) = (v2u){pg8::cvt_pk_bf16(y0[0], y0[1]), pg8::cvt_pk_bf16(y0[2], y0[3])};
                *(v2u*)(XN2 + (size_t)(rowbase + 2 * ip + 1) * D + col) = (v2u){pg8::cvt_pk_bf16(y1[0], y1[1]), pg8::cvt_pk_bf16(y1[2], y1[3])};
#pragma unroll
                for (int q = 0; q < 4; ++q)
#pragma unroll
                    for (int quad = 0; quad < 5; ++quad) { const f32x4 w = wl[((quad * 4 + q) * 4 + j) * 64 + lane];
#pragma unroll
                        for (int c = 0; c < 4; ++c) { lg[0][quad * 4 + c] += y0[q] * w[c]; lg[1][quad * 4 + c] += y1[q] * w[c]; } }
                asm volatile("" ::: "memory"); }
#pragma unroll
            for (int o = 1; o < 64; o <<= 1)
#pragma unroll
                for (int k = 0; k < 20; ++k) { lg[0][k] += __shfl_xor(lg[0][k], o); lg[1][k] += __shfl_xor(lg[1][k], o); }
            if (lane == 0) {
#pragma unroll
                for (int rr = 0; rr < 2; ++rr) {
                    float gl[4];
#pragma unroll
                    for (int k = 0; k < 4; ++k) gl[k] = lg[rr][k] + b_grp[k];
                    int gs = 0; float gm = gl[0];
#pragma unroll
                    for (int k = 1; k < 4; ++k) if (gl[k] > gm) { gm = gl[k]; gs = k; }
                    float den = 0.f;
#pragma unroll
                    for (int k = 0; k < 4; ++k) den += __expf(gl[k] - gm);
                    const float g_w = 1.f / den;
                    float ev[4];
#pragma unroll
                    for (int k = 0; k < 4; ++k) { float a = lg[rr][4 + k] + b_exp[k];
#pragma unroll
                        for (int g2 = 1; g2 < 4; ++g2) a = (gs == g2) ? (lg[rr][4 + g2 * 4 + k] + b_exp[g2 * 4 + k]) : a;
                        ev[k] = a; }
                    int i0 = 0; float v0 = ev[0];
#pragma unroll
                    for (int k = 1; k < 4; ++k) if (ev[k] > v0) { v0 = ev[k]; i0 = k; }
                    int i1 = -1; float v1 = -INFINITY;
#pragma unroll
                    for (int k = 0; k < 4; ++k) if (k != i0 && ev[k] > v1) { v1 = ev[k]; i1 = k; }
                    if (i1 < 0) { i1 = (i0 + 1) & 3; v1 = v0; }
                    const float e1 = __expf(v1 - v0); const float w0 = g_w / (1.f + e1), w1w = g_w * e1 / (1.f + e1);
                    const int ea = gs * 4 + i0, eb = gs * 4 + i1;
                    const int ra = __hip_atomic_fetch_add(&lcnt[ea], 1, __ATOMIC_RELAXED, __HIP_MEMORY_SCOPE_WORKGROUP), rb = __hip_atomic_fetch_add(&lcnt[eb], 1, __ATOMIC_RELAXED, __HIP_MEMORY_SCOPE_WORKGROUP);
                    const int lr = (wave * 16 + 2 * ip + rr) * 2;
                    tmpe[lr] = ea; tmpe[256 + lr] = ra; tmpe[512 + lr] = __builtin_bit_cast(int, w0);
                    tmpe[lr + 1] = eb; tmpe[256 + lr + 1] = rb; tmpe[512 + lr + 1] = __builtin_bit_cast(int, w1w);
                }
            }
        }
        __syncthreads();
        if (tid < 16) lcnt[16 + tid] = (int)__hip_atomic_fetch_add(ctl + CW_CNT + tid, (unsigned)lcnt[tid], RLX_AGENT);
        __syncthreads();
        if (tid < 256) { const int e = tmpe[tid], pos = lcnt[16 + e] + tmpe[256 + tid]; const int tok = bx * 128 + (tid >> 1);
            ELIST[e * ECAP + pos] = tok * 2 + (tid & 1); EWT[e * ECAP + pos] = __builtin_bit_cast(float, tmpe[512 + tid]); }
        __syncthreads();
    }
    SEAM(6);

    if (IN(7) || IN(8)) {
        PHASE_PTRS
        LAS int* tp = (LAS int*)(lds + MOE_OFF);
        if (tid == 0) { int acc = 0;
            for (int e = 0; e < 16; ++e) { const int c = (int)__hip_atomic_load(ctl + CW_CNT + e, RLX_AGENT); tp[e] = acc; tp[17 + e] = c; acc += (c + 255) >> 8; }
            tp[16] = acc; }
        __syncthreads();
    }
    if (IN(7)) {
        PHASE_PTRS
        const LAS int* tp = (const LAS int*)(lds + MOE_OFF);
        MoeOrder<true> S{tp, ELIST, G, bx, tp[16] * 4};
        EpiSwiGLU E{Hb};
        pg8::gemm_phase<EpiSwiGLU, MoeOrder<true>>(lds + RING_OFF, XN2, W13T, D, S, E);
    }
    SEAM(7);
    if (IN(8)) {
        PHASE_PTRS
        const LAS int* tp = (const LAS int*)(lds + MOE_OFF);
        MoeOrder<false> S{tp, ELIST, G, bx, tp[16] * 4};
        EpiMoeOut E{Yb, ELIST, EWT};
        pg8::gemm_phase<EpiMoeOut, MoeOrder<false>>(lds + RING_OFF, Hb, W2T, DE, S, E);
    }
    SEAM(8);

    if (IN(9)) {
        PHASE_PTRS
        const float* norm_final = KA(20); const float* xfin = KA(0); float* outp = ({ const __attribute__((address_space(4))) Args* _p = (const __attribute__((address_space(4))) Args*)__builtin_amdgcn_kernarg_segment_ptr(); asm volatile("" : "+s"(_p)); _p->out; });
        for (int row = gw; row < T; row += NGW) {
            const int mb = row >> 11; f32x4 v[4]; float s = 0.f;
#pragma unroll
            for (int j = 0; j < 4; ++j) { const int col = 4 * lane + 256 * j; const v2u pp = *(const v2u*)((const bf16*)X1 + (size_t)row * D + col);
                const f32x4 xv = *(const f32x4*)(xfin + (size_t)row * D + col) + *(const f32x4*)(MOD + mb * 6144 + 2048 + col) * (f32x4){bflo(pp.x), bfhi(pp.x), bflo(pp.y), bfhi(pp.y)}, ga = *(const f32x4*)(MOD + mb * 6144 + 5120 + col);
                const v2u y0 = *(const v2u*)(Yb + (size_t)(2 * row) * D + col), y1 = *(const v2u*)(Yb + (size_t)(2 * row + 1) * D + col);
                const f32x4 ys = (f32x4){bflo(y0.x) + bflo(y1.x), bfhi(y0.x) + bfhi(y1.x), bflo(y0.y) + bflo(y1.y), bfhi(y0.y) + bfhi(y1.y)};
                v[j] = xv + ga * ys; s += (v[j][0] * v[j][0] + v[j][1] * v[j][1]) + (v[j][2] * v[j][2] + v[j][3] * v[j][3]); }
            const float rstd = 1.f / sqrtf(wave_sum(s) * (1.f / D) + EPS);
#pragma unroll
            for (int j = 0; j < 4; ++j) { const int col = 4 * lane + 256 * j; const f32x4 g = *(const f32x4*)(norm_final + col);
                *(f32x4*)(outp + (size_t)row * D + col) = v[j] * rstd * g; }
        }
    }
#undef IN
#undef SEAM
}

#ifndef MK_N_LAUNCHES
#define MK_N_LAUNCHES 1
#endif
constexpr int NPHASE = 10;
extern "C" void kernel_launch(void* const* d_in, const int* in_sizes, int n_in, void* d_out, int out_size, void* d_ws, size_t ws_size, hipStream_t stream) {
    static int grid = 0;
    if (grid == 0) {
        if (n_in != 21 || in_sizes[0] != T * D || out_size != T * D || ws_size < WS_END) { fprintf(stderr, "kernel_launch: unexpected shapes (n_in %d, in0 %d, out %d, ws %zu)\n", n_in, n_in > 0 ? in_sizes[0] : -1, out_size, ws_size); grid = -1; return; }
        int dev = 0, cus = 0, per_cu = 0;
        if (hipGetDevice(&dev) != hipSuccess || hipDeviceGetAttribute(&cus, hipDeviceAttributeMultiprocessorCount, dev) != hipSuccess) { grid = -1; return; }
        if (hipFuncSetAttribute((const void*)fwd_mega, hipFuncAttributeMaxDynamicSharedMemorySize, LDS_BYTES) != hipSuccess) { fprintf(stderr, "kernel_launch: hipFuncSetAttribute failed\n"); grid = -1; return; }
        if (hipOccupancyMaxActiveBlocksPerMultiprocessor(&per_cu, (const void*)fwd_mega, NTHR, LDS_BYTES) != hipSuccess || per_cu < 1) fprintf(stderr, "kernel_launch: occupancy query reports %d\n", per_cu);
        (void)hipGetLastError();
        grid = cus;
        if (grid != 256) fprintf(stderr, "kernel_launch: %d CUs (built for 256)\n", grid);
    }
    if (grid < 0) return;
    (void)hipMemsetAsync((char*)d_ws + WS_CTL, 0, CTL_ZERO_BYTES, stream);
    Args a{};
    for (int i = 0; i < 21; ++i) a.in[i] = (const float*)d_in[i];
    a.out = (float*)d_out; a.ws = (unsigned char*)d_ws;
    if (MK_N_LAUNCHES == 1) {
        a.ph_lo = 0; a.ph_hi = NPHASE; a.li = 0;
        hipLaunchKernelGGL(fwd_mega, dim3(grid), dim3(NTHR), LDS_BYTES, stream, a);
    } else {
        for (int li = 0; li < NPHASE; ++li) { a.ph_lo = li; a.ph_hi = li + 1; a.li = 0; hipLaunchKernelGGL(fwd_mega, dim3(grid), dim3(NTHR), LDS_BYTES, stream, a);
#ifdef PROBE_DUP
            if (li == PROBE_DUP) {
#ifdef PROBE_SUB
                a.pad = PROBE_SUB;
#endif
                hipLaunchKernelGGL(fwd_mega, dim3(grid), dim3(NTHR), LDS_BYTES, stream, a); a.pad = 0; }
#endif
        }
    }
}
```

```cpp
#include <hip/hip_runtime.h>
#include <cstdio>
#include <cstdint>

#define GAS __attribute__((address_space(1)))
#define LAS __attribute__((address_space(3)))
typedef unsigned short bf16;
typedef unsigned short bf16_t;
typedef unsigned v4u __attribute__((ext_vector_type(4)));
typedef unsigned v2u __attribute__((ext_vector_type(2)));
typedef float f32x4 __attribute__((ext_vector_type(4)));
typedef float f32x2 __attribute__((ext_vector_type(2)));
typedef short bf16x8 __attribute__((ext_vector_type(8)));
typedef unsigned u32x4 __attribute__((ext_vector_type(4)));
typedef GAS unsigned gu32;
#define RLX_AGENT __ATOMIC_RELAXED, __HIP_MEMORY_SCOPE_AGENT
#define LDS_WAIT() asm volatile("s_waitcnt lgkmcnt(0)" ::: "memory")
#define VM_WAIT() asm volatile("s_waitcnt vmcnt(0)" ::: "memory")

constexpr int NB = 16, SEQ = 2048, D = 1024, T = NB * SEQ, LC = 256, TC = NB * LC, MROWS = T + TC;
constexpr int GW = 64, NROWS = SEQ / GW;
constexpr int INCOLS = 4096, SEGW = 512;
constexpr int NAH = 8, NAD = 64, HGH = 4, HGD = 128;
constexpr int KTOK = SEQ + LC;
constexpr int NE = 16, DE = 512, ECAP = T;
constexpr float EPS = 1e-6f;
constexpr int NWAVES = 8, NTHR = 512;

constexpr size_t MiB = 1u << 20;
constexpr size_t WS_CTL = 0, CTL_ZERO_BYTES = 1 * MiB;
constexpr size_t WS_MOD = 1 * MiB;
constexpr size_t WS_ROPE = WS_MOD + 512 * 1024, WS_LBT = WS_MOD + 520 * 1024;
constexpr size_t WS_ELIST = 2 * MiB, WS_EWT = 4 * MiB;
constexpr size_t WS_WINT = 8 * MiB, WS_WOUTT = 16 * MiB, WS_W13T = 18 * MiB, WS_W2T = 50 * MiB;
constexpr size_t WS_XN = 66 * MiB;
constexpr size_t WS_Q = 138 * MiB, WS_K = 170 * MiB, WS_V = 206 * MiB, WS_HQ = 242 * MiB, WS_HI = 274 * MiB, WS_LF = 310 * MiB, WS_LB = 346 * MiB, WS_G = 382 * MiB;
constexpr size_t WS_OF = 414 * MiB, WS_OB = 446 * MiB, WS_QR = 478 * MiB, WS_END = 510 * MiB;
constexpr size_t WS_MIX = WS_XN, WS_XN2 = WS_XN, WS_X1 = 138 * MiB, WS_H = 274 * MiB, WS_Y = 346 * MiB;
constexpr int CW_CNT = 64;
constexpr int CW_BAR = 4096;

constexpr int RING_OFF = 0, RING_BYTES = 131072;
constexpr int LDSCTL_OFF = RING_BYTES, MISC_OFF = LDSCTL_OFF + 320, MOE_OFF = LDSCTL_OFF + 1024;
constexpr int TAB_OFF = LDSCTL_OFF + 2048;
constexpr int LDS_BYTES = 147456;

__device__ __forceinline__ unsigned f2bf(float f) { unsigned u = __builtin_bit_cast(unsigned, f); return (u + 0x7fffu + ((u >> 16) & 1u)) >> 16; }
__device__ __forceinline__ unsigned pk2(float lo, float hi) { return f2bf(lo) | (f2bf(hi) << 16); }
__device__ __forceinline__ float bf2f(unsigned short b) { return __builtin_bit_cast(float, (unsigned)b << 16); }
__device__ __forceinline__ float bflo(unsigned u) { return __builtin_bit_cast(float, u << 16); }
__device__ __forceinline__ float bfhi(unsigned u) { return __builtin_bit_cast(float, u & 0xffff0000u); }
__device__ __forceinline__ unsigned pkh2(float lo, float hi) { _Float16 a = (_Float16)lo, b = (_Float16)hi; return (unsigned)__builtin_bit_cast(unsigned short, a) | ((unsigned)__builtin_bit_cast(unsigned short, b) << 16); }
__device__ __forceinline__ float h2f(unsigned short h) { return (float)__builtin_bit_cast(_Float16, h); }
__device__ __forceinline__ float silu_f(float v) { return v * __builtin_amdgcn_rcpf(1.f + __expf(-v)); }
__device__ __forceinline__ float wave_sum(float v) {
#pragma unroll
    for (int o = 1; o < 64; o <<= 1) v += __shfl_xor(v, o);
    return v;
}
__device__ __forceinline__ float wave_max(float v) {
#pragma unroll
    for (int o = 1; o < 64; o <<= 1) v = fmaxf(v, __shfl_xor(v, o));
    return v;
}

namespace pg8 {
constexpr int BM = 256, BK = 64, HALF = 128, HTB = HALF * BK * 2, STAGE_BYTES = 8 * HTB, NXCD = 8, WGM = 8;
__host__ __device__ __forceinline__ int lds_byte(int r, int c) { const int st = (r >> 4) * 2 + (c >> 5), rr = r & 15, cc = c & 31, ob = rr * 64 + cc * 2; return st * 1024 + (ob ^ (((ob >> 9) & 1) << 5)); }
__host__ __device__ __forceinline__ void stage_rc(int b, int& R, int& C) { const int st = b / 1024, sb = b % 1024, swz = sb ^ (((sb >> 9) & 1) << 5); R = (st >> 1) * 16 + swz / 64; C = (st & 1) * 32 + (swz % 64) / 2; }
__host__ __device__ __forceinline__ int perm32(int rho) { const int n = rho >> 4, i = rho & 15; return 8 * (i >> 2) + 4 * n + (i & 3); }

struct Unit { int pm, pn, e, tm, cnt; };

typedef float f32x2_t __attribute__((ext_vector_type(2))); typedef __bf16 bf16x2_t __attribute__((ext_vector_type(2)));
__device__ __forceinline__ unsigned cvt_pk_bf16(float lo, float hi) { f32x2_t v = {lo, hi}; bf16x2_t b = __builtin_convertvector(v, bf16x2_t); return __builtin_bit_cast(unsigned, b); }

struct DenseOrder {
    static constexpr bool GATHER = false;
    int nM, nN, nwg, G, c; bool pf;
    __device__ void init(int M, int N, int G_, int c_, bool pf_ = false) { nM = M / BM; nN = N / BM; nwg = nM * nN; G = G_; c = c_; pf = pf_; }
    __device__ bool next(int i, Unit& u) const {
        const long L = (long)i * G + c; if (L >= nwg) return false;
        int wgid = (int)L; { const int q = nwg / NXCD, r = nwg % NXCD, xcd = wgid % NXCD, off = wgid / NXCD; wgid = (xcd < r ? xcd * (q + 1) : r * (q + 1) + (xcd - r) * q) + off; }
        const int nig = WGM * nN, gid = wgid / nig, fm = gid * WGM, gsz = (nM - fm) < WGM ? (nM - fm) : WGM;
        u.pm = fm + ((wgid % nig) % gsz); u.pn = (wgid % nig) / gsz; u.e = 0; u.tm = 0; u.cnt = 0; return true;
    }
    __device__ __forceinline__ int a_row0(const Unit& u) const { return u.pm * BM; }
    __device__ __forceinline__ int a_row(const Unit& u, int r) const { return u.pm * BM + r; }
    __device__ __forceinline__ int b_row0(const Unit& u) const { return u.pn * BM; }
    __device__ __forceinline__ bool perm(const Unit&) const { return pf; }
};

template <class Epi, class Sched>
__device__ __forceinline__ void gemm_phase(LAS unsigned char* lds, const bf16_t* Aptr, const bf16_t* Btptr, const int K, const Sched& S, const Epi& E) {
    const int tid = threadIdx.x, wid = __builtin_amdgcn_readfirstlane(tid >> 6), lane = tid & 63, wr = wid >> 2, wc = wid & 3, fr = lane & 15, fq = lane >> 4;
    const int nt = K / BK;
    int sR[2], sC[2];
    unsigned voffA[2], voffBn[2], voffBp[2], voffB[2], nvB[2];
#pragma unroll
    for (int i = 0; i < 2; ++i) { int R, C; stage_rc(tid * 16 + i * 8192, R, C); const int Rb = (R & ~31) + perm32(R & 31);
        sR[i] = R; sC[i] = C; voffA[i] = (unsigned)(R * K + C) * 2u; voffBn[i] = (unsigned)(R * K + C) * 2u; voffBp[i] = (unsigned)(Rb * K + C) * 2u; }
    const size_t kstep = (size_t)(BK * 2);
    const size_t hstep = (size_t)HALF * K * 2;
    const size_t rowb = (size_t)K * 2;
    const unsigned ldsw = (unsigned)wid * 1024u;
    const int aoff = lds_byte(wr * 64 + fr, fq * 8), boff = lds_byte(wc * 32 + fr, fq * 8);
    const char* Ab = (const char*)Aptr;
#define PG8_SA(b, h) (((b) * 2 + (h)) * HTB)
#define PG8_SB(b, h) ((4 + (b) * 2 + (h)) * HTB)
#define PG8_STAGE(bufoff, gbase, voff) do { _Pragma("unroll") for (int _i = 0; _i < 2; ++_i) \
        __builtin_amdgcn_global_load_lds((const unsigned*)((const char*)(gbase) + (voff)[_i]), (LAS unsigned*)(lds + (bufoff) + ldsw + _i * 8192), 16, 0, 0); } while (0)
#define PG8_LDA(dst, b, h) do { _Pragma("unroll") for (int m = 0; m < 4; ++m) _Pragma("unroll") for (int k = 0; k < 2; ++k) dst[m][k] = *(const LAS bf16x8*)(lds + PG8_SA(b, h) + aoff + m * 2048 + k * 1024); } while (0)
#define PG8_LDB(dst, b, h) do { _Pragma("unroll") for (int n = 0; n < 2; ++n) _Pragma("unroll") for (int k = 0; k < 2; ++k) dst[n][k] = *(const LAS bf16x8*)(lds + PG8_SB(b, h) + boff + n * 2048 + k * 1024); } while (0)
#define PG8_MMA(ai, bj, At, Bt) do { __builtin_amdgcn_s_setprio(1); _Pragma("unroll") for (int m = 0; m < 4; ++m) _Pragma("unroll") for (int n = 0; n < 2; ++n) _Pragma("unroll") for (int k = 0; k < 2; ++k) \
        acc[ai][bj][m][n] = __builtin_amdgcn_mfma_f32_16x16x32_bf16(Bt[n][k], At[m][k], acc[ai][bj][m][n], 0, 0, 0); __builtin_amdgcn_s_setprio(0); } while (0)
#define PG8_WAIT_V(n) asm volatile("s_waitcnt vmcnt(" #n ")" ::: "memory")
#define PG8_WAIT_L(n) asm volatile("s_waitcnt lgkmcnt(" #n ")" ::: "memory")
#define PG8_BAR __builtin_amdgcn_s_barrier()
#define PG8_SCHED __builtin_amdgcn_sched_barrier(0)
    Unit cur, nxt; int ui = 0;
    if (!S.next(0, cur)) return;
    f32x4 acc[2][2][4][2];
#pragma unroll
    for (int a = 0; a < 2; ++a)
#pragma unroll
        for (int b = 0; b < 2; ++b)
#pragma unroll
            for (int m = 0; m < 4; ++m)
#pragma unroll
                for (int n = 0; n < 2; ++n) acc[a][b][m][n] = (f32x4){0.f, 0.f, 0.f, 0.f};
    bf16x8 At[4][2], B0[2][2], B1[2][2];
    const char* cA = Ab; unsigned cG[2][2];
    if constexpr (Sched::GATHER) {
#pragma unroll
        for (int h = 0; h < 2; ++h)
#pragma unroll
            for (int i = 0; i < 2; ++i) cG[h][i] = (unsigned)((size_t)S.a_row(cur, h * HALF + sR[i]) * rowb) + (unsigned)sC[i] * 2u;
    } else { cA = Ab + (ptrdiff_t)S.a_row0(cur) * (ptrdiff_t)rowb; cG[0][0] = cG[0][1] = cG[1][0] = cG[1][1] = 0u; }
    const char* cB = (const char*)Btptr + (ptrdiff_t)S.b_row0(cur) * (ptrdiff_t)rowb;
    { const bool pc = S.perm(cur); voffB[0] = pc ? voffBp[0] : voffBn[0]; voffB[1] = pc ? voffBp[1] : voffBn[1]; }
#define PG8_STAGEA(bufoff, h, dbase, goffs, kb) do { if constexpr (Sched::GATHER) { PG8_STAGE(bufoff, Ab + (kb), (goffs)[h]); } else { PG8_STAGE(bufoff, (dbase) + (h) * hstep + (kb), voffA); } } while (0)
    PG8_STAGE(PG8_SB(0, 0), cB, voffB); PG8_STAGE(PG8_SB(0, 1), cB + hstep, voffB); PG8_STAGEA(PG8_SA(0, 0), 0, cA, cG, 0); PG8_STAGEA(PG8_SA(0, 1), 1, cA, cG, 0);
    if (wr == 1) PG8_BAR;
    PG8_WAIT_V(2); PG8_BAR;
    PG8_STAGE(PG8_SB(1, 0), cB + kstep, voffB); PG8_STAGEA(PG8_SA(1, 0), 0, cA, cG, kstep); PG8_STAGE(PG8_SB(1, 1), cB + hstep + kstep, voffB);
    PG8_WAIT_V(6); PG8_BAR;
    for (;;) {
        const bool has_next = S.next(ui + 1, nxt);
        const char* nA = cA; const char* nB = cB; unsigned nG[2][2];
#pragma unroll
        for (int h = 0; h < 2; ++h)
#pragma unroll
            for (int i = 0; i < 2; ++i) nG[h][i] = cG[h][i];
        nvB[0] = voffB[0]; nvB[1] = voffB[1];
        if (has_next) {
            nB = (const char*)Btptr + (ptrdiff_t)S.b_row0(nxt) * (ptrdiff_t)rowb;
            { const bool pn_ = S.perm(nxt); nvB[0] = pn_ ? voffBp[0] : voffBn[0]; nvB[1] = pn_ ? voffBp[1] : voffBn[1]; }
            if constexpr (Sched::GATHER) {
#pragma unroll
                for (int h = 0; h < 2; ++h)
#pragma unroll
                    for (int i = 0; i < 2; ++i) nG[h][i] = (unsigned)((size_t)S.a_row(nxt, h * HALF + sR[i]) * rowb) + (unsigned)sC[i] * 2u;
            } else nA = Ab + (ptrdiff_t)S.a_row0(nxt) * (ptrdiff_t)rowb;
        }
        for (int t = 0; t < nt; t += 2) {
            const bool last = (t == nt - 2);
            const size_t kb1 = (size_t)(t + 1) * kstep;
            const size_t kb2 = last ? 0 : (size_t)(t + 2) * kstep, kb3 = kb2 + kstep;
            const char* a2 = last ? nA : cA; const char* b2 = last ? nB : cB + (size_t)(t + 2) * kstep; const char* b3 = b2 + kstep;
            unsigned vB2[2]; vB2[0] = last ? nvB[0] : voffB[0]; vB2[1] = last ? nvB[1] : voffB[1];
            unsigned g2[2][2];
#pragma unroll
            for (int h = 0; h < 2; ++h)
#pragma unroll
                for (int i = 0; i < 2; ++i) g2[h][i] = last ? nG[h][i] : cG[h][i];
            PG8_LDB(B0, 0, 0); PG8_LDB(B1, 0, 1); PG8_SCHED; PG8_LDA(At, 0, 0); PG8_STAGEA(PG8_SA(1, 1), 1, cA, cG, kb1);
            PG8_WAIT_V(8); PG8_WAIT_L(0); PG8_BAR; PG8_MMA(0, 0, At, B0); PG8_MMA(0, 1, At, B1); PG8_BAR; PG8_SCHED;
            PG8_LDA(At, 0, 1); PG8_STAGE(PG8_SB(0, 0), b2, vB2); PG8_STAGE(PG8_SB(0, 1), b2 + hstep, vB2); PG8_STAGEA(PG8_SA(0, 0), 0, a2, g2, kb2);
            PG8_WAIT_V(8); PG8_WAIT_L(0); PG8_BAR; PG8_MMA(1, 0, At, B0); PG8_MMA(1, 1, At, B1); PG8_BAR; PG8_SCHED;
            PG8_LDB(B0, 1, 0); PG8_LDB(B1, 1, 1); PG8_SCHED; PG8_LDA(At, 1, 0); PG8_STAGEA(PG8_SA(0, 1), 1, a2, g2, kb2);
            PG8_WAIT_V(8); PG8_WAIT_L(0); PG8_BAR; PG8_MMA(0, 0, At, B0); PG8_MMA(0, 1, At, B1); PG8_BAR; PG8_SCHED;
            PG8_LDA(At, 1, 1); PG8_STAGE(PG8_SB(1, 0), b3, vB2); PG8_STAGE(PG8_SB(1, 1), b3 + hstep, vB2); PG8_STAGEA(PG8_SA(1, 0), 0, a2, g2, kb3);
            PG8_WAIT_V(8); PG8_WAIT_L(0); PG8_BAR; PG8_MMA(1, 0, At, B0); PG8_MMA(1, 1, At, B1); PG8_BAR; PG8_SCHED;
        }
        if (wr == 0) PG8_BAR;
        E(acc, cur, wr, wc, fr, fq);
        if (!has_next) break;
#pragma unroll
        for (int a = 0; a < 2; ++a)
#pragma unroll
            for (int b = 0; b < 2; ++b)
#pragma unroll
                for (int m = 0; m < 4; ++m)
#pragma unroll
                    for (int n = 0; n < 2; ++n) acc[a][b][m][n] = (f32x4){0.f, 0.f, 0.f, 0.f};
        cur = nxt; cA = nA; cB = nB; ++ui; voffB[0] = nvB[0]; voffB[1] = nvB[1];
#pragma unroll
        for (int h = 0; h < 2; ++h)
#pragma unroll
            for (int i = 0; i < 2; ++i) cG[h][i] = nG[h][i];
        if (wr == 1) PG8_BAR;
    }
    PG8_WAIT_V(0);
    PG8_BAR;
#undef PG8_SA
#undef PG8_SB
#undef PG8_STAGE
#undef PG8_STAGEA
#undef PG8_LDA
#undef PG8_LDB
#undef PG8_MMA
#undef PG8_WAIT_V
#undef PG8_WAIT_L
#undef PG8_BAR
#undef PG8_SCHED
}
}

#define XB_TMO      128
#define XB_XCNT(j)  (256  + 64 * (j))
#define XB_XSUB(j)  (1280 + 64 * (j))
#define XB_XGEN(j)  (2304 + 64 * (j))
#define XB_TOP      3328
#define XB_TOPGEN   3392
#define XCD_BAR_WORDS 3456
#define XB_SPIN_CAP (1u << 18)
__device__ __forceinline__ unsigned xb_ld(unsigned* p)              { return __hip_atomic_load(p, __ATOMIC_RELAXED, __HIP_MEMORY_SCOPE_AGENT); }
__device__ __forceinline__ unsigned xb_add(unsigned* p, unsigned v) { return __hip_atomic_fetch_add(p, v, __ATOMIC_RELAXED, __HIP_MEMORY_SCOPE_AGENT); }
__device__ __forceinline__ unsigned xb_xcc_id() { return (unsigned)__builtin_amdgcn_s_getreg((3 << 11) | 20) & 0xFu; }
#define XB_SPIN(cond, bar) do { unsigned _sp = 0; while (cond) { __builtin_amdgcn_s_sleep(1); \
    if ((++_sp & 255u) == 0u) { if (xb_ld(&(bar)[XB_TMO])) break; if (_sp > XB_SPIN_CAP) { atomicAdd(&(bar)[XB_TMO], 1u); break; } } } } while (0)
struct XcdBarrier { unsigned* bar; unsigned x; volatile LAS unsigned* st; };
__device__ __forceinline__ XcdBarrier xcd_barrier_post(unsigned* bar, volatile LAS unsigned* st) {
    XcdBarrier b; b.bar = bar; b.x = xb_xcc_id(); b.st = st;
    if (threadIdx.x == 0) (void)xb_add(&bar[XB_XCNT(b.x)], 1u);
    return b;
}
__device__ __forceinline__ void xcd_barrier_complete(unsigned* bar, unsigned x, unsigned& nloc, unsigned& nx) {
    const unsigned G = gridDim.x * gridDim.y * gridDim.z;
    unsigned sum, cnt, mine, sp = 0u;
    for (;;) {
        sum = 0u; cnt = 0u; mine = 0u;
#pragma unroll
        for (unsigned j = 0; j < 16; ++j) { const unsigned c = xb_ld(&bar[XB_XCNT(j)]); sum += c; cnt += (c > 0u) ? 1u : 0u; mine = (j == x) ? c : mine; }
        if (sum == G) break;
        __builtin_amdgcn_s_sleep(1);
        if ((++sp & 255u) == 0u) { if (xb_ld(&bar[XB_TMO])) break; if (sp > XB_SPIN_CAP) { atomicAdd(&bar[XB_TMO], 1u); break; } }
    }
    nloc = mine > 0u ? mine : 1u; nx = cnt > 0u ? cnt : 1u;
}
__device__ __forceinline__ void xcd_barrier(const XcdBarrier& b) {
    asm volatile("s_waitcnt vmcnt(0)" ::: "memory");
    __syncthreads();
    if (threadIdx.x == 0) {
        unsigned* bar = b.bar;
        __builtin_amdgcn_s_waitcnt(0);
        unsigned nloc = b.st[0], nx = b.st[1];
        if (nloc == 0u) { xcd_barrier_complete(bar, b.x, nloc, nx); b.st[0] = nloc; b.st[1] = nx; }
        const unsigned old = xb_add(&bar[XB_XSUB(b.x)], 1u);
        const unsigned gen = old / nloc;
        if (old + 1u == (gen + 1u) * nloc) {
            __builtin_amdgcn_fence(__ATOMIC_RELEASE, "agent");
            asm volatile("s_waitcnt vmcnt(0)" ::: "memory");
            const unsigned og = xb_add(&bar[XB_TOP], 1u);
            const unsigned tg = og / nx;
            if (og + 1u == (tg + 1u) * nx) xb_add(&bar[XB_TOPGEN], 1u);
            else XB_SPIN(xb_ld(&bar[XB_TOPGEN]) == tg, bar);
            __builtin_amdgcn_fence(__ATOMIC_ACQUIRE, "agent");
            xb_add(&bar[XB_XGEN(b.x)], 1u);
            asm volatile("s_waitcnt vmcnt(0)" ::: "memory");
        } else {
            XB_SPIN(xb_ld(&bar[XB_XGEN(b.x)]) == gen, bar);
            __builtin_amdgcn_fence(__ATOMIC_ACQUIRE, "agent");
            asm volatile("s_waitcnt vmcnt(0)" ::: "memory");
        }
    }
    __syncthreads();
}

using pg8::Unit;
typedef f32x4 acc_t[2][2][4][2];

struct EpiProj {
    static constexpr bool PERM = false;
    unsigned char* ws; const LAS float* ropeL; const LAS float* lbtL; int skip;
    template <int KIND> __device__ __forceinline__ void swapped(const acc_t& acc, const Unit& u, int wr, int wc, int fr, int fq, bool latent) const {
        constexpr size_t so2 = KIND == 0 ? WS_V : KIND == 1 ? WS_HQ : KIND == 2 ? WS_HI : KIND == 3 ? WS_LF : WS_LB;
        bf16* dT = (bf16*)(ws + so2);
        constexpr int ldt = (KIND == 1) ? T : MROWS;
        const int wrow0 = (u.pn & 1) * 256 + wr * 64 + fr, tcol0 = u.pm * 256 + wc * 32 + 8 * fq;
        const LAS float* lbt = lbtL + (KIND == 4 ? 512 : 0);
#pragma unroll
        for (int ai = 0; ai < 2; ++ai)
#pragma unroll
            for (int m = 0; m < 4; ++m) { const int wrow = wrow0 + ai * 128 + m * 16; float lb = 0.f; if (KIND >= 3) lb = lbt[wrow];
#pragma unroll
                for (int bj = 0; bj < 2; ++bj) { float x[8]; u32x4 w;
#pragma unroll
                    for (int j = 0; j < 4; ++j) { x[j] = acc[ai][bj][m][0][j]; x[4 + j] = acc[ai][bj][m][1][j]; }
                    if (KIND >= 3) {
#pragma unroll
                        for (int j = 0; j < 8; ++j) { const float sg = __builtin_amdgcn_rcpf(1.f + __expf(-x[j])); x[j] = __log2f(lb + (1.f - lb) * sg); }
                        w = (u32x4){pkh2(x[0], x[1]), pkh2(x[2], x[3]), pkh2(x[4], x[5]), pkh2(x[6], x[7])}; }
                    else { if (KIND == 1) {
#pragma unroll
                            for (int j = 0; j < 8; ++j) x[j] = silu_f(x[j]); }
                        w = (u32x4){pg8::cvt_pk_bf16(x[0], x[1]), pg8::cvt_pk_bf16(x[2], x[3]), pg8::cvt_pk_bf16(x[4], x[5]), pg8::cvt_pk_bf16(x[6], x[7])}; }
                    size_t off = (size_t)wrow * ldt + tcol0 + bj * 128;
                    if (KIND == 0) { const int tc = tcol0 + bj * 128, bb_ = latent ? (tc >> 11) : ((tc - T) >> 8), tl = latent ? (tc & (SEQ - 1)) : (KTOK - LC + ((tc - T) & (LC - 1)));
                        off = ((((size_t)(bb_ * NAH + (wrow >> 6)) * (KTOK / 64) + (tl >> 6)) * NAD + (wrow & 63)) * 64) + (tl & 63); }
                    *(u32x4*)(dT + off) = w; } }
    }
    template <int SEG, bool LAT> __device__ __forceinline__ void rope(const acc_t& acc, int row0, int lcp, int wc, int fq) const {
        bf16* dK = (bf16*)(ws + (SEG == 0 ? WS_QR : WS_K)); bf16* dQ = (bf16*)(ws + WS_Q);
#pragma unroll
        for (int ai = 0; ai < 2; ++ai)
#pragma unroll
            for (int m = 0; m < 4; ++m) { const int row = row0 + ai * 128 + m * 16, sq = row & (SEQ - 1); const int pos = (wc & 1) ? (sq & 63) : (sq >> 6);
                f32x4 cs0 = (f32x4){1.f, 0.f, 1.f, 0.f}, cs1 = cs0;
                if (LAT) { cs0 = *(const LAS f32x4*)(ropeL + (pos * 16 + 4 * fq) * 2); cs1 = *(const LAS f32x4*)(ropeL + (pos * 16 + 4 * fq) * 2 + 4); }
                const float cc[4] = {cs0[0], cs0[2], cs1[0], cs1[2]}, sn[4] = {cs0[1], cs0[3], cs1[1], cs1[3]};
#pragma unroll
                for (int bj = 0; bj < 2; ++bj) { const f32x4 x1 = acc[ai][bj][m][0], x2 = acc[ai][bj][m][1]; float o1[4], o2[4];
#pragma unroll
                    for (int j = 0; j < 4; ++j) { o1[j] = LAT ? x1[j] * cc[j] - x2[j] * sn[j] : x1[j]; o2[j] = LAT ? x2[j] * cc[j] + x1[j] * sn[j] : x2[j]; }
                    size_t off = (size_t)row * SEGW + lcp + bj * 128;
                    if (SEG == 0) *(u32x4*)(dQ + off) = (u32x4){pg8::cvt_pk_bf16(x1[0], x1[1]), pg8::cvt_pk_bf16(x1[2], x1[3]), pg8::cvt_pk_bf16(x2[0], x2[1]), pg8::cvt_pk_bf16(x2[2], x2[3])};
                    else { const int cf = lcp + bj * 128, bb_ = LAT ? (row >> 11) : ((row - T) >> 8), tl = LAT ? sq : (KTOK - LC + ((row - T) & (LC - 1)));
                        off = ((size_t)(bb_ * NAH + (cf >> 6)) * KTOK + tl) * NAD + (cf & 63); }
                    *(u32x4*)(dK + off) = (u32x4){pg8::cvt_pk_bf16(o1[0], o1[1]), pg8::cvt_pk_bf16(o1[2], o1[3]), pg8::cvt_pk_bf16(o2[0], o2[1]), pg8::cvt_pk_bf16(o2[2], o2[3])}; } }
    }
    __device__ __forceinline__ void operator()(const acc_t& acc, const Unit& u, int wr, int wc, int fr, int fq) const {
        const int seg = u.pn >> 1; const bool latent = u.pm < (T / 256);
        if (skip) return;
        if (!latent && (seg == 0 || seg == 3 || seg == 7)) return;
        if (u.e) {
            if (seg == 2) swapped<0>(acc, u, wr, wc, fr, fq, latent);
            else if (seg == 3) swapped<1>(acc, u, wr, wc, fr, fq, latent);
            else if (seg == 4) swapped<2>(acc, u, wr, wc, fr, fq, latent);
            else if (seg == 5) swapped<3>(acc, u, wr, wc, fr, fq, latent);
            else swapped<4>(acc, u, wr, wc, fr, fq, latent);
            return;
        }
        const int row0 = u.pm * 256 + wr * 64 + fr;
        const int lcp = (u.pn & 1) * 256 + wc * 32 + 8 * fq;
        if (seg <= 1) {
            if (seg == 0) rope<0, true>(acc, row0, lcp, wc, fq);
            else if (latent) rope<1, true>(acc, row0, lcp, wc, fq);
            else rope<1, false>(acc, row0, lcp, wc, fq);
            return;
        }
        bf16* dG = (bf16*)(ws + WS_G);
#pragma unroll
        for (int ai = 0; ai < 2; ++ai)
#pragma unroll
            for (int m = 0; m < 4; ++m) { const int row = row0 + ai * 128 + m * 16;
#pragma unroll
                for (int bj = 0; bj < 2; ++bj) { float x[8];
#pragma unroll
                    for (int j = 0; j < 4; ++j) { x[j] = silu_f(acc[ai][bj][m][0][j]); x[4 + j] = silu_f(acc[ai][bj][m][1][j]); }
                    *(u32x4*)(dG + (size_t)row * SEGW + lcp + bj * 128) = (u32x4){pg8::cvt_pk_bf16(x[0], x[1]), pg8::cvt_pk_bf16(x[2], x[3]), pg8::cvt_pk_bf16(x[4], x[5]), pg8::cvt_pk_bf16(x[6], x[7])}; } }
    }
};
struct EpiP {
    static constexpr bool PERM = true;
    bf16* P;
    __device__ __forceinline__ void operator()(const acc_t& acc, const Unit& u, int wr, int wc, int fr, int fq) const {
        const int col0 = u.pn * 256 + wc * 32 + 8 * fq; const int row0 = u.pm * 256 + wr * 64 + fr;
#pragma unroll
        for (int ai = 0; ai < 2; ++ai)
#pragma unroll
            for (int m = 0; m < 4; ++m)
#pragma unroll
                for (int bj = 0; bj < 2; ++bj) { const f32x4 v0 = acc[ai][bj][m][0], v1 = acc[ai][bj][m][1];
                    *(u32x4*)(P + (size_t)(row0 + ai * 128 + m * 16) * D + col0 + bj * 128) = (u32x4){pg8::cvt_pk_bf16(v0[0], v0[1]), pg8::cvt_pk_bf16(v0[2], v0[3]), pg8::cvt_pk_bf16(v1[0], v1[1]), pg8::cvt_pk_bf16(v1[2], v1[3])}; }
    }
};
struct EpiSwiGLU {
    static constexpr bool PERM = true;
    bf16* H;
    __device__ __forceinline__ void operator()(const acc_t& acc, const Unit& u, int wr, int wc, int fr, int fq) const {
        const int hc = u.pn * 128 + wc * 32 + 8 * fq; const int row0 = u.pm * 256 + wr * 64 + fr;
#pragma unroll
        for (int ai = 0; ai < 2; ++ai)
#pragma unroll
            for (int m = 0; m < 4; ++m) { float h[8];
#pragma unroll
                for (int n = 0; n < 2; ++n)
#pragma unroll
                    for (int j = 0; j < 4; ++j) h[n * 4 + j] = silu_f(acc[ai][0][m][n][j]) * acc[ai][1][m][n][j];
                u32x4 w; w.x = pg8::cvt_pk_bf16(h[0], h[1]); w.y = pg8::cvt_pk_bf16(h[2], h[3]); w.z = pg8::cvt_pk_bf16(h[4], h[5]); w.w = pg8::cvt_pk_bf16(h[6], h[7]);
                *(u32x4*)(H + (size_t)(row0 + ai * 128 + m * 16) * DE + hc) = w; }
    }
};
struct EpiMoeOut {
    static constexpr bool PERM = true;
    bf16* Y; const int* elist; const float* ewt;
    __device__ __forceinline__ void operator()(const acc_t& acc, const Unit& u, int wr, int wc, int fr, int fq) const {
        const int col0 = u.pn * 256 + wc * 32 + 8 * fq;
#pragma unroll
        for (int ai = 0; ai < 2; ++ai)
#pragma unroll
            for (int m = 0; m < 4; ++m) { const int rank = u.tm * 256 + ai * 128 + wr * 64 + m * 16 + fr;
                if (rank < u.cnt) { const int tk = elist[u.e * ECAP + rank]; const float w = ewt[u.e * ECAP + rank];
#pragma unroll
                    for (int bj = 0; bj < 2; ++bj) { const f32x4 v0 = acc[ai][bj][m][0] * w, v1 = acc[ai][bj][m][1] * w; u32x4 o;
                        o.x = pg8::cvt_pk_bf16(v0[0], v0[1]); o.y = pg8::cvt_pk_bf16(v0[2], v0[3]); o.z = pg8::cvt_pk_bf16(v1[0], v1[1]); o.w = pg8::cvt_pk_bf16(v1[2], v1[3]);
                        *(u32x4*)(Y + (size_t)tk * D + col0 + bj * 128) = o; } } }
    }
};
template <bool GATHER_> struct MoeOrder {
    static constexpr bool GATHER = GATHER_;
    const LAS int* tp; const int* elist; int G, c, nwg;
    __device__ bool next(int i, Unit& u) const {
        const long L = (long)i * G + c; if (L >= nwg) return false;
        int wgid = (int)L; { const int q = nwg / 8, r = nwg % 8, xcd = wgid % 8, off = wgid / 8; wgid = (xcd < r ? xcd * (q + 1) : r * (q + 1) + (xcd - r) * q) + off; }
        const int gt = wgid >> 2; int e = 0;
#pragma unroll
        for (int k = 1; k < 16; ++k) e = (gt >= tp[k]) ? k : e;
        u.pm = gt; u.pn = wgid & 3; u.e = e; u.tm = gt - tp[e]; u.cnt = tp[17 + e]; return true;
    }
    __device__ __forceinline__ int a_row0(const Unit& u) const { return u.pm * 256; }
    __device__ __forceinline__ int a_row(const Unit& u, int r) const {
        if constexpr (GATHER_) { int rank = u.tm * 256 + r; rank = rank < u.cnt ? rank : u.cnt - 1; return elist[u.e * ECAP + rank] >> 1; }
        else return u.pm * 256 + r;
    }
    __device__ __forceinline__ int b_row0(const Unit& u) const { return u.e * 1024 + u.pn * 256; }
    __device__ __forceinline__ bool perm(const Unit&) const { return true; }
};


constexpr int SWMASK = 0x7C;
constexpr int W_REL_XN = (int)(((long long)WS_WINT - (long long)WS_XN) / 2048);
struct ProjOrder {
    static constexpr bool GATHER = false;
    pg8::DenseOrder d;
    __device__ void init(int G_, int c_) { d.init(MROWS, INCOLS, G_, c_); }
    __device__ bool next(int i, Unit& u) const { if (!d.next(i, u)) return false; u.e = (SWMASK >> (u.pn >> 1)) & 1; return true; }
    __device__ __forceinline__ int a_row0(const Unit& u) const { return u.e ? W_REL_XN + u.pn * 256 : u.pm * 256; }
    __device__ __forceinline__ int a_row(const Unit& u, int r) const { return a_row0(u) + r; }
    __device__ __forceinline__ int b_row0(const Unit& u) const { return u.e ? -W_REL_XN + u.pm * 256 : u.pn * 256; }
    __device__ __forceinline__ bool perm(const Unit& u) const { return (u.pn >> 1) >= 2; }
};


__device__ __forceinline__ bf16x8 pack8(const f32x4& a, const f32x4& b) {
    u32x4 w; w.x = pg8::cvt_pk_bf16(a[0], a[1]); w.y = pg8::cvt_pk_bf16(a[2], a[3]); w.z = pg8::cvt_pk_bf16(b[0], b[1]); w.w = pg8::cvt_pk_bf16(b[2], b[3]);
    return __builtin_bit_cast(bf16x8, w);
}
typedef unsigned bu4 __attribute__((__vector_size__(16)));
__device__ __forceinline__ bf16x8 bload16(__amdgpu_buffer_rsrc_t r, unsigned voff, unsigned soff) { return __builtin_bit_cast(bf16x8, __builtin_amdgcn_raw_buffer_load_b128(r, (int)voff, (int)soff, 0)); }
#define NA_SB() __builtin_amdgcn_sched_barrier(0)
__device__ __forceinline__ bf16x8 sel8(bool c, const bf16x8 a, const bf16x8 b) { const u32x4 x = __builtin_bit_cast(u32x4, a), y = __builtin_bit_cast(u32x4, b); u32x4 r;
    r.x = c ? x.x : y.x; r.y = c ? x.y : y.y; r.z = c ? x.z : y.z; r.w = c ? x.w : y.w; return __builtin_bit_cast(bf16x8, r); }
__device__ __forceinline__ void na_row(int b, int h, int r, const bf16* Q, const bf16* QR, __amdgpu_buffer_rsrc_t srdK, __amdgpu_buffer_rsrc_t srdV, bf16* MIX, const LAS float* rpbL, LAS unsigned char* qL, int lane) {
    const int qi = lane & 15, g = lane >> 4, rg = qi >> 2;
    constexpr float SC = 0.125f * 1.44269504f; const float NEG = -1e30f;
    int rs = r - 4; rs = rs < 0 ? 0 : (rs > NROWS - 8 ? NROWS - 8 : rs);
    const int tok0 = b * SEQ + r * GW;
    const unsigned klane = (unsigned)((8 * rg + (qi & 3)) * NAD + 8 * g) * 2u;
    const unsigned vlane = (unsigned)(qi * 64 + 8 * g) * 2u;
    const bool selK1 = (rg == 0), selK2 = (rg != 3), selV1 = (g == 0), selV2 = (g != 3);
#define NA_P0(j) ((j) == 0 ? 0 : (j) == 1 ? 1 : (j) == 2 ? 3 : 4)
#define NA_BB(j) (8 * (NA_P0(j) + ((g - NA_P0(j)) & 3)) - (16 * (j) + qi) + 31)
#define NA_LO(j) (((j) == 0 ? (qi < 8 ? 31 - qi : 23) : (j) == 3 ? (qi > 8 ? 31 - qi : 23) : 23) - NA_BB(j))
    f32x4 o[4][4]; float mref[4], lsum[4];
#pragma unroll
    for (int j = 0; j < 4; ++j) { mref[j] = 0.f; lsum[j] = 0.f;
#pragma unroll
        for (int dt = 0; dt < 4; ++dt) o[j][dt] = (f32x4){0.f, 0.f, 0.f, 0.f}; }
    bf16x8 kf[2][2][2], vf[2][4], Bp[4];
    LAS bf16x8* qs = (LAS bf16x8*)qL + lane;
#pragma unroll
    for (int j = 0; j < 4; ++j) { const bf16* qp = QR + (size_t)(tok0 + 16 * j + qi) * SEGW + h * NAD + 8 * g; qs[(2 * j) * 64] = *(const bf16x8*)qp; qs[(2 * j + 1) * 64] = *(const bf16x8*)(qp + 32); }
    const unsigned bh = (unsigned)(b * NAH + h);
    const unsigned ks0 = (bh * KTOK + (unsigned)(rs * GW)) * (NAD * 2u), vs0 = (bh * (KTOK / 64) + (unsigned)rs) * (NAD * 64 * 2u);
#define NA_KLD(so) do { _Pragma("unroll") for (int H = 0; H < 2; ++H) _Pragma("unroll") for (int m = 0; m < 2; ++m) _Pragma("unroll") for (int k = 0; k < 2; ++k) \
        kf[H][m][k] = bload16(srdK, klane, (so) + (unsigned)(H * 32 * NAD * 2 + m * 4 * NAD * 2 + k * 64)); } while (0)
#define NA_VLD(so) do { _Pragma("unroll") for (int H = 0; H < 2; ++H) _Pragma("unroll") for (int dt = 0; dt < 4; ++dt) \
        vf[H][dt] = bload16(srdV, vlane, (so) + (unsigned)(H * 64) + (unsigned)dt * (16 * 64 * 2)); } while (0)
    NA_KLD(ks0); NA_VLD(vs0);
    const LAS float* bp0 = rpbL + (h * 15 + rs - r + 7) * 64;
#pragma unroll 1
    for (int i = 0; i < 8; ++i) {
        const LAS float* bpi = bp0 + i * 64;
        NA_SB();
#pragma unroll
        for (int j = 0; j < 4; ++j) {
            f32x4 s0, s1; const bf16x8 q0 = qs[(2 * j) * 64], q1 = qs[(2 * j + 1) * 64];
            { const bf16x8 a00 = (j == 0) ? kf[0][0][0] : (j == 3) ? kf[1][0][0] : sel8(j == 1 ? selK1 : selK2, kf[1][0][0], kf[0][0][0]);
              const bf16x8 a01 = (j == 0) ? kf[0][0][1] : (j == 3) ? kf[1][0][1] : sel8(j == 1 ? selK1 : selK2, kf[1][0][1], kf[0][0][1]);
              const bf16x8 a10 = (j == 0) ? kf[0][1][0] : (j == 3) ? kf[1][1][0] : sel8(j == 1 ? selK1 : selK2, kf[1][1][0], kf[0][1][0]);
              const bf16x8 a11 = (j == 0) ? kf[0][1][1] : (j == 3) ? kf[1][1][1] : sel8(j == 1 ? selK1 : selK2, kf[1][1][1], kf[0][1][1]);
              s0 = __builtin_amdgcn_mfma_f32_16x16x32_bf16(a00, q0, (f32x4){0.f, 0.f, 0.f, 0.f}, 0, 0, 0); s0 = __builtin_amdgcn_mfma_f32_16x16x32_bf16(a01, q1, s0, 0, 0, 0);
              s1 = __builtin_amdgcn_mfma_f32_16x16x32_bf16(a10, q0, (f32x4){0.f, 0.f, 0.f, 0.f}, 0, 0, 0); s1 = __builtin_amdgcn_mfma_f32_16x16x32_bf16(a11, q1, s1, 0, 0, 0); }
            const int lo_j = NA_LO(j); const LAS float* bpj = bpi + NA_BB(j);
            { float b0 = bpj[0], b1 = bpj[1], b2 = bpj[2], b3 = bpj[3];
              asm volatile("" : "+v"(b0), "+v"(b1), "+v"(b2), "+v"(b3));
              const float bq[4] = {b0, b1, b2, b3};
#pragma unroll
              for (int e = 0; e < 4; ++e) { const float t0 = s0[e] * SC + bq[e]; s0[e] = ((unsigned)(e - lo_j) < 16u) ? t0 : NEG; } }
            { float b0 = bpj[4], b1 = bpj[5], b2 = bpj[6], b3 = bpj[7];
              asm volatile("" : "+v"(b0), "+v"(b1), "+v"(b2), "+v"(b3));
              const float bq[4] = {b0, b1, b2, b3};
#pragma unroll
              for (int e = 0; e < 4; ++e) { const float t1 = s1[e] * SC + bq[e]; s1[e] = ((unsigned)(4 + e - lo_j) < 16u) ? t1 : NEG; } }
            if (i == 0) { float mx = fmaxf(fmaxf(fmaxf(s0[0], s0[1]), fmaxf(s0[2], s0[3])), fmaxf(fmaxf(s1[0], s1[1]), fmaxf(s1[2], s1[3])));
                mx = fmaxf(mx, __shfl_xor(mx, 16)); mx = fmaxf(mx, __shfl_xor(mx, 32)); mref[j] = mx; }
            float ps = 0.f;
#pragma unroll
            for (int e = 0; e < 4; ++e) { s0[e] = __builtin_amdgcn_exp2f(fminf(s0[e] - mref[j], 100.f)); s1[e] = __builtin_amdgcn_exp2f(fminf(s1[e] - mref[j], 100.f)); ps += s0[e] + s1[e]; }
            lsum[j] += ps; Bp[j] = pack8(s0, s1);
            if (j == 1) { asm volatile("" : "+v"(Bp[0]), "+v"(Bp[1])); NA_SB(); }
        }
        asm volatile("" : "+v"(Bp[0]), "+v"(Bp[1]), "+v"(Bp[2]), "+v"(Bp[3]));
        NA_SB();
        if (i < 7) NA_KLD(ks0 + (unsigned)(i + 1) * (GW * NAD * 2));
        NA_SB();
#pragma unroll
        for (int j = 0; j < 4; ++j) {
#pragma unroll
            for (int dt = 0; dt < 4; ++dt) { const bf16x8 A = (j == 0) ? vf[0][dt] : (j == 3) ? vf[1][dt] : sel8(j == 1 ? selV1 : selV2, vf[1][dt], vf[0][dt]);
                o[j][dt] = __builtin_amdgcn_mfma_f32_16x16x32_bf16(A, Bp[j], o[j][dt], 0, 0, 0); }
            asm volatile("" : "+v"(o[j][0]), "+v"(o[j][1]), "+v"(o[j][2]), "+v"(o[j][3]));
            if (j == 1) NA_SB(); }
        NA_SB();
        if (i < 7) NA_VLD(vs0 + (unsigned)(i + 1) * (NAD * 64 * 2));
    }
#pragma unroll
    for (int j = 0; j < 4; ++j) { const bf16* qp = Q + (size_t)(tok0 + 16 * j + qi) * SEGW + h * NAD + 8 * g; qs[(2 * j) * 64] = *(const bf16x8*)qp; qs[(2 * j + 1) * 64] = *(const bf16x8*)(qp + 32); }
    const unsigned kc0 = (bh * KTOK + (unsigned)SEQ) * (NAD * 2u), vc0 = (bh * (KTOK / 64) + (unsigned)(SEQ / 64)) * (NAD * 64 * 2u);
#define NA_KLDC(so) do { _Pragma("unroll") for (int m = 0; m < 2; ++m) _Pragma("unroll") for (int k = 0; k < 2; ++k) kf[0][m][k] = bload16(srdK, klane, (so) + (unsigned)(m * 4 * NAD * 2 + k * 64)); } while (0)
#define NA_VLDC(so) do { _Pragma("unroll") for (int dt = 0; dt < 4; ++dt) vf[0][dt] = bload16(srdV, vlane, (so) + (unsigned)dt * (16 * 64 * 2)); } while (0)
    NA_KLDC(kc0); NA_VLDC(vc0);
#pragma unroll 1
    for (int i = 0; i < 8; ++i) {
        NA_SB();
#pragma unroll
        for (int j = 0; j < 4; ++j) {
            const bf16x8 q0 = qs[(2 * j) * 64], q1 = qs[(2 * j + 1) * 64];
            f32x4 s0 = __builtin_amdgcn_mfma_f32_16x16x32_bf16(kf[0][0][0], q0, (f32x4){0.f, 0.f, 0.f, 0.f}, 0, 0, 0); s0 = __builtin_amdgcn_mfma_f32_16x16x32_bf16(kf[0][0][1], q1, s0, 0, 0, 0);
            f32x4 s1 = __builtin_amdgcn_mfma_f32_16x16x32_bf16(kf[0][1][0], q0, (f32x4){0.f, 0.f, 0.f, 0.f}, 0, 0, 0); s1 = __builtin_amdgcn_mfma_f32_16x16x32_bf16(kf[0][1][1], q1, s1, 0, 0, 0);
            float ps = 0.f;
#pragma unroll
            for (int e = 0; e < 4; ++e) { s0[e] = __builtin_amdgcn_exp2f(fminf(s0[e] * SC - mref[j], 100.f)); s1[e] = __builtin_amdgcn_exp2f(fminf(s1[e] * SC - mref[j], 100.f)); ps += s0[e] + s1[e]; }
            lsum[j] += ps; Bp[j] = pack8(s0, s1);
        }
        asm volatile("" : "+v"(Bp[0]), "+v"(Bp[1]), "+v"(Bp[2]), "+v"(Bp[3]));
        NA_SB();
        if (i < 7) NA_KLDC(kc0 + (unsigned)(i + 1) * (32 * NAD * 2));
        NA_SB();
#pragma unroll
        for (int j = 0; j < 4; ++j)
#pragma unroll
            for (int dt = 0; dt < 4; ++dt) o[j][dt] = __builtin_amdgcn_mfma_f32_16x16x32_bf16(vf[0][dt], Bp[j], o[j][dt], 0, 0, 0);
#pragma unroll
        for (int j = 0; j < 4; ++j) asm volatile("" : "+v"(o[j][0]), "+v"(o[j][1]), "+v"(o[j][2]), "+v"(o[j][3]));
        NA_SB();
        if (i < 7) NA_VLDC(vc0 + (unsigned)(((i + 1) >> 1) * (NAD * 64 * 2) + ((i + 1) & 1) * 64));
    }
#undef NA_KLD
#undef NA_VLD
#undef NA_KLDC
#undef NA_VLDC
#pragma unroll
    for (int j = 0; j < 4; ++j) { float l = lsum[j]; l += __shfl_xor(l, 16); l += __shfl_xor(l, 32); const float inv = 1.f / l;
        bf16* op = MIX + (size_t)(tok0 + 16 * j + qi) * D + h * NAD + 4 * g;
#pragma unroll
        for (int dt = 0; dt < 4; ++dt) { const f32x4 v = o[j][dt] * inv; *(v2u*)(op + 16 * dt) = (v2u){pg8::cvt_pk_bf16(v[0], v[1]), pg8::cvt_pk_bf16(v[2], v[3])}; } }
}

typedef float f32x16 __attribute__((ext_vector_type(16)));
constexpr int SC_Q1 = 0, SC_K1 = SC_Q1 + 64 * 272, SC_K1T = SC_K1 + 64 * 272, SC_VT = SC_K1T + 128 * 144, SC_ST = SC_VT + 128 * 144, SC_TOT = SC_ST + 128 * 272, SC_CST = SC_TOT + 2 * 4 * 128 * 4, SC_END = SC_CST + 2 * 128 * 4;
static_assert(SC_END <= RING_BYTES, "scan LDS");
#define SCAN_MFMA(a, b, c) __builtin_amdgcn_mfma_f32_32x32x16_bf16(a, b, c, 0, 0, 0)
__device__ __forceinline__ void scan_unit(LAS unsigned char* lds, int b, int h, int dir, const unsigned short* LGT, const bf16* HQT, const bf16* HIT, bf16* OUT, int tid) {
    const int lane = tid & 63, w = __builtin_amdgcn_readfirstlane(tid >> 6), r = lane & 31, hh = lane >> 5;
    const int d = tid & 127, tq = tid >> 7;
    const int ti = w >> 2, ovi = w & 3;
    const int di = w >> 1, svi = 2 * (w & 1);
    f32x16 S0, S1;
#pragma unroll
    for (int i = 0; i < 16; ++i) { S0[i] = 0.f; S1[i] = 0.f; }
    const size_t chrow = (size_t)(h * HGD + d);
    constexpr int NCH = (LC + SEQ) / 64;
    auto col_of = [&](int c) -> int { return c < 4 ? (T + b * LC + 64 * (dir ? 3 - c : c)) : (b * SEQ + (dir ? SEQ - 64 * (c - 3) : 64 * (c - 4))); };
    LAS float* totb = (LAS float*)(lds + SC_TOT); LAS float* cst = (LAS float*)(lds + SC_CST);
    u32x4 lg0[2], lg1[2], vr[2], qr[2];
    { const int c0 = col_of(0) + 16 * tq, c1 = col_of(1) + 16 * tq;
      lg0[0] = *(const u32x4*)(LGT + chrow * MROWS + c0); lg0[1] = *(const u32x4*)(LGT + chrow * MROWS + c0 + 8);
      lg1[0] = *(const u32x4*)(LGT + chrow * MROWS + c1); lg1[1] = *(const u32x4*)(LGT + chrow * MROWS + c1 + 8);
      vr[0] = *(const u32x4*)(HIT + chrow * MROWS + c0); vr[1] = *(const u32x4*)(HIT + chrow * MROWS + c0 + 8); qr[0] = qr[1] = (u32x4){0u, 0u, 0u, 0u};
      float sm = 0.f;
#pragma unroll
      for (int i = 0; i < 8; ++i) { const unsigned u2 = lg0[i >> 2][i & 3]; sm += h2f((unsigned short)(u2 & 0xffff)) + h2f((unsigned short)(u2 >> 16)); }
      totb[tq * 128 + d] = sm; }
    __syncthreads();
#pragma unroll 1
    for (int c = 0; c < NCH; ++c) {
        const bool lat = c >= 4; const int par = c & 1;
        LAS float* tot = totb + par * 512;
        {
            float P[16], kk[16];
#pragma unroll
            for (int i = 0; i < 8; ++i) { const unsigned u2 = lg0[i >> 2][i & 3]; P[2 * i] = h2f((unsigned short)(u2 & 0xffff)); P[2 * i + 1] = h2f((unsigned short)(u2 >> 16)); }
#pragma unroll
            for (int i = 0; i < 16; ++i) kk[i] = 1.f - __builtin_amdgcn_exp2f(P[i]);
            if (!dir) {
#pragma unroll
                for (int i = 1; i < 16; ++i) P[i] += P[i - 1];
            } else {
#pragma unroll
                for (int i = 14; i >= 0; --i) P[i] += P[i + 1];
            }
            const float t0 = tot[d], t1 = tot[128 + d], t2 = tot[256 + d], t3 = tot[384 + d];
            const float Bm = dir ? (t2 + t3) : (t0 + t1);
            float offs; if (!dir) offs = (tq > 0 ? t0 : 0.f) + (tq > 1 ? t1 : 0.f) + (tq > 2 ? t2 : 0.f); else offs = (tq < 3 ? t3 : 0.f) + (tq < 2 ? t2 : 0.f) + (tq < 1 ? t1 : 0.f);
            const float sh = offs - Bm;
            if (tq == 0) { const float be = (t0 + t1) + (t2 + t3); cst[d] = __builtin_amdgcn_exp2f(be); cst[128 + d] = __builtin_amdgcn_exp2f(be - Bm); }
            unsigned kt[8];
            LAS bf16* q1 = (LAS bf16*)(lds + SC_Q1) + (16 * tq) * 136 + d; LAS bf16* k1 = (LAS bf16*)(lds + SC_K1) + (16 * tq) * 136 + d;
#pragma unroll
            for (int i = 0; i < 16; i += 2) {
                const float x0 = fminf(fmaxf(P[i] + sh, -120.f), 120.f), x1 = fminf(fmaxf(P[i + 1] + sh, -120.f), 120.f);
                const float k0 = kk[i] * __builtin_amdgcn_exp2f(-x0), k1v = kk[i + 1] * __builtin_amdgcn_exp2f(-x1);
                kt[i >> 1] = pg8::cvt_pk_bf16(k0, k1v);
                if (lat) { const unsigned qq = (i < 8 ? qr[0] : qr[1])[(i >> 1) & 3];
                    const unsigned qp2 = pg8::cvt_pk_bf16(bflo(qq) * __builtin_amdgcn_exp2f(x0), bfhi(qq) * __builtin_amdgcn_exp2f(x1));
                    q1[i * 136] = (bf16)(qp2 & 0xffff); q1[(i + 1) * 136] = (bf16)(qp2 >> 16);
                    k1[i * 136] = (bf16)(kt[i >> 1] & 0xffff); k1[(i + 1) * 136] = (bf16)(kt[i >> 1] >> 16); }
            }
            LAS unsigned char* k1t = lds + SC_K1T + d * 144 + 32 * tq;
            *(LAS u32x4*)k1t = (u32x4){kt[0], kt[1], kt[2], kt[3]}; *(LAS u32x4*)(k1t + 16) = (u32x4){kt[4], kt[5], kt[6], kt[7]};
            LAS unsigned char* vt = lds + SC_VT + d * 144 + 32 * tq;
            *(LAS u32x4*)vt = vr[0]; *(LAS u32x4*)(vt + 16) = vr[1];
        }
        if (lat) {
#pragma unroll
            for (int rg = 0; rg < 4; ++rg) { const int dd = 32 * di + 8 * rg + 4 * hh;
                const f32x4 a0 = *(const LAS f32x4*)(tot + dd), a1 = *(const LAS f32x4*)(tot + 128 + dd), a2 = *(const LAS f32x4*)(tot + 256 + dd), a3 = *(const LAS f32x4*)(tot + 384 + dd);
                const f32x4 bm = dir ? (a2 + a3) : (a0 + a1); float eb[4];
#pragma unroll
                for (int j = 0; j < 4; ++j) eb[j] = __builtin_amdgcn_exp2f(bm[j]);
                *(LAS v2u*)(lds + SC_ST + ((32 * svi + r) * 136 + dd) * 2) = (v2u){pg8::cvt_pk_bf16(S0[4 * rg] * eb[0], S0[4 * rg + 1] * eb[1]), pg8::cvt_pk_bf16(S0[4 * rg + 2] * eb[2], S0[4 * rg + 3] * eb[3])};
                *(LAS v2u*)(lds + SC_ST + ((32 * (svi + 1) + r) * 136 + dd) * 2) = (v2u){pg8::cvt_pk_bf16(S1[4 * rg] * eb[0], S1[4 * rg + 1] * eb[1]), pg8::cvt_pk_bf16(S1[4 * rg + 2] * eb[2], S1[4 * rg + 3] * eb[3])}; }
        }
        if (c + 1 < NCH) { float sm = 0.f;
#pragma unroll
            for (int i = 0; i < 8; ++i) { const unsigned u2 = lg1[i >> 2][i & 3]; sm += h2f((unsigned short)(u2 & 0xffff)) + h2f((unsigned short)(u2 >> 16)); }
            totb[(par ^ 1) * 512 + tq * 128 + d] = sm;
            lg0[0] = lg1[0]; lg0[1] = lg1[1];
            const int c1 = col_of(c + 1) + 16 * tq;
            vr[0] = *(const u32x4*)(HIT + chrow * MROWS + c1); vr[1] = *(const u32x4*)(HIT + chrow * MROWS + c1 + 8);
            if (c + 1 >= 4) { qr[0] = *(const u32x4*)(HQT + chrow * T + c1); qr[1] = *(const u32x4*)(HQT + chrow * T + c1 + 8); }
            if (c + 2 < NCH) { const int c2 = col_of(c + 2) + 16 * tq; lg1[0] = *(const u32x4*)(LGT + chrow * MROWS + c2); lg1[1] = *(const u32x4*)(LGT + chrow * MROWS + c2 + 8); } }
        __syncthreads();
        f32x16 dS0, dS1, O;
#pragma unroll
        for (int i = 0; i < 16; ++i) { dS0[i] = 0.f; dS1[i] = 0.f; O[i] = 0.f; }
        {
            bf16x8 fa[4], fb0[4], fb1[4];
#pragma unroll
            for (int ks = 0; ks < 4; ++ks) { fa[ks] = *(const LAS bf16x8*)(lds + SC_K1T + ((32 * di + r) * 72 + 16 * ks + 8 * hh) * 2);
                fb0[ks] = *(const LAS bf16x8*)(lds + SC_VT + ((32 * svi + r) * 72 + 16 * ks + 8 * hh) * 2); fb1[ks] = *(const LAS bf16x8*)(lds + SC_VT + ((32 * (svi + 1) + r) * 72 + 16 * ks + 8 * hh) * 2); }
#pragma unroll
            for (int ks = 0; ks < 4; ++ks) { dS0 = SCAN_MFMA(fa[ks], fb0[ks], dS0); dS1 = SCAN_MFMA(fa[ks], fb1[ks], dS1); }
        }
        if (lat) {
            bf16x8 fq[8];
#pragma unroll
            for (int ks = 0; ks < 8; ++ks) fq[ks] = *(const LAS bf16x8*)(lds + SC_Q1 + ((32 * ti + r) * 136 + 16 * ks + 8 * hh) * 2);
            {
                bf16x8 fs[8];
#pragma unroll
                for (int ks = 0; ks < 8; ++ks) fs[ks] = *(const LAS bf16x8*)(lds + SC_ST + ((32 * ovi + r) * 136 + 16 * ks + 8 * hh) * 2);
#pragma unroll
                for (int ks = 0; ks < 8; ++ks) O = SCAN_MFMA(fs[ks], fq[ks], O);
            }
#pragma unroll
            for (int si = 0; si < 2; ++si) {
                const bool live = dir ? (si >= ti) : (si <= ti);
                if (live) {
                    f32x16 At;
#pragma unroll
                    for (int i = 0; i < 16; ++i) At[i] = 0.f;
                    bf16x8 fk[8];
#pragma unroll
                    for (int ks = 0; ks < 8; ++ks) fk[ks] = *(const LAS bf16x8*)(lds + SC_K1 + ((32 * si + r) * 136 + 16 * ks + 8 * hh) * 2);
#pragma unroll
                    for (int ks = 0; ks < 8; ++ks) At = SCAN_MFMA(fk[ks], fq[ks], At);
                    const int tt = 32 * ti + r;
                    if (si == ti) {
#pragma unroll
                        for (int i = 0; i < 16; ++i) { const int ss = 32 * si + (i & 3) + 8 * (i >> 2) + 4 * hh; const bool keep = dir ? (ss >= tt) : (ss <= tt); At[i] = keep ? At[i] : 0.f; }
                    }
#pragma unroll
                    for (int k2 = 0; k2 < 2; ++k2) {
                        u32x4 pw; pw.x = pg8::cvt_pk_bf16(At[8 * k2], At[8 * k2 + 1]); pw.y = pg8::cvt_pk_bf16(At[8 * k2 + 2], At[8 * k2 + 3]); pw.z = pg8::cvt_pk_bf16(At[8 * k2 + 4], At[8 * k2 + 5]); pw.w = pg8::cvt_pk_bf16(At[8 * k2 + 6], At[8 * k2 + 7]);
                        const LAS unsigned char* vp = lds + SC_VT + ((32 * ovi + r) * 72 + 32 * si + 16 * k2 + 4 * hh) * 2;
                        const v2u lo = *(const LAS v2u*)vp, hi2 = *(const LAS v2u*)(vp + 16);
                        O = SCAN_MFMA(__builtin_bit_cast(bf16x8, (u32x4){lo.x, lo.y, hi2.x, hi2.y}), __builtin_bit_cast(bf16x8, pw), O);
                    }
                }
            }
            bf16* op = OUT + (size_t)(col_of(c) + 32 * ti + r) * SEGW + h * HGD + 32 * ovi + 4 * hh;
#pragma unroll
            for (int rg = 0; rg < 4; ++rg) *(v2u*)(op + 8 * rg) = (v2u){pg8::cvt_pk_bf16(O[4 * rg], O[4 * rg + 1]), pg8::cvt_pk_bf16(O[4 * rg + 2], O[4 * rg + 3])};
        }
#pragma unroll
        for (int rg = 0; rg < 4; ++rg) { const int dd = 32 * di + 8 * rg + 4 * hh;
            const f32x4 ee = *(const LAS f32x4*)(cst + dd), em = *(const LAS f32x4*)(cst + 128 + dd);
#pragma unroll
            for (int j = 0; j < 4; ++j) { S0[4 * rg + j] = ee[j] * S0[4 * rg + j] + em[j] * dS0[4 * rg + j]; S1[4 * rg + j] = ee[j] * S1[4 * rg + j] + em[j] * dS1[4 * rg + j]; } }
        __syncthreads();
    }
}

#ifdef DBG_NAIVE
__device__ __forceinline__ void scan_naive(LAS unsigned char* lds, int b, int h, int dir, const unsigned short* LGT, const bf16* HQT, const bf16* HIT, bf16* OUT, int tid) {
    const int dv = tid & 127, kg = tid >> 7;
    float St[32];
#pragma unroll
    for (int i = 0; i < 32; ++i) St[i] = 0.f;
    LAS float* sq = (LAS float*)lds; LAS float* sk = sq + 16 * 128; LAS float* sf = sk + 16 * 128; LAS float* sv = sf + 16 * 128; LAS float* so = sv + 16 * 128;
    constexpr int NSTEP = LC + SEQ;
    for (int j0 = 0; j0 < NSTEP; j0 += 16) {
        const bool isctx = j0 < LC;
        for (int idx = tid; idx < 16 * 128; idx += NTHR) { const int st = idx >> 7, ch = idx & 127, j = j0 + st;
            int col; if (j < LC) col = T + b * LC + (dir ? (LC - 1 - j) : j); else col = b * SEQ + (dir ? (SEQ - 1 - (j - LC)) : (j - LC));
            const size_t cr = (size_t)(h * HGD + ch);
            const float f = __builtin_amdgcn_exp2f(h2f(LGT[cr * MROWS + col]));
            sf[st * 128 + ch] = f; sk[st * 128 + ch] = 1.f - f; sv[st * 128 + ch] = bf2f(HIT[cr * MROWS + col]);
            if (!isctx) sq[st * 128 + ch] = bf2f(HQT[cr * T + col]); }
        __syncthreads();
        for (int st = 0; st < 16; ++st) {
            const float vv = sv[st * 128 + dv]; float o = 0.f;
#pragma unroll
            for (int i = 0; i < 32; ++i) { St[i] = sf[st * 128 + kg * 32 + i] * St[i] + sk[st * 128 + kg * 32 + i] * vv; o += St[i] * sq[st * 128 + kg * 32 + i]; }
            so[(st * 4 + kg) * 128 + dv] = o;
        }
        __syncthreads();
        if (!isctx) {
            for (int idx = tid; idx < 16 * 128; idx += NTHR) { const int st = idx >> 7, dd = idx & 127, j = j0 + st;
                const float o = (so[(st * 4 + 0) * 128 + dd] + so[(st * 4 + 1) * 128 + dd]) + (so[(st * 4 + 2) * 128 + dd] + so[(st * 4 + 3) * 128 + dd]);
                const int row = b * SEQ + (dir ? (SEQ - 1 - (j - LC)) : (j - LC));
                OUT[(size_t)row * SEGW + h * HGD + dd] = (bf16)f2bf(o); }
        }
        __syncthreads();
    }
}
#endif

__device__ __forceinline__ void transpose_item(const float* W, int ldw, int k0, int n0, bf16* WT, int ldk, int drow0, LAS float* scr, int lane) {
#pragma unroll 8
    for (int i = 0; i < 32; ++i) { const int kk = 2 * i + (lane >> 5); scr[kk * 33 + (lane & 31)] = W[(size_t)(k0 + kk) * ldw + n0 + (lane & 31)]; }
    LDS_WAIT(); asm volatile("" ::: "memory");
    const int c = lane & 7;
#pragma unroll
    for (int j = 0; j < 4; ++j) { const int n = (lane >> 3) + 8 * j; const LAS float* s = scr + (8 * c) * 33 + n;
        v4u o; o.x = pk2(s[0 * 33], s[1 * 33]); o.y = pk2(s[2 * 33], s[3 * 33]); o.z = pk2(s[4 * 33], s[5 * 33]); o.w = pk2(s[6 * 33], s[7 * 33]);
        *(GAS v4u*)(WT + (size_t)(drow0 + n) * ldk + k0 + 8 * c) = o; }
    LDS_WAIT(); asm volatile("" ::: "memory");
}

struct Args { const float* in[21]; float* out; unsigned char* ws; int ph_lo, ph_hi, li, pad; };

__global__ void __launch_bounds__(NTHR, 2) fwd_mega(Args args) {
    extern __shared__ __attribute__((aligned(16))) unsigned char lds_raw[];
    LAS unsigned char* lds = (LAS unsigned char*)lds_raw;
    volatile LAS unsigned* MISC = (volatile LAS unsigned*)(lds + MISC_OFF);
    const int tid = threadIdx.x, lane = tid & 63, wave = __builtin_amdgcn_readfirstlane(tid >> 6);
    const int G = gridDim.x; const int bx = blockIdx.x; const int vcu = (G % 8 == 0) ? (bx % 8) * (G / 8) + bx / 8 : bx;
    gu32* ctl0 = (gu32*)(args.ws + WS_CTL);
    const int gw = vcu * NWAVES + wave, NGW = G * NWAVES;
    for (int u = tid; u < (LDS_BYTES - LDSCTL_OFF) / 4; u += NTHR) ((LAS unsigned*)(lds + LDSCTL_OFF))[u] = 0u;
    __syncthreads();
    XcdBarrier bar = xcd_barrier_post((unsigned*)(ctl0 + CW_BAR) + args.li * XCD_BAR_WORDS, MISC + 8);
    const int lo = args.ph_lo, hi = args.ph_hi;
#ifndef PHMASK
#define PHMASK 0xFFFF
#endif
#define IN(k) (((PHMASK >> (k)) & 1) && lo <= (k) && (k) < hi)
#define SEAM(k) do { if (IN(k) && IN((k) + 1)) xcd_barrier(bar); } while (0)

#define KA(i) ({ const __attribute__((address_space(4))) Args* _p = (const __attribute__((address_space(4))) Args*)__builtin_amdgcn_kernarg_segment_ptr(); asm volatile("" : "+s"(_p)); _p->in[i]; })
#define WSP() ({ const __attribute__((address_space(4))) Args* _p = (const __attribute__((address_space(4))) Args*)__builtin_amdgcn_kernarg_segment_ptr(); asm volatile("" : "+s"(_p)); _p->ws; })
#define PHASE_PTRS unsigned char* ws = WSP(); float* MOD = (float*)(ws + WS_MOD); float* ROPE = (float*)(ws + WS_ROPE); float* LBT = (float*)(ws + WS_LBT); \
    bf16* WinT = (bf16*)(ws + WS_WINT); bf16* WoutT = (bf16*)(ws + WS_WOUTT); bf16* W13T = (bf16*)(ws + WS_W13T); bf16* W2T = (bf16*)(ws + WS_W2T); \
    bf16* XN = (bf16*)(ws + WS_XN); bf16* MIX = (bf16*)(ws + WS_MIX); bf16* XN2 = (bf16*)(ws + WS_XN2); \
    float* X1 = (float*)(ws + WS_X1); bf16* Hb = (bf16*)(ws + WS_H); bf16* Yb = (bf16*)(ws + WS_Y); \
    int* ELIST = (int*)(ws + WS_ELIST); float* EWT = (float*)(ws + WS_EWT); gu32* ctl = (gu32*)(ws + WS_CTL); \
    (void)MOD; (void)ROPE; (void)LBT; (void)WinT; (void)WoutT; (void)W13T; (void)W2T; (void)XN; (void)MIX; (void)XN2; (void)X1; (void)Hb; (void)Yb; (void)ELIST; (void)EWT; (void)ctl;
    if (IN(0)) {
        PHASE_PTRS
        const float* cvec = KA(1); const float* c_ctx = KA(3); const float* w_mod = KA(4); const float* b_mod = KA(5); const float* w_in = KA(8); const float* w_out = KA(9);
        const float* hg_lb = KA(11); const float* w1 = KA(17); const float* w3 = KA(18); const float* w2 = KA(19);
        if (bx == G - 1) {
            for (int idx = tid; idx < 1024; idx += NTHR) { const int pos = idx >> 4, i = idx & 15;
                double th = 1.0; for (int k = 0; k < i; ++k) th *= 0.5623413251903491;
                const double t2 = th * th; double c = 1.0, s = th, tc = 1.0, ts = th;
                for (int n = 1; n <= 12; ++n) { tc *= -t2 / (double)((2 * n - 1) * (2 * n)); c += tc; ts *= -t2 / (double)((2 * n) * (2 * n + 1)); s += ts; }
                double cr = 1.0, ci = 0.0; for (int p = 0; p < pos; ++p) { const double nr = cr * c - ci * s; ci = cr * s + ci * c; cr = nr; }
                ROPE[idx * 2] = (float)cr; ROPE[idx * 2 + 1] = (float)ci; }
            for (int idx = tid; idx < 1024; idx += NTHR) { const float h0 = hg_lb[idx], h1 = hg_lb[1024 + idx]; LBT[idx] = 1.f / (1.f + expf(h1 - h0)); }
        }
        if (bx < 96) {
            LAS float* sc = (LAS float*)lds;
            for (int idx = tid; idx < 17 * 1024; idx += NTHR) { const int r = idx >> 10, k = idx & 1023; const float cv = r < 16 ? cvec[r * 1024 + k] : c_ctx[k]; sc[idx] = cv / (1.f + expf(-cv)); }
            __syncthreads();
            const int col = 64 * bx + lane, k0 = 128 * wave;
            float acc[17];
#pragma unroll
            for (int r = 0; r < 17; ++r) acc[r] = 0.f;
            for (int kk = 0; kk < 128; kk += 4) {
                const float w0 = w_mod[(size_t)(k0 + kk) * 6144 + col], w1v = w_mod[(size_t)(k0 + kk + 1) * 6144 + col], w2v = w_mod[(size_t)(k0 + kk + 2) * 6144 + col], w3v = w_mod[(size_t)(k0 + kk + 3) * 6144 + col];
#pragma unroll
                for (int r = 0; r < 17; ++r) { const f32x4 a = *(const LAS f32x4*)(sc + r * 1024 + k0 + kk); acc[r] += a[0] * w0 + a[1] * w1v + a[2] * w2v + a[3] * w3v; }
            }
            LAS float* red = (LAS float*)(lds + 17 * 1024 * 4);
#pragma unroll
            for (int r = 0; r < 17; ++r) red[(wave * 17 + r) * 64 + lane] = acc[r];
            __syncthreads();
            for (int idx = tid; idx < 17 * 64; idx += NTHR) { const int r = idx >> 6, l = idx & 63; float s = 0.f;
#pragma unroll
                for (int w = 0; w < 8; ++w) s += red[(w * 17 + r) * 64 + l];
                MOD[r * 6144 + 64 * bx + l] = s + b_mod[64 * bx + l]; }
            __syncthreads();
        }
        {
            LAS float* scr = (LAS float*)(lds + wave * 16384);
            constexpr int I_IN = 16 * 128, I_OUT = 16 * 32, I_13 = 16 * 2 * 256, I_2 = 16 * 256, NIT = I_IN + I_OUT + I_13 + I_2;
            for (int it = gw; it < NIT; it += NGW) {
                int r = it;
                if (r < I_IN) { const int kb = r / 128, nb = r % 128; transpose_item(w_in, INCOLS, 64 * kb, 32 * nb, WinT, 1024, 32 * nb, scr, lane); continue; } r -= I_IN;
                if (r < I_OUT) { const int kb = r / 32, nb = r % 32; transpose_item(w_out, 1024, 64 * kb, 32 * nb, WoutT, 1024, 32 * nb, scr, lane); continue; } r -= I_OUT;
                if (r < I_13) { const int e = r / 512, rem = r % 512, s = rem / 256, r2 = rem % 256, kb = r2 / 16, nb = r2 % 16, n0 = 32 * nb;
                    transpose_item((s ? w3 : w1) + (size_t)e * 1024 * 512, 512, 64 * kb, n0, W13T, 1024, e * 1024 + 256 * (n0 / 128) + 128 * s + (n0 % 128), scr, lane); continue; } r -= I_13;
                { const int e = r / 256, r2 = r % 256, kb = r2 / 32, nb = r2 % 32; transpose_item(w2 + (size_t)e * 512 * 1024, 1024, 64 * kb, 32 * nb, W2T, 512, e * 1024 + 32 * nb, scr, lane); }
            }
        }
    }
    SEAM(0);

    if (IN(1)) {
        PHASE_PTRS
        const float* x = KA(0); const float* ctx = KA(2); const float* norm_mix = KA(6);
        for (int row = gw; row < MROWS; row += NGW) {
            const float* xr = row < T ? x + (size_t)row * D : ctx + (size_t)(row - T) * D; const int mb = row < T ? (row >> 11) : 16;
            f32x4 v[4]; float s = 0.f;
#pragma unroll
            for (int j = 0; j < 4; ++j) { v[j] = *(const f32x4*)(xr + 4 * lane + 256 * j); s += (v[j][0] * v[j][0] + v[j][1] * v[j][1]) + (v[j][2] * v[j][2] + v[j][3] * v[j][3]); }
            const float rstd = 1.f / sqrtf(wave_sum(s) * (1.f / D) + EPS);
#pragma unroll
            for (int j = 0; j < 4; ++j) { const int col = 4 * lane + 256 * j; const f32x4 g = *(const f32x4*)(norm_mix + col), sh = *(const f32x4*)(MOD + mb * 6144 + col), sc = *(const f32x4*)(MOD + mb * 6144 + 1024 + col);
                const f32x4 y = v[j] * rstd * g * (1.f + sc) + sh;
                *(v2u*)(XN + (size_t)row * D + col) = (v2u){pk2(y[0], y[1]), pk2(y[2], y[3])}; }
        }
    }
    SEAM(1);

    if (IN(2)) {
        PHASE_PTRS
        ProjOrder S; S.init(G, bx);
        LAS float* ropeL = (LAS float*)(lds + TAB_OFF); LAS float* lbtL = ropeL + 2048;
        for (int i = tid; i < 2048 + 1024; i += NTHR) ropeL[i] = i < 2048 ? ROPE[i] : LBT[i - 2048];
        __syncthreads();
        EpiProj E{ws, ropeL, lbtL, 0};
        pg8::gemm_phase<EpiProj, ProjOrder>(lds + RING_OFF, XN, WinT, D, S, E);
    }
    SEAM(2);

    if (IN(3)) {
        PHASE_PTRS
        const bf16* Qb = (const bf16*)(ws + WS_Q); const bf16* Kb = (const bf16*)(ws + WS_K); const bf16* Vb = (const bf16*)(ws + WS_V);
        const float* na_rpb = KA(10);
        const int subph = ({ const __attribute__((address_space(4))) Args* _p = (const __attribute__((address_space(4))) Args*)__builtin_amdgcn_kernarg_segment_ptr(); asm volatile("" : "+s"(_p)); _p->pad; });
#ifndef NO_SCAN
        if (bx < 128) {
            const int dir = bx & 1;
#ifdef DBG_NAIVE
            if (DBG_NAIVE & (1 << dir)) scan_naive(lds, bx >> 3, (bx >> 1) & 3, dir, (const unsigned short*)(ws + (dir ? WS_LB : WS_LF)), (const bf16*)(ws + WS_HQ), (const bf16*)(ws + WS_HI), (bf16*)(ws + (dir ? WS_OB : WS_OF)), tid);
            else
#endif
            if (subph != 2) scan_unit(lds, bx >> 3, (bx >> 1) & 3, dir, (const unsigned short*)(ws + (dir ? WS_LB : WS_LF)), (const bf16*)(ws + WS_HQ), (const bf16*)(ws + WS_HI), (bf16*)(ws + (dir ? WS_OB : WS_OF)), tid);
        } else
#endif
        {
            LAS float* rpbL = (LAS float*)lds;
            for (int idx = tid; idx < 8 * 15 * 64; idx += NTHR) { const int co = (idx & 63) - 16, hr = idx >> 6; rpbL[idx] = (co >= 0 && co < 31) ? na_rpb[hr * 31 + co] * 1.44269504f : 0.f; }
            __syncthreads();
            const __amdgpu_buffer_rsrc_t srdK = __builtin_amdgcn_make_buffer_rsrc((void*)Kb, (short)0, MROWS * SEGW * 2, 0x00020000), srdV = __builtin_amdgcn_make_buffer_rsrc((void*)Vb, (short)0, MROWS * SEGW * 2, 0x00020000);
            const int hx = bx & 7, idx = ((bx - 128) >> 3) * NWAVES + wave;
#pragma unroll 1
            for (int it = (subph == 1 ? 4 : 0); it < 4; ++it)
                na_row(it * 4 + (idx >> 5), hx, idx & 31, Qb, (const bf16*)(ws + WS_QR), srdK, srdV, MIX, rpbL, lds + 32768 + wave * 8192, lane);
        }
    }
    SEAM(3);

    if (IN(4)) {
        PHASE_PTRS
        const float* hg_norm = KA(12);
        const bf16* OF = (const bf16*)(ws + WS_OF); const bf16* OB = (const bf16*)(ws + WS_OB); const bf16* Gb = (const bf16*)(ws + WS_G);
        for (int tok = gw; tok < T; tok += NGW) {
            const size_t off = (size_t)tok * SEGW + lane * 8;
            const v4u a = *(const v4u*)(OF + off), bb = *(const v4u*)(OB + off), g = *(const v4u*)(Gb + off);
            float o[8]; float ss = 0.f;
#pragma unroll
            for (int e = 0; e < 4; ++e) { o[2 * e] = bflo(a[e]) + bflo(bb[e]); o[2 * e + 1] = bfhi(a[e]) + bfhi(bb[e]);
#ifdef DBG_SANITIZE
                if (!(fabsf(o[2 * e]) < 1e30f)) o[2 * e] = 0.f; if (!(fabsf(o[2 * e + 1]) < 1e30f)) o[2 * e + 1] = 0.f;
#endif
                ss += o[2 * e] * o[2 * e] + o[2 * e + 1] * o[2 * e + 1]; }
            ss += __shfl_xor(ss, 1); ss += __shfl_xor(ss, 2); ss += __shfl_xor(ss, 4); ss += __shfl_xor(ss, 8);
            const float rstd = 1.f / sqrtf(ss * (1.f / HGD) + EPS);
            const int dv0 = (lane & 15) * 8;
            const f32x4 g0 = *(const f32x4*)(hg_norm + dv0), g1 = *(const f32x4*)(hg_norm + dv0 + 4);
            const float gg[8] = {g0[0], g0[1], g0[2], g0[3], g1[0], g1[1], g1[2], g1[3]};
            float y[8];
#pragma unroll
            for (int e = 0; e < 4; ++e) { y[2 * e] = o[2 * e] * rstd * gg[2 * e] * bflo(g[e]); y[2 * e + 1] = o[2 * e + 1] * rstd * gg[2 * e + 1] * bfhi(g[e]); }
            *(v4u*)(MIX + (size_t)tok * D + 512 + lane * 8) = (v4u){pk2(y[0], y[1]), pk2(y[2], y[3]), pk2(y[4], y[5]), pk2(y[6], y[7])};
        }
    }
    SEAM(4);

    if (IN(5)) {
        PHASE_PTRS
        pg8::DenseOrder S; S.init(T, D, G, bx, true);
        EpiP E{(bf16*)X1};
        pg8::gemm_phase<EpiP, pg8::DenseOrder>(lds + RING_OFF, MIX, WoutT, D, S, E);
    }
    SEAM(5);

    if (IN(6)) {
        PHASE_PTRS
        const float* norm_ffn = KA(7); const float* w_grp = KA(13); const float* b_grp = KA(14); const float* w_exp = KA(15); const float* b_exp = KA(16);
        LAS f32x4* wl = (LAS f32x4*)lds;
        for (int idx = tid; idx < 5 * 1024; idx += NTHR) { const int quad = idx >> 10, col = idx & 1023; const int l = (col & 255) >> 2, q = col & 3, j = col >> 8;
            const f32x4 w = quad == 0 ? *(const f32x4*)(w_grp + col * 4) : *(const f32x4*)(w_exp + col * 16 + (quad - 1) * 4);
            wl[((quad * 4 + q) * 4 + j) * 64 + l] = w; }
        LAS int* lcnt = (LAS int*)(lds + 81920);
        LAS int* tmpe = (LAS int*)(lds + 81920 + 256);
        if (tid < 32) lcnt[tid] = 0;
        __syncthreads();
        const int rowbase = bx * 128 + wave * 16;
        const int mb = rowbase >> 11;
        f32x4 gsc[4], shv[4], gaa[4];
        const float* xin = KA(0); const bf16* Pb = (const bf16*)X1;
#pragma unroll
        for (int j = 0; j < 4; ++j) { const int col = 4 * lane + 256 * j; const f32x4 g = *(const f32x4*)(norm_ffn + col), sc = *(const f32x4*)(MOD + mb * 6144 + 4096 + col);
            gsc[j] = g * (1.f + sc); shv[j] = *(const f32x4*)(MOD + mb * 6144 + 3072 + col); gaa[j] = *(const f32x4*)(MOD + mb * 6144 + 2048 + col); }
        f32x4 vn[2][4]; v2u pn[2][4];
#pragma unroll
        for (int rr = 0; rr < 2; ++rr)
#pragma unroll
            for (int j = 0; j < 4; ++j) { const size_t o_ = (size_t)(rowbase + rr) * D + 4 * lane + 256 * j; vn[rr][j] = *(const f32x4*)(xin + o_); pn[rr][j] = *(const v2u*)(Pb + o_); }
#pragma unroll 1
        for (int ip = 0; ip < 8; ++ip) {
            asm volatile("" ::: "memory");
            f32x4 v[2][4];
#pragma unroll
            for (int rr = 0; rr < 2; ++rr)
#pragma unroll
                for (int j = 0; j < 4; ++j) v[rr][j] = vn[rr][j] + gaa[j] * (f32x4){bflo(pn[rr][j].x), bfhi(pn[rr][j].x), bflo(pn[rr][j].y), bfhi(pn[rr][j].y)};
            if (ip < 7) {
#pragma unroll
                for (int rr = 0; rr < 2; ++rr)
#pragma unroll
                    for (int j = 0; j < 4; ++j) { const size_t o_ = (size_t)(rowbase + 2 * ip + 2 + rr) * D + 4 * lane + 256 * j; vn[rr][j] = *(const f32x4*)(xin + o_); pn[rr][j] = *(const v2u*)(Pb + o_); } }
            float ss[2];
#pragma unroll
            for (int rr = 0; rr < 2; ++rr) { float s = 0.f;
#pragma unroll
                for (int j = 0; j < 4; ++j) s += (v[rr][j][0] * v[rr][j][0] + v[rr][j][1] * v[rr][j][1]) + (v[rr][j][2] * v[rr][j][2] + v[rr][j][3] * v[rr][j][3]);
                ss[rr] = s; }
#pragma unroll
            for (int o = 1; o < 64; o <<= 1) { ss[0] += __shfl_xor(ss[0], o); ss[1] += __shfl_xor(ss[1], o); }
            const float rstd0 = 1.f / sqrtf(ss[0] * (1.f / D) + EPS), rstd1 = 1.f / sqrtf(ss[1] * (1.f / D) + EPS);
            float lg[2][20];
#pragma unroll
            for (int k = 0; k < 20; ++k) { lg[0][k] = 0.f; lg[1][k] = 0.f; }
#pragma unroll
            for (int j = 0; j < 4; ++j) { const int col = 4 * lane + 256 * j;
                const f32x4 y0 = v[0][j] * rstd0 * gsc[j] + shv[j], y1 = v[1][j] * rstd1 * gsc[j] + shv[j];
                *(v2u*)(XN2 + (size_t)(rowbase + 2 * ip) * D + col) = (v2u){pg8::cvt_pk_bf16(y0[0], y0[1]), pg8::cvt_pk_bf16(y0[2], y0[3])};
                *(v2u*)(XN2 + (size_t)(rowbase + 2 * ip + 1) * D + col) = (v2u){pg8::cvt_pk_bf16(y1[0], y1[1]), pg8::cvt_pk_bf16(y1[2], y1[3])};
#pragma unroll
                for (int q = 0; q < 4; ++q)
#pragma unroll
                    for (int quad = 0; quad < 5; ++quad) { const f32x4 w = wl[((quad * 4 + q) * 4 + j) * 64 + lane];
#pragma unroll
                        for (int c = 0; c < 4; ++c) { lg[0][quad * 4 + c] += y0[q] * w[c]; lg[1][quad * 4 + c] += y1[q] * w[c]; } }
                asm volatile("" ::: "memory"); }
#pragma unroll
            for (int o = 1; o < 64; o <<= 1)
#pragma unroll
                for (int k = 0; k < 20; ++k) { lg[0][k] += __shfl_xor(lg[0][k], o); lg[1][k] += __shfl_xor(lg[1][k], o); }
            if (lane == 0) {
#pragma unroll
                for (int rr = 0; rr < 2; ++rr) {
                    float gl[4];
#pragma unroll
                    for (int k = 0; k < 4; ++k) gl[k] = lg[rr][k] + b_grp[k];
                    int gs = 0; float gm = gl[0];
#pragma unroll
                    for (int k = 1; k < 4; ++k) if (gl[k] > gm) { gm = gl[k]; gs = k; }
                    float den = 0.f;
#pragma unroll
                    for (int k = 0; k < 4; ++k) den += __expf(gl[k] - gm);
                    const float g_w = 1.f / den;
                    float ev[4];
#pragma unroll
                    for (int k = 0; k < 4; ++k) { float a = lg[rr][4 + k] + b_exp[k];
#pragma unroll
                        for (int g2 = 1; g2 < 4; ++g2) a = (gs == g2) ? (lg[rr][4 + g2 * 4 + k] + b_exp[g2 * 4 + k]) : a;
                        ev[k] = a; }
                    int i0 = 0; float v0 = ev[0];
#pragma unroll
                    for (int k = 1; k < 4; ++k) if (ev[k] > v0) { v0 = ev[k]; i0 = k; }
                    int i1 = -1; float v1 = -INFINITY;
#pragma unroll
                    for (int k = 0; k < 4; ++k) if (k != i0 && ev[k] > v1) { v1 = ev[k]; i1 = k; }
                    if (i1 < 0) { i1 = (i0 + 1) & 3; v1 = v0; }
                    const float e1 = __expf(v1 - v0); const float w0 = g_w / (1.f + e1), w1w = g_w * e1 / (1.f + e1);
                    const int ea = gs * 4 + i0, eb = gs * 4 + i1;
                    const int ra = __hip_atomic_fetch_add(&lcnt[ea], 1, __ATOMIC_RELAXED, __HIP_MEMORY_SCOPE_WORKGROUP), rb = __hip_atomic_fetch_add(&lcnt[eb], 1, __ATOMIC_RELAXED, __HIP_MEMORY_SCOPE_WORKGROUP);
                    const int lr = (wave * 16 + 2 * ip + rr) * 2;
                    tmpe[lr] = ea; tmpe[256 + lr] = ra; tmpe[512 + lr] = __builtin_bit_cast(int, w0);
                    tmpe[lr + 1] = eb; tmpe[256 + lr + 1] = rb; tmpe[512 + lr + 1] = __builtin_bit_cast(int, w1w);
                }
            }
        }
        __syncthreads();
        if (tid < 16) lcnt[16 + tid] = (int)__hip_atomic_fetch_add(ctl + CW_CNT + tid, (unsigned)lcnt[tid], RLX_AGENT);
        __syncthreads();
        if (tid < 256) { const int e = tmpe[tid], pos = lcnt[16 + e] + tmpe[256 + tid]; const int tok = bx * 128 + (tid >> 1);
            ELIST[e * ECAP + pos] = tok * 2 + (tid & 1); EWT[e * ECAP + pos] = __builtin_bit_cast(float, tmpe[512 + tid]); }
        __syncthreads();
    }
    SEAM(6);

    if (IN(7) || IN(8)) {
        PHASE_PTRS
        LAS int* tp = (LAS int*)(lds + MOE_OFF);
        if (tid == 0) { int acc = 0;
            for (int e = 0; e < 16; ++e) { const int c = (int)__hip_atomic_load(ctl + CW_CNT + e, RLX_AGENT); tp[e] = acc; tp[17 + e] = c; acc += (c + 255) >> 8; }
            tp[16] = acc; }
        __syncthreads();
    }
    if (IN(7)) {
        PHASE_PTRS
        const LAS int* tp = (const LAS int*)(lds + MOE_OFF);
        MoeOrder<true> S{tp, ELIST, G, bx, tp[16] * 4};
        EpiSwiGLU E{Hb};
        pg8::gemm_phase<EpiSwiGLU, MoeOrder<true>>(lds + RING_OFF, XN2, W13T, D, S, E);
    }
    SEAM(7);
    if (IN(8)) {
        PHASE_PTRS
        const LAS int* tp = (const LAS int*)(lds + MOE_OFF);
        MoeOrder<false> S{tp, ELIST, G, bx, tp[16] * 4};
        EpiMoeOut E{Yb, ELIST, EWT};
        pg8::gemm_phase<EpiMoeOut, MoeOrder<false>>(lds + RING_OFF, Hb, W2T, DE, S, E);
    }
    SEAM(8);

    if (IN(9)) {
        PHASE_PTRS
        const float* norm_final = KA(20); const float* xfin = KA(0); float* outp = ({ const __attribute__((address_space(4))) Args* _p = (const __attribute__((address_space(4))) Args*)__builtin_amdgcn_kernarg_segment_ptr(); asm volatile("" : "+s"(_p)); _p->out; });
        for (int row = gw; row < T; row += NGW) {
            const int mb = row >> 11; f32x4 v[4]; float s = 0.f;
#pragma unroll
            for (int j = 0; j < 4; ++j) { const int col = 4 * lane + 256 * j; const v2u pp = *(const v2u*)((const bf16*)X1 + (size_t)row * D + col);
                const f32x4 xv = *(const f32x4*)(xfin + (size_t)row * D + col) + *(const f32x4*)(MOD + mb * 6144 + 2048 + col) * (f32x4){bflo(pp.x), bfhi(pp.x), bflo(pp.y), bfhi(pp.y)}, ga = *(const f32x4*)(MOD + mb * 6144 + 5120 + col);
                const v2u y0 = *(const v2u*)(Yb + (size_t)(2 * row) * D + col), y1 = *(const v2u*)(Yb + (size_t)(2 * row + 1) * D + col);
                const f32x4 ys = (f32x4){bflo(y0.x) + bflo(y1.x), bfhi(y0.x) + bfhi(y1.x), bflo(y0.y) + bflo(y1.y), bfhi(y0.y) + bfhi(y1.y)};
                v[j] = xv + ga * ys; s += (v[j][0] * v[j][0] + v[j][1] * v[j][1]) + (v[j][2] * v[j][2] + v[j][3] * v[j][3]); }
            const float rstd = 1.f / sqrtf(wave_sum(s) * (1.f / D) + EPS);
#pragma unroll
            for (int j = 0; j < 4; ++j) { const int col = 4 * lane + 256 * j; const f32x4 g = *(const f32x4*)(norm_final + col);
                *(f32x4*)(outp + (size_t)row * D + col) = v[j] * rstd * g; }
        }
    }
#undef IN
#undef SEAM
}

#ifndef MK_N_LAUNCHES
#define MK_N_LAUNCHES 1
#endif
constexpr int NPHASE = 10;
extern "C" void kernel_launch(void* const* d_in, const int* in_sizes, int n_in, void* d_out, int out_size, void* d_ws, size_t ws_size, hipStream_t stream) {
    static int grid = 0;
    if (grid == 0) {
        if (n_in != 21 || in_sizes[0] != T * D || out_size != T * D || ws_size < WS_END) { fprintf(stderr, "kernel_launch: unexpected shapes (n_in %d, in0 %d, out %d, ws %zu)\n", n_in, n_in > 0 ? in_sizes[0] : -1, out_size, ws_size); grid = -1; return; }
        int dev = 0, cus = 0, per_cu = 0;
        if (hipGetDevice(&dev) != hipSuccess || hipDeviceGetAttribute(&cus, hipDeviceAttributeMultiprocessorCount, dev) != hipSuccess) { grid = -1; return; }
        if (hipFuncSetAttribute((const void*)fwd_mega, hipFuncAttributeMaxDynamicSharedMemorySize, LDS_BYTES) != hipSuccess) { fprintf(stderr, "kernel_launch: hipFuncSetAttribute failed\n"); grid = -1; return; }
        if (hipOccupancyMaxActiveBlocksPerMultiprocessor(&per_cu, (const void*)fwd_mega, NTHR, LDS_BYTES) != hipSuccess || per_cu < 1) fprintf(stderr, "kernel_launch: occupancy query reports %d\n", per_cu);
        (void)hipGetLastError();
        grid = cus;
        if (grid != 256) fprintf(stderr, "kernel_launch: %d CUs (built for 256)\n", grid);
    }
    if (grid < 0) return;
    (void)hipMemsetAsync((char*)d_ws + WS_CTL, 0, CTL_ZERO_BYTES, stream);
    Args a{};
    for (int i = 0; i < 21; ++i) a.in[i] = (const float*)d_in[i];
    a.out = (float*)d_out; a.ws = (unsigned char*)d_ws;
    if (MK_N_LAUNCHES == 1) {
        a.ph_lo = 0; a.ph_hi = NPHASE; a.li = 0;
        hipLaunchKernelGGL(fwd_mega, dim3(grid), dim3(NTHR), LDS_BYTES, stream, a);
    } else {
        for (int li = 0; li < NPHASE; ++li) { a.ph_lo = li; a.ph_hi = li + 1; a.li = 0; hipLaunchKernelGGL(fwd_mega, dim3(grid), dim3(NTHR), LDS_BYTES, stream, a);
#ifdef PROBE_DUP
            if (li == PROBE_DUP) {
#ifdef PROBE_SUB
                a.pad = PROBE_SUB;
#endif
                hipLaunchKernelGGL(fwd_mega, dim3(grid), dim3(NTHR), LDS_BYTES, stream, a); a.pad = 0; }
#endif
        }
    }
}
```

```cpp
#include <hip/hip_runtime.h>
#include <cstdio>
#include <cstdint>

#define GAS __attribute__((address_space(1)))
#define LAS __attribute__((address_space(3)))
typedef unsigned short bf16;
typedef unsigned short bf16_t;
typedef unsigned v4u __attribute__((ext_vector_type(4)));
typedef unsigned v2u __attribute__((ext_vector_type(2)));
typedef float f32x4 __attribute__((ext_vector_type(4)));
typedef float f32x2 __attribute__((ext_vector_type(2)));
typedef short bf16x8 __attribute__((ext_vector_type(8)));
typedef unsigned u32x4 __attribute__((ext_vector_type(4)));
typedef GAS unsigned gu32;
#define RLX_AGENT __ATOMIC_RELAXED, __HIP_MEMORY_SCOPE_AGENT
#define LDS_WAIT() asm volatile("s_waitcnt lgkmcnt(0)" ::: "memory")
#define VM_WAIT() asm volatile("s_waitcnt vmcnt(0)" ::: "memory")

constexpr int NB = 16, SEQ = 2048, D = 1024, T = NB * SEQ, LC = 256, TC = NB * LC, MROWS = T + TC;
constexpr int GW = 64, NROWS = SEQ / GW;
constexpr int INCOLS = 4096, SEGW = 512;
constexpr int NAH = 8, NAD = 64, HGH = 4, HGD = 128;
constexpr int KTOK = SEQ + LC;
constexpr int NE = 16, DE = 512, ECAP = T;
constexpr float EPS = 1e-6f;
constexpr int NWAVES = 8, NTHR = 512;

constexpr size_t MiB = 1u << 20;
constexpr size_t WS_CTL = 0, CTL_ZERO_BYTES = 32768;
constexpr size_t WS_MOD = 1 * MiB;
constexpr size_t WS_ROPE = WS_MOD + 512 * 1024, WS_LBT = WS_MOD + 520 * 1024;
constexpr size_t WS_ELIST = 2 * MiB, WS_EWT = 4 * MiB;
constexpr size_t WS_WINT = 8 * MiB, WS_WOUTT = 16 * MiB, WS_W13T = 18 * MiB, WS_W2T = 50 * MiB;
constexpr size_t WS_XN = 66 * MiB;
constexpr size_t WS_Q = 138 * MiB, WS_K = 170 * MiB, WS_V = 206 * MiB, WS_HQ = 242 * MiB, WS_HI = 274 * MiB, WS_LF = 310 * MiB, WS_LB = 346 * MiB, WS_G = 382 * MiB;
constexpr size_t WS_OF = 414 * MiB, WS_OB = 446 * MiB, WS_QR = 478 * MiB, WS_END = 510 * MiB;
constexpr size_t WS_MIX = WS_XN, WS_XN2 = WS_XN, WS_X1 = 138 * MiB, WS_H = 274 * MiB, WS_Y = 346 * MiB;
constexpr int CW_CNT = 64;
constexpr int CW_BAR = 4096;
static_assert((CW_BAR + 3456) * 4 <= (int)CTL_ZERO_BYTES, "barrier words inside the per-call memset");

constexpr int RING_OFF = 0, RING_BYTES = 131072;
constexpr int LDSCTL_OFF = RING_BYTES, MISC_OFF = LDSCTL_OFF + 320, MOE_OFF = LDSCTL_OFF + 1024;
constexpr int TAB_OFF = LDSCTL_OFF + 2048;
constexpr int LDS_BYTES = 147456;

__device__ __forceinline__ unsigned f2bf(float f) { unsigned u = __builtin_bit_cast(unsigned, f); return (u + 0x7fffu + ((u >> 16) & 1u)) >> 16; }
__device__ __forceinline__ unsigned pk2(float lo, float hi) { return f2bf(lo) | (f2bf(hi) << 16); }
__device__ __forceinline__ float bf2f(unsigned short b) { return __builtin_bit_cast(float, (unsigned)b << 16); }
__device__ __forceinline__ float bflo(unsigned u) { return __builtin_bit_cast(float, u << 16); }
__device__ __forceinline__ float bfhi(unsigned u) { return __builtin_bit_cast(float, u & 0xffff0000u); }
__device__ __forceinline__ unsigned pkh2(float lo, float hi) { _Float16 a = (_Float16)lo, b = (_Float16)hi; return (unsigned)__builtin_bit_cast(unsigned short, a) | ((unsigned)__builtin_bit_cast(unsigned short, b) << 16); }
__device__ __forceinline__ float h2f(unsigned short h) { return (float)__builtin_bit_cast(_Float16, h); }
__device__ __forceinline__ float silu_f(float v) { return v * __builtin_amdgcn_rcpf(1.f + __expf(-v)); }
__device__ __forceinline__ float wave_sum(float v) {
#pragma unroll
    for (int o = 1; o < 64; o <<= 1) v += __shfl_xor(v, o);
    return v;
}
__device__ __forceinline__ float wave_max(float v) {
#pragma unroll
    for (int o = 1; o < 64; o <<= 1) v = fmaxf(v, __shfl_xor(v, o));
    return v;
}

namespace pg8 {
constexpr int BM = 256, BK = 64, HALF = 128, HTB = HALF * BK * 2, STAGE_BYTES = 8 * HTB, NXCD = 8, WGM = 8;
__host__ __device__ __forceinline__ int lds_byte(int r, int c) { const int st = (r >> 4) * 2 + (c >> 5), rr = r & 15, cc = c & 31, ob = rr * 64 + cc * 2; return st * 1024 + (ob ^ (((ob >> 9) & 1) << 5)); }
__host__ __device__ __forceinline__ void stage_rc(int b, int& R, int& C) { const int st = b / 1024, sb = b % 1024, swz = sb ^ (((sb >> 9) & 1) << 5); R = (st >> 1) * 16 + swz / 64; C = (st & 1) * 32 + (swz % 64) / 2; }
__host__ __device__ __forceinline__ int perm32(int rho) { const int n = rho >> 4, i = rho & 15; return 8 * (i >> 2) + 4 * n + (i & 3); }

struct Unit { int pm, pn, e, tm, cnt; };

typedef float f32x2_t __attribute__((ext_vector_type(2))); typedef __bf16 bf16x2_t __attribute__((ext_vector_type(2)));
__device__ __forceinline__ unsigned cvt_pk_bf16(float lo, float hi) { f32x2_t v = {lo, hi}; bf16x2_t b = __builtin_convertvector(v, bf16x2_t); return __builtin_bit_cast(unsigned, b); }

struct DenseOrder {
    static constexpr bool GATHER = false;
    int nM, nN, nwg, G, c; bool pf;
    __device__ void init(int M, int N, int G_, int c_, bool pf_ = false) { nM = M / BM; nN = N / BM; nwg = nM * nN; G = G_; c = c_; pf = pf_; }
    __device__ bool next(int i, Unit& u) const {
        const long L = (long)i * G + c; if (L >= nwg) return false;
        int wgid = (int)L; { const int q = nwg / NXCD, r = nwg % NXCD, xcd = wgid % NXCD, off = wgid / NXCD; wgid = (xcd < r ? xcd * (q + 1) : r * (q + 1) + (xcd - r) * q) + off; }
        const int nig = WGM * nN, gid = wgid / nig, fm = gid * WGM, gsz = (nM - fm) < WGM ? (nM - fm) : WGM;
        u.pm = fm + ((wgid % nig) % gsz); u.pn = (wgid % nig) / gsz; u.e = 0; u.tm = 0; u.cnt = 0; return true;
    }
    __device__ __forceinline__ int a_row0(const Unit& u) const { return u.pm * BM; }
    __device__ __forceinline__ int a_row(const Unit& u, int r) const { return u.pm * BM + r; }
    __device__ __forceinline__ int b_row0(const Unit& u) const { return u.pn * BM; }
    __device__ __forceinline__ bool perm(const Unit&) const { return pf; }
};

template <class Epi, class Sched>
__device__ __forceinline__ void gemm_phase(LAS unsigned char* lds, const bf16_t* Aptr, const bf16_t* Btptr, const int K, const Sched& S, const Epi& E) {
    const int tid = threadIdx.x, wid = __builtin_amdgcn_readfirstlane(tid >> 6), lane = tid & 63, wr = wid >> 2, wc = wid & 3, fr = lane & 15, fq = lane >> 4;
    const int nt = K / BK;
    int sR[2], sC[2];
    unsigned voffA[2], voffBn[2], voffBp[2], voffB[2], nvB[2];
#pragma unroll
    for (int i = 0; i < 2; ++i) { int R, C; stage_rc(tid * 16 + i * 8192, R, C); const int Rb = (R & ~31) + perm32(R & 31);
        sR[i] = R; sC[i] = C; voffA[i] = (unsigned)(R * K + C) * 2u; voffBn[i] = (unsigned)(R * K + C) * 2u; voffBp[i] = (unsigned)(Rb * K + C) * 2u; }
    const size_t kstep = (size_t)(BK * 2);
    const size_t hstep = (size_t)HALF * K * 2;
    const size_t rowb = (size_t)K * 2;
    const unsigned ldsw = (unsigned)wid * 1024u;
    const int aoff = lds_byte(wr * 64 + fr, fq * 8), boff = lds_byte(wc * 32 + fr, fq * 8);
    const char* Ab = (const char*)Aptr;
#define PG8_SA(b, h) (((b) * 2 + (h)) * HTB)
#define PG8_SB(b, h) ((4 + (b) * 2 + (h)) * HTB)
#define PG8_STAGE(bufoff, gbase, voff) do { _Pragma("unroll") for (int _i = 0; _i < 2; ++_i) \
        __builtin_amdgcn_global_load_lds((const unsigned*)((const char*)(gbase) + (voff)[_i]), (LAS unsigned*)(lds + (bufoff) + ldsw + _i * 8192), 16, 0, 0); } while (0)
#define PG8_LDA(dst, b, h) do { _Pragma("unroll") for (int m = 0; m < 4; ++m) _Pragma("unroll") for (int k = 0; k < 2; ++k) dst[m][k] = *(const LAS bf16x8*)(lds + PG8_SA(b, h) + aoff + m * 2048 + k * 1024); } while (0)
#define PG8_LDB(dst, b, h) do { _Pragma("unroll") for (int n = 0; n < 2; ++n) _Pragma("unroll") for (int k = 0; k < 2; ++k) dst[n][k] = *(const LAS bf16x8*)(lds + PG8_SB(b, h) + boff + n * 2048 + k * 1024); } while (0)
#define PG8_MMA(ai, bj, At, Bt) do { __builtin_amdgcn_s_setprio(1); _Pragma("unroll") for (int m = 0; m < 4; ++m) _Pragma("unroll") for (int n = 0; n < 2; ++n) _Pragma("unroll") for (int k = 0; k < 2; ++k) \
        acc[ai][bj][m][n] = __builtin_amdgcn_mfma_f32_16x16x32_bf16(Bt[n][k], At[m][k], acc[ai][bj][m][n], 0, 0, 0); __builtin_amdgcn_s_setprio(0); } while (0)
#define PG8_WAIT_V(n) asm volatile("s_waitcnt vmcnt(" #n ")" ::: "memory")
#define PG8_WAIT_L(n) asm volatile("s_waitcnt lgkmcnt(" #n ")" ::: "memory")
#define PG8_BAR __builtin_amdgcn_s_barrier()
#define PG8_SCHED __builtin_amdgcn_sched_barrier(0)
    Unit cur, nxt; int ui = 0;
    if (!S.next(0, cur)) return;
    f32x4 acc[2][2][4][2];
#pragma unroll
    for (int a = 0; a < 2; ++a)
#pragma unroll
        for (int b = 0; b < 2; ++b)
#pragma unroll
            for (int m = 0; m < 4; ++m)
#pragma unroll
                for (int n = 0; n < 2; ++n) acc[a][b][m][n] = (f32x4){0.f, 0.f, 0.f, 0.f};
    bf16x8 At[4][2], B0[2][2], B1[2][2];
    const char* cA = Ab; unsigned cG[2][2];
    if constexpr (Sched::GATHER) {
#pragma unroll
        for (int h = 0; h < 2; ++h)
#pragma unroll
            for (int i = 0; i < 2; ++i) cG[h][i] = (unsigned)((size_t)S.a_row(cur, h * HALF + sR[i]) * rowb) + (unsigned)sC[i] * 2u;
    } else { cA = Ab + (ptrdiff_t)S.a_row0(cur) * (ptrdiff_t)rowb; cG[0][0] = cG[0][1] = cG[1][0] = cG[1][1] = 0u; }
    const char* cB = (const char*)Btptr + (ptrdiff_t)S.b_row0(cur) * (ptrdiff_t)rowb;
    { const bool pc = S.perm(cur); voffB[0] = pc ? voffBp[0] : voffBn[0]; voffB[1] = pc ? voffBp[1] : voffBn[1]; }
#define PG8_STAGEA(bufoff, h, dbase, goffs, kb) do { if constexpr (Sched::GATHER) { PG8_STAGE(bufoff, Ab + (kb), (goffs)[h]); } else { PG8_STAGE(bufoff, (dbase) + (h) * hstep + (kb), voffA); } } while (0)
    PG8_STAGE(PG8_SB(0, 0), cB, voffB); PG8_STAGE(PG8_SB(0, 1), cB + hstep, voffB); PG8_STAGEA(PG8_SA(0, 0), 0, cA, cG, 0); PG8_STAGEA(PG8_SA(0, 1), 1, cA, cG, 0);
    if (wr == 1) PG8_BAR;
    PG8_WAIT_V(2); PG8_BAR;
    PG8_STAGE(PG8_SB(1, 0), cB + kstep, voffB); PG8_STAGEA(PG8_SA(1, 0), 0, cA, cG, kstep); PG8_STAGE(PG8_SB(1, 1), cB + hstep + kstep, voffB);
    PG8_WAIT_V(6); PG8_BAR;
    for (;;) {
        const bool has_next = S.next(ui + 1, nxt);
        const char* nA = cA; const char* nB = cB; unsigned nG[2][2];
#pragma unroll
        for (int h = 0; h < 2; ++h)
#pragma unroll
            for (int i = 0; i < 2; ++i) nG[h][i] = cG[h][i];
        nvB[0] = voffB[0]; nvB[1] = voffB[1];
        if (has_next) {
            nB = (const char*)Btptr + (ptrdiff_t)S.b_row0(nxt) * (ptrdiff_t)rowb;
            { const bool pn_ = S.perm(nxt); nvB[0] = pn_ ? voffBp[0] : voffBn[0]; nvB[1] = pn_ ? voffBp[1] : voffBn[1]; }
            if constexpr (Sched::GATHER) {
#pragma unroll
                for (int h = 0; h < 2; ++h)
#pragma unroll
                    for (int i = 0; i < 2; ++i) nG[h][i] = (unsigned)((size_t)S.a_row(nxt, h * HALF + sR[i]) * rowb) + (unsigned)sC[i] * 2u;
            } else nA = Ab + (ptrdiff_t)S.a_row0(nxt) * (ptrdiff_t)rowb;
        }
        for (int t = 0; t < nt; t += 2) {
            const bool last = (t == nt - 2);
            const size_t kb1 = (size_t)(t + 1) * kstep;
            const size_t kb2 = last ? 0 : (size_t)(t + 2) * kstep, kb3 = kb2 + kstep;
            const char* a2 = last ? nA : cA; const char* b2 = last ? nB : cB + (size_t)(t + 2) * kstep; const char* b3 = b2 + kstep;
            unsigned vB2[2]; vB2[0] = last ? nvB[0] : voffB[0]; vB2[1] = last ? nvB[1] : voffB[1];
            unsigned g2[2][2];
#pragma unroll
            for (int h = 0; h < 2; ++h)
#pragma unroll
                for (int i = 0; i < 2; ++i) g2[h][i] = last ? nG[h][i] : cG[h][i];
            PG8_LDB(B0, 0, 0); PG8_LDB(B1, 0, 1); PG8_SCHED; PG8_LDA(At, 0, 0); PG8_STAGEA(PG8_SA(1, 1), 1, cA, cG, kb1);
            PG8_WAIT_V(8); PG8_WAIT_L(0); PG8_BAR; PG8_MMA(0, 0, At, B0); PG8_MMA(0, 1, At, B1); PG8_BAR; PG8_SCHED;
            PG8_LDA(At, 0, 1); PG8_STAGE(PG8_SB(0, 0), b2, vB2); PG8_STAGE(PG8_SB(0, 1), b2 + hstep, vB2); PG8_STAGEA(PG8_SA(0, 0), 0, a2, g2, kb2);
            PG8_WAIT_V(8); PG8_WAIT_L(0); PG8_BAR; PG8_MMA(1, 0, At, B0); PG8_MMA(1, 1, At, B1); PG8_BAR; PG8_SCHED;
            PG8_LDB(B0, 1, 0); PG8_LDB(B1, 1, 1); PG8_SCHED; PG8_LDA(At, 1, 0); PG8_STAGEA(PG8_SA(0, 1), 1, a2, g2, kb2);
            PG8_WAIT_V(8); PG8_WAIT_L(0); PG8_BAR; PG8_MMA(0, 0, At, B0); PG8_MMA(0, 1, At, B1); PG8_BAR; PG8_SCHED;
            PG8_LDA(At, 1, 1); PG8_STAGE(PG8_SB(1, 0), b3, vB2); PG8_STAGE(PG8_SB(1, 1), b3 + hstep, vB2); PG8_STAGEA(PG8_SA(1, 0), 0, a2, g2, kb3);
            PG8_WAIT_V(8); PG8_WAIT_L(0); PG8_BAR; PG8_MMA(1, 0, At, B0); PG8_MMA(1, 1, At, B1); PG8_BAR; PG8_SCHED;
        }
        if (wr == 0) PG8_BAR;
        E(acc, cur, wr, wc, fr, fq);
        if (!has_next) break;
#pragma unroll
        for (int a = 0; a < 2; ++a)
#pragma unroll
            for (int b = 0; b < 2; ++b)
#pragma unroll
                for (int m = 0; m < 4; ++m)
#pragma unroll
                    for (int n = 0; n < 2; ++n) acc[a][b][m][n] = (f32x4){0.f, 0.f, 0.f, 0.f};
        cur = nxt; cA = nA; cB = nB; ++ui; voffB[0] = nvB[0]; voffB[1] = nvB[1];
#pragma unroll
        for (int h = 0; h < 2; ++h)
#pragma unroll
            for (int i = 0; i < 2; ++i) cG[h][i] = nG[h][i];
        if (wr == 1) PG8_BAR;
    }
    PG8_WAIT_V(0);
    PG8_BAR;
#undef PG8_SA
#undef PG8_SB
#undef PG8_STAGE
#undef PG8_STAGEA
#undef PG8_LDA
#undef PG8_LDB
#undef PG8_MMA
#undef PG8_WAIT_V
#undef PG8_WAIT_L
#undef PG8_BAR
#undef PG8_SCHED
}
}

#define XB_TMO      128
#define XB_XCNT(j)  (256  + 64 * (j))
#define XB_XSUB(j)  (1280 + 64 * (j))
#define XB_XGEN(j)  (2304 + 64 * (j))
#define XB_TOP      3328
#define XB_TOPGEN   3392
#define XCD_BAR_WORDS 3456
#define XB_SPIN_CAP (1u << 18)
__device__ __forceinline__ unsigned xb_ld(unsigned* p)              { return __hip_atomic_load(p, __ATOMIC_RELAXED, __HIP_MEMORY_SCOPE_AGENT); }
__device__ __forceinline__ unsigned xb_add(unsigned* p, unsigned v) { return __hip_atomic_fetch_add(p, v, __ATOMIC_RELAXED, __HIP_MEMORY_SCOPE_AGENT); }
__device__ __forceinline__ unsigned xb_xcc_id() { return (unsigned)__builtin_amdgcn_s_getreg((3 << 11) | 20) & 0xFu; }
#define XB_SPIN(cond, bar) do { unsigned _sp = 0; while (cond) { __builtin_amdgcn_s_sleep(1); \
    if ((++_sp & 255u) == 0u) { if (xb_ld(&(bar)[XB_TMO])) break; if (_sp > XB_SPIN_CAP) { atomicAdd(&(bar)[XB_TMO], 1u); break; } } } } while (0)
struct XcdBarrier { unsigned* bar; unsigned x; volatile LAS unsigned* st; };
__device__ __forceinline__ XcdBarrier xcd_barrier_post(unsigned* bar, volatile LAS unsigned* st) {
    XcdBarrier b; b.bar = bar; b.x = xb_xcc_id(); b.st = st;
    if (threadIdx.x == 0) (void)xb_add(&bar[XB_XCNT(b.x)], 1u);
    return b;
}
__device__ __forceinline__ void xcd_barrier_complete(unsigned* bar, unsigned x, unsigned& nloc, unsigned& nx) {
    const unsigned G = gridDim.x * gridDim.y * gridDim.z;
    unsigned sum, cnt, mine, sp = 0u;
    for (;;) {
        sum = 0u; cnt = 0u; mine = 0u;
#pragma unroll
        for (unsigned j = 0; j < 16; ++j) { const unsigned c = xb_ld(&bar[XB_XCNT(j)]); sum += c; cnt += (c > 0u) ? 1u : 0u; mine = (j == x) ? c : mine; }
        if (sum == G) break;
        __builtin_amdgcn_s_sleep(1);
        if ((++sp & 255u) == 0u) { if (xb_ld(&bar[XB_TMO])) break; if (sp > XB_SPIN_CAP) { atomicAdd(&bar[XB_TMO], 1u); break; } }
    }
    nloc = mine > 0u ? mine : 1u; nx = cnt > 0u ? cnt : 1u;
}
__device__ __forceinline__ void xcd_barrier(const XcdBarrier& b) {
    asm volatile("s_waitcnt vmcnt(0)" ::: "memory");
    __syncthreads();
    if (threadIdx.x == 0) {
        unsigned* bar = b.bar;
        __builtin_amdgcn_s_waitcnt(0);
        unsigned nloc = b.st[0], nx = b.st[1];
        if (nloc == 0u) { xcd_barrier_complete(bar, b.x, nloc, nx); b.st[0] = nloc; b.st[1] = nx; }
        const unsigned old = xb_add(&bar[XB_XSUB(b.x)], 1u);
        const unsigned gen = old / nloc;
        if (old + 1u == (gen + 1u) * nloc) {
            __builtin_amdgcn_fence(__ATOMIC_RELEASE, "agent");
            asm volatile("s_waitcnt vmcnt(0)" ::: "memory");
            const unsigned og = xb_add(&bar[XB_TOP], 1u);
            const unsigned tg = og / nx;
            if (og + 1u == (tg + 1u) * nx) xb_add(&bar[XB_TOPGEN], 1u);
            else XB_SPIN(xb_ld(&bar[XB_TOPGEN]) == tg, bar);
            __builtin_amdgcn_fence(__ATOMIC_ACQUIRE, "agent");
            xb_add(&bar[XB_XGEN(b.x)], 1u);
            asm volatile("s_waitcnt vmcnt(0)" ::: "memory");
        } else {
            XB_SPIN(xb_ld(&bar[XB_XGEN(b.x)]) == gen, bar);
            __builtin_amdgcn_fence(__ATOMIC_ACQUIRE, "agent");
            asm volatile("s_waitcnt vmcnt(0)" ::: "memory");
        }
    }
    __syncthreads();
}

using pg8::Unit;
typedef f32x4 acc_t[2][2][4][2];

struct EpiProj {
    static constexpr bool PERM = false;
    unsigned char* ws; const LAS float* ropeL; const LAS float* lbtL; int skip;
    template <int KIND> __device__ __forceinline__ void swapped(const acc_t& acc, const Unit& u, int wr, int wc, int fr, int fq, bool latent) const {
        constexpr size_t so2 = KIND == 0 ? WS_V : KIND == 1 ? WS_HQ : KIND == 2 ? WS_HI : KIND == 3 ? WS_LF : WS_LB;
        bf16* dT = (bf16*)(ws + so2);
        constexpr int ldt = (KIND == 1) ? T : MROWS;
        const int wrow0 = (u.pn & 1) * 256 + wr * 64 + fr, tcol0 = u.pm * 256 + wc * 32 + 8 * fq;
        const LAS float* lbt = lbtL + (KIND == 4 ? 512 : 0);
#pragma unroll
        for (int ai = 0; ai < 2; ++ai)
#pragma unroll
            for (int m = 0; m < 4; ++m) { const int wrow = wrow0 + ai * 128 + m * 16; float lb = 0.f; if (KIND >= 3) lb = lbt[wrow];
#pragma unroll
                for (int bj = 0; bj < 2; ++bj) { float x[8]; u32x4 w;
#pragma unroll
                    for (int j = 0; j < 4; ++j) { x[j] = acc[ai][bj][m][0][j]; x[4 + j] = acc[ai][bj][m][1][j]; }
                    if (KIND >= 3) {
#pragma unroll
                        for (int j = 0; j < 8; ++j) { const float sg = __builtin_amdgcn_rcpf(1.f + __expf(-x[j])); x[j] = __log2f(lb + (1.f - lb) * sg); }
                        w = (u32x4){pkh2(x[0], x[1]), pkh2(x[2], x[3]), pkh2(x[4], x[5]), pkh2(x[6], x[7])}; }
                    else { if (KIND == 1) {
#pragma unroll
                            for (int j = 0; j < 8; ++j) x[j] = silu_f(x[j]); }
                        w = (u32x4){pg8::cvt_pk_bf16(x[0], x[1]), pg8::cvt_pk_bf16(x[2], x[3]), pg8::cvt_pk_bf16(x[4], x[5]), pg8::cvt_pk_bf16(x[6], x[7])}; }
                    size_t off = (size_t)wrow * ldt + tcol0 + bj * 128;
                    if (KIND == 0) { const int tc = tcol0 + bj * 128, bb_ = latent ? (tc >> 11) : ((tc - T) >> 8), tl = latent ? (tc & (SEQ - 1)) : (KTOK - LC + ((tc - T) & (LC - 1)));
                        off = ((((size_t)(bb_ * NAH + (wrow >> 6)) * (KTOK / 64) + (tl >> 6)) * NAD + (wrow & 63)) * 64) + (tl & 63); }
                    *(u32x4*)(dT + off) = w; } }
    }
    template <int SEG, bool LAT> __device__ __forceinline__ void rope(const acc_t& acc, int row0, int lcp, int wc, int fq) const {
        bf16* dK = (bf16*)(ws + (SEG == 0 ? WS_QR : WS_K)); bf16* dQ = (bf16*)(ws + WS_Q);
#pragma unroll
        for (int ai = 0; ai < 2; ++ai)
#pragma unroll
            for (int m = 0; m < 4; ++m) { const int row = row0 + ai * 128 + m * 16, sq = row & (SEQ - 1); const int pos = (wc & 1) ? (sq & 63) : (sq >> 6);
                f32x4 cs0 = (f32x4){1.f, 0.f, 1.f, 0.f}, cs1 = cs0;
                if (LAT) { cs0 = *(const LAS f32x4*)(ropeL + (pos * 16 + 4 * fq) * 2); cs1 = *(const LAS f32x4*)(ropeL + (pos * 16 + 4 * fq) * 2 + 4); }
                const float cc[4] = {cs0[0], cs0[2], cs1[0], cs1[2]}, sn[4] = {cs0[1], cs0[3], cs1[1], cs1[3]};
#pragma unroll
                for (int bj = 0; bj < 2; ++bj) { const f32x4 x1 = acc[ai][bj][m][0], x2 = acc[ai][bj][m][1]; float o1[4], o2[4];
#pragma unroll
                    for (int j = 0; j < 4; ++j) { o1[j] = LAT ? x1[j] * cc[j] - x2[j] * sn[j] : x1[j]; o2[j] = LAT ? x2[j] * cc[j] + x1[j] * sn[j] : x2[j]; }
                    size_t off = (size_t)row * SEGW + lcp + bj * 128;
                    if (SEG == 0) *(u32x4*)(dQ + off) = (u32x4){pg8::cvt_pk_bf16(x1[0], x1[1]), pg8::cvt_pk_bf16(x1[2], x1[3]), pg8::cvt_pk_bf16(x2[0], x2[1]), pg8::cvt_pk_bf16(x2[2], x2[3])};
                    else { const int cf = lcp + bj * 128, bb_ = LAT ? (row >> 11) : ((row - T) >> 8), tl = LAT ? sq : (KTOK - LC + ((row - T) & (LC - 1)));
                        off = ((size_t)(bb_ * NAH + (cf >> 6)) * KTOK + tl) * NAD + (cf & 63); }
                    *(u32x4*)(dK + off) = (u32x4){pg8::cvt_pk_bf16(o1[0], o1[1]), pg8::cvt_pk_bf16(o1[2], o1[3]), pg8::cvt_pk_bf16(o2[0], o2[1]), pg8::cvt_pk_bf16(o2[2], o2[3])}; } }
    }
    __device__ __forceinline__ void operator()(const acc_t& acc, const Unit& u, int wr, int wc, int fr, int fq) const {
        const int seg = u.pn >> 1; const bool latent = u.pm < (T / 256);
        if (skip) return;
        if (!latent && (seg == 0 || seg == 3 || seg == 7)) return;
        if (u.e) {
            if (seg == 2) swapped<0>(acc, u, wr, wc, fr, fq, latent);
            else if (seg == 3) swapped<1>(acc, u, wr, wc, fr, fq, latent);
            else if (seg == 4) swapped<2>(acc, u, wr, wc, fr, fq, latent);
            else if (seg == 5) swapped<3>(acc, u, wr, wc, fr, fq, latent);
            else swapped<4>(acc, u, wr, wc, fr, fq, latent);
            return;
        }
        const int row0 = u.pm * 256 + wr * 64 + fr;
        const int lcp = (u.pn & 1) * 256 + wc * 32 + 8 * fq;
        if (seg <= 1) {
            if (seg == 0) rope<0, true>(acc, row0, lcp, wc, fq);
            else if (latent) rope<1, true>(acc, row0, lcp, wc, fq);
            else rope<1, false>(acc, row0, lcp, wc, fq);
            return;
        }
        bf16* dG = (bf16*)(ws + WS_G);
#pragma unroll
        for (int ai = 0; ai < 2; ++ai)
#pragma unroll
            for (int m = 0; m < 4; ++m) { const int row = row0 + ai * 128 + m * 16;
#pragma unroll
                for (int bj = 0; bj < 2; ++bj) { float x[8];
#pragma unroll
                    for (int j = 0; j < 4; ++j) { x[j] = silu_f(acc[ai][bj][m][0][j]); x[4 + j] = silu_f(acc[ai][bj][m][1][j]); }
                    *(u32x4*)(dG + (size_t)row * SEGW + lcp + bj * 128) = (u32x4){pg8::cvt_pk_bf16(x[0], x[1]), pg8::cvt_pk_bf16(x[2], x[3]), pg8::cvt_pk_bf16(x[4], x[5]), pg8::cvt_pk_bf16(x[6], x[7])}; } }
    }
};
struct EpiP {
    static constexpr bool PERM = true;
    bf16* P;
    __device__ __forceinline__ void operator()(const acc_t& acc, const Unit& u, int wr, int wc, int fr, int fq) const {
        const int col0 = u.pn * 256 + wc * 32 + 8 * fq; const int row0 = u.pm * 256 + wr * 64 + fr;
#pragma unroll
        for (int ai = 0; ai < 2; ++ai)
#pragma unroll
            for (int m = 0; m < 4; ++m)
#pragma unroll
                for (int bj = 0; bj < 2; ++bj) { const f32x4 v0 = acc[ai][bj][m][0], v1 = acc[ai][bj][m][1];
                    *(u32x4*)(P + (size_t)(row0 + ai * 128 + m * 16) * D + col0 + bj * 128) = (u32x4){pg8::cvt_pk_bf16(v0[0], v0[1]), pg8::cvt_pk_bf16(v0[2], v0[3]), pg8::cvt_pk_bf16(v1[0], v1[1]), pg8::cvt_pk_bf16(v1[2], v1[3])}; }
    }
};
struct EpiSwiGLU {
    static constexpr bool PERM = true;
    bf16* H;
    __device__ __forceinline__ void operator()(const acc_t& acc, const Unit& u, int wr, int wc, int fr, int fq) const {
        const int hc = u.pn * 128 + wc * 32 + 8 * fq; const int row0 = u.pm * 256 + wr * 64 + fr;
#pragma unroll
        for (int ai = 0; ai < 2; ++ai)
#pragma unroll
            for (int m = 0; m < 4; ++m) { float h[8];
#pragma unroll
                for (int n = 0; n < 2; ++n)
#pragma unroll
                    for (int j = 0; j < 4; ++j) h[n * 4 + j] = silu_f(acc[ai][0][m][n][j]) * acc[ai][1][m][n][j];
                u32x4 w; w.x = pg8::cvt_pk_bf16(h[0], h[1]); w.y = pg8::cvt_pk_bf16(h[2], h[3]); w.z = pg8::cvt_pk_bf16(h[4], h[5]); w.w = pg8::cvt_pk_bf16(h[6], h[7]);
                *(u32x4*)(H + (size_t)(row0 + ai * 128 + m * 16) * DE + hc) = w; }
    }
};
struct EpiMoeOut {
    static constexpr bool PERM = true;
    bf16* Y; const int* elist; const float* ewt;
    __device__ __forceinline__ void operator()(const acc_t& acc, const Unit& u, int wr, int wc, int fr, int fq) const {
        const int col0 = u.pn * 256 + wc * 32 + 8 * fq;
#pragma unroll
        for (int ai = 0; ai < 2; ++ai)
#pragma unroll
            for (int m = 0; m < 4; ++m) { const int rank = u.tm * 256 + ai * 128 + wr * 64 + m * 16 + fr;
                if (rank < u.cnt) { const int tk = elist[u.e * ECAP + rank]; const float w = ewt[u.e * ECAP + rank];
#pragma unroll
                    for (int bj = 0; bj < 2; ++bj) { const f32x4 v0 = acc[ai][bj][m][0] * w, v1 = acc[ai][bj][m][1] * w; u32x4 o;
                        o.x = pg8::cvt_pk_bf16(v0[0], v0[1]); o.y = pg8::cvt_pk_bf16(v0[2], v0[3]); o.z = pg8::cvt_pk_bf16(v1[0], v1[1]); o.w = pg8::cvt_pk_bf16(v1[2], v1[3]);
                        *(u32x4*)(Y + (size_t)tk * D + col0 + bj * 128) = o; } } }
    }
};
template <bool GATHER_> struct MoeOrder {
    static constexpr bool GATHER = GATHER_;
    const LAS int* tp; const int* elist; int G, c, nwg;
    __device__ bool next(int i, Unit& u) const {
        const long L = (long)i * G + c; if (L >= nwg) return false;
        int wgid = (int)L; { const int q = nwg / 8, r = nwg % 8, xcd = wgid % 8, off = wgid / 8; wgid = (xcd < r ? xcd * (q + 1) : r * (q + 1) + (xcd - r) * q) + off; }
        const int gt = wgid >> 2; int e = 0;
#pragma unroll
        for (int k = 1; k < 16; ++k) e = (gt >= tp[k]) ? k : e;
        u.pm = gt; u.pn = wgid & 3; u.e = e; u.tm = gt - tp[e]; u.cnt = tp[17 + e]; return true;
    }
    __device__ __forceinline__ int a_row0(const Unit& u) const { return u.pm * 256; }
    __device__ __forceinline__ int a_row(const Unit& u, int r) const {
        if constexpr (GATHER_) { int rank = u.tm * 256 + r; rank = rank < u.cnt ? rank : u.cnt - 1; return elist[u.e * ECAP + rank] >> 1; }
        else return u.pm * 256 + r;
    }
    __device__ __forceinline__ int b_row0(const Unit& u) const { return u.e * 1024 + u.pn * 256; }
    __device__ __forceinline__ bool perm(const Unit&) const { return true; }
};


constexpr int SWMASK = 0x7C;
constexpr int W_REL_XN = (int)(((long long)WS_WINT - (long long)WS_XN) / 2048);
struct ProjOrder {
    static constexpr bool GATHER = false;
    pg8::DenseOrder d;
    __device__ void init(int G_, int c_) { d.init(MROWS, INCOLS, G_, c_); }
    __device__ bool next(int i, Unit& u) const { if (!d.next(i, u)) return false; u.e = (SWMASK >> (u.pn >> 1)) & 1; return true; }
    __device__ __forceinline__ int a_row0(const Unit& u) const { return u.e ? W_REL_XN + u.pn * 256 : u.pm * 256; }
    __device__ __forceinline__ int a_row(const Unit& u, int r) const { return a_row0(u) + r; }
    __device__ __forceinline__ int b_row0(const Unit& u) const { return u.e ? -W_REL_XN + u.pm * 256 : u.pn * 256; }
    __device__ __forceinline__ bool perm(const Unit& u) const { return (u.pn >> 1) >= 2; }
};


__device__ __forceinline__ bf16x8 pack8(const f32x4& a, const f32x4& b) {
    u32x4 w; w.x = pg8::cvt_pk_bf16(a[0], a[1]); w.y = pg8::cvt_pk_bf16(a[2], a[3]); w.z = pg8::cvt_pk_bf16(b[0], b[1]); w.w = pg8::cvt_pk_bf16(b[2], b[3]);
    return __builtin_bit_cast(bf16x8, w);
}
typedef unsigned bu4 __attribute__((__vector_size__(16)));
__device__ __forceinline__ bf16x8 bload16(__amdgpu_buffer_rsrc_t r, unsigned voff, unsigned soff) { return __builtin_bit_cast(bf16x8, __builtin_amdgcn_raw_buffer_load_b128(r, (int)voff, (int)soff, 0)); }
#define NA_SB() __builtin_amdgcn_sched_barrier(0)
__device__ __forceinline__ bf16x8 sel8(bool c, const bf16x8 a, const bf16x8 b) { const u32x4 x = __builtin_bit_cast(u32x4, a), y = __builtin_bit_cast(u32x4, b); u32x4 r;
    r.x = c ? x.x : y.x; r.y = c ? x.y : y.y; r.z = c ? x.z : y.z; r.w = c ? x.w : y.w; return __builtin_bit_cast(bf16x8, r); }
__device__ __forceinline__ void na_row(int b, int h, int r, const bf16* Q, const bf16* QR, __amdgpu_buffer_rsrc_t srdK, __amdgpu_buffer_rsrc_t srdV, bf16* MIX, const LAS float* rpbL, LAS unsigned char* qL, int lane) {
    const int qi = lane & 15, g = lane >> 4, rg = qi >> 2;
    constexpr float SC = 0.125f * 1.44269504f; const float NEG = -1e30f;
    int rs = r - 4; rs = rs < 0 ? 0 : (rs > NROWS - 8 ? NROWS - 8 : rs);
    const int tok0 = b * SEQ + r * GW;
    const unsigned klane = (unsigned)((8 * rg + (qi & 3)) * NAD + 8 * g) * 2u;
    const unsigned vlane = (unsigned)(qi * 64 + 8 * g) * 2u;
    const bool selK1 = (rg == 0), selK2 = (rg != 3), selV1 = (g == 0), selV2 = (g != 3);
#define NA_P0(j) ((j) == 0 ? 0 : (j) == 1 ? 1 : (j) == 2 ? 3 : 4)
#define NA_BB(j) (8 * (NA_P0(j) + ((g - NA_P0(j)) & 3)) - (16 * (j) + qi) + 31)
#define NA_LO(j) (((j) == 0 ? (qi < 8 ? 31 - qi : 23) : (j) == 3 ? (qi > 8 ? 31 - qi : 23) : 23) - NA_BB(j))
    f32x4 o[4][4]; float mref[4], lsum[4];
#pragma unroll
    for (int j = 0; j < 4; ++j) { mref[j] = 0.f; lsum[j] = 0.f;
#pragma unroll
        for (int dt = 0; dt < 4; ++dt) o[j][dt] = (f32x4){0.f, 0.f, 0.f, 0.f}; }
    bf16x8 kf[2][2][2], vf[2][4], Bp[4];
    LAS bf16x8* qs = (LAS bf16x8*)qL + lane;
#pragma unroll
    for (int j = 0; j < 4; ++j) { const bf16* qp = QR + (size_t)(tok0 + 16 * j + qi) * SEGW + h * NAD + 8 * g; qs[(2 * j) * 64] = *(const bf16x8*)qp; qs[(2 * j + 1) * 64] = *(const bf16x8*)(qp + 32); }
    const unsigned bh = (unsigned)(b * NAH + h);
    const unsigned ks0 = (bh * KTOK + (unsigned)(rs * GW)) * (NAD * 2u), vs0 = (bh * (KTOK / 64) + (unsigned)rs) * (NAD * 64 * 2u);
#define NA_KLD(so) do { _Pragma("unroll") for (int H = 0; H < 2; ++H) _Pragma("unroll") for (int m = 0; m < 2; ++m) _Pragma("unroll") for (int k = 0; k < 2; ++k) \
        kf[H][m][k] = bload16(srdK, klane, (so) + (unsigned)(H * 32 * NAD * 2 + m * 4 * NAD * 2 + k * 64)); } while (0)
#define NA_VLD(so) do { _Pragma("unroll") for (int H = 0; H < 2; ++H) _Pragma("unroll") for (int dt = 0; dt < 4; ++dt) \
        vf[H][dt] = bload16(srdV, vlane, (so) + (unsigned)(H * 64) + (unsigned)dt * (16 * 64 * 2)); } while (0)
    NA_KLD(ks0); NA_VLD(vs0);
    const LAS float* bp0 = rpbL + (h * 15 + rs - r + 7) * 64;
#pragma unroll 1
    for (int i = 0; i < 8; ++i) {
        const LAS float* bpi = bp0 + i * 64;
        NA_SB();
#pragma unroll
        for (int j = 0; j < 4; ++j) {
            f32x4 s0, s1; const bf16x8 q0 = qs[(2 * j) * 64], q1 = qs[(2 * j + 1) * 64];
            { const bf16x8 a00 = (j == 0) ? kf[0][0][0] : (j == 3) ? kf[1][0][0] : sel8(j == 1 ? selK1 : selK2, kf[1][0][0], kf[0][0][0]);
              const bf16x8 a01 = (j == 0) ? kf[0][0][1] : (j == 3) ? kf[1][0][1] : sel8(j == 1 ? selK1 : selK2, kf[1][0][1], kf[0][0][1]);
              const bf16x8 a10 = (j == 0) ? kf[0][1][0] : (j == 3) ? kf[1][1][0] : sel8(j == 1 ? selK1 : selK2, kf[1][1][0], kf[0][1][0]);
              const bf16x8 a11 = (j == 0) ? kf[0][1][1] : (j == 3) ? kf[1][1][1] : sel8(j == 1 ? selK1 : selK2, kf[1][1][1], kf[0][1][1]);
              s0 = __builtin_amdgcn_mfma_f32_16x16x32_bf16(a00, q0, (f32x4){0.f, 0.f, 0.f, 0.f}, 0, 0, 0); s0 = __builtin_amdgcn_mfma_f32_16x16x32_bf16(a01, q1, s0, 0, 0, 0);
              s1 = __builtin_amdgcn_mfma_f32_16x16x32_bf16(a10, q0, (f32x4){0.f, 0.f, 0.f, 0.f}, 0, 0, 0); s1 = __builtin_amdgcn_mfma_f32_16x16x32_bf16(a11, q1, s1, 0, 0, 0); }
            const int lo_j = NA_LO(j); const LAS float* bpj = bpi + NA_BB(j);
            { float b0 = bpj[0], b1 = bpj[1], b2 = bpj[2], b3 = bpj[3];
              asm volatile("" : "+v"(b0), "+v"(b1), "+v"(b2), "+v"(b3));
              const float bq[4] = {b0, b1, b2, b3};
#pragma unroll
              for (int e = 0; e < 4; ++e) { const float t0 = s0[e] * SC + bq[e]; s0[e] = ((unsigned)(e - lo_j) < 16u) ? t0 : NEG; } }
            { float b0 = bpj[4], b1 = bpj[5], b2 = bpj[6], b3 = bpj[7];
              asm volatile("" : "+v"(b0), "+v"(b1), "+v"(b2), "+v"(b3));
              const float bq[4] = {b0, b1, b2, b3};
#pragma unroll
              for (int e = 0; e < 4; ++e) { const float t1 = s1[e] * SC + bq[e]; s1[e] = ((unsigned)(4 + e - lo_j) < 16u) ? t1 : NEG; } }
            if (i == 0) { float mx = fmaxf(fmaxf(fmaxf(s0[0], s0[1]), fmaxf(s0[2], s0[3])), fmaxf(fmaxf(s1[0], s1[1]), fmaxf(s1[2], s1[3])));
                mx = fmaxf(mx, __shfl_xor(mx, 16)); mx = fmaxf(mx, __shfl_xor(mx, 32)); mref[j] = mx; }
            float ps = 0.f;
#pragma unroll
            for (int e = 0; e < 4; ++e) { s0[e] = __builtin_amdgcn_exp2f(fminf(s0[e] - mref[j], 100.f)); s1[e] = __builtin_amdgcn_exp2f(fminf(s1[e] - mref[j], 100.f)); ps += s0[e] + s1[e]; }
            lsum[j] += ps; Bp[j] = pack8(s0, s1);
            if (j == 1) { asm volatile("" : "+v"(Bp[0]), "+v"(Bp[1])); NA_SB(); }
        }
        asm volatile("" : "+v"(Bp[0]), "+v"(Bp[1]), "+v"(Bp[2]), "+v"(Bp[3]));
        NA_SB();
        if (i < 7) NA_KLD(ks0 + (unsigned)(i + 1) * (GW * NAD * 2));
        NA_SB();
#pragma unroll
        for (int j = 0; j < 4; ++j) {
#pragma unroll
            for (int dt = 0; dt < 4; ++dt) { const bf16x8 A = (j == 0) ? vf[0][dt] : (j == 3) ? vf[1][dt] : sel8(j == 1 ? selV1 : selV2, vf[1][dt], vf[0][dt]);
                o[j][dt] = __builtin_amdgcn_mfma_f32_16x16x32_bf16(A, Bp[j], o[j][dt], 0, 0, 0); }
            asm volatile("" : "+v"(o[j][0]), "+v"(o[j][1]), "+v"(o[j][2]), "+v"(o[j][3]));
            if (j == 1) NA_SB(); }
        NA_SB();
        if (i < 7) NA_VLD(vs0 + (unsigned)(i + 1) * (NAD * 64 * 2));
    }
#pragma unroll
    for (int j = 0; j < 4; ++j) { const bf16* qp = Q + (size_t)(tok0 + 16 * j + qi) * SEGW + h * NAD + 8 * g; qs[(2 * j) * 64] = *(const bf16x8*)qp; qs[(2 * j + 1) * 64] = *(const bf16x8*)(qp + 32); }
    const unsigned kc0 = (bh * KTOK + (unsigned)SEQ) * (NAD * 2u), vc0 = (bh * (KTOK / 64) + (unsigned)(SEQ / 64)) * (NAD * 64 * 2u);
#define NA_KLDC(so) do { _Pragma("unroll") for (int m = 0; m < 2; ++m) _Pragma("unroll") for (int k = 0; k < 2; ++k) kf[0][m][k] = bload16(srdK, klane, (so) + (unsigned)(m * 4 * NAD * 2 + k * 64)); } while (0)
#define NA_VLDC(so) do { _Pragma("unroll") for (int dt = 0; dt < 4; ++dt) vf[0][dt] = bload16(srdV, vlane, (so) + (unsigned)dt * (16 * 64 * 2)); } while (0)
    NA_KLDC(kc0); NA_VLDC(vc0);
#pragma unroll 1
    for (int i = 0; i < 8; ++i) {
        NA_SB();
#pragma unroll
        for (int j = 0; j < 4; ++j) {
            const bf16x8 q0 = qs[(2 * j) * 64], q1 = qs[(2 * j + 1) * 64];
            f32x4 s0 = __builtin_amdgcn_mfma_f32_16x16x32_bf16(kf[0][0][0], q0, (f32x4){0.f, 0.f, 0.f, 0.f}, 0, 0, 0); s0 = __builtin_amdgcn_mfma_f32_16x16x32_bf16(kf[0][0][1], q1, s0, 0, 0, 0);
            f32x4 s1 = __builtin_amdgcn_mfma_f32_16x16x32_bf16(kf[0][1][0], q0, (f32x4){0.f, 0.f, 0.f, 0.f}, 0, 0, 0); s1 = __builtin_amdgcn_mfma_f32_16x16x32_bf16(kf[0][1][1], q1, s1, 0, 0, 0);
            float ps = 0.f;
#pragma unroll
            for (int e = 0; e < 4; ++e) { s0[e] = __builtin_amdgcn_exp2f(fminf(s0[e] * SC - mref[j], 100.f)); s1[e] = __builtin_amdgcn_exp2f(fminf(s1[e] * SC - mref[j], 100.f)); ps += s0[e] + s1[e]; }
            lsum[j] += ps; Bp[j] = pack8(s0, s1);
        }
        asm volatile("" : "+v"(Bp[0]), "+v"(Bp[1]), "+v"(Bp[2]), "+v"(Bp[3]));
        NA_SB();
        if (i < 7) NA_KLDC(kc0 + (unsigned)(i + 1) * (32 * NAD * 2));
        NA_SB();
#pragma unroll
        for (int j = 0; j < 4; ++j)
#pragma unroll
            for (int dt = 0; dt < 4; ++dt) o[j][dt] = __builtin_amdgcn_mfma_f32_16x16x32_bf16(vf[0][dt], Bp[j], o[j][dt], 0, 0, 0);
#pragma unroll
        for (int j = 0; j < 4; ++j) asm volatile("" : "+v"(o[j][0]), "+v"(o[j][1]), "+v"(o[j][2]), "+v"(o[j][3]));
        NA_SB();
        if (i < 7) NA_VLDC(vc0 + (unsigned)(((i + 1) >> 1) * (NAD * 64 * 2) + ((i + 1) & 1) * 64));
    }
#undef NA_KLD
#undef NA_VLD
#undef NA_KLDC
#undef NA_VLDC
#pragma unroll
    for (int j = 0; j < 4; ++j) { float l = lsum[j]; l += __shfl_xor(l, 16); l += __shfl_xor(l, 32); const float inv = 1.f / l;
        bf16* op = MIX + (size_t)(tok0 + 16 * j + qi) * D + h * NAD + 4 * g;
#pragma unroll
        for (int dt = 0; dt < 4; ++dt) { const f32x4 v = o[j][dt] * inv; *(v2u*)(op + 16 * dt) = (v2u){pg8::cvt_pk_bf16(v[0], v[1]), pg8::cvt_pk_bf16(v[2], v[3])}; } }
}

typedef float f32x16 __attribute__((ext_vector_type(16)));
constexpr int SC_Q1 = 0, SC_K1 = SC_Q1 + 64 * 272, SC_K1T = SC_K1 + 64 * 272, SC_VT = SC_K1T + 128 * 144, SC_ST = SC_VT + 128 * 144, SC_TOT = SC_ST + 128 * 272, SC_CST = SC_TOT + 2 * 4 * 128 * 4, SC_END = SC_CST + 2 * 128 * 4;
static_assert(SC_END <= RING_BYTES, "scan LDS");
#define SCAN_MFMA(a, b, c) __builtin_amdgcn_mfma_f32_32x32x16_bf16(a, b, c, 0, 0, 0)
__device__ __forceinline__ void scan_unit(LAS unsigned char* lds, int b, int h, int dir, const unsigned short* LGT, const bf16* HQT, const bf16* HIT, bf16* OUT, int tid) {
    const int lane = tid & 63, w = __builtin_amdgcn_readfirstlane(tid >> 6), r = lane & 31, hh = lane >> 5;
    const int d = tid & 127, tq = tid >> 7;
    const int ti = w >> 2, ovi = w & 3;
    const int di = w >> 1, svi = 2 * (w & 1);
    f32x16 S0, S1;
#pragma unroll
    for (int i = 0; i < 16; ++i) { S0[i] = 0.f; S1[i] = 0.f; }
    const size_t chrow = (size_t)(h * HGD + d);
    constexpr int NCH = (LC + SEQ) / 64;
    auto col_of = [&](int c) -> int { return c < 4 ? (T + b * LC + 64 * (dir ? 3 - c : c)) : (b * SEQ + (dir ? SEQ - 64 * (c - 3) : 64 * (c - 4))); };
    LAS float* totb = (LAS float*)(lds + SC_TOT); LAS float* cst = (LAS float*)(lds + SC_CST);
    u32x4 lg0[2], lg1[2], vr[2], qr[2];
    { const int c0 = col_of(0) + 16 * tq, c1 = col_of(1) + 16 * tq;
      lg0[0] = *(const u32x4*)(LGT + chrow * MROWS + c0); lg0[1] = *(const u32x4*)(LGT + chrow * MROWS + c0 + 8);
      lg1[0] = *(const u32x4*)(LGT + chrow * MROWS + c1); lg1[1] = *(const u32x4*)(LGT + chrow * MROWS + c1 + 8);
      vr[0] = *(const u32x4*)(HIT + chrow * MROWS + c0); vr[1] = *(const u32x4*)(HIT + chrow * MROWS + c0 + 8); qr[0] = qr[1] = (u32x4){0u, 0u, 0u, 0u};
      float sm = 0.f;
#pragma unroll
      for (int i = 0; i < 8; ++i) { const unsigned u2 = lg0[i >> 2][i & 3]; sm += h2f((unsigned short)(u2 & 0xffff)) + h2f((unsigned short)(u2 >> 16)); }
      totb[tq * 128 + d] = sm; }
    __syncthreads();
#pragma unroll 1
    for (int c = 0; c < NCH; ++c) {
        const bool lat = c >= 4; const int par = c & 1;
        LAS float* tot = totb + par * 512;
        {
            float P[16], kk[16];
#pragma unroll
            for (int i = 0; i < 8; ++i) { const unsigned u2 = lg0[i >> 2][i & 3]; P[2 * i] = h2f((unsigned short)(u2 & 0xffff)); P[2 * i + 1] = h2f((unsigned short)(u2 >> 16)); }
#pragma unroll
            for (int i = 0; i < 16; ++i) kk[i] = 1.f - __builtin_amdgcn_exp2f(P[i]);
            if (!dir) {
#pragma unroll
                for (int i = 1; i < 16; ++i) P[i] += P[i - 1];
            } else {
#pragma unroll
                for (int i = 14; i >= 0; --i) P[i] += P[i + 1];
            }
            const float t0 = tot[d], t1 = tot[128 + d], t2 = tot[256 + d], t3 = tot[384 + d];
            const float Bm = dir ? (t2 + t3) : (t0 + t1);
            float offs; if (!dir) offs = (tq > 0 ? t0 : 0.f) + (tq > 1 ? t1 : 0.f) + (tq > 2 ? t2 : 0.f); else offs = (tq < 3 ? t3 : 0.f) + (tq < 2 ? t2 : 0.f) + (tq < 1 ? t1 : 0.f);
            const float sh = offs - Bm;
            if (tq == 0) { const float be = (t0 + t1) + (t2 + t3); cst[d] = __builtin_amdgcn_exp2f(be); cst[128 + d] = __builtin_amdgcn_exp2f(be - Bm); }
            unsigned kt[8];
            LAS bf16* q1 = (LAS bf16*)(lds + SC_Q1) + (16 * tq) * 136 + d; LAS bf16* k1 = (LAS bf16*)(lds + SC_K1) + (16 * tq) * 136 + d;
#pragma unroll
            for (int i = 0; i < 16; i += 2) {
                const float x0 = fminf(fmaxf(P[i] + sh, -120.f), 120.f), x1 = fminf(fmaxf(P[i + 1] + sh, -120.f), 120.f);
                const float k0 = kk[i] * __builtin_amdgcn_exp2f(-x0), k1v = kk[i + 1] * __builtin_amdgcn_exp2f(-x1);
                kt[i >> 1] = pg8::cvt_pk_bf16(k0, k1v);
                if (lat) { const unsigned qq = (i < 8 ? qr[0] : qr[1])[(i >> 1) & 3];
                    const unsigned qp2 = pg8::cvt_pk_bf16(bflo(qq) * __builtin_amdgcn_exp2f(x0), bfhi(qq) * __builtin_amdgcn_exp2f(x1));
                    q1[i * 136] = (bf16)(qp2 & 0xffff); q1[(i + 1) * 136] = (bf16)(qp2 >> 16);
                    k1[i * 136] = (bf16)(kt[i >> 1] & 0xffff); k1[(i + 1) * 136] = (bf16)(kt[i >> 1] >> 16); }
            }
            LAS unsigned char* k1t = lds + SC_K1T + d * 144 + 32 * tq;
            *(LAS u32x4*)k1t = (u32x4){kt[0], kt[1], kt[2], kt[3]}; *(LAS u32x4*)(k1t + 16) = (u32x4){kt[4], kt[5], kt[6], kt[7]};
            LAS unsigned char* vt = lds + SC_VT + d * 144 + 32 * tq;
            *(LAS u32x4*)vt = vr[0]; *(LAS u32x4*)(vt + 16) = vr[1];
        }
        if (lat) {
#pragma unroll
            for (int rg = 0; rg < 4; ++rg) { const int dd = 32 * di + 8 * rg + 4 * hh;
                const f32x4 a0 = *(const LAS f32x4*)(tot + dd), a1 = *(const LAS f32x4*)(tot + 128 + dd), a2 = *(const LAS f32x4*)(tot + 256 + dd), a3 = *(const LAS f32x4*)(tot + 384 + dd);
                const f32x4 bm = dir ? (a2 + a3) : (a0 + a1); float eb[4];
#pragma unroll
                for (int j = 0; j < 4; ++j) eb[j] = __builtin_amdgcn_exp2f(bm[j]);
                *(LAS v2u*)(lds + SC_ST + ((32 * svi + r) * 136 + dd) * 2) = (v2u){pg8::cvt_pk_bf16(S0[4 * rg] * eb[0], S0[4 * rg + 1] * eb[1]), pg8::cvt_pk_bf16(S0[4 * rg + 2] * eb[2], S0[4 * rg + 3] * eb[3])};
                *(LAS v2u*)(lds + SC_ST + ((32 * (svi + 1) + r) * 136 + dd) * 2) = (v2u){pg8::cvt_pk_bf16(S1[4 * rg] * eb[0], S1[4 * rg + 1] * eb[1]), pg8::cvt_pk_bf16(S1[4 * rg + 2] * eb[2], S1[4 * rg + 3] * eb[3])}; }
        }
        if (c + 1 < NCH) { float sm = 0.f;
#pragma unroll
            for (int i = 0; i < 8; ++i) { const unsigned u2 = lg1[i >> 2][i & 3]; sm += h2f((unsigned short)(u2 & 0xffff)) + h2f((unsigned short)(u2 >> 16)); }
            totb[(par ^ 1) * 512 + tq * 128 + d] = sm;
            lg0[0] = lg1[0]; lg0[1] = lg1[1];
            const int c1 = col_of(c + 1) + 16 * tq;
            vr[0] = *(const u32x4*)(HIT + chrow * MROWS + c1); vr[1] = *(const u32x4*)(HIT + chrow * MROWS + c1 + 8);
            if (c + 1 >= 4) { qr[0] = *(const u32x4*)(HQT + chrow * T + c1); qr[1] = *(const u32x4*)(HQT + chrow * T + c1 + 8); }
            if (c + 2 < NCH) { const int c2 = col_of(c + 2) + 16 * tq; lg1[0] = *(const u32x4*)(LGT + chrow * MROWS + c2); lg1[1] = *(const u32x4*)(LGT + chrow * MROWS + c2 + 8); } }
        __syncthreads();
        f32x16 dS0, dS1, O;
#pragma unroll
        for (int i = 0; i < 16; ++i) { dS0[i] = 0.f; dS1[i] = 0.f; O[i] = 0.f; }
        {
            bf16x8 fa[4], fb0[4], fb1[4];
#pragma unroll
            for (int ks = 0; ks < 4; ++ks) { fa[ks] = *(const LAS bf16x8*)(lds + SC_K1T + ((32 * di + r) * 72 + 16 * ks + 8 * hh) * 2);
                fb0[ks] = *(const LAS bf16x8*)(lds + SC_VT + ((32 * svi + r) * 72 + 16 * ks + 8 * hh) * 2); fb1[ks] = *(const LAS bf16x8*)(lds + SC_VT + ((32 * (svi + 1) + r) * 72 + 16 * ks + 8 * hh) * 2); }
#pragma unroll
            for (int ks = 0; ks < 4; ++ks) { dS0 = SCAN_MFMA(fa[ks], fb0[ks], dS0); dS1 = SCAN_MFMA(fa[ks], fb1[ks], dS1); }
        }
        if (lat) {
            bf16x8 fq[8];
#pragma unroll
            for (int ks = 0; ks < 8; ++ks) fq[ks] = *(const LAS bf16x8*)(lds + SC_Q1 + ((32 * ti + r) * 136 + 16 * ks + 8 * hh) * 2);
            {
                bf16x8 fs[8];
#pragma unroll
                for (int ks = 0; ks < 8; ++ks) fs[ks] = *(const LAS bf16x8*)(lds + SC_ST + ((32 * ovi + r) * 136 + 16 * ks + 8 * hh) * 2);
#pragma unroll
                for (int ks = 0; ks < 8; ++ks) O = SCAN_MFMA(fs[ks], fq[ks], O);
            }
#pragma unroll
            for (int si = 0; si < 2; ++si) {
                const bool live = dir ? (si >= ti) : (si <= ti);
                if (live) {
                    f32x16 At;
#pragma unroll
                    for (int i = 0; i < 16; ++i) At[i] = 0.f;
                    bf16x8 fk[8];
#pragma unroll
                    for (int ks = 0; ks < 8; ++ks) fk[ks] = *(const LAS bf16x8*)(lds + SC_K1 + ((32 * si + r) * 136 + 16 * ks + 8 * hh) * 2);
#pragma unroll
                    for (int ks = 0; ks < 8; ++ks) At = SCAN_MFMA(fk[ks], fq[ks], At);
                    const int tt = 32 * ti + r;
                    if (si == ti) {
#pragma unroll
                        for (int i = 0; i < 16; ++i) { const int ss = 32 * si + (i & 3) + 8 * (i >> 2) + 4 * hh; const bool keep = dir ? (ss >= tt) : (ss <= tt); At[i] = keep ? At[i] : 0.f; }
                    }
#pragma unroll
                    for (int k2 = 0; k2 < 2; ++k2) {
                        u32x4 pw; pw.x = pg8::cvt_pk_bf16(At[8 * k2], At[8 * k2 + 1]); pw.y = pg8::cvt_pk_bf16(At[8 * k2 + 2], At[8 * k2 + 3]); pw.z = pg8::cvt_pk_bf16(At[8 * k2 + 4], At[8 * k2 + 5]); pw.w = pg8::cvt_pk_bf16(At[8 * k2 + 6], At[8 * k2 + 7]);
                        const LAS unsigned char* vp = lds + SC_VT + ((32 * ovi + r) * 72 + 32 * si + 16 * k2 + 4 * hh) * 2;
                        const v2u lo = *(const LAS v2u*)vp, hi2 = *(const LAS v2u*)(vp + 16);
                        O = SCAN_MFMA(__builtin_bit_cast(bf16x8, (u32x4){lo.x, lo.y, hi2.x, hi2.y}), __builtin_bit_cast(bf16x8, pw), O);
                    }
                }
            }
            bf16* op = OUT + (size_t)(col_of(c) + 32 * ti + r) * SEGW + h * HGD + 32 * ovi + 4 * hh;
#pragma unroll
            for (int rg = 0; rg < 4; ++rg) *(v2u*)(op + 8 * rg) = (v2u){pg8::cvt_pk_bf16(O[4 * rg], O[4 * rg + 1]), pg8::cvt_pk_bf16(O[4 * rg + 2], O[4 * rg + 3])};
        }
#pragma unroll
        for (int rg = 0; rg < 4; ++rg) { const int dd = 32 * di + 8 * rg + 4 * hh;
            const f32x4 ee = *(const LAS f32x4*)(cst + dd), em = *(const LAS f32x4*)(cst + 128 + dd);
#pragma unroll
            for (int j = 0; j < 4; ++j) { S0[4 * rg + j] = ee[j] * S0[4 * rg + j] + em[j] * dS0[4 * rg + j]; S1[4 * rg + j] = ee[j] * S1[4 * rg + j] + em[j] * dS1[4 * rg + j]; } }
        __syncthreads();
    }
}

#ifdef DBG_NAIVE
__device__ __forceinline__ void scan_naive(LAS unsigned char* lds, int b, int h, int dir, const unsigned short* LGT, const bf16* HQT, const bf16* HIT, bf16* OUT, int tid) {
    const int dv = tid & 127, kg = tid >> 7;
    float St[32];
#pragma unroll
    for (int i = 0; i < 32; ++i) St[i] = 0.f;
    LAS float* sq = (LAS float*)lds; LAS float* sk = sq + 16 * 128; LAS float* sf = sk + 16 * 128; LAS float* sv = sf + 16 * 128; LAS float* so = sv + 16 * 128;
    constexpr int NSTEP = LC + SEQ;
    for (int j0 = 0; j0 < NSTEP; j0 += 16) {
        const bool isctx = j0 < LC;
        for (int idx = tid; idx < 16 * 128; idx += NTHR) { const int st = idx >> 7, ch = idx & 127, j = j0 + st;
            int col; if (j < LC) col = T + b * LC + (dir ? (LC - 1 - j) : j); else col = b * SEQ + (dir ? (SEQ - 1 - (j - LC)) : (j - LC));
            const size_t cr = (size_t)(h * HGD + ch);
            const float f = __builtin_amdgcn_exp2f(h2f(LGT[cr * MROWS + col]));
            sf[st * 128 + ch] = f; sk[st * 128 + ch] = 1.f - f; sv[st * 128 + ch] = bf2f(HIT[cr * MROWS + col]);
            if (!isctx) sq[st * 128 + ch] = bf2f(HQT[cr * T + col]); }
        __syncthreads();
        for (int st = 0; st < 16; ++st) {
            const float vv = sv[st * 128 + dv]; float o = 0.f;
#pragma unroll
            for (int i = 0; i < 32; ++i) { St[i] = sf[st * 128 + kg * 32 + i] * St[i] + sk[st * 128 + kg * 32 + i] * vv; o += St[i] * sq[st * 128 + kg * 32 + i]; }
            so[(st * 4 + kg) * 128 + dv] = o;
        }
        __syncthreads();
        if (!isctx) {
            for (int idx = tid; idx < 16 * 128; idx += NTHR) { const int st = idx >> 7, dd = idx & 127, j = j0 + st;
                const float o = (so[(st * 4 + 0) * 128 + dd] + so[(st * 4 + 1) * 128 + dd]) + (so[(st * 4 + 2) * 128 + dd] + so[(st * 4 + 3) * 128 + dd]);
                const int row = b * SEQ + (dir ? (SEQ - 1 - (j - LC)) : (j - LC));
                OUT[(size_t)row * SEGW + h * HGD + dd] = (bf16)f2bf(o); }
        }
        __syncthreads();
    }
}
#endif

__device__ __forceinline__ void transpose_item(const float* W, int ldw, int k0, int n0, bf16* WT, int ldk, int drow0, LAS float* scr, int lane) {
#pragma unroll 8
    for (int i = 0; i < 32; ++i) { const int kk = 2 * i + (lane >> 5); scr[kk * 33 + (lane & 31)] = W[(size_t)(k0 + kk) * ldw + n0 + (lane & 31)]; }
    LDS_WAIT(); asm volatile("" ::: "memory");
    const int c = lane & 7;
#pragma unroll
    for (int j = 0; j < 4; ++j) { const int n = (lane >> 3) + 8 * j; const LAS float* s = scr + (8 * c) * 33 + n;
        v4u o; o.x = pk2(s[0 * 33], s[1 * 33]); o.y = pk2(s[2 * 33], s[3 * 33]); o.z = pk2(s[4 * 33], s[5 * 33]); o.w = pk2(s[6 * 33], s[7 * 33]);
        *(GAS v4u*)(WT + (size_t)(drow0 + n) * ldk + k0 + 8 * c) = o; }
    LDS_WAIT(); asm volatile("" ::: "memory");
}

struct Args { const float* in[21]; float* out; unsigned char* ws; int ph_lo, ph_hi, li, pad; };

__global__ void __launch_bounds__(NTHR, 2) fwd_mega(Args args) {
    extern __shared__ __attribute__((aligned(16))) unsigned char lds_raw[];
    LAS unsigned char* lds = (LAS unsigned char*)lds_raw;
    volatile LAS unsigned* MISC = (volatile LAS unsigned*)(lds + MISC_OFF);
    const int tid = threadIdx.x, lane = tid & 63, wave = __builtin_amdgcn_readfirstlane(tid >> 6);
    const int G = gridDim.x; const int bx = blockIdx.x; const int vcu = (G % 8 == 0) ? (bx % 8) * (G / 8) + bx / 8 : bx;
    gu32* ctl0 = (gu32*)(args.ws + WS_CTL);
    const int gw = vcu * NWAVES + wave, NGW = G * NWAVES;
    for (int u = tid; u < (LDS_BYTES - LDSCTL_OFF) / 4; u += NTHR) ((LAS unsigned*)(lds + LDSCTL_OFF))[u] = 0u;
    __syncthreads();
    XcdBarrier bar = xcd_barrier_post((unsigned*)(ctl0 + CW_BAR) + args.li * XCD_BAR_WORDS, MISC + 8);
    const int lo = args.ph_lo, hi = args.ph_hi;
#ifndef PHMASK
#define PHMASK 0xFFFF
#endif
#define IN(k) (((PHMASK >> (k)) & 1) && lo <= (k) && (k) < hi)
#define SEAM(k) do { if (IN(k) && IN((k) + 1)) xcd_barrier(bar); } while (0)

#define KA(i) ({ const __attribute__((address_space(4))) Args* _p = (const __attribute__((address_space(4))) Args*)__builtin_amdgcn_kernarg_segment_ptr(); asm volatile("" : "+s"(_p)); _p->in[i]; })
#define WSP() ({ const __attribute__((address_space(4))) Args* _p = (const __attribute__((address_space(4))) Args*)__builtin_amdgcn_kernarg_segment_ptr(); asm volatile("" : "+s"(_p)); _p->ws; })
#define PHASE_PTRS unsigned char* ws = WSP(); float* MOD = (float*)(ws + WS_MOD); float* ROPE = (float*)(ws + WS_ROPE); float* LBT = (float*)(ws + WS_LBT); \
    bf16* WinT = (bf16*)(ws + WS_WINT); bf16* WoutT = (bf16*)(ws + WS_WOUTT); bf16* W13T = (bf16*)(ws + WS_W13T); bf16* W2T = (bf16*)(ws + WS_W2T); \
    bf16* XN = (bf16*)(ws + WS_XN); bf16* MIX = (bf16*)(ws + WS_MIX); bf16* XN2 = (bf16*)(ws + WS_XN2); \
    float* X1 = (float*)(ws + WS_X1); bf16* Hb = (bf16*)(ws + WS_H); bf16* Yb = (bf16*)(ws + WS_Y); \
    int* ELIST = (int*)(ws + WS_ELIST); float* EWT = (float*)(ws + WS_EWT); gu32* ctl = (gu32*)(ws + WS_CTL); \
    (void)MOD; (void)ROPE; (void)LBT; (void)WinT; (void)WoutT; (void)W13T; (void)W2T; (void)XN; (void)MIX; (void)XN2; (void)X1; (void)Hb; (void)Yb; (void)ELIST; (void)EWT; (void)ctl;
    if (IN(0)) {
        PHASE_PTRS
        const float* cvec = KA(1); const float* c_ctx = KA(3); const float* w_mod = KA(4); const float* b_mod = KA(5); const float* w_in = KA(8); const float* w_out = KA(9);
        const float* hg_lb = KA(11); const float* w1 = KA(17); const float* w3 = KA(18); const float* w2 = KA(19);
        if (bx == G - 1) {
            for (int idx = tid; idx < 1024; idx += NTHR) { const int pos = idx >> 4, i = idx & 15;
                double th = 1.0; for (int k = 0; k < i; ++k) th *= 0.5623413251903491;
                const double t2 = th * th; double c = 1.0, s = th, tc = 1.0, ts = th;
                for (int n = 1; n <= 12; ++n) { tc *= -t2 / (double)((2 * n - 1) * (2 * n)); c += tc; ts *= -t2 / (double)((2 * n) * (2 * n + 1)); s += ts; }
                double cr = 1.0, ci = 0.0; for (int p = 0; p < pos; ++p) { const double nr = cr * c - ci * s; ci = cr * s + ci * c; cr = nr; }
                ROPE[idx * 2] = (float)cr; ROPE[idx * 2 + 1] = (float)ci; }
            for (int idx = tid; idx < 1024; idx += NTHR) { const float h0 = hg_lb[idx], h1 = hg_lb[1024 + idx]; LBT[idx] = 1.f / (1.f + expf(h1 - h0)); }
        }
        if (bx < 96) {
            LAS float* sc = (LAS float*)lds;
            for (int idx = tid; idx < 17 * 1024; idx += NTHR) { const int r = idx >> 10, k = idx & 1023; const float cv = r < 16 ? cvec[r * 1024 + k] : c_ctx[k]; sc[idx] = cv / (1.f + expf(-cv)); }
            __syncthreads();
            const int col = 64 * bx + lane, k0 = 128 * wave;
            float acc[17];
#pragma unroll
            for (int r = 0; r < 17; ++r) acc[r] = 0.f;
            for (int kk = 0; kk < 128; kk += 4) {
                const float w0 = w_mod[(size_t)(k0 + kk) * 6144 + col], w1v = w_mod[(size_t)(k0 + kk + 1) * 6144 + col], w2v = w_mod[(size_t)(k0 + kk + 2) * 6144 + col], w3v = w_mod[(size_t)(k0 + kk + 3) * 6144 + col];
#pragma unroll
                for (int r = 0; r < 17; ++r) { const f32x4 a = *(const LAS f32x4*)(sc + r * 1024 + k0 + kk); acc[r] += a[0] * w0 + a[1] * w1v + a[2] * w2v + a[3] * w3v; }
            }
            LAS float* red = (LAS float*)(lds + 17 * 1024 * 4);
#pragma unroll
            for (int r = 0; r < 17; ++r) red[(wave * 17 + r) * 64 + lane] = acc[r];
            __syncthreads();
            for (int idx = tid; idx < 17 * 64; idx += NTHR) { const int r = idx >> 6, l = idx & 63; float s = 0.f;
#pragma unroll
                for (int w = 0; w < 8; ++w) s += red[(w * 17 + r) * 64 + l];
                MOD[r * 6144 + 64 * bx + l] = s + b_mod[64 * bx + l]; }
            __syncthreads();
        }
        {
            LAS float* scr = (LAS float*)(lds + wave * 16384);
            constexpr int I_IN = 16 * 128, I_OUT = 16 * 32, I_13 = 16 * 2 * 256, I_2 = 16 * 256, NIT = I_IN + I_OUT + I_13 + I_2;
            for (int it = gw; it < NIT; it += NGW) {
                int r = it;
                if (r < I_IN) { const int kb = r / 128, nb = r % 128; transpose_item(w_in, INCOLS, 64 * kb, 32 * nb, WinT, 1024, 32 * nb, scr, lane); continue; } r -= I_IN;
                if (r < I_OUT) { const int kb = r / 32, nb = r % 32; transpose_item(w_out, 1024, 64 * kb, 32 * nb, WoutT, 1024, 32 * nb, scr, lane); continue; } r -= I_OUT;
                if (r < I_13) { const int e = r / 512, rem = r % 512, s = rem / 256, r2 = rem % 256, kb = r2 / 16, nb = r2 % 16, n0 = 32 * nb;
                    transpose_item((s ? w3 : w1) + (size_t)e * 1024 * 512, 512, 64 * kb, n0, W13T, 1024, e * 1024 + 256 * (n0 / 128) + 128 * s + (n0 % 128), scr, lane); continue; } r -= I_13;
                { const int e = r / 256, r2 = r % 256, kb = r2 / 32, nb = r2 % 32; transpose_item(w2 + (size_t)e * 512 * 1024, 1024, 64 * kb, 32 * nb, W2T, 512, e * 1024 + 32 * nb, scr, lane); }
            }
        }
    }
    SEAM(0);

    if (IN(1)) {
        PHASE_PTRS
        const float* x = KA(0); const float* ctx = KA(2); const float* norm_mix = KA(6);
        for (int row = gw; row < MROWS; row += NGW) {
            const float* xr = row < T ? x + (size_t)row * D : ctx + (size_t)(row - T) * D; const int mb = row < T ? (row >> 11) : 16;
            f32x4 v[4]; float s = 0.f;
#pragma unroll
            for (int j = 0; j < 4; ++j) { v[j] = *(const f32x4*)(xr + 4 * lane + 256 * j); s += (v[j][0] * v[j][0] + v[j][1] * v[j][1]) + (v[j][2] * v[j][2] + v[j][3] * v[j][3]); }
            const float rstd = 1.f / sqrtf(wave_sum(s) * (1.f / D) + EPS);
#pragma unroll
            for (int j = 0; j < 4; ++j) { const int col = 4 * lane + 256 * j; const f32x4 g = *(const f32x4*)(norm_mix + col), sh = *(const f32x4*)(MOD + mb * 6144 + col), sc = *(const f32x4*)(MOD + mb * 6144 + 1024 + col);
                const f32x4 y = v[j] * rstd * g * (1.f + sc) + sh;
                *(v2u*)(XN + (size_t)row * D + col) = (v2u){pk2(y[0], y[1]), pk2(y[2], y[3])}; }
        }
    }
    SEAM(1);

    if (IN(2)) {
        PHASE_PTRS
        ProjOrder S; S.init(G, bx);
        LAS float* ropeL = (LAS float*)(lds + TAB_OFF); LAS float* lbtL = ropeL + 2048;
        for (int i = tid; i < 2048 + 1024; i += NTHR) ropeL[i] = i < 2048 ? ROPE[i] : LBT[i - 2048];
        __syncthreads();
        EpiProj E{ws, ropeL, lbtL, 0};
        pg8::gemm_phase<EpiProj, ProjOrder>(lds + RING_OFF, XN, WinT, D, S, E);
    }
    SEAM(2);

    if (IN(3)) {
        PHASE_PTRS
        const bf16* Qb = (const bf16*)(ws + WS_Q); const bf16* Kb = (const bf16*)(ws + WS_K); const bf16* Vb = (const bf16*)(ws + WS_V);
        const float* na_rpb = KA(10);
        const int subph = ({ const __attribute__((address_space(4))) Args* _p = (const __attribute__((address_space(4))) Args*)__builtin_amdgcn_kernarg_segment_ptr(); asm volatile("" : "+s"(_p)); _p->pad; });
#ifndef NO_SCAN
        if (bx < 128) {
            const int dir = bx & 1;
#ifdef DBG_NAIVE
            if (DBG_NAIVE & (1 << dir)) scan_naive(lds, bx >> 3, (bx >> 1) & 3, dir, (const unsigned short*)(ws + (dir ? WS_LB : WS_LF)), (const bf16*)(ws + WS_HQ), (const bf16*)(ws + WS_HI), (bf16*)(ws + (dir ? WS_OB : WS_OF)), tid);
            else
#endif
            if (subph != 2) scan_unit(lds, bx >> 3, (bx >> 1) & 3, dir, (const unsigned short*)(ws + (dir ? WS_LB : WS_LF)), (const bf16*)(ws + WS_HQ), (const bf16*)(ws + WS_HI), (bf16*)(ws + (dir ? WS_OB : WS_OF)), tid);
        } else
#endif
        {
            LAS float* rpbL = (LAS float*)lds;
            for (int idx = tid; idx < 8 * 15 * 64; idx += NTHR) { const int co = (idx & 63) - 16, hr = idx >> 6; rpbL[idx] = (co >= 0 && co < 31) ? na_rpb[hr * 31 + co] * 1.44269504f : 0.f; }
            __syncthreads();
            const __amdgpu_buffer_rsrc_t srdK = __builtin_amdgcn_make_buffer_rsrc((void*)Kb, (short)0, MROWS * SEGW * 2, 0x00020000), srdV = __builtin_amdgcn_make_buffer_rsrc((void*)Vb, (short)0, MROWS * SEGW * 2, 0x00020000);
            const int hx = bx & 7, idx = ((bx - 128) >> 3) * NWAVES + wave;
#pragma unroll 1
            for (int it = (subph == 1 ? 4 : 0); it < 4; ++it)
                na_row(it * 4 + (idx >> 5), hx, idx & 31, Qb, (const bf16*)(ws + WS_QR), srdK, srdV, MIX, rpbL, lds + 32768 + wave * 8192, lane);
        }
    }
    SEAM(3);

    if (IN(4)) {
        PHASE_PTRS
        const float* hg_norm = KA(12);
        const bf16* OF = (const bf16*)(ws + WS_OF); const bf16* OB = (const bf16*)(ws + WS_OB); const bf16* Gb = (const bf16*)(ws + WS_G);
        for (int tok = gw; tok < T; tok += NGW) {
            const size_t off = (size_t)tok * SEGW + lane * 8;
            const v4u a = *(const v4u*)(OF + off), bb = *(const v4u*)(OB + off), g = *(const v4u*)(Gb + off);
            float o[8]; float ss = 0.f;
#pragma unroll
            for (int e = 0; e < 4; ++e) { o[2 * e] = bflo(a[e]) + bflo(bb[e]); o[2 * e + 1] = bfhi(a[e]) + bfhi(bb[e]);
#ifdef DBG_SANITIZE
                if (!(fabsf(o[2 * e]) < 1e30f)) o[2 * e] = 0.f; if (!(fabsf(o[2 * e + 1]) < 1e30f)) o[2 * e + 1] = 0.f;
#endif
                ss += o[2 * e] * o[2 * e] + o[2 * e + 1] * o[2 * e + 1]; }
            ss += __shfl_xor(ss, 1); ss += __shfl_xor(ss, 2); ss += __shfl_xor(ss, 4); ss += __shfl_xor(ss, 8);
            const float rstd = 1.f / sqrtf(ss * (1.f / HGD) + EPS);
            const int dv0 = (lane & 15) * 8;
            const f32x4 g0 = *(const f32x4*)(hg_norm + dv0), g1 = *(const f32x4*)(hg_norm + dv0 + 4);
            const float gg[8] = {g0[0], g0[1], g0[2], g0[3], g1[0], g1[1], g1[2], g1[3]};
            float y[8];
#pragma unroll
            for (int e = 0; e < 4; ++e) { y[2 * e] = o[2 * e] * rstd * gg[2 * e] * bflo(g[e]); y[2 * e + 1] = o[2 * e + 1] * rstd * gg[2 * e + 1] * bfhi(g[e]); }
            *(v4u*)(MIX + (size_t)tok * D + 512 + lane * 8) = (v4u){pk2(y[0], y[1]), pk2(y[2], y[3]), pk2(y[4], y[5]), pk2(y[6], y[7])};
        }
    }
    SEAM(4);

    if (IN(5)) {
        PHASE_PTRS
        pg8::DenseOrder S; S.init(T, D, G, bx, true);
        EpiP E{(bf16*)X1};
        pg8::gemm_phase<EpiP, pg8::DenseOrder>(lds + RING_OFF, MIX, WoutT, D, S, E);
    }
    SEAM(5);

    if (IN(6)) {
        PHASE_PTRS
        const float* norm_ffn = KA(7); const float* w_grp = KA(13); const float* b_grp = KA(14); const float* w_exp = KA(15); const float* b_exp = KA(16);
        LAS f32x4* wl = (LAS f32x4*)lds;
        for (int idx = tid; idx < 5 * 1024; idx += NTHR) { const int quad = idx >> 10, col = idx & 1023; const int l = (col & 255) >> 2, q = col & 3, j = col >> 8;
            const f32x4 w = quad == 0 ? *(const f32x4*)(w_grp + col * 4) : *(const f32x4*)(w_exp + col * 16 + (quad - 1) * 4);
            wl[((quad * 4 + q) * 4 + j) * 64 + l] = w; }
        LAS int* lcnt = (LAS int*)(lds + 81920);
        LAS int* tmpe = (LAS int*)(lds + 81920 + 256);
        LAS float* rsc = (LAS float*)(lds + 86016);
        if (tid < 32) lcnt[tid] = 0;
        __syncthreads();
        const int rowbase = bx * 128 + wave * 16;
        const int mb = rowbase >> 11;
        f32x4 gsc[4], shv[4], gaa[4];
        const float* xin = KA(0); const bf16* Pb = (const bf16*)X1;
#pragma unroll
        for (int j = 0; j < 4; ++j) { const int col = 4 * lane + 256 * j; const f32x4 g = *(const f32x4*)(norm_ffn + col), sc = *(const f32x4*)(MOD + mb * 6144 + 4096 + col);
            gsc[j] = g * (1.f + sc); shv[j] = *(const f32x4*)(MOD + mb * 6144 + 3072 + col); gaa[j] = *(const f32x4*)(MOD + mb * 6144 + 2048 + col); }
        f32x4 vn[2][4]; v2u pn[2][4];
#pragma unroll
        for (int rr = 0; rr < 2; ++rr)
#pragma unroll
            for (int j = 0; j < 4; ++j) { const size_t o_ = (size_t)(rowbase + rr) * D + 4 * lane + 256 * j; vn[rr][j] = *(const f32x4*)(xin + o_); pn[rr][j] = *(const v2u*)(Pb + o_); }
#pragma unroll 1
        for (int ip = 0; ip < 8; ++ip) {
            asm volatile("" ::: "memory");
            f32x4 v[2][4];
#pragma unroll
            for (int rr = 0; rr < 2; ++rr)
#pragma unroll
                for (int j = 0; j < 4; ++j) v[rr][j] = vn[rr][j] + gaa[j] * (f32x4){bflo(pn[rr][j].x), bfhi(pn[rr][j].x), bflo(pn[rr][j].y), bfhi(pn[rr][j].y)};
            if (ip < 7) {
#pragma unroll
                for (int rr = 0; rr < 2; ++rr)
#pragma unroll
                    for (int j = 0; j < 4; ++j) { const size_t o_ = (size_t)(rowbase + 2 * ip + 2 + rr) * D + 4 * lane + 256 * j; vn[rr][j] = *(const f32x4*)(xin + o_); pn[rr][j] = *(const v2u*)(Pb + o_); } }
            float ss[2];
#pragma unroll
            for (int rr = 0; rr < 2; ++rr) { float s = 0.f;
#pragma unroll
                for (int j = 0; j < 4; ++j) s += (v[rr][j][0] * v[rr][j][0] + v[rr][j][1] * v[rr][j][1]) + (v[rr][j][2] * v[rr][j][2] + v[rr][j][3] * v[rr][j][3]);
                ss[rr] = s; }
#pragma unroll
            for (int o = 1; o < 64; o <<= 1) { ss[0] += __shfl_xor(ss[0], o); ss[1] += __shfl_xor(ss[1], o); }
            const float rstd0 = 1.f / sqrtf(ss[0] * (1.f / D) + EPS), rstd1 = 1.f / sqrtf(ss[1] * (1.f / D) + EPS);
            float lg[2][20];
#pragma unroll
            for (int k = 0; k < 20; ++k) { lg[0][k] = 0.f; lg[1][k] = 0.f; }
#pragma unroll
            for (int j = 0; j < 4; ++j) { const int col = 4 * lane + 256 * j;
                const f32x4 y0 = v[0][j] * rstd0 * gsc[j] + shv[j], y1 = v[1][j] * rstd1 * gsc[j] + shv[j];
                *(v2u*)(XN2 + (size_t)(rowbase + 2 * ip) * D + col) = (v2u){pg8::cvt_pk_bf16(y0[0], y0[1]), pg8::cvt_pk_bf16(y0[2], y0[3])};
                *(v2u*)(XN2 + (size_t)(rowbase + 2 * ip + 1) * D + col) = (v2u){pg8::cvt_pk_bf16(y1[0], y1[1]), pg8::cvt_pk_bf16(y1[2], y1[3])};
#pragma unroll
                for (int q = 0; q < 4; ++q)
#pragma unroll
                    for (int quad = 0; quad < 5; ++quad) { const f32x4 w = wl[((quad * 4 + q) * 4 + j) * 64 + lane];
#pragma unroll
                        for (int c = 0; c < 4; ++c) { lg[0][quad * 4 + c] += y0[q] * w[c]; lg[1][quad * 4 + c] += y1[q] * w[c]; } }
                asm volatile("" ::: "memory"); }
            {
                float rv[64];
#pragma unroll
                for (int k = 0; k < 64; ++k) rv[k] = k < 40 ? lg[k / 20][k % 20] : 0.f;
#pragma unroll
                for (int hb = 32; hb >= 1; hb >>= 1) { const bool hi_ = (lane & hb) != 0;
#pragma unroll
                    for (int i = 0; i < hb; ++i) { const float keep = hi_ ? rv[i + hb] : rv[i], send = hi_ ? rv[i] : rv[i + hb]; rv[i] = keep + __shfl_xor(send, hb); } }
                rsc[wave * 64 + lane] = rv[0];
            }
            if (lane < 2) {
                const int rr = lane; const LAS float* lgr = rsc + wave * 64 + rr * 20;
                {
                    float gl[4];
#pragma unroll
                    for (int k = 0; k < 4; ++k) gl[k] = lgr[k] + b_grp[k];
                    int gs = 0; float gm = gl[0];
#pragma unroll
                    for (int k = 1; k < 4; ++k) if (gl[k] > gm) { gm = gl[k]; gs = k; }
                    float den = 0.f;
#pragma unroll
                    for (int k = 0; k < 4; ++k) den += __expf(gl[k] - gm);
                    const float g_w = 1.f / den;
                    float ev[4];
#pragma unroll
                    for (int k = 0; k < 4; ++k) ev[k] = lgr[4 + gs * 4 + k] + b_exp[gs * 4 + k];
                    int i0 = 0; float v0 = ev[0];
#pragma unroll
                    for (int k = 1; k < 4; ++k) if (ev[k] > v0) { v0 = ev[k]; i0 = k; }
                    int i1 = -1; float v1 = -INFINITY;
#pragma unroll
                    for (int k = 0; k < 4; ++k) if (k != i0 && ev[k] > v1) { v1 = ev[k]; i1 = k; }
                    if (i1 < 0) { i1 = (i0 + 1) & 3; v1 = v0; }
                    const float e1 = __expf(v1 - v0); const float w0 = g_w / (1.f + e1), w1w = g_w * e1 / (1.f + e1);
                    const int ea = gs * 4 + i0, eb = gs * 4 + i1;
                    const int ra = __hip_atomic_fetch_add(&lcnt[ea], 1, __ATOMIC_RELAXED, __HIP_MEMORY_SCOPE_WORKGROUP), rb = __hip_atomic_fetch_add(&lcnt[eb], 1, __ATOMIC_RELAXED, __HIP_MEMORY_SCOPE_WORKGROUP);
                    const int lr = (wave * 16 + 2 * ip + rr) * 2;
                    tmpe[lr] = ea; tmpe[256 + lr] = ra; tmpe[512 + lr] = __builtin_bit_cast(int, w0);
                    tmpe[lr + 1] = eb; tmpe[256 + lr + 1] = rb; tmpe[512 + lr + 1] = __builtin_bit_cast(int, w1w);
                }
            }
        }
        __syncthreads();
        if (tid < 16) lcnt[16 + tid] = (int)__hip_atomic_fetch_add(ctl + CW_CNT + tid, (unsigned)lcnt[tid], RLX_AGENT);
        __syncthreads();
        if (tid < 256) { const int e = tmpe[tid], pos = lcnt[16 + e] + tmpe[256 + tid]; const int tok = bx * 128 + (tid >> 1);
            ELIST[e * ECAP + pos] = tok * 2 + (tid & 1); EWT[e * ECAP + pos] = __builtin_bit_cast(float, tmpe[512 + tid]); }
        __syncthreads();
    }
    SEAM(6);

    if (IN(7) || IN(8)) {
        PHASE_PTRS
        LAS int* tp = (LAS int*)(lds + MOE_OFF);
        if (tid == 0) { int acc = 0;
            for (int e = 0; e < 16; ++e) { const int c = (int)__hip_atomic_load(ctl + CW_CNT + e, RLX_AGENT); tp[e] = acc; tp[17 + e] = c; acc += (c + 255) >> 8; }
            tp[16] = acc; }
        __syncthreads();
    }
    if (IN(7)) {
        PHASE_PTRS
        const LAS int* tp = (const LAS int*)(lds + MOE_OFF);
        MoeOrder<true> S{tp, ELIST, G, bx, tp[16] * 4};
        EpiSwiGLU E{Hb};
        pg8::gemm_phase<EpiSwiGLU, MoeOrder<true>>(lds + RING_OFF, XN2, W13T, D, S, E);
    }
    SEAM(7);
    if (IN(8)) {
        PHASE_PTRS
        const LAS int* tp = (const LAS int*)(lds + MOE_OFF);
        MoeOrder<false> S{tp, ELIST, G, bx, tp[16] * 4};
        EpiMoeOut E{Yb, ELIST, EWT};
        pg8::gemm_phase<EpiMoeOut, MoeOrder<false>>(lds + RING_OFF, Hb, W2T, DE, S, E);
    }
    SEAM(8);

    if (IN(9)) {
        PHASE_PTRS
        const float* norm_final = KA(20); const float* xfin = KA(0); float* outp = ({ const __attribute__((address_space(4))) Args* _p = (const __attribute__((address_space(4))) Args*)__builtin_amdgcn_kernarg_segment_ptr(); asm volatile("" : "+s"(_p)); _p->out; });
        for (int row = gw; row < T; row += NGW) {
            const int mb = row >> 11; f32x4 v[4]; float s = 0.f;
#pragma unroll
            for (int j = 0; j < 4; ++j) { const int col = 4 * lane + 256 * j; const v2u pp = *(const v2u*)((const bf16*)X1 + (size_t)row * D + col);
                const f32x4 xv = *(const f32x4*)(xfin + (size_t)row * D + col) + *(const f32x4*)(MOD + mb * 6144 + 2048 + col) * (f32x4){bflo(pp.x), bfhi(pp.x), bflo(pp.y), bfhi(pp.y)}, ga = *(const f32x4*)(MOD + mb * 6144 + 5120 + col);
                const v2u y0 = *(const v2u*)(Yb + (size_t)(2 * row) * D + col), y1 = *(const v2u*)(Yb + (size_t)(2 * row + 1) * D + col);
                const f32x4 ys = (f32x4){bflo(y0.x) + bflo(y1.x), bfhi(y0.x) + bfhi(y1.x), bflo(y0.y) + bflo(y1.y), bfhi(y0.y) + bfhi(y1.y)};
                v[j] = xv + ga * ys; s += (v[j][0] * v[j][0] + v[j][1] * v[j][1]) + (v[j][2] * v[j][2] + v[j][3] * v[j][3]); }
            const float rstd = 1.f / sqrtf(wave_sum(s) * (1.f / D) + EPS);
#pragma unroll
            for (int j = 0; j < 4; ++j) { const int col = 4 * lane + 256 * j; const f32x4 g = *(const f32x4*)(norm_final + col);
                *(f32x4*)(outp + (size_t)row * D + col) = v[j] * rstd * g; }
        }
    }
#undef IN
#undef SEAM
}

#ifndef MK_N_LAUNCHES
#define MK_N_LAUNCHES 1
#endif
constexpr int NPHASE = 10;
extern "C" void kernel_launch(void* const* d_in, const int* in_sizes, int n_in, void* d_out, int out_size, void* d_ws, size_t ws_size, hipStream_t stream) {
    static int grid = 0;
    if (grid == 0) {
        if (n_in != 21 || in_sizes[0] != T * D || out_size != T * D || ws_size < WS_END) { fprintf(stderr, "kernel_launch: unexpected shapes (n_in %d, in0 %d, out %d, ws %zu)\n", n_in, n_in > 0 ? in_sizes[0] : -1, out_size, ws_size); grid = -1; return; }
        int dev = 0, cus = 0, per_cu = 0;
        if (hipGetDevice(&dev) != hipSuccess || hipDeviceGetAttribute(&cus, hipDeviceAttributeMultiprocessorCount, dev) != hipSuccess) { grid = -1; return; }
        if (hipFuncSetAttribute((const void*)fwd_mega, hipFuncAttributeMaxDynamicSharedMemorySize, LDS_BYTES) != hipSuccess) { fprintf(stderr, "kernel_launch: hipFuncSetAttribute failed\n"); grid = -1; return; }
        if (hipOccupancyMaxActiveBlocksPerMultiprocessor(&per_cu, (const void*)fwd_mega, NTHR, LDS_BYTES) != hipSuccess || per_cu < 1) fprintf(stderr, "kernel_launch: occupancy query reports %d\n", per_cu);
        (void)hipGetLastError();
        grid = cus;
        if (grid != 256) fprintf(stderr, "kernel_launch: %d CUs (built for 256)\n", grid);
    }
    if (grid < 0) return;
    (void)hipMemsetAsync((char*)d_ws + WS_CTL, 0, CTL_ZERO_BYTES, stream);
    Args a{};
    for (int i = 0; i < 21; ++i) a.in[i] = (const float*)d_in[i];
    a.out = (float*)d_out; a.ws = (unsigned char*)d_ws;
    if (MK_N_LAUNCHES == 1) {
        a.ph_lo = 0; a.ph_hi = NPHASE; a.li = 0;
        hipLaunchKernelGGL(fwd_mega, dim3(grid), dim3(NTHR), LDS_BYTES, stream, a);
    } else {
        for (int li = 0; li < NPHASE; ++li) { a.ph_lo = li; a.ph_hi = li + 1; a.li = 0; hipLaunchKernelGGL(fwd_mega, dim3(grid), dim3(NTHR), LDS_BYTES, stream, a);
#ifdef PROBE_DUP
            if (li == PROBE_DUP) {
#ifdef PROBE_SUB
                a.pad = PROBE_SUB;
#endif
                hipLaunchKernelGGL(fwd_mega, dim3(grid), dim3(NTHR), LDS_BYTES, stream, a); a.pad = 0; }
#endif
        }
    }
}
```

```cpp
#include <hip/hip_runtime.h>
#include <cstdio>
#include <cstdint>

#define GAS __attribute__((address_space(1)))
#define LAS __attribute__((address_space(3)))
typedef unsigned short bf16;
typedef unsigned short bf16_t;
typedef unsigned v4u __attribute__((ext_vector_type(4)));
typedef unsigned v2u __attribute__((ext_vector_type(2)));
typedef float f32x4 __attribute__((ext_vector_type(4)));
typedef float f32x2 __attribute__((ext_vector_type(2)));
typedef short bf16x8 __attribute__((ext_vector_type(8)));
typedef unsigned u32x4 __attribute__((ext_vector_type(4)));
typedef GAS unsigned gu32;
#define RLX_AGENT __ATOMIC_RELAXED, __HIP_MEMORY_SCOPE_AGENT
#define LDS_WAIT() asm volatile("s_waitcnt lgkmcnt(0)" ::: "memory")
#define VM_WAIT() asm volatile("s_waitcnt vmcnt(0)" ::: "memory")

constexpr int NB = 16, SEQ = 2048, D = 1024, T = NB * SEQ, LC = 256, TC = NB * LC, MROWS = T + TC;
constexpr int GW = 64, NROWS = SEQ / GW;
constexpr int INCOLS = 4096, SEGW = 512;
constexpr int NAH = 8, NAD = 64, HGH = 4, HGD = 128;
constexpr int KTOK = SEQ + LC;
constexpr int NE = 16, DE = 512, ECAP = T;
constexpr float EPS = 1e-6f;
constexpr int NWAVES = 8, NTHR = 512;

constexpr size_t MiB = 1u << 20;
constexpr size_t WS_CTL = 0, CTL_ZERO_BYTES = 32768;
constexpr size_t WS_MOD = 1 * MiB;
constexpr size_t WS_ROPE = WS_MOD + 512 * 1024, WS_LBT = WS_MOD + 520 * 1024;
constexpr size_t WS_ELIST = 2 * MiB, WS_EWT = 4 * MiB;
constexpr size_t WS_WINT = 8 * MiB, WS_WOUTT = 16 * MiB, WS_W13T = 18 * MiB, WS_W2T = 50 * MiB;
constexpr size_t WS_XN = 66 * MiB;
constexpr size_t WS_Q = 138 * MiB, WS_K = 170 * MiB, WS_V = 206 * MiB, WS_HQ = 242 * MiB, WS_HI = 274 * MiB, WS_LF = 310 * MiB, WS_LB = 346 * MiB, WS_G = 382 * MiB;
constexpr size_t WS_OF = 414 * MiB, WS_OB = 446 * MiB, WS_QR = 478 * MiB, WS_END = 510 * MiB;
constexpr size_t WS_MIX = WS_XN, WS_XN2 = WS_XN, WS_X1 = 138 * MiB, WS_H = 274 * MiB, WS_Y = 346 * MiB;
constexpr int CW_CNT = 64;
constexpr int CW_BAR = 4096;
static_assert((CW_BAR + 3456) * 4 <= (int)CTL_ZERO_BYTES, "barrier words inside the per-call memset");

constexpr int RING_OFF = 0, RING_BYTES = 131072;
constexpr int LDSCTL_OFF = RING_BYTES, MISC_OFF = LDSCTL_OFF + 320, MOE_OFF = LDSCTL_OFF + 1024;
constexpr int TAB_OFF = LDSCTL_OFF + 2048;
constexpr int LDS_BYTES = 147456;

__device__ __forceinline__ unsigned f2bf(float f) { unsigned u = __builtin_bit_cast(unsigned, f); return (u + 0x7fffu + ((u >> 16) & 1u)) >> 16; }
__device__ __forceinline__ unsigned pk2(float lo, float hi) { return f2bf(lo) | (f2bf(hi) << 16); }
__device__ __forceinline__ float bf2f(unsigned short b) { return __builtin_bit_cast(float, (unsigned)b << 16); }
__device__ __forceinline__ float bflo(unsigned u) { return __builtin_bit_cast(float, u << 16); }
__device__ __forceinline__ float bfhi(unsigned u) { return __builtin_bit_cast(float, u & 0xffff0000u); }
__device__ __forceinline__ unsigned pkh2(float lo, float hi) { _Float16 a = (_Float16)lo, b = (_Float16)hi; return (unsigned)__builtin_bit_cast(unsigned short, a) | ((unsigned)__builtin_bit_cast(unsigned short, b) << 16); }
__device__ __forceinline__ float h2f(unsigned short h) { return (float)__builtin_bit_cast(_Float16, h); }
__device__ __forceinline__ float silu_f(float v) { return v * __builtin_amdgcn_rcpf(1.f + __expf(-v)); }
__device__ __forceinline__ float wave_sum(float v) {
#pragma unroll
    for (int o = 1; o < 64; o <<= 1) v += __shfl_xor(v, o);
    return v;
}
__device__ __forceinline__ float wave_max(float v) {
#pragma unroll
    for (int o = 1; o < 64; o <<= 1) v = fmaxf(v, __shfl_xor(v, o));
    return v;
}

namespace pg8 {
constexpr int BM = 256, BK = 64, HALF = 128, HTB = HALF * BK * 2, STAGE_BYTES = 8 * HTB, NXCD = 8, WGM = 8;
__host__ __device__ __forceinline__ int lds_byte(int r, int c) { const int st = (r >> 4) * 2 + (c >> 5), rr = r & 15, cc = c & 31, ob = rr * 64 + cc * 2; return st * 1024 + (ob ^ (((ob >> 9) & 1) << 5)); }
__host__ __device__ __forceinline__ void stage_rc(int b, int& R, int& C) { const int st = b / 1024, sb = b % 1024, swz = sb ^ (((sb >> 9) & 1) << 5); R = (st >> 1) * 16 + swz / 64; C = (st & 1) * 32 + (swz % 64) / 2; }
__host__ __device__ __forceinline__ int perm32(int rho) { const int n = rho >> 4, i = rho & 15; return 8 * (i >> 2) + 4 * n + (i & 3); }

struct Unit { int pm, pn, e, tm, cnt; };

typedef float f32x2_t __attribute__((ext_vector_type(2))); typedef __bf16 bf16x2_t __attribute__((ext_vector_type(2)));
__device__ __forceinline__ unsigned cvt_pk_bf16(float lo, float hi) { f32x2_t v = {lo, hi}; bf16x2_t b = __builtin_convertvector(v, bf16x2_t); return __builtin_bit_cast(unsigned, b); }

struct DenseOrder {
    static constexpr bool GATHER = false;
    int nM, nN, nwg, G, c; bool pf;
    __device__ void init(int M, int N, int G_, int c_, bool pf_ = false) { nM = M / BM; nN = N / BM; nwg = nM * nN; G = G_; c = c_; pf = pf_; }
    __device__ bool next(int i, Unit& u) const {
        const long L = (long)i * G + c; if (L >= nwg) return false;
        int wgid = (int)L; { const int q = nwg / NXCD, r = nwg % NXCD, xcd = wgid % NXCD, off = wgid / NXCD; wgid = (xcd < r ? xcd * (q + 1) : r * (q + 1) + (xcd - r) * q) + off; }
        const int nig = WGM * nN, gid = wgid / nig, fm = gid * WGM, gsz = (nM - fm) < WGM ? (nM - fm) : WGM;
        u.pm = fm + ((wgid % nig) % gsz); u.pn = (wgid % nig) / gsz; u.e = 0; u.tm = 0; u.cnt = 0; return true;
    }
    __device__ __forceinline__ int a_row0(const Unit& u) const { return u.pm * BM; }
    __device__ __forceinline__ int a_row(const Unit& u, int r) const { return u.pm * BM + r; }
    __device__ __forceinline__ int b_row0(const Unit& u) const { return u.pn * BM; }
    __device__ __forceinline__ bool perm(const Unit&) const { return pf; }
};

template <class Epi, class Sched>
__device__ __forceinline__ void gemm_phase(LAS unsigned char* lds, const bf16_t* Aptr, const bf16_t* Btptr, const int K, const Sched& S, const Epi& E) {
    const int tid = threadIdx.x, wid = __builtin_amdgcn_readfirstlane(tid >> 6), lane = tid & 63, wr = wid >> 2, wc = wid & 3, fr = lane & 15, fq = lane >> 4;
    const int nt = K / BK;
    int sR[2], sC[2];
    unsigned voffA[2], voffBn[2], voffBp[2], voffB[2], nvB[2];
#pragma unroll
    for (int i = 0; i < 2; ++i) { int R, C; stage_rc(tid * 16 + i * 8192, R, C); const int Rb = (R & ~31) + perm32(R & 31);
        sR[i] = R; sC[i] = C; voffA[i] = (unsigned)(R * K + C) * 2u; voffBn[i] = (unsigned)(R * K + C) * 2u; voffBp[i] = (unsigned)(Rb * K + C) * 2u; }
    const size_t kstep = (size_t)(BK * 2);
    const size_t hstep = (size_t)HALF * K * 2;
    const size_t rowb = (size_t)K * 2;
    const unsigned ldsw = (unsigned)wid * 1024u;
    const int aoff = lds_byte(wr * 64 + fr, fq * 8), boff = lds_byte(wc * 32 + fr, fq * 8);
    const char* Ab = (const char*)Aptr;
#define PG8_SA(b, h) (((b) * 2 + (h)) * HTB)
#define PG8_SB(b, h) ((4 + (b) * 2 + (h)) * HTB)
#define PG8_STAGE(bufoff, gbase, voff) do { _Pragma("unroll") for (int _i = 0; _i < 2; ++_i) \
        __builtin_amdgcn_global_load_lds((const unsigned*)((const char*)(gbase) + (voff)[_i]), (LAS unsigned*)(lds + (bufoff) + ldsw + _i * 8192), 16, 0, 0); } while (0)
#define PG8_LDA(dst, b, h) do { _Pragma("unroll") for (int m = 0; m < 4; ++m) _Pragma("unroll") for (int k = 0; k < 2; ++k) dst[m][k] = *(const LAS bf16x8*)(lds + PG8_SA(b, h) + aoff + m * 2048 + k * 1024); } while (0)
#define PG8_LDB(dst, b, h) do { _Pragma("unroll") for (int n = 0; n < 2; ++n) _Pragma("unroll") for (int k = 0; k < 2; ++k) dst[n][k] = *(const LAS bf16x8*)(lds + PG8_SB(b, h) + boff + n * 2048 + k * 1024); } while (0)
#define PG8_MMA(ai, bj, At, Bt) do { __builtin_amdgcn_s_setprio(1); _Pragma("unroll") for (int m = 0; m < 4; ++m) _Pragma("unroll") for (int n = 0; n < 2; ++n) _Pragma("unroll") for (int k = 0; k < 2; ++k) \
        acc[ai][bj][m][n] = __builtin_amdgcn_mfma_f32_16x16x32_bf16(Bt[n][k], At[m][k], acc[ai][bj][m][n], 0, 0, 0); __builtin_amdgcn_s_setprio(0); } while (0)
#define PG8_WAIT_V(n) asm volatile("s_waitcnt vmcnt(" #n ")" ::: "memory")
#define PG8_WAIT_L(n) asm volatile("s_waitcnt lgkmcnt(" #n ")" ::: "memory")
#define PG8_BAR __builtin_amdgcn_s_barrier()
#define PG8_SCHED __builtin_amdgcn_sched_barrier(0)
    Unit cur, nxt; int ui = 0;
    if (!S.next(0, cur)) return;
    f32x4 acc[2][2][4][2];
#pragma unroll
    for (int a = 0; a < 2; ++a)
#pragma unroll
        for (int b = 0; b < 2; ++b)
#pragma unroll
            for (int m = 0; m < 4; ++m)
#pragma unroll
                for (int n = 0; n < 2; ++n) acc[a][b][m][n] = (f32x4){0.f, 0.f, 0.f, 0.f};
    bf16x8 At[4][2], B0[2][2], B1[2][2];
    const char* cA = Ab; unsigned cG[2][2];
    if constexpr (Sched::GATHER) {
#pragma unroll
        for (int h = 0; h < 2; ++h)
#pragma unroll
            for (int i = 0; i < 2; ++i) cG[h][i] = (unsigned)((size_t)S.a_row(cur, h * HALF + sR[i]) * rowb) + (unsigned)sC[i] * 2u;
    } else { cA = Ab + (ptrdiff_t)S.a_row0(cur) * (ptrdiff_t)rowb; cG[0][0] = cG[0][1] = cG[1][0] = cG[1][1] = 0u; }
    const char* cB = (const char*)Btptr + (ptrdiff_t)S.b_row0(cur) * (ptrdiff_t)rowb;
    { const bool pc = S.perm(cur); voffB[0] = pc ? voffBp[0] : voffBn[0]; voffB[1] = pc ? voffBp[1] : voffBn[1]; }
#define PG8_STAGEA(bufoff, h, dbase, goffs, kb) do { if constexpr (Sched::GATHER) { PG8_STAGE(bufoff, Ab + (kb), (goffs)[h]); } else { PG8_STAGE(bufoff, (dbase) + (h) * hstep + (kb), voffA); } } while (0)
    PG8_STAGE(PG8_SB(0, 0), cB, voffB); PG8_STAGE(PG8_SB(0, 1), cB + hstep, voffB); PG8_STAGEA(PG8_SA(0, 0), 0, cA, cG, 0); PG8_STAGEA(PG8_SA(0, 1), 1, cA, cG, 0);
    if (wr == 1) PG8_BAR;
    PG8_WAIT_V(2); PG8_BAR;
    PG8_STAGE(PG8_SB(1, 0), cB + kstep, voffB); PG8_STAGEA(PG8_SA(1, 0), 0, cA, cG, kstep); PG8_STAGE(PG8_SB(1, 1), cB + hstep + kstep, voffB);
    PG8_WAIT_V(6); PG8_BAR;
    for (;;) {
        const bool has_next = S.next(ui + 1, nxt);
        const char* nA = cA; const char* nB = cB; unsigned nG[2][2];
#pragma unroll
        for (int h = 0; h < 2; ++h)
#pragma unroll
            for (int i = 0; i < 2; ++i) nG[h][i] = cG[h][i];
        nvB[0] = voffB[0]; nvB[1] = voffB[1];
        if (has_next) {
            nB = (const char*)Btptr + (ptrdiff_t)S.b_row0(nxt) * (ptrdiff_t)rowb;
            { const bool pn_ = S.perm(nxt); nvB[0] = pn_ ? voffBp[0] : voffBn[0]; nvB[1] = pn_ ? voffBp[1] : voffBn[1]; }
            if constexpr (Sched::GATHER) {
#pragma unroll
                for (int h = 0; h < 2; ++h)
#pragma unroll
                    for (int i = 0; i < 2; ++i) nG[h][i] = (unsigned)((size_t)S.a_row(nxt, h * HALF + sR[i]) * rowb) + (unsigned)sC[i] * 2u;
            } else nA = Ab + (ptrdiff_t)S.a_row0(nxt) * (ptrdiff_t)rowb;
        }
        for (int t = 0; t < nt; t += 2) {
            const bool last = (t == nt - 2);
            const size_t kb1 = (size_t)(t + 1) * kstep;
            const size_t kb2 = last ? 0 : (size_t)(t + 2) * kstep, kb3 = kb2 + kstep;
            const char* a2 = last ? nA : cA; const char* b2 = last ? nB : cB + (size_t)(t + 2) * kstep; const char* b3 = b2 + kstep;
            unsigned vB2[2]; vB2[0] = last ? nvB[0] : voffB[0]; vB2[1] = last ? nvB[1] : voffB[1];
            unsigned g2[2][2];
#pragma unroll
            for (int h = 0; h < 2; ++h)
#pragma unroll
                for (int i = 0; i < 2; ++i) g2[h][i] = last ? nG[h][i] : cG[h][i];
            PG8_LDB(B0, 0, 0); PG8_LDB(B1, 0, 1); PG8_SCHED; PG8_LDA(At, 0, 0); PG8_STAGEA(PG8_SA(1, 1), 1, cA, cG, kb1);
            PG8_WAIT_V(8); PG8_WAIT_L(0); PG8_BAR; PG8_MMA(0, 0, At, B0); PG8_MMA(0, 1, At, B1); PG8_BAR; PG8_SCHED;
            PG8_LDA(At, 0, 1); PG8_STAGE(PG8_SB(0, 0), b2, vB2); PG8_STAGE(PG8_SB(0, 1), b2 + hstep, vB2); PG8_STAGEA(PG8_SA(0, 0), 0, a2, g2, kb2);
            PG8_WAIT_V(8); PG8_WAIT_L(0); PG8_BAR; PG8_MMA(1, 0, At, B0); PG8_MMA(1, 1, At, B1); PG8_BAR; PG8_SCHED;
            PG8_LDB(B0, 1, 0); PG8_LDB(B1, 1, 1); PG8_SCHED; PG8_LDA(At, 1, 0); PG8_STAGEA(PG8_SA(0, 1), 1, a2, g2, kb2);
            PG8_WAIT_V(8); PG8_WAIT_L(0); PG8_BAR; PG8_MMA(0, 0, At, B0); PG8_MMA(0, 1, At, B1); PG8_BAR; PG8_SCHED;
            PG8_LDA(At, 1, 1); PG8_STAGE(PG8_SB(1, 0), b3, vB2); PG8_STAGE(PG8_SB(1, 1), b3 + hstep, vB2); PG8_STAGEA(PG8_SA(1, 0), 0, a2, g2, kb3);
            PG8_WAIT_V(8); PG8_WAIT_L(0); PG8_BAR; PG8_MMA(1, 0, At, B0); PG8_MMA(1, 1, At, B1); PG8_BAR; PG8_SCHED;
        }
        if (wr == 0) PG8_BAR;
        E(acc, cur, wr, wc, fr, fq);
        if (!has_next) break;
#pragma unroll
        for (int a = 0; a < 2; ++a)
#pragma unroll
            for (int b = 0; b < 2; ++b)
#pragma unroll
                for (int m = 0; m < 4; ++m)
#pragma unroll
                    for (int n = 0; n < 2; ++n) acc[a][b][m][n] = (f32x4){0.f, 0.f, 0.f, 0.f};
        cur = nxt; cA = nA; cB = nB; ++ui; voffB[0] = nvB[0]; voffB[1] = nvB[1];
#pragma unroll
        for (int h = 0; h < 2; ++h)
#pragma unroll
            for (int i = 0; i < 2; ++i) cG[h][i] = nG[h][i];
        if (wr == 1) PG8_BAR;
    }
    PG8_WAIT_V(0);
    PG8_BAR;
#undef PG8_SA
#undef PG8_SB
#undef PG8_STAGE
#undef PG8_STAGEA
#undef PG8_LDA
#undef PG8_LDB
#undef PG8_MMA
#undef PG8_WAIT_V
#undef PG8_WAIT_L
#undef PG8_BAR
#undef PG8_SCHED
}
}

#define XB_TMO      128
#define XB_XCNT(j)  (256  + 64 * (j))
#define XB_XSUB(j)  (1280 + 64 * (j))
#define XB_XGEN(j)  (2304 + 64 * (j))
#define XB_TOP      3328
#define XB_TOPGEN   3392
#define XCD_BAR_WORDS 3456
#define XB_SPIN_CAP (1u << 18)
__device__ __forceinline__ unsigned xb_ld(unsigned* p)              { return __hip_atomic_load(p, __ATOMIC_RELAXED, __HIP_MEMORY_SCOPE_AGENT); }
__device__ __forceinline__ unsigned xb_add(unsigned* p, unsigned v) { return __hip_atomic_fetch_add(p, v, __ATOMIC_RELAXED, __HIP_MEMORY_SCOPE_AGENT); }
__device__ __forceinline__ unsigned xb_xcc_id() { return (unsigned)__builtin_amdgcn_s_getreg((3 << 11) | 20) & 0xFu; }
#define XB_SPIN(cond, bar) do { unsigned _sp = 0; while (cond) { __builtin_amdgcn_s_sleep(1); \
    if ((++_sp & 255u) == 0u) { if (xb_ld(&(bar)[XB_TMO])) break; if (_sp > XB_SPIN_CAP) { atomicAdd(&(bar)[XB_TMO], 1u); break; } } } } while (0)
struct XcdBarrier { unsigned* bar; unsigned x; volatile LAS unsigned* st; };
__device__ __forceinline__ XcdBarrier xcd_barrier_post(unsigned* bar, volatile LAS unsigned* st) {
    XcdBarrier b; b.bar = bar; b.x = xb_xcc_id(); b.st = st;
    if (threadIdx.x == 0) (void)xb_add(&bar[XB_XCNT(b.x)], 1u);
    return b;
}
__device__ __forceinline__ void xcd_barrier_complete(unsigned* bar, unsigned x, unsigned& nloc, unsigned& nx) {
    const unsigned G = gridDim.x * gridDim.y * gridDim.z;
    unsigned sum, cnt, mine, sp = 0u;
    for (;;) {
        sum = 0u; cnt = 0u; mine = 0u;
#pragma unroll
        for (unsigned j = 0; j < 16; ++j) { const unsigned c = xb_ld(&bar[XB_XCNT(j)]); sum += c; cnt += (c > 0u) ? 1u : 0u; mine = (j == x) ? c : mine; }
        if (sum == G) break;
        __builtin_amdgcn_s_sleep(1);
        if ((++sp & 255u) == 0u) { if (xb_ld(&bar[XB_TMO])) break; if (sp > XB_SPIN_CAP) { atomicAdd(&bar[XB_TMO], 1u); break; } }
    }
    nloc = mine > 0u ? mine : 1u; nx = cnt > 0u ? cnt : 1u;
}
__device__ __forceinline__ void xcd_barrier(const XcdBarrier& b) {
    asm volatile("s_waitcnt vmcnt(0)" ::: "memory");
    __syncthreads();
    if (threadIdx.x == 0) {
        unsigned* bar = b.bar;
        __builtin_amdgcn_s_waitcnt(0);
        unsigned nloc = b.st[0], nx = b.st[1];
        if (nloc == 0u) { xcd_barrier_complete(bar, b.x, nloc, nx); b.st[0] = nloc; b.st[1] = nx; }
        const unsigned old = xb_add(&bar[XB_XSUB(b.x)], 1u);
        const unsigned gen = old / nloc;
        if (old + 1u == (gen + 1u) * nloc) {
            __builtin_amdgcn_fence(__ATOMIC_RELEASE, "agent");
            asm volatile("s_waitcnt vmcnt(0)" ::: "memory");
            const unsigned og = xb_add(&bar[XB_TOP], 1u);
            const unsigned tg = og / nx;
            if (og + 1u == (tg + 1u) * nx) xb_add(&bar[XB_TOPGEN], 1u);
            else XB_SPIN(xb_ld(&bar[XB_TOPGEN]) == tg, bar);
            __builtin_amdgcn_fence(__ATOMIC_ACQUIRE, "agent");
            xb_add(&bar[XB_XGEN(b.x)], 1u);
            asm volatile("s_waitcnt vmcnt(0)" ::: "memory");
        } else {
            XB_SPIN(xb_ld(&bar[XB_XGEN(b.x)]) == gen, bar);
            __builtin_amdgcn_fence(__ATOMIC_ACQUIRE, "agent");
            asm volatile("s_waitcnt vmcnt(0)" ::: "memory");
        }
    }
    __syncthreads();
}

using pg8::Unit;
typedef f32x4 acc_t[2][2][4][2];

struct EpiProj {
    static constexpr bool PERM = false;
    unsigned char* ws; const LAS float* ropeL; const LAS float* lbtL; int skip;
    template <int KIND> __device__ __forceinline__ void swapped(const acc_t& acc, const Unit& u, int wr, int wc, int fr, int fq, bool latent) const {
        constexpr size_t so2 = KIND == 0 ? WS_V : KIND == 1 ? WS_HQ : KIND == 2 ? WS_HI : KIND == 3 ? WS_LF : WS_LB;
        bf16* dT = (bf16*)(ws + so2);
        constexpr int ldt = (KIND == 1) ? T : MROWS;
        const int wrow0 = (u.pn & 1) * 256 + wr * 64 + fr, tcol0 = u.pm * 256 + wc * 32 + 8 * fq;
        const LAS float* lbt = lbtL + (KIND == 4 ? 512 : 0);
#pragma unroll
        for (int ai = 0; ai < 2; ++ai)
#pragma unroll
            for (int m = 0; m < 4; ++m) { const int wrow = wrow0 + ai * 128 + m * 16; float lb = 0.f; if (KIND >= 3) lb = lbt[wrow];
#pragma unroll
                for (int bj = 0; bj < 2; ++bj) { float x[8]; u32x4 w;
#pragma unroll
                    for (int j = 0; j < 4; ++j) { x[j] = acc[ai][bj][m][0][j]; x[4 + j] = acc[ai][bj][m][1][j]; }
                    if (KIND >= 3) {
#pragma unroll
                        for (int j = 0; j < 8; ++j) { const float sg = __builtin_amdgcn_rcpf(1.f + __expf(-x[j])); x[j] = __log2f(lb + (1.f - lb) * sg); }
                        w = (u32x4){pkh2(x[0], x[1]), pkh2(x[2], x[3]), pkh2(x[4], x[5]), pkh2(x[6], x[7])}; }
                    else { if (KIND == 1) {
#pragma unroll
                            for (int j = 0; j < 8; ++j) x[j] = silu_f(x[j]); }
                        w = (u32x4){pg8::cvt_pk_bf16(x[0], x[1]), pg8::cvt_pk_bf16(x[2], x[3]), pg8::cvt_pk_bf16(x[4], x[5]), pg8::cvt_pk_bf16(x[6], x[7])}; }
                    size_t off = (size_t)wrow * ldt + tcol0 + bj * 128;
                    if (KIND == 0) { const int tc = tcol0 + bj * 128, bb_ = latent ? (tc >> 11) : ((tc - T) >> 8), tl = latent ? (tc & (SEQ - 1)) : (KTOK - LC + ((tc - T) & (LC - 1)));
                        off = ((((size_t)(bb_ * NAH + (wrow >> 6)) * (KTOK / 64) + (tl >> 6)) * NAD + (wrow & 63)) * 64) + (tl & 63); }
                    *(u32x4*)(dT + off) = w; } }
    }
    template <int SEG, bool LAT> __device__ __forceinline__ void rope(const acc_t& acc, int row0, int lcp, int wc, int fq) const {
        bf16* dK = (bf16*)(ws + (SEG == 0 ? WS_QR : WS_K)); bf16* dQ = (bf16*)(ws + WS_Q);
#pragma unroll
        for (int ai = 0; ai < 2; ++ai)
#pragma unroll
            for (int m = 0; m < 4; ++m) { const int row = row0 + ai * 128 + m * 16, sq = row & (SEQ - 1); const int pos = (wc & 1) ? (sq & 63) : (sq >> 6);
                f32x4 cs0 = (f32x4){1.f, 0.f, 1.f, 0.f}, cs1 = cs0;
                if (LAT) { cs0 = *(const LAS f32x4*)(ropeL + (pos * 16 + 4 * fq) * 2); cs1 = *(const LAS f32x4*)(ropeL + (pos * 16 + 4 * fq) * 2 + 4); }
                const float cc[4] = {cs0[0], cs0[2], cs1[0], cs1[2]}, sn[4] = {cs0[1], cs0[3], cs1[1], cs1[3]};
#pragma unroll
                for (int bj = 0; bj < 2; ++bj) { const f32x4 x1 = acc[ai][bj][m][0], x2 = acc[ai][bj][m][1]; float o1[4], o2[4];
#pragma unroll
                    for (int j = 0; j < 4; ++j) { o1[j] = LAT ? x1[j] * cc[j] - x2[j] * sn[j] : x1[j]; o2[j] = LAT ? x2[j] * cc[j] + x1[j] * sn[j] : x2[j]; }
                    size_t off = (size_t)row * SEGW + lcp + bj * 128;
                    if (SEG == 0) *(u32x4*)(dQ + off) = (u32x4){pg8::cvt_pk_bf16(x1[0], x1[1]), pg8::cvt_pk_bf16(x1[2], x1[3]), pg8::cvt_pk_bf16(x2[0], x2[1]), pg8::cvt_pk_bf16(x2[2], x2[3])};
                    else { const int cf = lcp + bj * 128, bb_ = LAT ? (row >> 11) : ((row - T) >> 8), tl = LAT ? sq : (KTOK - LC + ((row - T) & (LC - 1)));
                        off = ((size_t)(bb_ * NAH + (cf >> 6)) * KTOK + tl) * NAD + (cf & 63); }
                    *(u32x4*)(dK + off) = (u32x4){pg8::cvt_pk_bf16(o1[0], o1[1]), pg8::cvt_pk_bf16(o1[2], o1[3]), pg8::cvt_pk_bf16(o2[0], o2[1]), pg8::cvt_pk_bf16(o2[2], o2[3])}; } }
    }
    __device__ __forceinline__ void operator()(const acc_t& acc, const Unit& u, int wr, int wc, int fr, int fq) const {
        const int seg = u.pn >> 1; const bool latent = u.pm < (T / 256);
        if (skip) return;
        if (!latent && (seg == 0 || seg == 3 || seg == 7)) return;
        if (u.e) {
            if (seg == 2) swapped<0>(acc, u, wr, wc, fr, fq, latent);
            else if (seg == 3) swapped<1>(acc, u, wr, wc, fr, fq, latent);
            else if (seg == 4) swapped<2>(acc, u, wr, wc, fr, fq, latent);
            else if (seg == 5) swapped<3>(acc, u, wr, wc, fr, fq, latent);
            else swapped<4>(acc, u, wr, wc, fr, fq, latent);
            return;
        }
        const int row0 = u.pm * 256 + wr * 64 + fr;
        const int lcp = (u.pn & 1) * 256 + wc * 32 + 8 * fq;
        if (seg <= 1) {
            if (seg == 0) rope<0, true>(acc, row0, lcp, wc, fq);
            else if (latent) rope<1, true>(acc, row0, lcp, wc, fq);
            else rope<1, false>(acc, row0, lcp, wc, fq);
            return;
        }
        bf16* dG = (bf16*)(ws + WS_G);
#pragma unroll
        for (int ai = 0; ai < 2; ++ai)
#pragma unroll
            for (int m = 0; m < 4; ++m) { const int row = row0 + ai * 128 + m * 16;
#pragma unroll
                for (int bj = 0; bj < 2; ++bj) { float x[8];
#pragma unroll
                    for (int j = 0; j < 4; ++j) { x[j] = silu_f(acc[ai][bj][m][0][j]); x[4 + j] = silu_f(acc[ai][bj][m][1][j]); }
                    *(u32x4*)(dG + (size_t)row * SEGW + lcp + bj * 128) = (u32x4){pg8::cvt_pk_bf16(x[0], x[1]), pg8::cvt_pk_bf16(x[2], x[3]), pg8::cvt_pk_bf16(x[4], x[5]), pg8::cvt_pk_bf16(x[6], x[7])}; } }
    }
};
struct EpiP {
    static constexpr bool PERM = true;
    bf16* P;
    __device__ __forceinline__ void operator()(const acc_t& acc, const Unit& u, int wr, int wc, int fr, int fq) const {
        const int col0 = u.pn * 256 + wc * 32 + 8 * fq; const int row0 = u.pm * 256 + wr * 64 + fr;
#pragma unroll
        for (int ai = 0; ai < 2; ++ai)
#pragma unroll
            for (int m = 0; m < 4; ++m)
#pragma unroll
                for (int bj = 0; bj < 2; ++bj) { const f32x4 v0 = acc[ai][bj][m][0], v1 = acc[ai][bj][m][1];
                    *(u32x4*)(P + (size_t)(row0 + ai * 128 + m * 16) * D + col0 + bj * 128) = (u32x4){pg8::cvt_pk_bf16(v0[0], v0[1]), pg8::cvt_pk_bf16(v0[2], v0[3]), pg8::cvt_pk_bf16(v1[0], v1[1]), pg8::cvt_pk_bf16(v1[2], v1[3])}; }
    }
};
struct EpiSwiGLU {
    static constexpr bool PERM = true;
    bf16* H;
    __device__ __forceinline__ void operator()(const acc_t& acc, const Unit& u, int wr, int wc, int fr, int fq) const {
        const int hc = u.pn * 128 + wc * 32 + 8 * fq; const int row0 = u.pm * 256 + wr * 64 + fr;
#pragma unroll
        for (int ai = 0; ai < 2; ++ai)
#pragma unroll
            for (int m = 0; m < 4; ++m) { float h[8];
#pragma unroll
                for (int n = 0; n < 2; ++n)
#pragma unroll
                    for (int j = 0; j < 4; ++j) h[n * 4 + j] = silu_f(acc[ai][0][m][n][j]) * acc[ai][1][m][n][j];
                u32x4 w; w.x = pg8::cvt_pk_bf16(h[0], h[1]); w.y = pg8::cvt_pk_bf16(h[2], h[3]); w.z = pg8::cvt_pk_bf16(h[4], h[5]); w.w = pg8::cvt_pk_bf16(h[6], h[7]);
                *(u32x4*)(H + (size_t)(row0 + ai * 128 + m * 16) * DE + hc) = w; }
    }
};
struct EpiMoeOut {
    static constexpr bool PERM = true;
    bf16* Y; const int* elist; const float* ewt;
    __device__ __forceinline__ void operator()(const acc_t& acc, const Unit& u, int wr, int wc, int fr, int fq) const {
        const int col0 = u.pn * 256 + wc * 32 + 8 * fq;
#pragma unroll
        for (int ai = 0; ai < 2; ++ai)
#pragma unroll
            for (int m = 0; m < 4; ++m) { const int rank = u.tm * 256 + ai * 128 + wr * 64 + m * 16 + fr;
                if (rank < u.cnt) { const int tk = elist[u.e * ECAP + rank]; const float w = ewt[u.e * ECAP + rank];
#pragma unroll
                    for (int bj = 0; bj < 2; ++bj) { const f32x4 v0 = acc[ai][bj][m][0] * w, v1 = acc[ai][bj][m][1] * w; u32x4 o;
                        o.x = pg8::cvt_pk_bf16(v0[0], v0[1]); o.y = pg8::cvt_pk_bf16(v0[2], v0[3]); o.z = pg8::cvt_pk_bf16(v1[0], v1[1]); o.w = pg8::cvt_pk_bf16(v1[2], v1[3]);
                        *(u32x4*)(Y + (size_t)tk * D + col0 + bj * 128) = o; } } }
    }
};
template <bool GATHER_> struct MoeOrder {
    static constexpr bool GATHER = GATHER_;
    const LAS int* tp; const int* elist; int G, c, nwg;
    __device__ bool next(int i, Unit& u) const {
        const long L = (long)i * G + c; if (L >= nwg) return false;
        int wgid = (int)L; { const int q = nwg / 8, r = nwg % 8, xcd = wgid % 8, off = wgid / 8; wgid = (xcd < r ? xcd * (q + 1) : r * (q + 1) + (xcd - r) * q) + off; }
        const int gt = wgid >> 2; int e = 0;
#pragma unroll
        for (int k = 1; k < 16; ++k) e = (gt >= tp[k]) ? k : e;
        u.pm = gt; u.pn = wgid & 3; u.e = e; u.tm = gt - tp[e]; u.cnt = tp[17 + e]; return true;
    }
    __device__ __forceinline__ int a_row0(const Unit& u) const { return u.pm * 256; }
    __device__ __forceinline__ int a_row(const Unit& u, int r) const {
        if constexpr (GATHER_) { int rank = u.tm * 256 + r; rank = rank < u.cnt ? rank : u.cnt - 1; return elist[u.e * ECAP + rank] >> 1; }
        else return u.pm * 256 + r;
    }
    __device__ __forceinline__ int b_row0(const Unit& u) const { return u.e * 1024 + u.pn * 256; }
    __device__ __forceinline__ bool perm(const Unit&) const { return true; }
};


constexpr int SWMASK = 0x7C;
constexpr int W_REL_XN = (int)(((long long)WS_WINT - (long long)WS_XN) / 2048);
struct ProjOrder {
    static constexpr bool GATHER = false;
    pg8::DenseOrder d;
    __device__ void init(int G_, int c_) { d.init(MROWS, INCOLS, G_, c_); }
    __device__ bool next(int i, Unit& u) const { if (!d.next(i, u)) return false; u.e = (SWMASK >> (u.pn >> 1)) & 1; return true; }
    __device__ __forceinline__ int a_row0(const Unit& u) const { return u.e ? W_REL_XN + u.pn * 256 : u.pm * 256; }
    __device__ __forceinline__ int a_row(const Unit& u, int r) const { return a_row0(u) + r; }
    __device__ __forceinline__ int b_row0(const Unit& u) const { return u.e ? -W_REL_XN + u.pm * 256 : u.pn * 256; }
    __device__ __forceinline__ bool perm(const Unit& u) const { return (u.pn >> 1) >= 2; }
};


__device__ __forceinline__ bf16x8 pack8(const f32x4& a, const f32x4& b) {
    u32x4 w; w.x = pg8::cvt_pk_bf16(a[0], a[1]); w.y = pg8::cvt_pk_bf16(a[2], a[3]); w.z = pg8::cvt_pk_bf16(b[0], b[1]); w.w = pg8::cvt_pk_bf16(b[2], b[3]);
    return __builtin_bit_cast(bf16x8, w);
}
typedef unsigned bu4 __attribute__((__vector_size__(16)));
__device__ __forceinline__ bf16x8 bload16(__amdgpu_buffer_rsrc_t r, unsigned voff, unsigned soff) { return __builtin_bit_cast(bf16x8, __builtin_amdgcn_raw_buffer_load_b128(r, (int)voff, (int)soff, 0)); }
#define NA_SB() __builtin_amdgcn_sched_barrier(0)
__device__ __forceinline__ bf16x8 sel8(bool c, const bf16x8 a, const bf16x8 b) { const u32x4 x = __builtin_bit_cast(u32x4, a), y = __builtin_bit_cast(u32x4, b); u32x4 r;
    r.x = c ? x.x : y.x; r.y = c ? x.y : y.y; r.z = c ? x.z : y.z; r.w = c ? x.w : y.w; return __builtin_bit_cast(bf16x8, r); }
__device__ __forceinline__ void na_row(int b, int h, int r, const bf16* Q, const bf16* QR, __amdgpu_buffer_rsrc_t srdK, __amdgpu_buffer_rsrc_t srdV, bf16* MIX, const LAS float* rpbL, LAS unsigned char* qL, int lane) {
    const int qi = lane & 15, g = lane >> 4, rg = qi >> 2;
    constexpr float SC = 0.125f * 1.44269504f; const float NEG = -1e30f;
    int rs = r - 4; rs = rs < 0 ? 0 : (rs > NROWS - 8 ? NROWS - 8 : rs);
    const int tok0 = b * SEQ + r * GW;
    const unsigned klane = (unsigned)((8 * rg + (qi & 3)) * NAD + 8 * g) * 2u;
    const unsigned vlane = (unsigned)(qi * 64 + 8 * g) * 2u;
    const bool selK1 = (rg == 0), selK2 = (rg != 3), selV1 = (g == 0), selV2 = (g != 3);
#define NA_P0(j) ((j) == 0 ? 0 : (j) == 1 ? 1 : (j) == 2 ? 3 : 4)
#define NA_BB(j) (8 * (NA_P0(j) + ((g - NA_P0(j)) & 3)) - (16 * (j) + qi) + 31)
#define NA_LO(j) (((j) == 0 ? (qi < 8 ? 31 - qi : 23) : (j) == 3 ? (qi > 8 ? 31 - qi : 23) : 23) - NA_BB(j))
    f32x4 o[4][4]; float mref[4], lsum[4];
#pragma unroll
    for (int j = 0; j < 4; ++j) { mref[j] = 0.f; lsum[j] = 0.f;
#pragma unroll
        for (int dt = 0; dt < 4; ++dt) o[j][dt] = (f32x4){0.f, 0.f, 0.f, 0.f}; }
    bf16x8 kf[2][2][2], vf[2][4], Bp[4];
    LAS bf16x8* qs = (LAS bf16x8*)qL + lane;
#pragma unroll
    for (int j = 0; j < 4; ++j) { const bf16* qp = QR + (size_t)(tok0 + 16 * j + qi) * SEGW + h * NAD + 8 * g; qs[(2 * j) * 64] = *(const bf16x8*)qp; qs[(2 * j + 1) * 64] = *(const bf16x8*)(qp + 32); }
    const unsigned bh = (unsigned)(b * NAH + h);
    const unsigned ks0 = (bh * KTOK + (unsigned)(rs * GW)) * (NAD * 2u), vs0 = (bh * (KTOK / 64) + (unsigned)rs) * (NAD * 64 * 2u);
#define NA_KLD(so) do { _Pragma("unroll") for (int H = 0; H < 2; ++H) _Pragma("unroll") for (int m = 0; m < 2; ++m) _Pragma("unroll") for (int k = 0; k < 2; ++k) \
        kf[H][m][k] = bload16(srdK, klane, (so) + (unsigned)(H * 32 * NAD * 2 + m * 4 * NAD * 2 + k * 64)); } while (0)
#define NA_VLD(so) do { _Pragma("unroll") for (int H = 0; H < 2; ++H) _Pragma("unroll") for (int dt = 0; dt < 4; ++dt) \
        vf[H][dt] = bload16(srdV, vlane, (so) + (unsigned)(H * 64) + (unsigned)dt * (16 * 64 * 2)); } while (0)
    NA_KLD(ks0); NA_VLD(vs0);
    const LAS float* bp0 = rpbL + (h * 15 + rs - r + 7) * 64;
#pragma unroll 1
    for (int i = 0; i < 8; ++i) {
        const LAS float* bpi = bp0 + i * 64;
        NA_SB();
#pragma unroll
        for (int j = 0; j < 4; ++j) {
            f32x4 s0, s1; const bf16x8 q0 = qs[(2 * j) * 64], q1 = qs[(2 * j + 1) * 64];
            { const bf16x8 a00 = (j == 0) ? kf[0][0][0] : (j == 3) ? kf[1][0][0] : sel8(j == 1 ? selK1 : selK2, kf[1][0][0], kf[0][0][0]);
              const bf16x8 a01 = (j == 0) ? kf[0][0][1] : (j == 3) ? kf[1][0][1] : sel8(j == 1 ? selK1 : selK2, kf[1][0][1], kf[0][0][1]);
              const bf16x8 a10 = (j == 0) ? kf[0][1][0] : (j == 3) ? kf[1][1][0] : sel8(j == 1 ? selK1 : selK2, kf[1][1][0], kf[0][1][0]);
              const bf16x8 a11 = (j == 0) ? kf[0][1][1] : (j == 3) ? kf[1][1][1] : sel8(j == 1 ? selK1 : selK2, kf[1][1][1], kf[0][1][1]);
              s0 = __builtin_amdgcn_mfma_f32_16x16x32_bf16(a00, q0, (f32x4){0.f, 0.f, 0.f, 0.f}, 0, 0, 0); s0 = __builtin_amdgcn_mfma_f32_16x16x32_bf16(a01, q1, s0, 0, 0, 0);
              s1 = __builtin_amdgcn_mfma_f32_16x16x32_bf16(a10, q0, (f32x4){0.f, 0.f, 0.f, 0.f}, 0, 0, 0); s1 = __builtin_amdgcn_mfma_f32_16x16x32_bf16(a11, q1, s1, 0, 0, 0); }
            const int lo_j = NA_LO(j); const LAS float* bpj = bpi + NA_BB(j);
            { float b0 = bpj[0], b1 = bpj[1], b2 = bpj[2], b3 = bpj[3];
              asm volatile("" : "+v"(b0), "+v"(b1), "+v"(b2), "+v"(b3));
              const float bq[4] = {b0, b1, b2, b3};
#pragma unroll
              for (int e = 0; e < 4; ++e) { const float t0 = s0[e] * SC + bq[e]; s0[e] = ((unsigned)(e - lo_j) < 16u) ? t0 : NEG; } }
            { float b0 = bpj[4], b1 = bpj[5], b2 = bpj[6], b3 = bpj[7];
              asm volatile("" : "+v"(b0), "+v"(b1), "+v"(b2), "+v"(b3));
              const float bq[4] = {b0, b1, b2, b3};
#pragma unroll
              for (int e = 0; e < 4; ++e) { const float t1 = s1[e] * SC + bq[e]; s1[e] = ((unsigned)(4 + e - lo_j) < 16u) ? t1 : NEG; } }
            if (i == 0) { float mx = fmaxf(fmaxf(fmaxf(s0[0], s0[1]), fmaxf(s0[2], s0[3])), fmaxf(fmaxf(s1[0], s1[1]), fmaxf(s1[2], s1[3])));
                mx = fmaxf(mx, __shfl_xor(mx, 16)); mx = fmaxf(mx, __shfl_xor(mx, 32)); mref[j] = mx; }
            float ps = 0.f;
#pragma unroll
            for (int e = 0; e < 4; ++e) { s0[e] = __builtin_amdgcn_exp2f(fminf(s0[e] - mref[j], 100.f)); s1[e] = __builtin_amdgcn_exp2f(fminf(s1[e] - mref[j], 100.f)); ps += s0[e] + s1[e]; }
            lsum[j] += ps; Bp[j] = pack8(s0, s1);
            if (j == 1) { asm volatile("" : "+v"(Bp[0]), "+v"(Bp[1])); NA_SB(); }
        }
        asm volatile("" : "+v"(Bp[0]), "+v"(Bp[1]), "+v"(Bp[2]), "+v"(Bp[3]));
        NA_SB();
        if (i < 7) NA_KLD(ks0 + (unsigned)(i + 1) * (GW * NAD * 2));
        NA_SB();
#pragma unroll
        for (int j = 0; j < 4; ++j) {
#pragma unroll
            for (int dt = 0; dt < 4; ++dt) { const bf16x8 A = (j == 0) ? vf[0][dt] : (j == 3) ? vf[1][dt] : sel8(j == 1 ? selV1 : selV2, vf[1][dt], vf[0][dt]);
                o[j][dt] = __builtin_amdgcn_mfma_f32_16x16x32_bf16(A, Bp[j], o[j][dt], 0, 0, 0); }
            asm volatile("" : "+v"(o[j][0]), "+v"(o[j][1]), "+v"(o[j][2]), "+v"(o[j][3]));
            if (j == 1) NA_SB(); }
        NA_SB();
        if (i < 7) NA_VLD(vs0 + (unsigned)(i + 1) * (NAD * 64 * 2));
    }
#pragma unroll
    for (int j = 0; j < 4; ++j) { const bf16* qp = Q + (size_t)(tok0 + 16 * j + qi) * SEGW + h * NAD + 8 * g; qs[(2 * j) * 64] = *(const bf16x8*)qp; qs[(2 * j + 1) * 64] = *(const bf16x8*)(qp + 32); }
    const unsigned kc0 = (bh * KTOK + (unsigned)SEQ) * (NAD * 2u), vc0 = (bh * (KTOK / 64) + (unsigned)(SEQ / 64)) * (NAD * 64 * 2u);
#define NA_KLDC(so) do { _Pragma("unroll") for (int m = 0; m < 2; ++m) _Pragma("unroll") for (int k = 0; k < 2; ++k) kf[0][m][k] = bload16(srdK, klane, (so) + (unsigned)(m * 4 * NAD * 2 + k * 64)); } while (0)
#define NA_VLDC(so) do { _Pragma("unroll") for (int dt = 0; dt < 4; ++dt) vf[0][dt] = bload16(srdV, vlane, (so) + (unsigned)dt * (16 * 64 * 2)); } while (0)
    NA_KLDC(kc0); NA_VLDC(vc0);
#pragma unroll 1
    for (int i = 0; i < 8; ++i) {
        NA_SB();
#pragma unroll
        for (int j = 0; j < 4; ++j) {
            const bf16x8 q0 = qs[(2 * j) * 64], q1 = qs[(2 * j + 1) * 64];
            f32x4 s0 = __builtin_amdgcn_mfma_f32_16x16x32_bf16(kf[0][0][0], q0, (f32x4){0.f, 0.f, 0.f, 0.f}, 0, 0, 0); s0 = __builtin_amdgcn_mfma_f32_16x16x32_bf16(kf[0][0][1], q1, s0, 0, 0, 0);
            f32x4 s1 = __builtin_amdgcn_mfma_f32_16x16x32_bf16(kf[0][1][0], q0, (f32x4){0.f, 0.f, 0.f, 0.f}, 0, 0, 0); s1 = __builtin_amdgcn_mfma_f32_16x16x32_bf16(kf[0][1][1], q1, s1, 0, 0, 0);
            float ps = 0.f;
#pragma unroll
            for (int e = 0; e < 4; ++e) { s0[e] = __builtin_amdgcn_exp2f(fminf(s0[e] * SC - mref[j], 100.f)); s1[e] = __builtin_amdgcn_exp2f(fminf(s1[e] * SC - mref[j], 100.f)); ps += s0[e] + s1[e]; }
            lsum[j] += ps; Bp[j] = pack8(s0, s1);
        }
        asm volatile("" : "+v"(Bp[0]), "+v"(Bp[1]), "+v"(Bp[2]), "+v"(Bp[3]));
        NA_SB();
        if (i < 7) NA_KLDC(kc0 + (unsigned)(i + 1) * (32 * NAD * 2));
        NA_SB();
#pragma unroll
        for (int j = 0; j < 4; ++j)
#pragma unroll
            for (int dt = 0; dt < 4; ++dt) o[j][dt] = __builtin_amdgcn_mfma_f32_16x16x32_bf16(vf[0][dt], Bp[j], o[j][dt], 0, 0, 0);
#pragma unroll
        for (int j = 0; j < 4; ++j) asm volatile("" : "+v"(o[j][0]), "+v"(o[j][1]), "+v"(o[j][2]), "+v"(o[j][3]));
        NA_SB();
        if (i < 7) NA_VLDC(vc0 + (unsigned)(((i + 1) >> 1) * (NAD * 64 * 2) + ((i + 1) & 1) * 64));
    }
#undef NA_KLD
#undef NA_VLD
#undef NA_KLDC
#undef NA_VLDC
#pragma unroll
    for (int j = 0; j < 4; ++j) { float l = lsum[j]; l += __shfl_xor(l, 16); l += __shfl_xor(l, 32); const float inv = 1.f / l;
        bf16* op = MIX + (size_t)(tok0 + 16 * j + qi) * D + h * NAD + 4 * g;
#pragma unroll
        for (int dt = 0; dt < 4; ++dt) { const f32x4 v = o[j][dt] * inv; *(v2u*)(op + 16 * dt) = (v2u){pg8::cvt_pk_bf16(v[0], v[1]), pg8::cvt_pk_bf16(v[2], v[3])}; } }
}

typedef float f32x16 __attribute__((ext_vector_type(16)));
constexpr int SC_Q1 = 0, SC_K1 = SC_Q1 + 64 * 272, SC_K1T = SC_K1 + 64 * 272, SC_VT = SC_K1T + 128 * 144, SC_ST = SC_VT + 128 * 144, SC_TOT = SC_ST + 128 * 272, SC_CST = SC_TOT + 2 * 4 * 128 * 4, SC_END = SC_CST + 2 * 128 * 4;
static_assert(SC_END <= RING_BYTES, "scan LDS");
#define SCAN_MFMA(a, b, c) __builtin_amdgcn_mfma_f32_32x32x16_bf16(a, b, c, 0, 0, 0)
__device__ __forceinline__ void scan_unit(LAS unsigned char* lds, int b, int h, int dir, const unsigned short* LGT, const bf16* HQT, const bf16* HIT, bf16* OUT, int tid) {
    const int lane = tid & 63, w = __builtin_amdgcn_readfirstlane(tid >> 6), r = lane & 31, hh = lane >> 5;
    const int d = tid & 127, tq = tid >> 7;
    const int ti = w >> 2, ovi = w & 3;
    const int di = w >> 1, svi = 2 * (w & 1);
    f32x16 S0, S1;
#pragma unroll
    for (int i = 0; i < 16; ++i) { S0[i] = 0.f; S1[i] = 0.f; }
    const size_t chrow = (size_t)(h * HGD + d);
    constexpr int NCH = (LC + SEQ) / 64;
    auto col_of = [&](int c) -> int { return c < 4 ? (T + b * LC + 64 * (dir ? 3 - c : c)) : (b * SEQ + (dir ? SEQ - 64 * (c - 3) : 64 * (c - 4))); };
    LAS float* totb = (LAS float*)(lds + SC_TOT); LAS float* cst = (LAS float*)(lds + SC_CST);
    u32x4 lg0[2], lg1[2], vr[2], qr[2];
    { const int c0 = col_of(0) + 16 * tq, c1 = col_of(1) + 16 * tq;
      lg0[0] = *(const u32x4*)(LGT + chrow * MROWS + c0); lg0[1] = *(const u32x4*)(LGT + chrow * MROWS + c0 + 8);
      lg1[0] = *(const u32x4*)(LGT + chrow * MROWS + c1); lg1[1] = *(const u32x4*)(LGT + chrow * MROWS + c1 + 8);
      vr[0] = *(const u32x4*)(HIT + chrow * MROWS + c0); vr[1] = *(const u32x4*)(HIT + chrow * MROWS + c0 + 8); qr[0] = qr[1] = (u32x4){0u, 0u, 0u, 0u};
      float sm = 0.f;
#pragma unroll
      for (int i = 0; i < 8; ++i) { const unsigned u2 = lg0[i >> 2][i & 3]; sm += h2f((unsigned short)(u2 & 0xffff)) + h2f((unsigned short)(u2 >> 16)); }
      totb[tq * 128 + d] = sm; }
    __syncthreads();
#pragma unroll 1
    for (int c = 0; c < NCH; ++c) {
        const bool lat = c >= 4; const int par = c & 1;
        LAS float* tot = totb + par * 512;
        {
            float P[16], kk[16];
#pragma unroll
            for (int i = 0; i < 8; ++i) { const unsigned u2 = lg0[i >> 2][i & 3]; P[2 * i] = h2f((unsigned short)(u2 & 0xffff)); P[2 * i + 1] = h2f((unsigned short)(u2 >> 16)); }
#pragma unroll
            for (int i = 0; i < 16; ++i) kk[i] = 1.f - __builtin_amdgcn_exp2f(P[i]);
            if (!dir) {
#pragma unroll
                for (int i = 1; i < 16; ++i) P[i] += P[i - 1];
            } else {
#pragma unroll
                for (int i = 14; i >= 0; --i) P[i] += P[i + 1];
            }
            const float t0 = tot[d], t1 = tot[128 + d], t2 = tot[256 + d], t3 = tot[384 + d];
            const float Bm = dir ? (t2 + t3) : (t0 + t1);
            float offs; if (!dir) offs = (tq > 0 ? t0 : 0.f) + (tq > 1 ? t1 : 0.f) + (tq > 2 ? t2 : 0.f); else offs = (tq < 3 ? t3 : 0.f) + (tq < 2 ? t2 : 0.f) + (tq < 1 ? t1 : 0.f);
            const float sh = offs - Bm;
            if (tq == 0) { const float be = (t0 + t1) + (t2 + t3); cst[d] = __builtin_amdgcn_exp2f(be); cst[128 + d] = __builtin_amdgcn_exp2f(be - Bm); }
            unsigned kt[8];
            LAS bf16* q1 = (LAS bf16*)(lds + SC_Q1) + (16 * tq) * 136 + d; LAS bf16* k1 = (LAS bf16*)(lds + SC_K1) + (16 * tq) * 136 + d;
#pragma unroll
            for (int i = 0; i < 16; i += 2) {
                const float x0 = fminf(fmaxf(P[i] + sh, -120.f), 120.f), x1 = fminf(fmaxf(P[i + 1] + sh, -120.f), 120.f);
                const float k0 = kk[i] * __builtin_amdgcn_exp2f(-x0), k1v = kk[i + 1] * __builtin_amdgcn_exp2f(-x1);
                kt[i >> 1] = pg8::cvt_pk_bf16(k0, k1v);
                if (lat) { const unsigned qq = (i < 8 ? qr[0] : qr[1])[(i >> 1) & 3];
                    const unsigned qp2 = pg8::cvt_pk_bf16(bflo(qq) * __builtin_amdgcn_exp2f(x0), bfhi(qq) * __builtin_amdgcn_exp2f(x1));
                    q1[i * 136] = (bf16)(qp2 & 0xffff); q1[(i + 1) * 136] = (bf16)(qp2 >> 16);
                    k1[i * 136] = (bf16)(kt[i >> 1] & 0xffff); k1[(i + 1) * 136] = (bf16)(kt[i >> 1] >> 16); }
            }
            LAS unsigned char* k1t = lds + SC_K1T + d * 144 + 32 * tq;
            *(LAS u32x4*)k1t = (u32x4){kt[0], kt[1], kt[2], kt[3]}; *(LAS u32x4*)(k1t + 16) = (u32x4){kt[4], kt[5], kt[6], kt[7]};
            LAS unsigned char* vt = lds + SC_VT + d * 144 + 32 * tq;
            *(LAS u32x4*)vt = vr[0]; *(LAS u32x4*)(vt + 16) = vr[1];
        }
        if (lat) {
#pragma unroll
            for (int rg = 0; rg < 4; ++rg) { const int dd = 32 * di + 8 * rg + 4 * hh;
                const f32x4 a0 = *(const LAS f32x4*)(tot + dd), a1 = *(const LAS f32x4*)(tot + 128 + dd), a2 = *(const LAS f32x4*)(tot + 256 + dd), a3 = *(const LAS f32x4*)(tot + 384 + dd);
                const f32x4 bm = dir ? (a2 + a3) : (a0 + a1); float eb[4];
#pragma unroll
                for (int j = 0; j < 4; ++j) eb[j] = __builtin_amdgcn_exp2f(bm[j]);
                *(LAS v2u*)(lds + SC_ST + ((32 * svi + r) * 136 + dd) * 2) = (v2u){pg8::cvt_pk_bf16(S0[4 * rg] * eb[0], S0[4 * rg + 1] * eb[1]), pg8::cvt_pk_bf16(S0[4 * rg + 2] * eb[2], S0[4 * rg + 3] * eb[3])};
                *(LAS v2u*)(lds + SC_ST + ((32 * (svi + 1) + r) * 136 + dd) * 2) = (v2u){pg8::cvt_pk_bf16(S1[4 * rg] * eb[0], S1[4 * rg + 1] * eb[1]), pg8::cvt_pk_bf16(S1[4 * rg + 2] * eb[2], S1[4 * rg + 3] * eb[3])}; }
        }
        if (c + 1 < NCH) { float sm = 0.f;
#pragma unroll
            for (int i = 0; i < 8; ++i) { const unsigned u2 = lg1[i >> 2][i & 3]; sm += h2f((unsigned short)(u2 & 0xffff)) + h2f((unsigned short)(u2 >> 16)); }
            totb[(par ^ 1) * 512 + tq * 128 + d] = sm;
            lg0[0] = lg1[0]; lg0[1] = lg1[1];
            const int c1 = col_of(c + 1) + 16 * tq;
            vr[0] = *(const u32x4*)(HIT + chrow * MROWS + c1); vr[1] = *(const u32x4*)(HIT + chrow * MROWS + c1 + 8);
            if (c + 1 >= 4) { qr[0] = *(const u32x4*)(HQT + chrow * T + c1); qr[1] = *(const u32x4*)(HQT + chrow * T + c1 + 8); }
            if (c + 2 < NCH) { const int c2 = col_of(c + 2) + 16 * tq; lg1[0] = *(const u32x4*)(LGT + chrow * MROWS + c2); lg1[1] = *(const u32x4*)(LGT + chrow * MROWS + c2 + 8); } }
        __syncthreads();
        f32x16 dS0, dS1, O;
#pragma unroll
        for (int i = 0; i < 16; ++i) { dS0[i] = 0.f; dS1[i] = 0.f; O[i] = 0.f; }
        {
            bf16x8 fa[4], fb0[4], fb1[4];
#pragma unroll
            for (int ks = 0; ks < 4; ++ks) { fa[ks] = *(const LAS bf16x8*)(lds + SC_K1T + ((32 * di + r) * 72 + 16 * ks + 8 * hh) * 2);
                fb0[ks] = *(const LAS bf16x8*)(lds + SC_VT + ((32 * svi + r) * 72 + 16 * ks + 8 * hh) * 2); fb1[ks] = *(const LAS bf16x8*)(lds + SC_VT + ((32 * (svi + 1) + r) * 72 + 16 * ks + 8 * hh) * 2); }
#pragma unroll
            for (int ks = 0; ks < 4; ++ks) { dS0 = SCAN_MFMA(fa[ks], fb0[ks], dS0); dS1 = SCAN_MFMA(fa[ks], fb1[ks], dS1); }
        }
        if (lat) {
            bf16x8 fq[8];
#pragma unroll
            for (int ks = 0; ks < 8; ++ks) fq[ks] = *(const LAS bf16x8*)(lds + SC_Q1 + ((32 * ti + r) * 136 + 16 * ks + 8 * hh) * 2);
            {
                bf16x8 fs[8];
#pragma unroll
                for (int ks = 0; ks < 8; ++ks) fs[ks] = *(const LAS bf16x8*)(lds + SC_ST + ((32 * ovi + r) * 136 + 16 * ks + 8 * hh) * 2);
#pragma unroll
                for (int ks = 0; ks < 8; ++ks) O = SCAN_MFMA(fs[ks], fq[ks], O);
            }
#pragma unroll
            for (int si = 0; si < 2; ++si) {
                const bool live = dir ? (si >= ti) : (si <= ti);
                if (live) {
                    f32x16 At;
#pragma unroll
                    for (int i = 0; i < 16; ++i) At[i] = 0.f;
                    bf16x8 fk[8];
#pragma unroll
                    for (int ks = 0; ks < 8; ++ks) fk[ks] = *(const LAS bf16x8*)(lds + SC_K1 + ((32 * si + r) * 136 + 16 * ks + 8 * hh) * 2);
#pragma unroll
                    for (int ks = 0; ks < 8; ++ks) At = SCAN_MFMA(fk[ks], fq[ks], At);
                    const int tt = 32 * ti + r;
                    if (si == ti) {
#pragma unroll
                        for (int i = 0; i < 16; ++i) { const int ss = 32 * si + (i & 3) + 8 * (i >> 2) + 4 * hh; const bool keep = dir ? (ss >= tt) : (ss <= tt); At[i] = keep ? At[i] : 0.f; }
                    }
#pragma unroll
                    for (int k2 = 0; k2 < 2; ++k2) {
                        u32x4 pw; pw.x = pg8::cvt_pk_bf16(At[8 * k2], At[8 * k2 + 1]); pw.y = pg8::cvt_pk_bf16(At[8 * k2 + 2], At[8 * k2 + 3]); pw.z = pg8::cvt_pk_bf16(At[8 * k2 + 4], At[8 * k2 + 5]); pw.w = pg8::cvt_pk_bf16(At[8 * k2 + 6], At[8 * k2 + 7]);
                        const LAS unsigned char* vp = lds + SC_VT + ((32 * ovi + r) * 72 + 32 * si + 16 * k2 + 4 * hh) * 2;
                        const v2u lo = *(const LAS v2u*)vp, hi2 = *(const LAS v2u*)(vp + 16);
                        O = SCAN_MFMA(__builtin_bit_cast(bf16x8, (u32x4){lo.x, lo.y, hi2.x, hi2.y}), __builtin_bit_cast(bf16x8, pw), O);
                    }
                }
            }
            bf16* op = OUT + (size_t)(col_of(c) + 32 * ti + r) * SEGW + h * HGD + 32 * ovi + 4 * hh;
#pragma unroll
            for (int rg = 0; rg < 4; ++rg) *(v2u*)(op + 8 * rg) = (v2u){pg8::cvt_pk_bf16(O[4 * rg], O[4 * rg + 1]), pg8::cvt_pk_bf16(O[4 * rg + 2], O[4 * rg + 3])};
        }
#pragma unroll
        for (int rg = 0; rg < 4; ++rg) { const int dd = 32 * di + 8 * rg + 4 * hh;
            const f32x4 ee = *(const LAS f32x4*)(cst + dd), em = *(const LAS f32x4*)(cst + 128 + dd);
#pragma unroll
            for (int j = 0; j < 4; ++j) { S0[4 * rg + j] = ee[j] * S0[4 * rg + j] + em[j] * dS0[4 * rg + j]; S1[4 * rg + j] = ee[j] * S1[4 * rg + j] + em[j] * dS1[4 * rg + j]; } }
        __syncthreads();
    }
}

#ifdef DBG_NAIVE
__device__ __forceinline__ void scan_naive(LAS unsigned char* lds, int b, int h, int dir, const unsigned short* LGT, const bf16* HQT, const bf16* HIT, bf16* OUT, int tid) {
    const int dv = tid & 127, kg = tid >> 7;
    float St[32];
#pragma unroll
    for (int i = 0; i < 32; ++i) St[i] = 0.f;
    LAS float* sq = (LAS float*)lds; LAS float* sk = sq + 16 * 128; LAS float* sf = sk + 16 * 128; LAS float* sv = sf + 16 * 128; LAS float* so = sv + 16 * 128;
    constexpr int NSTEP = LC + SEQ;
    for (int j0 = 0; j0 < NSTEP; j0 += 16) {
        const bool isctx = j0 < LC;
        for (int idx = tid; idx < 16 * 128; idx += NTHR) { const int st = idx >> 7, ch = idx & 127, j = j0 + st;
            int col; if (j < LC) col = T + b * LC + (dir ? (LC - 1 - j) : j); else col = b * SEQ + (dir ? (SEQ - 1 - (j - LC)) : (j - LC));
            const size_t cr = (size_t)(h * HGD + ch);
            const float f = __builtin_amdgcn_exp2f(h2f(LGT[cr * MROWS + col]));
            sf[st * 128 + ch] = f; sk[st * 128 + ch] = 1.f - f; sv[st * 128 + ch] = bf2f(HIT[cr * MROWS + col]);
            if (!isctx) sq[st * 128 + ch] = bf2f(HQT[cr * T + col]); }
        __syncthreads();
        for (int st = 0; st < 16; ++st) {
            const float vv = sv[st * 128 + dv]; float o = 0.f;
#pragma unroll
            for (int i = 0; i < 32; ++i) { St[i] = sf[st * 128 + kg * 32 + i] * St[i] + sk[st * 128 + kg * 32 + i] * vv; o += St[i] * sq[st * 128 + kg * 32 + i]; }
            so[(st * 4 + kg) * 128 + dv] = o;
        }
        __syncthreads();
        if (!isctx) {
            for (int idx = tid; idx < 16 * 128; idx += NTHR) { const int st = idx >> 7, dd = idx & 127, j = j0 + st;
                const float o = (so[(st * 4 + 0) * 128 + dd] + so[(st * 4 + 1) * 128 + dd]) + (so[(st * 4 + 2) * 128 + dd] + so[(st * 4 + 3) * 128 + dd]);
                const int row = b * SEQ + (dir ? (SEQ - 1 - (j - LC)) : (j - LC));
                OUT[(size_t)row * SEGW + h * HGD + dd] = (bf16)f2bf(o); }
        }
        __syncthreads();
    }
}
#endif

__device__ __forceinline__ void transpose_item(const float* W, int ldw, int k0, int n0, bf16* WT, int ldk, int drow0, LAS float* scr, int lane) {
    f32x4 t[8];
#pragma unroll
    for (int i = 0; i < 8; ++i) t[i] = *(const f32x4*)(W + (size_t)(k0 + 8 * i + (lane >> 3)) * ldw + n0 + (lane & 7) * 4);
#pragma unroll
    for (int i = 0; i < 8; ++i) { LAS float* p = scr + (8 * i + (lane >> 3)) * 33 + (lane & 7) * 4; p[0] = t[i][0]; p[1] = t[i][1]; p[2] = t[i][2]; p[3] = t[i][3]; }
    LDS_WAIT(); asm volatile("" ::: "memory");
    const int c = lane & 7;
#pragma unroll
    for (int j = 0; j < 4; ++j) { const int n = (lane >> 3) + 8 * j; const LAS float* s = scr + (8 * c) * 33 + n;
        v4u o; o.x = pk2(s[0 * 33], s[1 * 33]); o.y = pk2(s[2 * 33], s[3 * 33]); o.z = pk2(s[4 * 33], s[5 * 33]); o.w = pk2(s[6 * 33], s[7 * 33]);
        *(GAS v4u*)(WT + (size_t)(drow0 + n) * ldk + k0 + 8 * c) = o; }
    LDS_WAIT(); asm volatile("" ::: "memory");
}

struct Args { const float* in[21]; float* out; unsigned char* ws; int ph_lo, ph_hi, li, pad; };

__global__ void __launch_bounds__(NTHR, 2) fwd_mega(Args args) {
    extern __shared__ __attribute__((aligned(16))) unsigned char lds_raw[];
    LAS unsigned char* lds = (LAS unsigned char*)lds_raw;
    volatile LAS unsigned* MISC = (volatile LAS unsigned*)(lds + MISC_OFF);
    const int tid = threadIdx.x, lane = tid & 63, wave = __builtin_amdgcn_readfirstlane(tid >> 6);
    const int G = gridDim.x; const int bx = blockIdx.x; const int vcu = (G % 8 == 0) ? (bx % 8) * (G / 8) + bx / 8 : bx;
    gu32* ctl0 = (gu32*)(args.ws + WS_CTL);
    const int gw = vcu * NWAVES + wave, NGW = G * NWAVES;
    for (int u = tid; u < (LDS_BYTES - LDSCTL_OFF) / 4; u += NTHR) ((LAS unsigned*)(lds + LDSCTL_OFF))[u] = 0u;
    __syncthreads();
    XcdBarrier bar = xcd_barrier_post((unsigned*)(ctl0 + CW_BAR) + args.li * XCD_BAR_WORDS, MISC + 8);
    const int lo = args.ph_lo, hi = args.ph_hi;
#ifndef PHMASK
#define PHMASK 0xFFFF
#endif
#define IN(k) (((PHMASK >> (k)) & 1) && lo <= (k) && (k) < hi)
#define SEAM(k) do { if (IN(k) && IN((k) + 1)) xcd_barrier(bar); } while (0)

#define KA(i) ({ const __attribute__((address_space(4))) Args* _p = (const __attribute__((address_space(4))) Args*)__builtin_amdgcn_kernarg_segment_ptr(); asm volatile("" : "+s"(_p)); _p->in[i]; })
#define WSP() ({ const __attribute__((address_space(4))) Args* _p = (const __attribute__((address_space(4))) Args*)__builtin_amdgcn_kernarg_segment_ptr(); asm volatile("" : "+s"(_p)); _p->ws; })
#define PHASE_PTRS unsigned char* ws = WSP(); float* MOD = (float*)(ws + WS_MOD); float* ROPE = (float*)(ws + WS_ROPE); float* LBT = (float*)(ws + WS_LBT); \
    bf16* WinT = (bf16*)(ws + WS_WINT); bf16* WoutT = (bf16*)(ws + WS_WOUTT); bf16* W13T = (bf16*)(ws + WS_W13T); bf16* W2T = (bf16*)(ws + WS_W2T); \
    bf16* XN = (bf16*)(ws + WS_XN); bf16* MIX = (bf16*)(ws + WS_MIX); bf16* XN2 = (bf16*)(ws + WS_XN2); \
    float* X1 = (float*)(ws + WS_X1); bf16* Hb = (bf16*)(ws + WS_H); bf16* Yb = (bf16*)(ws + WS_Y); \
    int* ELIST = (int*)(ws + WS_ELIST); float* EWT = (float*)(ws + WS_EWT); gu32* ctl = (gu32*)(ws + WS_CTL); \
    (void)MOD; (void)ROPE; (void)LBT; (void)WinT; (void)WoutT; (void)W13T; (void)W2T; (void)XN; (void)MIX; (void)XN2; (void)X1; (void)Hb; (void)Yb; (void)ELIST; (void)EWT; (void)ctl;
    if (IN(0)) {
        PHASE_PTRS
        const float* cvec = KA(1); const float* c_ctx = KA(3); const float* w_mod = KA(4); const float* b_mod = KA(5); const float* w_in = KA(8); const float* w_out = KA(9);
        const float* hg_lb = KA(11); const float* w1 = KA(17); const float* w3 = KA(18); const float* w2 = KA(19);
        if (bx == G - 1) {
            for (int idx = tid; idx < 1024; idx += NTHR) { const int pos = idx >> 4, i = idx & 15;
                double th = 1.0; for (int k = 0; k < i; ++k) th *= 0.5623413251903491;
                const double t2 = th * th; double c = 1.0, s = th, tc = 1.0, ts = th;
                for (int n = 1; n <= 12; ++n) { tc *= -t2 / (double)((2 * n - 1) * (2 * n)); c += tc; ts *= -t2 / (double)((2 * n) * (2 * n + 1)); s += ts; }
                double cr = 1.0, ci = 0.0; for (int p = 0; p < pos; ++p) { const double nr = cr * c - ci * s; ci = cr * s + ci * c; cr = nr; }
                ROPE[idx * 2] = (float)cr; ROPE[idx * 2 + 1] = (float)ci; }
            for (int idx = tid; idx < 1024; idx += NTHR) { const float h0 = hg_lb[idx], h1 = hg_lb[1024 + idx]; LBT[idx] = 1.f / (1.f + expf(h1 - h0)); }
        }
        if (bx < 96) {
            LAS float* sc = (LAS float*)lds;
            for (int idx = tid; idx < 17 * 1024; idx += NTHR) { const int r = idx >> 10, k = idx & 1023; const float cv = r < 16 ? cvec[r * 1024 + k] : c_ctx[k]; sc[idx] = cv / (1.f + expf(-cv)); }
            __syncthreads();
            const int col = 64 * bx + lane, k0 = 128 * wave;
            float acc[17];
#pragma unroll
            for (int r = 0; r < 17; ++r) acc[r] = 0.f;
            for (int kk = 0; kk < 128; kk += 4) {
                const float w0 = w_mod[(size_t)(k0 + kk) * 6144 + col], w1v = w_mod[(size_t)(k0 + kk + 1) * 6144 + col], w2v = w_mod[(size_t)(k0 + kk + 2) * 6144 + col], w3v = w_mod[(size_t)(k0 + kk + 3) * 6144 + col];
#pragma unroll
                for (int r = 0; r < 17; ++r) { const f32x4 a = *(const LAS f32x4*)(sc + r * 1024 + k0 + kk); acc[r] += a[0] * w0 + a[1] * w1v + a[2] * w2v + a[3] * w3v; }
            }
            LAS float* red = (LAS float*)(lds + 17 * 1024 * 4);
#pragma unroll
            for (int r = 0; r < 17; ++r) red[(wave * 17 + r) * 64 + lane] = acc[r];
            __syncthreads();
            for (int idx = tid; idx < 17 * 64; idx += NTHR) { const int r = idx >> 6, l = idx & 63; float s = 0.f;
#pragma unroll
                for (int w = 0; w < 8; ++w) s += red[(w * 17 + r) * 64 + l];
                MOD[r * 6144 + 64 * bx + l] = s + b_mod[64 * bx + l]; }
            __syncthreads();
        }
        {
            LAS float* scr = (LAS float*)(lds + wave * 16384);
            constexpr int I_IN = 16 * 128, I_OUT = 16 * 32, I_13 = 16 * 2 * 256, I_2 = 16 * 256, NIT = I_IN + I_OUT + I_13 + I_2;
            for (int it = gw; it < NIT; it += NGW) {
                int r = it;
                if (r < I_IN) { const int kb = r / 128, nb = r % 128; transpose_item(w_in, INCOLS, 64 * kb, 32 * nb, WinT, 1024, 32 * nb, scr, lane); continue; } r -= I_IN;
                if (r < I_OUT) { const int kb = r / 32, nb = r % 32; transpose_item(w_out, 1024, 64 * kb, 32 * nb, WoutT, 1024, 32 * nb, scr, lane); continue; } r -= I_OUT;
                if (r < I_13) { const int e = r / 512, rem = r % 512, s = rem / 256, r2 = rem % 256, kb = r2 / 16, nb = r2 % 16, n0 = 32 * nb;
                    transpose_item((s ? w3 : w1) + (size_t)e * 1024 * 512, 512, 64 * kb, n0, W13T, 1024, e * 1024 + 256 * (n0 / 128) + 128 * s + (n0 % 128), scr, lane); continue; } r -= I_13;
                { const int e = r / 256, r2 = r % 256, kb = r2 / 32, nb = r2 % 32; transpose_item(w2 + (size_t)e * 512 * 1024, 1024, 64 * kb, 32 * nb, W2T, 512, e * 1024 + 32 * nb, scr, lane); }
            }
        }
    }
    SEAM(0);

    if (IN(1)) {
        PHASE_PTRS
        const float* x = KA(0); const float* ctx = KA(2); const float* norm_mix = KA(6);
        for (int row = gw; row < MROWS; row += NGW) {
            const float* xr = row < T ? x + (size_t)row * D : ctx + (size_t)(row - T) * D; const int mb = row < T ? (row >> 11) : 16;
            f32x4 v[4]; float s = 0.f;
#pragma unroll
            for (int j = 0; j < 4; ++j) { v[j] = *(const f32x4*)(xr + 4 * lane + 256 * j); s += (v[j][0] * v[j][0] + v[j][1] * v[j][1]) + (v[j][2] * v[j][2] + v[j][3] * v[j][3]); }
            const float rstd = 1.f / sqrtf(wave_sum(s) * (1.f / D) + EPS);
#pragma unroll
            for (int j = 0; j < 4; ++j) { const int col = 4 * lane + 256 * j; const f32x4 g = *(const f32x4*)(norm_mix + col), sh = *(const f32x4*)(MOD + mb * 6144 + col), sc = *(const f32x4*)(MOD + mb * 6144 + 1024 + col);
                const f32x4 y = v[j] * rstd * g * (1.f + sc) + sh;
                *(v2u*)(XN + (size_t)row * D + col) = (v2u){pk2(y[0], y[1]), pk2(y[2], y[3])}; }
        }
    }
    SEAM(1);

    if (IN(2)) {
        PHASE_PTRS
        ProjOrder S; S.init(G, bx);
        LAS float* ropeL = (LAS float*)(lds + TAB_OFF); LAS float* lbtL = ropeL + 2048;
        for (int i = tid; i < 2048 + 1024; i += NTHR) ropeL[i] = i < 2048 ? ROPE[i] : LBT[i - 2048];
        __syncthreads();
        EpiProj E{ws, ropeL, lbtL, 0};
        pg8::gemm_phase<EpiProj, ProjOrder>(lds + RING_OFF, XN, WinT, D, S, E);
    }
    SEAM(2);

    if (IN(3)) {
        PHASE_PTRS
        const bf16* Qb = (const bf16*)(ws + WS_Q); const bf16* Kb = (const bf16*)(ws + WS_K); const bf16* Vb = (const bf16*)(ws + WS_V);
        const float* na_rpb = KA(10);
        const int subph = ({ const __attribute__((address_space(4))) Args* _p = (const __attribute__((address_space(4))) Args*)__builtin_amdgcn_kernarg_segment_ptr(); asm volatile("" : "+s"(_p)); _p->pad; });
#ifndef NO_SCAN
        if (bx < 128) {
            const int dir = bx & 1;
#ifdef DBG_NAIVE
            if (DBG_NAIVE & (1 << dir)) scan_naive(lds, bx >> 3, (bx >> 1) & 3, dir, (const unsigned short*)(ws + (dir ? WS_LB : WS_LF)), (const bf16*)(ws + WS_HQ), (const bf16*)(ws + WS_HI), (bf16*)(ws + (dir ? WS_OB : WS_OF)), tid);
            else
#endif
            if (subph != 2) scan_unit(lds, bx >> 3, (bx >> 1) & 3, dir, (const unsigned short*)(ws + (dir ? WS_LB : WS_LF)), (const bf16*)(ws + WS_HQ), (const bf16*)(ws + WS_HI), (bf16*)(ws + (dir ? WS_OB : WS_OF)), tid);
        } else
#endif
        {
            LAS float* rpbL = (LAS float*)lds;
            for (int idx = tid; idx < 8 * 15 * 64; idx += NTHR) { const int co = (idx & 63) - 16, hr = idx >> 6; rpbL[idx] = (co >= 0 && co < 31) ? na_rpb[hr * 31 + co] * 1.44269504f : 0.f; }
            __syncthreads();
            const __amdgpu_buffer_rsrc_t srdK = __builtin_amdgcn_make_buffer_rsrc((void*)Kb, (short)0, MROWS * SEGW * 2, 0x00020000), srdV = __builtin_amdgcn_make_buffer_rsrc((void*)Vb, (short)0, MROWS * SEGW * 2, 0x00020000);
            const int hx = bx & 7, idx = ((bx - 128) >> 3) * NWAVES + wave;
#pragma unroll 1
            for (int it = (subph == 1 ? 4 : 0); it < 4; ++it)
                na_row(it * 4 + (idx >> 5), hx, idx & 31, Qb, (const bf16*)(ws + WS_QR), srdK, srdV, MIX, rpbL, lds + 32768 + wave * 8192, lane);
        }
    }
    SEAM(3);

    if (IN(4)) {
        PHASE_PTRS
        const float* hg_norm = KA(12);
        const bf16* OF = (const bf16*)(ws + WS_OF); const bf16* OB = (const bf16*)(ws + WS_OB); const bf16* Gb = (const bf16*)(ws + WS_G);
        for (int tok = gw; tok < T; tok += NGW) {
            const size_t off = (size_t)tok * SEGW + lane * 8;
            const v4u a = *(const v4u*)(OF + off), bb = *(const v4u*)(OB + off), g = *(const v4u*)(Gb + off);
            float o[8]; float ss = 0.f;
#pragma unroll
            for (int e = 0; e < 4; ++e) { o[2 * e] = bflo(a[e]) + bflo(bb[e]); o[2 * e + 1] = bfhi(a[e]) + bfhi(bb[e]);
#ifdef DBG_SANITIZE
                if (!(fabsf(o[2 * e]) < 1e30f)) o[2 * e] = 0.f; if (!(fabsf(o[2 * e + 1]) < 1e30f)) o[2 * e + 1] = 0.f;
#endif
                ss += o[2 * e] * o[2 * e] + o[2 * e + 1] * o[2 * e + 1]; }
            ss += __shfl_xor(ss, 1); ss += __shfl_xor(ss, 2); ss += __shfl_xor(ss, 4); ss += __shfl_xor(ss, 8);
            const float rstd = 1.f / sqrtf(ss * (1.f / HGD) + EPS);
            const int dv0 = (lane & 15) * 8;
            const f32x4 g0 = *(const f32x4*)(hg_norm + dv0), g1 = *(const f32x4*)(hg_norm + dv0 + 4);
            const float gg[8] = {g0[0], g0[1], g0[2], g0[3], g1[0], g1[1], g1[2], g1[3]};
            float y[8];
#pragma unroll
            for (int e = 0; e < 4; ++e) { y[2 * e] = o[2 * e] * rstd * gg[2 * e] * bflo(g[e]); y[2 * e + 1] = o[2 * e + 1] * rstd * gg[2 * e + 1] * bfhi(g[e]); }
            *(v4u*)(MIX + (size_t)tok * D + 512 + lane * 8) = (v4u){pk2(y[0], y[1]), pk2(y[2], y[3]), pk2(y[4], y[5]), pk2(y[6], y[7])};
        }
    }
    SEAM(4);

    if (IN(5)) {
        PHASE_PTRS
        pg8::DenseOrder S; S.init(T, D, G, bx, true);
        EpiP E{(bf16*)X1};
        pg8::gemm_phase<EpiP, pg8::DenseOrder>(lds + RING_OFF, MIX, WoutT, D, S, E);
    }
    SEAM(5);

    if (IN(6)) {
        PHASE_PTRS
        const float* norm_ffn = KA(7); const float* w_grp = KA(13); const float* b_grp = KA(14); const float* w_exp = KA(15); const float* b_exp = KA(16);
        LAS f32x4* wl = (LAS f32x4*)lds;
        for (int idx = tid; idx < 5 * 1024; idx += NTHR) { const int quad = idx >> 10, col = idx & 1023; const int l = (col & 255) >> 2, q = col & 3, j = col >> 8;
            const f32x4 w = quad == 0 ? *(const f32x4*)(w_grp + col * 4) : *(const f32x4*)(w_exp + col * 16 + (quad - 1) * 4);
            wl[((quad * 4 + q) * 4 + j) * 64 + l] = w; }
        LAS int* lcnt = (LAS int*)(lds + 81920);
        LAS int* tmpe = (LAS int*)(lds + 81920 + 256);
        LAS float* rsc = (LAS float*)(lds + 86016);
        if (tid < 32) lcnt[tid] = 0;
        __syncthreads();
        const int rowbase = bx * 128 + wave * 16;
        const int mb = rowbase >> 11;
        f32x4 gsc[4], shv[4], gaa[4];
        const float* xin = KA(0); const bf16* Pb = (const bf16*)X1;
#pragma unroll
        for (int j = 0; j < 4; ++j) { const int col = 4 * lane + 256 * j; const f32x4 g = *(const f32x4*)(norm_ffn + col), sc = *(const f32x4*)(MOD + mb * 6144 + 4096 + col);
            gsc[j] = g * (1.f + sc); shv[j] = *(const f32x4*)(MOD + mb * 6144 + 3072 + col); gaa[j] = *(const f32x4*)(MOD + mb * 6144 + 2048 + col); }
        f32x4 vn[2][4]; v2u pn[2][4];
#pragma unroll
        for (int rr = 0; rr < 2; ++rr)
#pragma unroll
            for (int j = 0; j < 4; ++j) { const size_t o_ = (size_t)(rowbase + rr) * D + 4 * lane + 256 * j; vn[rr][j] = *(const f32x4*)(xin + o_); pn[rr][j] = *(const v2u*)(Pb + o_); }
#pragma unroll 1
        for (int ip = 0; ip < 8; ++ip) {
            asm volatile("" ::: "memory");
            f32x4 v[2][4];
#pragma unroll
            for (int rr = 0; rr < 2; ++rr)
#pragma unroll
                for (int j = 0; j < 4; ++j) v[rr][j] = vn[rr][j] + gaa[j] * (f32x4){bflo(pn[rr][j].x), bfhi(pn[rr][j].x), bflo(pn[rr][j].y), bfhi(pn[rr][j].y)};
            if (ip < 7) {
#pragma unroll
                for (int rr = 0; rr < 2; ++rr)
#pragma unroll
                    for (int j = 0; j < 4; ++j) { const size_t o_ = (size_t)(rowbase + 2 * ip + 2 + rr) * D + 4 * lane + 256 * j; vn[rr][j] = *(const f32x4*)(xin + o_); pn[rr][j] = *(const v2u*)(Pb + o_); } }
            float ss[2];
#pragma unroll
            for (int rr = 0; rr < 2; ++rr) { float s = 0.f;
#pragma unroll
                for (int j = 0; j < 4; ++j) s += (v[rr][j][0] * v[rr][j][0] + v[rr][j][1] * v[rr][j][1]) + (v[rr][j][2] * v[rr][j][2] + v[rr][j][3] * v[rr][j][3]);
                ss[rr] = s; }
#pragma unroll
            for (int o = 1; o < 64; o <<= 1) { ss[0] += __shfl_xor(ss[0], o); ss[1] += __shfl_xor(ss[1], o); }
            const float rstd0 = 1.f / sqrtf(ss[0] * (1.f / D) + EPS), rstd1 = 1.f / sqrtf(ss[1] * (1.f / D) + EPS);
            float lg[2][20];
#pragma unroll
            for (int k = 0; k < 20; ++k) { lg[0][k] = 0.f; lg[1][k] = 0.f; }
#pragma unroll
            for (int j = 0; j < 4; ++j) { const int col = 4 * lane + 256 * j;
                const f32x4 y0 = v[0][j] * rstd0 * gsc[j] + shv[j], y1 = v[1][j] * rstd1 * gsc[j] + shv[j];
                *(v2u*)(XN2 + (size_t)(rowbase + 2 * ip) * D + col) = (v2u){pg8::cvt_pk_bf16(y0[0], y0[1]), pg8::cvt_pk_bf16(y0[2], y0[3])};
                *(v2u*)(XN2 + (size_t)(rowbase + 2 * ip + 1) * D + col) = (v2u){pg8::cvt_pk_bf16(y1[0], y1[1]), pg8::cvt_pk_bf16(y1[2], y1[3])};
#pragma unroll
                for (int q = 0; q < 4; ++q)
#pragma unroll
                    for (int quad = 0; quad < 5; ++quad) { const f32x4 w = wl[((quad * 4 + q) * 4 + j) * 64 + lane];
#pragma unroll
                        for (int c = 0; c < 4; ++c) { lg[0][quad * 4 + c] += y0[q] * w[c]; lg[1][quad * 4 + c] += y1[q] * w[c]; } }
                asm volatile("" ::: "memory"); }
            {
                float rv[64];
#pragma unroll
                for (int k = 0; k < 64; ++k) rv[k] = k < 40 ? lg[k / 20][k % 20] : 0.f;
#pragma unroll
                for (int hb = 32; hb >= 1; hb >>= 1) { const bool hi_ = (lane & hb) != 0;
#pragma unroll
                    for (int i = 0; i < hb; ++i) { const float keep = hi_ ? rv[i + hb] : rv[i], send = hi_ ? rv[i] : rv[i + hb]; rv[i] = keep + __shfl_xor(send, hb); } }
                rsc[wave * 64 + lane] = rv[0];
            }
            if (lane < 2) {
                const int rr = lane; const LAS float* lgr = rsc + wave * 64 + rr * 20;
                {
                    float gl[4];
#pragma unroll
                    for (int k = 0; k < 4; ++k) gl[k] = lgr[k] + b_grp[k];
                    int gs = 0; float gm = gl[0];
#pragma unroll
                    for (int k = 1; k < 4; ++k) if (gl[k] > gm) { gm = gl[k]; gs = k; }
                    float den = 0.f;
#pragma unroll
                    for (int k = 0; k < 4; ++k) den += __expf(gl[k] - gm);
                    const float g_w = 1.f / den;
                    float ev[4];
#pragma unroll
                    for (int k = 0; k < 4; ++k) ev[k] = lgr[4 + gs * 4 + k] + b_exp[gs * 4 + k];
                    int i0 = 0; float v0 = ev[0];
#pragma unroll
                    for (int k = 1; k < 4; ++k) if (ev[k] > v0) { v0 = ev[k]; i0 = k; }
                    int i1 = -1; float v1 = -INFINITY;
#pragma unroll
                    for (int k = 0; k < 4; ++k) if (k != i0 && ev[k] > v1) { v1 = ev[k]; i1 = k; }
                    if (i1 < 0) { i1 = (i0 + 1) & 3; v1 = v0; }
                    const float e1 = __expf(v1 - v0); const float w0 = g_w / (1.f + e1), w1w = g_w * e1 / (1.f + e1);
                    const int ea = gs * 4 + i0, eb = gs * 4 + i1;
                    const int ra = __hip_atomic_fetch_add(&lcnt[ea], 1, __ATOMIC_RELAXED, __HIP_MEMORY_SCOPE_WORKGROUP), rb = __hip_atomic_fetch_add(&lcnt[eb], 1, __ATOMIC_RELAXED, __HIP_MEMORY_SCOPE_WORKGROUP);
                    const int lr = (wave * 16 + 2 * ip + rr) * 2;
                    tmpe[lr] = ea; tmpe[256 + lr] = ra; tmpe[512 + lr] = __builtin_bit_cast(int, w0);
                    tmpe[lr + 1] = eb; tmpe[256 + lr + 1] = rb; tmpe[512 + lr + 1] = __builtin_bit_cast(int, w1w);
                }
            }
        }
        __syncthreads();
        if (tid < 16) lcnt[16 + tid] = (int)__hip_atomic_fetch_add(ctl + CW_CNT + tid, (unsigned)lcnt[tid], RLX_AGENT);
        __syncthreads();
        if (tid < 256) { const int e = tmpe[tid], pos = lcnt[16 + e] + tmpe[256 + tid]; const int tok = bx * 128 + (tid >> 1);
            ELIST[e * ECAP + pos] = tok * 2 + (tid & 1); EWT[e * ECAP + pos] = __builtin_bit_cast(float, tmpe[512 + tid]); }
        __syncthreads();
    }
    SEAM(6);

    if (IN(7) || IN(8)) {
        PHASE_PTRS
        LAS int* tp = (LAS int*)(lds + MOE_OFF);
        if (tid == 0) { int acc = 0;
            for (int e = 0; e < 16; ++e) { const int c = (int)__hip_atomic_load(ctl + CW_CNT + e, RLX_AGENT); tp[e] = acc; tp[17 + e] = c; acc += (c + 255) >> 8; }
            tp[16] = acc; }
        __syncthreads();
    }
    if (IN(7)) {
        PHASE_PTRS
        const LAS int* tp = (const LAS int*)(lds + MOE_OFF);
        MoeOrder<true> S{tp, ELIST, G, bx, tp[16] * 4};
        EpiSwiGLU E{Hb};
        pg8::gemm_phase<EpiSwiGLU, MoeOrder<true>>(lds + RING_OFF, XN2, W13T, D, S, E);
    }
    SEAM(7);
    if (IN(8)) {
        PHASE_PTRS
        const LAS int* tp = (const LAS int*)(lds + MOE_OFF);
        MoeOrder<false> S{tp, ELIST, G, bx, tp[16] * 4};
        EpiMoeOut E{Yb, ELIST, EWT};
        pg8::gemm_phase<EpiMoeOut, MoeOrder<false>>(lds + RING_OFF, Hb, W2T, DE, S, E);
    }
    SEAM(8);

    if (IN(9)) {
        PHASE_PTRS
        const float* norm_final = KA(20); const float* xfin = KA(0); float* outp = ({ const __attribute__((address_space(4))) Args* _p = (const __attribute__((address_space(4))) Args*)__builtin_amdgcn_kernarg_segment_ptr(); asm volatile("" : "+s"(_p)); _p->out; });
        for (int row = gw; row < T; row += NGW) {
            const int mb = row >> 11; f32x4 v[4]; float s = 0.f;
#pragma unroll
            for (int j = 0; j < 4; ++j) { const int col = 4 * lane + 256 * j; const v2u pp = *(const v2u*)((const bf16*)X1 + (size_t)row * D + col);
                const f32x4 xv = *(const f32x4*)(xfin + (size_t)row * D + col) + *(const f32x4*)(MOD + mb * 6144 + 2048 + col) * (f32x4){bflo(pp.x), bfhi(pp.x), bflo(pp.y), bfhi(pp.y)}, ga = *(const f32x4*)(MOD + mb * 6144 + 5120 + col);
                const v2u y0 = *(const v2u*)(Yb + (size_t)(2 * row) * D + col), y1 = *(const v2u*)(Yb + (size_t)(2 * row + 1) * D + col);
                const f32x4 ys = (f32x4){bflo(y0.x) + bflo(y1.x), bfhi(y0.x) + bfhi(y1.x), bflo(y0.y) + bflo(y1.y), bfhi(y0.y) + bfhi(y1.y)};
                v[j] = xv + ga * ys; s += (v[j][0] * v[j][0] + v[j][1] * v[j][1]) + (v[j][2] * v[j][2] + v[j][3] * v[j][3]); }
            const float rstd = 1.f / sqrtf(wave_sum(s) * (1.f / D) + EPS);
#pragma unroll
            for (int j = 0; j < 4; ++j) { const int col = 4 * lane + 256 * j; const f32x4 g = *(const f32x4*)(norm_final + col);
                *(f32x4*)(outp + (size_t)row * D + col) = v[j] * rstd * g; }
        }
    }
#undef IN
#undef SEAM
}

#ifndef MK_N_LAUNCHES
#define MK_N_LAUNCHES 1
#endif
constexpr int NPHASE = 10;
extern "C" void kernel_launch(void* const* d_in, const int* in_sizes, int n_in, void* d_out, int out_size, void* d_ws, size_t ws_size, hipStream_t stream) {
    static int grid = 0;
    if (grid == 0) {
        if (n_in != 21 || in_sizes[0] != T * D || out_size != T * D || ws_size < WS_END) { fprintf(stderr, "kernel_launch: unexpected shapes (n_in %d, in0 %d, out %d, ws %zu)\n", n_in, n_in > 0 ? in_sizes[0] : -1, out_size, ws_size); grid = -1; return; }
        int dev = 0, cus = 0, per_cu = 0;
        if (hipGetDevice(&dev) != hipSuccess || hipDeviceGetAttribute(&cus, hipDeviceAttributeMultiprocessorCount, dev) != hipSuccess) { grid = -1; return; }
        if (hipFuncSetAttribute((const void*)fwd_mega, hipFuncAttributeMaxDynamicSharedMemorySize, LDS_BYTES) != hipSuccess) { fprintf(stderr, "kernel_launch: hipFuncSetAttribute failed\n"); grid = -1; return; }
        if (hipOccupancyMaxActiveBlocksPerMultiprocessor(&per_cu, (const void*)fwd_mega, NTHR, LDS_BYTES) != hipSuccess || per_cu < 1) fprintf(stderr, "kernel_launch: occupancy query reports %d\n", per_cu);
        (void)hipGetLastError();
        grid = cus;
        if (grid != 256) fprintf(stderr, "kernel_launch: %d CUs (built for 256)\n", grid);
    }
    if (grid < 0) return;
    (void)hipMemsetAsync((char*)d_ws + WS_CTL, 0, CTL_ZERO_BYTES, stream);
    Args a{};
    for (int i = 0; i < 21; ++i) a.in[i] = (const float*)d_in[i];
    a.out = (float*)d_out; a.ws = (unsigned char*)d_ws;
    if (MK_N_LAUNCHES == 1) {
        a.ph_lo = 0; a.ph_hi = NPHASE; a.li = 0;
        hipLaunchKernelGGL(fwd_mega, dim3(grid), dim3(NTHR), LDS_BYTES, stream, a);
    } else {
        for (int li = 0; li < NPHASE; ++li) { a.ph_lo = li; a.ph_hi = li + 1; a.li = 0; hipLaunchKernelGGL(fwd_mega, dim3(grid), dim3(NTHR), LDS_BYTES, stream, a);
#ifdef PROBE_DUP
            if (li == PROBE_DUP) {
#ifdef PROBE_SUB
                a.pad = PROBE_SUB;
#endif
                hipLaunchKernelGGL(fwd_mega, dim3(grid), dim3(NTHR), LDS_BYTES, stream, a); a.pad = 0; }
#endif
        }
    }
}
```

```cpp
#include <hip/hip_runtime.h>
#include <cstdio>
#include <cstdint>

#define GAS __attribute__((address_space(1)))
#define LAS __attribute__((address_space(3)))
typedef unsigned short bf16;
typedef unsigned short bf16_t;
typedef unsigned v4u __attribute__((ext_vector_type(4)));
typedef unsigned v2u __attribute__((ext_vector_type(2)));
typedef float f32x4 __attribute__((ext_vector_type(4)));
typedef float f32x2 __attribute__((ext_vector_type(2)));
typedef short bf16x8 __attribute__((ext_vector_type(8)));
typedef unsigned u32x4 __attribute__((ext_vector_type(4)));
typedef GAS unsigned gu32;
#define RLX_AGENT __ATOMIC_RELAXED, __HIP_MEMORY_SCOPE_AGENT
#define LDS_WAIT() asm volatile("s_waitcnt lgkmcnt(0)" ::: "memory")
#define VM_WAIT() asm volatile("s_waitcnt vmcnt(0)" ::: "memory")

constexpr int NB = 16, SEQ = 2048, D = 1024, T = NB * SEQ, LC = 256, TC = NB * LC, MROWS = T + TC;
constexpr int GW = 64, NROWS = SEQ / GW;
constexpr int INCOLS = 4096, SEGW = 512;
constexpr int NAH = 8, NAD = 64, HGH = 4, HGD = 128;
constexpr int KTOK = SEQ + LC;
constexpr int NE = 16, DE = 512, ECAP = T;
constexpr float EPS = 1e-6f;
constexpr int NWAVES = 8, NTHR = 512;

constexpr size_t MiB = 1u << 20;
constexpr size_t WS_CTL = 0, CTL_ZERO_BYTES = 32768;
constexpr size_t WS_MOD = 1 * MiB;
constexpr size_t WS_ROPE = WS_MOD + 512 * 1024, WS_LBT = WS_MOD + 520 * 1024;
constexpr size_t WS_ELIST = 2 * MiB, WS_EWT = 4 * MiB;
constexpr size_t WS_WINT = 8 * MiB, WS_WOUTT = 16 * MiB, WS_W13T = 18 * MiB, WS_W2T = 50 * MiB;
constexpr size_t WS_XN = 66 * MiB;
constexpr size_t WS_Q = 138 * MiB, WS_K = 170 * MiB, WS_V = 206 * MiB, WS_HQ = 242 * MiB, WS_HI = 274 * MiB, WS_LF = 310 * MiB, WS_LB = 346 * MiB, WS_G = 382 * MiB;
constexpr size_t WS_OF = 414 * MiB, WS_OB = 446 * MiB, WS_QR = 478 * MiB, WS_END = 510 * MiB;
constexpr size_t WS_MIX = WS_XN, WS_XN2 = WS_XN, WS_X1 = 138 * MiB, WS_H = 274 * MiB, WS_Y = 346 * MiB;
constexpr int CW_CNT = 64;
constexpr int CW_BAR = 4096;
static_assert((CW_BAR + 3456) * 4 <= (int)CTL_ZERO_BYTES, "barrier words inside the per-call memset");

constexpr int RING_OFF = 0, RING_BYTES = 131072;
constexpr int LDSCTL_OFF = RING_BYTES, MISC_OFF = LDSCTL_OFF + 320, MOE_OFF = LDSCTL_OFF + 1024;
constexpr int TAB_OFF = LDSCTL_OFF + 2048;
constexpr int LDS_BYTES = 147456;

__device__ __forceinline__ unsigned f2bf(float f) { unsigned u = __builtin_bit_cast(unsigned, f); return (u + 0x7fffu + ((u >> 16) & 1u)) >> 16; }
__device__ __forceinline__ unsigned pk2(float lo, float hi) { return f2bf(lo) | (f2bf(hi) << 16); }
__device__ __forceinline__ float bf2f(unsigned short b) { return __builtin_bit_cast(float, (unsigned)b << 16); }
__device__ __forceinline__ float bflo(unsigned u) { return __builtin_bit_cast(float, u << 16); }
__device__ __forceinline__ float bfhi(unsigned u) { return __builtin_bit_cast(float, u & 0xffff0000u); }
__device__ __forceinline__ unsigned pkh2(float lo, float hi) { _Float16 a = (_Float16)lo, b = (_Float16)hi; return (unsigned)__builtin_bit_cast(unsigned short, a) | ((unsigned)__builtin_bit_cast(unsigned short, b) << 16); }
__device__ __forceinline__ float h2f(unsigned short h) { return (float)__builtin_bit_cast(_Float16, h); }
__device__ __forceinline__ float silu_f(float v) { return v * __builtin_amdgcn_rcpf(1.f + __expf(-v)); }
__device__ __forceinline__ float wave_sum(float v) {
#pragma unroll
    for (int o = 1; o < 64; o <<= 1) v += __shfl_xor(v, o);
    return v;
}
__device__ __forceinline__ float wave_max(float v) {
#pragma unroll
    for (int o = 1; o < 64; o <<= 1) v = fmaxf(v, __shfl_xor(v, o));
    return v;
}

namespace pg8 {
constexpr int BM = 256, BK = 64, HALF = 128, HTB = HALF * BK * 2, STAGE_BYTES = 8 * HTB, NXCD = 8, WGM = 8;
__host__ __device__ __forceinline__ int lds_byte(int r, int c) { const int st = (r >> 4) * 2 + (c >> 5), rr = r & 15, cc = c & 31, ob = rr * 64 + cc * 2; return st * 1024 + (ob ^ (((ob >> 9) & 1) << 5)); }
__host__ __device__ __forceinline__ void stage_rc(int b, int& R, int& C) { const int st = b / 1024, sb = b % 1024, swz = sb ^ (((sb >> 9) & 1) << 5); R = (st >> 1) * 16 + swz / 64; C = (st & 1) * 32 + (swz % 64) / 2; }
__host__ __device__ __forceinline__ int perm32(int rho) { const int n = rho >> 4, i = rho & 15; return 8 * (i >> 2) + 4 * n + (i & 3); }

struct Unit { int pm, pn, e, tm, cnt; };

typedef float f32x2_t __attribute__((ext_vector_type(2))); typedef __bf16 bf16x2_t __attribute__((ext_vector_type(2)));
__device__ __forceinline__ unsigned cvt_pk_bf16(float lo, float hi) { f32x2_t v = {lo, hi}; bf16x2_t b = __builtin_convertvector(v, bf16x2_t); return __builtin_bit_cast(unsigned, b); }

struct DenseOrder {
    static constexpr bool GATHER = false;
    int nM, nN, nwg, G, c; bool pf;
    __device__ void init(int M, int N, int G_, int c_, bool pf_ = false) { nM = M / BM; nN = N / BM; nwg = nM * nN; G = G_; c = c_; pf = pf_; }
    __device__ bool next(int i, Unit& u) const {
        const long L = (long)i * G + c; if (L >= nwg) return false;
        int wgid = (int)L; { const int q = nwg / NXCD, r = nwg % NXCD, xcd = wgid % NXCD, off = wgid / NXCD; wgid = (xcd < r ? xcd * (q + 1) : r * (q + 1) + (xcd - r) * q) + off; }
        const int nig = WGM * nN, gid = wgid / nig, fm = gid * WGM, gsz = (nM - fm) < WGM ? (nM - fm) : WGM;
        u.pm = fm + ((wgid % nig) % gsz); u.pn = (wgid % nig) / gsz; u.e = 0; u.tm = 0; u.cnt = 0; return true;
    }
    __device__ __forceinline__ int a_row0(const Unit& u) const { return u.pm * BM; }
    __device__ __forceinline__ int a_row(const Unit& u, int r) const { return u.pm * BM + r; }
    __device__ __forceinline__ int b_row0(const Unit& u) const { return u.pn * BM; }
    __device__ __forceinline__ bool perm(const Unit&) const { return pf; }
};

template <class Epi, class Sched>
__device__ __forceinline__ void gemm_phase(LAS unsigned char* lds, const bf16_t* Aptr, const bf16_t* Btptr, const int K, const Sched& S, const Epi& E) {
    const int tid = threadIdx.x, wid = __builtin_amdgcn_readfirstlane(tid >> 6), lane = tid & 63, wr = wid >> 2, wc = wid & 3, fr = lane & 15, fq = lane >> 4;
    const int nt = K / BK;
    int sR[2], sC[2];
    unsigned voffA[2], voffBn[2], voffBp[2], voffB[2], nvB[2];
#pragma unroll
    for (int i = 0; i < 2; ++i) { int R, C; stage_rc(tid * 16 + i * 8192, R, C); const int Rb = (R & ~31) + perm32(R & 31);
        sR[i] = R; sC[i] = C; voffA[i] = (unsigned)(R * K + C) * 2u; voffBn[i] = (unsigned)(R * K + C) * 2u; voffBp[i] = (unsigned)(Rb * K + C) * 2u; }
    const size_t kstep = (size_t)(BK * 2);
    const size_t hstep = (size_t)HALF * K * 2;
    const size_t rowb = (size_t)K * 2;
    const unsigned ldsw = (unsigned)wid * 1024u;
    const int aoff = lds_byte(wr * 64 + fr, fq * 8), boff = lds_byte(wc * 32 + fr, fq * 8);
    const char* Ab = (const char*)Aptr;
#define PG8_SA(b, h) (((b) * 2 + (h)) * HTB)
#define PG8_SB(b, h) ((4 + (b) * 2 + (h)) * HTB)
#define PG8_STAGE(bufoff, gbase, voff) do { _Pragma("unroll") for (int _i = 0; _i < 2; ++_i) \
        __builtin_amdgcn_global_load_lds((const unsigned*)((const char*)(gbase) + (voff)[_i]), (LAS unsigned*)(lds + (bufoff) + ldsw + _i * 8192), 16, 0, 0); } while (0)
#define PG8_LDA(dst, b, h) do { _Pragma("unroll") for (int m = 0; m < 4; ++m) _Pragma("unroll") for (int k = 0; k < 2; ++k) dst[m][k] = *(const LAS bf16x8*)(lds + PG8_SA(b, h) + aoff + m * 2048 + k * 1024); } while (0)
#define PG8_LDB(dst, b, h) do { _Pragma("unroll") for (int n = 0; n < 2; ++n) _Pragma("unroll") for (int k = 0; k < 2; ++k) dst[n][k] = *(const LAS bf16x8*)(lds + PG8_SB(b, h) + boff + n * 2048 + k * 1024); } while (0)
#define PG8_MMA(ai, bj, At, Bt) do { __builtin_amdgcn_s_setprio(1); _Pragma("unroll") for (int m = 0; m < 4; ++m) _Pragma("unroll") for (int n = 0; n < 2; ++n) _Pragma("unroll") for (int k = 0; k < 2; ++k) \
        acc[ai][bj][m][n] = __builtin_amdgcn_mfma_f32_16x16x32_bf16(Bt[n][k], At[m][k], acc[ai][bj][m][n], 0, 0, 0); __builtin_amdgcn_s_setprio(0); } while (0)
#define PG8_WAIT_V(n) asm volatile("s_waitcnt vmcnt(" #n ")" ::: "memory")
#define PG8_WAIT_L(n) asm volatile("s_waitcnt lgkmcnt(" #n ")" ::: "memory")
#define PG8_BAR __builtin_amdgcn_s_barrier()
#define PG8_SCHED __builtin_amdgcn_sched_barrier(0)
    Unit cur, nxt; int ui = 0;
    if (!S.next(0, cur)) return;
    f32x4 acc[2][2][4][2];
#pragma unroll
    for (int a = 0; a < 2; ++a)
#pragma unroll
        for (int b = 0; b < 2; ++b)
#pragma unroll
            for (int m = 0; m < 4; ++m)
#pragma unroll
                for (int n = 0; n < 2; ++n) acc[a][b][m][n] = (f32x4){0.f, 0.f, 0.f, 0.f};
    bf16x8 At[4][2], B0[2][2], B1[2][2];
    const char* cA = Ab; unsigned cG[2][2];
    if constexpr (Sched::GATHER) {
#pragma unroll
        for (int h = 0; h < 2; ++h)
#pragma unroll
            for (int i = 0; i < 2; ++i) cG[h][i] = (unsigned)((size_t)S.a_row(cur, h * HALF + sR[i]) * rowb) + (unsigned)sC[i] * 2u;
    } else { cA = Ab + (ptrdiff_t)S.a_row0(cur) * (ptrdiff_t)rowb; cG[0][0] = cG[0][1] = cG[1][0] = cG[1][1] = 0u; }
    const char* cB = (const char*)Btptr + (ptrdiff_t)S.b_row0(cur) * (ptrdiff_t)rowb;
    { const bool pc = S.perm(cur); voffB[0] = pc ? voffBp[0] : voffBn[0]; voffB[1] = pc ? voffBp[1] : voffBn[1]; }
#define PG8_STAGEA(bufoff, h, dbase, goffs, kb) do { if constexpr (Sched::GATHER) { PG8_STAGE(bufoff, Ab + (kb), (goffs)[h]); } else { PG8_STAGE(bufoff, (dbase) + (h) * hstep + (kb), voffA); } } while (0)
    PG8_STAGE(PG8_SB(0, 0), cB, voffB); PG8_STAGE(PG8_SB(0, 1), cB + hstep, voffB); PG8_STAGEA(PG8_SA(0, 0), 0, cA, cG, 0); PG8_STAGEA(PG8_SA(0, 1), 1, cA, cG, 0);
    if (wr == 1) PG8_BAR;
    PG8_WAIT_V(2); PG8_BAR;
    PG8_STAGE(PG8_SB(1, 0), cB + kstep, voffB); PG8_STAGEA(PG8_SA(1, 0), 0, cA, cG, kstep); PG8_STAGE(PG8_SB(1, 1), cB + hstep + kstep, voffB);
    PG8_WAIT_V(6); PG8_BAR;
    for (;;) {
        const bool has_next = S.next(ui + 1, nxt);
        const char* nA = cA; const char* nB = cB; unsigned nG[2][2];
#pragma unroll
        for (int h = 0; h < 2; ++h)
#pragma unroll
            for (int i = 0; i < 2; ++i) nG[h][i] = cG[h][i];
        nvB[0] = voffB[0]; nvB[1] = voffB[1];
        if (has_next) {
            nB = (const char*)Btptr + (ptrdiff_t)S.b_row0(nxt) * (ptrdiff_t)rowb;
            { const bool pn_ = S.perm(nxt); nvB[0] = pn_ ? voffBp[0] : voffBn[0]; nvB[1] = pn_ ? voffBp[1] : voffBn[1]; }
            if constexpr (Sched::GATHER) {
#pragma unroll
                for (int h = 0; h < 2; ++h)
#pragma unroll
                    for (int i = 0; i < 2; ++i) nG[h][i] = (unsigned)((size_t)S.a_row(nxt, h * HALF + sR[i]) * rowb) + (unsigned)sC[i] * 2u;
            } else nA = Ab + (ptrdiff_t)S.a_row0(nxt) * (ptrdiff_t)rowb;
        }
        for (int t = 0; t < nt; t += 2) {
            const bool last = (t == nt - 2);
            const size_t kb1 = (size_t)(t + 1) * kstep;
            const size_t kb2 = last ? 0 : (size_t)(t + 2) * kstep, kb3 = kb2 + kstep;
            const char* a2 = last ? nA : cA; const char* b2 = last ? nB : cB + (size_t)(t + 2) * kstep; const char* b3 = b2 + kstep;
            unsigned vB2[2]; vB2[0] = last ? nvB[0] : voffB[0]; vB2[1] = last ? nvB[1] : voffB[1];
            unsigned g2[2][2];
#pragma unroll
            for (int h = 0; h < 2; ++h)
#pragma unroll
                for (int i = 0; i < 2; ++i) g2[h][i] = last ? nG[h][i] : cG[h][i];
            PG8_LDB(B0, 0, 0); PG8_LDB(B1, 0, 1); PG8_SCHED; PG8_LDA(At, 0, 0); PG8_STAGEA(PG8_SA(1, 1), 1, cA, cG, kb1);
            PG8_WAIT_V(8); PG8_WAIT_L(0); PG8_BAR; PG8_MMA(0, 0, At, B0); PG8_MMA(0, 1, At, B1); PG8_BAR; PG8_SCHED;
            PG8_LDA(At, 0, 1); PG8_STAGE(PG8_SB(0, 0), b2, vB2); PG8_STAGE(PG8_SB(0, 1), b2 + hstep, vB2); PG8_STAGEA(PG8_SA(0, 0), 0, a2, g2, kb2);
            PG8_WAIT_V(8); PG8_WAIT_L(0); PG8_BAR; PG8_MMA(1, 0, At, B0); PG8_MMA(1, 1, At, B1); PG8_BAR; PG8_SCHED;
            PG8_LDB(B0, 1, 0); PG8_LDB(B1, 1, 1); PG8_SCHED; PG8_LDA(At, 1, 0); PG8_STAGEA(PG8_SA(0, 1), 1, a2, g2, kb2);
            PG8_WAIT_V(8); PG8_WAIT_L(0); PG8_BAR; PG8_MMA(0, 0, At, B0); PG8_MMA(0, 1, At, B1); PG8_BAR; PG8_SCHED;
            PG8_LDA(At, 1, 1); PG8_STAGE(PG8_SB(1, 0), b3, vB2); PG8_STAGE(PG8_SB(1, 1), b3 + hstep, vB2); PG8_STAGEA(PG8_SA(1, 0), 0, a2, g2, kb3);
            PG8_WAIT_V(8); PG8_WAIT_L(0); PG8_BAR; PG8_MMA(1, 0, At, B0); PG8_MMA(1, 1, At, B1); PG8_BAR; PG8_SCHED;
        }
        if (wr == 0) PG8_BAR;
        E(acc, cur, wr, wc, fr, fq);
        if (!has_next) break;
#pragma unroll
        for (int a = 0; a < 2; ++a)
#pragma unroll
            for (int b = 0; b < 2; ++b)
#pragma unroll
                for (int m = 0; m < 4; ++m)
#pragma unroll
                    for (int n = 0; n < 2; ++n) acc[a][b][m][n] = (f32x4){0.f, 0.f, 0.f, 0.f};
        cur = nxt; cA = nA; cB = nB; ++ui; voffB[0] = nvB[0]; voffB[1] = nvB[1];
#pragma unroll
        for (int h = 0; h < 2; ++h)
#pragma unroll
            for (int i = 0; i < 2; ++i) cG[h][i] = nG[h][i];
        if (wr == 1) PG8_BAR;
    }
    PG8_WAIT_V(0);
    PG8_BAR;
#undef PG8_SA
#undef PG8_SB
#undef PG8_STAGE
#undef PG8_STAGEA
#undef PG8_LDA
#undef PG8_LDB
#undef PG8_MMA
#undef PG8_WAIT_V
#undef PG8_WAIT_L
#undef PG8_BAR
#undef PG8_SCHED
}
}

#define XB_TMO      128
#define XB_XCNT(j)  (256  + 64 * (j))
#define XB_XSUB(j)  (1280 + 64 * (j))
#define XB_XGEN(j)  (2304 + 64 * (j))
#define XB_TOP      3328
#define XB_TOPGEN   3392
#define XCD_BAR_WORDS 3456
#define XB_SPIN_CAP (1u << 18)
__device__ __forceinline__ unsigned xb_ld(unsigned* p)              { return __hip_atomic_load(p, __ATOMIC_RELAXED, __HIP_MEMORY_SCOPE_AGENT); }
__device__ __forceinline__ unsigned xb_add(unsigned* p, unsigned v) { return __hip_atomic_fetch_add(p, v, __ATOMIC_RELAXED, __HIP_MEMORY_SCOPE_AGENT); }
__device__ __forceinline__ unsigned xb_xcc_id() { return (unsigned)__builtin_amdgcn_s_getreg((3 << 11) | 20) & 0xFu; }
#define XB_SPIN(cond, bar) do { unsigned _sp = 0; while (cond) { __builtin_amdgcn_s_sleep(1); \
    if ((++_sp & 255u) == 0u) { if (xb_ld(&(bar)[XB_TMO])) break; if (_sp > XB_SPIN_CAP) { atomicAdd(&(bar)[XB_TMO], 1u); break; } } } } while (0)
struct XcdBarrier { unsigned* bar; unsigned x; volatile LAS unsigned* st; };
__device__ __forceinline__ XcdBarrier xcd_barrier_post(unsigned* bar, volatile LAS unsigned* st) {
    XcdBarrier b; b.bar = bar; b.x = xb_xcc_id(); b.st = st;
    if (threadIdx.x == 0) (void)xb_add(&bar[XB_XCNT(b.x)], 1u);
    return b;
}
__device__ __forceinline__ void xcd_barrier_complete(unsigned* bar, unsigned x, unsigned& nloc, unsigned& nx) {
    const unsigned G = gridDim.x * gridDim.y * gridDim.z;
    unsigned sum, cnt, mine, sp = 0u;
    for (;;) {
        sum = 0u; cnt = 0u; mine = 0u;
#pragma unroll
        for (unsigned j = 0; j < 16; ++j) { const unsigned c = xb_ld(&bar[XB_XCNT(j)]); sum += c; cnt += (c > 0u) ? 1u : 0u; mine = (j == x) ? c : mine; }
        if (sum == G) break;
        __builtin_amdgcn_s_sleep(1);
        if ((++sp & 255u) == 0u) { if (xb_ld(&bar[XB_TMO])) break; if (sp > XB_SPIN_CAP) { atomicAdd(&bar[XB_TMO], 1u); break; } }
    }
    nloc = mine > 0u ? mine : 1u; nx = cnt > 0u ? cnt : 1u;
}
__device__ __forceinline__ void xcd_barrier(const XcdBarrier& b) {
    asm volatile("s_waitcnt vmcnt(0)" ::: "memory");
    __syncthreads();
    if (threadIdx.x == 0) {
        unsigned* bar = b.bar;
        __builtin_amdgcn_s_waitcnt(0);
        unsigned nloc = b.st[0], nx = b.st[1];
        if (nloc == 0u) { xcd_barrier_complete(bar, b.x, nloc, nx); b.st[0] = nloc; b.st[1] = nx; }
        const unsigned old = xb_add(&bar[XB_XSUB(b.x)], 1u);
        const unsigned gen = old / nloc;
        if (old + 1u == (gen + 1u) * nloc) {
            __builtin_amdgcn_fence(__ATOMIC_RELEASE, "agent");
            asm volatile("s_waitcnt vmcnt(0)" ::: "memory");
            const unsigned og = xb_add(&bar[XB_TOP], 1u);
            const unsigned tg = og / nx;
            if (og + 1u == (tg + 1u) * nx) xb_add(&bar[XB_TOPGEN], 1u);
            else XB_SPIN(xb_ld(&bar[XB_TOPGEN]) == tg, bar);
            __builtin_amdgcn_fence(__ATOMIC_ACQUIRE, "agent");
            xb_add(&bar[XB_XGEN(b.x)], 1u);
            asm volatile("s_waitcnt vmcnt(0)" ::: "memory");
        } else {
            XB_SPIN(xb_ld(&bar[XB_XGEN(b.x)]) == gen, bar);
            __builtin_amdgcn_fence(__ATOMIC_ACQUIRE, "agent");
            asm volatile("s_waitcnt vmcnt(0)" ::: "memory");
        }
    }
    __syncthreads();
}

using pg8::Unit;
typedef f32x4 acc_t[2][2][4][2];

struct EpiProj {
    static constexpr bool PERM = false;
    unsigned char* ws; const LAS float* ropeL; const LAS float* lbtL; int skip;
    template <int KIND> __device__ __forceinline__ void swapped(const acc_t& acc, const Unit& u, int wr, int wc, int fr, int fq, bool latent) const {
        constexpr size_t so2 = KIND == 0 ? WS_V : KIND == 1 ? WS_HQ : KIND == 2 ? WS_HI : KIND == 3 ? WS_LF : WS_LB;
        bf16* dT = (bf16*)(ws + so2);
        constexpr int ldt = (KIND == 1) ? T : MROWS;
        const int wrow0 = (u.pn & 1) * 256 + wr * 64 + fr, tcol0 = u.pm * 256 + wc * 32 + 8 * fq;
        const LAS float* lbt = lbtL + (KIND == 4 ? 512 : 0);
#pragma unroll
        for (int ai = 0; ai < 2; ++ai)
#pragma unroll
            for (int m = 0; m < 4; ++m) { const int wrow = wrow0 + ai * 128 + m * 16; float lb = 0.f; if (KIND >= 3) lb = lbt[wrow];
#pragma unroll
                for (int bj = 0; bj < 2; ++bj) { float x[8]; u32x4 w;
#pragma unroll
                    for (int j = 0; j < 4; ++j) { x[j] = acc[ai][bj][m][0][j]; x[4 + j] = acc[ai][bj][m][1][j]; }
                    if (KIND >= 3) {
#pragma unroll
                        for (int j = 0; j < 8; ++j) { const float sg = __builtin_amdgcn_rcpf(1.f + __expf(-x[j])); x[j] = __log2f(lb + (1.f - lb) * sg); }
                        w = (u32x4){pkh2(x[0], x[1]), pkh2(x[2], x[3]), pkh2(x[4], x[5]), pkh2(x[6], x[7])}; }
                    else { if (KIND == 1) {
#pragma unroll
                            for (int j = 0; j < 8; ++j) x[j] = silu_f(x[j]); }
                        w = (u32x4){pg8::cvt_pk_bf16(x[0], x[1]), pg8::cvt_pk_bf16(x[2], x[3]), pg8::cvt_pk_bf16(x[4], x[5]), pg8::cvt_pk_bf16(x[6], x[7])}; }
                    size_t off = (size_t)wrow * ldt + tcol0 + bj * 128;
                    if (KIND == 0) { const int tc = tcol0 + bj * 128, bb_ = latent ? (tc >> 11) : ((tc - T) >> 8), tl = latent ? (tc & (SEQ - 1)) : (KTOK - LC + ((tc - T) & (LC - 1)));
                        off = ((((size_t)(bb_ * NAH + (wrow >> 6)) * (KTOK / 64) + (tl >> 6)) * NAD + (wrow & 63)) * 64) + (tl & 63); }
                    *(u32x4*)(dT + off) = w; } }
    }
    template <int SEG, bool LAT> __device__ __forceinline__ void rope(const acc_t& acc, int row0, int lcp, int wc, int fq) const {
        bf16* dK = (bf16*)(ws + (SEG == 0 ? WS_QR : WS_K)); bf16* dQ = (bf16*)(ws + WS_Q);
#pragma unroll
        for (int ai = 0; ai < 2; ++ai)
#pragma unroll
            for (int m = 0; m < 4; ++m) { const int row = row0 + ai * 128 + m * 16, sq = row & (SEQ - 1); const int pos = (wc & 1) ? (sq & 63) : (sq >> 6);
                f32x4 cs0 = (f32x4){1.f, 0.f, 1.f, 0.f}, cs1 = cs0;
                if (LAT) { cs0 = *(const LAS f32x4*)(ropeL + (pos * 16 + 4 * fq) * 2); cs1 = *(const LAS f32x4*)(ropeL + (pos * 16 + 4 * fq) * 2 + 4); }
                const float cc[4] = {cs0[0], cs0[2], cs1[0], cs1[2]}, sn[4] = {cs0[1], cs0[3], cs1[1], cs1[3]};
#pragma unroll
                for (int bj = 0; bj < 2; ++bj) { const f32x4 x1 = acc[ai][bj][m][0], x2 = acc[ai][bj][m][1]; float o1[4], o2[4];
#pragma unroll
                    for (int j = 0; j < 4; ++j) { o1[j] = LAT ? x1[j] * cc[j] - x2[j] * sn[j] : x1[j]; o2[j] = LAT ? x2[j] * cc[j] + x1[j] * sn[j] : x2[j]; }
                    size_t off = (size_t)row * SEGW + lcp + bj * 128;
                    if (SEG == 0) *(u32x4*)(dQ + off) = (u32x4){pg8::cvt_pk_bf16(x1[0], x1[1]), pg8::cvt_pk_bf16(x1[2], x1[3]), pg8::cvt_pk_bf16(x2[0], x2[1]), pg8::cvt_pk_bf16(x2[2], x2[3])};
                    else { const int cf = lcp + bj * 128, bb_ = LAT ? (row >> 11) : ((row - T) >> 8), tl = LAT ? sq : (KTOK - LC + ((row - T) & (LC - 1)));
                        off = ((size_t)(bb_ * NAH + (cf >> 6)) * KTOK + tl) * NAD + (cf & 63); }
                    *(u32x4*)(dK + off) = (u32x4){pg8::cvt_pk_bf16(o1[0], o1[1]), pg8::cvt_pk_bf16(o1[2], o1[3]), pg8::cvt_pk_bf16(o2[0], o2[1]), pg8::cvt_pk_bf16(o2[2], o2[3])}; } }
    }
    __device__ __forceinline__ void operator()(const acc_t& acc, const Unit& u, int wr, int wc, int fr, int fq) const {
        const int seg = u.pn >> 1; const bool latent = u.pm < (T / 256);
        if (skip) return;
        if (!latent && (seg == 0 || seg == 3 || seg == 7)) return;
        if (u.e) {
            if (seg == 2) swapped<0>(acc, u, wr, wc, fr, fq, latent);
            else if (seg == 3) swapped<1>(acc, u, wr, wc, fr, fq, latent);
            else if (seg == 4) swapped<2>(acc, u, wr, wc, fr, fq, latent);
            else if (seg == 5) swapped<3>(acc, u, wr, wc, fr, fq, latent);
            else swapped<4>(acc, u, wr, wc, fr, fq, latent);
            return;
        }
        const int row0 = u.pm * 256 + wr * 64 + fr;
        const int lcp = (u.pn & 1) * 256 + wc * 32 + 8 * fq;
        if (seg <= 1) {
            if (seg == 0) rope<0, true>(acc, row0, lcp, wc, fq);
            else if (latent) rope<1, true>(acc, row0, lcp, wc, fq);
            else rope<1, false>(acc, row0, lcp, wc, fq);
            return;
        }
        bf16* dG = (bf16*)(ws + WS_G);
#pragma unroll
        for (int ai = 0; ai < 2; ++ai)
#pragma unroll
            for (int m = 0; m < 4; ++m) { const int row = row0 + ai * 128 + m * 16;
#pragma unroll
                for (int bj = 0; bj < 2; ++bj) { float x[8];
#pragma unroll
                    for (int j = 0; j < 4; ++j) { x[j] = silu_f(acc[ai][bj][m][0][j]); x[4 + j] = silu_f(acc[ai][bj][m][1][j]); }
                    *(u32x4*)(dG + (size_t)row * SEGW + lcp + bj * 128) = (u32x4){pg8::cvt_pk_bf16(x[0], x[1]), pg8::cvt_pk_bf16(x[2], x[3]), pg8::cvt_pk_bf16(x[4], x[5]), pg8::cvt_pk_bf16(x[6], x[7])}; } }
    }
};
struct EpiP {
    static constexpr bool PERM = true;
    bf16* P;
    __device__ __forceinline__ void operator()(const acc_t& acc, const Unit& u, int wr, int wc, int fr, int fq) const {
        const int col0 = u.pn * 256 + wc * 32 + 8 * fq; const int row0 = u.pm * 256 + wr * 64 + fr;
#pragma unroll
        for (int ai = 0; ai < 2; ++ai)
#pragma unroll
            for (int m = 0; m < 4; ++m)
#pragma unroll
                for (int bj = 0; bj < 2; ++bj) { const f32x4 v0 = acc[ai][bj][m][0], v1 = acc[ai][bj][m][1];
                    *(u32x4*)(P + (size_t)(row0 + ai * 128 + m * 16) * D + col0 + bj * 128) = (u32x4){pg8::cvt_pk_bf16(v0[0], v0[1]), pg8::cvt_pk_bf16(v0[2], v0[3]), pg8::cvt_pk_bf16(v1[0], v1[1]), pg8::cvt_pk_bf16(v1[2], v1[3])}; }
    }
};
struct EpiSwiGLU {
    static constexpr bool PERM = true;
    bf16* H;
    __device__ __forceinline__ void operator()(const acc_t& acc, const Unit& u, int wr, int wc, int fr, int fq) const {
        const int hc = u.pn * 128 + wc * 32 + 8 * fq; const int row0 = u.pm * 256 + wr * 64 + fr;
#pragma unroll
        for (int ai = 0; ai < 2; ++ai)
#pragma unroll
            for (int m = 0; m < 4; ++m) { float h[8];
#pragma unroll
                for (int n = 0; n < 2; ++n)
#pragma unroll
                    for (int j = 0; j < 4; ++j) h[n * 4 + j] = silu_f(acc[ai][0][m][n][j]) * acc[ai][1][m][n][j];
                u32x4 w; w.x = pg8::cvt_pk_bf16(h[0], h[1]); w.y = pg8::cvt_pk_bf16(h[2], h[3]); w.z = pg8::cvt_pk_bf16(h[4], h[5]); w.w = pg8::cvt_pk_bf16(h[6], h[7]);
                *(u32x4*)(H + (size_t)(row0 + ai * 128 + m * 16) * DE + hc) = w; }
    }
};
struct EpiMoeOut {
    static constexpr bool PERM = true;
    bf16* Y; const int* elist; const float* ewt;
    __device__ __forceinline__ void operator()(const acc_t& acc, const Unit& u, int wr, int wc, int fr, int fq) const {
        const int col0 = u.pn * 256 + wc * 32 + 8 * fq;
#pragma unroll
        for (int ai = 0; ai < 2; ++ai)
#pragma unroll
            for (int m = 0; m < 4; ++m) { const int rank = u.tm * 256 + ai * 128 + wr * 64 + m * 16 + fr;
                if (rank < u.cnt) { const int tk = elist[u.e * ECAP + rank]; const float w = ewt[u.e * ECAP + rank];
#pragma unroll
                    for (int bj = 0; bj < 2; ++bj) { const f32x4 v0 = acc[ai][bj][m][0] * w, v1 = acc[ai][bj][m][1] * w; u32x4 o;
                        o.x = pg8::cvt_pk_bf16(v0[0], v0[1]); o.y = pg8::cvt_pk_bf16(v0[2], v0[3]); o.z = pg8::cvt_pk_bf16(v1[0], v1[1]); o.w = pg8::cvt_pk_bf16(v1[2], v1[3]);
                        *(u32x4*)(Y + (size_t)tk * D + col0 + bj * 128) = o; } } }
    }
};
template <bool GATHER_> struct MoeOrder {
    static constexpr bool GATHER = GATHER_;
    const LAS int* tp; const int* elist; int G, c, nwg;
    __device__ bool next(int i, Unit& u) const {
        const long L = (long)i * G + c; if (L >= nwg) return false;
        int wgid = (int)L; { const int q = nwg / 8, r = nwg % 8, xcd = wgid % 8, off = wgid / 8; wgid = (xcd < r ? xcd * (q + 1) : r * (q + 1) + (xcd - r) * q) + off; }
        const int gt = wgid >> 2; int e = 0;
#pragma unroll
        for (int k = 1; k < 16; ++k) e = (gt >= tp[k]) ? k : e;
        u.pm = gt; u.pn = wgid & 3; u.e = e; u.tm = gt - tp[e]; u.cnt = tp[17 + e]; return true;
    }
    __device__ __forceinline__ int a_row0(const Unit& u) const { return u.pm * 256; }
    __device__ __forceinline__ int a_row(const Unit& u, int r) const {
        if constexpr (GATHER_) { int rank = u.tm * 256 + r; rank = rank < u.cnt ? rank : u.cnt - 1; return elist[u.e * ECAP + rank] >> 1; }
        else return u.pm * 256 + r;
    }
    __device__ __forceinline__ int b_row0(const Unit& u) const { return u.e * 1024 + u.pn * 256; }
    __device__ __forceinline__ bool perm(const Unit&) const { return true; }
};


constexpr int SWMASK = 0x7C;
constexpr int W_REL_XN = (int)(((long long)WS_WINT - (long long)WS_XN) / 2048);
struct ProjOrder {
    static constexpr bool GATHER = false;
    pg8::DenseOrder d;
    __device__ void init(int G_, int c_) { d.init(MROWS, INCOLS, G_, c_); }
    __device__ bool next(int i, Unit& u) const { if (!d.next(i, u)) return false; u.e = (SWMASK >> (u.pn >> 1)) & 1; return true; }
    __device__ __forceinline__ int a_row0(const Unit& u) const { return u.e ? W_REL_XN + u.pn * 256 : u.pm * 256; }
    __device__ __forceinline__ int a_row(const Unit& u, int r) const { return a_row0(u) + r; }
    __device__ __forceinline__ int b_row0(const Unit& u) const { return u.e ? -W_REL_XN + u.pm * 256 : u.pn * 256; }
    __device__ __forceinline__ bool perm(const Unit& u) const { return (u.pn >> 1) >= 2; }
};


__device__ __forceinline__ bf16x8 pack8(const f32x4& a, const f32x4& b) {
    u32x4 w; w.x = pg8::cvt_pk_bf16(a[0], a[1]); w.y = pg8::cvt_pk_bf16(a[2], a[3]); w.z = pg8::cvt_pk_bf16(b[0], b[1]); w.w = pg8::cvt_pk_bf16(b[2], b[3]);
    return __builtin_bit_cast(bf16x8, w);
}
typedef unsigned bu4 __attribute__((__vector_size__(16)));
__device__ __forceinline__ bf16x8 bload16(__amdgpu_buffer_rsrc_t r, unsigned voff, unsigned soff) { return __builtin_bit_cast(bf16x8, __builtin_amdgcn_raw_buffer_load_b128(r, (int)voff, (int)soff, 0)); }
#define NA_SB() __builtin_amdgcn_sched_barrier(0)
__device__ __forceinline__ bf16x8 sel8(bool c, const bf16x8 a, const bf16x8 b) { const u32x4 x = __builtin_bit_cast(u32x4, a), y = __builtin_bit_cast(u32x4, b); u32x4 r;
    r.x = c ? x.x : y.x; r.y = c ? x.y : y.y; r.z = c ? x.z : y.z; r.w = c ? x.w : y.w; return __builtin_bit_cast(bf16x8, r); }
__device__ __forceinline__ void na_stage_ctx(LAS unsigned char* cL, const bf16* KH, const bf16* VH, int b, int h, int tid) {
    const size_t bh = (size_t)(b * NAH + h);
    const u32x4* ksrc = (const u32x4*)(KH + (bh * KTOK + SEQ) * NAD); const u32x4* vsrc = (const u32x4*)(VH + (bh * (KTOK / 64) + SEQ / 64) * (NAD * 64));
#pragma unroll
    for (int j = 0; j < 4; ++j) { const int L = tid + NTHR * j; const u32x4 kv = ksrc[L], vv = vsrc[L];
        const int key = L >> 3, ch = L & 7, fk = (((key >> 3) & 3) << 1) | ((key >> 1) & 1);
        *(LAS u32x4*)(cL + key * 128 + ((ch ^ fk) << 4)) = kv;
        const int blk = L >> 9, dd = (L >> 3) & 63;
        *(LAS u32x4*)(cL + 32768 + blk * 8192 + dd * 128 + ((ch ^ ((dd >> 1) & 7)) << 4)) = vv; }
}
__device__ __forceinline__ void na_row(int b, int h, int r, const bf16* Q, const bf16* QR, __amdgpu_buffer_rsrc_t srdK, __amdgpu_buffer_rsrc_t srdV, bf16* MIX, const LAS float* rpbL, LAS unsigned char* qL, const LAS unsigned char* cL, int lane) {
    const int qi = lane & 15, g = lane >> 4, rg = qi >> 2;
    constexpr float SC = 0.125f * 1.44269504f; const float NEG = -1e30f;
    int rs = r - 4; rs = rs < 0 ? 0 : (rs > NROWS - 8 ? NROWS - 8 : rs);
    const int tok0 = b * SEQ + r * GW;
    const unsigned klane = (unsigned)((8 * rg + (qi & 3)) * NAD + 8 * g) * 2u;
    const unsigned vlane = (unsigned)(qi * 64 + 8 * g) * 2u;
    const bool selK1 = (rg == 0), selK2 = (rg != 3), selV1 = (g == 0), selV2 = (g != 3);
#define NA_P0(j) ((j) == 0 ? 0 : (j) == 1 ? 1 : (j) == 2 ? 3 : 4)
#define NA_BB(j) (8 * (NA_P0(j) + ((g - NA_P0(j)) & 3)) - (16 * (j) + qi) + 31)
#define NA_LO(j) (((j) == 0 ? (qi < 8 ? 31 - qi : 23) : (j) == 3 ? (qi > 8 ? 31 - qi : 23) : 23) - NA_BB(j))
    f32x4 o[4][4]; float mref[4], lsum[4];
#pragma unroll
    for (int j = 0; j < 4; ++j) { mref[j] = 0.f; lsum[j] = 0.f;
#pragma unroll
        for (int dt = 0; dt < 4; ++dt) o[j][dt] = (f32x4){0.f, 0.f, 0.f, 0.f}; }
    bf16x8 kf[2][2][2], vf[2][4], Bp[4];
    LAS bf16x8* qs = (LAS bf16x8*)qL + lane;
#pragma unroll
    for (int j = 0; j < 4; ++j) { const bf16* qp = QR + (size_t)(tok0 + 16 * j + qi) * SEGW + h * NAD + 8 * g; qs[(2 * j) * 64] = *(const bf16x8*)qp; qs[(2 * j + 1) * 64] = *(const bf16x8*)(qp + 32); }
    const unsigned bh = (unsigned)(b * NAH + h);
    const unsigned ks0 = (bh * KTOK + (unsigned)(rs * GW)) * (NAD * 2u), vs0 = (bh * (KTOK / 64) + (unsigned)rs) * (NAD * 64 * 2u);
#define NA_KLD(so) do { _Pragma("unroll") for (int H = 0; H < 2; ++H) _Pragma("unroll") for (int m = 0; m < 2; ++m) _Pragma("unroll") for (int k = 0; k < 2; ++k) \
        kf[H][m][k] = bload16(srdK, klane, (so) + (unsigned)(H * 32 * NAD * 2 + m * 4 * NAD * 2 + k * 64)); } while (0)
#define NA_VLD(so) do { _Pragma("unroll") for (int H = 0; H < 2; ++H) _Pragma("unroll") for (int dt = 0; dt < 4; ++dt) \
        vf[H][dt] = bload16(srdV, vlane, (so) + (unsigned)(H * 64) + (unsigned)dt * (16 * 64 * 2)); } while (0)
    NA_KLD(ks0); NA_VLD(vs0);
    const LAS float* bp0 = rpbL + (rs - r + 7) * 64;
#pragma unroll 1
    for (int i = 0; i < 8; ++i) {
        const LAS float* bpi = bp0 + i * 64;
        NA_SB();
#pragma unroll
        for (int j = 0; j < 4; ++j) {
            f32x4 s0, s1; const bf16x8 q0 = qs[(2 * j) * 64], q1 = qs[(2 * j + 1) * 64];
            { const bf16x8 a00 = (j == 0) ? kf[0][0][0] : (j == 3) ? kf[1][0][0] : sel8(j == 1 ? selK1 : selK2, kf[1][0][0], kf[0][0][0]);
              const bf16x8 a01 = (j == 0) ? kf[0][0][1] : (j == 3) ? kf[1][0][1] : sel8(j == 1 ? selK1 : selK2, kf[1][0][1], kf[0][0][1]);
              const bf16x8 a10 = (j == 0) ? kf[0][1][0] : (j == 3) ? kf[1][1][0] : sel8(j == 1 ? selK1 : selK2, kf[1][1][0], kf[0][1][0]);
              const bf16x8 a11 = (j == 0) ? kf[0][1][1] : (j == 3) ? kf[1][1][1] : sel8(j == 1 ? selK1 : selK2, kf[1][1][1], kf[0][1][1]);
              s0 = __builtin_amdgcn_mfma_f32_16x16x32_bf16(a00, q0, (f32x4){0.f, 0.f, 0.f, 0.f}, 0, 0, 0); s0 = __builtin_amdgcn_mfma_f32_16x16x32_bf16(a01, q1, s0, 0, 0, 0);
              s1 = __builtin_amdgcn_mfma_f32_16x16x32_bf16(a10, q0, (f32x4){0.f, 0.f, 0.f, 0.f}, 0, 0, 0); s1 = __builtin_amdgcn_mfma_f32_16x16x32_bf16(a11, q1, s1, 0, 0, 0); }
            const int lo_j = NA_LO(j); const LAS float* bpj = bpi + NA_BB(j);
            { float b0 = bpj[0], b1 = bpj[1], b2 = bpj[2], b3 = bpj[3];
              asm volatile("" : "+v"(b0), "+v"(b1), "+v"(b2), "+v"(b3));
              const float bq[4] = {b0, b1, b2, b3};
#pragma unroll
              for (int e = 0; e < 4; ++e) { const float t0 = s0[e] * SC + bq[e]; s0[e] = ((unsigned)(e - lo_j) < 16u) ? t0 : NEG; } }
            { float b0 = bpj[4], b1 = bpj[5], b2 = bpj[6], b3 = bpj[7];
              asm volatile("" : "+v"(b0), "+v"(b1), "+v"(b2), "+v"(b3));
              const float bq[4] = {b0, b1, b2, b3};
#pragma unroll
              for (int e = 0; e < 4; ++e) { const float t1 = s1[e] * SC + bq[e]; s1[e] = ((unsigned)(4 + e - lo_j) < 16u) ? t1 : NEG; } }
            if (i == 0) { float mx = fmaxf(fmaxf(fmaxf(s0[0], s0[1]), fmaxf(s0[2], s0[3])), fmaxf(fmaxf(s1[0], s1[1]), fmaxf(s1[2], s1[3])));
                mx = fmaxf(mx, __shfl_xor(mx, 16)); mx = fmaxf(mx, __shfl_xor(mx, 32)); mref[j] = mx; }
            float ps = 0.f;
#pragma unroll
            for (int e = 0; e < 4; ++e) { s0[e] = __builtin_amdgcn_exp2f(fminf(s0[e] - mref[j], 100.f)); s1[e] = __builtin_amdgcn_exp2f(fminf(s1[e] - mref[j], 100.f)); ps += s0[e] + s1[e]; }
            lsum[j] += ps; Bp[j] = pack8(s0, s1);
            if (j == 1) { asm volatile("" : "+v"(Bp[0]), "+v"(Bp[1])); NA_SB(); }
        }
        asm volatile("" : "+v"(Bp[0]), "+v"(Bp[1]), "+v"(Bp[2]), "+v"(Bp[3]));
        NA_SB();
        if (i < 7) NA_KLD(ks0 + (unsigned)(i + 1) * (GW * NAD * 2));
        NA_SB();
#pragma unroll
        for (int j = 0; j < 4; ++j) {
#pragma unroll
            for (int dt = 0; dt < 4; ++dt) { const bf16x8 A = (j == 0) ? vf[0][dt] : (j == 3) ? vf[1][dt] : sel8(j == 1 ? selV1 : selV2, vf[1][dt], vf[0][dt]);
                o[j][dt] = __builtin_amdgcn_mfma_f32_16x16x32_bf16(A, Bp[j], o[j][dt], 0, 0, 0); }
            asm volatile("" : "+v"(o[j][0]), "+v"(o[j][1]), "+v"(o[j][2]), "+v"(o[j][3]));
            if (j == 1) NA_SB(); }
        NA_SB();
        if (i < 7) NA_VLD(vs0 + (unsigned)(i + 1) * (NAD * 64 * 2));
    }
#pragma unroll
    for (int j = 0; j < 4; ++j) { const bf16* qp = Q + (size_t)(tok0 + 16 * j + qi) * SEGW + h * NAD + 8 * g; qs[(2 * j) * 64] = *(const bf16x8*)qp; qs[(2 * j + 1) * 64] = *(const bf16x8*)(qp + 32); }
    const unsigned kx = (unsigned)((rg << 1) | ((qi >> 1) & 1)), vx = (unsigned)((qi >> 1) & 7);
    const unsigned ka0 = (unsigned)(8 * rg + (qi & 3)) * 128u + (((unsigned)g ^ kx) << 4), ka1 = ka0 ^ 64u;
    const unsigned va = (unsigned)qi * 128u + (((unsigned)g ^ vx) << 4);
#pragma unroll 1
    for (int i = 0; i < 8; ++i) {
        NA_SB();
#pragma unroll
        for (int m = 0; m < 2; ++m) { kf[0][m][0] = *(const LAS bf16x8*)(cL + i * 4096 + m * 512 + ka0); kf[0][m][1] = *(const LAS bf16x8*)(cL + i * 4096 + m * 512 + ka1); }
#pragma unroll
        for (int dt = 0; dt < 4; ++dt) vf[0][dt] = *(const LAS bf16x8*)(cL + 32768 + (i >> 1) * 8192 + dt * 2048 + (va ^ ((unsigned)(i & 1) << 6)));
#pragma unroll
        for (int j = 0; j < 4; ++j) {
            const bf16x8 q0 = qs[(2 * j) * 64], q1 = qs[(2 * j + 1) * 64];
            f32x4 s0 = __builtin_amdgcn_mfma_f32_16x16x32_bf16(kf[0][0][0], q0, (f32x4){0.f, 0.f, 0.f, 0.f}, 0, 0, 0); s0 = __builtin_amdgcn_mfma_f32_16x16x32_bf16(kf[0][0][1], q1, s0, 0, 0, 0);
            f32x4 s1 = __builtin_amdgcn_mfma_f32_16x16x32_bf16(kf[0][1][0], q0, (f32x4){0.f, 0.f, 0.f, 0.f}, 0, 0, 0); s1 = __builtin_amdgcn_mfma_f32_16x16x32_bf16(kf[0][1][1], q1, s1, 0, 0, 0);
            float ps = 0.f;
#pragma unroll
            for (int e = 0; e < 4; ++e) { s0[e] = __builtin_amdgcn_exp2f(fminf(s0[e] * SC - mref[j], 100.f)); s1[e] = __builtin_amdgcn_exp2f(fminf(s1[e] * SC - mref[j], 100.f)); ps += s0[e] + s1[e]; }
            lsum[j] += ps; Bp[j] = pack8(s0, s1);
        }
        asm volatile("" : "+v"(Bp[0]), "+v"(Bp[1]), "+v"(Bp[2]), "+v"(Bp[3]));
        NA_SB();
#pragma unroll
        for (int j = 0; j < 4; ++j)
#pragma unroll
            for (int dt = 0; dt < 4; ++dt) o[j][dt] = __builtin_amdgcn_mfma_f32_16x16x32_bf16(vf[0][dt], Bp[j], o[j][dt], 0, 0, 0);
#pragma unroll
        for (int j = 0; j < 4; ++j) asm volatile("" : "+v"(o[j][0]), "+v"(o[j][1]), "+v"(o[j][2]), "+v"(o[j][3]));
    }
#undef NA_KLD
#undef NA_VLD
#pragma unroll
    for (int j = 0; j < 4; ++j) { float l = lsum[j]; l += __shfl_xor(l, 16); l += __shfl_xor(l, 32); const float inv = 1.f / l;
        bf16* op = MIX + (size_t)(tok0 + 16 * j + qi) * D + h * NAD + 4 * g;
#pragma unroll
        for (int dt = 0; dt < 4; ++dt) { const f32x4 v = o[j][dt] * inv; *(v2u*)(op + 16 * dt) = (v2u){pg8::cvt_pk_bf16(v[0], v[1]), pg8::cvt_pk_bf16(v[2], v[3])}; } }
}

typedef float f32x16 __attribute__((ext_vector_type(16)));
constexpr int SC_Q1 = 0, SC_K1 = SC_Q1 + 64 * 272, SC_K1T = SC_K1 + 64 * 272, SC_VT = SC_K1T + 128 * 144, SC_ST = SC_VT + 128 * 144, SC_TOT = SC_ST + 128 * 272, SC_CST = SC_TOT + 2 * 4 * 128 * 4, SC_END = SC_CST + 2 * 128 * 4;
static_assert(SC_END <= RING_BYTES, "scan LDS");
#define SCAN_MFMA(a, b, c) __builtin_amdgcn_mfma_f32_32x32x16_bf16(a, b, c, 0, 0, 0)
__device__ __forceinline__ void scan_unit(LAS unsigned char* lds, int b, int h, int dir, const unsigned short* LGT, const bf16* HQT, const bf16* HIT, bf16* OUT, int tid) {
    const int lane = tid & 63, w = __builtin_amdgcn_readfirstlane(tid >> 6), r = lane & 31, hh = lane >> 5;
    const int d = tid & 127, tq = tid >> 7;
    const int ti = w >> 2, ovi = w & 3;
    const int di = w >> 1, svi = 2 * (w & 1);
    f32x16 S0, S1;
#pragma unroll
    for (int i = 0; i < 16; ++i) { S0[i] = 0.f; S1[i] = 0.f; }
    const size_t chrow = (size_t)(h * HGD + d);
    constexpr int NCH = (LC + SEQ) / 64;
    auto col_of = [&](int c) -> int { return c < 4 ? (T + b * LC + 64 * (dir ? 3 - c : c)) : (b * SEQ + (dir ? SEQ - 64 * (c - 3) : 64 * (c - 4))); };
    LAS float* totb = (LAS float*)(lds + SC_TOT); LAS float* cst = (LAS float*)(lds + SC_CST);
    u32x4 lg0[2], lg1[2], vr[2], qr[2];
    { const int c0 = col_of(0) + 16 * tq, c1 = col_of(1) + 16 * tq;
      lg0[0] = *(const u32x4*)(LGT + chrow * MROWS + c0); lg0[1] = *(const u32x4*)(LGT + chrow * MROWS + c0 + 8);
      lg1[0] = *(const u32x4*)(LGT + chrow * MROWS + c1); lg1[1] = *(const u32x4*)(LGT + chrow * MROWS + c1 + 8);
      vr[0] = *(const u32x4*)(HIT + chrow * MROWS + c0); vr[1] = *(const u32x4*)(HIT + chrow * MROWS + c0 + 8); qr[0] = qr[1] = (u32x4){0u, 0u, 0u, 0u};
      float sm = 0.f;
#pragma unroll
      for (int i = 0; i < 8; ++i) { const unsigned u2 = lg0[i >> 2][i & 3]; sm += h2f((unsigned short)(u2 & 0xffff)) + h2f((unsigned short)(u2 >> 16)); }
      totb[tq * 128 + d] = sm; }
    __syncthreads();
#pragma unroll 1
    for (int c = 0; c < NCH; ++c) {
        const bool lat = c >= 4; const int par = c & 1;
        LAS float* tot = totb + par * 512;
        {
            float P[16], kk[16];
#pragma unroll
            for (int i = 0; i < 8; ++i) { const unsigned u2 = lg0[i >> 2][i & 3]; P[2 * i] = h2f((unsigned short)(u2 & 0xffff)); P[2 * i + 1] = h2f((unsigned short)(u2 >> 16)); }
#pragma unroll
            for (int i = 0; i < 16; ++i) kk[i] = 1.f - __builtin_amdgcn_exp2f(P[i]);
            if (!dir) {
#pragma unroll
                for (int i = 1; i < 16; ++i) P[i] += P[i - 1];
            } else {
#pragma unroll
                for (int i = 14; i >= 0; --i) P[i] += P[i + 1];
            }
            const float t0 = tot[d], t1 = tot[128 + d], t2 = tot[256 + d], t3 = tot[384 + d];
            const float Bm = dir ? (t2 + t3) : (t0 + t1);
            float offs; if (!dir) offs = (tq > 0 ? t0 : 0.f) + (tq > 1 ? t1 : 0.f) + (tq > 2 ? t2 : 0.f); else offs = (tq < 3 ? t3 : 0.f) + (tq < 2 ? t2 : 0.f) + (tq < 1 ? t1 : 0.f);
            const float sh = offs - Bm;
            if (tq == 0) { const float be = (t0 + t1) + (t2 + t3); cst[d] = __builtin_amdgcn_exp2f(be); cst[128 + d] = __builtin_amdgcn_exp2f(be - Bm); }
            unsigned kt[8];
            LAS bf16* q1 = (LAS bf16*)(lds + SC_Q1) + (16 * tq) * 136 + d; LAS bf16* k1 = (LAS bf16*)(lds + SC_K1) + (16 * tq) * 136 + d;
#pragma unroll
            for (int i = 0; i < 16; i += 2) {
                const float x0 = fminf(fmaxf(P[i] + sh, -120.f), 120.f), x1 = fminf(fmaxf(P[i + 1] + sh, -120.f), 120.f);
                const float k0 = kk[i] * __builtin_amdgcn_exp2f(-x0), k1v = kk[i + 1] * __builtin_amdgcn_exp2f(-x1);
                kt[i >> 1] = pg8::cvt_pk_bf16(k0, k1v);
                if (lat) { const unsigned qq = (i < 8 ? qr[0] : qr[1])[(i >> 1) & 3];
                    const unsigned qp2 = pg8::cvt_pk_bf16(bflo(qq) * __builtin_amdgcn_exp2f(x0), bfhi(qq) * __builtin_amdgcn_exp2f(x1));
                    q1[i * 136] = (bf16)(qp2 & 0xffff); q1[(i + 1) * 136] = (bf16)(qp2 >> 16);
                    k1[i * 136] = (bf16)(kt[i >> 1] & 0xffff); k1[(i + 1) * 136] = (bf16)(kt[i >> 1] >> 16); }
            }
            LAS unsigned char* k1t = lds + SC_K1T + d * 144 + 32 * tq;
            *(LAS u32x4*)k1t = (u32x4){kt[0], kt[1], kt[2], kt[3]}; *(LAS u32x4*)(k1t + 16) = (u32x4){kt[4], kt[5], kt[6], kt[7]};
            LAS unsigned char* vt = lds + SC_VT + d * 144 + 32 * tq;
            *(LAS u32x4*)vt = vr[0]; *(LAS u32x4*)(vt + 16) = vr[1];
        }
        if (lat) {
#pragma unroll
            for (int rg = 0; rg < 4; ++rg) { const int dd = 32 * di + 8 * rg + 4 * hh;
                const f32x4 a0 = *(const LAS f32x4*)(tot + dd), a1 = *(const LAS f32x4*)(tot + 128 + dd), a2 = *(const LAS f32x4*)(tot + 256 + dd), a3 = *(const LAS f32x4*)(tot + 384 + dd);
                const f32x4 bm = dir ? (a2 + a3) : (a0 + a1); float eb[4];
#pragma unroll
                for (int j = 0; j < 4; ++j) eb[j] = __builtin_amdgcn_exp2f(bm[j]);
                *(LAS v2u*)(lds + SC_ST + ((32 * svi + r) * 136 + dd) * 2) = (v2u){pg8::cvt_pk_bf16(S0[4 * rg] * eb[0], S0[4 * rg + 1] * eb[1]), pg8::cvt_pk_bf16(S0[4 * rg + 2] * eb[2], S0[4 * rg + 3] * eb[3])};
                *(LAS v2u*)(lds + SC_ST + ((32 * (svi + 1) + r) * 136 + dd) * 2) = (v2u){pg8::cvt_pk_bf16(S1[4 * rg] * eb[0], S1[4 * rg + 1] * eb[1]), pg8::cvt_pk_bf16(S1[4 * rg + 2] * eb[2], S1[4 * rg + 3] * eb[3])}; }
        }
        if (c + 1 < NCH) { float sm = 0.f;
#pragma unroll
            for (int i = 0; i < 8; ++i) { const unsigned u2 = lg1[i >> 2][i & 3]; sm += h2f((unsigned short)(u2 & 0xffff)) + h2f((unsigned short)(u2 >> 16)); }
            totb[(par ^ 1) * 512 + tq * 128 + d] = sm;
            lg0[0] = lg1[0]; lg0[1] = lg1[1];
            const int c1 = col_of(c + 1) + 16 * tq;
            vr[0] = *(const u32x4*)(HIT + chrow * MROWS + c1); vr[1] = *(const u32x4*)(HIT + chrow * MROWS + c1 + 8);
            if (c + 1 >= 4) { qr[0] = *(const u32x4*)(HQT + chrow * T + c1); qr[1] = *(const u32x4*)(HQT + chrow * T + c1 + 8); }
            if (c + 2 < NCH) { const int c2 = col_of(c + 2) + 16 * tq; lg1[0] = *(const u32x4*)(LGT + chrow * MROWS + c2); lg1[1] = *(const u32x4*)(LGT + chrow * MROWS + c2 + 8); } }
        __syncthreads();
        f32x16 dS0, dS1, O;
#pragma unroll
        for (int i = 0; i < 16; ++i) { dS0[i] = 0.f; dS1[i] = 0.f; O[i] = 0.f; }
        {
            bf16x8 fa[4], fb0[4], fb1[4];
#pragma unroll
            for (int ks = 0; ks < 4; ++ks) { fa[ks] = *(const LAS bf16x8*)(lds + SC_K1T + ((32 * di + r) * 72 + 16 * ks + 8 * hh) * 2);
                fb0[ks] = *(const LAS bf16x8*)(lds + SC_VT + ((32 * svi + r) * 72 + 16 * ks + 8 * hh) * 2); fb1[ks] = *(const LAS bf16x8*)(lds + SC_VT + ((32 * (svi + 1) + r) * 72 + 16 * ks + 8 * hh) * 2); }
#pragma unroll
            for (int ks = 0; ks < 4; ++ks) { dS0 = SCAN_MFMA(fa[ks], fb0[ks], dS0); dS1 = SCAN_MFMA(fa[ks], fb1[ks], dS1); }
        }
        if (lat) {
            bf16x8 fq[8];
#pragma unroll
            for (int ks = 0; ks < 8; ++ks) fq[ks] = *(const LAS bf16x8*)(lds + SC_Q1 + ((32 * ti + r) * 136 + 16 * ks + 8 * hh) * 2);
            {
                bf16x8 fs[8];
#pragma unroll
                for (int ks = 0; ks < 8; ++ks) fs[ks] = *(const LAS bf16x8*)(lds + SC_ST + ((32 * ovi + r) * 136 + 16 * ks + 8 * hh) * 2);
#pragma unroll
                for (int ks = 0; ks < 8; ++ks) O = SCAN_MFMA(fs[ks], fq[ks], O);
            }
#pragma unroll
            for (int si = 0; si < 2; ++si) {
                const bool live = dir ? (si >= ti) : (si <= ti);
                if (live) {
                    f32x16 At;
#pragma unroll
                    for (int i = 0; i < 16; ++i) At[i] = 0.f;
                    bf16x8 fk[8];
#pragma unroll
                    for (int ks = 0; ks < 8; ++ks) fk[ks] = *(const LAS bf16x8*)(lds + SC_K1 + ((32 * si + r) * 136 + 16 * ks + 8 * hh) * 2);
#pragma unroll
                    for (int ks = 0; ks < 8; ++ks) At = SCAN_MFMA(fk[ks], fq[ks], At);
                    const int tt = 32 * ti + r;
                    if (si == ti) {
#pragma unroll
                        for (int i = 0; i < 16; ++i) { const int ss = 32 * si + (i & 3) + 8 * (i >> 2) + 4 * hh; const bool keep = dir ? (ss >= tt) : (ss <= tt); At[i] = keep ? At[i] : 0.f; }
                    }
#pragma unroll
                    for (int k2 = 0; k2 < 2; ++k2) {
                        u32x4 pw; pw.x = pg8::cvt_pk_bf16(At[8 * k2], At[8 * k2 + 1]); pw.y = pg8::cvt_pk_bf16(At[8 * k2 + 2], At[8 * k2 + 3]); pw.z = pg8::cvt_pk_bf16(At[8 * k2 + 4], At[8 * k2 + 5]); pw.w = pg8::cvt_pk_bf16(At[8 * k2 + 6], At[8 * k2 + 7]);
                        const LAS unsigned char* vp = lds + SC_VT + ((32 * ovi + r) * 72 + 32 * si + 16 * k2 + 4 * hh) * 2;
                        const v2u lo = *(const LAS v2u*)vp, hi2 = *(const LAS v2u*)(vp + 16);
                        O = SCAN_MFMA(__builtin_bit_cast(bf16x8, (u32x4){lo.x, lo.y, hi2.x, hi2.y}), __builtin_bit_cast(bf16x8, pw), O);
                    }
                }
            }
            bf16* op = OUT + (size_t)(col_of(c) + 32 * ti + r) * SEGW + h * HGD + 32 * ovi + 4 * hh;
#pragma unroll
            for (int rg = 0; rg < 4; ++rg) *(v2u*)(op + 8 * rg) = (v2u){pg8::cvt_pk_bf16(O[4 * rg], O[4 * rg + 1]), pg8::cvt_pk_bf16(O[4 * rg + 2], O[4 * rg + 3])};
        }
#pragma unroll
        for (int rg = 0; rg < 4; ++rg) { const int dd = 32 * di + 8 * rg + 4 * hh;
            const f32x4 ee = *(const LAS f32x4*)(cst + dd), em = *(const LAS f32x4*)(cst + 128 + dd);
#pragma unroll
            for (int j = 0; j < 4; ++j) { S0[4 * rg + j] = ee[j] * S0[4 * rg + j] + em[j] * dS0[4 * rg + j]; S1[4 * rg + j] = ee[j] * S1[4 * rg + j] + em[j] * dS1[4 * rg + j]; } }
        __syncthreads();
    }
}

#ifdef DBG_NAIVE
__device__ __forceinline__ void scan_naive(LAS unsigned char* lds, int b, int h, int dir, const unsigned short* LGT, const bf16* HQT, const bf16* HIT, bf16* OUT, int tid) {
    const int dv = tid & 127, kg = tid >> 7;
    float St[32];
#pragma unroll
    for (int i = 0; i < 32; ++i) St[i] = 0.f;
    LAS float* sq = (LAS float*)lds; LAS float* sk = sq + 16 * 128; LAS float* sf = sk + 16 * 128; LAS float* sv = sf + 16 * 128; LAS float* so = sv + 16 * 128;
    constexpr int NSTEP = LC + SEQ;
    for (int j0 = 0; j0 < NSTEP; j0 += 16) {
        const bool isctx = j0 < LC;
        for (int idx = tid; idx < 16 * 128; idx += NTHR) { const int st = idx >> 7, ch = idx & 127, j = j0 + st;
            int col; if (j < LC) col = T + b * LC + (dir ? (LC - 1 - j) : j); else col = b * SEQ + (dir ? (SEQ - 1 - (j - LC)) : (j - LC));
            const size_t cr = (size_t)(h * HGD + ch);
            const float f = __builtin_amdgcn_exp2f(h2f(LGT[cr * MROWS + col]));
            sf[st * 128 + ch] = f; sk[st * 128 + ch] = 1.f - f; sv[st * 128 + ch] = bf2f(HIT[cr * MROWS + col]);
            if (!isctx) sq[st * 128 + ch] = bf2f(HQT[cr * T + col]); }
        __syncthreads();
        for (int st = 0; st < 16; ++st) {
            const float vv = sv[st * 128 + dv]; float o = 0.f;
#pragma unroll
            for (int i = 0; i < 32; ++i) { St[i] = sf[st * 128 + kg * 32 + i] * St[i] + sk[st * 128 + kg * 32 + i] * vv; o += St[i] * sq[st * 128 + kg * 32 + i]; }
            so[(st * 4 + kg) * 128 + dv] = o;
        }
        __syncthreads();
        if (!isctx) {
            for (int idx = tid; idx < 16 * 128; idx += NTHR) { const int st = idx >> 7, dd = idx & 127, j = j0 + st;
                const float o = (so[(st * 4 + 0) * 128 + dd] + so[(st * 4 + 1) * 128 + dd]) + (so[(st * 4 + 2) * 128 + dd] + so[(st * 4 + 3) * 128 + dd]);
                const int row = b * SEQ + (dir ? (SEQ - 1 - (j - LC)) : (j - LC));
                OUT[(size_t)row * SEGW + h * HGD + dd] = (bf16)f2bf(o); }
        }
        __syncthreads();
    }
}
#endif

__device__ __forceinline__ void transpose_item(const float* W, int ldw, int k0, int n0, bf16* WT, int ldk, int drow0, LAS float* scr, int lane) {
    f32x4 t[8];
#pragma unroll
    for (int i = 0; i < 8; ++i) t[i] = *(const f32x4*)(W + (size_t)(k0 + 8 * i + (lane >> 3)) * ldw + n0 + (lane & 7) * 4);
#pragma unroll
    for (int i = 0; i < 8; ++i) { LAS float* p = scr + (8 * i + (lane >> 3)) * 33 + (lane & 7) * 4; p[0] = t[i][0]; p[1] = t[i][1]; p[2] = t[i][2]; p[3] = t[i][3]; }
    LDS_WAIT(); asm volatile("" ::: "memory");
    const int c = lane & 7;
#pragma unroll
    for (int j = 0; j < 4; ++j) { const int n = (lane >> 3) + 8 * j; const LAS float* s = scr + (8 * c) * 33 + n;
        v4u o; o.x = pk2(s[0 * 33], s[1 * 33]); o.y = pk2(s[2 * 33], s[3 * 33]); o.z = pk2(s[4 * 33], s[5 * 33]); o.w = pk2(s[6 * 33], s[7 * 33]);
        *(GAS v4u*)(WT + (size_t)(drow0 + n) * ldk + k0 + 8 * c) = o; }
    LDS_WAIT(); asm volatile("" ::: "memory");
}

struct Args { const float* in[21]; float* out; unsigned char* ws; int ph_lo, ph_hi, li, pad; };

__global__ void __launch_bounds__(NTHR, 2) fwd_mega(Args args) {
    extern __shared__ __attribute__((aligned(16))) unsigned char lds_raw[];
    LAS unsigned char* lds = (LAS unsigned char*)lds_raw;
    volatile LAS unsigned* MISC = (volatile LAS unsigned*)(lds + MISC_OFF);
    const int tid = threadIdx.x, lane = tid & 63, wave = __builtin_amdgcn_readfirstlane(tid >> 6);
    const int G = gridDim.x; const int bx = blockIdx.x; const int vcu = (G % 8 == 0) ? (bx % 8) * (G / 8) + bx / 8 : bx;
    gu32* ctl0 = (gu32*)(args.ws + WS_CTL);
    const int gw = vcu * NWAVES + wave, NGW = G * NWAVES;
    for (int u = tid; u < (LDS_BYTES - LDSCTL_OFF) / 4; u += NTHR) ((LAS unsigned*)(lds + LDSCTL_OFF))[u] = 0u;
    __syncthreads();
    XcdBarrier bar = xcd_barrier_post((unsigned*)(ctl0 + CW_BAR) + args.li * XCD_BAR_WORDS, MISC + 8);
    const int lo = args.ph_lo, hi = args.ph_hi;
#ifndef PHMASK
#define PHMASK 0xFFFF
#endif
#define IN(k) (((PHMASK >> (k)) & 1) && lo <= (k) && (k) < hi)
#define SEAM(k) do { if (IN(k) && IN((k) + 1)) xcd_barrier(bar); } while (0)

#define KA(i) ({ const __attribute__((address_space(4))) Args* _p = (const __attribute__((address_space(4))) Args*)__builtin_amdgcn_kernarg_segment_ptr(); asm volatile("" : "+s"(_p)); _p->in[i]; })
#define WSP() ({ const __attribute__((address_space(4))) Args* _p = (const __attribute__((address_space(4))) Args*)__builtin_amdgcn_kernarg_segment_ptr(); asm volatile("" : "+s"(_p)); _p->ws; })
#define PHASE_PTRS unsigned char* ws = WSP(); float* MOD = (float*)(ws + WS_MOD); float* ROPE = (float*)(ws + WS_ROPE); float* LBT = (float*)(ws + WS_LBT); \
    bf16* WinT = (bf16*)(ws + WS_WINT); bf16* WoutT = (bf16*)(ws + WS_WOUTT); bf16* W13T = (bf16*)(ws + WS_W13T); bf16* W2T = (bf16*)(ws + WS_W2T); \
    bf16* XN = (bf16*)(ws + WS_XN); bf16* MIX = (bf16*)(ws + WS_MIX); bf16* XN2 = (bf16*)(ws + WS_XN2); \
    float* X1 = (float*)(ws + WS_X1); bf16* Hb = (bf16*)(ws + WS_H); bf16* Yb = (bf16*)(ws + WS_Y); \
    int* ELIST = (int*)(ws + WS_ELIST); float* EWT = (float*)(ws + WS_EWT); gu32* ctl = (gu32*)(ws + WS_CTL); \
    (void)MOD; (void)ROPE; (void)LBT; (void)WinT; (void)WoutT; (void)W13T; (void)W2T; (void)XN; (void)MIX; (void)XN2; (void)X1; (void)Hb; (void)Yb; (void)ELIST; (void)EWT; (void)ctl;
    if (IN(0)) {
        PHASE_PTRS
        const float* cvec = KA(1); const float* c_ctx = KA(3); const float* w_mod = KA(4); const float* b_mod = KA(5); const float* w_in = KA(8); const float* w_out = KA(9);
        const float* hg_lb = KA(11); const float* w1 = KA(17); const float* w3 = KA(18); const float* w2 = KA(19);
        if (bx == G - 1) {
            for (int idx = tid; idx < 1024; idx += NTHR) { const int pos = idx >> 4, i = idx & 15;
                double th = 1.0; for (int k = 0; k < i; ++k) th *= 0.5623413251903491;
                const double t2 = th * th; double c = 1.0, s = th, tc = 1.0, ts = th;
                for (int n = 1; n <= 12; ++n) { tc *= -t2 / (double)((2 * n - 1) * (2 * n)); c += tc; ts *= -t2 / (double)((2 * n) * (2 * n + 1)); s += ts; }
                double cr = 1.0, ci = 0.0; for (int p = 0; p < pos; ++p) { const double nr = cr * c - ci * s; ci = cr * s + ci * c; cr = nr; }
                ROPE[idx * 2] = (float)cr; ROPE[idx * 2 + 1] = (float)ci; }
            for (int idx = tid; idx < 1024; idx += NTHR) { const float h0 = hg_lb[idx], h1 = hg_lb[1024 + idx]; LBT[idx] = 1.f / (1.f + expf(h1 - h0)); }
        }
        if (bx < 96) {
            LAS float* sc = (LAS float*)lds;
            for (int idx = tid; idx < 17 * 1024; idx += NTHR) { const int r = idx >> 10, k = idx & 1023; const float cv = r < 16 ? cvec[r * 1024 + k] : c_ctx[k]; sc[idx] = cv / (1.f + expf(-cv)); }
            __syncthreads();
            const int col = 64 * bx + lane, k0 = 128 * wave;
            float acc[17];
#pragma unroll
            for (int r = 0; r < 17; ++r) acc[r] = 0.f;
            for (int kk = 0; kk < 128; kk += 4) {
                const float w0 = w_mod[(size_t)(k0 + kk) * 6144 + col], w1v = w_mod[(size_t)(k0 + kk + 1) * 6144 + col], w2v = w_mod[(size_t)(k0 + kk + 2) * 6144 + col], w3v = w_mod[(size_t)(k0 + kk + 3) * 6144 + col];
#pragma unroll
                for (int r = 0; r < 17; ++r) { const f32x4 a = *(const LAS f32x4*)(sc + r * 1024 + k0 + kk); acc[r] += a[0] * w0 + a[1] * w1v + a[2] * w2v + a[3] * w3v; }
            }
            LAS float* red = (LAS float*)(lds + 17 * 1024 * 4);
#pragma unroll
            for (int r = 0; r < 17; ++r) red[(wave * 17 + r) * 64 + lane] = acc[r];
            __syncthreads();
            for (int idx = tid; idx < 17 * 64; idx += NTHR) { const int r = idx >> 6, l = idx & 63; float s = 0.f;
#pragma unroll
                for (int w = 0; w < 8; ++w) s += red[(w * 17 + r) * 64 + l];
                MOD[r * 6144 + 64 * bx + l] = s + b_mod[64 * bx + l]; }
            __syncthreads();
        }
        {
            LAS float* scr = (LAS float*)(lds + wave * 16384);
            constexpr int I_IN = 16 * 128, I_OUT = 16 * 32, I_13 = 16 * 2 * 256, I_2 = 16 * 256, NIT = I_IN + I_OUT + I_13 + I_2;
            for (int it = gw; it < NIT; it += NGW) {
                int r = it;
                if (r < I_IN) { const int kb = r / 128, nb = r % 128; transpose_item(w_in, INCOLS, 64 * kb, 32 * nb, WinT, 1024, 32 * nb, scr, lane); continue; } r -= I_IN;
                if (r < I_OUT) { const int kb = r / 32, nb = r % 32; transpose_item(w_out, 1024, 64 * kb, 32 * nb, WoutT, 1024, 32 * nb, scr, lane); continue; } r -= I_OUT;
                if (r < I_13) { const int e = r / 512, rem = r % 512, s = rem / 256, r2 = rem % 256, kb = r2 / 16, nb = r2 % 16, n0 = 32 * nb;
                    transpose_item((s ? w3 : w1) + (size_t)e * 1024 * 512, 512, 64 * kb, n0, W13T, 1024, e * 1024 + 256 * (n0 / 128) + 128 * s + (n0 % 128), scr, lane); continue; } r -= I_13;
                { const int e = r / 256, r2 = r % 256, kb = r2 / 32, nb = r2 % 32; transpose_item(w2 + (size_t)e * 512 * 1024, 1024, 64 * kb, 32 * nb, W2T, 512, e * 1024 + 32 * nb, scr, lane); }
            }
        }
    }
    SEAM(0);

    if (IN(1)) {
        PHASE_PTRS
        const float* x = KA(0); const float* ctx = KA(2); const float* norm_mix = KA(6);
        for (int row = gw; row < MROWS; row += NGW) {
            const float* xr = row < T ? x + (size_t)row * D : ctx + (size_t)(row - T) * D; const int mb = row < T ? (row >> 11) : 16;
            f32x4 v[4]; float s = 0.f;
#pragma unroll
            for (int j = 0; j < 4; ++j) { v[j] = *(const f32x4*)(xr + 4 * lane + 256 * j); s += (v[j][0] * v[j][0] + v[j][1] * v[j][1]) + (v[j][2] * v[j][2] + v[j][3] * v[j][3]); }
            const float rstd = 1.f / sqrtf(wave_sum(s) * (1.f / D) + EPS);
#pragma unroll
            for (int j = 0; j < 4; ++j) { const int col = 4 * lane + 256 * j; const f32x4 g = *(const f32x4*)(norm_mix + col), sh = *(const f32x4*)(MOD + mb * 6144 + col), sc = *(const f32x4*)(MOD + mb * 6144 + 1024 + col);
                const f32x4 y = v[j] * rstd * g * (1.f + sc) + sh;
                *(v2u*)(XN + (size_t)row * D + col) = (v2u){pk2(y[0], y[1]), pk2(y[2], y[3])}; }
        }
    }
    SEAM(1);

    if (IN(2)) {
        PHASE_PTRS
        ProjOrder S; S.init(G, bx);
        LAS float* ropeL = (LAS float*)(lds + TAB_OFF); LAS float* lbtL = ropeL + 2048;
        for (int i = tid; i < 2048 + 1024; i += NTHR) ropeL[i] = i < 2048 ? ROPE[i] : LBT[i - 2048];
        __syncthreads();
        EpiProj E{ws, ropeL, lbtL, 0};
        pg8::gemm_phase<EpiProj, ProjOrder>(lds + RING_OFF, XN, WinT, D, S, E);
    }
    SEAM(2);

    if (IN(3)) {
        PHASE_PTRS
        const bf16* Qb = (const bf16*)(ws + WS_Q); const bf16* Kb = (const bf16*)(ws + WS_K); const bf16* Vb = (const bf16*)(ws + WS_V);
        const float* na_rpb = KA(10);
        const int subph = ({ const __attribute__((address_space(4))) Args* _p = (const __attribute__((address_space(4))) Args*)__builtin_amdgcn_kernarg_segment_ptr(); asm volatile("" : "+s"(_p)); _p->pad; });
#ifndef NO_SCAN
        if (bx < 128) {
            const int dir = bx & 1;
#ifdef DBG_NAIVE
            if (DBG_NAIVE & (1 << dir)) scan_naive(lds, bx >> 3, (bx >> 1) & 3, dir, (const unsigned short*)(ws + (dir ? WS_LB : WS_LF)), (const bf16*)(ws + WS_HQ), (const bf16*)(ws + WS_HI), (bf16*)(ws + (dir ? WS_OB : WS_OF)), tid);
            else
#endif
            if (subph != 2) scan_unit(lds, bx >> 3, (bx >> 1) & 3, dir, (const unsigned short*)(ws + (dir ? WS_LB : WS_LF)), (const bf16*)(ws + WS_HQ), (const bf16*)(ws + WS_HI), (bf16*)(ws + (dir ? WS_OB : WS_OF)), tid);
        } else
#endif
        {
            const int hx = bx & 7, idx = ((bx - 128) >> 3) * NWAVES + wave;
            LAS float* rpbL = (LAS float*)(lds + TAB_OFF);
            for (int t2 = tid; t2 < 15 * 64; t2 += NTHR) { const int co = (t2 & 63) - 16, ro = t2 >> 6; rpbL[t2] = (co >= 0 && co < 31) ? na_rpb[(hx * 15 + ro) * 31 + co] * 1.44269504f : 0.f; }
            const __amdgpu_buffer_rsrc_t srdK = __builtin_amdgcn_make_buffer_rsrc((void*)Kb, (short)0, MROWS * SEGW * 2, 0x00020000), srdV = __builtin_amdgcn_make_buffer_rsrc((void*)Vb, (short)0, MROWS * SEGW * 2, 0x00020000);
#pragma unroll 1
            for (int it = (subph == 1 ? 4 : 0); it < 4; ++it) {
                const int bb = it * 4 + (idx >> 5);
                __syncthreads();
                na_stage_ctx(lds, Kb, Vb, bb, hx, tid);
                __syncthreads();
                na_row(bb, hx, idx & 31, Qb, (const bf16*)(ws + WS_QR), srdK, srdV, MIX, rpbL, lds + 65536 + wave * 8192, lds, lane);
            }
        }
    }
    SEAM(3);

    if (IN(4)) {
        PHASE_PTRS
        const float* hg_norm = KA(12);
        const bf16* OF = (const bf16*)(ws + WS_OF); const bf16* OB = (const bf16*)(ws + WS_OB); const bf16* Gb = (const bf16*)(ws + WS_G);
        for (int tok = gw; tok < T; tok += NGW) {
            const size_t off = (size_t)tok * SEGW + lane * 8;
            const v4u a = *(const v4u*)(OF + off), bb = *(const v4u*)(OB + off), g = *(const v4u*)(Gb + off);
            float o[8]; float ss = 0.f;
#pragma unroll
            for (int e = 0; e < 4; ++e) { o[2 * e] = bflo(a[e]) + bflo(bb[e]); o[2 * e + 1] = bfhi(a[e]) + bfhi(bb[e]);
#ifdef DBG_SANITIZE
                if (!(fabsf(o[2 * e]) < 1e30f)) o[2 * e] = 0.f; if (!(fabsf(o[2 * e + 1]) < 1e30f)) o[2 * e + 1] = 0.f;
#endif
                ss += o[2 * e] * o[2 * e] + o[2 * e + 1] * o[2 * e + 1]; }
            ss += __shfl_xor(ss, 1); ss += __shfl_xor(ss, 2); ss += __shfl_xor(ss, 4); ss += __shfl_xor(ss, 8);
            const float rstd = 1.f / sqrtf(ss * (1.f / HGD) + EPS);
            const int dv0 = (lane & 15) * 8;
            const f32x4 g0 = *(const f32x4*)(hg_norm + dv0), g1 = *(const f32x4*)(hg_norm + dv0 + 4);
            const float gg[8] = {g0[0], g0[1], g0[2], g0[3], g1[0], g1[1], g1[2], g1[3]};
            float y[8];
#pragma unroll
            for (int e = 0; e < 4; ++e) { y[2 * e] = o[2 * e] * rstd * gg[2 * e] * bflo(g[e]); y[2 * e + 1] = o[2 * e + 1] * rstd * gg[2 * e + 1] * bfhi(g[e]); }
            *(v4u*)(MIX + (size_t)tok * D + 512 + lane * 8) = (v4u){pk2(y[0], y[1]), pk2(y[2], y[3]), pk2(y[4], y[5]), pk2(y[6], y[7])};
        }
    }
    SEAM(4);

    if (IN(5)) {
        PHASE_PTRS
        pg8::DenseOrder S; S.init(T, D, G, bx, true);
        EpiP E{(bf16*)X1};
        pg8::gemm_phase<EpiP, pg8::DenseOrder>(lds + RING_OFF, MIX, WoutT, D, S, E);
    }
    SEAM(5);

    if (IN(6)) {
        PHASE_PTRS
        const float* norm_ffn = KA(7); const float* w_grp = KA(13); const float* b_grp = KA(14); const float* w_exp = KA(15); const float* b_exp = KA(16);
        LAS f32x4* wl = (LAS f32x4*)lds;
        for (int idx = tid; idx < 5 * 1024; idx += NTHR) { const int quad = idx >> 10, col = idx & 1023; const int l = (col & 255) >> 2, q = col & 3, j = col >> 8;
            const f32x4 w = quad == 0 ? *(const f32x4*)(w_grp + col * 4) : *(const f32x4*)(w_exp + col * 16 + (quad - 1) * 4);
            wl[((quad * 4 + q) * 4 + j) * 64 + l] = w; }
        LAS int* lcnt = (LAS int*)(lds + 81920);
        LAS int* tmpe = (LAS int*)(lds + 81920 + 256);
        LAS float* rsc = (LAS float*)(lds + 86016);
        if (tid < 32) lcnt[tid] = 0;
        __syncthreads();
        const int rowbase = bx * 128 + wave * 16;
        const int mb = rowbase >> 11;
        f32x4 gsc[4], shv[4], gaa[4];
        const float* xin = KA(0); const bf16* Pb = (const bf16*)X1;
#pragma unroll
        for (int j = 0; j < 4; ++j) { const int col = 4 * lane + 256 * j; const f32x4 g = *(const f32x4*)(norm_ffn + col), sc = *(const f32x4*)(MOD + mb * 6144 + 4096 + col);
            gsc[j] = g * (1.f + sc); shv[j] = *(const f32x4*)(MOD + mb * 6144 + 3072 + col); gaa[j] = *(const f32x4*)(MOD + mb * 6144 + 2048 + col); }
        f32x4 vn[2][4]; v2u pn[2][4];
#pragma unroll
        for (int rr = 0; rr < 2; ++rr)
#pragma unroll
            for (int j = 0; j < 4; ++j) { const size_t o_ = (size_t)(rowbase + rr) * D + 4 * lane + 256 * j; vn[rr][j] = *(const f32x4*)(xin + o_); pn[rr][j] = *(const v2u*)(Pb + o_); }
#pragma unroll 1
        for (int ip = 0; ip < 8; ++ip) {
            asm volatile("" ::: "memory");
            f32x4 v[2][4];
#pragma unroll
            for (int rr = 0; rr < 2; ++rr)
#pragma unroll
                for (int j = 0; j < 4; ++j) v[rr][j] = vn[rr][j] + gaa[j] * (f32x4){bflo(pn[rr][j].x), bfhi(pn[rr][j].x), bflo(pn[rr][j].y), bfhi(pn[rr][j].y)};
            if (ip < 7) {
#pragma unroll
                for (int rr = 0; rr < 2; ++rr)
#pragma unroll
                    for (int j = 0; j < 4; ++j) { const size_t o_ = (size_t)(rowbase + 2 * ip + 2 + rr) * D + 4 * lane + 256 * j; vn[rr][j] = *(const f32x4*)(xin + o_); pn[rr][j] = *(const v2u*)(Pb + o_); } }
            float ss[2];
#pragma unroll
            for (int rr = 0; rr < 2; ++rr) { float s = 0.f;
#pragma unroll
                for (int j = 0; j < 4; ++j) s += (v[rr][j][0] * v[rr][j][0] + v[rr][j][1] * v[rr][j][1]) + (v[rr][j][2] * v[rr][j][2] + v[rr][j][3] * v[rr][j][3]);
                ss[rr] = s; }
#pragma unroll
            for (int o = 1; o < 64; o <<= 1) { ss[0] += __shfl_xor(ss[0], o); ss[1] += __shfl_xor(ss[1], o); }
            const float rstd0 = 1.f / sqrtf(ss[0] * (1.f / D) + EPS), rstd1 = 1.f / sqrtf(ss[1] * (1.f / D) + EPS);
            float lg[2][20];
#pragma unroll
            for (int k = 0; k < 20; ++k) { lg[0][k] = 0.f; lg[1][k] = 0.f; }
#pragma unroll
            for (int j = 0; j < 4; ++j) { const int col = 4 * lane + 256 * j;
                const f32x4 y0 = v[0][j] * rstd0 * gsc[j] + shv[j], y1 = v[1][j] * rstd1 * gsc[j] + shv[j];
                *(v2u*)(XN2 + (size_t)(rowbase + 2 * ip) * D + col) = (v2u){pg8::cvt_pk_bf16(y0[0], y0[1]), pg8::cvt_pk_bf16(y0[2], y0[3])};
                *(v2u*)(XN2 + (size_t)(rowbase + 2 * ip + 1) * D + col) = (v2u){pg8::cvt_pk_bf16(y1[0], y1[1]), pg8::cvt_pk_bf16(y1[2], y1[3])};
#pragma unroll
                for (int q = 0; q < 4; ++q)
#pragma unroll
                    for (int quad = 0; quad < 5; ++quad) { const f32x4 w = wl[((quad * 4 + q) * 4 + j) * 64 + lane];
#pragma unroll
                        for (int c = 0; c < 4; ++c) { lg[0][quad * 4 + c] += y0[q] * w[c]; lg[1][quad * 4 + c] += y1[q] * w[c]; } }
                asm volatile("" ::: "memory"); }
            {
                float rv[64];
#pragma unroll
                for (int k = 0; k < 64; ++k) rv[k] = k < 40 ? lg[k / 20][k % 20] : 0.f;
#pragma unroll
                for (int hb = 32; hb >= 1; hb >>= 1) { const bool hi_ = (lane & hb) != 0;
#pragma unroll
                    for (int i = 0; i < hb; ++i) { const float keep = hi_ ? rv[i + hb] : rv[i], send = hi_ ? rv[i] : rv[i + hb]; rv[i] = keep + __shfl_xor(send, hb); } }
                rsc[wave * 64 + lane] = rv[0];
            }
            if (lane < 2) {
                const int rr = lane; const LAS float* lgr = rsc + wave * 64 + rr * 20;
                {
                    float gl[4];
#pragma unroll
                    for (int k = 0; k < 4; ++k) gl[k] = lgr[k] + b_grp[k];
                    int gs = 0; float gm = gl[0];
#pragma unroll
                    for (int k = 1; k < 4; ++k) if (gl[k] > gm) { gm = gl[k]; gs = k; }
                    float den = 0.f;
#pragma unroll
                    for (int k = 0; k < 4; ++k) den += __expf(gl[k] - gm);
                    const float g_w = 1.f / den;
                    float ev[4];
#pragma unroll
                    for (int k = 0; k < 4; ++k) ev[k] = lgr[4 + gs * 4 + k] + b_exp[gs * 4 + k];
                    int i0 = 0; float v0 = ev[0];
#pragma unroll
                    for (int k = 1; k < 4; ++k) if (ev[k] > v0) { v0 = ev[k]; i0 = k; }
                    int i1 = -1; float v1 = -INFINITY;
#pragma unroll
                    for (int k = 0; k < 4; ++k) if (k != i0 && ev[k] > v1) { v1 = ev[k]; i1 = k; }
                    if (i1 < 0) { i1 = (i0 + 1) & 3; v1 = v0; }
                    const float e1 = __expf(v1 - v0); const float w0 = g_w / (1.f + e1), w1w = g_w * e1 / (1.f + e1);
                    const int ea = gs * 4 + i0, eb = gs * 4 + i1;
                    const int ra = __hip_atomic_fetch_add(&lcnt[ea], 1, __ATOMIC_RELAXED, __HIP_MEMORY_SCOPE_WORKGROUP), rb = __hip_atomic_fetch_add(&lcnt[eb], 1, __ATOMIC_RELAXED, __HIP_MEMORY_SCOPE_WORKGROUP);
                    const int lr = (wave * 16 + 2 * ip + rr) * 2;
                    tmpe[lr] = ea; tmpe[256 + lr] = ra; tmpe[512 + lr] = __builtin_bit_cast(int, w0);
                    tmpe[lr + 1] = eb; tmpe[256 + lr + 1] = rb; tmpe[512 + lr + 1] = __builtin_bit_cast(int, w1w);
                }
            }
        }
        __syncthreads();
        if (tid < 16) lcnt[16 + tid] = (int)__hip_atomic_fetch_add(ctl + CW_CNT + tid, (unsigned)lcnt[tid], RLX_AGENT);
        __syncthreads();
        if (tid < 256) { const int e = tmpe[tid], pos = lcnt[16 + e] + tmpe[256 + tid]; const int tok = bx * 128 + (tid >> 1);
            ELIST[e * ECAP + pos] = tok * 2 + (tid & 1); EWT[e * ECAP + pos] = __builtin_bit_cast(float, tmpe[512 + tid]); }
        __syncthreads();
    }
    SEAM(6);

    if (IN(7) || IN(8)) {
        PHASE_PTRS
        LAS int* tp = (LAS int*)(lds + MOE_OFF);
        if (tid == 0) { int acc = 0;
            for (int e = 0; e < 16; ++e) { const int c = (int)__hip_atomic_load(ctl + CW_CNT + e, RLX_AGENT); tp[e] = acc; tp[17 + e] = c; acc += (c + 255) >> 8; }
            tp[16] = acc; }
        __syncthreads();
    }
    if (IN(7)) {
        PHASE_PTRS
        const LAS int* tp = (const LAS int*)(lds + MOE_OFF);
        MoeOrder<true> S{tp, ELIST, G, bx, tp[16] * 4};
        EpiSwiGLU E{Hb};
        pg8::gemm_phase<EpiSwiGLU, MoeOrder<true>>(lds + RING_OFF, XN2, W13T, D, S, E);
    }
    SEAM(7);
    if (IN(8)) {
        PHASE_PTRS
        const LAS int* tp = (const LAS int*)(lds + MOE_OFF);
        MoeOrder<false> S{tp, ELIST, G, bx, tp[16] * 4};
        EpiMoeOut E{Yb, ELIST, EWT};
        pg8::gemm_phase<EpiMoeOut, MoeOrder<false>>(lds + RING_OFF, Hb, W2T, DE, S, E);
    }
    SEAM(8);

    if (IN(9)) {
        PHASE_PTRS
        const float* norm_final = KA(20); const float* xfin = KA(0); float* outp = ({ const __attribute__((address_space(4))) Args* _p = (const __attribute__((address_space(4))) Args*)__builtin_amdgcn_kernarg_segment_ptr(); asm volatile("" : "+s"(_p)); _p->out; });
        for (int row = gw; row < T; row += NGW) {
            const int mb = row >> 11; f32x4 v[4]; float s = 0.f;
#pragma unroll
            for (int j = 0; j < 4; ++j) { const int col = 4 * lane + 256 * j; const v2u pp = *(const v2u*)((const bf16*)X1 + (size_t)row * D + col);
                const f32x4 xv = *(const f32x4*)(xfin + (size_t)row * D + col) + *(const f32x4*)(MOD + mb * 6144 + 2048 + col) * (f32x4){bflo(pp.x), bfhi(pp.x), bflo(pp.y), bfhi(pp.y)}, ga = *(const f32x4*)(MOD + mb * 6144 + 5120 + col);
                const v2u y0 = *(const v2u*)(Yb + (size_t)(2 * row) * D + col), y1 = *(const v2u*)(Yb + (size_t)(2 * row + 1) * D + col);
                const f32x4 ys = (f32x4){bflo(y0.x) + bflo(y1.x), bfhi(y0.x) + bfhi(y1.x), bflo(y0.y) + bflo(y1.y), bfhi(y0.y) + bfhi(y1.y)};
                v[j] = xv + ga * ys; s += (v[j][0] * v[j][0] + v[j][1] * v[j][1]) + (v[j][2] * v[j][2] + v[j][3] * v[j][3]); }
            const float rstd = 1.f / sqrtf(wave_sum(s) * (1.f / D) + EPS);
#pragma unroll
            for (int j = 0; j < 4; ++j) { const int col = 4 * lane + 256 * j; const f32x4 g = *(const f32x4*)(norm_final + col);
                *(f32x4*)(outp + (size_t)row * D + col) = v[j] * rstd * g; }
        }
    }
#undef IN
#undef SEAM
}

#ifndef MK_N_LAUNCHES
#define MK_N_LAUNCHES 1
#endif
constexpr int NPHASE = 10;
extern "C" void kernel_launch(void* const* d_in, const int* in_sizes, int n_in, void* d_out, int out_size, void* d_ws, size_t ws_size, hipStream_t stream) {
    static int grid = 0;
    if (grid == 0) {
        if (n_in != 21 || in_sizes[0] != T * D || out_size != T * D || ws_size < WS_END) { fprintf(stderr, "kernel_launch: unexpected shapes (n_in %d, in0 %d, out %d, ws %zu)\n", n_in, n_in > 0 ? in_sizes[0] : -1, out_size, ws_size); grid = -1; return; }
        int dev = 0, cus = 0, per_cu = 0;
        if (hipGetDevice(&dev) != hipSuccess || hipDeviceGetAttribute(&cus, hipDeviceAttributeMultiprocessorCount, dev) != hipSuccess) { grid = -1; return; }
        if (hipFuncSetAttribute((const void*)fwd_mega, hipFuncAttributeMaxDynamicSharedMemorySize, LDS_BYTES) != hipSuccess) { fprintf(stderr, "kernel_launch: hipFuncSetAttribute failed\n"); grid = -1; return; }
        if (hipOccupancyMaxActiveBlocksPerMultiprocessor(&per_cu, (const void*)fwd_mega, NTHR, LDS_BYTES) != hipSuccess || per_cu < 1) fprintf(stderr, "kernel_launch: occupancy query reports %d\n", per_cu);
        (void)hipGetLastError();
        grid = cus;
        if (grid != 256) fprintf(stderr, "kernel_launch: %d CUs (built for 256)\n", grid);
    }
    if (grid < 0) return;
    (void)hipMemsetAsync((char*)d_ws + WS_CTL, 0, CTL_ZERO_BYTES, stream);
    Args a{};
    for (int i = 0; i < 21; ++i) a.in[i] = (const float*)d_in[i];
    a.out = (float*)d_out; a.ws = (unsigned char*)d_ws;
    if (MK_N_LAUNCHES == 1) {
        a.ph_lo = 0; a.ph_hi = NPHASE; a.li = 0;
        hipLaunchKernelGGL(fwd_mega, dim3(grid), dim3(NTHR), LDS_BYTES, stream, a);
    } else {
        for (int li = 0; li < NPHASE; ++li) { a.ph_lo = li; a.ph_hi = li + 1; a.li = 0; hipLaunchKernelGGL(fwd_mega, dim3(grid), dim3(NTHR), LDS_BYTES, stream, a);
#ifdef PROBE_DUP
            if (li == PROBE_DUP) {
#ifdef PROBE_SUB
                a.pad = PROBE_SUB;
#endif
                hipLaunchKernelGGL(fwd_mega, dim3(grid), dim3(NTHR), LDS_BYTES, stream, a); a.pad = 0; }
#endif
        }
    }
}
```

```cpp
#include <hip/hip_runtime.h>
#include <cstdio>
#include <cstdint>

#define GAS __attribute__((address_space(1)))
#define LAS __attribute__((address_space(3)))
typedef unsigned short bf16;
typedef unsigned short bf16_t;
typedef unsigned v4u __attribute__((ext_vector_type(4)));
typedef unsigned v2u __attribute__((ext_vector_type(2)));
typedef float f32x4 __attribute__((ext_vector_type(4)));
typedef float f32x2 __attribute__((ext_vector_type(2)));
typedef short bf16x8 __attribute__((ext_vector_type(8)));
typedef unsigned u32x4 __attribute__((ext_vector_type(4)));
typedef GAS unsigned gu32;
#define RLX_AGENT __ATOMIC_RELAXED, __HIP_MEMORY_SCOPE_AGENT
#define LDS_WAIT() asm volatile("s_waitcnt lgkmcnt(0)" ::: "memory")
#define VM_WAIT() asm volatile("s_waitcnt vmcnt(0)" ::: "memory")

constexpr int NB = 16, SEQ = 2048, D = 1024, T = NB * SEQ, LC = 256, TC = NB * LC, MROWS = T + TC;
constexpr int GW = 64, NROWS = SEQ / GW;
constexpr int INCOLS = 4096, SEGW = 512;
constexpr int NAH = 8, NAD = 64, HGH = 4, HGD = 128;
constexpr int KTOK = SEQ + LC;
constexpr int NE = 16, DE = 512, ECAP = T;
constexpr float EPS = 1e-6f;
constexpr int NWAVES = 8, NTHR = 512;

constexpr size_t MiB = 1u << 20;
constexpr size_t WS_CTL = 0, CTL_ZERO_BYTES = 32768;
constexpr size_t WS_MOD = 1 * MiB;
constexpr size_t WS_ROPE = WS_MOD + 512 * 1024, WS_LBT = WS_MOD + 520 * 1024;
constexpr size_t WS_ELIST = 2 * MiB, WS_EWT = 4 * MiB;
constexpr size_t WS_WINT = 8 * MiB, WS_WOUTT = 16 * MiB, WS_W13T = 18 * MiB, WS_W2T = 50 * MiB;
constexpr size_t WS_XN = 66 * MiB;
constexpr size_t WS_Q = 138 * MiB, WS_K = 170 * MiB, WS_V = 206 * MiB, WS_HQ = 242 * MiB, WS_HI = 274 * MiB, WS_LF = 310 * MiB, WS_LB = 346 * MiB, WS_G = 382 * MiB;
constexpr size_t WS_OF = 414 * MiB, WS_OB = 446 * MiB, WS_QR = 478 * MiB, WS_END = 510 * MiB;
constexpr size_t WS_MIX = WS_XN, WS_XN2 = WS_XN, WS_X1 = 138 * MiB, WS_H = 274 * MiB, WS_Y = 346 * MiB;
constexpr int CW_CNT = 64;
constexpr int CW_BAR = 4096;
static_assert((CW_BAR + 3456) * 4 <= (int)CTL_ZERO_BYTES, "barrier words inside the per-call memset");

constexpr int RING_OFF = 0, RING_BYTES = 131072;
constexpr int LDSCTL_OFF = RING_BYTES, MISC_OFF = LDSCTL_OFF + 320, MOE_OFF = LDSCTL_OFF + 1024;
constexpr int TAB_OFF = LDSCTL_OFF + 2048;
constexpr int LDS_BYTES = 147456;

__device__ __forceinline__ unsigned f2bf(float f) { unsigned u = __builtin_bit_cast(unsigned, f); return (u + 0x7fffu + ((u >> 16) & 1u)) >> 16; }
__device__ __forceinline__ unsigned pk2(float lo, float hi) { return f2bf(lo) | (f2bf(hi) << 16); }
__device__ __forceinline__ float bf2f(unsigned short b) { return __builtin_bit_cast(float, (unsigned)b << 16); }
__device__ __forceinline__ float bflo(unsigned u) { return __builtin_bit_cast(float, u << 16); }
__device__ __forceinline__ float bfhi(unsigned u) { return __builtin_bit_cast(float, u & 0xffff0000u); }
__device__ __forceinline__ unsigned pkh2(float lo, float hi) { _Float16 a = (_Float16)lo, b = (_Float16)hi; return (unsigned)__builtin_bit_cast(unsigned short, a) | ((unsigned)__builtin_bit_cast(unsigned short, b) << 16); }
__device__ __forceinline__ float h2f(unsigned short h) { return (float)__builtin_bit_cast(_Float16, h); }
__device__ __forceinline__ float silu_f(float v) { return v * __builtin_amdgcn_rcpf(1.f + __expf(-v)); }
__device__ __forceinline__ float wave_sum(float v) {
#pragma unroll
    for (int o = 1; o < 64; o <<= 1) v += __shfl_xor(v, o);
    return v;
}
__device__ __forceinline__ float wave_max(float v) {
#pragma unroll
    for (int o = 1; o < 64; o <<= 1) v = fmaxf(v, __shfl_xor(v, o));
    return v;
}

namespace pg8 {
constexpr int BM = 256, BK = 64, HALF = 128, HTB = HALF * BK * 2, STAGE_BYTES = 8 * HTB, NXCD = 8, WGM = 8;
__host__ __device__ __forceinline__ int lds_byte(int r, int c) { const int st = (r >> 4) * 2 + (c >> 5), rr = r & 15, cc = c & 31, ob = rr * 64 + cc * 2; return st * 1024 + (ob ^ (((ob >> 9) & 1) << 5)); }
__host__ __device__ __forceinline__ void stage_rc(int b, int& R, int& C) { const int st = b / 1024, sb = b % 1024, swz = sb ^ (((sb >> 9) & 1) << 5); R = (st >> 1) * 16 + swz / 64; C = (st & 1) * 32 + (swz % 64) / 2; }
__host__ __device__ __forceinline__ int perm32(int rho) { const int n = rho >> 4, i = rho & 15; return 8 * (i >> 2) + 4 * n + (i & 3); }

struct Unit { int pm, pn, e, tm, cnt; };

typedef float f32x2_t __attribute__((ext_vector_type(2))); typedef __bf16 bf16x2_t __attribute__((ext_vector_type(2)));
__device__ __forceinline__ unsigned cvt_pk_bf16(float lo, float hi) { f32x2_t v = {lo, hi}; bf16x2_t b = __builtin_convertvector(v, bf16x2_t); return __builtin_bit_cast(unsigned, b); }

struct DenseOrder {
    static constexpr bool GATHER = false;
    int nM, nN, nwg, G, c; bool pf;
    __device__ void init(int M, int N, int G_, int c_, bool pf_ = false) { nM = M / BM; nN = N / BM; nwg = nM * nN; G = G_; c = c_; pf = pf_; }
    __device__ bool next(int i, Unit& u) const {
        const long L = (long)i * G + c; if (L >= nwg) return false;
        int wgid = (int)L; { const int q = nwg / NXCD, r = nwg % NXCD, xcd = wgid % NXCD, off = wgid / NXCD; wgid = (xcd < r ? xcd * (q + 1) : r * (q + 1) + (xcd - r) * q) + off; }
        const int nig = WGM * nN, gid = wgid / nig, fm = gid * WGM, gsz = (nM - fm) < WGM ? (nM - fm) : WGM;
        u.pm = fm + ((wgid % nig) % gsz); u.pn = (wgid % nig) / gsz; u.e = 0; u.tm = 0; u.cnt = 0; return true;
    }
    __device__ __forceinline__ int a_row0(const Unit& u) const { return u.pm * BM; }
    __device__ __forceinline__ int a_row(const Unit& u, int r) const { return u.pm * BM + r; }
    __device__ __forceinline__ int b_row0(const Unit& u) const { return u.pn * BM; }
    __device__ __forceinline__ bool perm(const Unit&) const { return pf; }
};

template <class Epi, class Sched>
__device__ __forceinline__ void gemm_phase(LAS unsigned char* lds, const bf16_t* Aptr, const bf16_t* Btptr, const int K, const Sched& S, const Epi& E) {
    const int tid = threadIdx.x, wid = __builtin_amdgcn_readfirstlane(tid >> 6), lane = tid & 63, wr = wid >> 2, wc = wid & 3, fr = lane & 15, fq = lane >> 4;
    const int nt = K / BK;
    int sR[2], sC[2];
    unsigned voffA[2], voffBn[2], voffBp[2], voffB[2], nvB[2];
#pragma unroll
    for (int i = 0; i < 2; ++i) { int R, C; stage_rc(tid * 16 + i * 8192, R, C); const int Rb = (R & ~31) + perm32(R & 31);
        sR[i] = R; sC[i] = C; voffA[i] = (unsigned)(R * K + C) * 2u; voffBn[i] = (unsigned)(R * K + C) * 2u; voffBp[i] = (unsigned)(Rb * K + C) * 2u; }
    const size_t kstep = (size_t)(BK * 2);
    const size_t hstep = (size_t)HALF * K * 2;
    const size_t rowb = (size_t)K * 2;
    const unsigned ldsw = (unsigned)wid * 1024u;
    const int aoff = lds_byte(wr * 64 + fr, fq * 8), boff = lds_byte(wc * 32 + fr, fq * 8);
    const char* Ab = (const char*)Aptr;
#define PG8_SA(b, h) (((b) * 2 + (h)) * HTB)
#define PG8_SB(b, h) ((4 + (b) * 2 + (h)) * HTB)
#define PG8_STAGE(bufoff, gbase, voff) do { _Pragma("unroll") for (int _i = 0; _i < 2; ++_i) \
        __builtin_amdgcn_global_load_lds((const unsigned*)((const char*)(gbase) + (voff)[_i]), (LAS unsigned*)(lds + (bufoff) + ldsw + _i * 8192), 16, 0, 0); } while (0)
#define PG8_LDA(dst, b, h) do { _Pragma("unroll") for (int m = 0; m < 4; ++m) _Pragma("unroll") for (int k = 0; k < 2; ++k) dst[m][k] = *(const LAS bf16x8*)(lds + PG8_SA(b, h) + aoff + m * 2048 + k * 1024); } while (0)
#define PG8_LDB(dst, b, h) do { _Pragma("unroll") for (int n = 0; n < 2; ++n) _Pragma("unroll") for (int k = 0; k < 2; ++k) dst[n][k] = *(const LAS bf16x8*)(lds + PG8_SB(b, h) + boff + n * 2048 + k * 1024); } while (0)
#define PG8_MMA(ai, bj, At, Bt) do { __builtin_amdgcn_s_setprio(1); _Pragma("unroll") for (int m = 0; m < 4; ++m) _Pragma("unroll") for (int n = 0; n < 2; ++n) _Pragma("unroll") for (int k = 0; k < 2; ++k) \
        acc[ai][bj][m][n] = __builtin_amdgcn_mfma_f32_16x16x32_bf16(Bt[n][k], At[m][k], acc[ai][bj][m][n], 0, 0, 0); __builtin_amdgcn_s_setprio(0); } while (0)
#define PG8_WAIT_V(n) asm volatile("s_waitcnt vmcnt(" #n ")" ::: "memory")
#define PG8_WAIT_L(n) asm volatile("s_waitcnt lgkmcnt(" #n ")" ::: "memory")
#define PG8_BAR __builtin_amdgcn_s_barrier()
#define PG8_SCHED __builtin_amdgcn_sched_barrier(0)
    Unit cur, nxt; int ui = 0;
    if (!S.next(0, cur)) return;
    f32x4 acc[2][2][4][2];
#pragma unroll
    for (int a = 0; a < 2; ++a)
#pragma unroll
        for (int b = 0; b < 2; ++b)
#pragma unroll
            for (int m = 0; m < 4; ++m)
#pragma unroll
                for (int n = 0; n < 2; ++n) acc[a][b][m][n] = (f32x4){0.f, 0.f, 0.f, 0.f};
    bf16x8 At[4][2], B0[2][2], B1[2][2];
    const char* cA = Ab; unsigned cG[2][2];
    if constexpr (Sched::GATHER) {
#pragma unroll
        for (int h = 0; h < 2; ++h)
#pragma unroll
            for (int i = 0; i < 2; ++i) cG[h][i] = (unsigned)((size_t)S.a_row(cur, h * HALF + sR[i]) * rowb) + (unsigned)sC[i] * 2u;
    } else { cA = Ab + (ptrdiff_t)S.a_row0(cur) * (ptrdiff_t)rowb; cG[0][0] = cG[0][1] = cG[1][0] = cG[1][1] = 0u; }
    const char* cB = (const char*)Btptr + (ptrdiff_t)S.b_row0(cur) * (ptrdiff_t)rowb;
    { const bool pc = S.perm(cur); voffB[0] = pc ? voffBp[0] : voffBn[0]; voffB[1] = pc ? voffBp[1] : voffBn[1]; }
#define PG8_STAGEA(bufoff, h, dbase, goffs, kb) do { if constexpr (Sched::GATHER) { PG8_STAGE(bufoff, Ab + (kb), (goffs)[h]); } else { PG8_STAGE(bufoff, (dbase) + (h) * hstep + (kb), voffA); } } while (0)
    PG8_STAGE(PG8_SB(0, 0), cB, voffB); PG8_STAGE(PG8_SB(0, 1), cB + hstep, voffB); PG8_STAGEA(PG8_SA(0, 0), 0, cA, cG, 0); PG8_STAGEA(PG8_SA(0, 1), 1, cA, cG, 0);
    if (wr == 1) PG8_BAR;
    PG8_WAIT_V(2); PG8_BAR;
    PG8_STAGE(PG8_SB(1, 0), cB + kstep, voffB); PG8_STAGEA(PG8_SA(1, 0), 0, cA, cG, kstep); PG8_STAGE(PG8_SB(1, 1), cB + hstep + kstep, voffB);
    PG8_WAIT_V(6); PG8_BAR;
    for (;;) {
        const bool has_next = S.next(ui + 1, nxt);
        const char* nA = cA; const char* nB = cB; unsigned nG[2][2];
#pragma unroll
        for (int h = 0; h < 2; ++h)
#pragma unroll
            for (int i = 0; i < 2; ++i) nG[h][i] = cG[h][i];
        nvB[0] = voffB[0]; nvB[1] = voffB[1];
        if (has_next) {
            nB = (const char*)Btptr + (ptrdiff_t)S.b_row0(nxt) * (ptrdiff_t)rowb;
            { const bool pn_ = S.perm(nxt); nvB[0] = pn_ ? voffBp[0] : voffBn[0]; nvB[1] = pn_ ? voffBp[1] : voffBn[1]; }
            if constexpr (Sched::GATHER) {
#pragma unroll
                for (int h = 0; h < 2; ++h)
#pragma unroll
                    for (int i = 0; i < 2; ++i) nG[h][i] = (unsigned)((size_t)S.a_row(nxt, h * HALF + sR[i]) * rowb) + (unsigned)sC[i] * 2u;
            } else nA = Ab + (ptrdiff_t)S.a_row0(nxt) * (ptrdiff_t)rowb;
        }
        for (int t = 0; t < nt; t += 2) {
            const bool last = (t == nt - 2);
            const size_t kb1 = (size_t)(t + 1) * kstep;
            const size_t kb2 = last ? 0 : (size_t)(t + 2) * kstep, kb3 = kb2 + kstep;
            const char* a2 = last ? nA : cA; const char* b2 = last ? nB : cB + (size_t)(t + 2) * kstep; const char* b3 = b2 + kstep;
            unsigned vB2[2]; vB2[0] = last ? nvB[0] : voffB[0]; vB2[1] = last ? nvB[1] : voffB[1];
            unsigned g2[2][2];
#pragma unroll
            for (int h = 0; h < 2; ++h)
#pragma unroll
                for (int i = 0; i < 2; ++i) g2[h][i] = last ? nG[h][i] : cG[h][i];
            PG8_LDB(B0, 0, 0); PG8_LDB(B1, 0, 1); PG8_SCHED; PG8_LDA(At, 0, 0); PG8_STAGEA(PG8_SA(1, 1), 1, cA, cG, kb1);
            PG8_WAIT_V(8); PG8_WAIT_L(0); PG8_BAR; PG8_MMA(0, 0, At, B0); PG8_MMA(0, 1, At, B1); PG8_BAR; PG8_SCHED;
            PG8_LDA(At, 0, 1); PG8_STAGE(PG8_SB(0, 0), b2, vB2); PG8_STAGE(PG8_SB(0, 1), b2 + hstep, vB2); PG8_STAGEA(PG8_SA(0, 0), 0, a2, g2, kb2);
            PG8_WAIT_V(8); PG8_WAIT_L(0); PG8_BAR; PG8_MMA(1, 0, At, B0); PG8_MMA(1, 1, At, B1); PG8_BAR; PG8_SCHED;
            PG8_LDB(B0, 1, 0); PG8_LDB(B1, 1, 1); PG8_SCHED; PG8_LDA(At, 1, 0); PG8_STAGEA(PG8_SA(0, 1), 1, a2, g2, kb2);
            PG8_WAIT_V(8); PG8_WAIT_L(0); PG8_BAR; PG8_MMA(0, 0, At, B0); PG8_MMA(0, 1, At, B1); PG8_BAR; PG8_SCHED;
            PG8_LDA(At, 1, 1); PG8_STAGE(PG8_SB(1, 0), b3, vB2); PG8_STAGE(PG8_SB(1, 1), b3 + hstep, vB2); PG8_STAGEA(PG8_SA(1, 0), 0, a2, g2, kb3);
            PG8_WAIT_V(8); PG8_WAIT_L(0); PG8_BAR; PG8_MMA(1, 0, At, B0); PG8_MMA(1, 1, At, B1); PG8_BAR; PG8_SCHED;
        }
        if (wr == 0) PG8_BAR;
        E(acc, cur, wr, wc, fr, fq);
        if (!has_next) break;
#pragma unroll
        for (int a = 0; a < 2; ++a)
#pragma unroll
            for (int b = 0; b < 2; ++b)
#pragma unroll
                for (int m = 0; m < 4; ++m)
#pragma unroll
                    for (int n = 0; n < 2; ++n) acc[a][b][m][n] = (f32x4){0.f, 0.f, 0.f, 0.f};
        cur = nxt; cA = nA; cB = nB; ++ui; voffB[0] = nvB[0]; voffB[1] = nvB[1];
#pragma unroll
        for (int h = 0; h < 2; ++h)
#pragma unroll
            for (int i = 0; i < 2; ++i) cG[h][i] = nG[h][i];
        if (wr == 1) PG8_BAR;
    }
    PG8_WAIT_V(0);
    PG8_BAR;
#undef PG8_SA
#undef PG8_SB
#undef PG8_STAGE
#undef PG8_STAGEA
#undef PG8_LDA
#undef PG8_LDB
#undef PG8_MMA
#undef PG8_WAIT_V
#undef PG8_WAIT_L
#undef PG8_BAR
#undef PG8_SCHED
}
}

#define XB_TMO      128
#define XB_XCNT(j)  (256  + 64 * (j))
#define XB_XSUB(j)  (1280 + 64 * (j))
#define XB_XGEN(j)  (2304 + 64 * (j))
#define XB_TOP      3328
#define XB_TOPGEN   3392
#define XCD_BAR_WORDS 3456
#define XB_SPIN_CAP (1u << 18)
__device__ __forceinline__ unsigned xb_ld(unsigned* p)              { return __hip_atomic_load(p, __ATOMIC_RELAXED, __HIP_MEMORY_SCOPE_AGENT); }
__device__ __forceinline__ unsigned xb_add(unsigned* p, unsigned v) { return __hip_atomic_fetch_add(p, v, __ATOMIC_RELAXED, __HIP_MEMORY_SCOPE_AGENT); }
__device__ __forceinline__ unsigned xb_xcc_id() { return (unsigned)__builtin_amdgcn_s_getreg((3 << 11) | 20) & 0xFu; }
#define XB_SPIN(cond, bar) do { unsigned _sp = 0; while (cond) { __builtin_amdgcn_s_sleep(1); \
    if ((++_sp & 255u) == 0u) { if (xb_ld(&(bar)[XB_TMO])) break; if (_sp > XB_SPIN_CAP) { atomicAdd(&(bar)[XB_TMO], 1u); break; } } } } while (0)
struct XcdBarrier { unsigned* bar; unsigned x; volatile LAS unsigned* st; };
__device__ __forceinline__ XcdBarrier xcd_barrier_post(unsigned* bar, volatile LAS unsigned* st) {
    XcdBarrier b; b.bar = bar; b.x = xb_xcc_id(); b.st = st;
    if (threadIdx.x == 0) (void)xb_add(&bar[XB_XCNT(b.x)], 1u);
    return b;
}
__device__ __forceinline__ void xcd_barrier_complete(unsigned* bar, unsigned x, unsigned& nloc, unsigned& nx) {
    const unsigned G = gridDim.x * gridDim.y * gridDim.z;
    unsigned sum, cnt, mine, sp = 0u;
    for (;;) {
        sum = 0u; cnt = 0u; mine = 0u;
#pragma unroll
        for (unsigned j = 0; j < 16; ++j) { const unsigned c = xb_ld(&bar[XB_XCNT(j)]); sum += c; cnt += (c > 0u) ? 1u : 0u; mine = (j == x) ? c : mine; }
        if (sum == G) break;
        __builtin_amdgcn_s_sleep(1);
        if ((++sp & 255u) == 0u) { if (xb_ld(&bar[XB_TMO])) break; if (sp > XB_SPIN_CAP) { atomicAdd(&bar[XB_TMO], 1u); break; } }
    }
    nloc = mine > 0u ? mine : 1u; nx = cnt > 0u ? cnt : 1u;
}
__device__ __forceinline__ void xcd_barrier(const XcdBarrier& b) {
    asm volatile("s_waitcnt vmcnt(0)" ::: "memory");
    __syncthreads();
    if (threadIdx.x == 0) {
        unsigned* bar = b.bar;
        __builtin_amdgcn_s_waitcnt(0);
        unsigned nloc = b.st[0], nx = b.st[1];
        if (nloc == 0u) { xcd_barrier_complete(bar, b.x, nloc, nx); b.st[0] = nloc; b.st[1] = nx; }
        const unsigned old = xb_add(&bar[XB_XSUB(b.x)], 1u);
        const unsigned gen = old / nloc;
        if (old + 1u == (gen + 1u) * nloc) {
            __builtin_amdgcn_fence(__ATOMIC_RELEASE, "agent");
            asm volatile("s_waitcnt vmcnt(0)" ::: "memory");
            const unsigned og = xb_add(&bar[XB_TOP], 1u);
            const unsigned tg = og / nx;
            if (og + 1u == (tg + 1u) * nx) xb_add(&bar[XB_TOPGEN], 1u);
            else XB_SPIN(xb_ld(&bar[XB_TOPGEN]) == tg, bar);
            __builtin_amdgcn_fence(__ATOMIC_ACQUIRE, "agent");
            xb_add(&bar[XB_XGEN(b.x)], 1u);
            asm volatile("s_waitcnt vmcnt(0)" ::: "memory");
        } else {
            XB_SPIN(xb_ld(&bar[XB_XGEN(b.x)]) == gen, bar);
            __builtin_amdgcn_fence(__ATOMIC_ACQUIRE, "agent");
            asm volatile("s_waitcnt vmcnt(0)" ::: "memory");
        }
    }
    __syncthreads();
}

using pg8::Unit;
typedef f32x4 acc_t[2][2][4][2];

struct EpiProj {
    static constexpr bool PERM = false;
    unsigned char* ws; const LAS float* ropeL; const LAS float* lbtL; int skip;
    template <int KIND> __device__ __forceinline__ void swapped(const acc_t& acc, const Unit& u, int wr, int wc, int fr, int fq, bool latent) const {
        constexpr size_t so2 = KIND == 0 ? WS_V : KIND == 1 ? WS_HQ : KIND == 2 ? WS_HI : KIND == 3 ? WS_LF : WS_LB;
        bf16* dT = (bf16*)(ws + so2);
        constexpr int ldt = (KIND == 1) ? T : MROWS;
        const int wrow0 = (u.pn & 1) * 256 + wr * 64 + fr, tcol0 = u.pm * 256 + wc * 32 + 8 * fq;
        const LAS float* lbt = lbtL + (KIND == 4 ? 512 : 0);
#pragma unroll
        for (int ai = 0; ai < 2; ++ai)
#pragma unroll
            for (int m = 0; m < 4; ++m) { const int wrow = wrow0 + ai * 128 + m * 16; float lb = 0.f; if (KIND >= 3) lb = lbt[wrow];
#pragma unroll
                for (int bj = 0; bj < 2; ++bj) { float x[8]; u32x4 w;
#pragma unroll
                    for (int j = 0; j < 4; ++j) { x[j] = acc[ai][bj][m][0][j]; x[4 + j] = acc[ai][bj][m][1][j]; }
                    if (KIND >= 3) {
#pragma unroll
                        for (int j = 0; j < 8; ++j) { const float sg = __builtin_amdgcn_rcpf(1.f + __expf(-x[j])); x[j] = __log2f(lb + (1.f - lb) * sg); }
                        w = (u32x4){pkh2(x[0], x[1]), pkh2(x[2], x[3]), pkh2(x[4], x[5]), pkh2(x[6], x[7])}; }
                    else { if (KIND == 1) {
#pragma unroll
                            for (int j = 0; j < 8; ++j) x[j] = silu_f(x[j]); }
                        w = (u32x4){pg8::cvt_pk_bf16(x[0], x[1]), pg8::cvt_pk_bf16(x[2], x[3]), pg8::cvt_pk_bf16(x[4], x[5]), pg8::cvt_pk_bf16(x[6], x[7])}; }
                    size_t off = (size_t)wrow * ldt + tcol0 + bj * 128;
                    if (KIND == 0) { const int tc = tcol0 + bj * 128, bb_ = latent ? (tc >> 11) : ((tc - T) >> 8), tl = latent ? (tc & (SEQ - 1)) : (KTOK - LC + ((tc - T) & (LC - 1)));
                        off = ((((size_t)(bb_ * NAH + (wrow >> 6)) * (KTOK / 64) + (tl >> 6)) * NAD + (wrow & 63)) * 64) + (tl & 63); }
                    *(u32x4*)(dT + off) = w; } }
    }
    template <int SEG, bool LAT> __device__ __forceinline__ void rope(const acc_t& acc, int row0, int lcp, int wc, int fq) const {
        bf16* dK = (bf16*)(ws + (SEG == 0 ? WS_QR : WS_K)); bf16* dQ = (bf16*)(ws + WS_Q);
#pragma unroll
        for (int ai = 0; ai < 2; ++ai)
#pragma unroll
            for (int m = 0; m < 4; ++m) { const int row = row0 + ai * 128 + m * 16, sq = row & (SEQ - 1); const int pos = (wc & 1) ? (sq & 63) : (sq >> 6);
                f32x4 cs0 = (f32x4){1.f, 0.f, 1.f, 0.f}, cs1 = cs0;
                if (LAT) { cs0 = *(const LAS f32x4*)(ropeL + (pos * 16 + 4 * fq) * 2); cs1 = *(const LAS f32x4*)(ropeL + (pos * 16 + 4 * fq) * 2 + 4); }
                const float cc[4] = {cs0[0], cs0[2], cs1[0], cs1[2]}, sn[4] = {cs0[1], cs0[3], cs1[1], cs1[3]};
#pragma unroll
                for (int bj = 0; bj < 2; ++bj) { const f32x4 x1 = acc[ai][bj][m][0], x2 = acc[ai][bj][m][1]; float o1[4], o2[4];
#pragma unroll
                    for (int j = 0; j < 4; ++j) { o1[j] = LAT ? x1[j] * cc[j] - x2[j] * sn[j] : x1[j]; o2[j] = LAT ? x2[j] * cc[j] + x1[j] * sn[j] : x2[j]; }
                    size_t off = (size_t)row * SEGW + lcp + bj * 128;
                    if (SEG == 0) *(u32x4*)(dQ + off) = (u32x4){pg8::cvt_pk_bf16(x1[0], x1[1]), pg8::cvt_pk_bf16(x1[2], x1[3]), pg8::cvt_pk_bf16(x2[0], x2[1]), pg8::cvt_pk_bf16(x2[2], x2[3])};
                    else { const int cf = lcp + bj * 128, bb_ = LAT ? (row >> 11) : ((row - T) >> 8), tl = LAT ? sq : (KTOK - LC + ((row - T) & (LC - 1)));
                        off = ((size_t)(bb_ * NAH + (cf >> 6)) * KTOK + tl) * NAD + (cf & 63); }
                    *(u32x4*)(dK + off) = (u32x4){pg8::cvt_pk_bf16(o1[0], o1[1]), pg8::cvt_pk_bf16(o1[2], o1[3]), pg8::cvt_pk_bf16(o2[0], o2[1]), pg8::cvt_pk_bf16(o2[2], o2[3])}; } }
    }
    __device__ __forceinline__ void operator()(const acc_t& acc, const Unit& u, int wr, int wc, int fr, int fq) const {
        const int seg = u.pn >> 1; const bool latent = u.pm < (T / 256);
        if (skip) return;
        if (!latent && (seg == 0 || seg == 3 || seg == 7)) return;
        if (u.e) {
            if (seg == 2) swapped<0>(acc, u, wr, wc, fr, fq, latent);
            else if (seg == 3) swapped<1>(acc, u, wr, wc, fr, fq, latent);
            else if (seg == 4) swapped<2>(acc, u, wr, wc, fr, fq, latent);
            else if (seg == 5) swapped<3>(acc, u, wr, wc, fr, fq, latent);
            else swapped<4>(acc, u, wr, wc, fr, fq, latent);
            return;
        }
        const int row0 = u.pm * 256 + wr * 64 + fr;
        const int lcp = (u.pn & 1) * 256 + wc * 32 + 8 * fq;
        if (seg <= 1) {
            if (seg == 0) rope<0, true>(acc, row0, lcp, wc, fq);
            else if (latent) rope<1, true>(acc, row0, lcp, wc, fq);
            else rope<1, false>(acc, row0, lcp, wc, fq);
            return;
        }
        bf16* dG = (bf16*)(ws + WS_G);
#pragma unroll
        for (int ai = 0; ai < 2; ++ai)
#pragma unroll
            for (int m = 0; m < 4; ++m) { const int row = row0 + ai * 128 + m * 16;
#pragma unroll
                for (int bj = 0; bj < 2; ++bj) { float x[8];
#pragma unroll
                    for (int j = 0; j < 4; ++j) { x[j] = silu_f(acc[ai][bj][m][0][j]); x[4 + j] = silu_f(acc[ai][bj][m][1][j]); }
                    *(u32x4*)(dG + (size_t)row * SEGW + lcp + bj * 128) = (u32x4){pg8::cvt_pk_bf16(x[0], x[1]), pg8::cvt_pk_bf16(x[2], x[3]), pg8::cvt_pk_bf16(x[4], x[5]), pg8::cvt_pk_bf16(x[6], x[7])}; } }
    }
};
struct EpiP {
    static constexpr bool PERM = true;
    bf16* P;
    __device__ __forceinline__ void operator()(const acc_t& acc, const Unit& u, int wr, int wc, int fr, int fq) const {
        const int col0 = u.pn * 256 + wc * 32 + 8 * fq; const int row0 = u.pm * 256 + wr * 64 + fr;
#pragma unroll
        for (int ai = 0; ai < 2; ++ai)
#pragma unroll
            for (int m = 0; m < 4; ++m)
#pragma unroll
                for (int bj = 0; bj < 2; ++bj) { const f32x4 v0 = acc[ai][bj][m][0], v1 = acc[ai][bj][m][1];
                    *(u32x4*)(P + (size_t)(row0 + ai * 128 + m * 16) * D + col0 + bj * 128) = (u32x4){pg8::cvt_pk_bf16(v0[0], v0[1]), pg8::cvt_pk_bf16(v0[2], v0[3]), pg8::cvt_pk_bf16(v1[0], v1[1]), pg8::cvt_pk_bf16(v1[2], v1[3])}; }
    }
};
struct EpiSwiGLU {
    static constexpr bool PERM = true;
    bf16* H;
    __device__ __forceinline__ void operator()(const acc_t& acc, const Unit& u, int wr, int wc, int fr, int fq) const {
        const int hc = u.pn * 128 + wc * 32 + 8 * fq; const int row0 = u.pm * 256 + wr * 64 + fr;
#pragma unroll
        for (int ai = 0; ai < 2; ++ai)
#pragma unroll
            for (int m = 0; m < 4; ++m) { float h[8];
#pragma unroll
                for (int n = 0; n < 2; ++n)
#pragma unroll
                    for (int j = 0; j < 4; ++j) h[n * 4 + j] = silu_f(acc[ai][0][m][n][j]) * acc[ai][1][m][n][j];
                u32x4 w; w.x = pg8::cvt_pk_bf16(h[0], h[1]); w.y = pg8::cvt_pk_bf16(h[2], h[3]); w.z = pg8::cvt_pk_bf16(h[4], h[5]); w.w = pg8::cvt_pk_bf16(h[6], h[7]);
                *(u32x4*)(H + (size_t)(row0 + ai * 128 + m * 16) * DE + hc) = w; }
    }
};
struct EpiMoeOut {
    static constexpr bool PERM = true;
    bf16* Y; const int* elist; const float* ewt;
    __device__ __forceinline__ void operator()(const acc_t& acc, const Unit& u, int wr, int wc, int fr, int fq) const {
        const int col0 = u.pn * 256 + wc * 32 + 8 * fq;
#pragma unroll
        for (int ai = 0; ai < 2; ++ai)
#pragma unroll
            for (int m = 0; m < 4; ++m) { const int rank = u.tm * 256 + ai * 128 + wr * 64 + m * 16 + fr;
                if (rank < u.cnt) { const int tk = elist[u.e * ECAP + rank]; const float w = ewt[u.e * ECAP + rank];
#pragma unroll
                    for (int bj = 0; bj < 2; ++bj) { const f32x4 v0 = acc[ai][bj][m][0] * w, v1 = acc[ai][bj][m][1] * w; u32x4 o;
                        o.x = pg8::cvt_pk_bf16(v0[0], v0[1]); o.y = pg8::cvt_pk_bf16(v0[2], v0[3]); o.z = pg8::cvt_pk_bf16(v1[0], v1[1]); o.w = pg8::cvt_pk_bf16(v1[2], v1[3]);
                        *(u32x4*)(Y + (size_t)tk * D + col0 + bj * 128) = o; } } }
    }
};
template <bool GATHER_> struct MoeOrder {
    static constexpr bool GATHER = GATHER_;
    const LAS int* tp; const int* elist; int G, c, nwg;
    __device__ bool next(int i, Unit& u) const {
        const long L = (long)i * G + c; if (L >= nwg) return false;
        int wgid = (int)L; { const int q = nwg / 8, r = nwg % 8, xcd = wgid % 8, off = wgid / 8; wgid = (xcd < r ? xcd * (q + 1) : r * (q + 1) + (xcd - r) * q) + off; }
        const int gt = wgid >> 2; int e = 0;
#pragma unroll
        for (int k = 1; k < 16; ++k) e = (gt >= tp[k]) ? k : e;
        u.pm = gt; u.pn = wgid & 3; u.e = e; u.tm = gt - tp[e]; u.cnt = tp[17 + e]; return true;
    }
    __device__ __forceinline__ int a_row0(const Unit& u) const { return u.pm * 256; }
    __device__ __forceinline__ int a_row(const Unit& u, int r) const {
        if constexpr (GATHER_) { int rank = u.tm * 256 + r; rank = rank < u.cnt ? rank : u.cnt - 1; return elist[u.e * ECAP + rank] >> 1; }
        else return u.pm * 256 + r;
    }
    __device__ __forceinline__ int b_row0(const Unit& u) const { return u.e * 1024 + u.pn * 256; }
    __device__ __forceinline__ bool perm(const Unit&) const { return true; }
};


constexpr int SWMASK = 0x7C;
constexpr int W_REL_XN = (int)(((long long)WS_WINT - (long long)WS_XN) / 2048);
struct ProjOrder {
    static constexpr bool GATHER = false;
    pg8::DenseOrder d;
    __device__ void init(int G_, int c_) { d.init(MROWS, INCOLS, G_, c_); }
    __device__ bool next(int i, Unit& u) const { if (!d.next(i, u)) return false; u.e = (SWMASK >> (u.pn >> 1)) & 1; return true; }
    __device__ __forceinline__ int a_row0(const Unit& u) const { return u.e ? W_REL_XN + u.pn * 256 : u.pm * 256; }
    __device__ __forceinline__ int a_row(const Unit& u, int r) const { return a_row0(u) + r; }
    __device__ __forceinline__ int b_row0(const Unit& u) const { return u.e ? -W_REL_XN + u.pm * 256 : u.pn * 256; }
    __device__ __forceinline__ bool perm(const Unit& u) const { return (u.pn >> 1) >= 2; }
};


__device__ __forceinline__ bf16x8 pack8(const f32x4& a, const f32x4& b) {
    u32x4 w; w.x = pg8::cvt_pk_bf16(a[0], a[1]); w.y = pg8::cvt_pk_bf16(a[2], a[3]); w.z = pg8::cvt_pk_bf16(b[0], b[1]); w.w = pg8::cvt_pk_bf16(b[2], b[3]);
    return __builtin_bit_cast(bf16x8, w);
}
typedef unsigned bu4 __attribute__((__vector_size__(16)));
__device__ __forceinline__ bf16x8 bload16(__amdgpu_buffer_rsrc_t r, unsigned voff, unsigned soff) { return __builtin_bit_cast(bf16x8, __builtin_amdgcn_raw_buffer_load_b128(r, (int)voff, (int)soff, 0)); }
#define NA_SB() __builtin_amdgcn_sched_barrier(0)
__device__ __forceinline__ bf16x8 sel8(bool c, const bf16x8 a, const bf16x8 b) { const u32x4 x = __builtin_bit_cast(u32x4, a), y = __builtin_bit_cast(u32x4, b); u32x4 r;
    r.x = c ? x.x : y.x; r.y = c ? x.y : y.y; r.z = c ? x.z : y.z; r.w = c ? x.w : y.w; return __builtin_bit_cast(bf16x8, r); }
constexpr int NA_CTXK = 0, NA_CTXV = 32768, NA_RING = 65536, NA_SLOT = 16384;
#define NA_BAR() do { asm volatile("s_waitcnt lgkmcnt(0)" ::: "memory"); __builtin_amdgcn_s_barrier(); asm volatile("" ::: "memory"); } while (0)
struct NaState { f32x4 o[2][4]; float mref[2], lsum[2]; };
template <bool LOCAL>
__device__ __forceinline__ void na_step(NaState& st, const bf16x8 (&q)[2][2], const LAS unsigned char* kb, const LAS unsigned char* vb, unsigned vsw, const LAS float* bpi,
                                        bool setref, int qi, int g, int jb) {
    constexpr float SC = 0.125f * 1.44269504f; const float NEG = -1e30f;
    const int rg = qi >> 2;
    const unsigned kx = (unsigned)((rg << 1) | ((qi >> 1) & 1)), vx = (unsigned)((qi >> 1) & 7);
    const unsigned ka0 = (unsigned)(8 * rg + (qi & 3)) * 128u + (((unsigned)g ^ kx) << 4), ka1 = ka0 ^ 64u;
    const unsigned va = (unsigned)qi * 128u + (((unsigned)g ^ vx) << 4);
#pragma unroll
    for (int j = 0; j < 2; ++j) {
        const int jj = jb + j; const int P0 = (jj == 0) ? 0 : (jj == 1) ? 1 : (jj == 2) ? 3 : 4;
        const int pk = P0 + ((rg - P0) & 3), pv = P0 + ((g - P0) & 3);
        const unsigned kh = LOCAL ? (unsigned)(pk >> 2) * 4096u : 0u, vh = LOCAL ? (unsigned)(pv >> 2) * 64u : 0u;
        const bf16x8 a00 = *(const LAS bf16x8*)(kb + (ka0 + kh)), a01 = *(const LAS bf16x8*)(kb + (ka1 + kh)), a10 = *(const LAS bf16x8*)(kb + 512 + (ka0 + kh)), a11 = *(const LAS bf16x8*)(kb + 512 + (ka1 + kh));
        bf16x8 vf[4]; const unsigned vaj = (va ^ vsw) ^ vh;
#pragma unroll
        for (int dt = 0; dt < 4; ++dt) vf[dt] = *(const LAS bf16x8*)(vb + dt * 2048 + vaj);
        f32x4 s0 = __builtin_amdgcn_mfma_f32_16x16x32_bf16(a00, q[j][0], (f32x4){0.f, 0.f, 0.f, 0.f}, 0, 0, 0); s0 = __builtin_amdgcn_mfma_f32_16x16x32_bf16(a01, q[j][1], s0, 0, 0, 0);
        f32x4 s1 = __builtin_amdgcn_mfma_f32_16x16x32_bf16(a10, q[j][0], (f32x4){0.f, 0.f, 0.f, 0.f}, 0, 0, 0); s1 = __builtin_amdgcn_mfma_f32_16x16x32_bf16(a11, q[j][1], s1, 0, 0, 0);
        if (LOCAL) {
            const int bbj = 8 * pv - (16 * jj + qi) + 31;
            const int dlo = (jj == 0) ? (qi < 8 ? 31 - qi : 23) : (jj == 3) ? (qi > 8 ? 31 - qi : 23) : 23;
            const int lo_j = dlo - bbj; const LAS float* bpj = bpi + bbj;
            { float b0 = bpj[0], b1 = bpj[1], b2 = bpj[2], b3 = bpj[3];
              asm volatile("" : "+v"(b0), "+v"(b1), "+v"(b2), "+v"(b3));
              const float bq[4] = {b0, b1, b2, b3};
#pragma unroll
              for (int e = 0; e < 4; ++e) { const float t0 = s0[e] * SC + bq[e]; s0[e] = ((unsigned)(e - lo_j) < 16u) ? t0 : NEG; } }
            { float b0 = bpj[4], b1 = bpj[5], b2 = bpj[6], b3 = bpj[7];
              asm volatile("" : "+v"(b0), "+v"(b1), "+v"(b2), "+v"(b3));
              const float bq[4] = {b0, b1, b2, b3};
#pragma unroll
              for (int e = 0; e < 4; ++e) { const float t1 = s1[e] * SC + bq[e]; s1[e] = ((unsigned)(4 + e - lo_j) < 16u) ? t1 : NEG; } }
        } else {
#pragma unroll
            for (int e = 0; e < 4; ++e) { s0[e] *= SC; s1[e] *= SC; }
        }
        if (setref) { float mx = fmaxf(fmaxf(fmaxf(s0[0], s0[1]), fmaxf(s0[2], s0[3])), fmaxf(fmaxf(s1[0], s1[1]), fmaxf(s1[2], s1[3])));
            mx = fmaxf(mx, __shfl_xor(mx, 16)); mx = fmaxf(mx, __shfl_xor(mx, 32)); st.mref[j] = mx; }
        float ps = 0.f;
#pragma unroll
        for (int e = 0; e < 4; ++e) { s0[e] = __builtin_amdgcn_exp2f(fminf(s0[e] - st.mref[j], 100.f)); s1[e] = __builtin_amdgcn_exp2f(fminf(s1[e] - st.mref[j], 100.f)); ps += s0[e] + s1[e]; }
        st.lsum[j] += ps; const bf16x8 Bp = pack8(s0, s1);
#pragma unroll
        for (int dt = 0; dt < 4; ++dt) st.o[j][dt] = __builtin_amdgcn_mfma_f32_16x16x32_bf16(vf[dt], Bp, st.o[j][dt], 0, 0, 0);
    }
}
__device__ __forceinline__ void na_wg(LAS unsigned char* lds, int bb, int h, const bf16* Q, const bf16* QR, const bf16* KH, const bf16* VH, bf16* MIX, const LAS float* rpbL, int tid) {
    const int lane = tid & 63, w = __builtin_amdgcn_readfirstlane(tid >> 6), qi = lane & 15, g = lane >> 4;
    const int jb = 2 * (w & 1);
    const size_t bh = (size_t)(bb * NAH + h);
    { const u32x4* ksrc = (const u32x4*)(KH + (bh * KTOK + SEQ) * NAD); const u32x4* vsrc = (const u32x4*)(VH + (bh * (KTOK / 64) + SEQ / 64) * (NAD * 64));
#pragma unroll
      for (int j = 0; j < 4; ++j) { const int L = tid + NTHR * j; const u32x4 kv = ksrc[L], vv = vsrc[L];
          const int key = L >> 3, ch = L & 7, fk = (((key >> 3) & 3) << 1) | ((key >> 1) & 1);
          *(LAS u32x4*)(lds + NA_CTXK + key * 128 + ((ch ^ fk) << 4)) = kv;
          const int blk = L >> 9, dd = (L >> 3) & 63;
          *(LAS u32x4*)(lds + NA_CTXV + blk * 8192 + dd * 128 + ((ch ^ ((dd >> 1) & 7)) << 4)) = vv; } }
    const int skey = tid >> 3, sch = tid & 7;
    const unsigned skoff = (unsigned)(skey * 128 + ((sch ^ ((((skey >> 3) & 3) << 1) | ((skey >> 1) & 1))) << 4)), svoff = (unsigned)(8192 + skey * 128 + ((sch ^ ((skey >> 1) & 7)) << 4));
    const u32x4* kg = (const u32x4*)(KH + bh * KTOK * NAD) + tid;
    const u32x4* vg = (const u32x4*)(VH + bh * (KTOK / 64) * (NAD * 64)) + tid;
#pragma unroll 1
    for (int item = 0; item < 8; ++item) {
        const int r0 = 4 * item, r = r0 + (w >> 1);
        int rs = r - 4; rs = rs < 0 ? 0 : (rs > NROWS - 8 ? NROWS - 8 : rs);
        int rs0 = r0 - 4; rs0 = rs0 < 0 ? 0 : (rs0 > NROWS - 8 ? NROWS - 8 : rs0);
        int rs3 = r0 - 1; rs3 = rs3 < 0 ? 0 : (rs3 > NROWS - 8 ? NROWS - 8 : rs3);
        const int nloc = rs3 + 8 - rs0, off = rs - rs0;
        const int tok0 = bb * SEQ + r * GW;
        NaState st; bf16x8 qrot[2][2], qraw[2][2];
#pragma unroll
        for (int j = 0; j < 2; ++j) { st.mref[j] = 0.f; st.lsum[j] = 0.f;
#pragma unroll
            for (int dt = 0; dt < 4; ++dt) st.o[j][dt] = (f32x4){0.f, 0.f, 0.f, 0.f};
            const size_t qo = (size_t)(tok0 + 16 * (jb + j) + qi) * SEGW + h * NAD + 8 * g;
            qrot[j][0] = *(const bf16x8*)(QR + qo); qrot[j][1] = *(const bf16x8*)(QR + qo + 32); qraw[j][0] = *(const bf16x8*)(Q + qo); qraw[j][1] = *(const bf16x8*)(Q + qo + 32); }
        u32x4 sk = kg[(size_t)rs0 * 512], sv = vg[(size_t)rs0 * 512];
        *(LAS u32x4*)(lds + NA_RING + skoff) = sk; *(LAS u32x4*)(lds + NA_RING + svoff) = sv;
        sk = kg[(size_t)(rs0 + 1) * 512]; sv = vg[(size_t)(rs0 + 1) * 512];
        NA_BAR();
        int ic = 0;
#pragma unroll 1
        for (int slot = 0; slot < 16; ++slot) {
            if (slot + 1 < nloc) { const int rsl = (slot + 1) % 3; *(LAS u32x4*)(lds + NA_RING + rsl * NA_SLOT + skoff) = sk; *(LAS u32x4*)(lds + NA_RING + rsl * NA_SLOT + svoff) = sv; }
            { const int nr = slot + 2 < nloc ? slot + 2 : nloc - 1; sk = kg[(size_t)(rs0 + nr) * 512]; sv = vg[(size_t)(rs0 + nr) * 512]; }
            int qz = qi, gz = g; asm volatile("" : "+v"(qz), "+v"(gz));
            const int il = slot - off;
            if (il >= 0 && il < 8) {
                const LAS unsigned char* rb = lds + NA_RING + (slot % 3) * NA_SLOT;
                na_step<true>(st, qrot, rb, rb + 8192, 0u, rpbL + (rs + il - r + 7) * 64, slot == 0, qz, gz, jb);
            } else {
                na_step<false>(st, qraw, lds + NA_CTXK + ic * 4096, lds + NA_CTXV + (ic >> 1) * 8192, (unsigned)(ic & 1) << 6, rpbL, slot == 0, qz, gz, jb);
                ++ic;
            }
            NA_BAR();
        }
#pragma unroll
        for (int j = 0; j < 2; ++j) { float l = st.lsum[j]; l += __shfl_xor(l, 16); l += __shfl_xor(l, 32); const float inv = 1.f / l;
            bf16* op = MIX + (size_t)(tok0 + 16 * (jb + j) + qi) * D + h * NAD + 4 * g;
#pragma unroll
            for (int dt = 0; dt < 4; ++dt) { const f32x4 v = st.o[j][dt] * inv; *(v2u*)(op + 16 * dt) = (v2u){pg8::cvt_pk_bf16(v[0], v[1]), pg8::cvt_pk_bf16(v[2], v[3])}; } }
    }
}

typedef float f32x16 __attribute__((ext_vector_type(16)));
constexpr int SC_Q1 = 0, SC_K1 = SC_Q1 + 64 * 272, SC_K1T = SC_K1 + 64 * 272, SC_VT = SC_K1T + 128 * 144, SC_ST = SC_VT + 128 * 144, SC_TOT = SC_ST + 128 * 272, SC_CST = SC_TOT + 2 * 4 * 128 * 4, SC_END = SC_CST + 2 * 128 * 4;
static_assert(SC_END <= RING_BYTES, "scan LDS");
#define SCAN_MFMA(a, b, c) __builtin_amdgcn_mfma_f32_32x32x16_bf16(a, b, c, 0, 0, 0)
#define SCAN_BAR() do { asm volatile("s_waitcnt lgkmcnt(0)" ::: "memory"); __builtin_amdgcn_s_barrier(); asm volatile("" ::: "memory"); } while (0)
__device__ __forceinline__ void scan_unit(LAS unsigned char* lds, int b, int h, int dir, const unsigned short* LGT, const bf16* HQT, const bf16* HIT, bf16* OUT, int tid) {
    const int lane = tid & 63, w = __builtin_amdgcn_readfirstlane(tid >> 6), r = lane & 31, hh = lane >> 5;
    const int d = tid & 127, tq = tid >> 7;
    const int ti = w >> 2, ovi = w & 3;
    const int di = w >> 1, svi = 2 * (w & 1);
    f32x16 S0, S1;
#pragma unroll
    for (int i = 0; i < 16; ++i) { S0[i] = 0.f; S1[i] = 0.f; }
    const size_t chrow = (size_t)(h * HGD + d);
    constexpr int NCH = (LC + SEQ) / 64;
    auto col_of = [&](int c) -> int { return c < 4 ? (T + b * LC + 64 * (dir ? 3 - c : c)) : (b * SEQ + (dir ? SEQ - 64 * (c - 3) : 64 * (c - 4))); };
    LAS float* totb = (LAS float*)(lds + SC_TOT); LAS float* cst = (LAS float*)(lds + SC_CST);
    u32x4 lg0[2], lg1[2], vr[2], qr[2], vn[2], qn[2];
    { const int c0 = col_of(0) + 16 * tq, c1 = col_of(1) + 16 * tq;
      lg0[0] = *(const u32x4*)(LGT + chrow * MROWS + c0); lg0[1] = *(const u32x4*)(LGT + chrow * MROWS + c0 + 8);
      lg1[0] = *(const u32x4*)(LGT + chrow * MROWS + c1); lg1[1] = *(const u32x4*)(LGT + chrow * MROWS + c1 + 8);
      vr[0] = *(const u32x4*)(HIT + chrow * MROWS + c0); vr[1] = *(const u32x4*)(HIT + chrow * MROWS + c0 + 8); qr[0] = qr[1] = (u32x4){0u, 0u, 0u, 0u};
      vn[0] = *(const u32x4*)(HIT + chrow * MROWS + c1); vn[1] = *(const u32x4*)(HIT + chrow * MROWS + c1 + 8); qn[0] = qn[1] = (u32x4){0u, 0u, 0u, 0u};
      float sm = 0.f;
#pragma unroll
      for (int i = 0; i < 8; ++i) { const unsigned u2 = lg0[i >> 2][i & 3]; sm += h2f((unsigned short)(u2 & 0xffff)) + h2f((unsigned short)(u2 >> 16)); }
      totb[tq * 128 + d] = sm; }
    SCAN_BAR();
#pragma unroll 1
    for (int c = 0; c < NCH; ++c) {
        const bool lat = c >= 4; const int par = c & 1;
        LAS float* tot = totb + par * 512;
        {
            float P[16], kk[16];
#pragma unroll
            for (int i = 0; i < 8; ++i) { const unsigned u2 = lg0[i >> 2][i & 3]; P[2 * i] = h2f((unsigned short)(u2 & 0xffff)); P[2 * i + 1] = h2f((unsigned short)(u2 >> 16)); }
#pragma unroll
            for (int i = 0; i < 16; ++i) kk[i] = 1.f - __builtin_amdgcn_exp2f(P[i]);
            if (!dir) {
#pragma unroll
                for (int i = 1; i < 16; ++i) P[i] += P[i - 1];
            } else {
#pragma unroll
                for (int i = 14; i >= 0; --i) P[i] += P[i + 1];
            }
            const float t0 = tot[d], t1 = tot[128 + d], t2 = tot[256 + d], t3 = tot[384 + d];
            const float Bm = dir ? (t2 + t3) : (t0 + t1);
            float offs; if (!dir) offs = (tq > 0 ? t0 : 0.f) + (tq > 1 ? t1 : 0.f) + (tq > 2 ? t2 : 0.f); else offs = (tq < 3 ? t3 : 0.f) + (tq < 2 ? t2 : 0.f) + (tq < 1 ? t1 : 0.f);
            const float sh = offs - Bm;
            if (tq == 0) { const float be = (t0 + t1) + (t2 + t3); cst[d] = __builtin_amdgcn_exp2f(be); cst[128 + d] = __builtin_amdgcn_exp2f(be - Bm); }
            unsigned kt[8];
            LAS bf16* q1 = (LAS bf16*)(lds + SC_Q1) + (16 * tq) * 136 + d; LAS bf16* k1 = (LAS bf16*)(lds + SC_K1) + (16 * tq) * 136 + d;
#pragma unroll
            for (int i = 0; i < 16; i += 2) {
                const float x0 = fminf(fmaxf(P[i] + sh, -120.f), 120.f), x1 = fminf(fmaxf(P[i + 1] + sh, -120.f), 120.f);
                const float k0 = kk[i] * __builtin_amdgcn_exp2f(-x0), k1v = kk[i + 1] * __builtin_amdgcn_exp2f(-x1);
                kt[i >> 1] = pg8::cvt_pk_bf16(k0, k1v);
                if (lat) { const unsigned qq = (i < 8 ? qr[0] : qr[1])[(i >> 1) & 3];
                    const unsigned qp2 = pg8::cvt_pk_bf16(bflo(qq) * __builtin_amdgcn_exp2f(x0), bfhi(qq) * __builtin_amdgcn_exp2f(x1));
                    q1[i * 136] = (bf16)(qp2 & 0xffff); q1[(i + 1) * 136] = (bf16)(qp2 >> 16);
                    k1[i * 136] = (bf16)(kt[i >> 1] & 0xffff); k1[(i + 1) * 136] = (bf16)(kt[i >> 1] >> 16); }
            }
            LAS unsigned char* k1t = lds + SC_K1T + d * 144 + 32 * tq;
            *(LAS u32x4*)k1t = (u32x4){kt[0], kt[1], kt[2], kt[3]}; *(LAS u32x4*)(k1t + 16) = (u32x4){kt[4], kt[5], kt[6], kt[7]};
            LAS unsigned char* vt = lds + SC_VT + d * 144 + 32 * tq;
            *(LAS u32x4*)vt = vr[0]; *(LAS u32x4*)(vt + 16) = vr[1];
        }
        if (lat) {
#pragma unroll
            for (int rg = 0; rg < 4; ++rg) { const int dd = 32 * di + 8 * rg + 4 * hh;
                const f32x4 a0 = *(const LAS f32x4*)(tot + dd), a1 = *(const LAS f32x4*)(tot + 128 + dd), a2 = *(const LAS f32x4*)(tot + 256 + dd), a3 = *(const LAS f32x4*)(tot + 384 + dd);
                const f32x4 bm = dir ? (a2 + a3) : (a0 + a1); float eb[4];
#pragma unroll
                for (int j = 0; j < 4; ++j) eb[j] = __builtin_amdgcn_exp2f(bm[j]);
                *(LAS v2u*)(lds + SC_ST + ((32 * svi + r) * 136 + dd) * 2) = (v2u){pg8::cvt_pk_bf16(S0[4 * rg] * eb[0], S0[4 * rg + 1] * eb[1]), pg8::cvt_pk_bf16(S0[4 * rg + 2] * eb[2], S0[4 * rg + 3] * eb[3])};
                *(LAS v2u*)(lds + SC_ST + ((32 * (svi + 1) + r) * 136 + dd) * 2) = (v2u){pg8::cvt_pk_bf16(S1[4 * rg] * eb[0], S1[4 * rg + 1] * eb[1]), pg8::cvt_pk_bf16(S1[4 * rg + 2] * eb[2], S1[4 * rg + 3] * eb[3])}; }
        }
        { float sm = 0.f;
#pragma unroll
            for (int i = 0; i < 8; ++i) { const unsigned u2 = lg1[i >> 2][i & 3]; sm += h2f((unsigned short)(u2 & 0xffff)) + h2f((unsigned short)(u2 >> 16)); }
            totb[(par ^ 1) * 512 + tq * 128 + d] = sm;
            lg0[0] = lg1[0]; lg0[1] = lg1[1]; vr[0] = vn[0]; vr[1] = vn[1]; qr[0] = qn[0]; qr[1] = qn[1];
            const int cm = c + 2 < NCH ? c + 2 : NCH - 1, cq = cm < 4 ? 4 : cm;
            const int c2 = col_of(cm) + 16 * tq, c2q = col_of(cq) + 16 * tq;
            vn[0] = *(const u32x4*)(HIT + chrow * MROWS + c2); vn[1] = *(const u32x4*)(HIT + chrow * MROWS + c2 + 8);
            qn[0] = *(const u32x4*)(HQT + chrow * T + c2q); qn[1] = *(const u32x4*)(HQT + chrow * T + c2q + 8);
            lg1[0] = *(const u32x4*)(LGT + chrow * MROWS + c2); lg1[1] = *(const u32x4*)(LGT + chrow * MROWS + c2 + 8); }
        SCAN_BAR();
        f32x16 dS0, dS1, O;
#pragma unroll
        for (int i = 0; i < 16; ++i) { dS0[i] = 0.f; dS1[i] = 0.f; O[i] = 0.f; }
        {
            bf16x8 fa[4], fb0[4], fb1[4];
#pragma unroll
            for (int ks = 0; ks < 4; ++ks) { fa[ks] = *(const LAS bf16x8*)(lds + SC_K1T + ((32 * di + r) * 72 + 16 * ks + 8 * hh) * 2);
                fb0[ks] = *(const LAS bf16x8*)(lds + SC_VT + ((32 * svi + r) * 72 + 16 * ks + 8 * hh) * 2); fb1[ks] = *(const LAS bf16x8*)(lds + SC_VT + ((32 * (svi + 1) + r) * 72 + 16 * ks + 8 * hh) * 2); }
#pragma unroll
            for (int ks = 0; ks < 4; ++ks) { dS0 = SCAN_MFMA(fa[ks], fb0[ks], dS0); dS1 = SCAN_MFMA(fa[ks], fb1[ks], dS1); }
        }
        if (lat) {
            bf16x8 fq[8];
#pragma unroll
            for (int ks = 0; ks < 8; ++ks) fq[ks] = *(const LAS bf16x8*)(lds + SC_Q1 + ((32 * ti + r) * 136 + 16 * ks + 8 * hh) * 2);
            {
                bf16x8 fs[8];
#pragma unroll
                for (int ks = 0; ks < 8; ++ks) fs[ks] = *(const LAS bf16x8*)(lds + SC_ST + ((32 * ovi + r) * 136 + 16 * ks + 8 * hh) * 2);
#pragma unroll
                for (int ks = 0; ks < 8; ++ks) O = SCAN_MFMA(fs[ks], fq[ks], O);
            }
#pragma unroll
            for (int si = 0; si < 2; ++si) {
                const bool live = dir ? (si >= ti) : (si <= ti);
                if (live) {
                    f32x16 At;
#pragma unroll
                    for (int i = 0; i < 16; ++i) At[i] = 0.f;
                    bf16x8 fk[8];
#pragma unroll
                    for (int ks = 0; ks < 8; ++ks) fk[ks] = *(const LAS bf16x8*)(lds + SC_K1 + ((32 * si + r) * 136 + 16 * ks + 8 * hh) * 2);
#pragma unroll
                    for (int ks = 0; ks < 8; ++ks) At = SCAN_MFMA(fk[ks], fq[ks], At);
                    const int tt = 32 * ti + r;
                    if (si == ti) {
#pragma unroll
                        for (int i = 0; i < 16; ++i) { const int ss = 32 * si + (i & 3) + 8 * (i >> 2) + 4 * hh; const bool keep = dir ? (ss >= tt) : (ss <= tt); At[i] = keep ? At[i] : 0.f; }
                    }
#pragma unroll
                    for (int k2 = 0; k2 < 2; ++k2) {
                        u32x4 pw; pw.x = pg8::cvt_pk_bf16(At[8 * k2], At[8 * k2 + 1]); pw.y = pg8::cvt_pk_bf16(At[8 * k2 + 2], At[8 * k2 + 3]); pw.z = pg8::cvt_pk_bf16(At[8 * k2 + 4], At[8 * k2 + 5]); pw.w = pg8::cvt_pk_bf16(At[8 * k2 + 6], At[8 * k2 + 7]);
                        const LAS unsigned char* vp = lds + SC_VT + ((32 * ovi + r) * 72 + 32 * si + 16 * k2 + 4 * hh) * 2;
                        const v2u lo = *(const LAS v2u*)vp, hi2 = *(const LAS v2u*)(vp + 16);
                        O = SCAN_MFMA(__builtin_bit_cast(bf16x8, (u32x4){lo.x, lo.y, hi2.x, hi2.y}), __builtin_bit_cast(bf16x8, pw), O);
                    }
                }
            }
            bf16* op = OUT + (size_t)(col_of(c) + 32 * ti + r) * SEGW + h * HGD + 32 * ovi + 4 * hh;
#pragma unroll
            for (int rg = 0; rg < 4; ++rg) *(v2u*)(op + 8 * rg) = (v2u){pg8::cvt_pk_bf16(O[4 * rg], O[4 * rg + 1]), pg8::cvt_pk_bf16(O[4 * rg + 2], O[4 * rg + 3])};
        }
#pragma unroll
        for (int rg = 0; rg < 4; ++rg) { const int dd = 32 * di + 8 * rg + 4 * hh;
            const f32x4 ee = *(const LAS f32x4*)(cst + dd), em = *(const LAS f32x4*)(cst + 128 + dd);
#pragma unroll
            for (int j = 0; j < 4; ++j) { S0[4 * rg + j] = ee[j] * S0[4 * rg + j] + em[j] * dS0[4 * rg + j]; S1[4 * rg + j] = ee[j] * S1[4 * rg + j] + em[j] * dS1[4 * rg + j]; } }
        SCAN_BAR();
    }
}

#ifdef DBG_NAIVE
__device__ __forceinline__ void scan_naive(LAS unsigned char* lds, int b, int h, int dir, const unsigned short* LGT, const bf16* HQT, const bf16* HIT, bf16* OUT, int tid) {
    const int dv = tid & 127, kg = tid >> 7;
    float St[32];
#pragma unroll
    for (int i = 0; i < 32; ++i) St[i] = 0.f;
    LAS float* sq = (LAS float*)lds; LAS float* sk = sq + 16 * 128; LAS float* sf = sk + 16 * 128; LAS float* sv = sf + 16 * 128; LAS float* so = sv + 16 * 128;
    constexpr int NSTEP = LC + SEQ;
    for (int j0 = 0; j0 < NSTEP; j0 += 16) {
        const bool isctx = j0 < LC;
        for (int idx = tid; idx < 16 * 128; idx += NTHR) { const int st = idx >> 7, ch = idx & 127, j = j0 + st;
            int col; if (j < LC) col = T + b * LC + (dir ? (LC - 1 - j) : j); else col = b * SEQ + (dir ? (SEQ - 1 - (j - LC)) : (j - LC));
            const size_t cr = (size_t)(h * HGD + ch);
            const float f = __builtin_amdgcn_exp2f(h2f(LGT[cr * MROWS + col]));
            sf[st * 128 + ch] = f; sk[st * 128 + ch] = 1.f - f; sv[st * 128 + ch] = bf2f(HIT[cr * MROWS + col]);
            if (!isctx) sq[st * 128 + ch] = bf2f(HQT[cr * T + col]); }
        __syncthreads();
        for (int st = 0; st < 16; ++st) {
            const float vv = sv[st * 128 + dv]; float o = 0.f;
#pragma unroll
            for (int i = 0; i < 32; ++i) { St[i] = sf[st * 128 + kg * 32 + i] * St[i] + sk[st * 128 + kg * 32 + i] * vv; o += St[i] * sq[st * 128 + kg * 32 + i]; }
            so[(st * 4 + kg) * 128 + dv] = o;
        }
        __syncthreads();
        if (!isctx) {
            for (int idx = tid; idx < 16 * 128; idx += NTHR) { const int st = idx >> 7, dd = idx & 127, j = j0 + st;
                const float o = (so[(st * 4 + 0) * 128 + dd] + so[(st * 4 + 1) * 128 + dd]) + (so[(st * 4 + 2) * 128 + dd] + so[(st * 4 + 3) * 128 + dd]);
                const int row = b * SEQ + (dir ? (SEQ - 1 - (j - LC)) : (j - LC));
                OUT[(size_t)row * SEGW + h * HGD + dd] = (bf16)f2bf(o); }
        }
        __syncthreads();
    }
}
#endif

__device__ __forceinline__ void transpose_item(const float* W, int ldw, int k0, int n0, bf16* WT, int ldk, int drow0, LAS float* scr, int lane) {
    f32x4 t[8];
#pragma unroll
    for (int i = 0; i < 8; ++i) t[i] = *(const f32x4*)(W + (size_t)(k0 + 8 * i + (lane >> 3)) * ldw + n0 + (lane & 7) * 4);
#pragma unroll
    for (int i = 0; i < 8; ++i) { LAS float* p = scr + (8 * i + (lane >> 3)) * 33 + (lane & 7) * 4; p[0] = t[i][0]; p[1] = t[i][1]; p[2] = t[i][2]; p[3] = t[i][3]; }
    LDS_WAIT(); asm volatile("" ::: "memory");
    const int c = lane & 7;
#pragma unroll
    for (int j = 0; j < 4; ++j) { const int n = (lane >> 3) + 8 * j; const LAS float* s = scr + (8 * c) * 33 + n;
        v4u o; o.x = pk2(s[0 * 33], s[1 * 33]); o.y = pk2(s[2 * 33], s[3 * 33]); o.z = pk2(s[4 * 33], s[5 * 33]); o.w = pk2(s[6 * 33], s[7 * 33]);
        *(GAS v4u*)(WT + (size_t)(drow0 + n) * ldk + k0 + 8 * c) = o; }
    LDS_WAIT(); asm volatile("" ::: "memory");
}

struct Args { const float* in[21]; float* out; unsigned char* ws; int ph_lo, ph_hi, li, pad; };

__global__ void __launch_bounds__(NTHR, 2) fwd_mega(Args args) {
    extern __shared__ __attribute__((aligned(16))) unsigned char lds_raw[];
    LAS unsigned char* lds = (LAS unsigned char*)lds_raw;
    volatile LAS unsigned* MISC = (volatile LAS unsigned*)(lds + MISC_OFF);
    const int tid = threadIdx.x, lane = tid & 63, wave = __builtin_amdgcn_readfirstlane(tid >> 6);
    const int G = gridDim.x; const int bx = blockIdx.x; const int vcu = (G % 8 == 0) ? (bx % 8) * (G / 8) + bx / 8 : bx;
    gu32* ctl0 = (gu32*)(args.ws + WS_CTL);
    const int gw = vcu * NWAVES + wave, NGW = G * NWAVES;
    for (int u = tid; u < (LDS_BYTES - LDSCTL_OFF) / 4; u += NTHR) ((LAS unsigned*)(lds + LDSCTL_OFF))[u] = 0u;
    __syncthreads();
    XcdBarrier bar = xcd_barrier_post((unsigned*)(ctl0 + CW_BAR) + args.li * XCD_BAR_WORDS, MISC + 8);
    const int lo = args.ph_lo, hi = args.ph_hi;
#ifndef PHMASK
#define PHMASK 0xFFFF
#endif
#define IN(k) (((PHMASK >> (k)) & 1) && lo <= (k) && (k) < hi)
#define SEAM(k) do { if (IN(k) && IN((k) + 1)) xcd_barrier(bar); } while (0)

#define KA(i) ({ const __attribute__((address_space(4))) Args* _p = (const __attribute__((address_space(4))) Args*)__builtin_amdgcn_kernarg_segment_ptr(); asm volatile("" : "+s"(_p)); _p->in[i]; })
#define WSP() ({ const __attribute__((address_space(4))) Args* _p = (const __attribute__((address_space(4))) Args*)__builtin_amdgcn_kernarg_segment_ptr(); asm volatile("" : "+s"(_p)); _p->ws; })
#define PHASE_PTRS unsigned char* ws = WSP(); float* MOD = (float*)(ws + WS_MOD); float* ROPE = (float*)(ws + WS_ROPE); float* LBT = (float*)(ws + WS_LBT); \
    bf16* WinT = (bf16*)(ws + WS_WINT); bf16* WoutT = (bf16*)(ws + WS_WOUTT); bf16* W13T = (bf16*)(ws + WS_W13T); bf16* W2T = (bf16*)(ws + WS_W2T); \
    bf16* XN = (bf16*)(ws + WS_XN); bf16* MIX = (bf16*)(ws + WS_MIX); bf16* XN2 = (bf16*)(ws + WS_XN2); \
    float* X1 = (float*)(ws + WS_X1); bf16* Hb = (bf16*)(ws + WS_H); bf16* Yb = (bf16*)(ws + WS_Y); \
    int* ELIST = (int*)(ws + WS_ELIST); float* EWT = (float*)(ws + WS_EWT); gu32* ctl = (gu32*)(ws + WS_CTL); \
    (void)MOD; (void)ROPE; (void)LBT; (void)WinT; (void)WoutT; (void)W13T; (void)W2T; (void)XN; (void)MIX; (void)XN2; (void)X1; (void)Hb; (void)Yb; (void)ELIST; (void)EWT; (void)ctl;
    if (IN(0)) {
        PHASE_PTRS
        const float* cvec = KA(1); const float* c_ctx = KA(3); const float* w_mod = KA(4); const float* b_mod = KA(5); const float* w_in = KA(8); const float* w_out = KA(9);
        const float* hg_lb = KA(11); const float* w1 = KA(17); const float* w3 = KA(18); const float* w2 = KA(19);
        if (bx == G - 1) {
            for (int idx = tid; idx < 1024; idx += NTHR) { const int pos = idx >> 4, i = idx & 15;
                double th = 1.0; for (int k = 0; k < i; ++k) th *= 0.5623413251903491;
                const double t2 = th * th; double c = 1.0, s = th, tc = 1.0, ts = th;
                for (int n = 1; n <= 12; ++n) { tc *= -t2 / (double)((2 * n - 1) * (2 * n)); c += tc; ts *= -t2 / (double)((2 * n) * (2 * n + 1)); s += ts; }
                double cr = 1.0, ci = 0.0; for (int p = 0; p < pos; ++p) { const double nr = cr * c - ci * s; ci = cr * s + ci * c; cr = nr; }
                ROPE[idx * 2] = (float)cr; ROPE[idx * 2 + 1] = (float)ci; }
            for (int idx = tid; idx < 1024; idx += NTHR) { const float h0 = hg_lb[idx], h1 = hg_lb[1024 + idx]; LBT[idx] = 1.f / (1.f + expf(h1 - h0)); }
        }
        if (bx < 96) {
            LAS float* sc = (LAS float*)lds;
            for (int idx = tid; idx < 17 * 1024; idx += NTHR) { const int r = idx >> 10, k = idx & 1023; const float cv = r < 16 ? cvec[r * 1024 + k] : c_ctx[k]; sc[idx] = cv / (1.f + expf(-cv)); }
            __syncthreads();
            const int col = 64 * bx + lane, k0 = 128 * wave;
            float acc[17];
#pragma unroll
            for (int r = 0; r < 17; ++r) acc[r] = 0.f;
            for (int kk = 0; kk < 128; kk += 4) {
                const float w0 = w_mod[(size_t)(k0 + kk) * 6144 + col], w1v = w_mod[(size_t)(k0 + kk + 1) * 6144 + col], w2v = w_mod[(size_t)(k0 + kk + 2) * 6144 + col], w3v = w_mod[(size_t)(k0 + kk + 3) * 6144 + col];
#pragma unroll
                for (int r = 0; r < 17; ++r) { const f32x4 a = *(const LAS f32x4*)(sc + r * 1024 + k0 + kk); acc[r] += a[0] * w0 + a[1] * w1v + a[2] * w2v + a[3] * w3v; }
            }
            LAS float* red = (LAS float*)(lds + 17 * 1024 * 4);
#pragma unroll
            for (int r = 0; r < 17; ++r) red[(wave * 17 + r) * 64 + lane] = acc[r];
            __syncthreads();
            for (int idx = tid; idx < 17 * 64; idx += NTHR) { const int r = idx >> 6, l = idx & 63; float s = 0.f;
#pragma unroll
                for (int w = 0; w < 8; ++w) s += red[(w * 17 + r) * 64 + l];
                MOD[r * 6144 + 64 * bx + l] = s + b_mod[64 * bx + l]; }
            __syncthreads();
        }
        {
            LAS float* scr = (LAS float*)(lds + wave * 16384);
            constexpr int I_IN = 16 * 128, I_OUT = 16 * 32, I_13 = 16 * 2 * 256, I_2 = 16 * 256, NIT = I_IN + I_OUT + I_13 + I_2;
            for (int it = gw; it < NIT; it += NGW) {
                int r = it;
                if (r < I_IN) { const int kb = r / 128, nb = r % 128; transpose_item(w_in, INCOLS, 64 * kb, 32 * nb, WinT, 1024, 32 * nb, scr, lane); continue; } r -= I_IN;
                if (r < I_OUT) { const int kb = r / 32, nb = r % 32; transpose_item(w_out, 1024, 64 * kb, 32 * nb, WoutT, 1024, 32 * nb, scr, lane); continue; } r -= I_OUT;
                if (r < I_13) { const int e = r / 512, rem = r % 512, s = rem / 256, r2 = rem % 256, kb = r2 / 16, nb = r2 % 16, n0 = 32 * nb;
                    transpose_item((s ? w3 : w1) + (size_t)e * 1024 * 512, 512, 64 * kb, n0, W13T, 1024, e * 1024 + 256 * (n0 / 128) + 128 * s + (n0 % 128), scr, lane); continue; } r -= I_13;
                { const int e = r / 256, r2 = r % 256, kb = r2 / 32, nb = r2 % 32; transpose_item(w2 + (size_t)e * 512 * 1024, 1024, 64 * kb, 32 * nb, W2T, 512, e * 1024 + 32 * nb, scr, lane); }
            }
        }
    }
    SEAM(0);

    if (IN(1)) {
        PHASE_PTRS
        const float* x = KA(0); const float* ctx = KA(2); const float* norm_mix = KA(6);
        for (int row = gw; row < MROWS; row += NGW) {
            const float* xr = row < T ? x + (size_t)row * D : ctx + (size_t)(row - T) * D; const int mb = row < T ? (row >> 11) : 16;
            f32x4 v[4]; float s = 0.f;
#pragma unroll
            for (int j = 0; j < 4; ++j) { v[j] = *(const f32x4*)(xr + 4 * lane + 256 * j); s += (v[j][0] * v[j][0] + v[j][1] * v[j][1]) + (v[j][2] * v[j][2] + v[j][3] * v[j][3]); }
            const float rstd = 1.f / sqrtf(wave_sum(s) * (1.f / D) + EPS);
#pragma unroll
            for (int j = 0; j < 4; ++j) { const int col = 4 * lane + 256 * j; const f32x4 g = *(const f32x4*)(norm_mix + col), sh = *(const f32x4*)(MOD + mb * 6144 + col), sc = *(const f32x4*)(MOD + mb * 6144 + 1024 + col);
                const f32x4 y = v[j] * rstd * g * (1.f + sc) + sh;
                *(v2u*)(XN + (size_t)row * D + col) = (v2u){pk2(y[0], y[1]), pk2(y[2], y[3])}; }
        }
    }
    SEAM(1);

    if (IN(2)) {
        PHASE_PTRS
        ProjOrder S; S.init(G, bx);
        LAS float* ropeL = (LAS float*)(lds + TAB_OFF); LAS float* lbtL = ropeL + 2048;
        for (int i = tid; i < 2048 + 1024; i += NTHR) ropeL[i] = i < 2048 ? ROPE[i] : LBT[i - 2048];
        __syncthreads();
        EpiProj E{ws, ropeL, lbtL, 0};
        pg8::gemm_phase<EpiProj, ProjOrder>(lds + RING_OFF, XN, WinT, D, S, E);
    }
    SEAM(2);

    if (IN(3)) {
        PHASE_PTRS
        const bf16* Qb = (const bf16*)(ws + WS_Q); const bf16* Kb = (const bf16*)(ws + WS_K); const bf16* Vb = (const bf16*)(ws + WS_V);
        const float* na_rpb = KA(10);
        const int subph = ({ const __attribute__((address_space(4))) Args* _p = (const __attribute__((address_space(4))) Args*)__builtin_amdgcn_kernarg_segment_ptr(); asm volatile("" : "+s"(_p)); _p->pad; });
#ifndef NO_SCAN
        if (bx < 128) {
            const int dir = bx & 1;
#ifdef DBG_NAIVE
            if (DBG_NAIVE & (1 << dir)) scan_naive(lds, bx >> 3, (bx >> 1) & 3, dir, (const unsigned short*)(ws + (dir ? WS_LB : WS_LF)), (const bf16*)(ws + WS_HQ), (const bf16*)(ws + WS_HI), (bf16*)(ws + (dir ? WS_OB : WS_OF)), tid);
            else
#endif
            if (subph != 2) scan_unit(lds, bx >> 3, (bx >> 1) & 3, dir, (const unsigned short*)(ws + (dir ? WS_LB : WS_LF)), (const bf16*)(ws + WS_HQ), (const bf16*)(ws + WS_HI), (bf16*)(ws + (dir ? WS_OB : WS_OF)), tid);
        } else
#endif
        {
            const int hx = bx & 7, bb = (bx - 128) >> 3;
            LAS float* rpbL = (LAS float*)(lds + TAB_OFF);
            for (int t2 = tid; t2 < 15 * 64; t2 += NTHR) { const int co = (t2 & 63) - 16, ro = t2 >> 6; rpbL[t2] = (co >= 0 && co < 31) ? na_rpb[(hx * 15 + ro) * 31 + co] * 1.44269504f : 0.f; }
            if (subph != 1) na_wg(lds, bb, hx, Qb, (const bf16*)(ws + WS_QR), Kb, Vb, MIX, rpbL, tid);
        }
    }
    SEAM(3);

    if (IN(4)) {
        PHASE_PTRS
        const float* hg_norm = KA(12);
        const bf16* OF = (const bf16*)(ws + WS_OF); const bf16* OB = (const bf16*)(ws + WS_OB); const bf16* Gb = (const bf16*)(ws + WS_G);
        for (int tok = gw; tok < T; tok += NGW) {
            const size_t off = (size_t)tok * SEGW + lane * 8;
            const v4u a = *(const v4u*)(OF + off), bb = *(const v4u*)(OB + off), g = *(const v4u*)(Gb + off);
            float o[8]; float ss = 0.f;
#pragma unroll
            for (int e = 0; e < 4; ++e) { o[2 * e] = bflo(a[e]) + bflo(bb[e]); o[2 * e + 1] = bfhi(a[e]) + bfhi(bb[e]);
#ifdef DBG_SANITIZE
                if (!(fabsf(o[2 * e]) < 1e30f)) o[2 * e] = 0.f; if (!(fabsf(o[2 * e + 1]) < 1e30f)) o[2 * e + 1] = 0.f;
#endif
                ss += o[2 * e] * o[2 * e] + o[2 * e + 1] * o[2 * e + 1]; }
            ss += __shfl_xor(ss, 1); ss += __shfl_xor(ss, 2); ss += __shfl_xor(ss, 4); ss += __shfl_xor(ss, 8);
            const float rstd = 1.f / sqrtf(ss * (1.f / HGD) + EPS);
            const int dv0 = (lane & 15) * 8;
            const f32x4 g0 = *(const f32x4*)(hg_norm + dv0), g1 = *(const f32x4*)(hg_norm + dv0 + 4);
            const float gg[8] = {g0[0], g0[1], g0[2], g0[3], g1[0], g1[1], g1[2], g1[3]};
            float y[8];
#pragma unroll
            for (int e = 0; e < 4; ++e) { y[2 * e] = o[2 * e] * rstd * gg[2 * e] * bflo(g[e]); y[2 * e + 1] = o[2 * e + 1] * rstd * gg[2 * e + 1] * bfhi(g[e]); }
            *(v4u*)(MIX + (size_t)tok * D + 512 + lane * 8) = (v4u){pk2(y[0], y[1]), pk2(y[2], y[3]), pk2(y[4], y[5]), pk2(y[6], y[7])};
        }
    }
    SEAM(4);

    if (IN(5)) {
        PHASE_PTRS
        pg8::DenseOrder S; S.init(T, D, G, bx, true);
        EpiP E{(bf16*)X1};
        pg8::gemm_phase<EpiP, pg8::DenseOrder>(lds + RING_OFF, MIX, WoutT, D, S, E);
    }
    SEAM(5);

    if (IN(6)) {
        PHASE_PTRS
        const float* norm_ffn = KA(7); const float* w_grp = KA(13); const float* b_grp = KA(14); const float* w_exp = KA(15); const float* b_exp = KA(16);
        LAS f32x4* wl = (LAS f32x4*)lds;
        for (int idx = tid; idx < 5 * 1024; idx += NTHR) { const int quad = idx >> 10, col = idx & 1023; const int l = (col & 255) >> 2, q = col & 3, j = col >> 8;
            const f32x4 w = quad == 0 ? *(const f32x4*)(w_grp + col * 4) : *(const f32x4*)(w_exp + col * 16 + (quad - 1) * 4);
            wl[((quad * 4 + q) * 4 + j) * 64 + l] = w; }
        LAS int* lcnt = (LAS int*)(lds + 81920);
        LAS int* tmpe = (LAS int*)(lds + 81920 + 256);
        LAS float* rsc = (LAS float*)(lds + 86016);
        if (tid < 32) lcnt[tid] = 0;
        __syncthreads();
        const int rowbase = bx * 128 + wave * 16;
        const int mb = rowbase >> 11;
        f32x4 gsc[4], shv[4], gaa[4];
        const float* xin = KA(0); const bf16* Pb = (const bf16*)X1;
#pragma unroll
        for (int j = 0; j < 4; ++j) { const int col = 4 * lane + 256 * j; const f32x4 g = *(const f32x4*)(norm_ffn + col), sc = *(const f32x4*)(MOD + mb * 6144 + 4096 + col);
            gsc[j] = g * (1.f + sc); shv[j] = *(const f32x4*)(MOD + mb * 6144 + 3072 + col); gaa[j] = *(const f32x4*)(MOD + mb * 6144 + 2048 + col); }
        f32x4 vn[2][4]; v2u pn[2][4];
#pragma unroll
        for (int rr = 0; rr < 2; ++rr)
#pragma unroll
            for (int j = 0; j < 4; ++j) { const size_t o_ = (size_t)(rowbase + rr) * D + 4 * lane + 256 * j; vn[rr][j] = *(const f32x4*)(xin + o_); pn[rr][j] = *(const v2u*)(Pb + o_); }
#pragma unroll 1
        for (int ip = 0; ip < 8; ++ip) {
            asm volatile("" ::: "memory");
            f32x4 v[2][4];
#pragma unroll
            for (int rr = 0; rr < 2; ++rr)
#pragma unroll
                for (int j = 0; j < 4; ++j) v[rr][j] = vn[rr][j] + gaa[j] * (f32x4){bflo(pn[rr][j].x), bfhi(pn[rr][j].x), bflo(pn[rr][j].y), bfhi(pn[rr][j].y)};
            if (ip < 7) {
#pragma unroll
                for (int rr = 0; rr < 2; ++rr)
#pragma unroll
                    for (int j = 0; j < 4; ++j) { const size_t o_ = (size_t)(rowbase + 2 * ip + 2 + rr) * D + 4 * lane + 256 * j; vn[rr][j] = *(const f32x4*)(xin + o_); pn[rr][j] = *(const v2u*)(Pb + o_); } }
            float ss[2];
#pragma unroll
            for (int rr = 0; rr < 2; ++rr) { float s = 0.f;
#pragma unroll
                for (int j = 0; j < 4; ++j) s += (v[rr][j][0] * v[rr][j][0] + v[rr][j][1] * v[rr][j][1]) + (v[rr][j][2] * v[rr][j][2] + v[rr][j][3] * v[rr][j][3]);
                ss[rr] = s; }
#pragma unroll
            for (int o = 1; o < 64; o <<= 1) { ss[0] += __shfl_xor(ss[0], o); ss[1] += __shfl_xor(ss[1], o); }
            const float rstd0 = 1.f / sqrtf(ss[0] * (1.f / D) + EPS), rstd1 = 1.f / sqrtf(ss[1] * (1.f / D) + EPS);
            float lg[2][20];
#pragma unroll
            for (int k = 0; k < 20; ++k) { lg[0][k] = 0.f; lg[1][k] = 0.f; }
#pragma unroll
            for (int j = 0; j < 4; ++j) { const int col = 4 * lane + 256 * j;
                const f32x4 y0 = v[0][j] * rstd0 * gsc[j] + shv[j], y1 = v[1][j] * rstd1 * gsc[j] + shv[j];
                *(v2u*)(XN2 + (size_t)(rowbase + 2 * ip) * D + col) = (v2u){pg8::cvt_pk_bf16(y0[0], y0[1]), pg8::cvt_pk_bf16(y0[2], y0[3])};
                *(v2u*)(XN2 + (size_t)(rowbase + 2 * ip + 1) * D + col) = (v2u){pg8::cvt_pk_bf16(y1[0], y1[1]), pg8::cvt_pk_bf16(y1[2], y1[3])};
#pragma unroll
                for (int q = 0; q < 4; ++q)
#pragma unroll
                    for (int quad = 0; quad < 5; ++quad) { const f32x4 w = wl[((quad * 4 + q) * 4 + j) * 64 + lane];
#pragma unroll
                        for (int c = 0; c < 4; ++c) { lg[0][quad * 4 + c] += y0[q] * w[c]; lg[1][quad * 4 + c] += y1[q] * w[c]; } }
                asm volatile("" ::: "memory"); }
            {
                float rv[64];
#pragma unroll
                for (int k = 0; k < 64; ++k) rv[k] = k < 40 ? lg[k / 20][k % 20] : 0.f;
#pragma unroll
                for (int hb = 32; hb >= 1; hb >>= 1) { const bool hi_ = (lane & hb) != 0;
#pragma unroll
                    for (int i = 0; i < hb; ++i) { const float keep = hi_ ? rv[i + hb] : rv[i], send = hi_ ? rv[i] : rv[i + hb]; rv[i] = keep + __shfl_xor(send, hb); } }
                rsc[wave * 64 + lane] = rv[0];
            }
            if (lane < 2) {
                const int rr = lane; const LAS float* lgr = rsc + wave * 64 + rr * 20;
                {
                    float gl[4];
#pragma unroll
                    for (int k = 0; k < 4; ++k) gl[k] = lgr[k] + b_grp[k];
                    int gs = 0; float gm = gl[0];
#pragma unroll
                    for (int k = 1; k < 4; ++k) if (gl[k] > gm) { gm = gl[k]; gs = k; }
                    float den = 0.f;
#pragma unroll
                    for (int k = 0; k < 4; ++k) den += __expf(gl[k] - gm);
                    const float g_w = 1.f / den;
                    float ev[4];
#pragma unroll
                    for (int k = 0; k < 4; ++k) ev[k] = lgr[4 + gs * 4 + k] + b_exp[gs * 4 + k];
                    int i0 = 0; float v0 = ev[0];
#pragma unroll
                    for (int k = 1; k < 4; ++k) if (ev[k] > v0) { v0 = ev[k]; i0 = k; }
                    int i1 = -1; float v1 = -INFINITY;
#pragma unroll
                    for (int k = 0; k < 4; ++k) if (k != i0 && ev[k] > v1) { v1 = ev[k]; i1 = k; }
                    if (i1 < 0) { i1 = (i0 + 1) & 3; v1 = v0; }
                    const float e1 = __expf(v1 - v0); const float w0 = g_w / (1.f + e1), w1w = g_w * e1 / (1.f + e1);
                    const int ea = gs * 4 + i0, eb = gs * 4 + i1;
                    const int ra = __hip_atomic_fetch_add(&lcnt[ea], 1, __ATOMIC_RELAXED, __HIP_MEMORY_SCOPE_WORKGROUP), rb = __hip_atomic_fetch_add(&lcnt[eb], 1, __ATOMIC_RELAXED, __HIP_MEMORY_SCOPE_WORKGROUP);
                    const int lr = (wave * 16 + 2 * ip + rr) * 2;
                    tmpe[lr] = ea; tmpe[256 + lr] = ra; tmpe[512 + lr] = __builtin_bit_cast(int, w0);
                    tmpe[lr + 1] = eb; tmpe[256 + lr + 1] = rb; tmpe[512 + lr + 1] = __builtin_bit_cast(int, w1w);
                }
            }
        }
        __syncthreads();
        if (tid < 16) lcnt[16 + tid] = (int)__hip_atomic_fetch_add(ctl + CW_CNT + tid, (unsigned)lcnt[tid], RLX_AGENT);
        __syncthreads();
        if (tid < 256) { const int e = tmpe[tid], pos = lcnt[16 + e] + tmpe[256 + tid]; const int tok = bx * 128 + (tid >> 1);
            ELIST[e * ECAP + pos] = tok * 2 + (tid & 1); EWT[e * ECAP + pos] = __builtin_bit_cast(float, tmpe[512 + tid]); }
        __syncthreads();
    }
    SEAM(6);

    if (IN(7) || IN(8)) {
        PHASE_PTRS
        LAS int* tp = (LAS int*)(lds + MOE_OFF);
        if (tid == 0) { int acc = 0;
            for (int e = 0; e < 16; ++e) { const int c = (int)__hip_atomic_load(ctl + CW_CNT + e, RLX_AGENT); tp[e] = acc; tp[17 + e] = c; acc += (c + 255) >> 8; }
            tp[16] = acc; }
        __syncthreads();
    }
    if (IN(7)) {
        PHASE_PTRS
        const LAS int* tp = (const LAS int*)(lds + MOE_OFF);
        MoeOrder<true> S{tp, ELIST, G, bx, tp[16] * 4};
        EpiSwiGLU E{Hb};
        pg8::gemm_phase<EpiSwiGLU, MoeOrder<true>>(lds + RING_OFF, XN2, W13T, D, S, E);
    }
    SEAM(7);
    if (IN(8)) {
        PHASE_PTRS
        const LAS int* tp = (const LAS int*)(lds + MOE_OFF);
        MoeOrder<false> S{tp, ELIST, G, bx, tp[16] * 4};
        EpiMoeOut E{Yb, ELIST, EWT};
        pg8::gemm_phase<EpiMoeOut, MoeOrder<false>>(lds + RING_OFF, Hb, W2T, DE, S, E);
    }
    SEAM(8);

    if (IN(9)) {
        PHASE_PTRS
        const float* norm_final = KA(20); const float* xfin = KA(0); float* outp = ({ const __attribute__((address_space(4))) Args* _p = (const __attribute__((address_space(4))) Args*)__builtin_amdgcn_kernarg_segment_ptr(); asm volatile("" : "+s"(_p)); _p->out; });
        for (int row = gw; row < T; row += NGW) {
            const int mb = row >> 11; f32x4 v[4]; float s = 0.f;
#pragma unroll
            for (int j = 0; j < 4; ++j) { const int col = 4 * lane + 256 * j; const v2u pp = *(const v2u*)((const bf16*)X1 + (size_t)row * D + col);
                const f32x4 xv = *(const f32x4*)(xfin + (size_t)row * D + col) + *(const f32x4*)(MOD + mb * 6144 + 2048 + col) * (f32x4){bflo(pp.x), bfhi(pp.x), bflo(pp.y), bfhi(pp.y)}, ga = *(const f32x4*)(MOD + mb * 6144 + 5120 + col);
                const v2u y0 = *(const v2u*)(Yb + (size_t)(2 * row) * D + col), y1 = *(const v2u*)(Yb + (size_t)(2 * row + 1) * D + col);
                const f32x4 ys = (f32x4){bflo(y0.x) + bflo(y1.x), bfhi(y0.x) + bfhi(y1.x), bflo(y0.y) + bflo(y1.y), bfhi(y0.y) + bfhi(y1.y)};
                v[j] = xv + ga * ys; s += (v[j][0] * v[j][0] + v[j][1] * v[j][1]) + (v[j][2] * v[j][2] + v[j][3] * v[j][3]); }
            const float rstd = 1.f / sqrtf(wave_sum(s) * (1.f / D) + EPS);
#pragma unroll
            for (int j = 0; j < 4; ++j) { const int col = 4 * lane + 256 * j; const f32x4 g = *(const f32x4*)(norm_final + col);
                *(f32x4*)(outp + (size_t)row * D + col) = v[j] * rstd * g; }
        }
    }
#undef IN
#undef SEAM
}

#ifndef MK_N_LAUNCHES
#define MK_N_LAUNCHES 1
#endif
constexpr int NPHASE = 10;
extern "C" void kernel_launch(void* const* d_in, const int* in_sizes, int n_in, void* d_out, int out_size, void* d_ws, size_t ws_size, hipStream_t stream) {
    static int grid = 0;
    if (grid == 0) {
        if (n_in != 21 || in_sizes[0] != T * D || out_size != T * D || ws_size < WS_END) { fprintf(stderr, "kernel_launch: unexpected shapes (n_in %d, in0 %d, out %d, ws %zu)\n", n_in, n_in > 0 ? in_sizes[0] : -1, out_size, ws_size); grid = -1; return; }
        int dev = 0, cus = 0, per_cu = 0;
        if (hipGetDevice(&dev) != hipSuccess || hipDeviceGetAttribute(&cus, hipDeviceAttributeMultiprocessorCount, dev) != hipSuccess) { grid = -1; return; }
        if (hipFuncSetAttribute((const void*)fwd_mega, hipFuncAttributeMaxDynamicSharedMemorySize, LDS_BYTES) != hipSuccess) { fprintf(stderr, "kernel_launch: hipFuncSetAttribute failed\n"); grid = -1; return; }
        if (hipOccupancyMaxActiveBlocksPerMultiprocessor(&per_cu, (const void*)fwd_mega, NTHR, LDS_BYTES) != hipSuccess || per_cu < 1) fprintf(stderr, "kernel_launch: occupancy query reports %d\n", per_cu);
        (void)hipGetLastError();
        grid = cus;
        if (grid != 256) fprintf(stderr, "kernel_launch: %d CUs (built for 256)\n", grid);
    }
    if (grid < 0) return;
    (void)hipMemsetAsync((char*)d_ws + WS_CTL, 0, CTL_ZERO_BYTES, stream);
    Args a{};
    for (int i = 0; i < 21; ++i) a.in[i] = (const float*)d_in[i];
    a.out = (float*)d_out; a.ws = (unsigned char*)d_ws;
    if (MK_N_LAUNCHES == 1) {
        a.ph_lo = 0; a.ph_hi = NPHASE; a.li = 0;
        hipLaunchKernelGGL(fwd_mega, dim3(grid), dim3(NTHR), LDS_BYTES, stream, a);
    } else {
        for (int li = 0; li < NPHASE; ++li) { a.ph_lo = li; a.ph_hi = li + 1; a.li = 0; hipLaunchKernelGGL(fwd_mega, dim3(grid), dim3(NTHR), LDS_BYTES, stream, a);
#ifdef PROBE_DUP
            if (li == PROBE_DUP) {
#ifdef PROBE_SUB
                a.pad = PROBE_SUB;
#endif
                hipLaunchKernelGGL(fwd_mega, dim3(grid), dim3(NTHR), LDS_BYTES, stream, a); a.pad = 0; }
#endif
        }
    }
}
```

```cpp
#include <hip/hip_runtime.h>
#include <cstdio>
#include <cstdint>

#define GAS __attribute__((address_space(1)))
#define LAS __attribute__((address_space(3)))
typedef unsigned short bf16;
typedef unsigned short bf16_t;
typedef unsigned v4u __attribute__((ext_vector_type(4)));
typedef unsigned v2u __attribute__((ext_vector_type(2)));
typedef float f32x4 __attribute__((ext_vector_type(4)));
typedef float f32x2 __attribute__((ext_vector_type(2)));
typedef short bf16x8 __attribute__((ext_vector_type(8)));
typedef unsigned u32x4 __attribute__((ext_vector_type(4)));
typedef GAS unsigned gu32;
typedef unsigned bu4v __attribute__((__vector_size__(16)));
#define RLX_AGENT __ATOMIC_RELAXED, __HIP_MEMORY_SCOPE_AGENT
#define LDS_WAIT() asm volatile("s_waitcnt lgkmcnt(0)" ::: "memory")
#define VM_WAIT() asm volatile("s_waitcnt vmcnt(0)" ::: "memory")

constexpr int NB = 16, SEQ = 2048, D = 1024, T = NB * SEQ, LC = 256, TC = NB * LC, MROWS = T + TC;
constexpr int GW = 64, NROWS = SEQ / GW;
constexpr int INCOLS = 4096, SEGW = 512;
constexpr int NAH = 8, NAD = 64, HGH = 4, HGD = 128;
constexpr int KTOK = SEQ + LC;
constexpr int NE = 16, DE = 512, ECAP = T;
constexpr float EPS = 1e-6f;
constexpr int NWAVES = 8, NTHR = 512;

constexpr size_t MiB = 1u << 20;
constexpr size_t WS_CTL = 0, CTL_ZERO_BYTES = 32768;
constexpr size_t WS_MOD = 1 * MiB;
constexpr size_t WS_ROPE = WS_MOD + 512 * 1024, WS_LBT = WS_MOD + 520 * 1024;
constexpr size_t WS_ELIST = 2 * MiB, WS_EWT = 4 * MiB;
constexpr size_t WS_WINT = 8 * MiB, WS_WOUTT = 16 * MiB, WS_W13T = 18 * MiB, WS_W2T = 50 * MiB;
constexpr size_t WS_XN = 66 * MiB;
constexpr size_t WS_Q = 138 * MiB, WS_K = 170 * MiB, WS_V = 206 * MiB, WS_HQ = 242 * MiB, WS_HI = 274 * MiB, WS_LF = 310 * MiB, WS_LB = 346 * MiB, WS_G = 382 * MiB;
constexpr size_t WS_OF = 414 * MiB, WS_OB = 446 * MiB, WS_QR = 478 * MiB, WS_END = 510 * MiB;
constexpr size_t WS_MIX = WS_XN, WS_XN2 = WS_XN, WS_X1 = 138 * MiB, WS_H = 274 * MiB, WS_Y = 346 * MiB;
constexpr int CW_CNT = 64;
constexpr int CW_TILE = 512;
constexpr int CW_BAR = 4096;
static_assert((CW_BAR + 3456) * 4 <= (int)CTL_ZERO_BYTES, "barrier words inside the per-call memset");

constexpr int RING_OFF = 0, RING_BYTES = 131072;
constexpr int LDSCTL_OFF = RING_BYTES, MISC_OFF = LDSCTL_OFF + 320, MOE_OFF = LDSCTL_OFF + 1024;
constexpr int TAB_OFF = LDSCTL_OFF + 2048;
constexpr int LDS_BYTES = 147456;

__device__ __forceinline__ unsigned f2bf(float f) { unsigned u = __builtin_bit_cast(unsigned, f); return (u + 0x7fffu + ((u >> 16) & 1u)) >> 16; }
__device__ __forceinline__ unsigned pk2(float lo, float hi) { return f2bf(lo) | (f2bf(hi) << 16); }
__device__ __forceinline__ float bf2f(unsigned short b) { return __builtin_bit_cast(float, (unsigned)b << 16); }
__device__ __forceinline__ float bflo(unsigned u) { return __builtin_bit_cast(float, u << 16); }
__device__ __forceinline__ float bfhi(unsigned u) { return __builtin_bit_cast(float, u & 0xffff0000u); }
__device__ __forceinline__ unsigned pkh2(float lo, float hi) { _Float16 a = (_Float16)lo, b = (_Float16)hi; return (unsigned)__builtin_bit_cast(unsigned short, a) | ((unsigned)__builtin_bit_cast(unsigned short, b) << 16); }
__device__ __forceinline__ float h2f(unsigned short h) { return (float)__builtin_bit_cast(_Float16, h); }
__device__ __forceinline__ float silu_f(float v) { return v * __builtin_amdgcn_rcpf(1.f + __expf(-v)); }
__device__ __forceinline__ float wave_sum(float v) {
#pragma unroll
    for (int o = 1; o < 64; o <<= 1) v += __shfl_xor(v, o);
    return v;
}
__device__ __forceinline__ float wave_max(float v) {
#pragma unroll
    for (int o = 1; o < 64; o <<= 1) v = fmaxf(v, __shfl_xor(v, o));
    return v;
}

namespace pg8 {
constexpr int BM = 256, BK = 64, HALF = 128, HTB = HALF * BK * 2, STAGE_BYTES = 8 * HTB, NXCD = 8, WGM = 8;
__host__ __device__ __forceinline__ int lds_byte(int r, int c) { const int st = (r >> 4) * 2 + (c >> 5), rr = r & 15, cc = c & 31, ob = rr * 64 + cc * 2; return st * 1024 + (ob ^ (((ob >> 9) & 1) << 5)); }
__host__ __device__ __forceinline__ void stage_rc(int b, int& R, int& C) { const int st = b / 1024, sb = b % 1024, swz = sb ^ (((sb >> 9) & 1) << 5); R = (st >> 1) * 16 + swz / 64; C = (st & 1) * 32 + (swz % 64) / 2; }
__host__ __device__ __forceinline__ int perm32(int rho) { const int n = rho >> 4, i = rho & 15; return 8 * (i >> 2) + 4 * n + (i & 3); }

struct Unit { int pm, pn, e, tm, cnt; };

typedef float f32x2_t __attribute__((ext_vector_type(2))); typedef __bf16 bf16x2_t __attribute__((ext_vector_type(2)));
__device__ __forceinline__ unsigned cvt_pk_bf16(float lo, float hi) { f32x2_t v = {lo, hi}; bf16x2_t b = __builtin_convertvector(v, bf16x2_t); return __builtin_bit_cast(unsigned, b); }

struct DenseOrder {
    static constexpr bool GATHER = false;
    int nM, nN, nwg, G, c; bool pf;
    __device__ void init(int M, int N, int G_, int c_, bool pf_ = false) { nM = M / BM; nN = N / BM; nwg = nM * nN; G = G_; c = c_; pf = pf_; }
    __device__ bool next(int i, Unit& u) const {
        const long L = (long)i * G + c; if (L >= nwg) return false;
        int wgid = (int)L; { const int q = nwg / NXCD, r = nwg % NXCD, xcd = wgid % NXCD, off = wgid / NXCD; wgid = (xcd < r ? xcd * (q + 1) : r * (q + 1) + (xcd - r) * q) + off; }
        const int nig = WGM * nN, gid = wgid / nig, fm = gid * WGM, gsz = (nM - fm) < WGM ? (nM - fm) : WGM;
        u.pm = fm + ((wgid % nig) % gsz); u.pn = (wgid % nig) / gsz; u.e = 0; u.tm = 0; u.cnt = 0; return true;
    }
    __device__ __forceinline__ int a_row0(const Unit& u) const { return u.pm * BM; }
    __device__ __forceinline__ int a_row(const Unit& u, int r) const { return u.pm * BM + r; }
    __device__ __forceinline__ int b_row0(const Unit& u) const { return u.pn * BM; }
    __device__ __forceinline__ bool perm(const Unit&) const { return pf; }
    __device__ __forceinline__ void a_ready(const Unit&, int) const {}
};

template <class Epi, class Sched>
__device__ __forceinline__ void gemm_phase(LAS unsigned char* lds, const bf16_t* Aptr, const bf16_t* Btptr, const int K, const Sched& S, const Epi& E) {
    const int tid = threadIdx.x, wid = __builtin_amdgcn_readfirstlane(tid >> 6), lane = tid & 63, wr = wid >> 2, wc = wid & 3, fr = lane & 15, fq = lane >> 4;
    const int nt = K / BK;
    int sR[2], sC[2];
    unsigned voffA[2], voffBn[2], voffBp[2], voffB[2], nvB[2];
#pragma unroll
    for (int i = 0; i < 2; ++i) { int R, C; stage_rc(tid * 16 + i * 8192, R, C); const int Rb = (R & ~31) + perm32(R & 31);
        sR[i] = R; sC[i] = C; voffA[i] = (unsigned)(R * K + C) * 2u; voffBn[i] = (unsigned)(R * K + C) * 2u; voffBp[i] = (unsigned)(Rb * K + C) * 2u; }
    const size_t kstep = (size_t)(BK * 2);
    const size_t hstep = (size_t)HALF * K * 2;
    const size_t rowb = (size_t)K * 2;
    const unsigned ldsw = (unsigned)wid * 1024u;
    const int aoff = lds_byte(wr * 64 + fr, fq * 8), boff = lds_byte(wc * 32 + fr, fq * 8);
    const char* Ab = (const char*)Aptr;
#define PG8_SA(b, h) (((b) * 2 + (h)) * HTB)
#define PG8_SB(b, h) ((4 + (b) * 2 + (h)) * HTB)
#define PG8_STAGE(bufoff, gbase, voff) do { _Pragma("unroll") for (int _i = 0; _i < 2; ++_i) \
        __builtin_amdgcn_global_load_lds((const unsigned*)((const char*)(gbase) + (voff)[_i]), (LAS unsigned*)(lds + (bufoff) + ldsw + _i * 8192), 16, 0, 0); } while (0)
#define PG8_LDA(dst, b, h) do { _Pragma("unroll") for (int m = 0; m < 4; ++m) _Pragma("unroll") for (int k = 0; k < 2; ++k) dst[m][k] = *(const LAS bf16x8*)(lds + PG8_SA(b, h) + aoff + m * 2048 + k * 1024); } while (0)
#define PG8_LDB(dst, b, h) do { _Pragma("unroll") for (int n = 0; n < 2; ++n) _Pragma("unroll") for (int k = 0; k < 2; ++k) dst[n][k] = *(const LAS bf16x8*)(lds + PG8_SB(b, h) + boff + n * 2048 + k * 1024); } while (0)
#define PG8_MMA(ai, bj, At, Bt) do { __builtin_amdgcn_s_setprio(1); _Pragma("unroll") for (int m = 0; m < 4; ++m) _Pragma("unroll") for (int n = 0; n < 2; ++n) _Pragma("unroll") for (int k = 0; k < 2; ++k) \
        acc[ai][bj][m][n] = __builtin_amdgcn_mfma_f32_16x16x32_bf16(Bt[n][k], At[m][k], acc[ai][bj][m][n], 0, 0, 0); __builtin_amdgcn_s_setprio(0); } while (0)
#define PG8_WAIT_V(n) asm volatile("s_waitcnt vmcnt(" #n ")" ::: "memory")
#define PG8_WAIT_L(n) asm volatile("s_waitcnt lgkmcnt(" #n ")" ::: "memory")
#define PG8_BAR __builtin_amdgcn_s_barrier()
#define PG8_SCHED __builtin_amdgcn_sched_barrier(0)
    Unit cur, nxt; int ui = 0;
    if (!S.next(0, cur)) return;
    f32x4 acc[2][2][4][2];
#pragma unroll
    for (int a = 0; a < 2; ++a)
#pragma unroll
        for (int b = 0; b < 2; ++b)
#pragma unroll
            for (int m = 0; m < 4; ++m)
#pragma unroll
                for (int n = 0; n < 2; ++n) acc[a][b][m][n] = (f32x4){0.f, 0.f, 0.f, 0.f};
    bf16x8 At[4][2], B0[2][2], B1[2][2];
    const char* cA = Ab; unsigned cG[2][2];
    if constexpr (Sched::GATHER) {
#pragma unroll
        for (int h = 0; h < 2; ++h)
#pragma unroll
            for (int i = 0; i < 2; ++i) cG[h][i] = (unsigned)((size_t)S.a_row(cur, h * HALF + sR[i]) * rowb) + (unsigned)sC[i] * 2u;
    } else { cA = Ab + (ptrdiff_t)S.a_row0(cur) * (ptrdiff_t)rowb; cG[0][0] = cG[0][1] = cG[1][0] = cG[1][1] = 0u; }
    S.a_ready(cur, wid);
    const char* cB = (const char*)Btptr + (ptrdiff_t)S.b_row0(cur) * (ptrdiff_t)rowb;
    { const bool pc = S.perm(cur); voffB[0] = pc ? voffBp[0] : voffBn[0]; voffB[1] = pc ? voffBp[1] : voffBn[1]; }
#define PG8_STAGEA(bufoff, h, dbase, goffs, kb) do { if constexpr (Sched::GATHER) { PG8_STAGE(bufoff, Ab + (kb), (goffs)[h]); } else { PG8_STAGE(bufoff, (dbase) + (h) * hstep + (kb), voffA); } } while (0)
    PG8_STAGE(PG8_SB(0, 0), cB, voffB); PG8_STAGE(PG8_SB(0, 1), cB + hstep, voffB); PG8_STAGEA(PG8_SA(0, 0), 0, cA, cG, 0); PG8_STAGEA(PG8_SA(0, 1), 1, cA, cG, 0);
    if (wr == 1) PG8_BAR;
    PG8_WAIT_V(2); PG8_BAR;
    PG8_STAGE(PG8_SB(1, 0), cB + kstep, voffB); PG8_STAGEA(PG8_SA(1, 0), 0, cA, cG, kstep); PG8_STAGE(PG8_SB(1, 1), cB + hstep + kstep, voffB);
    PG8_WAIT_V(6); PG8_BAR;
    for (;;) {
        const bool has_next = S.next(ui + 1, nxt);
        const char* nA = cA; const char* nB = cB; unsigned nG[2][2];
#pragma unroll
        for (int h = 0; h < 2; ++h)
#pragma unroll
            for (int i = 0; i < 2; ++i) nG[h][i] = cG[h][i];
        nvB[0] = voffB[0]; nvB[1] = voffB[1];
        if (has_next) {
            nB = (const char*)Btptr + (ptrdiff_t)S.b_row0(nxt) * (ptrdiff_t)rowb;
            { const bool pn_ = S.perm(nxt); nvB[0] = pn_ ? voffBp[0] : voffBn[0]; nvB[1] = pn_ ? voffBp[1] : voffBn[1]; }
            if constexpr (Sched::GATHER) {
#pragma unroll
                for (int h = 0; h < 2; ++h)
#pragma unroll
                    for (int i = 0; i < 2; ++i) nG[h][i] = (unsigned)((size_t)S.a_row(nxt, h * HALF + sR[i]) * rowb) + (unsigned)sC[i] * 2u;
            } else nA = Ab + (ptrdiff_t)S.a_row0(nxt) * (ptrdiff_t)rowb;
        }
        for (int t = 0; t < nt; t += 2) {
            const bool last = (t == nt - 2);
            if (last && has_next) S.a_ready(nxt, wid);
            const size_t kb1 = (size_t)(t + 1) * kstep;
            const size_t kb2 = last ? 0 : (size_t)(t + 2) * kstep, kb3 = kb2 + kstep;
            const char* a2 = last ? nA : cA; const char* b2 = last ? nB : cB + (size_t)(t + 2) * kstep; const char* b3 = b2 + kstep;
            unsigned vB2[2]; vB2[0] = last ? nvB[0] : voffB[0]; vB2[1] = last ? nvB[1] : voffB[1];
            unsigned g2[2][2];
#pragma unroll
            for (int h = 0; h < 2; ++h)
#pragma unroll
                for (int i = 0; i < 2; ++i) g2[h][i] = last ? nG[h][i] : cG[h][i];
            PG8_LDB(B0, 0, 0); PG8_LDB(B1, 0, 1); PG8_SCHED; PG8_LDA(At, 0, 0); PG8_STAGEA(PG8_SA(1, 1), 1, cA, cG, kb1);
            PG8_WAIT_V(8); PG8_WAIT_L(0); PG8_BAR; PG8_MMA(0, 0, At, B0); PG8_MMA(0, 1, At, B1); PG8_BAR; PG8_SCHED;
            PG8_LDA(At, 0, 1); PG8_STAGE(PG8_SB(0, 0), b2, vB2); PG8_STAGE(PG8_SB(0, 1), b2 + hstep, vB2); PG8_STAGEA(PG8_SA(0, 0), 0, a2, g2, kb2);
            PG8_WAIT_V(8); PG8_WAIT_L(0); PG8_BAR; PG8_MMA(1, 0, At, B0); PG8_MMA(1, 1, At, B1); PG8_BAR; PG8_SCHED;
            PG8_LDB(B0, 1, 0); PG8_LDB(B1, 1, 1); PG8_SCHED; PG8_LDA(At, 1, 0); PG8_STAGEA(PG8_SA(0, 1), 1, a2, g2, kb2);
            PG8_WAIT_V(8); PG8_WAIT_L(0); PG8_BAR; PG8_MMA(0, 0, At, B0); PG8_MMA(0, 1, At, B1); PG8_BAR; PG8_SCHED;
            PG8_LDA(At, 1, 1); PG8_STAGE(PG8_SB(1, 0), b3, vB2); PG8_STAGE(PG8_SB(1, 1), b3 + hstep, vB2); PG8_STAGEA(PG8_SA(1, 0), 0, a2, g2, kb3);
            PG8_WAIT_V(8); PG8_WAIT_L(0); PG8_BAR; PG8_MMA(1, 0, At, B0); PG8_MMA(1, 1, At, B1); PG8_BAR; PG8_SCHED;
        }
        if (wr == 0) PG8_BAR;
        E(acc, cur, wr, wc, fr, fq);
        if (!has_next) break;
#pragma unroll
        for (int a = 0; a < 2; ++a)
#pragma unroll
            for (int b = 0; b < 2; ++b)
#pragma unroll
                for (int m = 0; m < 4; ++m)
#pragma unroll
                    for (int n = 0; n < 2; ++n) acc[a][b][m][n] = (f32x4){0.f, 0.f, 0.f, 0.f};
        cur = nxt; cA = nA; cB = nB; ++ui; voffB[0] = nvB[0]; voffB[1] = nvB[1];
#pragma unroll
        for (int h = 0; h < 2; ++h)
#pragma unroll
            for (int i = 0; i < 2; ++i) cG[h][i] = nG[h][i];
        if (wr == 1) PG8_BAR;
    }
    PG8_WAIT_V(0);
    PG8_BAR;
#undef PG8_SA
#undef PG8_SB
#undef PG8_STAGE
#undef PG8_STAGEA
#undef PG8_LDA
#undef PG8_LDB
#undef PG8_MMA
#undef PG8_WAIT_V
#undef PG8_WAIT_L
#undef PG8_BAR
#undef PG8_SCHED
}
}

#define XB_TMO      128
#define XB_XCNT(j)  (256  + 64 * (j))
#define XB_XSUB(j)  (1280 + 64 * (j))
#define XB_XGEN(j)  (2304 + 64 * (j))
#define XB_TOP      3328
#define XB_TOPGEN   3392
#define XCD_BAR_WORDS 3456
#define XB_SPIN_CAP (1u << 18)
__device__ __forceinline__ unsigned xb_ld(unsigned* p)              { return __hip_atomic_load(p, __ATOMIC_RELAXED, __HIP_MEMORY_SCOPE_AGENT); }
__device__ __forceinline__ unsigned xb_add(unsigned* p, unsigned v) { return __hip_atomic_fetch_add(p, v, __ATOMIC_RELAXED, __HIP_MEMORY_SCOPE_AGENT); }
__device__ __forceinline__ unsigned xb_xcc_id() { return (unsigned)__builtin_amdgcn_s_getreg((3 << 11) | 20) & 0xFu; }
#define XB_SPIN(cond, bar) do { unsigned _sp = 0; while (cond) { __builtin_amdgcn_s_sleep(1); \
    if ((++_sp & 255u) == 0u) { if (xb_ld(&(bar)[XB_TMO])) break; if (_sp > XB_SPIN_CAP) { atomicAdd(&(bar)[XB_TMO], 1u); break; } } } } while (0)
struct XcdBarrier { unsigned* bar; unsigned x; volatile LAS unsigned* st; };
__device__ __forceinline__ XcdBarrier xcd_barrier_post(unsigned* bar, volatile LAS unsigned* st) {
    XcdBarrier b; b.bar = bar; b.x = xb_xcc_id(); b.st = st;
    if (threadIdx.x == 0) (void)xb_add(&bar[XB_XCNT(b.x)], 1u);
    return b;
}
__device__ __forceinline__ void xcd_barrier_complete(unsigned* bar, unsigned x, unsigned& nloc, unsigned& nx) {
    const unsigned G = gridDim.x * gridDim.y * gridDim.z;
    unsigned sum, cnt, mine, sp = 0u;
    for (;;) {
        sum = 0u; cnt = 0u; mine = 0u;
#pragma unroll
        for (unsigned j = 0; j < 16; ++j) { const unsigned c = xb_ld(&bar[XB_XCNT(j)]); sum += c; cnt += (c > 0u) ? 1u : 0u; mine = (j == x) ? c : mine; }
        if (sum == G) break;
        __builtin_amdgcn_s_sleep(1);
        if ((++sp & 255u) == 0u) { if (xb_ld(&bar[XB_TMO])) break; if (sp > XB_SPIN_CAP) { atomicAdd(&bar[XB_TMO], 1u); break; } }
    }
    nloc = mine > 0u ? mine : 1u; nx = cnt > 0u ? cnt : 1u;
}
__device__ __forceinline__ void xcd_barrier(const XcdBarrier& b) {
    asm volatile("s_waitcnt vmcnt(0)" ::: "memory");
    __syncthreads();
    if (threadIdx.x == 0) {
        unsigned* bar = b.bar;
        __builtin_amdgcn_s_waitcnt(0);
        unsigned nloc = b.st[0], nx = b.st[1];
        if (nloc == 0u) { xcd_barrier_complete(bar, b.x, nloc, nx); b.st[0] = nloc; b.st[1] = nx; }
        const unsigned old = xb_add(&bar[XB_XSUB(b.x)], 1u);
        const unsigned gen = old / nloc;
        if (old + 1u == (gen + 1u) * nloc) {
            __builtin_amdgcn_fence(__ATOMIC_RELEASE, "agent");
            asm volatile("s_waitcnt vmcnt(0)" ::: "memory");
            const unsigned og = xb_add(&bar[XB_TOP], 1u);
            const unsigned tg = og / nx;
            if (og + 1u == (tg + 1u) * nx) xb_add(&bar[XB_TOPGEN], 1u);
            else XB_SPIN(xb_ld(&bar[XB_TOPGEN]) == tg, bar);
            __builtin_amdgcn_fence(__ATOMIC_ACQUIRE, "agent");
            xb_add(&bar[XB_XGEN(b.x)], 1u);
            asm volatile("s_waitcnt vmcnt(0)" ::: "memory");
        } else {
            XB_SPIN(xb_ld(&bar[XB_XGEN(b.x)]) == gen, bar);
            __builtin_amdgcn_fence(__ATOMIC_ACQUIRE, "agent");
            asm volatile("s_waitcnt vmcnt(0)" ::: "memory");
        }
    }
    __syncthreads();
}

using pg8::Unit;
typedef f32x4 acc_t[2][2][4][2];

struct EpiProj {
    static constexpr bool PERM = false;
    unsigned char* ws; const LAS float* ropeL; const LAS float* lbtL; int skip;
    template <int KIND> __device__ __forceinline__ void swapped(const acc_t& acc, const Unit& u, int wr, int wc, int fr, int fq, bool latent) const {
        constexpr size_t so2 = KIND == 0 ? WS_V : KIND == 1 ? WS_HQ : KIND == 2 ? WS_HI : KIND == 3 ? WS_LF : WS_LB;
        bf16* dT = (bf16*)(ws + so2);
        constexpr int ldt = (KIND == 1) ? T : MROWS;
        const int wrow0 = (u.pn & 1) * 256 + wr * 64 + fr, tcol0 = u.pm * 256 + wc * 32 + 8 * fq;
        const LAS float* lbt = lbtL + (KIND == 4 ? 512 : 0);
#pragma unroll
        for (int ai = 0; ai < 2; ++ai)
#pragma unroll
            for (int m = 0; m < 4; ++m) { const int wrow = wrow0 + ai * 128 + m * 16; float lb = 0.f; if (KIND >= 3) lb = lbt[wrow];
#pragma unroll
                for (int bj = 0; bj < 2; ++bj) { float x[8]; u32x4 w;
#pragma unroll
                    for (int j = 0; j < 4; ++j) { x[j] = acc[ai][bj][m][0][j]; x[4 + j] = acc[ai][bj][m][1][j]; }
                    if (KIND >= 3) {
#pragma unroll
                        for (int j = 0; j < 8; ++j) { const float sg = __builtin_amdgcn_rcpf(1.f + __expf(-x[j])); x[j] = __log2f(lb + (1.f - lb) * sg); }
                        w = (u32x4){pkh2(x[0], x[1]), pkh2(x[2], x[3]), pkh2(x[4], x[5]), pkh2(x[6], x[7])}; }
                    else { if (KIND == 1) {
#pragma unroll
                            for (int j = 0; j < 8; ++j) x[j] = silu_f(x[j]); }
                        w = (u32x4){pg8::cvt_pk_bf16(x[0], x[1]), pg8::cvt_pk_bf16(x[2], x[3]), pg8::cvt_pk_bf16(x[4], x[5]), pg8::cvt_pk_bf16(x[6], x[7])}; }
                    size_t off = (size_t)wrow * ldt + tcol0 + bj * 128;
                    if (KIND == 0) { const int tc = tcol0 + bj * 128, bb_ = latent ? (tc >> 11) : ((tc - T) >> 8), tl = latent ? (tc & (SEQ - 1)) : (KTOK - LC + ((tc - T) & (LC - 1)));
                        off = ((((size_t)(bb_ * NAH + (wrow >> 6)) * (KTOK / 64) + (tl >> 6)) * NAD + (wrow & 63)) * 64) + (tl & 63); }
                    *(u32x4*)(dT + off) = w; } }
    }
    template <int SEG, bool LAT> __device__ __forceinline__ void rope(const acc_t& acc, int row0, int lcp, int wc, int fq) const {
        bf16* dK = (bf16*)(ws + (SEG == 0 ? WS_QR : WS_K)); bf16* dQ = (bf16*)(ws + WS_Q);
#pragma unroll
        for (int ai = 0; ai < 2; ++ai)
#pragma unroll
            for (int m = 0; m < 4; ++m) { const int row = row0 + ai * 128 + m * 16, sq = row & (SEQ - 1); const int pos = (wc & 1) ? (sq & 63) : (sq >> 6);
                f32x4 cs0 = (f32x4){1.f, 0.f, 1.f, 0.f}, cs1 = cs0;
                if (LAT) { cs0 = *(const LAS f32x4*)(ropeL + (pos * 16 + 4 * fq) * 2); cs1 = *(const LAS f32x4*)(ropeL + (pos * 16 + 4 * fq) * 2 + 4); }
                const float cc[4] = {cs0[0], cs0[2], cs1[0], cs1[2]}, sn[4] = {cs0[1], cs0[3], cs1[1], cs1[3]};
#pragma unroll
                for (int bj = 0; bj < 2; ++bj) { const f32x4 x1 = acc[ai][bj][m][0], x2 = acc[ai][bj][m][1]; float o1[4], o2[4];
#pragma unroll
                    for (int j = 0; j < 4; ++j) { o1[j] = LAT ? x1[j] * cc[j] - x2[j] * sn[j] : x1[j]; o2[j] = LAT ? x2[j] * cc[j] + x1[j] * sn[j] : x2[j]; }
                    size_t off = (size_t)row * SEGW + lcp + bj * 128;
                    if (SEG == 0) *(u32x4*)(dQ + off) = (u32x4){pg8::cvt_pk_bf16(x1[0], x1[1]), pg8::cvt_pk_bf16(x1[2], x1[3]), pg8::cvt_pk_bf16(x2[0], x2[1]), pg8::cvt_pk_bf16(x2[2], x2[3])};
                    else { const int cf = lcp + bj * 128, bb_ = LAT ? (row >> 11) : ((row - T) >> 8), tl = LAT ? sq : (KTOK - LC + ((row - T) & (LC - 1)));
                        off = ((size_t)(bb_ * NAH + (cf >> 6)) * KTOK + tl) * NAD + (cf & 63); }
                    *(u32x4*)(dK + off) = (u32x4){pg8::cvt_pk_bf16(o1[0], o1[1]), pg8::cvt_pk_bf16(o1[2], o1[3]), pg8::cvt_pk_bf16(o2[0], o2[1]), pg8::cvt_pk_bf16(o2[2], o2[3])}; } }
    }
    __device__ __forceinline__ void operator()(const acc_t& acc, const Unit& u, int wr, int wc, int fr, int fq) const {
        const int seg = u.pn >> 1; const bool latent = u.pm < (T / 256);
        if (skip) return;
        if (!latent && (seg == 0 || seg == 3 || seg == 7)) return;
        if (u.e) {
            if (seg == 2) swapped<0>(acc, u, wr, wc, fr, fq, latent);
            else if (seg == 3) swapped<1>(acc, u, wr, wc, fr, fq, latent);
            else if (seg == 4) swapped<2>(acc, u, wr, wc, fr, fq, latent);
            else if (seg == 5) swapped<3>(acc, u, wr, wc, fr, fq, latent);
            else swapped<4>(acc, u, wr, wc, fr, fq, latent);
            return;
        }
        const int row0 = u.pm * 256 + wr * 64 + fr;
        const int lcp = (u.pn & 1) * 256 + wc * 32 + 8 * fq;
        if (seg <= 1) {
            if (seg == 0) rope<0, true>(acc, row0, lcp, wc, fq);
            else if (latent) rope<1, true>(acc, row0, lcp, wc, fq);
            else rope<1, false>(acc, row0, lcp, wc, fq);
            return;
        }
        bf16* dG = (bf16*)(ws + WS_G);
#pragma unroll
        for (int ai = 0; ai < 2; ++ai)
#pragma unroll
            for (int m = 0; m < 4; ++m) { const int row = row0 + ai * 128 + m * 16;
#pragma unroll
                for (int bj = 0; bj < 2; ++bj) { float x[8];
#pragma unroll
                    for (int j = 0; j < 4; ++j) { x[j] = silu_f(acc[ai][bj][m][0][j]); x[4 + j] = silu_f(acc[ai][bj][m][1][j]); }
                    *(u32x4*)(dG + (size_t)row * SEGW + lcp + bj * 128) = (u32x4){pg8::cvt_pk_bf16(x[0], x[1]), pg8::cvt_pk_bf16(x[2], x[3]), pg8::cvt_pk_bf16(x[4], x[5]), pg8::cvt_pk_bf16(x[6], x[7])}; } }
    }
};
struct EpiP {
    static constexpr bool PERM = true;
    bf16* P;
    __device__ __forceinline__ void operator()(const acc_t& acc, const Unit& u, int wr, int wc, int fr, int fq) const {
        const int col0 = u.pn * 256 + wc * 32 + 8 * fq; const int row0 = u.pm * 256 + wr * 64 + fr;
#pragma unroll
        for (int ai = 0; ai < 2; ++ai)
#pragma unroll
            for (int m = 0; m < 4; ++m)
#pragma unroll
                for (int bj = 0; bj < 2; ++bj) { const f32x4 v0 = acc[ai][bj][m][0], v1 = acc[ai][bj][m][1];
                    *(u32x4*)(P + (size_t)(row0 + ai * 128 + m * 16) * D + col0 + bj * 128) = (u32x4){pg8::cvt_pk_bf16(v0[0], v0[1]), pg8::cvt_pk_bf16(v0[2], v0[3]), pg8::cvt_pk_bf16(v1[0], v1[1]), pg8::cvt_pk_bf16(v1[2], v1[3])}; }
    }
};
struct EpiSwiGLU {
    static constexpr bool PERM = true;
    bf16* H; gu32* tcnt;
    __device__ __forceinline__ void operator()(const acc_t& acc, const Unit& u, int wr, int wc, int fr, int fq) const {
        const int hc = u.pn * 128 + wc * 32 + 8 * fq; const int row0 = u.pm * 256 + wr * 64 + fr;
        const __amdgpu_buffer_rsrc_t hr = __builtin_amdgcn_make_buffer_rsrc((void*)H, (short)0, 0x7ffffff0, 0x00020000);
#pragma unroll
        for (int ai = 0; ai < 2; ++ai)
#pragma unroll
            for (int m = 0; m < 4; ++m) { float h[8];
#pragma unroll
                for (int n = 0; n < 2; ++n)
#pragma unroll
                    for (int j = 0; j < 4; ++j) h[n * 4 + j] = silu_f(acc[ai][0][m][n][j]) * acc[ai][1][m][n][j];
                u32x4 w; w.x = pg8::cvt_pk_bf16(h[0], h[1]); w.y = pg8::cvt_pk_bf16(h[2], h[3]); w.z = pg8::cvt_pk_bf16(h[4], h[5]); w.w = pg8::cvt_pk_bf16(h[6], h[7]);
                const unsigned off = (unsigned)(((size_t)(row0 + ai * 128 + m * 16) * DE + hc) * 2);
                __builtin_amdgcn_raw_buffer_store_b128(__builtin_bit_cast(bu4v, w), hr, (int)off, 0, 16); }
        if (tcnt) { asm volatile("s_waitcnt vmcnt(0)" ::: "memory");
            if (fr == 0 && fq == 0) (void)__hip_atomic_fetch_add(tcnt + u.pm, 1u, RLX_AGENT); }
    }
};
struct EpiMoeOut {
    static constexpr bool PERM = true;
    bf16* Y; const int* elist; const float* ewt;
    __device__ __forceinline__ void operator()(const acc_t& acc, const Unit& u, int wr, int wc, int fr, int fq) const {
        const int col0 = u.pn * 256 + wc * 32 + 8 * fq;
#pragma unroll
        for (int ai = 0; ai < 2; ++ai)
#pragma unroll
            for (int m = 0; m < 4; ++m) { const int rank = u.tm * 256 + ai * 128 + wr * 64 + m * 16 + fr;
                if (rank < u.cnt) { const int tk = elist[u.e * ECAP + rank]; const float w = ewt[u.e * ECAP + rank];
#pragma unroll
                    for (int bj = 0; bj < 2; ++bj) { const f32x4 v0 = acc[ai][bj][m][0] * w, v1 = acc[ai][bj][m][1] * w; u32x4 o;
                        o.x = pg8::cvt_pk_bf16(v0[0], v0[1]); o.y = pg8::cvt_pk_bf16(v0[2], v0[3]); o.z = pg8::cvt_pk_bf16(v1[0], v1[1]); o.w = pg8::cvt_pk_bf16(v1[2], v1[3]);
                        *(u32x4*)(Y + (size_t)tk * D + col0 + bj * 128) = o; } } }
    }
};
template <bool GATHER_> struct MoeOrder {
    static constexpr bool GATHER = GATHER_;
    const LAS int* tp; const int* elist; int G, c, nwg; gu32* tcnt;
    __device__ bool next(int i, Unit& u) const {
        const long L = (long)i * G + c; if (L >= nwg) return false;
        int wgid = (int)L; { const int q = nwg / 8, r = nwg % 8, xcd = wgid % 8, off = wgid / 8; wgid = (xcd < r ? xcd * (q + 1) : r * (q + 1) + (xcd - r) * q) + off; }
        const int gt = wgid >> 2; int e = 0;
#pragma unroll
        for (int k = 1; k < 16; ++k) e = (gt >= tp[k]) ? k : e;
        u.pm = gt; u.pn = wgid & 3; u.e = e; u.tm = gt - tp[e]; u.cnt = tp[17 + e]; return true;
    }
    __device__ __forceinline__ int a_row0(const Unit& u) const { return u.pm * 256; }
    __device__ __forceinline__ int a_row(const Unit& u, int r) const {
        if constexpr (GATHER_) { int rank = u.tm * 256 + r; rank = rank < u.cnt ? rank : u.cnt - 1; return elist[u.e * ECAP + rank] >> 1; }
        else return u.pm * 256 + r;
    }
    __device__ __forceinline__ int b_row0(const Unit& u) const { return u.e * 1024 + u.pn * 256; }
    __device__ __forceinline__ bool perm(const Unit&) const { return true; }
    __device__ __forceinline__ void a_ready(const Unit& u, int wid) const {
        if constexpr (!GATHER_) {
            if (tcnt) {
                if (wid == 0) { unsigned sp = 0; while (__hip_atomic_load(tcnt + u.pm, RLX_AGENT) < 32u) { __builtin_amdgcn_s_sleep(2); if (++sp > (1u << 20)) break; }
                    __builtin_amdgcn_fence(__ATOMIC_ACQUIRE, "agent"); asm volatile("s_waitcnt vmcnt(0)" ::: "memory"); }
                __builtin_amdgcn_s_barrier();
            }
        }
    }
};


constexpr int SWMASK = 0x7C;
constexpr int W_REL_XN = (int)(((long long)WS_WINT - (long long)WS_XN) / 2048);
struct ProjOrder {
    static constexpr bool GATHER = false;
    pg8::DenseOrder d;
    __device__ void init(int G_, int c_) { d.init(MROWS, INCOLS, G_, c_); }
    __device__ bool next(int i, Unit& u) const { if (!d.next(i, u)) return false; u.e = (SWMASK >> (u.pn >> 1)) & 1; return true; }
    __device__ __forceinline__ int a_row0(const Unit& u) const { return u.e ? W_REL_XN + u.pn * 256 : u.pm * 256; }
    __device__ __forceinline__ int a_row(const Unit& u, int r) const { return a_row0(u) + r; }
    __device__ __forceinline__ int b_row0(const Unit& u) const { return u.e ? -W_REL_XN + u.pm * 256 : u.pn * 256; }
    __device__ __forceinline__ bool perm(const Unit& u) const { return (u.pn >> 1) >= 2; }
    __device__ __forceinline__ void a_ready(const Unit&, int) const {}
};


__device__ __forceinline__ bf16x8 pack8(const f32x4& a, const f32x4& b) {
    u32x4 w; w.x = pg8::cvt_pk_bf16(a[0], a[1]); w.y = pg8::cvt_pk_bf16(a[2], a[3]); w.z = pg8::cvt_pk_bf16(b[0], b[1]); w.w = pg8::cvt_pk_bf16(b[2], b[3]);
    return __builtin_bit_cast(bf16x8, w);
}
typedef unsigned bu4 __attribute__((__vector_size__(16)));
__device__ __forceinline__ bf16x8 bload16(__amdgpu_buffer_rsrc_t r, unsigned voff, unsigned soff) { return __builtin_bit_cast(bf16x8, __builtin_amdgcn_raw_buffer_load_b128(r, (int)voff, (int)soff, 0)); }
#define NA_SB() __builtin_amdgcn_sched_barrier(0)
__device__ __forceinline__ bf16x8 sel8(bool c, const bf16x8 a, const bf16x8 b) { const u32x4 x = __builtin_bit_cast(u32x4, a), y = __builtin_bit_cast(u32x4, b); u32x4 r;
    r.x = c ? x.x : y.x; r.y = c ? x.y : y.y; r.z = c ? x.z : y.z; r.w = c ? x.w : y.w; return __builtin_bit_cast(bf16x8, r); }
constexpr int NA_CTXK = 0, NA_CTXV = 32768, NA_RING = 65536, NA_SLOT = 16384;
#define NA_BAR() do { asm volatile("s_waitcnt lgkmcnt(0)" ::: "memory"); __builtin_amdgcn_s_barrier(); asm volatile("" ::: "memory"); } while (0)
struct NaState { f32x4 o[2][4]; float mref[2], lsum[2]; };
template <bool LOCAL>
__device__ __forceinline__ void na_step(NaState& st, const bf16x8 (&q)[2][2], const LAS unsigned char* kb, const LAS unsigned char* vb, unsigned vsw, const LAS float* bpi,
                                        bool setref, int qi, int g, int jb) {
    constexpr float SC = 0.125f * 1.44269504f; const float NEG = -1e30f;
    const int rg = qi >> 2;
    const unsigned kx = (unsigned)((rg << 1) | ((qi >> 1) & 1)), vx = (unsigned)((qi >> 1) & 7);
    const unsigned ka0 = (unsigned)(8 * rg + (qi & 3)) * 128u + (((unsigned)g ^ kx) << 4), ka1 = ka0 ^ 64u;
    const unsigned va = (unsigned)qi * 128u + (((unsigned)g ^ vx) << 4);
#pragma unroll
    for (int j = 0; j < 2; ++j) {
        const int jj = jb + j; const int P0 = (jj == 0) ? 0 : (jj == 1) ? 1 : (jj == 2) ? 3 : 4;
        const int pk = P0 + ((rg - P0) & 3), pv = P0 + ((g - P0) & 3);
        const unsigned kh = LOCAL ? (unsigned)(pk >> 2) * 4096u : 0u, vh = LOCAL ? (unsigned)(pv >> 2) * 64u : 0u;
        const bf16x8 a00 = *(const LAS bf16x8*)(kb + (ka0 + kh)), a01 = *(const LAS bf16x8*)(kb + (ka1 + kh)), a10 = *(const LAS bf16x8*)(kb + 512 + (ka0 + kh)), a11 = *(const LAS bf16x8*)(kb + 512 + (ka1 + kh));
        bf16x8 vf[4]; const unsigned vaj = (va ^ vsw) ^ vh;
#pragma unroll
        for (int dt = 0; dt < 4; ++dt) vf[dt] = *(const LAS bf16x8*)(vb + dt * 2048 + vaj);
        f32x4 s0 = __builtin_amdgcn_mfma_f32_16x16x32_bf16(a00, q[j][0], (f32x4){0.f, 0.f, 0.f, 0.f}, 0, 0, 0); s0 = __builtin_amdgcn_mfma_f32_16x16x32_bf16(a01, q[j][1], s0, 0, 0, 0);
        f32x4 s1 = __builtin_amdgcn_mfma_f32_16x16x32_bf16(a10, q[j][0], (f32x4){0.f, 0.f, 0.f, 0.f}, 0, 0, 0); s1 = __builtin_amdgcn_mfma_f32_16x16x32_bf16(a11, q[j][1], s1, 0, 0, 0);
        if (LOCAL) {
            const int bbj = 8 * pv - (16 * jj + qi) + 31;
            const int dlo = (jj == 0) ? (qi < 8 ? 31 - qi : 23) : (jj == 3) ? (qi > 8 ? 31 - qi : 23) : 23;
            const int lo_j = dlo - bbj; const LAS float* bpj = bpi + bbj;
            { float b0 = bpj[0], b1 = bpj[1], b2 = bpj[2], b3 = bpj[3];
              asm volatile("" : "+v"(b0), "+v"(b1), "+v"(b2), "+v"(b3));
              const float bq[4] = {b0, b1, b2, b3};
#pragma unroll
              for (int e = 0; e < 4; ++e) { const float t0 = s0[e] * SC + bq[e]; s0[e] = ((unsigned)(e - lo_j) < 16u) ? t0 : NEG; } }
            { float b0 = bpj[4], b1 = bpj[5], b2 = bpj[6], b3 = bpj[7];
              asm volatile("" : "+v"(b0), "+v"(b1), "+v"(b2), "+v"(b3));
              const float bq[4] = {b0, b1, b2, b3};
#pragma unroll
              for (int e = 0; e < 4; ++e) { const float t1 = s1[e] * SC + bq[e]; s1[e] = ((unsigned)(4 + e - lo_j) < 16u) ? t1 : NEG; } }
        } else {
#pragma unroll
            for (int e = 0; e < 4; ++e) { s0[e] *= SC; s1[e] *= SC; }
        }
        if (setref) { float mx = fmaxf(fmaxf(fmaxf(s0[0], s0[1]), fmaxf(s0[2], s0[3])), fmaxf(fmaxf(s1[0], s1[1]), fmaxf(s1[2], s1[3])));
            mx = fmaxf(mx, __shfl_xor(mx, 16)); mx = fmaxf(mx, __shfl_xor(mx, 32)); st.mref[j] = mx; }
        float ps = 0.f;
#pragma unroll
        for (int e = 0; e < 4; ++e) { s0[e] = __builtin_amdgcn_exp2f(fminf(s0[e] - st.mref[j], 100.f)); s1[e] = __builtin_amdgcn_exp2f(fminf(s1[e] - st.mref[j], 100.f)); ps += s0[e] + s1[e]; }
        st.lsum[j] += ps; const bf16x8 Bp = pack8(s0, s1);
#pragma unroll
        for (int dt = 0; dt < 4; ++dt) st.o[j][dt] = __builtin_amdgcn_mfma_f32_16x16x32_bf16(vf[dt], Bp, st.o[j][dt], 0, 0, 0);
    }
}
__device__ __forceinline__ void na_wg(LAS unsigned char* lds, int bb, int h, const bf16* Q, const bf16* QR, const bf16* KH, const bf16* VH, bf16* MIX, const LAS float* rpbL, int tid) {
    const int lane = tid & 63, w = __builtin_amdgcn_readfirstlane(tid >> 6), qi = lane & 15, g = lane >> 4;
    const int jb = 2 * (w & 1);
    const size_t bh = (size_t)(bb * NAH + h);
    { const u32x4* ksrc = (const u32x4*)(KH + (bh * KTOK + SEQ) * NAD); const u32x4* vsrc = (const u32x4*)(VH + (bh * (KTOK / 64) + SEQ / 64) * (NAD * 64));
#pragma unroll
      for (int j = 0; j < 4; ++j) { const int L = tid + NTHR * j; const u32x4 kv = ksrc[L], vv = vsrc[L];
          const int key = L >> 3, ch = L & 7, fk = (((key >> 3) & 3) << 1) | ((key >> 1) & 1);
          *(LAS u32x4*)(lds + NA_CTXK + key * 128 + ((ch ^ fk) << 4)) = kv;
          const int blk = L >> 9, dd = (L >> 3) & 63;
          *(LAS u32x4*)(lds + NA_CTXV + blk * 8192 + dd * 128 + ((ch ^ ((dd >> 1) & 7)) << 4)) = vv; } }
    const int skey = tid >> 3, sch = tid & 7;
    const unsigned skoff = (unsigned)(skey * 128 + ((sch ^ ((((skey >> 3) & 3) << 1) | ((skey >> 1) & 1))) << 4)), svoff = (unsigned)(8192 + skey * 128 + ((sch ^ ((skey >> 1) & 7)) << 4));
    const u32x4* kg = (const u32x4*)(KH + bh * KTOK * NAD) + tid;
    const u32x4* vg = (const u32x4*)(VH + bh * (KTOK / 64) * (NAD * 64)) + tid;
#pragma unroll 1
    for (int item = 0; item < 8; ++item) {
        const int r0 = 4 * item, r = r0 + (w >> 1);
        int rs = r - 4; rs = rs < 0 ? 0 : (rs > NROWS - 8 ? NROWS - 8 : rs);
        int rs0 = r0 - 4; rs0 = rs0 < 0 ? 0 : (rs0 > NROWS - 8 ? NROWS - 8 : rs0);
        int rs3 = r0 - 1; rs3 = rs3 < 0 ? 0 : (rs3 > NROWS - 8 ? NROWS - 8 : rs3);
        const int nloc = rs3 + 8 - rs0, off = rs - rs0;
        const int tok0 = bb * SEQ + r * GW;
        NaState st; bf16x8 qrot[2][2], qraw[2][2];
#pragma unroll
        for (int j = 0; j < 2; ++j) { st.mref[j] = 0.f; st.lsum[j] = 0.f;
#pragma unroll
            for (int dt = 0; dt < 4; ++dt) st.o[j][dt] = (f32x4){0.f, 0.f, 0.f, 0.f};
            const size_t qo = (size_t)(tok0 + 16 * (jb + j) + qi) * SEGW + h * NAD + 8 * g;
            qrot[j][0] = *(const bf16x8*)(QR + qo); qrot[j][1] = *(const bf16x8*)(QR + qo + 32); qraw[j][0] = *(const bf16x8*)(Q + qo); qraw[j][1] = *(const bf16x8*)(Q + qo + 32); }
        u32x4 sk = kg[(size_t)rs0 * 512], sv = vg[(size_t)rs0 * 512];
        *(LAS u32x4*)(lds + NA_RING + skoff) = sk; *(LAS u32x4*)(lds + NA_RING + svoff) = sv;
        sk = kg[(size_t)(rs0 + 1) * 512]; sv = vg[(size_t)(rs0 + 1) * 512];
        NA_BAR();
        int ic = 0;
#pragma unroll 1
        for (int slot = 0; slot < 16; ++slot) {
            if (slot + 1 < nloc) { const int rsl = (slot + 1) % 3; *(LAS u32x4*)(lds + NA_RING + rsl * NA_SLOT + skoff) = sk; *(LAS u32x4*)(lds + NA_RING + rsl * NA_SLOT + svoff) = sv; }
            { const int nr = slot + 2 < nloc ? slot + 2 : nloc - 1; sk = kg[(size_t)(rs0 + nr) * 512]; sv = vg[(size_t)(rs0 + nr) * 512]; }
            const int qz = qi, gz = g;
            const int il = slot - off;
            if (il >= 0 && il < 8) {
                const LAS unsigned char* rb = lds + NA_RING + (slot % 3) * NA_SLOT;
                na_step<true>(st, qrot, rb, rb + 8192, 0u, rpbL + (rs + il - r + 7) * 64, slot == 0, qz, gz, jb);
            } else {
                na_step<false>(st, qraw, lds + NA_CTXK + ic * 4096, lds + NA_CTXV + (ic >> 1) * 8192, (unsigned)(ic & 1) << 6, rpbL, slot == 0, qz, gz, jb);
                ++ic;
            }
            NA_BAR();
        }
#pragma unroll
        for (int j = 0; j < 2; ++j) { float l = st.lsum[j]; l += __shfl_xor(l, 16); l += __shfl_xor(l, 32); const float inv = 1.f / l;
            bf16* op = MIX + (size_t)(tok0 + 16 * (jb + j) + qi) * D + h * NAD + 4 * g;
#pragma unroll
            for (int dt = 0; dt < 4; ++dt) { const f32x4 v = st.o[j][dt] * inv; *(v2u*)(op + 16 * dt) = (v2u){pg8::cvt_pk_bf16(v[0], v[1]), pg8::cvt_pk_bf16(v[2], v[3])}; } }
    }
}

typedef float f32x16 __attribute__((ext_vector_type(16)));
constexpr int SC_Q1 = 0, SC_K1 = SC_Q1 + 64 * 272, SC_K1T = SC_K1 + 64 * 272, SC_VT = SC_K1T + 128 * 144, SC_ST = SC_VT + 128 * 144, SC_TOT = SC_ST + 128 * 272, SC_CST = SC_TOT + 2 * 4 * 128 * 4, SC_END = SC_CST + 2 * 128 * 4;
static_assert(SC_END <= RING_BYTES, "scan LDS");
#define SCAN_MFMA(a, b, c) __builtin_amdgcn_mfma_f32_32x32x16_bf16(a, b, c, 0, 0, 0)
#define SCAN_BAR() do { asm volatile("s_waitcnt lgkmcnt(0)" ::: "memory"); __builtin_amdgcn_s_barrier(); asm volatile("" ::: "memory"); } while (0)
__device__ __forceinline__ void scan_unit(LAS unsigned char* lds, int b, int h, int dir, const unsigned short* LGT, const bf16* HQT, const bf16* HIT, bf16* OUT, int tid) {
    const int lane = tid & 63, w = __builtin_amdgcn_readfirstlane(tid >> 6), r = lane & 31, hh = lane >> 5;
    const int d = tid & 127, tq = tid >> 7;
    const int ti = w >> 2, ovi = w & 3;
    const int di = w >> 1, svi = 2 * (w & 1);
    f32x16 S0, S1;
#pragma unroll
    for (int i = 0; i < 16; ++i) { S0[i] = 0.f; S1[i] = 0.f; }
    const size_t chrow = (size_t)(h * HGD + d);
    constexpr int NCH = (LC + SEQ) / 64;
    auto col_of = [&](int c) -> int { return c < 4 ? (T + b * LC + 64 * (dir ? 3 - c : c)) : (b * SEQ + (dir ? SEQ - 64 * (c - 3) : 64 * (c - 4))); };
    LAS float* totb = (LAS float*)(lds + SC_TOT); LAS float* cst = (LAS float*)(lds + SC_CST);
    u32x4 lg0[2], lg1[2], vr[2], qr[2], vn[2], qn[2];
    { const int c0 = col_of(0) + 16 * tq, c1 = col_of(1) + 16 * tq;
      lg0[0] = *(const u32x4*)(LGT + chrow * MROWS + c0); lg0[1] = *(const u32x4*)(LGT + chrow * MROWS + c0 + 8);
      lg1[0] = *(const u32x4*)(LGT + chrow * MROWS + c1); lg1[1] = *(const u32x4*)(LGT + chrow * MROWS + c1 + 8);
      vr[0] = *(const u32x4*)(HIT + chrow * MROWS + c0); vr[1] = *(const u32x4*)(HIT + chrow * MROWS + c0 + 8); qr[0] = qr[1] = (u32x4){0u, 0u, 0u, 0u};
      vn[0] = *(const u32x4*)(HIT + chrow * MROWS + c1); vn[1] = *(const u32x4*)(HIT + chrow * MROWS + c1 + 8); qn[0] = qn[1] = (u32x4){0u, 0u, 0u, 0u};
      float sm = 0.f;
#pragma unroll
      for (int i = 0; i < 8; ++i) { const unsigned u2 = lg0[i >> 2][i & 3]; sm += h2f((unsigned short)(u2 & 0xffff)) + h2f((unsigned short)(u2 >> 16)); }
      totb[tq * 128 + d] = sm; }
    SCAN_BAR();
#pragma unroll 1
    for (int c = 0; c < NCH; ++c) {
        const bool lat = c >= 4; const int par = c & 1;
        LAS float* tot = totb + par * 512;
        {
            float P[16], kk[16];
#pragma unroll
            for (int i = 0; i < 8; ++i) { const unsigned u2 = lg0[i >> 2][i & 3]; P[2 * i] = h2f((unsigned short)(u2 & 0xffff)); P[2 * i + 1] = h2f((unsigned short)(u2 >> 16)); }
#pragma unroll
            for (int i = 0; i < 16; ++i) kk[i] = 1.f - __builtin_amdgcn_exp2f(P[i]);
            if (!dir) {
#pragma unroll
                for (int i = 1; i < 16; ++i) P[i] += P[i - 1];
            } else {
#pragma unroll
                for (int i = 14; i >= 0; --i) P[i] += P[i + 1];
            }
            const float t0 = tot[d], t1 = tot[128 + d], t2 = tot[256 + d], t3 = tot[384 + d];
            const float Bm = dir ? (t2 + t3) : (t0 + t1);
            float offs; if (!dir) offs = (tq > 0 ? t0 : 0.f) + (tq > 1 ? t1 : 0.f) + (tq > 2 ? t2 : 0.f); else offs = (tq < 3 ? t3 : 0.f) + (tq < 2 ? t2 : 0.f) + (tq < 1 ? t1 : 0.f);
            const float sh = offs - Bm;
            if (tq == 0) { const float be = (t0 + t1) + (t2 + t3); cst[d] = __builtin_amdgcn_exp2f(be); cst[128 + d] = __builtin_amdgcn_exp2f(be - Bm); }
            unsigned kt[8];
            LAS bf16* q1 = (LAS bf16*)(lds + SC_Q1) + (16 * tq) * 136 + d; LAS bf16* k1 = (LAS bf16*)(lds + SC_K1) + (16 * tq) * 136 + d;
#pragma unroll
            for (int i = 0; i < 16; i += 2) {
                const float x0 = fminf(fmaxf(P[i] + sh, -120.f), 120.f), x1 = fminf(fmaxf(P[i + 1] + sh, -120.f), 120.f);
                const float k0 = kk[i] * __builtin_amdgcn_exp2f(-x0), k1v = kk[i + 1] * __builtin_amdgcn_exp2f(-x1);
                kt[i >> 1] = pg8::cvt_pk_bf16(k0, k1v);
                if (lat) { const unsigned qq = (i < 8 ? qr[0] : qr[1])[(i >> 1) & 3];
                    const unsigned qp2 = pg8::cvt_pk_bf16(bflo(qq) * __builtin_amdgcn_exp2f(x0), bfhi(qq) * __builtin_amdgcn_exp2f(x1));
                    q1[i * 136] = (bf16)(qp2 & 0xffff); q1[(i + 1) * 136] = (bf16)(qp2 >> 16);
                    k1[i * 136] = (bf16)(kt[i >> 1] & 0xffff); k1[(i + 1) * 136] = (bf16)(kt[i >> 1] >> 16); }
            }
            LAS unsigned char* k1t = lds + SC_K1T + d * 144 + 32 * tq;
            *(LAS u32x4*)k1t = (u32x4){kt[0], kt[1], kt[2], kt[3]}; *(LAS u32x4*)(k1t + 16) = (u32x4){kt[4], kt[5], kt[6], kt[7]};
            LAS unsigned char* vt = lds + SC_VT + d * 144 + 32 * tq;
            *(LAS u32x4*)vt = vr[0]; *(LAS u32x4*)(vt + 16) = vr[1];
        }
        if (lat) {
#pragma unroll
            for (int rg = 0; rg < 4; ++rg) { const int dd = 32 * di + 8 * rg + 4 * hh;
                const f32x4 a0 = *(const LAS f32x4*)(tot + dd), a1 = *(const LAS f32x4*)(tot + 128 + dd), a2 = *(const LAS f32x4*)(tot + 256 + dd), a3 = *(const LAS f32x4*)(tot + 384 + dd);
                const f32x4 bm = dir ? (a2 + a3) : (a0 + a1); float eb[4];
#pragma unroll
                for (int j = 0; j < 4; ++j) eb[j] = __builtin_amdgcn_exp2f(bm[j]);
                *(LAS v2u*)(lds + SC_ST + ((32 * svi + r) * 136 + dd) * 2) = (v2u){pg8::cvt_pk_bf16(S0[4 * rg] * eb[0], S0[4 * rg + 1] * eb[1]), pg8::cvt_pk_bf16(S0[4 * rg + 2] * eb[2], S0[4 * rg + 3] * eb[3])};
                *(LAS v2u*)(lds + SC_ST + ((32 * (svi + 1) + r) * 136 + dd) * 2) = (v2u){pg8::cvt_pk_bf16(S1[4 * rg] * eb[0], S1[4 * rg + 1] * eb[1]), pg8::cvt_pk_bf16(S1[4 * rg + 2] * eb[2], S1[4 * rg + 3] * eb[3])}; }
        }
        { float sm = 0.f;
#pragma unroll
            for (int i = 0; i < 8; ++i) { const unsigned u2 = lg1[i >> 2][i & 3]; sm += h2f((unsigned short)(u2 & 0xffff)) + h2f((unsigned short)(u2 >> 16)); }
            totb[(par ^ 1) * 512 + tq * 128 + d] = sm;
            lg0[0] = lg1[0]; lg0[1] = lg1[1]; vr[0] = vn[0]; vr[1] = vn[1]; qr[0] = qn[0]; qr[1] = qn[1];
            const int cm = c + 2 < NCH ? c + 2 : NCH - 1, cq = cm < 4 ? 4 : cm;
            const int c2 = col_of(cm) + 16 * tq, c2q = col_of(cq) + 16 * tq;
            vn[0] = *(const u32x4*)(HIT + chrow * MROWS + c2); vn[1] = *(const u32x4*)(HIT + chrow * MROWS + c2 + 8);
            qn[0] = *(const u32x4*)(HQT + chrow * T + c2q); qn[1] = *(const u32x4*)(HQT + chrow * T + c2q + 8);
            lg1[0] = *(const u32x4*)(LGT + chrow * MROWS + c2); lg1[1] = *(const u32x4*)(LGT + chrow * MROWS + c2 + 8); }
        SCAN_BAR();
        f32x16 dS0, dS1, O;
#pragma unroll
        for (int i = 0; i < 16; ++i) { dS0[i] = 0.f; dS1[i] = 0.f; O[i] = 0.f; }
        {
            bf16x8 fa[4], fb0[4], fb1[4];
#pragma unroll
            for (int ks = 0; ks < 4; ++ks) { fa[ks] = *(const LAS bf16x8*)(lds + SC_K1T + ((32 * di + r) * 72 + 16 * ks + 8 * hh) * 2);
                fb0[ks] = *(const LAS bf16x8*)(lds + SC_VT + ((32 * svi + r) * 72 + 16 * ks + 8 * hh) * 2); fb1[ks] = *(const LAS bf16x8*)(lds + SC_VT + ((32 * (svi + 1) + r) * 72 + 16 * ks + 8 * hh) * 2); }
#pragma unroll
            for (int ks = 0; ks < 4; ++ks) { dS0 = SCAN_MFMA(fa[ks], fb0[ks], dS0); dS1 = SCAN_MFMA(fa[ks], fb1[ks], dS1); }
        }
        if (lat) {
            bf16x8 fq[8];
#pragma unroll
            for (int ks = 0; ks < 8; ++ks) fq[ks] = *(const LAS bf16x8*)(lds + SC_Q1 + ((32 * ti + r) * 136 + 16 * ks + 8 * hh) * 2);
            {
                bf16x8 fs[8];
#pragma unroll
                for (int ks = 0; ks < 8; ++ks) fs[ks] = *(const LAS bf16x8*)(lds + SC_ST + ((32 * ovi + r) * 136 + 16 * ks + 8 * hh) * 2);
#pragma unroll
                for (int ks = 0; ks < 8; ++ks) O = SCAN_MFMA(fs[ks], fq[ks], O);
            }
#pragma unroll
            for (int si = 0; si < 2; ++si) {
                const bool live = dir ? (si >= ti) : (si <= ti);
                if (live) {
                    f32x16 At;
#pragma unroll
                    for (int i = 0; i < 16; ++i) At[i] = 0.f;
                    bf16x8 fk[8];
#pragma unroll
                    for (int ks = 0; ks < 8; ++ks) fk[ks] = *(const LAS bf16x8*)(lds + SC_K1 + ((32 * si + r) * 136 + 16 * ks + 8 * hh) * 2);
#pragma unroll
                    for (int ks = 0; ks < 8; ++ks) At = SCAN_MFMA(fk[ks], fq[ks], At);
                    const int tt = 32 * ti + r;
                    if (si == ti) {
#pragma unroll
                        for (int i = 0; i < 16; ++i) { const int ss = 32 * si + (i & 3) + 8 * (i >> 2) + 4 * hh; const bool keep = dir ? (ss >= tt) : (ss <= tt); At[i] = keep ? At[i] : 0.f; }
                    }
#pragma unroll
                    for (int k2 = 0; k2 < 2; ++k2) {
                        u32x4 pw; pw.x = pg8::cvt_pk_bf16(At[8 * k2], At[8 * k2 + 1]); pw.y = pg8::cvt_pk_bf16(At[8 * k2 + 2], At[8 * k2 + 3]); pw.z = pg8::cvt_pk_bf16(At[8 * k2 + 4], At[8 * k2 + 5]); pw.w = pg8::cvt_pk_bf16(At[8 * k2 + 6], At[8 * k2 + 7]);
                        const LAS unsigned char* vp = lds + SC_VT + ((32 * ovi + r) * 72 + 32 * si + 16 * k2 + 4 * hh) * 2;
                        const v2u lo = *(const LAS v2u*)vp, hi2 = *(const LAS v2u*)(vp + 16);
                        O = SCAN_MFMA(__builtin_bit_cast(bf16x8, (u32x4){lo.x, lo.y, hi2.x, hi2.y}), __builtin_bit_cast(bf16x8, pw), O);
                    }
                }
            }
            bf16* op = OUT + (size_t)(col_of(c) + 32 * ti + r) * SEGW + h * HGD + 32 * ovi + 4 * hh;
#pragma unroll
            for (int rg = 0; rg < 4; ++rg) *(v2u*)(op + 8 * rg) = (v2u){pg8::cvt_pk_bf16(O[4 * rg], O[4 * rg + 1]), pg8::cvt_pk_bf16(O[4 * rg + 2], O[4 * rg + 3])};
        }
#pragma unroll
        for (int rg = 0; rg < 4; ++rg) { const int dd = 32 * di + 8 * rg + 4 * hh;
            const f32x4 ee = *(const LAS f32x4*)(cst + dd), em = *(const LAS f32x4*)(cst + 128 + dd);
#pragma unroll
            for (int j = 0; j < 4; ++j) { S0[4 * rg + j] = ee[j] * S0[4 * rg + j] + em[j] * dS0[4 * rg + j]; S1[4 * rg + j] = ee[j] * S1[4 * rg + j] + em[j] * dS1[4 * rg + j]; } }
        SCAN_BAR();
    }
}

#ifdef DBG_NAIVE
__device__ __forceinline__ void scan_naive(LAS unsigned char* lds, int b, int h, int dir, const unsigned short* LGT, const bf16* HQT, const bf16* HIT, bf16* OUT, int tid) {
    const int dv = tid & 127, kg = tid >> 7;
    float St[32];
#pragma unroll
    for (int i = 0; i < 32; ++i) St[i] = 0.f;
    LAS float* sq = (LAS float*)lds; LAS float* sk = sq + 16 * 128; LAS float* sf = sk + 16 * 128; LAS float* sv = sf + 16 * 128; LAS float* so = sv + 16 * 128;
    constexpr int NSTEP = LC + SEQ;
    for (int j0 = 0; j0 < NSTEP; j0 += 16) {
        const bool isctx = j0 < LC;
        for (int idx = tid; idx < 16 * 128; idx += NTHR) { const int st = idx >> 7, ch = idx & 127, j = j0 + st;
            int col; if (j < LC) col = T + b * LC + (dir ? (LC - 1 - j) : j); else col = b * SEQ + (dir ? (SEQ - 1 - (j - LC)) : (j - LC));
            const size_t cr = (size_t)(h * HGD + ch);
            const float f = __builtin_amdgcn_exp2f(h2f(LGT[cr * MROWS + col]));
            sf[st * 128 + ch] = f; sk[st * 128 + ch] = 1.f - f; sv[st * 128 + ch] = bf2f(HIT[cr * MROWS + col]);
            if (!isctx) sq[st * 128 + ch] = bf2f(HQT[cr * T + col]); }
        __syncthreads();
        for (int st = 0; st < 16; ++st) {
            const float vv = sv[st * 128 + dv]; float o = 0.f;
#pragma unroll
            for (int i = 0; i < 32; ++i) { St[i] = sf[st * 128 + kg * 32 + i] * St[i] + sk[st * 128 + kg * 32 + i] * vv; o += St[i] * sq[st * 128 + kg * 32 + i]; }
            so[(st * 4 + kg) * 128 + dv] = o;
        }
        __syncthreads();
        if (!isctx) {
            for (int idx = tid; idx < 16 * 128; idx += NTHR) { const int st = idx >> 7, dd = idx & 127, j = j0 + st;
                const float o = (so[(st * 4 + 0) * 128 + dd] + so[(st * 4 + 1) * 128 + dd]) + (so[(st * 4 + 2) * 128 + dd] + so[(st * 4 + 3) * 128 + dd]);
                const int row = b * SEQ + (dir ? (SEQ - 1 - (j - LC)) : (j - LC));
                OUT[(size_t)row * SEGW + h * HGD + dd] = (bf16)f2bf(o); }
        }
        __syncthreads();
    }
}
#endif

__device__ __forceinline__ void transpose_item(const float* W, int ldw, int k0, int n0, bf16* WT, int ldk, int drow0, LAS float* scr, int lane) {
    f32x4 t[8];
#pragma unroll
    for (int i = 0; i < 8; ++i) t[i] = *(const f32x4*)(W + (size_t)(k0 + 8 * i + (lane >> 3)) * ldw + n0 + (lane & 7) * 4);
#pragma unroll
    for (int i = 0; i < 8; ++i) { LAS float* p = scr + (8 * i + (lane >> 3)) * 33 + (lane & 7) * 4; p[0] = t[i][0]; p[1] = t[i][1]; p[2] = t[i][2]; p[3] = t[i][3]; }
    LDS_WAIT(); asm volatile("" ::: "memory");
    const int c = lane & 7;
#pragma unroll
    for (int j = 0; j < 4; ++j) { const int n = (lane >> 3) + 8 * j; const LAS float* s = scr + (8 * c) * 33 + n;
        v4u o; o.x = pk2(s[0 * 33], s[1 * 33]); o.y = pk2(s[2 * 33], s[3 * 33]); o.z = pk2(s[4 * 33], s[5 * 33]); o.w = pk2(s[6 * 33], s[7 * 33]);
        *(GAS v4u*)(WT + (size_t)(drow0 + n) * ldk + k0 + 8 * c) = o; }
    LDS_WAIT(); asm volatile("" ::: "memory");
}

struct Args { const float* in[21]; float* out; unsigned char* ws; int ph_lo, ph_hi, li, pad; };

__global__ void __launch_bounds__(NTHR, 2) fwd_mega(Args args) {
    extern __shared__ __attribute__((aligned(16))) unsigned char lds_raw[];
    LAS unsigned char* lds = (LAS unsigned char*)lds_raw;
    volatile LAS unsigned* MISC = (volatile LAS unsigned*)(lds + MISC_OFF);
    const int tid = threadIdx.x, lane = tid & 63, wave = __builtin_amdgcn_readfirstlane(tid >> 6);
    const int G = gridDim.x; const int bx = blockIdx.x; const int vcu = (G % 8 == 0) ? (bx % 8) * (G / 8) + bx / 8 : bx;
    gu32* ctl0 = (gu32*)(args.ws + WS_CTL);
    const int gw = vcu * NWAVES + wave, NGW = G * NWAVES;
    for (int u = tid; u < (LDS_BYTES - LDSCTL_OFF) / 4; u += NTHR) ((LAS unsigned*)(lds + LDSCTL_OFF))[u] = 0u;
    __syncthreads();
    XcdBarrier bar = xcd_barrier_post((unsigned*)(ctl0 + CW_BAR) + args.li * XCD_BAR_WORDS, MISC + 8);
    const int lo = args.ph_lo, hi = args.ph_hi;
#ifndef PHMASK
#define PHMASK 0xFFFF
#endif
#define IN(k) (((PHMASK >> (k)) & 1) && lo <= (k) && (k) < hi)
#define SEAM(k) do { if (IN(k) && IN((k) + 1)) xcd_barrier(bar); } while (0)

#define KA(i) ({ const __attribute__((address_space(4))) Args* _p = (const __attribute__((address_space(4))) Args*)__builtin_amdgcn_kernarg_segment_ptr(); asm volatile("" : "+s"(_p)); _p->in[i]; })
#define WSP() ({ const __attribute__((address_space(4))) Args* _p = (const __attribute__((address_space(4))) Args*)__builtin_amdgcn_kernarg_segment_ptr(); asm volatile("" : "+s"(_p)); _p->ws; })
#define PHASE_PTRS unsigned char* ws = WSP(); float* MOD = (float*)(ws + WS_MOD); float* ROPE = (float*)(ws + WS_ROPE); float* LBT = (float*)(ws + WS_LBT); \
    bf16* WinT = (bf16*)(ws + WS_WINT); bf16* WoutT = (bf16*)(ws + WS_WOUTT); bf16* W13T = (bf16*)(ws + WS_W13T); bf16* W2T = (bf16*)(ws + WS_W2T); \
    bf16* XN = (bf16*)(ws + WS_XN); bf16* MIX = (bf16*)(ws + WS_MIX); bf16* XN2 = (bf16*)(ws + WS_XN2); \
    float* X1 = (float*)(ws + WS_X1); bf16* Hb = (bf16*)(ws + WS_H); bf16* Yb = (bf16*)(ws + WS_Y); \
    int* ELIST = (int*)(ws + WS_ELIST); float* EWT = (float*)(ws + WS_EWT); gu32* ctl = (gu32*)(ws + WS_CTL); \
    (void)MOD; (void)ROPE; (void)LBT; (void)WinT; (void)WoutT; (void)W13T; (void)W2T; (void)XN; (void)MIX; (void)XN2; (void)X1; (void)Hb; (void)Yb; (void)ELIST; (void)EWT; (void)ctl;
    if (IN(0)) {
        PHASE_PTRS
        const float* cvec = KA(1); const float* c_ctx = KA(3); const float* w_mod = KA(4); const float* b_mod = KA(5); const float* w_in = KA(8); const float* w_out = KA(9);
        const float* hg_lb = KA(11); const float* w1 = KA(17); const float* w3 = KA(18); const float* w2 = KA(19);
        if (bx == G - 1) {
            for (int idx = tid; idx < 1024; idx += NTHR) { const int pos = idx >> 4, i = idx & 15;
                double th = 1.0; for (int k = 0; k < i; ++k) th *= 0.5623413251903491;
                const double t2 = th * th; double c = 1.0, s = th, tc = 1.0, ts = th;
                for (int n = 1; n <= 12; ++n) { tc *= -t2 / (double)((2 * n - 1) * (2 * n)); c += tc; ts *= -t2 / (double)((2 * n) * (2 * n + 1)); s += ts; }
                double cr = 1.0, ci = 0.0; for (int p = 0; p < pos; ++p) { const double nr = cr * c - ci * s; ci = cr * s + ci * c; cr = nr; }
                ROPE[idx * 2] = (float)cr; ROPE[idx * 2 + 1] = (float)ci; }
            for (int idx = tid; idx < 1024; idx += NTHR) { const float h0 = hg_lb[idx], h1 = hg_lb[1024 + idx]; LBT[idx] = 1.f / (1.f + expf(h1 - h0)); }
        }
        if (bx < 96) {
            LAS float* sc = (LAS float*)lds;
            for (int idx = tid; idx < 17 * 1024; idx += NTHR) { const int r = idx >> 10, k = idx & 1023; const float cv = r < 16 ? cvec[r * 1024 + k] : c_ctx[k]; sc[idx] = cv / (1.f + expf(-cv)); }
            __syncthreads();
            const int col = 64 * bx + lane, k0 = 128 * wave;
            float acc[17];
#pragma unroll
            for (int r = 0; r < 17; ++r) acc[r] = 0.f;
            for (int kk = 0; kk < 128; kk += 4) {
                const float w0 = w_mod[(size_t)(k0 + kk) * 6144 + col], w1v = w_mod[(size_t)(k0 + kk + 1) * 6144 + col], w2v = w_mod[(size_t)(k0 + kk + 2) * 6144 + col], w3v = w_mod[(size_t)(k0 + kk + 3) * 6144 + col];
#pragma unroll
                for (int r = 0; r < 17; ++r) { const f32x4 a = *(const LAS f32x4*)(sc + r * 1024 + k0 + kk); acc[r] += a[0] * w0 + a[1] * w1v + a[2] * w2v + a[3] * w3v; }
            }
            LAS float* red = (LAS float*)(lds + 17 * 1024 * 4);
#pragma unroll
            for (int r = 0; r < 17; ++r) red[(wave * 17 + r) * 64 + lane] = acc[r];
            __syncthreads();
            for (int idx = tid; idx < 17 * 64; idx += NTHR) { const int r = idx >> 6, l = idx & 63; float s = 0.f;
#pragma unroll
                for (int w = 0; w < 8; ++w) s += red[(w * 17 + r) * 64 + l];
                MOD[r * 6144 + 64 * bx + l] = s + b_mod[64 * bx + l]; }
            __syncthreads();
        }
        {
            LAS float* scr = (LAS float*)(lds + wave * 16384);
            constexpr int I_IN = 16 * 128, I_OUT = 16 * 32, I_13 = 16 * 2 * 256, I_2 = 16 * 256, NIT = I_IN + I_OUT + I_13 + I_2;
            for (int it = gw; it < NIT; it += NGW) {
                int r = it;
                if (r < I_IN) { const int kb = r / 128, nb = r % 128; transpose_item(w_in, INCOLS, 64 * kb, 32 * nb, WinT, 1024, 32 * nb, scr, lane); continue; } r -= I_IN;
                if (r < I_OUT) { const int kb = r / 32, nb = r % 32; transpose_item(w_out, 1024, 64 * kb, 32 * nb, WoutT, 1024, 32 * nb, scr, lane); continue; } r -= I_OUT;
                if (r < I_13) { const int e = r / 512, rem = r % 512, s = rem / 256, r2 = rem % 256, kb = r2 / 16, nb = r2 % 16, n0 = 32 * nb;
                    transpose_item((s ? w3 : w1) + (size_t)e * 1024 * 512, 512, 64 * kb, n0, W13T, 1024, e * 1024 + 256 * (n0 / 128) + 128 * s + (n0 % 128), scr, lane); continue; } r -= I_13;
                { const int e = r / 256, r2 = r % 256, kb = r2 / 32, nb = r2 % 32; transpose_item(w2 + (size_t)e * 512 * 1024, 1024, 64 * kb, 32 * nb, W2T, 512, e * 1024 + 32 * nb, scr, lane); }
            }
        }
    }
    SEAM(0);

    if (IN(1)) {
        PHASE_PTRS
        const float* x = KA(0); const float* ctx = KA(2); const float* norm_mix = KA(6);
        for (int row = gw; row < MROWS; row += NGW) {
            const float* xr = row < T ? x + (size_t)row * D : ctx + (size_t)(row - T) * D; const int mb = row < T ? (row >> 11) : 16;
            f32x4 v[4]; float s = 0.f;
#pragma unroll
            for (int j = 0; j < 4; ++j) { v[j] = *(const f32x4*)(xr + 4 * lane + 256 * j); s += (v[j][0] * v[j][0] + v[j][1] * v[j][1]) + (v[j][2] * v[j][2] + v[j][3] * v[j][3]); }
            const float rstd = 1.f / sqrtf(wave_sum(s) * (1.f / D) + EPS);
#pragma unroll
            for (int j = 0; j < 4; ++j) { const int col = 4 * lane + 256 * j; const f32x4 g = *(const f32x4*)(norm_mix + col), sh = *(const f32x4*)(MOD + mb * 6144 + col), sc = *(const f32x4*)(MOD + mb * 6144 + 1024 + col);
                const f32x4 y = v[j] * rstd * g * (1.f + sc) + sh;
                *(v2u*)(XN + (size_t)row * D + col) = (v2u){pk2(y[0], y[1]), pk2(y[2], y[3])}; }
        }
    }
    SEAM(1);

    if (IN(2)) {
        PHASE_PTRS
        ProjOrder S; S.init(G, bx);
        LAS float* ropeL = (LAS float*)(lds + TAB_OFF); LAS float* lbtL = ropeL + 2048;
        for (int i = tid; i < 2048 + 1024; i += NTHR) ropeL[i] = i < 2048 ? ROPE[i] : LBT[i - 2048];
        __syncthreads();
        EpiProj E{ws, ropeL, lbtL, 0};
        pg8::gemm_phase<EpiProj, ProjOrder>(lds + RING_OFF, XN, WinT, D, S, E);
    }
    SEAM(2);

    if (IN(3)) {
        PHASE_PTRS
        const bf16* Qb = (const bf16*)(ws + WS_Q); const bf16* Kb = (const bf16*)(ws + WS_K); const bf16* Vb = (const bf16*)(ws + WS_V);
        const float* na_rpb = KA(10);
        const int subph = ({ const __attribute__((address_space(4))) Args* _p = (const __attribute__((address_space(4))) Args*)__builtin_amdgcn_kernarg_segment_ptr(); asm volatile("" : "+s"(_p)); _p->pad; });
#ifndef NO_SCAN
        if (bx < 128) {
            const int dir = bx & 1;
#ifdef DBG_NAIVE
            if (DBG_NAIVE & (1 << dir)) scan_naive(lds, bx >> 3, (bx >> 1) & 3, dir, (const unsigned short*)(ws + (dir ? WS_LB : WS_LF)), (const bf16*)(ws + WS_HQ), (const bf16*)(ws + WS_HI), (bf16*)(ws + (dir ? WS_OB : WS_OF)), tid);
            else
#endif
            if (subph != 2) scan_unit(lds, bx >> 3, (bx >> 1) & 3, dir, (const unsigned short*)(ws + (dir ? WS_LB : WS_LF)), (const bf16*)(ws + WS_HQ), (const bf16*)(ws + WS_HI), (bf16*)(ws + (dir ? WS_OB : WS_OF)), tid);
        } else
#endif
        {
            const int hx = bx & 7, bb = (bx - 128) >> 3;
            LAS float* rpbL = (LAS float*)(lds + TAB_OFF);
            for (int t2 = tid; t2 < 15 * 64; t2 += NTHR) { const int co = (t2 & 63) - 16, ro = t2 >> 6; rpbL[t2] = (co >= 0 && co < 31) ? na_rpb[(hx * 15 + ro) * 31 + co] * 1.44269504f : 0.f; }
            if (subph != 1) na_wg(lds, bb, hx, Qb, (const bf16*)(ws + WS_QR), Kb, Vb, MIX, rpbL, tid);
        }
    }
    SEAM(3);

    if (IN(4)) {
        PHASE_PTRS
        const float* hg_norm = KA(12);
        const bf16* OF = (const bf16*)(ws + WS_OF); const bf16* OB = (const bf16*)(ws + WS_OB); const bf16* Gb = (const bf16*)(ws + WS_G);
        for (int tok = gw; tok < T; tok += NGW) {
            const size_t off = (size_t)tok * SEGW + lane * 8;
            const v4u a = *(const v4u*)(OF + off), bb = *(const v4u*)(OB + off), g = *(const v4u*)(Gb + off);
            float o[8]; float ss = 0.f;
#pragma unroll
            for (int e = 0; e < 4; ++e) { o[2 * e] = bflo(a[e]) + bflo(bb[e]); o[2 * e + 1] = bfhi(a[e]) + bfhi(bb[e]);
#ifdef DBG_SANITIZE
                if (!(fabsf(o[2 * e]) < 1e30f)) o[2 * e] = 0.f; if (!(fabsf(o[2 * e + 1]) < 1e30f)) o[2 * e + 1] = 0.f;
#endif
                ss += o[2 * e] * o[2 * e] + o[2 * e + 1] * o[2 * e + 1]; }
            ss += __shfl_xor(ss, 1); ss += __shfl_xor(ss, 2); ss += __shfl_xor(ss, 4); ss += __shfl_xor(ss, 8);
            const float rstd = 1.f / sqrtf(ss * (1.f / HGD) + EPS);
            const int dv0 = (lane & 15) * 8;
            const f32x4 g0 = *(const f32x4*)(hg_norm + dv0), g1 = *(const f32x4*)(hg_norm + dv0 + 4);
            const float gg[8] = {g0[0], g0[1], g0[2], g0[3], g1[0], g1[1], g1[2], g1[3]};
            float y[8];
#pragma unroll
            for (int e = 0; e < 4; ++e) { y[2 * e] = o[2 * e] * rstd * gg[2 * e] * bflo(g[e]); y[2 * e + 1] = o[2 * e + 1] * rstd * gg[2 * e + 1] * bfhi(g[e]); }
            *(v4u*)(MIX + (size_t)tok * D + 512 + lane * 8) = (v4u){pk2(y[0], y[1]), pk2(y[2], y[3]), pk2(y[4], y[5]), pk2(y[6], y[7])};
        }
    }
    SEAM(4);

    if (IN(5)) {
        PHASE_PTRS
        pg8::DenseOrder S; S.init(T, D, G, bx, true);
        EpiP E{(bf16*)X1};
        pg8::gemm_phase<EpiP, pg8::DenseOrder>(lds + RING_OFF, MIX, WoutT, D, S, E);
    }
    SEAM(5);

    if (IN(6)) {
        PHASE_PTRS
        const float* norm_ffn = KA(7); const float* w_grp = KA(13); const float* b_grp = KA(14); const float* w_exp = KA(15); const float* b_exp = KA(16);
        LAS f32x4* wl = (LAS f32x4*)lds;
        for (int idx = tid; idx < 5 * 1024; idx += NTHR) { const int quad = idx >> 10, col = idx & 1023; const int l = (col & 255) >> 2, q = col & 3, j = col >> 8;
            const f32x4 w = quad == 0 ? *(const f32x4*)(w_grp + col * 4) : *(const f32x4*)(w_exp + col * 16 + (quad - 1) * 4);
            wl[((quad * 4 + q) * 4 + j) * 64 + l] = w; }
        LAS int* lcnt = (LAS int*)(lds + 81920);
        LAS int* tmpe = (LAS int*)(lds + 81920 + 256);
        LAS float* rsc = (LAS float*)(lds + 86016);
        if (tid < 32) lcnt[tid] = 0;
        __syncthreads();
        const int rowbase = bx * 128 + wave * 16;
        const int mb = rowbase >> 11;
        f32x4 gsc[4], shv[4], gaa[4];
        const float* xin = KA(0); const bf16* Pb = (const bf16*)X1;
#pragma unroll
        for (int j = 0; j < 4; ++j) { const int col = 4 * lane + 256 * j; const f32x4 g = *(const f32x4*)(norm_ffn + col), sc = *(const f32x4*)(MOD + mb * 6144 + 4096 + col);
            gsc[j] = g * (1.f + sc); shv[j] = *(const f32x4*)(MOD + mb * 6144 + 3072 + col); gaa[j] = *(const f32x4*)(MOD + mb * 6144 + 2048 + col); }
        f32x4 vn[2][4]; v2u pn[2][4];
#pragma unroll
        for (int rr = 0; rr < 2; ++rr)
#pragma unroll
            for (int j = 0; j < 4; ++j) { const size_t o_ = (size_t)(rowbase + rr) * D + 4 * lane + 256 * j; vn[rr][j] = *(const f32x4*)(xin + o_); pn[rr][j] = *(const v2u*)(Pb + o_); }
#pragma unroll 1
        for (int ip = 0; ip < 8; ++ip) {
            asm volatile("" ::: "memory");
            f32x4 v[2][4];
#pragma unroll
            for (int rr = 0; rr < 2; ++rr)
#pragma unroll
                for (int j = 0; j < 4; ++j) v[rr][j] = vn[rr][j] + gaa[j] * (f32x4){bflo(pn[rr][j].x), bfhi(pn[rr][j].x), bflo(pn[rr][j].y), bfhi(pn[rr][j].y)};
            if (ip < 7) {
#pragma unroll
                for (int rr = 0; rr < 2; ++rr)
#pragma unroll
                    for (int j = 0; j < 4; ++j) { const size_t o_ = (size_t)(rowbase + 2 * ip + 2 + rr) * D + 4 * lane + 256 * j; vn[rr][j] = *(const f32x4*)(xin + o_); pn[rr][j] = *(const v2u*)(Pb + o_); } }
            float ss[2];
#pragma unroll
            for (int rr = 0; rr < 2; ++rr) { float s = 0.f;
#pragma unroll
                for (int j = 0; j < 4; ++j) s += (v[rr][j][0] * v[rr][j][0] + v[rr][j][1] * v[rr][j][1]) + (v[rr][j][2] * v[rr][j][2] + v[rr][j][3] * v[rr][j][3]);
                ss[rr] = s; }
#pragma unroll
            for (int o = 1; o < 64; o <<= 1) { ss[0] += __shfl_xor(ss[0], o); ss[1] += __shfl_xor(ss[1], o); }
            const float rstd0 = 1.f / sqrtf(ss[0] * (1.f / D) + EPS), rstd1 = 1.f / sqrtf(ss[1] * (1.f / D) + EPS);
            float lg[2][20];
#pragma unroll
            for (int k = 0; k < 20; ++k) { lg[0][k] = 0.f; lg[1][k] = 0.f; }
#pragma unroll
            for (int j = 0; j < 4; ++j) { const int col = 4 * lane + 256 * j;
                const f32x4 y0 = v[0][j] * rstd0 * gsc[j] + shv[j], y1 = v[1][j] * rstd1 * gsc[j] + shv[j];
                *(v2u*)(XN2 + (size_t)(rowbase + 2 * ip) * D + col) = (v2u){pg8::cvt_pk_bf16(y0[0], y0[1]), pg8::cvt_pk_bf16(y0[2], y0[3])};
                *(v2u*)(XN2 + (size_t)(rowbase + 2 * ip + 1) * D + col) = (v2u){pg8::cvt_pk_bf16(y1[0], y1[1]), pg8::cvt_pk_bf16(y1[2], y1[3])};
#pragma unroll
                for (int q = 0; q < 4; ++q)
#pragma unroll
                    for (int quad = 0; quad < 5; ++quad) { const f32x4 w = wl[((quad * 4 + q) * 4 + j) * 64 + lane];
#pragma unroll
                        for (int c = 0; c < 4; ++c) { lg[0][quad * 4 + c] += y0[q] * w[c]; lg[1][quad * 4 + c] += y1[q] * w[c]; } }
                asm volatile("" ::: "memory"); }
            {
                float rv[64];
#pragma unroll
                for (int k = 0; k < 64; ++k) rv[k] = k < 40 ? lg[k / 20][k % 20] : 0.f;
#pragma unroll
                for (int hb = 32; hb >= 1; hb >>= 1) { const bool hi_ = (lane & hb) != 0;
#pragma unroll
                    for (int i = 0; i < hb; ++i) { const float keep = hi_ ? rv[i + hb] : rv[i], send = hi_ ? rv[i] : rv[i + hb]; rv[i] = keep + __shfl_xor(send, hb); } }
                rsc[wave * 64 + lane] = rv[0];
            }
            if (lane < 2) {
                const int rr = lane; const LAS float* lgr = rsc + wave * 64 + rr * 20;
                {
                    float gl[4];
#pragma unroll
                    for (int k = 0; k < 4; ++k) gl[k] = lgr[k] + b_grp[k];
                    int gs = 0; float gm = gl[0];
#pragma unroll
                    for (int k = 1; k < 4; ++k) if (gl[k] > gm) { gm = gl[k]; gs = k; }
                    float den = 0.f;
#pragma unroll
                    for (int k = 0; k < 4; ++k) den += __expf(gl[k] - gm);
                    const float g_w = 1.f / den;
                    float ev[4];
#pragma unroll
                    for (int k = 0; k < 4; ++k) ev[k] = lgr[4 + gs * 4 + k] + b_exp[gs * 4 + k];
                    int i0 = 0; float v0 = ev[0];
#pragma unroll
                    for (int k = 1; k < 4; ++k) if (ev[k] > v0) { v0 = ev[k]; i0 = k; }
                    int i1 = -1; float v1 = -INFINITY;
#pragma unroll
                    for (int k = 0; k < 4; ++k) if (k != i0 && ev[k] > v1) { v1 = ev[k]; i1 = k; }
                    if (i1 < 0) { i1 = (i0 + 1) & 3; v1 = v0; }
                    const float e1 = __expf(v1 - v0); const float w0 = g_w / (1.f + e1), w1w = g_w * e1 / (1.f + e1);
                    const int ea = gs * 4 + i0, eb = gs * 4 + i1;
                    const int ra = __hip_atomic_fetch_add(&lcnt[ea], 1, __ATOMIC_RELAXED, __HIP_MEMORY_SCOPE_WORKGROUP), rb = __hip_atomic_fetch_add(&lcnt[eb], 1, __ATOMIC_RELAXED, __HIP_MEMORY_SCOPE_WORKGROUP);
                    const int lr = (wave * 16 + 2 * ip + rr) * 2;
                    tmpe[lr] = ea; tmpe[256 + lr] = ra; tmpe[512 + lr] = __builtin_bit_cast(int, w0);
                    tmpe[lr + 1] = eb; tmpe[256 + lr + 1] = rb; tmpe[512 + lr + 1] = __builtin_bit_cast(int, w1w);
                }
            }
        }
        __syncthreads();
        if (tid < 16) lcnt[16 + tid] = (int)__hip_atomic_fetch_add(ctl + CW_CNT + tid, (unsigned)lcnt[tid], RLX_AGENT);
        __syncthreads();
        if (tid < 256) { const int e = tmpe[tid], pos = lcnt[16 + e] + tmpe[256 + tid]; const int tok = bx * 128 + (tid >> 1);
            ELIST[e * ECAP + pos] = tok * 2 + (tid & 1); EWT[e * ECAP + pos] = __builtin_bit_cast(float, tmpe[512 + tid]); }
        __syncthreads();
    }
    SEAM(6);

    if (IN(7) || IN(8)) {
        PHASE_PTRS
        LAS int* tp = (LAS int*)(lds + MOE_OFF);
        if (tid == 0) { int acc = 0;
            for (int e = 0; e < 16; ++e) { const int c = (int)__hip_atomic_load(ctl + CW_CNT + e, RLX_AGENT); tp[e] = acc; tp[17 + e] = c; acc += (c + 255) >> 8; }
            tp[16] = acc; }
        __syncthreads();
    }
    if (IN(7)) {
        PHASE_PTRS
        const LAS int* tp = (const LAS int*)(lds + MOE_OFF);
        const int nu = tp[16] * 4; const bool merged = IN(8);
        gu32* tc = merged ? (gu32*)(ctl + CW_TILE) : (gu32*)nullptr;
        { MoeOrder<true> S{tp, ELIST, G, bx, nu, (gu32*)nullptr};
          EpiSwiGLU E{Hb, tc};
          pg8::gemm_phase<EpiSwiGLU, MoeOrder<true>>(lds + RING_OFF, XN2, W13T, D, S, E); }
        if (merged) { int cs = bx + (nu % G); cs = cs >= G ? cs - G : cs;
          MoeOrder<false> S{tp, ELIST, G, cs, nu, tc};
          EpiMoeOut E{Yb, ELIST, EWT};
          pg8::gemm_phase<EpiMoeOut, MoeOrder<false>>(lds + RING_OFF, Hb, W2T, DE, S, E); }
    }
    if (IN(8) && !IN(7)) {
        PHASE_PTRS
        const LAS int* tp = (const LAS int*)(lds + MOE_OFF);
        MoeOrder<false> S{tp, ELIST, G, bx, tp[16] * 4, (gu32*)nullptr};
        EpiMoeOut E{Yb, ELIST, EWT};
        pg8::gemm_phase<EpiMoeOut, MoeOrder<false>>(lds + RING_OFF, Hb, W2T, DE, S, E);
    }
    SEAM(8);

    if (IN(9)) {
        PHASE_PTRS
        const float* norm_final = KA(20); const float* xfin = KA(0); float* outp = ({ const __attribute__((address_space(4))) Args* _p = (const __attribute__((address_space(4))) Args*)__builtin_amdgcn_kernarg_segment_ptr(); asm volatile("" : "+s"(_p)); _p->out; });
        for (int row = gw; row < T; row += NGW) {
            const int mb = row >> 11; f32x4 v[4]; float s = 0.f;
#pragma unroll
            for (int j = 0; j < 4; ++j) { const int col = 4 * lane + 256 * j; const v2u pp = *(const v2u*)((const bf16*)X1 + (size_t)row * D + col);
                const f32x4 xv = *(const f32x4*)(xfin + (size_t)row * D + col) + *(const f32x4*)(MOD + mb * 6144 + 2048 + col) * (f32x4){bflo(pp.x), bfhi(pp.x), bflo(pp.y), bfhi(pp.y)}, ga = *(const f32x4*)(MOD + mb * 6144 + 5120 + col);
                const v2u y0 = *(const v2u*)(Yb + (size_t)(2 * row) * D + col), y1 = *(const v2u*)(Yb + (size_t)(2 * row + 1) * D + col);
                const f32x4 ys = (f32x4){bflo(y0.x) + bflo(y1.x), bfhi(y0.x) + bfhi(y1.x), bflo(y0.y) + bflo(y1.y), bfhi(y0.y) + bfhi(y1.y)};
                v[j] = xv + ga * ys; s += (v[j][0] * v[j][0] + v[j][1] * v[j][1]) + (v[j][2] * v[j][2] + v[j][3] * v[j][3]); }
            const float rstd = 1.f / sqrtf(wave_sum(s) * (1.f / D) + EPS);
#pragma unroll
            for (int j = 0; j < 4; ++j) { const int col = 4 * lane + 256 * j; const f32x4 g = *(const f32x4*)(norm_final + col);
                *(f32x4*)(outp + (size_t)row * D + col) = v[j] * rstd * g; }
        }
    }
#undef IN
#undef SEAM
}

#ifndef MK_N_LAUNCHES
#define MK_N_LAUNCHES 1
#endif
constexpr int NPHASE = 10;
extern "C" void kernel_launch(void* const* d_in, const int* in_sizes, int n_in, void* d_out, int out_size, void* d_ws, size_t ws_size, hipStream_t stream) {
    static int grid = 0;
    if (grid == 0) {
        if (n_in != 21 || in_sizes[0] != T * D || out_size != T * D || ws_size < WS_END) { fprintf(stderr, "kernel_launch: unexpected shapes (n_in %d, in0 %d, out %d, ws %zu)\n", n_in, n_in > 0 ? in_sizes[0] : -1, out_size, ws_size); grid = -1; return; }
        int dev = 0, cus = 0, per_cu = 0;
        if (hipGetDevice(&dev) != hipSuccess || hipDeviceGetAttribute(&cus, hipDeviceAttributeMultiprocessorCount, dev) != hipSuccess) { grid = -1; return; }
        if (hipFuncSetAttribute((const void*)fwd_mega, hipFuncAttributeMaxDynamicSharedMemorySize, LDS_BYTES) != hipSuccess) { fprintf(stderr, "kernel_launch: hipFuncSetAttribute failed\n"); grid = -1; return; }
        if (hipOccupancyMaxActiveBlocksPerMultiprocessor(&per_cu, (const void*)fwd_mega, NTHR, LDS_BYTES) != hipSuccess || per_cu < 1) fprintf(stderr, "kernel_launch: occupancy query reports %d\n", per_cu);
        (void)hipGetLastError();
        grid = cus;
        if (grid != 256) fprintf(stderr, "kernel_launch: %d CUs (built for 256)\n", grid);
    }
    if (grid < 0) return;
    (void)hipMemsetAsync((char*)d_ws + WS_CTL, 0, CTL_ZERO_BYTES, stream);
    Args a{};
    for (int i = 0; i < 21; ++i) a.in[i] = (const float*)d_in[i];
    a.out = (float*)d_out; a.ws = (unsigned char*)d_ws;
    if (MK_N_LAUNCHES == 1) {
        a.ph_lo = 0; a.ph_hi = NPHASE; a.li = 0;
        hipLaunchKernelGGL(fwd_mega, dim3(grid), dim3(NTHR), LDS_BYTES, stream, a);
    } else {
        for (int li = 0; li < NPHASE; ++li) { a.ph_lo = li; a.ph_hi = li + 1; a.li = 0; hipLaunchKernelGGL(fwd_mega, dim3(grid), dim3(NTHR), LDS_BYTES, stream, a);
#ifdef PROBE_DUP
            if (li == PROBE_DUP) {
#ifdef PROBE_SUB
                a.pad = PROBE_SUB;
#endif
                hipLaunchKernelGGL(fwd_mega, dim3(grid), dim3(NTHR), LDS_BYTES, stream, a); a.pad = 0; }
#endif
        }
    }
}
```

```cpp
#include <hip/hip_runtime.h>
#include <cstdio>
#include <cstdint>

#define GAS __attribute__((address_space(1)))
#define LAS __attribute__((address_space(3)))
typedef unsigned short bf16;
typedef unsigned short bf16_t;
typedef unsigned v4u __attribute__((ext_vector_type(4)));
typedef unsigned v2u __attribute__((ext_vector_type(2)));
typedef float f32x4 __attribute__((ext_vector_type(4)));
typedef float f32x2 __attribute__((ext_vector_type(2)));
typedef short bf16x8 __attribute__((ext_vector_type(8)));
typedef unsigned u32x4 __attribute__((ext_vector_type(4)));
typedef GAS unsigned gu32;
typedef unsigned bu4v __attribute__((__vector_size__(16)));
#define RLX_AGENT __ATOMIC_RELAXED, __HIP_MEMORY_SCOPE_AGENT
#define LDS_WAIT() asm volatile("s_waitcnt lgkmcnt(0)" ::: "memory")
#define VM_WAIT() asm volatile("s_waitcnt vmcnt(0)" ::: "memory")

constexpr int NB = 16, SEQ = 2048, D = 1024, T = NB * SEQ, LC = 256, TC = NB * LC, MROWS = T + TC;
constexpr int GW = 64, NROWS = SEQ / GW;
constexpr int INCOLS = 4096, SEGW = 512;
constexpr int NAH = 8, NAD = 64, HGH = 4, HGD = 128;
constexpr int KTOK = SEQ + LC;
constexpr int NE = 16, DE = 512, ECAP = T;
constexpr float EPS = 1e-6f;
constexpr int NWAVES = 8, NTHR = 512;

constexpr size_t MiB = 1u << 20;
constexpr size_t WS_CTL = 0, CTL_ZERO_BYTES = 32768;
constexpr size_t WS_MOD = 1 * MiB;
constexpr size_t WS_ROPE = WS_MOD + 512 * 1024, WS_LBT = WS_MOD + 520 * 1024;
constexpr size_t WS_ELIST = 2 * MiB, WS_EWT = 4 * MiB;
constexpr size_t WS_WINT = 8 * MiB, WS_WOUTT = 16 * MiB, WS_W13T = 18 * MiB, WS_W2T = 50 * MiB;
constexpr size_t WS_XN = 66 * MiB;
constexpr size_t WS_Q = 138 * MiB, WS_K = 170 * MiB, WS_V = 206 * MiB, WS_HQ = 242 * MiB, WS_HI = 274 * MiB, WS_LF = 310 * MiB, WS_LB = 346 * MiB, WS_G = 382 * MiB;
constexpr size_t WS_OF = 414 * MiB, WS_OB = 446 * MiB, WS_QR = 478 * MiB, WS_END = 510 * MiB;
constexpr size_t WS_MIX = WS_XN, WS_XN2 = WS_XN, WS_X1 = 138 * MiB, WS_H = 274 * MiB, WS_Y = 346 * MiB;
constexpr int CW_CNT = 64;
constexpr int CW_TILE = 512;
constexpr int CW_BAR = 4096;
static_assert((CW_BAR + 3456) * 4 <= (int)CTL_ZERO_BYTES, "barrier words inside the per-call memset");

constexpr int RING_OFF = 0, RING_BYTES = 131072;
constexpr int LDSCTL_OFF = RING_BYTES, MISC_OFF = LDSCTL_OFF + 320, MOE_OFF = LDSCTL_OFF + 1024;
constexpr int TAB_OFF = LDSCTL_OFF + 2048;
constexpr int LDS_BYTES = 147456;

__device__ __forceinline__ unsigned f2bf(float f) { unsigned u = __builtin_bit_cast(unsigned, f); return (u + 0x7fffu + ((u >> 16) & 1u)) >> 16; }
__device__ __forceinline__ unsigned pk2(float lo, float hi) { return f2bf(lo) | (f2bf(hi) << 16); }
__device__ __forceinline__ float bf2f(unsigned short b) { return __builtin_bit_cast(float, (unsigned)b << 16); }
__device__ __forceinline__ float bflo(unsigned u) { return __builtin_bit_cast(float, u << 16); }
__device__ __forceinline__ float bfhi(unsigned u) { return __builtin_bit_cast(float, u & 0xffff0000u); }
__device__ __forceinline__ unsigned pkh2(float lo, float hi) { _Float16 a = (_Float16)lo, b = (_Float16)hi; return (unsigned)__builtin_bit_cast(unsigned short, a) | ((unsigned)__builtin_bit_cast(unsigned short, b) << 16); }
__device__ __forceinline__ float h2f(unsigned short h) { return (float)__builtin_bit_cast(_Float16, h); }
__device__ __forceinline__ float silu_f(float v) { return v * __builtin_amdgcn_rcpf(1.f + __expf(-v)); }
__device__ __forceinline__ float wave_sum(float v) {
#pragma unroll
    for (int o = 1; o < 64; o <<= 1) v += __shfl_xor(v, o);
    return v;
}
__device__ __forceinline__ float wave_max(float v) {
#pragma unroll
    for (int o = 1; o < 64; o <<= 1) v = fmaxf(v, __shfl_xor(v, o));
    return v;
}

namespace pg8 {
constexpr int BM = 256, BK = 64, HALF = 128, HTB = HALF * BK * 2, STAGE_BYTES = 8 * HTB, NXCD = 8, WGM = 8;
__host__ __device__ __forceinline__ int lds_byte(int r, int c) { const int st = (r >> 4) * 2 + (c >> 5), rr = r & 15, cc = c & 31, ob = rr * 64 + cc * 2; return st * 1024 + (ob ^ (((ob >> 9) & 1) << 5)); }
__host__ __device__ __forceinline__ void stage_rc(int b, int& R, int& C) { const int st = b / 1024, sb = b % 1024, swz = sb ^ (((sb >> 9) & 1) << 5); R = (st >> 1) * 16 + swz / 64; C = (st & 1) * 32 + (swz % 64) / 2; }
__host__ __device__ __forceinline__ int perm32(int rho) { const int n = rho >> 4, i = rho & 15; return 8 * (i >> 2) + 4 * n + (i & 3); }

struct Unit { int pm, pn, e, tm, cnt; };

typedef float f32x2_t __attribute__((ext_vector_type(2))); typedef __bf16 bf16x2_t __attribute__((ext_vector_type(2)));
__device__ __forceinline__ unsigned cvt_pk_bf16(float lo, float hi) { f32x2_t v = {lo, hi}; bf16x2_t b = __builtin_convertvector(v, bf16x2_t); return __builtin_bit_cast(unsigned, b); }

struct DenseOrder {
    static constexpr bool GATHER = false;
    int nM, nN, nwg, G, c; bool pf;
    __device__ void init(int M, int N, int G_, int c_, bool pf_ = false) { nM = M / BM; nN = N / BM; nwg = nM * nN; G = G_; c = c_; pf = pf_; }
    __device__ bool next(int i, Unit& u) const {
        const long L = (long)i * G + c; if (L >= nwg) return false;
        int wgid = (int)L; { const int q = nwg / NXCD, r = nwg % NXCD, xcd = wgid % NXCD, off = wgid / NXCD; wgid = (xcd < r ? xcd * (q + 1) : r * (q + 1) + (xcd - r) * q) + off; }
        const int nig = WGM * nN, gid = wgid / nig, fm = gid * WGM, gsz = (nM - fm) < WGM ? (nM - fm) : WGM;
        u.pm = fm + ((wgid % nig) % gsz); u.pn = (wgid % nig) / gsz; u.e = 0; u.tm = 0; u.cnt = 0; return true;
    }
    __device__ __forceinline__ int a_row0(const Unit& u) const { return u.pm * BM; }
    __device__ __forceinline__ int a_row(const Unit& u, int r) const { return u.pm * BM + r; }
    __device__ __forceinline__ int b_row0(const Unit& u) const { return u.pn * BM; }
    __device__ __forceinline__ bool perm(const Unit&) const { return pf; }
    __device__ __forceinline__ void a_ready(const Unit&, int) const {}
};

template <class Epi, class Sched>
__device__ __forceinline__ void gemm_phase(LAS unsigned char* lds, const bf16_t* Aptr, const bf16_t* Btptr, const int K, const Sched& S, const Epi& E) {
    const int tid = threadIdx.x, wid = __builtin_amdgcn_readfirstlane(tid >> 6), lane = tid & 63, wr = wid >> 2, wc = wid & 3, fr = lane & 15, fq = lane >> 4;
    const int nt = K / BK;
    int sR[2], sC[2];
    unsigned voffA[2], voffBn[2], voffBp[2], voffB[2], nvB[2];
#pragma unroll
    for (int i = 0; i < 2; ++i) { int R, C; stage_rc(tid * 16 + i * 8192, R, C); const int Rb = (R & ~31) + perm32(R & 31);
        sR[i] = R; sC[i] = C; voffA[i] = (unsigned)(R * K + C) * 2u; voffBn[i] = (unsigned)(R * K + C) * 2u; voffBp[i] = (unsigned)(Rb * K + C) * 2u; }
    const size_t kstep = (size_t)(BK * 2);
    const size_t hstep = (size_t)HALF * K * 2;
    const size_t rowb = (size_t)K * 2;
    const unsigned ldsw = (unsigned)wid * 1024u;
    const int aoff = lds_byte(wr * 64 + fr, fq * 8), boff = lds_byte(wc * 32 + fr, fq * 8);
    const char* Ab = (const char*)Aptr;
#define PG8_SA(b, h) (((b) * 2 + (h)) * HTB)
#define PG8_SB(b, h) ((4 + (b) * 2 + (h)) * HTB)
#define PG8_STAGE(bufoff, gbase, voff) do { _Pragma("unroll") for (int _i = 0; _i < 2; ++_i) \
        __builtin_amdgcn_global_load_lds((const unsigned*)((const char*)(gbase) + (voff)[_i]), (LAS unsigned*)(lds + (bufoff) + ldsw + _i * 8192), 16, 0, 0); } while (0)
#define PG8_LDA(dst, b, h) do { _Pragma("unroll") for (int m = 0; m < 4; ++m) _Pragma("unroll") for (int k = 0; k < 2; ++k) dst[m][k] = *(const LAS bf16x8*)(lds + PG8_SA(b, h) + aoff + m * 2048 + k * 1024); } while (0)
#define PG8_LDB(dst, b, h) do { _Pragma("unroll") for (int n = 0; n < 2; ++n) _Pragma("unroll") for (int k = 0; k < 2; ++k) dst[n][k] = *(const LAS bf16x8*)(lds + PG8_SB(b, h) + boff + n * 2048 + k * 1024); } while (0)
#define PG8_MMA(ai, bj, At, Bt) do { __builtin_amdgcn_s_setprio(1); _Pragma("unroll") for (int m = 0; m < 4; ++m) _Pragma("unroll") for (int n = 0; n < 2; ++n) _Pragma("unroll") for (int k = 0; k < 2; ++k) \
        acc[ai][bj][m][n] = __builtin_amdgcn_mfma_f32_16x16x32_bf16(Bt[n][k], At[m][k], acc[ai][bj][m][n], 0, 0, 0); __builtin_amdgcn_s_setprio(0); } while (0)
#define PG8_WAIT_V(n) asm volatile("s_waitcnt vmcnt(" #n ")" ::: "memory")
#define PG8_WAIT_L(n) asm volatile("s_waitcnt lgkmcnt(" #n ")" ::: "memory")
#define PG8_BAR __builtin_amdgcn_s_barrier()
#define PG8_SCHED __builtin_amdgcn_sched_barrier(0)
    Unit cur, nxt; int ui = 0;
    if (!S.next(0, cur)) return;
    f32x4 acc[2][2][4][2];
#pragma unroll
    for (int a = 0; a < 2; ++a)
#pragma unroll
        for (int b = 0; b < 2; ++b)
#pragma unroll
            for (int m = 0; m < 4; ++m)
#pragma unroll
                for (int n = 0; n < 2; ++n) acc[a][b][m][n] = (f32x4){0.f, 0.f, 0.f, 0.f};
    bf16x8 At[4][2], B0[2][2], B1[2][2];
    const char* cA = Ab; unsigned cG[2][2];
    if constexpr (Sched::GATHER) {
#pragma unroll
        for (int h = 0; h < 2; ++h)
#pragma unroll
            for (int i = 0; i < 2; ++i) cG[h][i] = (unsigned)((size_t)S.a_row(cur, h * HALF + sR[i]) * rowb) + (unsigned)sC[i] * 2u;
    } else { cA = Ab + (ptrdiff_t)S.a_row0(cur) * (ptrdiff_t)rowb; cG[0][0] = cG[0][1] = cG[1][0] = cG[1][1] = 0u; }
    S.a_ready(cur, wid);
    const char* cB = (const char*)Btptr + (ptrdiff_t)S.b_row0(cur) * (ptrdiff_t)rowb;
    { const bool pc = S.perm(cur); voffB[0] = pc ? voffBp[0] : voffBn[0]; voffB[1] = pc ? voffBp[1] : voffBn[1]; }
#define PG8_STAGEA(bufoff, h, dbase, goffs, kb) do { if constexpr (Sched::GATHER) { PG8_STAGE(bufoff, Ab + (kb), (goffs)[h]); } else { PG8_STAGE(bufoff, (dbase) + (h) * hstep + (kb), voffA); } } while (0)
    PG8_STAGE(PG8_SB(0, 0), cB, voffB); PG8_STAGE(PG8_SB(0, 1), cB + hstep, voffB); PG8_STAGEA(PG8_SA(0, 0), 0, cA, cG, 0); PG8_STAGEA(PG8_SA(0, 1), 1, cA, cG, 0);
    if (wr == 1) PG8_BAR;
    PG8_WAIT_V(2); PG8_BAR;
    PG8_STAGE(PG8_SB(1, 0), cB + kstep, voffB); PG8_STAGEA(PG8_SA(1, 0), 0, cA, cG, kstep); PG8_STAGE(PG8_SB(1, 1), cB + hstep + kstep, voffB);
    PG8_WAIT_V(6); PG8_BAR;
    for (;;) {
        const bool has_next = S.next(ui + 1, nxt);
        const char* nA = cA; const char* nB = cB; unsigned nG[2][2];
#pragma unroll
        for (int h = 0; h < 2; ++h)
#pragma unroll
            for (int i = 0; i < 2; ++i) nG[h][i] = cG[h][i];
        nvB[0] = voffB[0]; nvB[1] = voffB[1];
        if (has_next) {
            nB = (const char*)Btptr + (ptrdiff_t)S.b_row0(nxt) * (ptrdiff_t)rowb;
            { const bool pn_ = S.perm(nxt); nvB[0] = pn_ ? voffBp[0] : voffBn[0]; nvB[1] = pn_ ? voffBp[1] : voffBn[1]; }
            if constexpr (Sched::GATHER) {
#pragma unroll
                for (int h = 0; h < 2; ++h)
#pragma unroll
                    for (int i = 0; i < 2; ++i) nG[h][i] = (unsigned)((size_t)S.a_row(nxt, h * HALF + sR[i]) * rowb) + (unsigned)sC[i] * 2u;
            } else nA = Ab + (ptrdiff_t)S.a_row0(nxt) * (ptrdiff_t)rowb;
        }
        for (int t = 0; t < nt; t += 2) {
            const bool last = (t == nt - 2);
            if (last && has_next) S.a_ready(nxt, wid);
            const size_t kb1 = (size_t)(t + 1) * kstep;
            const size_t kb2 = last ? 0 : (size_t)(t + 2) * kstep, kb3 = kb2 + kstep;
            const char* a2 = last ? nA : cA; const char* b2 = last ? nB : cB + (size_t)(t + 2) * kstep; const char* b3 = b2 + kstep;
            unsigned vB2[2]; vB2[0] = last ? nvB[0] : voffB[0]; vB2[1] = last ? nvB[1] : voffB[1];
            unsigned g2[2][2];
#pragma unroll
            for (int h = 0; h < 2; ++h)
#pragma unroll
                for (int i = 0; i < 2; ++i) g2[h][i] = last ? nG[h][i] : cG[h][i];
            PG8_LDB(B0, 0, 0); PG8_LDB(B1, 0, 1); PG8_SCHED; PG8_LDA(At, 0, 0); PG8_STAGEA(PG8_SA(1, 1), 1, cA, cG, kb1);
            PG8_WAIT_V(8); PG8_WAIT_L(0); PG8_BAR; PG8_MMA(0, 0, At, B0); PG8_MMA(0, 1, At, B1); PG8_BAR; PG8_SCHED;
            PG8_LDA(At, 0, 1); PG8_STAGE(PG8_SB(0, 0), b2, vB2); PG8_STAGE(PG8_SB(0, 1), b2 + hstep, vB2); PG8_STAGEA(PG8_SA(0, 0), 0, a2, g2, kb2);
            PG8_WAIT_V(8); PG8_WAIT_L(0); PG8_BAR; PG8_MMA(1, 0, At, B0); PG8_MMA(1, 1, At, B1); PG8_BAR; PG8_SCHED;
            PG8_LDB(B0, 1, 0); PG8_LDB(B1, 1, 1); PG8_SCHED; PG8_LDA(At, 1, 0); PG8_STAGEA(PG8_SA(0, 1), 1, a2, g2, kb2);
            PG8_WAIT_V(8); PG8_WAIT_L(0); PG8_BAR; PG8_MMA(0, 0, At, B0); PG8_MMA(0, 1, At, B1); PG8_BAR; PG8_SCHED;
            PG8_LDA(At, 1, 1); PG8_STAGE(PG8_SB(1, 0), b3, vB2); PG8_STAGE(PG8_SB(1, 1), b3 + hstep, vB2); PG8_STAGEA(PG8_SA(1, 0), 0, a2, g2, kb3);
            PG8_WAIT_V(8); PG8_WAIT_L(0); PG8_BAR; PG8_MMA(1, 0, At, B0); PG8_MMA(1, 1, At, B1); PG8_BAR; PG8_SCHED;
        }
        if (wr == 0) PG8_BAR;
        E(acc, cur, wr, wc, fr, fq);
        if (!has_next) break;
#pragma unroll
        for (int a = 0; a < 2; ++a)
#pragma unroll
            for (int b = 0; b < 2; ++b)
#pragma unroll
                for (int m = 0; m < 4; ++m)
#pragma unroll
                    for (int n = 0; n < 2; ++n) acc[a][b][m][n] = (f32x4){0.f, 0.f, 0.f, 0.f};
        cur = nxt; cA = nA; cB = nB; ++ui; voffB[0] = nvB[0]; voffB[1] = nvB[1];
#pragma unroll
        for (int h = 0; h < 2; ++h)
#pragma unroll
            for (int i = 0; i < 2; ++i) cG[h][i] = nG[h][i];
        if (wr == 1) PG8_BAR;
    }
    PG8_WAIT_V(0);
    PG8_BAR;
#undef PG8_SA
#undef PG8_SB
#undef PG8_STAGE
#undef PG8_STAGEA
#undef PG8_LDA
#undef PG8_LDB
#undef PG8_MMA
#undef PG8_WAIT_V
#undef PG8_WAIT_L
#undef PG8_BAR
#undef PG8_SCHED
}
}

#define XB_TMO      128
#define XB_XCNT(j)  (256  + 64 * (j))
#define XB_XSUB(j)  (1280 + 64 * (j))
#define XB_XGEN(j)  (2304 + 64 * (j))
#define XB_TOP      3328
#define XB_TOPGEN   3392
#define XCD_BAR_WORDS 3456
#define XB_SPIN_CAP (1u << 18)
__device__ __forceinline__ unsigned xb_ld(unsigned* p)              { return __hip_atomic_load(p, __ATOMIC_RELAXED, __HIP_MEMORY_SCOPE_AGENT); }
__device__ __forceinline__ unsigned xb_add(unsigned* p, unsigned v) { return __hip_atomic_fetch_add(p, v, __ATOMIC_RELAXED, __HIP_MEMORY_SCOPE_AGENT); }
__device__ __forceinline__ unsigned xb_xcc_id() { return (unsigned)__builtin_amdgcn_s_getreg((3 << 11) | 20) & 0xFu; }
#define XB_SPIN(cond, bar) do { unsigned _sp = 0; while (cond) { __builtin_amdgcn_s_sleep(1); \
    if ((++_sp & 255u) == 0u) { if (xb_ld(&(bar)[XB_TMO])) break; if (_sp > XB_SPIN_CAP) { atomicAdd(&(bar)[XB_TMO], 1u); break; } } } } while (0)
struct XcdBarrier { unsigned* bar; unsigned x; volatile LAS unsigned* st; };
__device__ __forceinline__ XcdBarrier xcd_barrier_post(unsigned* bar, volatile LAS unsigned* st) {
    XcdBarrier b; b.bar = bar; b.x = xb_xcc_id(); b.st = st;
    if (threadIdx.x == 0) (void)xb_add(&bar[XB_XCNT(b.x)], 1u);
    return b;
}
__device__ __forceinline__ void xcd_barrier_complete(unsigned* bar, unsigned x, unsigned& nloc, unsigned& nx) {
    const unsigned G = gridDim.x * gridDim.y * gridDim.z;
    unsigned sum, cnt, mine, sp = 0u;
    for (;;) {
        sum = 0u; cnt = 0u; mine = 0u;
#pragma unroll
        for (unsigned j = 0; j < 16; ++j) { const unsigned c = xb_ld(&bar[XB_XCNT(j)]); sum += c; cnt += (c > 0u) ? 1u : 0u; mine = (j == x) ? c : mine; }
        if (sum == G) break;
        __builtin_amdgcn_s_sleep(1);
        if ((++sp & 255u) == 0u) { if (xb_ld(&bar[XB_TMO])) break; if (sp > XB_SPIN_CAP) { atomicAdd(&bar[XB_TMO], 1u); break; } }
    }
    nloc = mine > 0u ? mine : 1u; nx = cnt > 0u ? cnt : 1u;
}
__device__ __forceinline__ void xcd_barrier(const XcdBarrier& b) {
    asm volatile("s_waitcnt vmcnt(0)" ::: "memory");
    __syncthreads();
    if (threadIdx.x == 0) {
        unsigned* bar = b.bar;
        __builtin_amdgcn_s_waitcnt(0);
        unsigned nloc = b.st[0], nx = b.st[1];
        if (nloc == 0u) { xcd_barrier_complete(bar, b.x, nloc, nx); b.st[0] = nloc; b.st[1] = nx; }
        const unsigned old = xb_add(&bar[XB_XSUB(b.x)], 1u);
        const unsigned gen = old / nloc;
        if (old + 1u == (gen + 1u) * nloc) {
            __builtin_amdgcn_fence(__ATOMIC_RELEASE, "agent");
            asm volatile("s_waitcnt vmcnt(0)" ::: "memory");
            const unsigned og = xb_add(&bar[XB_TOP], 1u);
            const unsigned tg = og / nx;
            if (og + 1u == (tg + 1u) * nx) xb_add(&bar[XB_TOPGEN], 1u);
            else XB_SPIN(xb_ld(&bar[XB_TOPGEN]) == tg, bar);
            __builtin_amdgcn_fence(__ATOMIC_ACQUIRE, "agent");
            xb_add(&bar[XB_XGEN(b.x)], 1u);
            asm volatile("s_waitcnt vmcnt(0)" ::: "memory");
        } else {
            XB_SPIN(xb_ld(&bar[XB_XGEN(b.x)]) == gen, bar);
            __builtin_amdgcn_fence(__ATOMIC_ACQUIRE, "agent");
            asm volatile("s_waitcnt vmcnt(0)" ::: "memory");
        }
    }
    __syncthreads();
}

using pg8::Unit;
typedef f32x4 acc_t[2][2][4][2];

struct EpiProj {
    static constexpr bool PERM = false;
    unsigned char* ws; const LAS float* ropeL; const LAS float* lbtL; int skip;
    template <int KIND> __device__ __forceinline__ void swapped(const acc_t& acc, const Unit& u, int wr, int wc, int fr, int fq, bool latent) const {
        constexpr size_t so2 = KIND == 0 ? WS_V : KIND == 1 ? WS_HQ : KIND == 2 ? WS_HI : KIND == 3 ? WS_LF : WS_LB;
        bf16* dT = (bf16*)(ws + so2);
        constexpr int ldt = (KIND == 1) ? T : MROWS;
        const int wrow0 = (u.pn & 1) * 256 + wr * 64 + fr, tcol0 = u.pm * 256 + wc * 32 + 8 * fq;
        const LAS float* lbt = lbtL + (KIND == 4 ? 512 : 0);
#pragma unroll
        for (int ai = 0; ai < 2; ++ai)
#pragma unroll
            for (int m = 0; m < 4; ++m) { const int wrow = wrow0 + ai * 128 + m * 16; float lb = 0.f; if (KIND >= 3) lb = lbt[wrow];
#pragma unroll
                for (int bj = 0; bj < 2; ++bj) { float x[8]; u32x4 w;
#pragma unroll
                    for (int j = 0; j < 4; ++j) { x[j] = acc[ai][bj][m][0][j]; x[4 + j] = acc[ai][bj][m][1][j]; }
                    if (KIND >= 3) {
#pragma unroll
                        for (int j = 0; j < 8; ++j) { const float sg = __builtin_amdgcn_rcpf(1.f + __expf(-x[j])); x[j] = __log2f(lb + (1.f - lb) * sg); }
                        w = (u32x4){pkh2(x[0], x[1]), pkh2(x[2], x[3]), pkh2(x[4], x[5]), pkh2(x[6], x[7])}; }
                    else { if (KIND == 1) {
#pragma unroll
                            for (int j = 0; j < 8; ++j) x[j] = silu_f(x[j]); }
                        w = (u32x4){pg8::cvt_pk_bf16(x[0], x[1]), pg8::cvt_pk_bf16(x[2], x[3]), pg8::cvt_pk_bf16(x[4], x[5]), pg8::cvt_pk_bf16(x[6], x[7])}; }
                    size_t off = (size_t)wrow * ldt + tcol0 + bj * 128;
                    if (KIND == 0) { const int tc = tcol0 + bj * 128, bb_ = latent ? (tc >> 11) : ((tc - T) >> 8), tl = latent ? (tc & (SEQ - 1)) : (KTOK - LC + ((tc - T) & (LC - 1)));
                        off = ((((size_t)(bb_ * NAH + (wrow >> 6)) * (KTOK / 64) + (tl >> 6)) * NAD + (wrow & 63)) * 64) + (tl & 63); }
                    __builtin_nontemporal_store((u32x4)(w), (u32x4*)(dT + off)); } }
    }
    template <int SEG, bool LAT> __device__ __forceinline__ void rope(const acc_t& acc, int row0, int lcp, int wc, int fq) const {
        bf16* dK = (bf16*)(ws + (SEG == 0 ? WS_QR : WS_K)); bf16* dQ = (bf16*)(ws + WS_Q);
#pragma unroll
        for (int ai = 0; ai < 2; ++ai)
#pragma unroll
            for (int m = 0; m < 4; ++m) { const int row = row0 + ai * 128 + m * 16, sq = row & (SEQ - 1); const int pos = (wc & 1) ? (sq & 63) : (sq >> 6);
                f32x4 cs0 = (f32x4){1.f, 0.f, 1.f, 0.f}, cs1 = cs0;
                if (LAT) { cs0 = *(const LAS f32x4*)(ropeL + (pos * 16 + 4 * fq) * 2); cs1 = *(const LAS f32x4*)(ropeL + (pos * 16 + 4 * fq) * 2 + 4); }
                const float cc[4] = {cs0[0], cs0[2], cs1[0], cs1[2]}, sn[4] = {cs0[1], cs0[3], cs1[1], cs1[3]};
#pragma unroll
                for (int bj = 0; bj < 2; ++bj) { const f32x4 x1 = acc[ai][bj][m][0], x2 = acc[ai][bj][m][1]; float o1[4], o2[4];
#pragma unroll
                    for (int j = 0; j < 4; ++j) { o1[j] = LAT ? x1[j] * cc[j] - x2[j] * sn[j] : x1[j]; o2[j] = LAT ? x2[j] * cc[j] + x1[j] * sn[j] : x2[j]; }
                    size_t off = (size_t)row * SEGW + lcp + bj * 128;
                    if (SEG == 0) __builtin_nontemporal_store((u32x4)((u32x4){pg8::cvt_pk_bf16(x1[0], x1[1]), pg8::cvt_pk_bf16(x1[2], x1[3]), pg8::cvt_pk_bf16(x2[0], x2[1]), pg8::cvt_pk_bf16(x2[2], x2[3])}), (u32x4*)(dQ + off));
                    else { const int cf = lcp + bj * 128, bb_ = LAT ? (row >> 11) : ((row - T) >> 8), tl = LAT ? sq : (KTOK - LC + ((row - T) & (LC - 1)));
                        off = ((size_t)(bb_ * NAH + (cf >> 6)) * KTOK + tl) * NAD + (cf & 63); }
                    __builtin_nontemporal_store((u32x4)((u32x4){pg8::cvt_pk_bf16(o1[0], o1[1]), pg8::cvt_pk_bf16(o1[2], o1[3]), pg8::cvt_pk_bf16(o2[0], o2[1]), pg8::cvt_pk_bf16(o2[2], o2[3])}), (u32x4*)(dK + off)); } }
    }
    __device__ __forceinline__ void operator()(const acc_t& acc, const Unit& u, int wr, int wc, int fr, int fq) const {
        const int seg = u.pn >> 1; const bool latent = u.pm < (T / 256);
        if (skip) return;
        if (!latent && (seg == 0 || seg == 3 || seg == 7)) return;
        if (u.e) {
            if (seg == 2) swapped<0>(acc, u, wr, wc, fr, fq, latent);
            else if (seg == 3) swapped<1>(acc, u, wr, wc, fr, fq, latent);
            else if (seg == 4) swapped<2>(acc, u, wr, wc, fr, fq, latent);
            else if (seg == 5) swapped<3>(acc, u, wr, wc, fr, fq, latent);
            else swapped<4>(acc, u, wr, wc, fr, fq, latent);
            return;
        }
        const int row0 = u.pm * 256 + wr * 64 + fr;
        const int lcp = (u.pn & 1) * 256 + wc * 32 + 8 * fq;
        if (seg <= 1) {
            if (seg == 0) rope<0, true>(acc, row0, lcp, wc, fq);
            else if (latent) rope<1, true>(acc, row0, lcp, wc, fq);
            else rope<1, false>(acc, row0, lcp, wc, fq);
            return;
        }
        bf16* dG = (bf16*)(ws + WS_G);
#pragma unroll
        for (int ai = 0; ai < 2; ++ai)
#pragma unroll
            for (int m = 0; m < 4; ++m) { const int row = row0 + ai * 128 + m * 16;
#pragma unroll
                for (int bj = 0; bj < 2; ++bj) { float x[8];
#pragma unroll
                    for (int j = 0; j < 4; ++j) { x[j] = silu_f(acc[ai][bj][m][0][j]); x[4 + j] = silu_f(acc[ai][bj][m][1][j]); }
                    __builtin_nontemporal_store((u32x4)((u32x4){pg8::cvt_pk_bf16(x[0], x[1]), pg8::cvt_pk_bf16(x[2], x[3]), pg8::cvt_pk_bf16(x[4], x[5]), pg8::cvt_pk_bf16(x[6], x[7])}), (u32x4*)(dG + (size_t)row * SEGW + lcp + bj * 128)); } }
    }
};
struct EpiP {
    static constexpr bool PERM = true;
    bf16* P;
    __device__ __forceinline__ void operator()(const acc_t& acc, const Unit& u, int wr, int wc, int fr, int fq) const {
        const int col0 = u.pn * 256 + wc * 32 + 8 * fq; const int row0 = u.pm * 256 + wr * 64 + fr;
#pragma unroll
        for (int ai = 0; ai < 2; ++ai)
#pragma unroll
            for (int m = 0; m < 4; ++m)
#pragma unroll
                for (int bj = 0; bj < 2; ++bj) { const f32x4 v0 = acc[ai][bj][m][0], v1 = acc[ai][bj][m][1];
                    *(u32x4*)(P + (size_t)(row0 + ai * 128 + m * 16) * D + col0 + bj * 128) = (u32x4){pg8::cvt_pk_bf16(v0[0], v0[1]), pg8::cvt_pk_bf16(v0[2], v0[3]), pg8::cvt_pk_bf16(v1[0], v1[1]), pg8::cvt_pk_bf16(v1[2], v1[3])}; }
    }
};
struct EpiSwiGLU {
    static constexpr bool PERM = true;
    bf16* H; gu32* tcnt;
    __device__ __forceinline__ void operator()(const acc_t& acc, const Unit& u, int wr, int wc, int fr, int fq) const {
        const int hc = u.pn * 128 + wc * 32 + 8 * fq; const int row0 = u.pm * 256 + wr * 64 + fr;
        const __amdgpu_buffer_rsrc_t hr = __builtin_amdgcn_make_buffer_rsrc((void*)H, (short)0, 0x7ffffff0, 0x00020000);
#pragma unroll
        for (int ai = 0; ai < 2; ++ai)
#pragma unroll
            for (int m = 0; m < 4; ++m) { float h[8];
#pragma unroll
                for (int n = 0; n < 2; ++n)
#pragma unroll
                    for (int j = 0; j < 4; ++j) h[n * 4 + j] = silu_f(acc[ai][0][m][n][j]) * acc[ai][1][m][n][j];
                u32x4 w; w.x = pg8::cvt_pk_bf16(h[0], h[1]); w.y = pg8::cvt_pk_bf16(h[2], h[3]); w.z = pg8::cvt_pk_bf16(h[4], h[5]); w.w = pg8::cvt_pk_bf16(h[6], h[7]);
                const unsigned off = (unsigned)(((size_t)(row0 + ai * 128 + m * 16) * DE + hc) * 2);
                __builtin_amdgcn_raw_buffer_store_b128(__builtin_bit_cast(bu4v, w), hr, (int)off, 0, 16); }
        if (tcnt) { asm volatile("s_waitcnt vmcnt(0)" ::: "memory");
            if (fr == 0 && fq == 0) (void)__hip_atomic_fetch_add(tcnt + u.pm, 1u, RLX_AGENT); }
    }
};
struct EpiMoeOut {
    static constexpr bool PERM = true;
    bf16* Y; const int* elist; const float* ewt;
    __device__ __forceinline__ void operator()(const acc_t& acc, const Unit& u, int wr, int wc, int fr, int fq) const {
        const int col0 = u.pn * 256 + wc * 32 + 8 * fq;
#pragma unroll
        for (int ai = 0; ai < 2; ++ai)
#pragma unroll
            for (int m = 0; m < 4; ++m) { const int rank = u.tm * 256 + ai * 128 + wr * 64 + m * 16 + fr;
                if (rank < u.cnt) { const int tk = elist[u.e * ECAP + rank]; const float w = ewt[u.e * ECAP + rank];
#pragma unroll
                    for (int bj = 0; bj < 2; ++bj) { const f32x4 v0 = acc[ai][bj][m][0] * w, v1 = acc[ai][bj][m][1] * w; u32x4 o;
                        o.x = pg8::cvt_pk_bf16(v0[0], v0[1]); o.y = pg8::cvt_pk_bf16(v0[2], v0[3]); o.z = pg8::cvt_pk_bf16(v1[0], v1[1]); o.w = pg8::cvt_pk_bf16(v1[2], v1[3]);
                        *(u32x4*)(Y + (size_t)tk * D + col0 + bj * 128) = o; } } }
    }
};
template <bool GATHER_> struct MoeOrder {
    static constexpr bool GATHER = GATHER_;
    const LAS int* tp; const int* elist; int G, c, nwg; gu32* tcnt;
    __device__ bool next(int i, Unit& u) const {
        const long L = (long)i * G + c; if (L >= nwg) return false;
        int wgid = (int)L; { const int q = nwg / 8, r = nwg % 8, xcd = wgid % 8, off = wgid / 8; wgid = (xcd < r ? xcd * (q + 1) : r * (q + 1) + (xcd - r) * q) + off; }
        const int gt = wgid >> 2; int e = 0;
#pragma unroll
        for (int k = 1; k < 16; ++k) e = (gt >= tp[k]) ? k : e;
        u.pm = gt; u.pn = wgid & 3; u.e = e; u.tm = gt - tp[e]; u.cnt = tp[17 + e]; return true;
    }
    __device__ __forceinline__ int a_row0(const Unit& u) const { return u.pm * 256; }
    __device__ __forceinline__ int a_row(const Unit& u, int r) const {
        if constexpr (GATHER_) { int rank = u.tm * 256 + r; rank = rank < u.cnt ? rank : u.cnt - 1; return elist[u.e * ECAP + rank] >> 1; }
        else return u.pm * 256 + r;
    }
    __device__ __forceinline__ int b_row0(const Unit& u) const { return u.e * 1024 + u.pn * 256; }
    __device__ __forceinline__ bool perm(const Unit&) const { return true; }
    __device__ __forceinline__ void a_ready(const Unit& u, int wid) const {
        if constexpr (!GATHER_) {
            if (tcnt) {
                if (wid == 0) { unsigned sp = 0; while (__hip_atomic_load(tcnt + u.pm, RLX_AGENT) < 32u) { __builtin_amdgcn_s_sleep(2); if (++sp > (1u << 20)) break; }
                    __builtin_amdgcn_fence(__ATOMIC_ACQUIRE, "agent"); asm volatile("s_waitcnt vmcnt(0)" ::: "memory"); }
                __builtin_amdgcn_s_barrier();
            }
        }
    }
};


constexpr int SWMASK = 0x7C;
constexpr int W_REL_XN = (int)(((long long)WS_WINT - (long long)WS_XN) / 2048);
struct ProjOrder {
    static constexpr bool GATHER = false;
    pg8::DenseOrder d;
    __device__ void init(int G_, int c_) { d.init(MROWS, INCOLS, G_, c_); }
    __device__ bool next(int i, Unit& u) const { if (!d.next(i, u)) return false; u.e = (SWMASK >> (u.pn >> 1)) & 1; return true; }
    __device__ __forceinline__ int a_row0(const Unit& u) const { return u.e ? W_REL_XN + u.pn * 256 : u.pm * 256; }
    __device__ __forceinline__ int a_row(const Unit& u, int r) const { return a_row0(u) + r; }
    __device__ __forceinline__ int b_row0(const Unit& u) const { return u.e ? -W_REL_XN + u.pm * 256 : u.pn * 256; }
    __device__ __forceinline__ bool perm(const Unit& u) const { return (u.pn >> 1) >= 2; }
    __device__ __forceinline__ void a_ready(const Unit&, int) const {}
};


__device__ __forceinline__ bf16x8 pack8(const f32x4& a, const f32x4& b) {
    u32x4 w; w.x = pg8::cvt_pk_bf16(a[0], a[1]); w.y = pg8::cvt_pk_bf16(a[2], a[3]); w.z = pg8::cvt_pk_bf16(b[0], b[1]); w.w = pg8::cvt_pk_bf16(b[2], b[3]);
    return __builtin_bit_cast(bf16x8, w);
}
typedef unsigned bu4 __attribute__((__vector_size__(16)));
__device__ __forceinline__ bf16x8 bload16(__amdgpu_buffer_rsrc_t r, unsigned voff, unsigned soff) { return __builtin_bit_cast(bf16x8, __builtin_amdgcn_raw_buffer_load_b128(r, (int)voff, (int)soff, 0)); }
#define NA_SB() __builtin_amdgcn_sched_barrier(0)
__device__ __forceinline__ bf16x8 sel8(bool c, const bf16x8 a, const bf16x8 b) { const u32x4 x = __builtin_bit_cast(u32x4, a), y = __builtin_bit_cast(u32x4, b); u32x4 r;
    r.x = c ? x.x : y.x; r.y = c ? x.y : y.y; r.z = c ? x.z : y.z; r.w = c ? x.w : y.w; return __builtin_bit_cast(bf16x8, r); }
constexpr int NA_CTXK = 0, NA_CTXV = 32768, NA_RING = 65536, NA_SLOT = 16384;
#define NA_BAR() do { asm volatile("s_waitcnt lgkmcnt(0)" ::: "memory"); __builtin_amdgcn_s_barrier(); asm volatile("" ::: "memory"); } while (0)
struct NaState { f32x4 o[2][4]; float mref[2], lsum[2]; };
template <bool LOCAL>
__device__ __forceinline__ void na_step(NaState& st, const bf16x8 (&q)[2][2], const LAS unsigned char* kb, const LAS unsigned char* vb, unsigned vsw, const LAS float* bpi,
                                        bool setref, int qi, int g, int jb) {
    constexpr float SC = 0.125f * 1.44269504f; const float NEG = -1e30f;
    const int rg = qi >> 2;
    const unsigned kx = (unsigned)((rg << 1) | ((qi >> 1) & 1)), vx = (unsigned)((qi >> 1) & 7);
    const unsigned ka0 = (unsigned)(8 * rg + (qi & 3)) * 128u + (((unsigned)g ^ kx) << 4), ka1 = ka0 ^ 64u;
    const unsigned va = (unsigned)qi * 128u + (((unsigned)g ^ vx) << 4);
#pragma unroll
    for (int j = 0; j < 2; ++j) {
        const int jj = jb + j; const int P0 = (jj == 0) ? 0 : (jj == 1) ? 1 : (jj == 2) ? 3 : 4;
        const int pk = P0 + ((rg - P0) & 3), pv = P0 + ((g - P0) & 3);
        const unsigned kh = LOCAL ? (unsigned)(pk >> 2) * 4096u : 0u, vh = LOCAL ? (unsigned)(pv >> 2) * 64u : 0u;
        const bf16x8 a00 = *(const LAS bf16x8*)(kb + (ka0 + kh)), a01 = *(const LAS bf16x8*)(kb + (ka1 + kh)), a10 = *(const LAS bf16x8*)(kb + 512 + (ka0 + kh)), a11 = *(const LAS bf16x8*)(kb + 512 + (ka1 + kh));
        bf16x8 vf[4]; const unsigned vaj = (va ^ vsw) ^ vh;
#pragma unroll
        for (int dt = 0; dt < 4; ++dt) vf[dt] = *(const LAS bf16x8*)(vb + dt * 2048 + vaj);
        f32x4 s0 = __builtin_amdgcn_mfma_f32_16x16x32_bf16(a00, q[j][0], (f32x4){0.f, 0.f, 0.f, 0.f}, 0, 0, 0); s0 = __builtin_amdgcn_mfma_f32_16x16x32_bf16(a01, q[j][1], s0, 0, 0, 0);
        f32x4 s1 = __builtin_amdgcn_mfma_f32_16x16x32_bf16(a10, q[j][0], (f32x4){0.f, 0.f, 0.f, 0.f}, 0, 0, 0); s1 = __builtin_amdgcn_mfma_f32_16x16x32_bf16(a11, q[j][1], s1, 0, 0, 0);
        if (LOCAL) {
            const int bbj = 8 * pv - (16 * jj + qi) + 31;
            const int dlo = (jj == 0) ? (qi < 8 ? 31 - qi : 23) : (jj == 3) ? (qi > 8 ? 31 - qi : 23) : 23;
            const int lo_j = dlo - bbj; const LAS float* bpj = bpi + bbj;
            { float b0 = bpj[0], b1 = bpj[1], b2 = bpj[2], b3 = bpj[3];
              asm volatile("" : "+v"(b0), "+v"(b1), "+v"(b2), "+v"(b3));
              const float bq[4] = {b0, b1, b2, b3};
#pragma unroll
              for (int e = 0; e < 4; ++e) { const float t0 = s0[e] * SC + bq[e]; s0[e] = ((unsigned)(e - lo_j) < 16u) ? t0 : NEG; } }
            { float b0 = bpj[4], b1 = bpj[5], b2 = bpj[6], b3 = bpj[7];
              asm volatile("" : "+v"(b0), "+v"(b1), "+v"(b2), "+v"(b3));
              const float bq[4] = {b0, b1, b2, b3};
#pragma unroll
              for (int e = 0; e < 4; ++e) { const float t1 = s1[e] * SC + bq[e]; s1[e] = ((unsigned)(4 + e - lo_j) < 16u) ? t1 : NEG; } }
        } else {
#pragma unroll
            for (int e = 0; e < 4; ++e) { s0[e] *= SC; s1[e] *= SC; }
        }
        if (setref) { float mx = fmaxf(fmaxf(fmaxf(s0[0], s0[1]), fmaxf(s0[2], s0[3])), fmaxf(fmaxf(s1[0], s1[1]), fmaxf(s1[2], s1[3])));
            mx = fmaxf(mx, __shfl_xor(mx, 16)); mx = fmaxf(mx, __shfl_xor(mx, 32)); st.mref[j] = mx; }
        float ps = 0.f;
#pragma unroll
        for (int e = 0; e < 4; ++e) { s0[e] = __builtin_amdgcn_exp2f(fminf(s0[e] - st.mref[j], 100.f)); s1[e] = __builtin_amdgcn_exp2f(fminf(s1[e] - st.mref[j], 100.f)); ps += s0[e] + s1[e]; }
        st.lsum[j] += ps; const bf16x8 Bp = pack8(s0, s1);
#pragma unroll
        for (int dt = 0; dt < 4; ++dt) st.o[j][dt] = __builtin_amdgcn_mfma_f32_16x16x32_bf16(vf[dt], Bp, st.o[j][dt], 0, 0, 0);
    }
}
__device__ __forceinline__ void na_wg(LAS unsigned char* lds, int bb, int h, const bf16* Q, const bf16* QR, const bf16* KH, const bf16* VH, bf16* MIX, const LAS float* rpbL, int tid) {
    const int lane = tid & 63, w = __builtin_amdgcn_readfirstlane(tid >> 6), qi = lane & 15, g = lane >> 4;
    const int jb = 2 * (w & 1);
    const size_t bh = (size_t)(bb * NAH + h);
    { const u32x4* ksrc = (const u32x4*)(KH + (bh * KTOK + SEQ) * NAD); const u32x4* vsrc = (const u32x4*)(VH + (bh * (KTOK / 64) + SEQ / 64) * (NAD * 64));
#pragma unroll
      for (int j = 0; j < 4; ++j) { const int L = tid + NTHR * j; const u32x4 kv = ksrc[L], vv = vsrc[L];
          const int key = L >> 3, ch = L & 7, fk = (((key >> 3) & 3) << 1) | ((key >> 1) & 1);
          *(LAS u32x4*)(lds + NA_CTXK + key * 128 + ((ch ^ fk) << 4)) = kv;
          const int blk = L >> 9, dd = (L >> 3) & 63;
          *(LAS u32x4*)(lds + NA_CTXV + blk * 8192 + dd * 128 + ((ch ^ ((dd >> 1) & 7)) << 4)) = vv; } }
    const int skey = tid >> 3, sch = tid & 7;
    const unsigned skoff = (unsigned)(skey * 128 + ((sch ^ ((((skey >> 3) & 3) << 1) | ((skey >> 1) & 1))) << 4)), svoff = (unsigned)(8192 + skey * 128 + ((sch ^ ((skey >> 1) & 7)) << 4));
    const u32x4* kg = (const u32x4*)(KH + bh * KTOK * NAD) + tid;
    const u32x4* vg = (const u32x4*)(VH + bh * (KTOK / 64) * (NAD * 64)) + tid;
#pragma unroll 1
    for (int item = 0; item < 8; ++item) {
        const int r0 = 4 * item, r = r0 + (w >> 1);
        int rs = r - 4; rs = rs < 0 ? 0 : (rs > NROWS - 8 ? NROWS - 8 : rs);
        int rs0 = r0 - 4; rs0 = rs0 < 0 ? 0 : (rs0 > NROWS - 8 ? NROWS - 8 : rs0);
        int rs3 = r0 - 1; rs3 = rs3 < 0 ? 0 : (rs3 > NROWS - 8 ? NROWS - 8 : rs3);
        const int nloc = rs3 + 8 - rs0, off = rs - rs0;
        const int tok0 = bb * SEQ + r * GW;
        NaState st; bf16x8 qrot[2][2], qraw[2][2];
#pragma unroll
        for (int j = 0; j < 2; ++j) { st.mref[j] = 0.f; st.lsum[j] = 0.f;
#pragma unroll
            for (int dt = 0; dt < 4; ++dt) st.o[j][dt] = (f32x4){0.f, 0.f, 0.f, 0.f};
            const size_t qo = (size_t)(tok0 + 16 * (jb + j) + qi) * SEGW + h * NAD + 8 * g;
            qrot[j][0] = *(const bf16x8*)(QR + qo); qrot[j][1] = *(const bf16x8*)(QR + qo + 32); qraw[j][0] = *(const bf16x8*)(Q + qo); qraw[j][1] = *(const bf16x8*)(Q + qo + 32); }
        u32x4 sk = kg[(size_t)rs0 * 512], sv = vg[(size_t)rs0 * 512];
        *(LAS u32x4*)(lds + NA_RING + skoff) = sk; *(LAS u32x4*)(lds + NA_RING + svoff) = sv;
        sk = kg[(size_t)(rs0 + 1) * 512]; sv = vg[(size_t)(rs0 + 1) * 512];
        NA_BAR();
        int ic = 0;
#pragma unroll 1
        for (int slot = 0; slot < 16; ++slot) {
            if (slot + 1 < nloc) { const int rsl = (slot + 1) % 3; *(LAS u32x4*)(lds + NA_RING + rsl * NA_SLOT + skoff) = sk; *(LAS u32x4*)(lds + NA_RING + rsl * NA_SLOT + svoff) = sv; }
            { const int nr = slot + 2 < nloc ? slot + 2 : nloc - 1; sk = kg[(size_t)(rs0 + nr) * 512]; sv = vg[(size_t)(rs0 + nr) * 512]; }
            const int qz = qi, gz = g;
            const int il = slot - off;
            if (il >= 0 && il < 8) {
                const LAS unsigned char* rb = lds + NA_RING + (slot % 3) * NA_SLOT;
                na_step<true>(st, qrot, rb, rb + 8192, 0u, rpbL + (rs + il - r + 7) * 64, slot == 0, qz, gz, jb);
            } else {
                na_step<false>(st, qraw, lds + NA_CTXK + ic * 4096, lds + NA_CTXV + (ic >> 1) * 8192, (unsigned)(ic & 1) << 6, rpbL, slot == 0, qz, gz, jb);
                ++ic;
            }
            NA_BAR();
        }
#pragma unroll
        for (int j = 0; j < 2; ++j) { float l = st.lsum[j]; l += __shfl_xor(l, 16); l += __shfl_xor(l, 32); const float inv = 1.f / l;
            bf16* op = MIX + (size_t)(tok0 + 16 * (jb + j) + qi) * D + h * NAD + 4 * g;
#pragma unroll
            for (int dt = 0; dt < 4; ++dt) { const f32x4 v = st.o[j][dt] * inv; *(v2u*)(op + 16 * dt) = (v2u){pg8::cvt_pk_bf16(v[0], v[1]), pg8::cvt_pk_bf16(v[2], v[3])}; } }
    }
}

typedef float f32x16 __attribute__((ext_vector_type(16)));
constexpr int SC_Q1 = 0, SC_K1 = SC_Q1 + 64 * 272, SC_K1T = SC_K1 + 64 * 272, SC_VT = SC_K1T + 128 * 144, SC_ST = SC_VT + 128 * 144, SC_TOT = SC_ST + 128 * 272, SC_CST = SC_TOT + 2 * 4 * 128 * 4, SC_END = SC_CST + 2 * 128 * 4;
static_assert(SC_END <= RING_BYTES, "scan LDS");
#define SCAN_MFMA(a, b, c) __builtin_amdgcn_mfma_f32_32x32x16_bf16(a, b, c, 0, 0, 0)
#define SCAN_BAR() do { asm volatile("s_waitcnt lgkmcnt(0)" ::: "memory"); __builtin_amdgcn_s_barrier(); asm volatile("" ::: "memory"); } while (0)
__device__ __forceinline__ void scan_unit(LAS unsigned char* lds, int b, int h, int dir, const unsigned short* LGT, const bf16* HQT, const bf16* HIT, bf16* OUT, int tid) {
    const int lane = tid & 63, w = __builtin_amdgcn_readfirstlane(tid >> 6), r = lane & 31, hh = lane >> 5;
    const int d = tid & 127, tq = tid >> 7;
    const int ti = w >> 2, ovi = w & 3;
    const int di = w >> 1, svi = 2 * (w & 1);
    f32x16 S0, S1;
#pragma unroll
    for (int i = 0; i < 16; ++i) { S0[i] = 0.f; S1[i] = 0.f; }
    const size_t chrow = (size_t)(h * HGD + d);
    constexpr int NCH = (LC + SEQ) / 64;
    auto col_of = [&](int c) -> int { return c < 4 ? (T + b * LC + 64 * (dir ? 3 - c : c)) : (b * SEQ + (dir ? SEQ - 64 * (c - 3) : 64 * (c - 4))); };
    LAS float* totb = (LAS float*)(lds + SC_TOT); LAS float* cst = (LAS float*)(lds + SC_CST);
    u32x4 lg0[2], lg1[2], vr[2], qr[2], vn[2], qn[2];
    { const int c0 = col_of(0) + 16 * tq, c1 = col_of(1) + 16 * tq;
      lg0[0] = *(const u32x4*)(LGT + chrow * MROWS + c0); lg0[1] = *(const u32x4*)(LGT + chrow * MROWS + c0 + 8);
      lg1[0] = *(const u32x4*)(LGT + chrow * MROWS + c1); lg1[1] = *(const u32x4*)(LGT + chrow * MROWS + c1 + 8);
      vr[0] = *(const u32x4*)(HIT + chrow * MROWS + c0); vr[1] = *(const u32x4*)(HIT + chrow * MROWS + c0 + 8); qr[0] = qr[1] = (u32x4){0u, 0u, 0u, 0u};
      vn[0] = *(const u32x4*)(HIT + chrow * MROWS + c1); vn[1] = *(const u32x4*)(HIT + chrow * MROWS + c1 + 8); qn[0] = qn[1] = (u32x4){0u, 0u, 0u, 0u};
      float sm = 0.f;
#pragma unroll
      for (int i = 0; i < 8; ++i) { const unsigned u2 = lg0[i >> 2][i & 3]; sm += h2f((unsigned short)(u2 & 0xffff)) + h2f((unsigned short)(u2 >> 16)); }
      totb[tq * 128 + d] = sm; }
    SCAN_BAR();
#pragma unroll 1
    for (int c = 0; c < NCH; ++c) {
        const bool lat = c >= 4; const int par = c & 1;
        LAS float* tot = totb + par * 512;
        {
            float P[16], kk[16];
#pragma unroll
            for (int i = 0; i < 8; ++i) { const unsigned u2 = lg0[i >> 2][i & 3]; P[2 * i] = h2f((unsigned short)(u2 & 0xffff)); P[2 * i + 1] = h2f((unsigned short)(u2 >> 16)); }
#pragma unroll
            for (int i = 0; i < 16; ++i) kk[i] = 1.f - __builtin_amdgcn_exp2f(P[i]);
            if (!dir) {
#pragma unroll
                for (int i = 1; i < 16; ++i) P[i] += P[i - 1];
            } else {
#pragma unroll
                for (int i = 14; i >= 0; --i) P[i] += P[i + 1];
            }
            const float t0 = tot[d], t1 = tot[128 + d], t2 = tot[256 + d], t3 = tot[384 + d];
            const float Bm = dir ? (t2 + t3) : (t0 + t1);
            float offs; if (!dir) offs = (tq > 0 ? t0 : 0.f) + (tq > 1 ? t1 : 0.f) + (tq > 2 ? t2 : 0.f); else offs = (tq < 3 ? t3 : 0.f) + (tq < 2 ? t2 : 0.f) + (tq < 1 ? t1 : 0.f);
            const float sh = offs - Bm;
            if (tq == 0) { const float be = (t0 + t1) + (t2 + t3); cst[d] = __builtin_amdgcn_exp2f(be); cst[128 + d] = __builtin_amdgcn_exp2f(be - Bm); }
            unsigned kt[8];
            LAS bf16* q1 = (LAS bf16*)(lds + SC_Q1) + (16 * tq) * 136 + d; LAS bf16* k1 = (LAS bf16*)(lds + SC_K1) + (16 * tq) * 136 + d;
#pragma unroll
            for (int i = 0; i < 16; i += 2) {
                const float x0 = fminf(fmaxf(P[i] + sh, -120.f), 120.f), x1 = fminf(fmaxf(P[i + 1] + sh, -120.f), 120.f);
                const float k0 = kk[i] * __builtin_amdgcn_exp2f(-x0), k1v = kk[i + 1] * __builtin_amdgcn_exp2f(-x1);
                kt[i >> 1] = pg8::cvt_pk_bf16(k0, k1v);
                if (lat) { const unsigned qq = (i < 8 ? qr[0] : qr[1])[(i >> 1) & 3];
                    const unsigned qp2 = pg8::cvt_pk_bf16(bflo(qq) * __builtin_amdgcn_exp2f(x0), bfhi(qq) * __builtin_amdgcn_exp2f(x1));
                    q1[i * 136] = (bf16)(qp2 & 0xffff); q1[(i + 1) * 136] = (bf16)(qp2 >> 16);
                    k1[i * 136] = (bf16)(kt[i >> 1] & 0xffff); k1[(i + 1) * 136] = (bf16)(kt[i >> 1] >> 16); }
            }
            LAS unsigned char* k1t = lds + SC_K1T + d * 144 + 32 * tq;
            *(LAS u32x4*)k1t = (u32x4){kt[0], kt[1], kt[2], kt[3]}; *(LAS u32x4*)(k1t + 16) = (u32x4){kt[4], kt[5], kt[6], kt[7]};
            LAS unsigned char* vt = lds + SC_VT + d * 144 + 32 * tq;
            *(LAS u32x4*)vt = vr[0]; *(LAS u32x4*)(vt + 16) = vr[1];
        }
        if (lat) {
#pragma unroll
            for (int rg = 0; rg < 4; ++rg) { const int dd = 32 * di + 8 * rg + 4 * hh;
                const f32x4 a0 = *(const LAS f32x4*)(tot + dd), a1 = *(const LAS f32x4*)(tot + 128 + dd), a2 = *(const LAS f32x4*)(tot + 256 + dd), a3 = *(const LAS f32x4*)(tot + 384 + dd);
                const f32x4 bm = dir ? (a2 + a3) : (a0 + a1); float eb[4];
#pragma unroll
                for (int j = 0; j < 4; ++j) eb[j] = __builtin_amdgcn_exp2f(bm[j]);
                *(LAS v2u*)(lds + SC_ST + ((32 * svi + r) * 136 + dd) * 2) = (v2u){pg8::cvt_pk_bf16(S0[4 * rg] * eb[0], S0[4 * rg + 1] * eb[1]), pg8::cvt_pk_bf16(S0[4 * rg + 2] * eb[2], S0[4 * rg + 3] * eb[3])};
                *(LAS v2u*)(lds + SC_ST + ((32 * (svi + 1) + r) * 136 + dd) * 2) = (v2u){pg8::cvt_pk_bf16(S1[4 * rg] * eb[0], S1[4 * rg + 1] * eb[1]), pg8::cvt_pk_bf16(S1[4 * rg + 2] * eb[2], S1[4 * rg + 3] * eb[3])}; }
        }
        { float sm = 0.f;
#pragma unroll
            for (int i = 0; i < 8; ++i) { const unsigned u2 = lg1[i >> 2][i & 3]; sm += h2f((unsigned short)(u2 & 0xffff)) + h2f((unsigned short)(u2 >> 16)); }
            totb[(par ^ 1) * 512 + tq * 128 + d] = sm;
            lg0[0] = lg1[0]; lg0[1] = lg1[1]; vr[0] = vn[0]; vr[1] = vn[1]; qr[0] = qn[0]; qr[1] = qn[1];
            const int cm = c + 2 < NCH ? c + 2 : NCH - 1, cq = cm < 4 ? 4 : cm;
            const int c2 = col_of(cm) + 16 * tq, c2q = col_of(cq) + 16 * tq;
            vn[0] = *(const u32x4*)(HIT + chrow * MROWS + c2); vn[1] = *(const u32x4*)(HIT + chrow * MROWS + c2 + 8);
            qn[0] = *(const u32x4*)(HQT + chrow * T + c2q); qn[1] = *(const u32x4*)(HQT + chrow * T + c2q + 8);
            lg1[0] = *(const u32x4*)(LGT + chrow * MROWS + c2); lg1[1] = *(const u32x4*)(LGT + chrow * MROWS + c2 + 8); }
        SCAN_BAR();
        f32x16 dS0, dS1, O;
#pragma unroll
        for (int i = 0; i < 16; ++i) { dS0[i] = 0.f; dS1[i] = 0.f; O[i] = 0.f; }
        {
            bf16x8 fa[4], fb0[4], fb1[4];
#pragma unroll
            for (int ks = 0; ks < 4; ++ks) { fa[ks] = *(const LAS bf16x8*)(lds + SC_K1T + ((32 * di + r) * 72 + 16 * ks + 8 * hh) * 2);
                fb0[ks] = *(const LAS bf16x8*)(lds + SC_VT + ((32 * svi + r) * 72 + 16 * ks + 8 * hh) * 2); fb1[ks] = *(const LAS bf16x8*)(lds + SC_VT + ((32 * (svi + 1) + r) * 72 + 16 * ks + 8 * hh) * 2); }
#pragma unroll
            for (int ks = 0; ks < 4; ++ks) { dS0 = SCAN_MFMA(fa[ks], fb0[ks], dS0); dS1 = SCAN_MFMA(fa[ks], fb1[ks], dS1); }
        }
        if (lat) {
            bf16x8 fq[8];
#pragma unroll
            for (int ks = 0; ks < 8; ++ks) fq[ks] = *(const LAS bf16x8*)(lds + SC_Q1 + ((32 * ti + r) * 136 + 16 * ks + 8 * hh) * 2);
            {
                bf16x8 fs[8];
#pragma unroll
                for (int ks = 0; ks < 8; ++ks) fs[ks] = *(const LAS bf16x8*)(lds + SC_ST + ((32 * ovi + r) * 136 + 16 * ks + 8 * hh) * 2);
#pragma unroll
                for (int ks = 0; ks < 8; ++ks) O = SCAN_MFMA(fs[ks], fq[ks], O);
            }
#pragma unroll
            for (int si = 0; si < 2; ++si) {
                const bool live = dir ? (si >= ti) : (si <= ti);
                if (live) {
                    f32x16 At;
#pragma unroll
                    for (int i = 0; i < 16; ++i) At[i] = 0.f;
                    bf16x8 fk[8];
#pragma unroll
                    for (int ks = 0; ks < 8; ++ks) fk[ks] = *(const LAS bf16x8*)(lds + SC_K1 + ((32 * si + r) * 136 + 16 * ks + 8 * hh) * 2);
#pragma unroll
                    for (int ks = 0; ks < 8; ++ks) At = SCAN_MFMA(fk[ks], fq[ks], At);
                    const int tt = 32 * ti + r;
                    if (si == ti) {
#pragma unroll
                        for (int i = 0; i < 16; ++i) { const int ss = 32 * si + (i & 3) + 8 * (i >> 2) + 4 * hh; const bool keep = dir ? (ss >= tt) : (ss <= tt); At[i] = keep ? At[i] : 0.f; }
                    }
#pragma unroll
                    for (int k2 = 0; k2 < 2; ++k2) {
                        u32x4 pw; pw.x = pg8::cvt_pk_bf16(At[8 * k2], At[8 * k2 + 1]); pw.y = pg8::cvt_pk_bf16(At[8 * k2 + 2], At[8 * k2 + 3]); pw.z = pg8::cvt_pk_bf16(At[8 * k2 + 4], At[8 * k2 + 5]); pw.w = pg8::cvt_pk_bf16(At[8 * k2 + 6], At[8 * k2 + 7]);
                        const LAS unsigned char* vp = lds + SC_VT + ((32 * ovi + r) * 72 + 32 * si + 16 * k2 + 4 * hh) * 2;
                        const v2u lo = *(const LAS v2u*)vp, hi2 = *(const LAS v2u*)(vp + 16);
                        O = SCAN_MFMA(__builtin_bit_cast(bf16x8, (u32x4){lo.x, lo.y, hi2.x, hi2.y}), __builtin_bit_cast(bf16x8, pw), O);
                    }
                }
            }
            bf16* op = OUT + (size_t)(col_of(c) + 32 * ti + r) * SEGW + h * HGD + 32 * ovi + 4 * hh;
#pragma unroll
            for (int rg = 0; rg < 4; ++rg) *(v2u*)(op + 8 * rg) = (v2u){pg8::cvt_pk_bf16(O[4 * rg], O[4 * rg + 1]), pg8::cvt_pk_bf16(O[4 * rg + 2], O[4 * rg + 3])};
        }
#pragma unroll
        for (int rg = 0; rg < 4; ++rg) { const int dd = 32 * di + 8 * rg + 4 * hh;
            const f32x4 ee = *(const LAS f32x4*)(cst + dd), em = *(const LAS f32x4*)(cst + 128 + dd);
#pragma unroll
            for (int j = 0; j < 4; ++j) { S0[4 * rg + j] = ee[j] * S0[4 * rg + j] + em[j] * dS0[4 * rg + j]; S1[4 * rg + j] = ee[j] * S1[4 * rg + j] + em[j] * dS1[4 * rg + j]; } }
        SCAN_BAR();
    }
}

#ifdef DBG_NAIVE
__device__ __forceinline__ void scan_naive(LAS unsigned char* lds, int b, int h, int dir, const unsigned short* LGT, const bf16* HQT, const bf16* HIT, bf16* OUT, int tid) {
    const int dv = tid & 127, kg = tid >> 7;
    float St[32];
#pragma unroll
    for (int i = 0; i < 32; ++i) St[i] = 0.f;
    LAS float* sq = (LAS float*)lds; LAS float* sk = sq + 16 * 128; LAS float* sf = sk + 16 * 128; LAS float* sv = sf + 16 * 128; LAS float* so = sv + 16 * 128;
    constexpr int NSTEP = LC + SEQ;
    for (int j0 = 0; j0 < NSTEP; j0 += 16) {
        const bool isctx = j0 < LC;
        for (int idx = tid; idx < 16 * 128; idx += NTHR) { const int st = idx >> 7, ch = idx & 127, j = j0 + st;
            int col; if (j < LC) col = T + b * LC + (dir ? (LC - 1 - j) : j); else col = b * SEQ + (dir ? (SEQ - 1 - (j - LC)) : (j - LC));
            const size_t cr = (size_t)(h * HGD + ch);
            const float f = __builtin_amdgcn_exp2f(h2f(LGT[cr * MROWS + col]));
            sf[st * 128 + ch] = f; sk[st * 128 + ch] = 1.f - f; sv[st * 128 + ch] = bf2f(HIT[cr * MROWS + col]);
            if (!isctx) sq[st * 128 + ch] = bf2f(HQT[cr * T + col]); }
        __syncthreads();
        for (int st = 0; st < 16; ++st) {
            const float vv = sv[st * 128 + dv]; float o = 0.f;
#pragma unroll
            for (int i = 0; i < 32; ++i) { St[i] = sf[st * 128 + kg * 32 + i] * St[i] + sk[st * 128 + kg * 32 + i] * vv; o += St[i] * sq[st * 128 + kg * 32 + i]; }
            so[(st * 4 + kg) * 128 + dv] = o;
        }
        __syncthreads();
        if (!isctx) {
            for (int idx = tid; idx < 16 * 128; idx += NTHR) { const int st = idx >> 7, dd = idx & 127, j = j0 + st;
                const float o = (so[(st * 4 + 0) * 128 + dd] + so[(st * 4 + 1) * 128 + dd]) + (so[(st * 4 + 2) * 128 + dd] + so[(st * 4 + 3) * 128 + dd]);
                const int row = b * SEQ + (dir ? (SEQ - 1 - (j - LC)) : (j - LC));
                OUT[(size_t)row * SEGW + h * HGD + dd] = (bf16)f2bf(o); }
        }
        __syncthreads();
    }
}
#endif

__device__ __forceinline__ void transpose_item(const float* W, int ldw, int k0, int n0, bf16* WT, int ldk, int drow0, LAS float* scr, int lane) {
    f32x4 t[8];
#pragma unroll
    for (int i = 0; i < 8; ++i) t[i] = *(const f32x4*)(W + (size_t)(k0 + 8 * i + (lane >> 3)) * ldw + n0 + (lane & 7) * 4);
#pragma unroll
    for (int i = 0; i < 8; ++i) { LAS float* p = scr + (8 * i + (lane >> 3)) * 33 + (lane & 7) * 4; p[0] = t[i][0]; p[1] = t[i][1]; p[2] = t[i][2]; p[3] = t[i][3]; }
    LDS_WAIT(); asm volatile("" ::: "memory");
    const int c = lane & 7;
#pragma unroll
    for (int j = 0; j < 4; ++j) { const int n = (lane >> 3) + 8 * j; const LAS float* s = scr + (8 * c) * 33 + n;
        v4u o; o.x = pk2(s[0 * 33], s[1 * 33]); o.y = pk2(s[2 * 33], s[3 * 33]); o.z = pk2(s[4 * 33], s[5 * 33]); o.w = pk2(s[6 * 33], s[7 * 33]);
        *(GAS v4u*)(WT + (size_t)(drow0 + n) * ldk + k0 + 8 * c) = o; }
    LDS_WAIT(); asm volatile("" ::: "memory");
}

struct Args { const float* in[21]; float* out; unsigned char* ws; int ph_lo, ph_hi, li, pad; };

__global__ void __launch_bounds__(NTHR, 2) fwd_mega(Args args) {
    extern __shared__ __attribute__((aligned(16))) unsigned char lds_raw[];
    LAS unsigned char* lds = (LAS unsigned char*)lds_raw;
    volatile LAS unsigned* MISC = (volatile LAS unsigned*)(lds + MISC_OFF);
    const int tid = threadIdx.x, lane = tid & 63, wave = __builtin_amdgcn_readfirstlane(tid >> 6);
    const int G = gridDim.x; const int bx = blockIdx.x; const int vcu = (G % 8 == 0) ? (bx % 8) * (G / 8) + bx / 8 : bx;
    gu32* ctl0 = (gu32*)(args.ws + WS_CTL);
    const int gw = vcu * NWAVES + wave, NGW = G * NWAVES;
    for (int u = tid; u < (LDS_BYTES - LDSCTL_OFF) / 4; u += NTHR) ((LAS unsigned*)(lds + LDSCTL_OFF))[u] = 0u;
    __syncthreads();
    XcdBarrier bar = xcd_barrier_post((unsigned*)(ctl0 + CW_BAR) + args.li * XCD_BAR_WORDS, MISC + 8);
    const int lo = args.ph_lo, hi = args.ph_hi;
#ifndef PHMASK
#define PHMASK 0xFFFF
#endif
#define IN(k) (((PHMASK >> (k)) & 1) && lo <= (k) && (k) < hi)
#define SEAM(k) do { if (IN(k) && IN((k) + 1)) xcd_barrier(bar); } while (0)

#define KA(i) ({ const __attribute__((address_space(4))) Args* _p = (const __attribute__((address_space(4))) Args*)__builtin_amdgcn_kernarg_segment_ptr(); asm volatile("" : "+s"(_p)); _p->in[i]; })
#define WSP() ({ const __attribute__((address_space(4))) Args* _p = (const __attribute__((address_space(4))) Args*)__builtin_amdgcn_kernarg_segment_ptr(); asm volatile("" : "+s"(_p)); _p->ws; })
#define PHASE_PTRS unsigned char* ws = WSP(); float* MOD = (float*)(ws + WS_MOD); float* ROPE = (float*)(ws + WS_ROPE); float* LBT = (float*)(ws + WS_LBT); \
    bf16* WinT = (bf16*)(ws + WS_WINT); bf16* WoutT = (bf16*)(ws + WS_WOUTT); bf16* W13T = (bf16*)(ws + WS_W13T); bf16* W2T = (bf16*)(ws + WS_W2T); \
    bf16* XN = (bf16*)(ws + WS_XN); bf16* MIX = (bf16*)(ws + WS_MIX); bf16* XN2 = (bf16*)(ws + WS_XN2); \
    float* X1 = (float*)(ws + WS_X1); bf16* Hb = (bf16*)(ws + WS_H); bf16* Yb = (bf16*)(ws + WS_Y); \
    int* ELIST = (int*)(ws + WS_ELIST); float* EWT = (float*)(ws + WS_EWT); gu32* ctl = (gu32*)(ws + WS_CTL); \
    (void)MOD; (void)ROPE; (void)LBT; (void)WinT; (void)WoutT; (void)W13T; (void)W2T; (void)XN; (void)MIX; (void)XN2; (void)X1; (void)Hb; (void)Yb; (void)ELIST; (void)EWT; (void)ctl;
    if (IN(0)) {
        PHASE_PTRS
        const float* cvec = KA(1); const float* c_ctx = KA(3); const float* w_mod = KA(4); const float* b_mod = KA(5); const float* w_in = KA(8); const float* w_out = KA(9);
        const float* hg_lb = KA(11); const float* w1 = KA(17); const float* w3 = KA(18); const float* w2 = KA(19);
        if (bx == G - 1) {
            for (int idx = tid; idx < 1024; idx += NTHR) { const int pos = idx >> 4, i = idx & 15;
                double th = 1.0; for (int k = 0; k < i; ++k) th *= 0.5623413251903491;
                const double t2 = th * th; double c = 1.0, s = th, tc = 1.0, ts = th;
                for (int n = 1; n <= 12; ++n) { tc *= -t2 / (double)((2 * n - 1) * (2 * n)); c += tc; ts *= -t2 / (double)((2 * n) * (2 * n + 1)); s += ts; }
                double cr = 1.0, ci = 0.0; for (int p = 0; p < pos; ++p) { const double nr = cr * c - ci * s; ci = cr * s + ci * c; cr = nr; }
                ROPE[idx * 2] = (float)cr; ROPE[idx * 2 + 1] = (float)ci; }
            for (int idx = tid; idx < 1024; idx += NTHR) { const float h0 = hg_lb[idx], h1 = hg_lb[1024 + idx]; LBT[idx] = 1.f / (1.f + expf(h1 - h0)); }
        }
        if (bx < 96) {
            LAS float* sc = (LAS float*)lds;
            for (int idx = tid; idx < 17 * 1024; idx += NTHR) { const int r = idx >> 10, k = idx & 1023; const float cv = r < 16 ? cvec[r * 1024 + k] : c_ctx[k]; sc[idx] = cv / (1.f + expf(-cv)); }
            __syncthreads();
            const int col = 64 * bx + lane, k0 = 128 * wave;
            float acc[17];
#pragma unroll
            for (int r = 0; r < 17; ++r) acc[r] = 0.f;
            for (int kk = 0; kk < 128; kk += 4) {
                const float w0 = w_mod[(size_t)(k0 + kk) * 6144 + col], w1v = w_mod[(size_t)(k0 + kk + 1) * 6144 + col], w2v = w_mod[(size_t)(k0 + kk + 2) * 6144 + col], w3v = w_mod[(size_t)(k0 + kk + 3) * 6144 + col];
#pragma unroll
                for (int r = 0; r < 17; ++r) { const f32x4 a = *(const LAS f32x4*)(sc + r * 1024 + k0 + kk); acc[r] += a[0] * w0 + a[1] * w1v + a[2] * w2v + a[3] * w3v; }
            }
            LAS float* red = (LAS float*)(lds + 17 * 1024 * 4);
#pragma unroll
            for (int r = 0; r < 17; ++r) red[(wave * 17 + r) * 64 + lane] = acc[r];
            __syncthreads();
            for (int idx = tid; idx < 17 * 64; idx += NTHR) { const int r = idx >> 6, l = idx & 63; float s = 0.f;
#pragma unroll
                for (int w = 0; w < 8; ++w) s += red[(w * 17 + r) * 64 + l];
                MOD[r * 6144 + 64 * bx + l] = s + b_mod[64 * bx + l]; }
            __syncthreads();
        }
        {
            LAS float* scr = (LAS float*)(lds + wave * 16384);
            constexpr int I_IN = 16 * 128, I_OUT = 16 * 32, I_13 = 16 * 2 * 256, I_2 = 16 * 256, NIT = I_IN + I_OUT + I_13 + I_2;
            for (int it = gw; it < NIT; it += NGW) {
                int r = it;
                if (r < I_IN) { const int kb = r / 128, nb = r % 128; transpose_item(w_in, INCOLS, 64 * kb, 32 * nb, WinT, 1024, 32 * nb, scr, lane); continue; } r -= I_IN;
                if (r < I_OUT) { const int kb = r / 32, nb = r % 32; transpose_item(w_out, 1024, 64 * kb, 32 * nb, WoutT, 1024, 32 * nb, scr, lane); continue; } r -= I_OUT;
                if (r < I_13) { const int e = r / 512, rem = r % 512, s = rem / 256, r2 = rem % 256, kb = r2 / 16, nb = r2 % 16, n0 = 32 * nb;
                    transpose_item((s ? w3 : w1) + (size_t)e * 1024 * 512, 512, 64 * kb, n0, W13T, 1024, e * 1024 + 256 * (n0 / 128) + 128 * s + (n0 % 128), scr, lane); continue; } r -= I_13;
                { const int e = r / 256, r2 = r % 256, kb = r2 / 32, nb = r2 % 32; transpose_item(w2 + (size_t)e * 512 * 1024, 1024, 64 * kb, 32 * nb, W2T, 512, e * 1024 + 32 * nb, scr, lane); }
            }
        }
    }
    SEAM(0);

    if (IN(1)) {
        PHASE_PTRS
        const float* x = KA(0); const float* ctx = KA(2); const float* norm_mix = KA(6);
        for (int row = gw; row < MROWS; row += NGW) {
            const float* xr = row < T ? x + (size_t)row * D : ctx + (size_t)(row - T) * D; const int mb = row < T ? (row >> 11) : 16;
            f32x4 v[4]; float s = 0.f;
#pragma unroll
            for (int j = 0; j < 4; ++j) { v[j] = *(const f32x4*)(xr + 4 * lane + 256 * j); s += (v[j][0] * v[j][0] + v[j][1] * v[j][1]) + (v[j][2] * v[j][2] + v[j][3] * v[j][3]); }
            const float rstd = 1.f / sqrtf(wave_sum(s) * (1.f / D) + EPS);
#pragma unroll
            for (int j = 0; j < 4; ++j) { const int col = 4 * lane + 256 * j; const f32x4 g = *(const f32x4*)(norm_mix + col), sh = *(const f32x4*)(MOD + mb * 6144 + col), sc = *(const f32x4*)(MOD + mb * 6144 + 1024 + col);
                const f32x4 y = v[j] * rstd * g * (1.f + sc) + sh;
                *(v2u*)(XN + (size_t)row * D + col) = (v2u){pk2(y[0], y[1]), pk2(y[2], y[3])}; }
        }
    }
    SEAM(1);

    if (IN(2)) {
        PHASE_PTRS
        ProjOrder S; S.init(G, bx);
        LAS float* ropeL = (LAS float*)(lds + TAB_OFF); LAS float* lbtL = ropeL + 2048;
        for (int i = tid; i < 2048 + 1024; i += NTHR) ropeL[i] = i < 2048 ? ROPE[i] : LBT[i - 2048];
        __syncthreads();
        EpiProj E{ws, ropeL, lbtL, 0};
        pg8::gemm_phase<EpiProj, ProjOrder>(lds + RING_OFF, XN, WinT, D, S, E);
    }
    SEAM(2);

    if (IN(3)) {
        PHASE_PTRS
        const bf16* Qb = (const bf16*)(ws + WS_Q); const bf16* Kb = (const bf16*)(ws + WS_K); const bf16* Vb = (const bf16*)(ws + WS_V);
        const float* na_rpb = KA(10);
        const int subph = ({ const __attribute__((address_space(4))) Args* _p = (const __attribute__((address_space(4))) Args*)__builtin_amdgcn_kernarg_segment_ptr(); asm volatile("" : "+s"(_p)); _p->pad; });
#ifndef NO_SCAN
        if (bx < 128) {
            const int dir = bx & 1;
#ifdef DBG_NAIVE
            if (DBG_NAIVE & (1 << dir)) scan_naive(lds, bx >> 3, (bx >> 1) & 3, dir, (const unsigned short*)(ws + (dir ? WS_LB : WS_LF)), (const bf16*)(ws + WS_HQ), (const bf16*)(ws + WS_HI), (bf16*)(ws + (dir ? WS_OB : WS_OF)), tid);
            else
#endif
            if (subph != 2) scan_unit(lds, bx >> 3, (bx >> 1) & 3, dir, (const unsigned short*)(ws + (dir ? WS_LB : WS_LF)), (const bf16*)(ws + WS_HQ), (const bf16*)(ws + WS_HI), (bf16*)(ws + (dir ? WS_OB : WS_OF)), tid);
        } else
#endif
        {
            const int hx = bx & 7, bb = (bx - 128) >> 3;
            LAS float* rpbL = (LAS float*)(lds + TAB_OFF);
            for (int t2 = tid; t2 < 15 * 64; t2 += NTHR) { const int co = (t2 & 63) - 16, ro = t2 >> 6; rpbL[t2] = (co >= 0 && co < 31) ? na_rpb[(hx * 15 + ro) * 31 + co] * 1.44269504f : 0.f; }
            if (subph != 1) na_wg(lds, bb, hx, Qb, (const bf16*)(ws + WS_QR), Kb, Vb, MIX, rpbL, tid);
        }
    }
    SEAM(3);

    if (IN(4)) {
        PHASE_PTRS
        const float* hg_norm = KA(12);
        const bf16* OF = (const bf16*)(ws + WS_OF); const bf16* OB = (const bf16*)(ws + WS_OB); const bf16* Gb = (const bf16*)(ws + WS_G);
        for (int tok = gw; tok < T; tok += NGW) {
            const size_t off = (size_t)tok * SEGW + lane * 8;
            const v4u a = *(const v4u*)(OF + off), bb = *(const v4u*)(OB + off), g = *(const v4u*)(Gb + off);
            float o[8]; float ss = 0.f;
#pragma unroll
            for (int e = 0; e < 4; ++e) { o[2 * e] = bflo(a[e]) + bflo(bb[e]); o[2 * e + 1] = bfhi(a[e]) + bfhi(bb[e]);
#ifdef DBG_SANITIZE
                if (!(fabsf(o[2 * e]) < 1e30f)) o[2 * e] = 0.f; if (!(fabsf(o[2 * e + 1]) < 1e30f)) o[2 * e + 1] = 0.f;
#endif
                ss += o[2 * e] * o[2 * e] + o[2 * e + 1] * o[2 * e + 1]; }
            ss += __shfl_xor(ss, 1); ss += __shfl_xor(ss, 2); ss += __shfl_xor(ss, 4); ss += __shfl_xor(ss, 8);
            const float rstd = 1.f / sqrtf(ss * (1.f / HGD) + EPS);
            const int dv0 = (lane & 15) * 8;
            const f32x4 g0 = *(const f32x4*)(hg_norm + dv0), g1 = *(const f32x4*)(hg_norm + dv0 + 4);
            const float gg[8] = {g0[0], g0[1], g0[2], g0[3], g1[0], g1[1], g1[2], g1[3]};
            float y[8];
#pragma unroll
            for (int e = 0; e < 4; ++e) { y[2 * e] = o[2 * e] * rstd * gg[2 * e] * bflo(g[e]); y[2 * e + 1] = o[2 * e + 1] * rstd * gg[2 * e + 1] * bfhi(g[e]); }
            *(v4u*)(MIX + (size_t)tok * D + 512 + lane * 8) = (v4u){pk2(y[0], y[1]), pk2(y[2], y[3]), pk2(y[4], y[5]), pk2(y[6], y[7])};
        }
    }
    SEAM(4);

    if (IN(5)) {
        PHASE_PTRS
        pg8::DenseOrder S; S.init(T, D, G, bx, true);
        EpiP E{(bf16*)X1};
        pg8::gemm_phase<EpiP, pg8::DenseOrder>(lds + RING_OFF, MIX, WoutT, D, S, E);
    }
    SEAM(5);

    if (IN(6)) {
        PHASE_PTRS
        const float* norm_ffn = KA(7); const float* w_grp = KA(13); const float* b_grp = KA(14); const float* w_exp = KA(15); const float* b_exp = KA(16);
        LAS f32x4* wl = (LAS f32x4*)lds;
        for (int idx = tid; idx < 5 * 1024; idx += NTHR) { const int quad = idx >> 10, col = idx & 1023; const int l = (col & 255) >> 2, q = col & 3, j = col >> 8;
            const f32x4 w = quad == 0 ? *(const f32x4*)(w_grp + col * 4) : *(const f32x4*)(w_exp + col * 16 + (quad - 1) * 4);
            wl[((quad * 4 + q) * 4 + j) * 64 + l] = w; }
        LAS int* lcnt = (LAS int*)(lds + 81920);
        LAS int* tmpe = (LAS int*)(lds + 81920 + 256);
        LAS float* rsc = (LAS float*)(lds + 86016);
        if (tid < 32) lcnt[tid] = 0;
        __syncthreads();
        const int rowbase = bx * 128 + wave * 16;
        const int mb = rowbase >> 11;
        f32x4 gsc[4], shv[4], gaa[4];
        const float* xin = KA(0); const bf16* Pb = (const bf16*)X1;
#pragma unroll
        for (int j = 0; j < 4; ++j) { const int col = 4 * lane + 256 * j; const f32x4 g = *(const f32x4*)(norm_ffn + col), sc = *(const f32x4*)(MOD + mb * 6144 + 4096 + col);
            gsc[j] = g * (1.f + sc); shv[j] = *(const f32x4*)(MOD + mb * 6144 + 3072 + col); gaa[j] = *(const f32x4*)(MOD + mb * 6144 + 2048 + col); }
        f32x4 vn[2][4]; v2u pn[2][4];
#pragma unroll
        for (int rr = 0; rr < 2; ++rr)
#pragma unroll
            for (int j = 0; j < 4; ++j) { const size_t o_ = (size_t)(rowbase + rr) * D + 4 * lane + 256 * j; vn[rr][j] = *(const f32x4*)(xin + o_); pn[rr][j] = *(const v2u*)(Pb + o_); }
#pragma unroll 1
        for (int ip = 0; ip < 8; ++ip) {
            asm volatile("" ::: "memory");
            f32x4 v[2][4];
#pragma unroll
            for (int rr = 0; rr < 2; ++rr)
#pragma unroll
                for (int j = 0; j < 4; ++j) v[rr][j] = vn[rr][j] + gaa[j] * (f32x4){bflo(pn[rr][j].x), bfhi(pn[rr][j].x), bflo(pn[rr][j].y), bfhi(pn[rr][j].y)};
            if (ip < 7) {
#pragma unroll
                for (int rr = 0; rr < 2; ++rr)
#pragma unroll
                    for (int j = 0; j < 4; ++j) { const size_t o_ = (size_t)(rowbase + 2 * ip + 2 + rr) * D + 4 * lane + 256 * j; vn[rr][j] = *(const f32x4*)(xin + o_); pn[rr][j] = *(const v2u*)(Pb + o_); } }
            float ss[2];
#pragma unroll
            for (int rr = 0; rr < 2; ++rr) { float s = 0.f;
#pragma unroll
                for (int j = 0; j < 4; ++j) s += (v[rr][j][0] * v[rr][j][0] + v[rr][j][1] * v[rr][j][1]) + (v[rr][j][2] * v[rr][j][2] + v[rr][j][3] * v[rr][j][3]);
                ss[rr] = s; }
#pragma unroll
            for (int o = 1; o < 64; o <<= 1) { ss[0] += __shfl_xor(ss[0], o); ss[1] += __shfl_xor(ss[1], o); }
            const float rstd0 = 1.f / sqrtf(ss[0] * (1.f / D) + EPS), rstd1 = 1.f / sqrtf(ss[1] * (1.f / D) + EPS);
            float lg[2][20];
#pragma unroll
            for (int k = 0; k < 20; ++k) { lg[0][k] = 0.f; lg[1][k] = 0.f; }
#pragma unroll
            for (int j = 0; j < 4; ++j) { const int col = 4 * lane + 256 * j;
                const f32x4 y0 = v[0][j] * rstd0 * gsc[j] + shv[j], y1 = v[1][j] * rstd1 * gsc[j] + shv[j];
                *(v2u*)(XN2 + (size_t)(rowbase + 2 * ip) * D + col) = (v2u){pg8::cvt_pk_bf16(y0[0], y0[1]), pg8::cvt_pk_bf16(y0[2], y0[3])};
                *(v2u*)(XN2 + (size_t)(rowbase + 2 * ip + 1) * D + col) = (v2u){pg8::cvt_pk_bf16(y1[0], y1[1]), pg8::cvt_pk_bf16(y1[2], y1[3])};
#pragma unroll
                for (int q = 0; q < 4; ++q)
#pragma unroll
                    for (int quad = 0; quad < 5; ++quad) { const f32x4 w = wl[((quad * 4 + q) * 4 + j) * 64 + lane];
#pragma unroll
                        for (int c = 0; c < 4; ++c) { lg[0][quad * 4 + c] += y0[q] * w[c]; lg[1][quad * 4 + c] += y1[q] * w[c]; } }
                asm volatile("" ::: "memory"); }
            {
                float rv[64];
#pragma unroll
                for (int k = 0; k < 64; ++k) rv[k] = k < 40 ? lg[k / 20][k % 20] : 0.f;
#pragma unroll
                for (int hb = 32; hb >= 1; hb >>= 1) { const bool hi_ = (lane & hb) != 0;
#pragma unroll
                    for (int i = 0; i < hb; ++i) { const float keep = hi_ ? rv[i + hb] : rv[i], send = hi_ ? rv[i] : rv[i + hb]; rv[i] = keep + __shfl_xor(send, hb); } }
                rsc[wave * 64 + lane] = rv[0];
            }
            if (lane < 2) {
                const int rr = lane; const LAS float* lgr = rsc + wave * 64 + rr * 20;
                {
                    float gl[4];
#pragma unroll
                    for (int k = 0; k < 4; ++k) gl[k] = lgr[k] + b_grp[k];
                    int gs = 0; float gm = gl[0];
#pragma unroll
                    for (int k = 1; k < 4; ++k) if (gl[k] > gm) { gm = gl[k]; gs = k; }
                    float den = 0.f;
#pragma unroll
                    for (int k = 0; k < 4; ++k) den += __expf(gl[k] - gm);
                    const float g_w = 1.f / den;
                    float ev[4];
#pragma unroll
                    for (int k = 0; k < 4; ++k) ev[k] = lgr[4 + gs * 4 + k] + b_exp[gs * 4 + k];
                    int i0 = 0; float v0 = ev[0];
#pragma unroll
                    for (int k = 1; k < 4; ++k) if (ev[k] > v0) { v0 = ev[k]; i0 = k; }
                    int i1 = -1; float v1 = -INFINITY;
#pragma unroll
                    for (int k = 0; k < 4; ++k) if (k != i0 && ev[k] > v1) { v1 = ev[k]; i1 = k; }
                    if (i1 < 0) { i1 = (i0 + 1) & 3; v1 = v0; }
                    const float e1 = __expf(v1 - v0); const float w0 = g_w / (1.f + e1), w1w = g_w * e1 / (1.f + e1);
                    const int ea = gs * 4 + i0, eb = gs * 4 + i1;
                    const int ra = __hip_atomic_fetch_add(&lcnt[ea], 1, __ATOMIC_RELAXED, __HIP_MEMORY_SCOPE_WORKGROUP), rb = __hip_atomic_fetch_add(&lcnt[eb], 1, __ATOMIC_RELAXED, __HIP_MEMORY_SCOPE_WORKGROUP);
                    const int lr = (wave * 16 + 2 * ip + rr) * 2;
                    tmpe[lr] = ea; tmpe[256 + lr] = ra; tmpe[512 + lr] = __builtin_bit_cast(int, w0);
                    tmpe[lr + 1] = eb; tmpe[256 + lr + 1] = rb; tmpe[512 + lr + 1] = __builtin_bit_cast(int, w1w);
                }
            }
        }
        __syncthreads();
        if (tid < 16) lcnt[16 + tid] = (int)__hip_atomic_fetch_add(ctl + CW_CNT + tid, (unsigned)lcnt[tid], RLX_AGENT);
        __syncthreads();
        if (tid < 256) { const int e = tmpe[tid], pos = lcnt[16 + e] + tmpe[256 + tid]; const int tok = bx * 128 + (tid >> 1);
            ELIST[e * ECAP + pos] = tok * 2 + (tid & 1); EWT[e * ECAP + pos] = __builtin_bit_cast(float, tmpe[512 + tid]); }
        __syncthreads();
    }
    SEAM(6);

    if (IN(7) || IN(8)) {
        PHASE_PTRS
        LAS int* tp = (LAS int*)(lds + MOE_OFF);
        if (tid == 0) { int acc = 0;
            for (int e = 0; e < 16; ++e) { const int c = (int)__hip_atomic_load(ctl + CW_CNT + e, RLX_AGENT); tp[e] = acc; tp[17 + e] = c; acc += (c + 255) >> 8; }
            tp[16] = acc; }
        __syncthreads();
    }
    if (IN(7)) {
        PHASE_PTRS
        const LAS int* tp = (const LAS int*)(lds + MOE_OFF);
        const int nu = tp[16] * 4; const bool merged = IN(8);
        gu32* tc = merged ? (gu32*)(ctl + CW_TILE) : (gu32*)nullptr;
        { MoeOrder<true> S{tp, ELIST, G, bx, nu, (gu32*)nullptr};
          EpiSwiGLU E{Hb, tc};
          pg8::gemm_phase<EpiSwiGLU, MoeOrder<true>>(lds + RING_OFF, XN2, W13T, D, S, E); }
        if (merged) { int cs = bx + (nu % G); cs = cs >= G ? cs - G : cs;
          MoeOrder<false> S{tp, ELIST, G, cs, nu, tc};
          EpiMoeOut E{Yb, ELIST, EWT};
          pg8::gemm_phase<EpiMoeOut, MoeOrder<false>>(lds + RING_OFF, Hb, W2T, DE, S, E); }
    }
    if (IN(8) && !IN(7)) {
        PHASE_PTRS
        const LAS int* tp = (const LAS int*)(lds + MOE_OFF);
        MoeOrder<false> S{tp, ELIST, G, bx, tp[16] * 4, (gu32*)nullptr};
        EpiMoeOut E{Yb, ELIST, EWT};
        pg8::gemm_phase<EpiMoeOut, MoeOrder<false>>(lds + RING_OFF, Hb, W2T, DE, S, E);
    }
    SEAM(8);

    if (IN(9)) {
        PHASE_PTRS
        const float* norm_final = KA(20); const float* xfin = KA(0); float* outp = ({ const __attribute__((address_space(4))) Args* _p = (const __attribute__((address_space(4))) Args*)__builtin_amdgcn_kernarg_segment_ptr(); asm volatile("" : "+s"(_p)); _p->out; });
        for (int row = gw; row < T; row += NGW) {
            const int mb = row >> 11; f32x4 v[4]; float s = 0.f;
#pragma unroll
            for (int j = 0; j < 4; ++j) { const int col = 4 * lane + 256 * j; const v2u pp = *(const v2u*)((const bf16*)X1 + (size_t)row * D + col);
                const f32x4 xv = *(const f32x4*)(xfin + (size_t)row * D + col) + *(const f32x4*)(MOD + mb * 6144 + 2048 + col) * (f32x4){bflo(pp.x), bfhi(pp.x), bflo(pp.y), bfhi(pp.y)}, ga = *(const f32x4*)(MOD + mb * 6144 + 5120 + col);
                const v2u y0 = *(const v2u*)(Yb + (size_t)(2 * row) * D + col), y1 = *(const v2u*)(Yb + (size_t)(2 * row + 1) * D + col);
                const f32x4 ys = (f32x4){bflo(y0.x) + bflo(y1.x), bfhi(y0.x) + bfhi(y1.x), bflo(y0.y) + bflo(y1.y), bfhi(y0.y) + bfhi(y1.y)};
                v[j] = xv + ga * ys; s += (v[j][0] * v[j][0] + v[j][1] * v[j][1]) + (v[j][2] * v[j][2] + v[j][3] * v[j][3]); }
            const float rstd = 1.f / sqrtf(wave_sum(s) * (1.f / D) + EPS);
#pragma unroll
            for (int j = 0; j < 4; ++j) { const int col = 4 * lane + 256 * j; const f32x4 g = *(const f32x4*)(norm_final + col);
                *(f32x4*)(outp + (size_t)row * D + col) = v[j] * rstd * g; }
        }
    }
#undef IN
#undef SEAM
}

#ifndef MK_N_LAUNCHES
#define MK_N_LAUNCHES 1
#endif
constexpr int NPHASE = 10;
extern "C" void kernel_launch(void* const* d_in, const int* in_sizes, int n_in, void* d_out, int out_size, void* d_ws, size_t ws_size, hipStream_t stream) {
    static int grid = 0;
    if (grid == 0) {
        if (n_in != 21 || in_sizes[0] != T * D || out_size != T * D || ws_size < WS_END) { fprintf(stderr, "kernel_launch: unexpected shapes (n_in %d, in0 %d, out %d, ws %zu)\n", n_in, n_in > 0 ? in_sizes[0] : -1, out_size, ws_size); grid = -1; return; }
        int dev = 0, cus = 0, per_cu = 0;
        if (hipGetDevice(&dev) != hipSuccess || hipDeviceGetAttribute(&cus, hipDeviceAttributeMultiprocessorCount, dev) != hipSuccess) { grid = -1; return; }
        if (hipFuncSetAttribute((const void*)fwd_mega, hipFuncAttributeMaxDynamicSharedMemorySize, LDS_BYTES) != hipSuccess) { fprintf(stderr, "kernel_launch: hipFuncSetAttribute failed\n"); grid = -1; return; }
        if (hipOccupancyMaxActiveBlocksPerMultiprocessor(&per_cu, (const void*)fwd_mega, NTHR, LDS_BYTES) != hipSuccess || per_cu < 1) fprintf(stderr, "kernel_launch: occupancy query reports %d\n", per_cu);
        (void)hipGetLastError();
        grid = cus;
        if (grid != 256) fprintf(stderr, "kernel_launch: %d CUs (built for 256)\n", grid);
    }
    if (grid < 0) return;
    (void)hipMemsetAsync((char*)d_ws + WS_CTL, 0, CTL_ZERO_BYTES, stream);
    Args a{};
    for (int i = 0; i < 21; ++i) a.in[i] = (const float*)d_in[i];
    a.out = (float*)d_out; a.ws = (unsigned char*)d_ws;
    if (MK_N_LAUNCHES == 1) {
        a.ph_lo = 0; a.ph_hi = NPHASE; a.li = 0;
        hipLaunchKernelGGL(fwd_mega, dim3(grid), dim3(NTHR), LDS_BYTES, stream, a);
    } else {
        for (int li = 0; li < NPHASE; ++li) { a.ph_lo = li; a.ph_hi = li + 1; a.li = 0; hipLaunchKernelGGL(fwd_mega, dim3(grid), dim3(NTHR), LDS_BYTES, stream, a);
#ifdef PROBE_DUP
            if (li == PROBE_DUP) {
#ifdef PROBE_SUB
                a.pad = PROBE_SUB;
#endif
                hipLaunchKernelGGL(fwd_mega, dim3(grid), dim3(NTHR), LDS_BYTES, stream, a); a.pad = 0; }
#endif
        }
    }
}
```

```cpp
#include <hip/hip_runtime.h>
#include <cstdio>
#include <cstdint>

#define GAS __attribute__((address_space(1)))
#define LAS __attribute__((address_space(3)))
typedef unsigned short bf16;
typedef unsigned short bf16_t;
typedef unsigned v4u __attribute__((ext_vector_type(4)));
typedef unsigned v2u __attribute__((ext_vector_type(2)));
typedef float f32x4 __attribute__((ext_vector_type(4)));
typedef float f32x2 __attribute__((ext_vector_type(2)));
typedef short bf16x8 __attribute__((ext_vector_type(8)));
typedef unsigned u32x4 __attribute__((ext_vector_type(4)));
typedef GAS unsigned gu32;
typedef unsigned bu4v __attribute__((__vector_size__(16)));
#define RLX_AGENT __ATOMIC_RELAXED, __HIP_MEMORY_SCOPE_AGENT
#define LDS_WAIT() asm volatile("s_waitcnt lgkmcnt(0)" ::: "memory")
#define VM_WAIT() asm volatile("s_waitcnt vmcnt(0)" ::: "memory")

constexpr int NB = 16, SEQ = 2048, D = 1024, T = NB * SEQ, LC = 256, TC = NB * LC, MROWS = T + TC;
constexpr int GW = 64, NROWS = SEQ / GW;
constexpr int INCOLS = 4096, SEGW = 512;
constexpr int NAH = 8, NAD = 64, HGH = 4, HGD = 128;
constexpr int KTOK = SEQ + LC;
constexpr int NE = 16, DE = 512, ECAP = T;
constexpr float EPS = 1e-6f;
constexpr int NWAVES = 8, NTHR = 512;

constexpr size_t MiB = 1u << 20;
constexpr size_t WS_CTL = 0, CTL_ZERO_BYTES = 32768;
constexpr size_t WS_MOD = 1 * MiB;
constexpr size_t WS_ROPE = WS_MOD + 512 * 1024, WS_LBT = WS_MOD + 520 * 1024;
constexpr size_t WS_ELIST = 2 * MiB, WS_EWT = 4 * MiB;
constexpr size_t WS_WINT = 8 * MiB, WS_WOUTT = 16 * MiB, WS_W13T = 18 * MiB, WS_W2T = 50 * MiB;
constexpr size_t WS_XN = 66 * MiB;
constexpr size_t WS_Q = 138 * MiB, WS_K = 170 * MiB, WS_V = 206 * MiB, WS_HQ = 242 * MiB, WS_HI = 274 * MiB, WS_LF = 310 * MiB, WS_LB = 346 * MiB, WS_G = 382 * MiB;
constexpr size_t WS_OF = 414 * MiB, WS_OB = 446 * MiB, WS_QR = 478 * MiB, WS_END = 510 * MiB;
constexpr size_t WS_MIX = WS_XN, WS_XN2 = WS_XN, WS_X1 = 138 * MiB, WS_H = 274 * MiB, WS_Y = 346 * MiB;
constexpr size_t WS_X1B = 206 * MiB;
constexpr int CW_CNT = 64;
constexpr int CW_TILE = 512;
constexpr int CW_BAR = 4096;
static_assert((CW_BAR + 3456) * 4 <= (int)CTL_ZERO_BYTES, "barrier words inside the per-call memset");

constexpr int RING_OFF = 0, RING_BYTES = 131072;
constexpr int LDSCTL_OFF = RING_BYTES, MISC_OFF = LDSCTL_OFF + 320, MOE_OFF = LDSCTL_OFF + 1024;
constexpr int TAB_OFF = LDSCTL_OFF + 2048;
constexpr int LDS_BYTES = 147456;

__device__ __forceinline__ unsigned f2bf(float f) { unsigned u = __builtin_bit_cast(unsigned, f); return (u + 0x7fffu + ((u >> 16) & 1u)) >> 16; }
__device__ __forceinline__ unsigned pk2(float lo, float hi) { return f2bf(lo) | (f2bf(hi) << 16); }
__device__ __forceinline__ float bf2f(unsigned short b) { return __builtin_bit_cast(float, (unsigned)b << 16); }
__device__ __forceinline__ float bflo(unsigned u) { return __builtin_bit_cast(float, u << 16); }
__device__ __forceinline__ float bfhi(unsigned u) { return __builtin_bit_cast(float, u & 0xffff0000u); }
__device__ __forceinline__ unsigned pkh2(float lo, float hi) { _Float16 a = (_Float16)lo, b = (_Float16)hi; return (unsigned)__builtin_bit_cast(unsigned short, a) | ((unsigned)__builtin_bit_cast(unsigned short, b) << 16); }
__device__ __forceinline__ float h2f(unsigned short h) { return (float)__builtin_bit_cast(_Float16, h); }
__device__ __forceinline__ float silu_f(float v) { return v * __builtin_amdgcn_rcpf(1.f + __expf(-v)); }
__device__ __forceinline__ float wave_sum(float v) {
#pragma unroll
    for (int o = 1; o < 64; o <<= 1) v += __shfl_xor(v, o);
    return v;
}
__device__ __forceinline__ float wave_max(float v) {
#pragma unroll
    for (int o = 1; o < 64; o <<= 1) v = fmaxf(v, __shfl_xor(v, o));
    return v;
}

namespace pg8 {
constexpr int BM = 256, BK = 64, HALF = 128, HTB = HALF * BK * 2, STAGE_BYTES = 8 * HTB, NXCD = 8, WGM = 8;
__host__ __device__ __forceinline__ int lds_byte(int r, int c) { const int st = (r >> 4) * 2 + (c >> 5), rr = r & 15, cc = c & 31, ob = rr * 64 + cc * 2; return st * 1024 + (ob ^ (((ob >> 9) & 1) << 5)); }
__host__ __device__ __forceinline__ void stage_rc(int b, int& R, int& C) { const int st = b / 1024, sb = b % 1024, swz = sb ^ (((sb >> 9) & 1) << 5); R = (st >> 1) * 16 + swz / 64; C = (st & 1) * 32 + (swz % 64) / 2; }
__host__ __device__ __forceinline__ int perm32(int rho) { const int n = rho >> 4, i = rho & 15; return 8 * (i >> 2) + 4 * n + (i & 3); }

struct Unit { int pm, pn, e, tm, cnt; };

typedef float f32x2_t __attribute__((ext_vector_type(2))); typedef __bf16 bf16x2_t __attribute__((ext_vector_type(2)));
__device__ __forceinline__ unsigned cvt_pk_bf16(float lo, float hi) { f32x2_t v = {lo, hi}; bf16x2_t b = __builtin_convertvector(v, bf16x2_t); return __builtin_bit_cast(unsigned, b); }

struct DenseOrder {
    static constexpr bool GATHER = false;
    int nM, nN, nwg, G, c; bool pf;
    __device__ void init(int M, int N, int G_, int c_, bool pf_ = false) { nM = M / BM; nN = N / BM; nwg = nM * nN; G = G_; c = c_; pf = pf_; }
    __device__ bool next(int i, Unit& u) const {
        const long L = (long)i * G + c; if (L >= nwg) return false;
        int wgid = (int)L; { const int q = nwg / NXCD, r = nwg % NXCD, xcd = wgid % NXCD, off = wgid / NXCD; wgid = (xcd < r ? xcd * (q + 1) : r * (q + 1) + (xcd - r) * q) + off; }
        const int nig = WGM * nN, gid = wgid / nig, fm = gid * WGM, gsz = (nM - fm) < WGM ? (nM - fm) : WGM;
        u.pm = fm + ((wgid % nig) % gsz); u.pn = (wgid % nig) / gsz; u.e = 0; u.tm = 0; u.cnt = 0; return true;
    }
    __device__ __forceinline__ int a_row0(const Unit& u) const { return u.pm * BM; }
    __device__ __forceinline__ int a_row(const Unit& u, int r) const { return u.pm * BM + r; }
    __device__ __forceinline__ int b_row0(const Unit& u) const { return u.pn * BM; }
    __device__ __forceinline__ bool perm(const Unit&) const { return pf; }
    __device__ __forceinline__ void a_ready(const Unit&, int) const {}
};

template <class Epi, class Sched>
__device__ __forceinline__ void gemm_phase(LAS unsigned char* lds, const bf16_t* Aptr, const bf16_t* Btptr, const int K, const Sched& S, const Epi& E) {
    const int tid = threadIdx.x, wid = __builtin_amdgcn_readfirstlane(tid >> 6), lane = tid & 63, wr = wid >> 2, wc = wid & 3, fr = lane & 15, fq = lane >> 4;
    const int nt = K / BK;
    int sR[2], sC[2];
    unsigned voffA[2], voffBn[2], voffBp[2], voffB[2], nvB[2];
#pragma unroll
    for (int i = 0; i < 2; ++i) { int R, C; stage_rc(tid * 16 + i * 8192, R, C); const int Rb = (R & ~31) + perm32(R & 31);
        sR[i] = R; sC[i] = C; voffA[i] = (unsigned)(R * K + C) * 2u; voffBn[i] = (unsigned)(R * K + C) * 2u; voffBp[i] = (unsigned)(Rb * K + C) * 2u; }
    const size_t kstep = (size_t)(BK * 2);
    const size_t hstep = (size_t)HALF * K * 2;
    const size_t rowb = (size_t)K * 2;
    const unsigned ldsw = (unsigned)wid * 1024u;
    const int aoff = lds_byte(wr * 64 + fr, fq * 8), boff = lds_byte(wc * 32 + fr, fq * 8);
    const char* Ab = (const char*)Aptr;
#define PG8_SA(b, h) (((b) * 2 + (h)) * HTB)
#define PG8_SB(b, h) ((4 + (b) * 2 + (h)) * HTB)
#define PG8_STAGE(bufoff, gbase, voff) do { _Pragma("unroll") for (int _i = 0; _i < 2; ++_i) \
        __builtin_amdgcn_global_load_lds((const unsigned*)((const char*)(gbase) + (voff)[_i]), (LAS unsigned*)(lds + (bufoff) + ldsw + _i * 8192), 16, 0, 0); } while (0)
#define PG8_LDA(dst, b, h) do { _Pragma("unroll") for (int m = 0; m < 4; ++m) _Pragma("unroll") for (int k = 0; k < 2; ++k) dst[m][k] = *(const LAS bf16x8*)(lds + PG8_SA(b, h) + aoff + m * 2048 + k * 1024); } while (0)
#define PG8_LDB(dst, b, h) do { _Pragma("unroll") for (int n = 0; n < 2; ++n) _Pragma("unroll") for (int k = 0; k < 2; ++k) dst[n][k] = *(const LAS bf16x8*)(lds + PG8_SB(b, h) + boff + n * 2048 + k * 1024); } while (0)
#define PG8_MMA(ai, bj, At, Bt) do { __builtin_amdgcn_s_setprio(1); _Pragma("unroll") for (int m = 0; m < 4; ++m) _Pragma("unroll") for (int n = 0; n < 2; ++n) _Pragma("unroll") for (int k = 0; k < 2; ++k) \
        acc[ai][bj][m][n] = __builtin_amdgcn_mfma_f32_16x16x32_bf16(Bt[n][k], At[m][k], acc[ai][bj][m][n], 0, 0, 0); __builtin_amdgcn_s_setprio(0); } while (0)
#define PG8_WAIT_V(n) asm volatile("s_waitcnt vmcnt(" #n ")" ::: "memory")
#define PG8_WAIT_L(n) asm volatile("s_waitcnt lgkmcnt(" #n ")" ::: "memory")
#define PG8_BAR __builtin_amdgcn_s_barrier()
#define PG8_SCHED __builtin_amdgcn_sched_barrier(0)
    Unit cur, nxt; int ui = 0;
    if (!S.next(0, cur)) return;
    f32x4 acc[2][2][4][2];
#pragma unroll
    for (int a = 0; a < 2; ++a)
#pragma unroll
        for (int b = 0; b < 2; ++b)
#pragma unroll
            for (int m = 0; m < 4; ++m)
#pragma unroll
                for (int n = 0; n < 2; ++n) acc[a][b][m][n] = (f32x4){0.f, 0.f, 0.f, 0.f};
    bf16x8 At[4][2], B0[2][2], B1[2][2];
    const char* cA = Ab; unsigned cG[2][2];
    if constexpr (Sched::GATHER) {
#pragma unroll
        for (int h = 0; h < 2; ++h)
#pragma unroll
            for (int i = 0; i < 2; ++i) cG[h][i] = (unsigned)((size_t)S.a_row(cur, h * HALF + sR[i]) * rowb) + (unsigned)sC[i] * 2u;
    } else { cA = Ab + (ptrdiff_t)S.a_row0(cur) * (ptrdiff_t)rowb; cG[0][0] = cG[0][1] = cG[1][0] = cG[1][1] = 0u; }
    S.a_ready(cur, wid);
    const char* cB = (const char*)Btptr + (ptrdiff_t)S.b_row0(cur) * (ptrdiff_t)rowb;
    { const bool pc = S.perm(cur); voffB[0] = pc ? voffBp[0] : voffBn[0]; voffB[1] = pc ? voffBp[1] : voffBn[1]; }
#define PG8_STAGEA(bufoff, h, dbase, goffs, kb) do { if constexpr (Sched::GATHER) { PG8_STAGE(bufoff, Ab + (kb), (goffs)[h]); } else { PG8_STAGE(bufoff, (dbase) + (h) * hstep + (kb), voffA); } } while (0)
    PG8_STAGE(PG8_SB(0, 0), cB, voffB); PG8_STAGE(PG8_SB(0, 1), cB + hstep, voffB); PG8_STAGEA(PG8_SA(0, 0), 0, cA, cG, 0); PG8_STAGEA(PG8_SA(0, 1), 1, cA, cG, 0);
    if (wr == 1) PG8_BAR;
    PG8_WAIT_V(2); PG8_BAR;
    PG8_STAGE(PG8_SB(1, 0), cB + kstep, voffB); PG8_STAGEA(PG8_SA(1, 0), 0, cA, cG, kstep); PG8_STAGE(PG8_SB(1, 1), cB + hstep + kstep, voffB);
    PG8_WAIT_V(6); PG8_BAR;
    for (;;) {
        const bool has_next = S.next(ui + 1, nxt);
        const char* nA = cA; const char* nB = cB; unsigned nG[2][2];
#pragma unroll
        for (int h = 0; h < 2; ++h)
#pragma unroll
            for (int i = 0; i < 2; ++i) nG[h][i] = cG[h][i];
        nvB[0] = voffB[0]; nvB[1] = voffB[1];
        if (has_next) {
            nB = (const char*)Btptr + (ptrdiff_t)S.b_row0(nxt) * (ptrdiff_t)rowb;
            { const bool pn_ = S.perm(nxt); nvB[0] = pn_ ? voffBp[0] : voffBn[0]; nvB[1] = pn_ ? voffBp[1] : voffBn[1]; }
            if constexpr (Sched::GATHER) {
#pragma unroll
                for (int h = 0; h < 2; ++h)
#pragma unroll
                    for (int i = 0; i < 2; ++i) nG[h][i] = (unsigned)((size_t)S.a_row(nxt, h * HALF + sR[i]) * rowb) + (unsigned)sC[i] * 2u;
            } else nA = Ab + (ptrdiff_t)S.a_row0(nxt) * (ptrdiff_t)rowb;
        }
        for (int t = 0; t < nt; t += 2) {
            const bool last = (t == nt - 2);
            if (last && has_next) S.a_ready(nxt, wid);
            const size_t kb1 = (size_t)(t + 1) * kstep;
            const size_t kb2 = last ? 0 : (size_t)(t + 2) * kstep, kb3 = kb2 + kstep;
            const char* a2 = last ? nA : cA; const char* b2 = last ? nB : cB + (size_t)(t + 2) * kstep; const char* b3 = b2 + kstep;
            unsigned vB2[2]; vB2[0] = last ? nvB[0] : voffB[0]; vB2[1] = last ? nvB[1] : voffB[1];
            unsigned g2[2][2];
#pragma unroll
            for (int h = 0; h < 2; ++h)
#pragma unroll
                for (int i = 0; i < 2; ++i) g2[h][i] = last ? nG[h][i] : cG[h][i];
            PG8_LDB(B0, 0, 0); PG8_LDB(B1, 0, 1); PG8_SCHED; PG8_LDA(At, 0, 0); PG8_STAGEA(PG8_SA(1, 1), 1, cA, cG, kb1);
            PG8_WAIT_V(8); PG8_WAIT_L(0); PG8_BAR; PG8_MMA(0, 0, At, B0); PG8_MMA(0, 1, At, B1); PG8_BAR; PG8_SCHED;
            PG8_LDA(At, 0, 1); PG8_STAGE(PG8_SB(0, 0), b2, vB2); PG8_STAGE(PG8_SB(0, 1), b2 + hstep, vB2); PG8_STAGEA(PG8_SA(0, 0), 0, a2, g2, kb2);
            PG8_WAIT_V(8); PG8_WAIT_L(0); PG8_BAR; PG8_MMA(1, 0, At, B0); PG8_MMA(1, 1, At, B1); PG8_BAR; PG8_SCHED;
            PG8_LDB(B0, 1, 0); PG8_LDB(B1, 1, 1); PG8_SCHED; PG8_LDA(At, 1, 0); PG8_STAGEA(PG8_SA(0, 1), 1, a2, g2, kb2);
            PG8_WAIT_V(8); PG8_WAIT_L(0); PG8_BAR; PG8_MMA(0, 0, At, B0); PG8_MMA(0, 1, At, B1); PG8_BAR; PG8_SCHED;
            PG8_LDA(At, 1, 1); PG8_STAGE(PG8_SB(1, 0), b3, vB2); PG8_STAGE(PG8_SB(1, 1), b3 + hstep, vB2); PG8_STAGEA(PG8_SA(1, 0), 0, a2, g2, kb3);
            PG8_WAIT_V(8); PG8_WAIT_L(0); PG8_BAR; PG8_MMA(1, 0, At, B0); PG8_MMA(1, 1, At, B1); PG8_BAR; PG8_SCHED;
        }
        if (wr == 0) PG8_BAR;
        E(acc, cur, wr, wc, fr, fq);
        if (!has_next) break;
#pragma unroll
        for (int a = 0; a < 2; ++a)
#pragma unroll
            for (int b = 0; b < 2; ++b)
#pragma unroll
                for (int m = 0; m < 4; ++m)
#pragma unroll
                    for (int n = 0; n < 2; ++n) acc[a][b][m][n] = (f32x4){0.f, 0.f, 0.f, 0.f};
        cur = nxt; cA = nA; cB = nB; ++ui; voffB[0] = nvB[0]; voffB[1] = nvB[1];
#pragma unroll
        for (int h = 0; h < 2; ++h)
#pragma unroll
            for (int i = 0; i < 2; ++i) cG[h][i] = nG[h][i];
        if (wr == 1) PG8_BAR;
    }
    PG8_WAIT_V(0);
    PG8_BAR;
#undef PG8_SA
#undef PG8_SB
#undef PG8_STAGE
#undef PG8_STAGEA
#undef PG8_LDA
#undef PG8_LDB
#undef PG8_MMA
#undef PG8_WAIT_V
#undef PG8_WAIT_L
#undef PG8_BAR
#undef PG8_SCHED
}
}

#define XB_TMO      128
#define XB_XCNT(j)  (256  + 64 * (j))
#define XB_XSUB(j)  (1280 + 64 * (j))
#define XB_XGEN(j)  (2304 + 64 * (j))
#define XB_TOP      3328
#define XB_TOPGEN   3392
#define XCD_BAR_WORDS 3456
#define XB_SPIN_CAP (1u << 18)
__device__ __forceinline__ unsigned xb_ld(unsigned* p)              { return __hip_atomic_load(p, __ATOMIC_RELAXED, __HIP_MEMORY_SCOPE_AGENT); }
__device__ __forceinline__ unsigned xb_add(unsigned* p, unsigned v) { return __hip_atomic_fetch_add(p, v, __ATOMIC_RELAXED, __HIP_MEMORY_SCOPE_AGENT); }
__device__ __forceinline__ unsigned xb_xcc_id() { return (unsigned)__builtin_amdgcn_s_getreg((3 << 11) | 20) & 0xFu; }
#define XB_SPIN(cond, bar) do { unsigned _sp = 0; while (cond) { __builtin_amdgcn_s_sleep(1); \
    if ((++_sp & 255u) == 0u) { if (xb_ld(&(bar)[XB_TMO])) break; if (_sp > XB_SPIN_CAP) { atomicAdd(&(bar)[XB_TMO], 1u); break; } } } } while (0)
struct XcdBarrier { unsigned* bar; unsigned x; volatile LAS unsigned* st; };
__device__ __forceinline__ XcdBarrier xcd_barrier_post(unsigned* bar, volatile LAS unsigned* st) {
    XcdBarrier b; b.bar = bar; b.x = xb_xcc_id(); b.st = st;
    if (threadIdx.x == 0) (void)xb_add(&bar[XB_XCNT(b.x)], 1u);
    return b;
}
__device__ __forceinline__ void xcd_barrier_complete(unsigned* bar, unsigned x, unsigned& nloc, unsigned& nx) {
    const unsigned G = gridDim.x * gridDim.y * gridDim.z;
    unsigned sum, cnt, mine, sp = 0u;
    for (;;) {
        sum = 0u; cnt = 0u; mine = 0u;
#pragma unroll
        for (unsigned j = 0; j < 16; ++j) { const unsigned c = xb_ld(&bar[XB_XCNT(j)]); sum += c; cnt += (c > 0u) ? 1u : 0u; mine = (j == x) ? c : mine; }
        if (sum == G) break;
        __builtin_amdgcn_s_sleep(1);
        if ((++sp & 255u) == 0u) { if (xb_ld(&bar[XB_TMO])) break; if (sp > XB_SPIN_CAP) { atomicAdd(&bar[XB_TMO], 1u); break; } }
    }
    nloc = mine > 0u ? mine : 1u; nx = cnt > 0u ? cnt : 1u;
}
__device__ __forceinline__ void xcd_barrier(const XcdBarrier& b) {
    asm volatile("s_waitcnt vmcnt(0)" ::: "memory");
    __syncthreads();
    if (threadIdx.x == 0) {
        unsigned* bar = b.bar;
        __builtin_amdgcn_s_waitcnt(0);
        unsigned nloc = b.st[0], nx = b.st[1];
        if (nloc == 0u) { xcd_barrier_complete(bar, b.x, nloc, nx); b.st[0] = nloc; b.st[1] = nx; }
        const unsigned old = xb_add(&bar[XB_XSUB(b.x)], 1u);
        const unsigned gen = old / nloc;
        if (old + 1u == (gen + 1u) * nloc) {
            __builtin_amdgcn_fence(__ATOMIC_RELEASE, "agent");
            asm volatile("s_waitcnt vmcnt(0)" ::: "memory");
            const unsigned og = xb_add(&bar[XB_TOP], 1u);
            const unsigned tg = og / nx;
            if (og + 1u == (tg + 1u) * nx) xb_add(&bar[XB_TOPGEN], 1u);
            else XB_SPIN(xb_ld(&bar[XB_TOPGEN]) == tg, bar);
            __builtin_amdgcn_fence(__ATOMIC_ACQUIRE, "agent");
            xb_add(&bar[XB_XGEN(b.x)], 1u);
            asm volatile("s_waitcnt vmcnt(0)" ::: "memory");
        } else {
            XB_SPIN(xb_ld(&bar[XB_XGEN(b.x)]) == gen, bar);
            __builtin_amdgcn_fence(__ATOMIC_ACQUIRE, "agent");
            asm volatile("s_waitcnt vmcnt(0)" ::: "memory");
        }
    }
    __syncthreads();
}

using pg8::Unit;
typedef f32x4 acc_t[2][2][4][2];

struct EpiProj {
    static constexpr bool PERM = false;
    unsigned char* ws; const LAS float* ropeL; const LAS float* lbtL; int skip;
    template <int KIND> __device__ __forceinline__ void swapped(const acc_t& acc, const Unit& u, int wr, int wc, int fr, int fq, bool latent) const {
        constexpr size_t so2 = KIND == 0 ? WS_V : KIND == 1 ? WS_HQ : KIND == 2 ? WS_HI : KIND == 3 ? WS_LF : WS_LB;
        bf16* dT = (bf16*)(ws + so2);
        constexpr int ldt = (KIND == 1) ? T : MROWS;
        const int wrow0 = (u.pn & 1) * 256 + wr * 64 + fr, tcol0 = u.pm * 256 + wc * 32 + 8 * fq;
        const LAS float* lbt = lbtL + (KIND == 4 ? 512 : 0);
#pragma unroll
        for (int ai = 0; ai < 2; ++ai)
#pragma unroll
            for (int m = 0; m < 4; ++m) { const int wrow = wrow0 + ai * 128 + m * 16; float lb = 0.f; if (KIND >= 3) lb = lbt[wrow];
#pragma unroll
                for (int bj = 0; bj < 2; ++bj) { float x[8]; u32x4 w;
#pragma unroll
                    for (int j = 0; j < 4; ++j) { x[j] = acc[ai][bj][m][0][j]; x[4 + j] = acc[ai][bj][m][1][j]; }
                    if (KIND >= 3) {
#pragma unroll
                        for (int j = 0; j < 8; ++j) { const float sg = __builtin_amdgcn_rcpf(1.f + __expf(-x[j])); x[j] = __log2f(lb + (1.f - lb) * sg); }
                        w = (u32x4){pkh2(x[0], x[1]), pkh2(x[2], x[3]), pkh2(x[4], x[5]), pkh2(x[6], x[7])}; }
                    else { if (KIND == 1) {
#pragma unroll
                            for (int j = 0; j < 8; ++j) x[j] = silu_f(x[j]); }
                        w = (u32x4){pg8::cvt_pk_bf16(x[0], x[1]), pg8::cvt_pk_bf16(x[2], x[3]), pg8::cvt_pk_bf16(x[4], x[5]), pg8::cvt_pk_bf16(x[6], x[7])}; }
                    size_t off = (size_t)wrow * ldt + tcol0 + bj * 128;
                    if (KIND == 0) { const int tc = tcol0 + bj * 128, bb_ = latent ? (tc >> 11) : ((tc - T) >> 8), tl = latent ? (tc & (SEQ - 1)) : (KTOK - LC + ((tc - T) & (LC - 1)));
                        off = ((((size_t)(bb_ * NAH + (wrow >> 6)) * (KTOK / 64) + (tl >> 6)) * NAD + (wrow & 63)) * 64) + (tl & 63); }
                    __builtin_nontemporal_store((u32x4)(w), (u32x4*)(dT + off)); } }
    }
    template <int SEG, bool LAT> __device__ __forceinline__ void rope(const acc_t& acc, int row0, int lcp, int wc, int fq) const {
        bf16* dK = (bf16*)(ws + (SEG == 0 ? WS_QR : WS_K)); bf16* dQ = (bf16*)(ws + WS_Q);
#pragma unroll
        for (int ai = 0; ai < 2; ++ai)
#pragma unroll
            for (int m = 0; m < 4; ++m) { const int row = row0 + ai * 128 + m * 16, sq = row & (SEQ - 1); const int pos = (wc & 1) ? (sq & 63) : (sq >> 6);
                f32x4 cs0 = (f32x4){1.f, 0.f, 1.f, 0.f}, cs1 = cs0;
                if (LAT) { cs0 = *(const LAS f32x4*)(ropeL + (pos * 16 + 4 * fq) * 2); cs1 = *(const LAS f32x4*)(ropeL + (pos * 16 + 4 * fq) * 2 + 4); }
                const float cc[4] = {cs0[0], cs0[2], cs1[0], cs1[2]}, sn[4] = {cs0[1], cs0[3], cs1[1], cs1[3]};
#pragma unroll
                for (int bj = 0; bj < 2; ++bj) { const f32x4 x1 = acc[ai][bj][m][0], x2 = acc[ai][bj][m][1]; float o1[4], o2[4];
#pragma unroll
                    for (int j = 0; j < 4; ++j) { o1[j] = LAT ? x1[j] * cc[j] - x2[j] * sn[j] : x1[j]; o2[j] = LAT ? x2[j] * cc[j] + x1[j] * sn[j] : x2[j]; }
                    size_t off = (size_t)row * SEGW + lcp + bj * 128;
                    if (SEG == 0) __builtin_nontemporal_store((u32x4)((u32x4){pg8::cvt_pk_bf16(x1[0], x1[1]), pg8::cvt_pk_bf16(x1[2], x1[3]), pg8::cvt_pk_bf16(x2[0], x2[1]), pg8::cvt_pk_bf16(x2[2], x2[3])}), (u32x4*)(dQ + off));
                    else { const int cf = lcp + bj * 128, bb_ = LAT ? (row >> 11) : ((row - T) >> 8), tl = LAT ? sq : (KTOK - LC + ((row - T) & (LC - 1)));
                        off = ((size_t)(bb_ * NAH + (cf >> 6)) * KTOK + tl) * NAD + (cf & 63); }
                    __builtin_nontemporal_store((u32x4)((u32x4){pg8::cvt_pk_bf16(o1[0], o1[1]), pg8::cvt_pk_bf16(o1[2], o1[3]), pg8::cvt_pk_bf16(o2[0], o2[1]), pg8::cvt_pk_bf16(o2[2], o2[3])}), (u32x4*)(dK + off)); } }
    }
    __device__ __forceinline__ void operator()(const acc_t& acc, const Unit& u, int wr, int wc, int fr, int fq) const {
        const int seg = u.pn >> 1; const bool latent = u.pm < (T / 256);
        if (skip) return;
        if (!latent && (seg == 0 || seg == 3 || seg == 7)) return;
        if (u.e) {
            if (seg == 2) swapped<0>(acc, u, wr, wc, fr, fq, latent);
            else if (seg == 3) swapped<1>(acc, u, wr, wc, fr, fq, latent);
            else if (seg == 4) swapped<2>(acc, u, wr, wc, fr, fq, latent);
            else if (seg == 5) swapped<3>(acc, u, wr, wc, fr, fq, latent);
            else swapped<4>(acc, u, wr, wc, fr, fq, latent);
            return;
        }
        const int row0 = u.pm * 256 + wr * 64 + fr;
        const int lcp = (u.pn & 1) * 256 + wc * 32 + 8 * fq;
        if (seg <= 1) {
            if (seg == 0) rope<0, true>(acc, row0, lcp, wc, fq);
            else if (latent) rope<1, true>(acc, row0, lcp, wc, fq);
            else rope<1, false>(acc, row0, lcp, wc, fq);
            return;
        }
        bf16* dG = (bf16*)(ws + WS_G);
#pragma unroll
        for (int ai = 0; ai < 2; ++ai)
#pragma unroll
            for (int m = 0; m < 4; ++m) { const int row = row0 + ai * 128 + m * 16;
#pragma unroll
                for (int bj = 0; bj < 2; ++bj) { float x[8];
#pragma unroll
                    for (int j = 0; j < 4; ++j) { x[j] = silu_f(acc[ai][bj][m][0][j]); x[4 + j] = silu_f(acc[ai][bj][m][1][j]); }
                    __builtin_nontemporal_store((u32x4)((u32x4){pg8::cvt_pk_bf16(x[0], x[1]), pg8::cvt_pk_bf16(x[2], x[3]), pg8::cvt_pk_bf16(x[4], x[5]), pg8::cvt_pk_bf16(x[6], x[7])}), (u32x4*)(dG + (size_t)row * SEGW + lcp + bj * 128)); } }
    }
};
struct EpiP {
    static constexpr bool PERM = true;
    bf16* P;
    __device__ __forceinline__ void operator()(const acc_t& acc, const Unit& u, int wr, int wc, int fr, int fq) const {
        const int col0 = u.pn * 256 + wc * 32 + 8 * fq; const int row0 = u.pm * 256 + wr * 64 + fr;
#pragma unroll
        for (int ai = 0; ai < 2; ++ai)
#pragma unroll
            for (int m = 0; m < 4; ++m)
#pragma unroll
                for (int bj = 0; bj < 2; ++bj) { const f32x4 v0 = acc[ai][bj][m][0], v1 = acc[ai][bj][m][1];
                    *(u32x4*)(P + (size_t)(row0 + ai * 128 + m * 16) * D + col0 + bj * 128) = (u32x4){pg8::cvt_pk_bf16(v0[0], v0[1]), pg8::cvt_pk_bf16(v0[2], v0[3]), pg8::cvt_pk_bf16(v1[0], v1[1]), pg8::cvt_pk_bf16(v1[2], v1[3])}; }
    }
};
struct EpiSwiGLU {
    static constexpr bool PERM = true;
    bf16* H; gu32* tcnt;
    __device__ __forceinline__ void operator()(const acc_t& acc, const Unit& u, int wr, int wc, int fr, int fq) const {
        const int hc = u.pn * 128 + wc * 32 + 8 * fq; const int row0 = u.pm * 256 + wr * 64 + fr;
        const __amdgpu_buffer_rsrc_t hr = __builtin_amdgcn_make_buffer_rsrc((void*)H, (short)0, 0x7ffffff0, 0x00020000);
#pragma unroll
        for (int ai = 0; ai < 2; ++ai)
#pragma unroll
            for (int m = 0; m < 4; ++m) { float h[8];
#pragma unroll
                for (int n = 0; n < 2; ++n)
#pragma unroll
                    for (int j = 0; j < 4; ++j) h[n * 4 + j] = silu_f(acc[ai][0][m][n][j]) * acc[ai][1][m][n][j];
                u32x4 w; w.x = pg8::cvt_pk_bf16(h[0], h[1]); w.y = pg8::cvt_pk_bf16(h[2], h[3]); w.z = pg8::cvt_pk_bf16(h[4], h[5]); w.w = pg8::cvt_pk_bf16(h[6], h[7]);
                const unsigned off = (unsigned)(((size_t)(row0 + ai * 128 + m * 16) * DE + hc) * 2);
                __builtin_amdgcn_raw_buffer_store_b128(__builtin_bit_cast(bu4v, w), hr, (int)off, 0, 16); }
        if (tcnt) { asm volatile("s_waitcnt vmcnt(0)" ::: "memory");
            if (fr == 0 && fq == 0) (void)__hip_atomic_fetch_add(tcnt + u.pm, 1u, RLX_AGENT); }
    }
};
struct EpiMoeOut {
    static constexpr bool PERM = true;
    bf16* Y; const int* elist; const float* ewt;
    __device__ __forceinline__ void operator()(const acc_t& acc, const Unit& u, int wr, int wc, int fr, int fq) const {
        const int col0 = u.pn * 256 + wc * 32 + 8 * fq;
#pragma unroll
        for (int ai = 0; ai < 2; ++ai)
#pragma unroll
            for (int m = 0; m < 4; ++m) { const int rank = u.tm * 256 + ai * 128 + wr * 64 + m * 16 + fr;
                if (rank < u.cnt) { const int tk = elist[u.e * ECAP + rank]; const float w = ewt[u.e * ECAP + rank];
#pragma unroll
                    for (int bj = 0; bj < 2; ++bj) { const f32x4 v0 = acc[ai][bj][m][0] * w, v1 = acc[ai][bj][m][1] * w; u32x4 o;
                        o.x = pg8::cvt_pk_bf16(v0[0], v0[1]); o.y = pg8::cvt_pk_bf16(v0[2], v0[3]); o.z = pg8::cvt_pk_bf16(v1[0], v1[1]); o.w = pg8::cvt_pk_bf16(v1[2], v1[3]);
                        *(u32x4*)(Y + (size_t)tk * D + col0 + bj * 128) = o; } } }
    }
};
template <bool GATHER_> struct MoeOrder {
    static constexpr bool GATHER = GATHER_;
    const LAS int* tp; const int* elist; int G, c, nwg; gu32* tcnt;
    int rem = -1;
    __device__ bool next(int i, Unit& u) const {
        long L;
        if (rem < 0) L = (long)i * G + c;
        else { const int Lw = G - rem; L = c >= rem ? (i < 2 ? (long)(c - rem) + (long)i * Lw : 2L * Lw + c + (long)(i - 2) * G) : 2L * Lw + c + (long)i * G; }
        if (L >= nwg) return false;
        int wgid = (int)L; { const int q = nwg / 8, r = nwg % 8, xcd = wgid % 8, off = wgid / 8; wgid = (xcd < r ? xcd * (q + 1) : r * (q + 1) + (xcd - r) * q) + off; }
        const int gt = wgid >> 2; int e = 0;
#pragma unroll
        for (int k = 1; k < 16; ++k) e = (gt >= tp[k]) ? k : e;
        u.pm = gt; u.pn = wgid & 3; u.e = e; u.tm = gt - tp[e]; u.cnt = tp[17 + e]; return true;
    }
    __device__ __forceinline__ int a_row0(const Unit& u) const { return u.pm * 256; }
    __device__ __forceinline__ int a_row(const Unit& u, int r) const {
        if constexpr (GATHER_) { int rank = u.tm * 256 + r; rank = rank < u.cnt ? rank : u.cnt - 1; return elist[u.e * ECAP + rank] >> 1; }
        else return u.pm * 256 + r;
    }
    __device__ __forceinline__ int b_row0(const Unit& u) const { return u.e * 1024 + u.pn * 256; }
    __device__ __forceinline__ bool perm(const Unit&) const { return true; }
    __device__ __forceinline__ void a_ready(const Unit& u, int wid) const {
        if constexpr (!GATHER_) {
            if (tcnt) {
                if (wid == 0) { unsigned sp = 0; while (__hip_atomic_load(tcnt + u.pm, RLX_AGENT) < 32u) { __builtin_amdgcn_s_sleep(2); if (++sp > (1u << 20)) break; }
                    __builtin_amdgcn_fence(__ATOMIC_ACQUIRE, "agent"); asm volatile("s_waitcnt vmcnt(0)" ::: "memory"); }
                __builtin_amdgcn_s_barrier();
            }
        }
    }
};


constexpr int SWMASK = 0x7C;
constexpr int W_REL_XN = (int)(((long long)WS_WINT - (long long)WS_XN) / 2048);
struct ProjOrder {
    static constexpr bool GATHER = false;
    pg8::DenseOrder d;
    __device__ void init(int G_, int c_) { d.init(MROWS, INCOLS, G_, c_); }
    __device__ bool next(int i, Unit& u) const { if (!d.next(i, u)) return false; u.e = (SWMASK >> (u.pn >> 1)) & 1; return true; }
    __device__ __forceinline__ int a_row0(const Unit& u) const { return u.e ? W_REL_XN + u.pn * 256 : u.pm * 256; }
    __device__ __forceinline__ int a_row(const Unit& u, int r) const { return a_row0(u) + r; }
    __device__ __forceinline__ int b_row0(const Unit& u) const { return u.e ? -W_REL_XN + u.pm * 256 : u.pn * 256; }
    __device__ __forceinline__ bool perm(const Unit& u) const { return (u.pn >> 1) >= 2; }
    __device__ __forceinline__ void a_ready(const Unit&, int) const {}
};


__device__ __forceinline__ bf16x8 pack8(const f32x4& a, const f32x4& b) {
    u32x4 w; w.x = pg8::cvt_pk_bf16(a[0], a[1]); w.y = pg8::cvt_pk_bf16(a[2], a[3]); w.z = pg8::cvt_pk_bf16(b[0], b[1]); w.w = pg8::cvt_pk_bf16(b[2], b[3]);
    return __builtin_bit_cast(bf16x8, w);
}
typedef unsigned bu4 __attribute__((__vector_size__(16)));
__device__ __forceinline__ bf16x8 bload16(__amdgpu_buffer_rsrc_t r, unsigned voff, unsigned soff) { return __builtin_bit_cast(bf16x8, __builtin_amdgcn_raw_buffer_load_b128(r, (int)voff, (int)soff, 0)); }
#define NA_SB() __builtin_amdgcn_sched_barrier(0)
__device__ __forceinline__ bf16x8 sel8(bool c, const bf16x8 a, const bf16x8 b) { const u32x4 x = __builtin_bit_cast(u32x4, a), y = __builtin_bit_cast(u32x4, b); u32x4 r;
    r.x = c ? x.x : y.x; r.y = c ? x.y : y.y; r.z = c ? x.z : y.z; r.w = c ? x.w : y.w; return __builtin_bit_cast(bf16x8, r); }
constexpr int NA_CTXK = 0, NA_CTXV = 32768, NA_RING = 65536, NA_SLOT = 16384;
#define NA_BAR() do { asm volatile("s_waitcnt lgkmcnt(0)" ::: "memory"); __builtin_amdgcn_s_barrier(); asm volatile("" ::: "memory"); } while (0)
struct NaState { f32x4 o[2][4]; float mref[2], lsum[2]; };
template <bool LOCAL>
__device__ __forceinline__ void na_step(NaState& st, const bf16x8 (&q)[2][2], const LAS unsigned char* kb, const LAS unsigned char* vb, unsigned vsw, const LAS float* bpi,
                                        bool setref, int qi, int g, int jb) {
    constexpr float SC = 0.125f * 1.44269504f; const float NEG = -1e30f;
    const int rg = qi >> 2;
    const unsigned kx = (unsigned)((rg << 1) | ((qi >> 1) & 1)), vx = (unsigned)((qi >> 1) & 7);
    const unsigned ka0 = (unsigned)(8 * rg + (qi & 3)) * 128u + (((unsigned)g ^ kx) << 4), ka1 = ka0 ^ 64u;
    const unsigned va = (unsigned)qi * 128u + (((unsigned)g ^ vx) << 4);
#pragma unroll
    for (int j = 0; j < 2; ++j) {
        const int jj = jb + j; const int P0 = (jj == 0) ? 0 : (jj == 1) ? 1 : (jj == 2) ? 3 : 4;
        const int pk = P0 + ((rg - P0) & 3), pv = P0 + ((g - P0) & 3);
        const unsigned kh = LOCAL ? (unsigned)(pk >> 2) * 4096u : 0u, vh = LOCAL ? (unsigned)(pv >> 2) * 64u : 0u;
        const bf16x8 a00 = *(const LAS bf16x8*)(kb + (ka0 + kh)), a01 = *(const LAS bf16x8*)(kb + (ka1 + kh)), a10 = *(const LAS bf16x8*)(kb + 512 + (ka0 + kh)), a11 = *(const LAS bf16x8*)(kb + 512 + (ka1 + kh));
        bf16x8 vf[4]; const unsigned vaj = (va ^ vsw) ^ vh;
#pragma unroll
        for (int dt = 0; dt < 4; ++dt) vf[dt] = *(const LAS bf16x8*)(vb + dt * 2048 + vaj);
        f32x4 s0 = __builtin_amdgcn_mfma_f32_16x16x32_bf16(a00, q[j][0], (f32x4){0.f, 0.f, 0.f, 0.f}, 0, 0, 0); s0 = __builtin_amdgcn_mfma_f32_16x16x32_bf16(a01, q[j][1], s0, 0, 0, 0);
        f32x4 s1 = __builtin_amdgcn_mfma_f32_16x16x32_bf16(a10, q[j][0], (f32x4){0.f, 0.f, 0.f, 0.f}, 0, 0, 0); s1 = __builtin_amdgcn_mfma_f32_16x16x32_bf16(a11, q[j][1], s1, 0, 0, 0);
        if (LOCAL) {
            const int bbj = 8 * pv - (16 * jj + qi) + 31;
            const int dlo = (jj == 0) ? (qi < 8 ? 31 - qi : 23) : (jj == 3) ? (qi > 8 ? 31 - qi : 23) : 23;
            const int lo_j = dlo - bbj; const LAS float* bpj = bpi + bbj;
            { float b0 = bpj[0], b1 = bpj[1], b2 = bpj[2], b3 = bpj[3];
              asm volatile("" : "+v"(b0), "+v"(b1), "+v"(b2), "+v"(b3));
              const float bq[4] = {b0, b1, b2, b3};
#pragma unroll
              for (int e = 0; e < 4; ++e) { const float t0 = s0[e] * SC + bq[e]; s0[e] = ((unsigned)(e - lo_j) < 16u) ? t0 : NEG; } }
            { float b0 = bpj[4], b1 = bpj[5], b2 = bpj[6], b3 = bpj[7];
              asm volatile("" : "+v"(b0), "+v"(b1), "+v"(b2), "+v"(b3));
              const float bq[4] = {b0, b1, b2, b3};
#pragma unroll
              for (int e = 0; e < 4; ++e) { const float t1 = s1[e] * SC + bq[e]; s1[e] = ((unsigned)(4 + e - lo_j) < 16u) ? t1 : NEG; } }
        } else {
#pragma unroll
            for (int e = 0; e < 4; ++e) { s0[e] *= SC; s1[e] *= SC; }
        }
        if (setref) { float mx = fmaxf(fmaxf(fmaxf(s0[0], s0[1]), fmaxf(s0[2], s0[3])), fmaxf(fmaxf(s1[0], s1[1]), fmaxf(s1[2], s1[3])));
            mx = fmaxf(mx, __shfl_xor(mx, 16)); mx = fmaxf(mx, __shfl_xor(mx, 32)); st.mref[j] = mx; }
        float ps = 0.f;
#pragma unroll
        for (int e = 0; e < 4; ++e) { s0[e] = __builtin_amdgcn_exp2f(fminf(s0[e] - st.mref[j], 100.f)); s1[e] = __builtin_amdgcn_exp2f(fminf(s1[e] - st.mref[j], 100.f)); ps += s0[e] + s1[e]; }
        st.lsum[j] += ps; const bf16x8 Bp = pack8(s0, s1);
#pragma unroll
        for (int dt = 0; dt < 4; ++dt) st.o[j][dt] = __builtin_amdgcn_mfma_f32_16x16x32_bf16(vf[dt], Bp, st.o[j][dt], 0, 0, 0);
    }
}
__device__ __forceinline__ void na_wg(LAS unsigned char* lds, int bb, int h, const bf16* Q, const bf16* QR, const bf16* KH, const bf16* VH, bf16* MIX, const LAS float* rpbL, int tid) {
    const int lane = tid & 63, w = __builtin_amdgcn_readfirstlane(tid >> 6), qi = lane & 15, g = lane >> 4;
    const int jb = 2 * (w & 1);
    const size_t bh = (size_t)(bb * NAH + h);
    { const u32x4* ksrc = (const u32x4*)(KH + (bh * KTOK + SEQ) * NAD); const u32x4* vsrc = (const u32x4*)(VH + (bh * (KTOK / 64) + SEQ / 64) * (NAD * 64));
#pragma unroll
      for (int j = 0; j < 4; ++j) { const int L = tid + NTHR * j; const u32x4 kv = ksrc[L], vv = vsrc[L];
          const int key = L >> 3, ch = L & 7, fk = (((key >> 3) & 3) << 1) | ((key >> 1) & 1);
          *(LAS u32x4*)(lds + NA_CTXK + key * 128 + ((ch ^ fk) << 4)) = kv;
          const int blk = L >> 9, dd = (L >> 3) & 63;
          *(LAS u32x4*)(lds + NA_CTXV + blk * 8192 + dd * 128 + ((ch ^ ((dd >> 1) & 7)) << 4)) = vv; } }
    const int skey = tid >> 3, sch = tid & 7;
    const unsigned skoff = (unsigned)(skey * 128 + ((sch ^ ((((skey >> 3) & 3) << 1) | ((skey >> 1) & 1))) << 4)), svoff = (unsigned)(8192 + skey * 128 + ((sch ^ ((skey >> 1) & 7)) << 4));
    const u32x4* kg = (const u32x4*)(KH + bh * KTOK * NAD) + tid;
    const u32x4* vg = (const u32x4*)(VH + bh * (KTOK / 64) * (NAD * 64)) + tid;
#pragma unroll 1
    for (int item = 0; item < 8; ++item) {
        const int r0 = 4 * item, r = r0 + (w >> 1);
        int rs = r - 4; rs = rs < 0 ? 0 : (rs > NROWS - 8 ? NROWS - 8 : rs);
        int rs0 = r0 - 4; rs0 = rs0 < 0 ? 0 : (rs0 > NROWS - 8 ? NROWS - 8 : rs0);
        int rs3 = r0 - 1; rs3 = rs3 < 0 ? 0 : (rs3 > NROWS - 8 ? NROWS - 8 : rs3);
        const int nloc = rs3 + 8 - rs0, off = rs - rs0;
        const int tok0 = bb * SEQ + r * GW;
        NaState st; bf16x8 qrot[2][2], qraw[2][2];
#pragma unroll
        for (int j = 0; j < 2; ++j) { st.mref[j] = 0.f; st.lsum[j] = 0.f;
#pragma unroll
            for (int dt = 0; dt < 4; ++dt) st.o[j][dt] = (f32x4){0.f, 0.f, 0.f, 0.f};
            const size_t qo = (size_t)(tok0 + 16 * (jb + j) + qi) * SEGW + h * NAD + 8 * g;
            qrot[j][0] = *(const bf16x8*)(QR + qo); qrot[j][1] = *(const bf16x8*)(QR + qo + 32); qraw[j][0] = *(const bf16x8*)(Q + qo); qraw[j][1] = *(const bf16x8*)(Q + qo + 32); }
        u32x4 sk = kg[(size_t)rs0 * 512], sv = vg[(size_t)rs0 * 512];
        *(LAS u32x4*)(lds + NA_RING + skoff) = sk; *(LAS u32x4*)(lds + NA_RING + svoff) = sv;
        sk = kg[(size_t)(rs0 + 1) * 512]; sv = vg[(size_t)(rs0 + 1) * 512];
        NA_BAR();
        int ic = 0;
#pragma unroll 1
        for (int slot = 0; slot < 16; ++slot) {
            if (slot + 1 < nloc) { const int rsl = (slot + 1) % 3; *(LAS u32x4*)(lds + NA_RING + rsl * NA_SLOT + skoff) = sk; *(LAS u32x4*)(lds + NA_RING + rsl * NA_SLOT + svoff) = sv; }
            { const int nr = slot + 2 < nloc ? slot + 2 : nloc - 1; sk = kg[(size_t)(rs0 + nr) * 512]; sv = vg[(size_t)(rs0 + nr) * 512]; }
            const int qz = qi, gz = g;
            const int il = slot - off;
            if (il >= 0 && il < 8) {
                const LAS unsigned char* rb = lds + NA_RING + (slot % 3) * NA_SLOT;
                na_step<true>(st, qrot, rb, rb + 8192, 0u, rpbL + (rs + il - r + 7) * 64, slot == 0, qz, gz, jb);
            } else {
                na_step<false>(st, qraw, lds + NA_CTXK + ic * 4096, lds + NA_CTXV + (ic >> 1) * 8192, (unsigned)(ic & 1) << 6, rpbL, slot == 0, qz, gz, jb);
                ++ic;
            }
            NA_BAR();
        }
#pragma unroll
        for (int j = 0; j < 2; ++j) { float l = st.lsum[j]; l += __shfl_xor(l, 16); l += __shfl_xor(l, 32); const float inv = 1.f / l;
            bf16* op = MIX + (size_t)(tok0 + 16 * (jb + j) + qi) * D + h * NAD + 4 * g;
#pragma unroll
            for (int dt = 0; dt < 4; ++dt) { const f32x4 v = st.o[j][dt] * inv; *(v2u*)(op + 16 * dt) = (v2u){pg8::cvt_pk_bf16(v[0], v[1]), pg8::cvt_pk_bf16(v[2], v[3])}; } }
    }
}

typedef float f32x16 __attribute__((ext_vector_type(16)));
constexpr int SC_Q1 = 0, SC_K1 = SC_Q1 + 64 * 272, SC_K1T = SC_K1 + 64 * 272, SC_VT = SC_K1T + 128 * 144, SC_ST = SC_VT + 128 * 144, SC_TOT = SC_ST + 128 * 272, SC_CST = SC_TOT + 2 * 4 * 128 * 4, SC_END = SC_CST + 2 * 128 * 4;
static_assert(SC_END <= RING_BYTES, "scan LDS");
#define SCAN_MFMA(a, b, c) __builtin_amdgcn_mfma_f32_32x32x16_bf16(a, b, c, 0, 0, 0)
#define SCAN_BAR() do { asm volatile("s_waitcnt lgkmcnt(0)" ::: "memory"); __builtin_amdgcn_s_barrier(); asm volatile("" ::: "memory"); } while (0)
__device__ __forceinline__ void scan_unit(LAS unsigned char* lds, int b, int h, int dir, const unsigned short* LGT, const bf16* HQT, const bf16* HIT, bf16* OUT, int tid) {
    const int lane = tid & 63, w = __builtin_amdgcn_readfirstlane(tid >> 6), r = lane & 31, hh = lane >> 5;
    const int d = tid & 127, tq = tid >> 7;
    const int ti = w >> 2, ovi = w & 3;
    const int di = w >> 1, svi = 2 * (w & 1);
    f32x16 S0, S1;
#pragma unroll
    for (int i = 0; i < 16; ++i) { S0[i] = 0.f; S1[i] = 0.f; }
    const size_t chrow = (size_t)(h * HGD + d);
    constexpr int NCH = (LC + SEQ) / 64;
    auto col_of = [&](int c) -> int { return c < 4 ? (T + b * LC + 64 * (dir ? 3 - c : c)) : (b * SEQ + (dir ? SEQ - 64 * (c - 3) : 64 * (c - 4))); };
    LAS float* totb = (LAS float*)(lds + SC_TOT); LAS float* cst = (LAS float*)(lds + SC_CST);
    u32x4 lg0[2], lg1[2], vr[2], qr[2], vn[2], qn[2];
    { const int c0 = col_of(0) + 16 * tq, c1 = col_of(1) + 16 * tq;
      lg0[0] = *(const u32x4*)(LGT + chrow * MROWS + c0); lg0[1] = *(const u32x4*)(LGT + chrow * MROWS + c0 + 8);
      lg1[0] = *(const u32x4*)(LGT + chrow * MROWS + c1); lg1[1] = *(const u32x4*)(LGT + chrow * MROWS + c1 + 8);
      vr[0] = *(const u32x4*)(HIT + chrow * MROWS + c0); vr[1] = *(const u32x4*)(HIT + chrow * MROWS + c0 + 8); qr[0] = qr[1] = (u32x4){0u, 0u, 0u, 0u};
      vn[0] = *(const u32x4*)(HIT + chrow * MROWS + c1); vn[1] = *(const u32x4*)(HIT + chrow * MROWS + c1 + 8); qn[0] = qn[1] = (u32x4){0u, 0u, 0u, 0u};
      float sm = 0.f;
#pragma unroll
      for (int i = 0; i < 8; ++i) { const unsigned u2 = lg0[i >> 2][i & 3]; sm += h2f((unsigned short)(u2 & 0xffff)) + h2f((unsigned short)(u2 >> 16)); }
      totb[tq * 128 + d] = sm; }
    SCAN_BAR();
#pragma unroll 1
    for (int c = 0; c < NCH; ++c) {
        const bool lat = c >= 4; const int par = c & 1;
        LAS float* tot = totb + par * 512;
        {
            float P[16], kk[16];
#pragma unroll
            for (int i = 0; i < 8; ++i) { const unsigned u2 = lg0[i >> 2][i & 3]; P[2 * i] = h2f((unsigned short)(u2 & 0xffff)); P[2 * i + 1] = h2f((unsigned short)(u2 >> 16)); }
#pragma unroll
            for (int i = 0; i < 16; ++i) kk[i] = 1.f - __builtin_amdgcn_exp2f(P[i]);
            if (!dir) {
#pragma unroll
                for (int i = 1; i < 16; ++i) P[i] += P[i - 1];
            } else {
#pragma unroll
                for (int i = 14; i >= 0; --i) P[i] += P[i + 1];
            }
            const float t0 = tot[d], t1 = tot[128 + d], t2 = tot[256 + d], t3 = tot[384 + d];
            const float Bm = dir ? (t2 + t3) : (t0 + t1);
            float offs; if (!dir) offs = (tq > 0 ? t0 : 0.f) + (tq > 1 ? t1 : 0.f) + (tq > 2 ? t2 : 0.f); else offs = (tq < 3 ? t3 : 0.f) + (tq < 2 ? t2 : 0.f) + (tq < 1 ? t1 : 0.f);
            const float sh = offs - Bm;
            if (tq == 0) { const float be = (t0 + t1) + (t2 + t3); cst[d] = __builtin_amdgcn_exp2f(be); cst[128 + d] = __builtin_amdgcn_exp2f(be - Bm); }
            unsigned kt[8];
            LAS bf16* q1 = (LAS bf16*)(lds + SC_Q1) + (16 * tq) * 136 + d; LAS bf16* k1 = (LAS bf16*)(lds + SC_K1) + (16 * tq) * 136 + d;
#pragma unroll
            for (int i = 0; i < 16; i += 2) {
                const float x0 = fminf(fmaxf(P[i] + sh, -120.f), 120.f), x1 = fminf(fmaxf(P[i + 1] + sh, -120.f), 120.f);
                const float k0 = kk[i] * __builtin_amdgcn_exp2f(-x0), k1v = kk[i + 1] * __builtin_amdgcn_exp2f(-x1);
                kt[i >> 1] = pg8::cvt_pk_bf16(k0, k1v);
                if (lat) { const unsigned qq = (i < 8 ? qr[0] : qr[1])[(i >> 1) & 3];
                    const unsigned qp2 = pg8::cvt_pk_bf16(bflo(qq) * __builtin_amdgcn_exp2f(x0), bfhi(qq) * __builtin_amdgcn_exp2f(x1));
                    q1[i * 136] = (bf16)(qp2 & 0xffff); q1[(i + 1) * 136] = (bf16)(qp2 >> 16);
                    k1[i * 136] = (bf16)(kt[i >> 1] & 0xffff); k1[(i + 1) * 136] = (bf16)(kt[i >> 1] >> 16); }
            }
            LAS unsigned char* k1t = lds + SC_K1T + d * 144 + 32 * tq;
            *(LAS u32x4*)k1t = (u32x4){kt[0], kt[1], kt[2], kt[3]}; *(LAS u32x4*)(k1t + 16) = (u32x4){kt[4], kt[5], kt[6], kt[7]};
            LAS unsigned char* vt = lds + SC_VT + d * 144 + 32 * tq;
            *(LAS u32x4*)vt = vr[0]; *(LAS u32x4*)(vt + 16) = vr[1];
        }
        if (lat) {
#pragma unroll
            for (int rg = 0; rg < 4; ++rg) { const int dd = 32 * di + 8 * rg + 4 * hh;
                const f32x4 a0 = *(const LAS f32x4*)(tot + dd), a1 = *(const LAS f32x4*)(tot + 128 + dd), a2 = *(const LAS f32x4*)(tot + 256 + dd), a3 = *(const LAS f32x4*)(tot + 384 + dd);
                const f32x4 bm = dir ? (a2 + a3) : (a0 + a1); float eb[4];
#pragma unroll
                for (int j = 0; j < 4; ++j) eb[j] = __builtin_amdgcn_exp2f(bm[j]);
                *(LAS v2u*)(lds + SC_ST + ((32 * svi + r) * 136 + dd) * 2) = (v2u){pg8::cvt_pk_bf16(S0[4 * rg] * eb[0], S0[4 * rg + 1] * eb[1]), pg8::cvt_pk_bf16(S0[4 * rg + 2] * eb[2], S0[4 * rg + 3] * eb[3])};
                *(LAS v2u*)(lds + SC_ST + ((32 * (svi + 1) + r) * 136 + dd) * 2) = (v2u){pg8::cvt_pk_bf16(S1[4 * rg] * eb[0], S1[4 * rg + 1] * eb[1]), pg8::cvt_pk_bf16(S1[4 * rg + 2] * eb[2], S1[4 * rg + 3] * eb[3])}; }
        }
        { float sm = 0.f;
#pragma unroll
            for (int i = 0; i < 8; ++i) { const unsigned u2 = lg1[i >> 2][i & 3]; sm += h2f((unsigned short)(u2 & 0xffff)) + h2f((unsigned short)(u2 >> 16)); }
            totb[(par ^ 1) * 512 + tq * 128 + d] = sm;
            lg0[0] = lg1[0]; lg0[1] = lg1[1]; vr[0] = vn[0]; vr[1] = vn[1]; qr[0] = qn[0]; qr[1] = qn[1];
            const int cm = c + 2 < NCH ? c + 2 : NCH - 1, cq = cm < 4 ? 4 : cm;
            const int c2 = col_of(cm) + 16 * tq, c2q = col_of(cq) + 16 * tq;
            vn[0] = *(const u32x4*)(HIT + chrow * MROWS + c2); vn[1] = *(const u32x4*)(HIT + chrow * MROWS + c2 + 8);
            qn[0] = *(const u32x4*)(HQT + chrow * T + c2q); qn[1] = *(const u32x4*)(HQT + chrow * T + c2q + 8);
            lg1[0] = *(const u32x4*)(LGT + chrow * MROWS + c2); lg1[1] = *(const u32x4*)(LGT + chrow * MROWS + c2 + 8); }
        SCAN_BAR();
        f32x16 dS0, dS1, O;
#pragma unroll
        for (int i = 0; i < 16; ++i) { dS0[i] = 0.f; dS1[i] = 0.f; O[i] = 0.f; }
        {
            bf16x8 fa[4], fb0[4], fb1[4];
#pragma unroll
            for (int ks = 0; ks < 4; ++ks) { fa[ks] = *(const LAS bf16x8*)(lds + SC_K1T + ((32 * di + r) * 72 + 16 * ks + 8 * hh) * 2);
                fb0[ks] = *(const LAS bf16x8*)(lds + SC_VT + ((32 * svi + r) * 72 + 16 * ks + 8 * hh) * 2); fb1[ks] = *(const LAS bf16x8*)(lds + SC_VT + ((32 * (svi + 1) + r) * 72 + 16 * ks + 8 * hh) * 2); }
#pragma unroll
            for (int ks = 0; ks < 4; ++ks) { dS0 = SCAN_MFMA(fa[ks], fb0[ks], dS0); dS1 = SCAN_MFMA(fa[ks], fb1[ks], dS1); }
        }
        if (lat) {
            bf16x8 fq[8];
#pragma unroll
            for (int ks = 0; ks < 8; ++ks) fq[ks] = *(const LAS bf16x8*)(lds + SC_Q1 + ((32 * ti + r) * 136 + 16 * ks + 8 * hh) * 2);
            {
                bf16x8 fs[8];
#pragma unroll
                for (int ks = 0; ks < 8; ++ks) fs[ks] = *(const LAS bf16x8*)(lds + SC_ST + ((32 * ovi + r) * 136 + 16 * ks + 8 * hh) * 2);
#pragma unroll
                for (int ks = 0; ks < 8; ++ks) O = SCAN_MFMA(fs[ks], fq[ks], O);
            }
#pragma unroll
            for (int si = 0; si < 2; ++si) {
                const bool live = dir ? (si >= ti) : (si <= ti);
                if (live) {
                    f32x16 At;
#pragma unroll
                    for (int i = 0; i < 16; ++i) At[i] = 0.f;
                    bf16x8 fk[8];
#pragma unroll
                    for (int ks = 0; ks < 8; ++ks) fk[ks] = *(const LAS bf16x8*)(lds + SC_K1 + ((32 * si + r) * 136 + 16 * ks + 8 * hh) * 2);
#pragma unroll
                    for (int ks = 0; ks < 8; ++ks) At = SCAN_MFMA(fk[ks], fq[ks], At);
                    const int tt = 32 * ti + r;
                    if (si == ti) {
#pragma unroll
                        for (int i = 0; i < 16; ++i) { const int ss = 32 * si + (i & 3) + 8 * (i >> 2) + 4 * hh; const bool keep = dir ? (ss >= tt) : (ss <= tt); At[i] = keep ? At[i] : 0.f; }
                    }
#pragma unroll
                    for (int k2 = 0; k2 < 2; ++k2) {
                        u32x4 pw; pw.x = pg8::cvt_pk_bf16(At[8 * k2], At[8 * k2 + 1]); pw.y = pg8::cvt_pk_bf16(At[8 * k2 + 2], At[8 * k2 + 3]); pw.z = pg8::cvt_pk_bf16(At[8 * k2 + 4], At[8 * k2 + 5]); pw.w = pg8::cvt_pk_bf16(At[8 * k2 + 6], At[8 * k2 + 7]);
                        const LAS unsigned char* vp = lds + SC_VT + ((32 * ovi + r) * 72 + 32 * si + 16 * k2 + 4 * hh) * 2;
                        const v2u lo = *(const LAS v2u*)vp, hi2 = *(const LAS v2u*)(vp + 16);
                        O = SCAN_MFMA(__builtin_bit_cast(bf16x8, (u32x4){lo.x, lo.y, hi2.x, hi2.y}), __builtin_bit_cast(bf16x8, pw), O);
                    }
                }
            }
            bf16* op = OUT + (size_t)(col_of(c) + 32 * ti + r) * SEGW + h * HGD + 32 * ovi + 4 * hh;
#pragma unroll
            for (int rg = 0; rg < 4; ++rg) *(v2u*)(op + 8 * rg) = (v2u){pg8::cvt_pk_bf16(O[4 * rg], O[4 * rg + 1]), pg8::cvt_pk_bf16(O[4 * rg + 2], O[4 * rg + 3])};
        }
#pragma unroll
        for (int rg = 0; rg < 4; ++rg) { const int dd = 32 * di + 8 * rg + 4 * hh;
            const f32x4 ee = *(const LAS f32x4*)(cst + dd), em = *(const LAS f32x4*)(cst + 128 + dd);
#pragma unroll
            for (int j = 0; j < 4; ++j) { S0[4 * rg + j] = ee[j] * S0[4 * rg + j] + em[j] * dS0[4 * rg + j]; S1[4 * rg + j] = ee[j] * S1[4 * rg + j] + em[j] * dS1[4 * rg + j]; } }
        SCAN_BAR();
    }
}

#ifdef DBG_NAIVE
__device__ __forceinline__ void scan_naive(LAS unsigned char* lds, int b, int h, int dir, const unsigned short* LGT, const bf16* HQT, const bf16* HIT, bf16* OUT, int tid) {
    const int dv = tid & 127, kg = tid >> 7;
    float St[32];
#pragma unroll
    for (int i = 0; i < 32; ++i) St[i] = 0.f;
    LAS float* sq = (LAS float*)lds; LAS float* sk = sq + 16 * 128; LAS float* sf = sk + 16 * 128; LAS float* sv = sf + 16 * 128; LAS float* so = sv + 16 * 128;
    constexpr int NSTEP = LC + SEQ;
    for (int j0 = 0; j0 < NSTEP; j0 += 16) {
        const bool isctx = j0 < LC;
        for (int idx = tid; idx < 16 * 128; idx += NTHR) { const int st = idx >> 7, ch = idx & 127, j = j0 + st;
            int col; if (j < LC) col = T + b * LC + (dir ? (LC - 1 - j) : j); else col = b * SEQ + (dir ? (SEQ - 1 - (j - LC)) : (j - LC));
            const size_t cr = (size_t)(h * HGD + ch);
            const float f = __builtin_amdgcn_exp2f(h2f(LGT[cr * MROWS + col]));
            sf[st * 128 + ch] = f; sk[st * 128 + ch] = 1.f - f; sv[st * 128 + ch] = bf2f(HIT[cr * MROWS + col]);
            if (!isctx) sq[st * 128 + ch] = bf2f(HQT[cr * T + col]); }
        __syncthreads();
        for (int st = 0; st < 16; ++st) {
            const float vv = sv[st * 128 + dv]; float o = 0.f;
#pragma unroll
            for (int i = 0; i < 32; ++i) { St[i] = sf[st * 128 + kg * 32 + i] * St[i] + sk[st * 128 + kg * 32 + i] * vv; o += St[i] * sq[st * 128 + kg * 32 + i]; }
            so[(st * 4 + kg) * 128 + dv] = o;
        }
        __syncthreads();
        if (!isctx) {
            for (int idx = tid; idx < 16 * 128; idx += NTHR) { const int st = idx >> 7, dd = idx & 127, j = j0 + st;
                const float o = (so[(st * 4 + 0) * 128 + dd] + so[(st * 4 + 1) * 128 + dd]) + (so[(st * 4 + 2) * 128 + dd] + so[(st * 4 + 3) * 128 + dd]);
                const int row = b * SEQ + (dir ? (SEQ - 1 - (j - LC)) : (j - LC));
                OUT[(size_t)row * SEGW + h * HGD + dd] = (bf16)f2bf(o); }
        }
        __syncthreads();
    }
}
#endif

__device__ __forceinline__ void transpose_item(const float* W, int ldw, int k0, int n0, bf16* WT, int ldk, int drow0, LAS float* scr, int lane) {
    f32x4 t[8];
#pragma unroll
    for (int i = 0; i < 8; ++i) t[i] = *(const f32x4*)(W + (size_t)(k0 + 8 * i + (lane >> 3)) * ldw + n0 + (lane & 7) * 4);
#pragma unroll
    for (int i = 0; i < 8; ++i) { LAS float* p = scr + (8 * i + (lane >> 3)) * 33 + (lane & 7) * 4; p[0] = t[i][0]; p[1] = t[i][1]; p[2] = t[i][2]; p[3] = t[i][3]; }
    LDS_WAIT(); asm volatile("" ::: "memory");
    const int c = lane & 7;
#pragma unroll
    for (int j = 0; j < 4; ++j) { const int n = (lane >> 3) + 8 * j; const LAS float* s = scr + (8 * c) * 33 + n;
        v4u o; o.x = pk2(s[0 * 33], s[1 * 33]); o.y = pk2(s[2 * 33], s[3 * 33]); o.z = pk2(s[4 * 33], s[5 * 33]); o.w = pk2(s[6 * 33], s[7 * 33]);
        *(GAS v4u*)(WT + (size_t)(drow0 + n) * ldk + k0 + 8 * c) = o; }
    LDS_WAIT(); asm volatile("" ::: "memory");
}

struct Args { const float* in[21]; float* out; unsigned char* ws; int ph_lo, ph_hi, li, pad; };

__global__ void __launch_bounds__(NTHR, 2) fwd_mega(Args args) {
    extern __shared__ __attribute__((aligned(16))) unsigned char lds_raw[];
    LAS unsigned char* lds = (LAS unsigned char*)lds_raw;
    volatile LAS unsigned* MISC = (volatile LAS unsigned*)(lds + MISC_OFF);
    const int tid = threadIdx.x, lane = tid & 63, wave = __builtin_amdgcn_readfirstlane(tid >> 6);
    const int G = gridDim.x; const int bx = blockIdx.x; const int vcu = (G % 8 == 0) ? (bx % 8) * (G / 8) + bx / 8 : bx;
    gu32* ctl0 = (gu32*)(args.ws + WS_CTL);
    const int gw = vcu * NWAVES + wave, NGW = G * NWAVES;
    for (int u = tid; u < (LDS_BYTES - LDSCTL_OFF) / 4; u += NTHR) ((LAS unsigned*)(lds + LDSCTL_OFF))[u] = 0u;
    __syncthreads();
    XcdBarrier bar = xcd_barrier_post((unsigned*)(ctl0 + CW_BAR) + args.li * XCD_BAR_WORDS, MISC + 8);
    const int lo = args.ph_lo, hi = args.ph_hi;
#ifndef PHMASK
#define PHMASK 0xFFFF
#endif
#define IN(k) (((PHMASK >> (k)) & 1) && lo <= (k) && (k) < hi)
#define SEAM(k) do { if (IN(k) && IN((k) + 1)) xcd_barrier(bar); } while (0)

#define KA(i) ({ const __attribute__((address_space(4))) Args* _p = (const __attribute__((address_space(4))) Args*)__builtin_amdgcn_kernarg_segment_ptr(); asm volatile("" : "+s"(_p)); _p->in[i]; })
#define WSP() ({ const __attribute__((address_space(4))) Args* _p = (const __attribute__((address_space(4))) Args*)__builtin_amdgcn_kernarg_segment_ptr(); asm volatile("" : "+s"(_p)); _p->ws; })
#define PHASE_PTRS unsigned char* ws = WSP(); float* MOD = (float*)(ws + WS_MOD); float* ROPE = (float*)(ws + WS_ROPE); float* LBT = (float*)(ws + WS_LBT); \
    bf16* WinT = (bf16*)(ws + WS_WINT); bf16* WoutT = (bf16*)(ws + WS_WOUTT); bf16* W13T = (bf16*)(ws + WS_W13T); bf16* W2T = (bf16*)(ws + WS_W2T); \
    bf16* XN = (bf16*)(ws + WS_XN); bf16* MIX = (bf16*)(ws + WS_MIX); bf16* XN2 = (bf16*)(ws + WS_XN2); \
    float* X1 = (float*)(ws + WS_X1); bf16* Hb = (bf16*)(ws + WS_H); bf16* Yb = (bf16*)(ws + WS_Y); \
    int* ELIST = (int*)(ws + WS_ELIST); float* EWT = (float*)(ws + WS_EWT); gu32* ctl = (gu32*)(ws + WS_CTL); \
    (void)MOD; (void)ROPE; (void)LBT; (void)WinT; (void)WoutT; (void)W13T; (void)W2T; (void)XN; (void)MIX; (void)XN2; (void)X1; (void)Hb; (void)Yb; (void)ELIST; (void)EWT; (void)ctl;
    if (IN(0)) {
        PHASE_PTRS
        const float* cvec = KA(1); const float* c_ctx = KA(3); const float* w_mod = KA(4); const float* b_mod = KA(5); const float* w_in = KA(8); const float* w_out = KA(9);
        const float* hg_lb = KA(11); const float* w1 = KA(17); const float* w3 = KA(18); const float* w2 = KA(19);
        if (bx == G - 1) {
            for (int idx = tid; idx < 1024; idx += NTHR) { const int pos = idx >> 4, i = idx & 15;
                double th = 1.0; for (int k = 0; k < i; ++k) th *= 0.5623413251903491;
                const double t2 = th * th; double c = 1.0, s = th, tc = 1.0, ts = th;
                for (int n = 1; n <= 12; ++n) { tc *= -t2 / (double)((2 * n - 1) * (2 * n)); c += tc; ts *= -t2 / (double)((2 * n) * (2 * n + 1)); s += ts; }
                double cr = 1.0, ci = 0.0; for (int p = 0; p < pos; ++p) { const double nr = cr * c - ci * s; ci = cr * s + ci * c; cr = nr; }
                ROPE[idx * 2] = (float)cr; ROPE[idx * 2 + 1] = (float)ci; }
            for (int idx = tid; idx < 1024; idx += NTHR) { const float h0 = hg_lb[idx], h1 = hg_lb[1024 + idx]; LBT[idx] = 1.f / (1.f + expf(h1 - h0)); }
        }
        if (bx < 96) {
            LAS float* sc = (LAS float*)lds;
            for (int idx = tid; idx < 17 * 1024; idx += NTHR) { const int r = idx >> 10, k = idx & 1023; const float cv = r < 16 ? cvec[r * 1024 + k] : c_ctx[k]; sc[idx] = cv / (1.f + expf(-cv)); }
            __syncthreads();
            const int col = 64 * bx + lane, k0 = 128 * wave;
            float acc[17];
#pragma unroll
            for (int r = 0; r < 17; ++r) acc[r] = 0.f;
            for (int kk = 0; kk < 128; kk += 4) {
                const float w0 = w_mod[(size_t)(k0 + kk) * 6144 + col], w1v = w_mod[(size_t)(k0 + kk + 1) * 6144 + col], w2v = w_mod[(size_t)(k0 + kk + 2) * 6144 + col], w3v = w_mod[(size_t)(k0 + kk + 3) * 6144 + col];
#pragma unroll
                for (int r = 0; r < 17; ++r) { const f32x4 a = *(const LAS f32x4*)(sc + r * 1024 + k0 + kk); acc[r] += a[0] * w0 + a[1] * w1v + a[2] * w2v + a[3] * w3v; }
            }
            LAS float* red = (LAS float*)(lds + 17 * 1024 * 4);
#pragma unroll
            for (int r = 0; r < 17; ++r) red[(wave * 17 + r) * 64 + lane] = acc[r];
            __syncthreads();
            for (int idx = tid; idx < 17 * 64; idx += NTHR) { const int r = idx >> 6, l = idx & 63; float s = 0.f;
#pragma unroll
                for (int w = 0; w < 8; ++w) s += red[(w * 17 + r) * 64 + l];
                MOD[r * 6144 + 64 * bx + l] = s + b_mod[64 * bx + l]; }
            __syncthreads();
        }
        {
            LAS float* scr = (LAS float*)(lds + wave * 16384);
            constexpr int I_IN = 16 * 128, I_OUT = 16 * 32, I_13 = 16 * 2 * 256, I_2 = 16 * 256, NIT = I_IN + I_OUT + I_13 + I_2;
            for (int it = gw; it < NIT; it += NGW) {
                int r = it;
                if (r < I_IN) { const int kb = r / 128, nb = r % 128; transpose_item(w_in, INCOLS, 64 * kb, 32 * nb, WinT, 1024, 32 * nb, scr, lane); continue; } r -= I_IN;
                if (r < I_OUT) { const int kb = r / 32, nb = r % 32; transpose_item(w_out, 1024, 64 * kb, 32 * nb, WoutT, 1024, 32 * nb, scr, lane); continue; } r -= I_OUT;
                if (r < I_13) { const int e = r / 512, rem = r % 512, s = rem / 256, r2 = rem % 256, kb = r2 / 16, nb = r2 % 16, n0 = 32 * nb;
                    transpose_item((s ? w3 : w1) + (size_t)e * 1024 * 512, 512, 64 * kb, n0, W13T, 1024, e * 1024 + 256 * (n0 / 128) + 128 * s + (n0 % 128), scr, lane); continue; } r -= I_13;
                { const int e = r / 256, r2 = r % 256, kb = r2 / 32, nb = r2 % 32; transpose_item(w2 + (size_t)e * 512 * 1024, 1024, 64 * kb, 32 * nb, W2T, 512, e * 1024 + 32 * nb, scr, lane); }
            }
        }
    }
    SEAM(0);

    if (IN(1)) {
        PHASE_PTRS
        const float* x = KA(0); const float* ctx = KA(2); const float* norm_mix = KA(6);
        for (int row = gw; row < MROWS; row += NGW) {
            const float* xr = row < T ? x + (size_t)row * D : ctx + (size_t)(row - T) * D; const int mb = row < T ? (row >> 11) : 16;
            f32x4 v[4]; float s = 0.f;
#pragma unroll
            for (int j = 0; j < 4; ++j) { v[j] = *(const f32x4*)(xr + 4 * lane + 256 * j); s += (v[j][0] * v[j][0] + v[j][1] * v[j][1]) + (v[j][2] * v[j][2] + v[j][3] * v[j][3]); }
            const float rstd = 1.f / sqrtf(wave_sum(s) * (1.f / D) + EPS);
#pragma unroll
            for (int j = 0; j < 4; ++j) { const int col = 4 * lane + 256 * j; const f32x4 g = *(const f32x4*)(norm_mix + col), sh = *(const f32x4*)(MOD + mb * 6144 + col), sc = *(const f32x4*)(MOD + mb * 6144 + 1024 + col);
                const f32x4 y = v[j] * rstd * g * (1.f + sc) + sh;
                *(v2u*)(XN + (size_t)row * D + col) = (v2u){pk2(y[0], y[1]), pk2(y[2], y[3])}; }
        }
    }
    SEAM(1);

    if (IN(2)) {
        PHASE_PTRS
        ProjOrder S; S.init(G, bx);
        LAS float* ropeL = (LAS float*)(lds + TAB_OFF); LAS float* lbtL = ropeL + 2048;
        for (int i = tid; i < 2048 + 1024; i += NTHR) ropeL[i] = i < 2048 ? ROPE[i] : LBT[i - 2048];
        __syncthreads();
        EpiProj E{ws, ropeL, lbtL, 0};
        pg8::gemm_phase<EpiProj, ProjOrder>(lds + RING_OFF, XN, WinT, D, S, E);
    }
    SEAM(2);

    if (IN(3)) {
        PHASE_PTRS
        const bf16* Qb = (const bf16*)(ws + WS_Q); const bf16* Kb = (const bf16*)(ws + WS_K); const bf16* Vb = (const bf16*)(ws + WS_V);
        const float* na_rpb = KA(10);
        const int subph = ({ const __attribute__((address_space(4))) Args* _p = (const __attribute__((address_space(4))) Args*)__builtin_amdgcn_kernarg_segment_ptr(); asm volatile("" : "+s"(_p)); _p->pad; });
#ifndef NO_SCAN
        if (bx < 128) {
            const int dir = bx & 1;
#ifdef DBG_NAIVE
            if (DBG_NAIVE & (1 << dir)) scan_naive(lds, bx >> 3, (bx >> 1) & 3, dir, (const unsigned short*)(ws + (dir ? WS_LB : WS_LF)), (const bf16*)(ws + WS_HQ), (const bf16*)(ws + WS_HI), (bf16*)(ws + (dir ? WS_OB : WS_OF)), tid);
            else
#endif
            if (subph != 2) scan_unit(lds, bx >> 3, (bx >> 1) & 3, dir, (const unsigned short*)(ws + (dir ? WS_LB : WS_LF)), (const bf16*)(ws + WS_HQ), (const bf16*)(ws + WS_HI), (bf16*)(ws + (dir ? WS_OB : WS_OF)), tid);
        } else
#endif
        {
            const int hx = bx & 7, bb = (bx - 128) >> 3;
            LAS float* rpbL = (LAS float*)(lds + TAB_OFF);
            for (int t2 = tid; t2 < 15 * 64; t2 += NTHR) { const int co = (t2 & 63) - 16, ro = t2 >> 6; rpbL[t2] = (co >= 0 && co < 31) ? na_rpb[(hx * 15 + ro) * 31 + co] * 1.44269504f : 0.f; }
            if (subph != 1) na_wg(lds, bb, hx, Qb, (const bf16*)(ws + WS_QR), Kb, Vb, MIX, rpbL, tid);
        }
    }
    SEAM(3);

    if (IN(4)) {
        PHASE_PTRS
        const float* hg_norm = KA(12);
        const bf16* OF = (const bf16*)(ws + WS_OF); const bf16* OB = (const bf16*)(ws + WS_OB); const bf16* Gb = (const bf16*)(ws + WS_G);
        for (int tok = gw; tok < T; tok += NGW) {
            const size_t off = (size_t)tok * SEGW + lane * 8;
            const v4u a = *(const v4u*)(OF + off), bb = *(const v4u*)(OB + off), g = *(const v4u*)(Gb + off);
            float o[8]; float ss = 0.f;
#pragma unroll
            for (int e = 0; e < 4; ++e) { o[2 * e] = bflo(a[e]) + bflo(bb[e]); o[2 * e + 1] = bfhi(a[e]) + bfhi(bb[e]);
#ifdef DBG_SANITIZE
                if (!(fabsf(o[2 * e]) < 1e30f)) o[2 * e] = 0.f; if (!(fabsf(o[2 * e + 1]) < 1e30f)) o[2 * e + 1] = 0.f;
#endif
                ss += o[2 * e] * o[2 * e] + o[2 * e + 1] * o[2 * e + 1]; }
            ss += __shfl_xor(ss, 1); ss += __shfl_xor(ss, 2); ss += __shfl_xor(ss, 4); ss += __shfl_xor(ss, 8);
            const float rstd = 1.f / sqrtf(ss * (1.f / HGD) + EPS);
            const int dv0 = (lane & 15) * 8;
            const f32x4 g0 = *(const f32x4*)(hg_norm + dv0), g1 = *(const f32x4*)(hg_norm + dv0 + 4);
            const float gg[8] = {g0[0], g0[1], g0[2], g0[3], g1[0], g1[1], g1[2], g1[3]};
            float y[8];
#pragma unroll
            for (int e = 0; e < 4; ++e) { y[2 * e] = o[2 * e] * rstd * gg[2 * e] * bflo(g[e]); y[2 * e + 1] = o[2 * e + 1] * rstd * gg[2 * e + 1] * bfhi(g[e]); }
            *(v4u*)(MIX + (size_t)tok * D + 512 + lane * 8) = (v4u){pk2(y[0], y[1]), pk2(y[2], y[3]), pk2(y[4], y[5]), pk2(y[6], y[7])};
        }
    }
    SEAM(4);

    if (IN(5)) {
        PHASE_PTRS
        pg8::DenseOrder S; S.init(T, D, G, bx, true);
        EpiP E{(bf16*)X1};
        pg8::gemm_phase<EpiP, pg8::DenseOrder>(lds + RING_OFF, MIX, WoutT, D, S, E);
    }
    SEAM(5);

    if (IN(6)) {
        PHASE_PTRS
        const float* norm_ffn = KA(7); const float* w_grp = KA(13); const float* b_grp = KA(14); const float* w_exp = KA(15); const float* b_exp = KA(16);
        LAS float* wst = (LAS float*)lds;
        LAS float* gscL = (LAS float*)(lds + 86016); LAS float* shvL = gscL + 1024;
        LAS float* cpart = (LAS float*)(lds + 94208); LAS float* cst = (LAS float*)(lds + 96256);
        LAS float* part = (LAS float*)(lds + 98304);
        LAS float* ssqp = (LAS float*)(lds + 114688);
        LAS float* tot = (LAS float*)(lds + 115200);
        LAS int* lcnt = (LAS int*)(lds + 117248);
        LAS int* tmpe = (LAS int*)(lds + 117376);
        const int rowbase = bx * 128, mb = rowbase >> 11;
        for (int idx = tid; idx < 5 * 1024; idx += NTHR) { const int quad = idx >> 10, col = idx & 1023;
            const f32x4 w = quad == 0 ? *(const f32x4*)(w_grp + col * 4) : *(const f32x4*)(w_exp + col * 16 + (quad - 1) * 4);
#pragma unroll
            for (int c = 0; c < 4; ++c) wst[col * 21 + quad * 4 + c] = w[c]; }
        for (int col = tid; col < 1024; col += NTHR) { gscL[col] = norm_ffn[col] * (1.f + MOD[mb * 6144 + 4096 + col]); shvL[col] = MOD[mb * 6144 + 3072 + col]; }
        if (tid < 32) lcnt[tid] = 0;
        __syncthreads();
        { const int idx = tid & 31, prt = tid >> 5; float sacc = 0.f;
            if (idx < 20) for (int c = 0; c < 64; ++c) sacc += shvL[prt * 64 + c] * wst[(prt * 64 + c) * 21 + idx];
            cpart[prt * 32 + idx] = sacc; }
        __syncthreads();
        if (tid < 32) { float sacc = 0.f;
            for (int p = 0; p < 16; ++p) sacc += cpart[p * 32 + tid];
            cst[tid] = tid < 4 ? sacc + b_grp[tid] : tid < 20 ? sacc + b_exp[tid - 4] : 0.f; }
        const int r = lane & 15, kg = lane >> 4, cb = 128 * wave + 8 * kg;
        bf16x8 whi[2][4], wlo[2][4];
#pragma unroll
        for (int t = 0; t < 2; ++t)
#pragma unroll
            for (int sx = 0; sx < 4; ++sx) { float wv[8];
#pragma unroll
                for (int j = 0; j < 8; ++j) { const int col = cb + 32 * sx + j; const int n = 16 * t + r; wv[j] = n < 20 ? gscL[col] * wst[col * 21 + (n < 20 ? n : 0)] : 0.f; }
                u32x4 h, l;
#pragma unroll
                for (int e = 0; e < 4; ++e) { h[e] = pg8::cvt_pk_bf16(wv[2 * e], wv[2 * e + 1]); l[e] = pg8::cvt_pk_bf16(wv[2 * e] - bflo(h[e]), wv[2 * e + 1] - bfhi(h[e])); }
                whi[t][sx] = __builtin_bit_cast(bf16x8, h); wlo[t][sx] = __builtin_bit_cast(bf16x8, l); }
        f32x4 gaa[4][2];
#pragma unroll
        for (int sx = 0; sx < 4; ++sx) { gaa[sx][0] = *(const f32x4*)(MOD + mb * 6144 + 2048 + cb + 32 * sx); gaa[sx][1] = *(const f32x4*)(MOD + mb * 6144 + 2048 + cb + 32 * sx + 4); }
        const float* xin = KA(0); const bf16* Pb = (const bf16*)X1; bf16* X1B = (bf16*)(ws + WS_X1B);
        f32x4 xn[4][2]; u32x4 pn[4];
#define P6_LOAD(it_) do { const size_t o_ = (size_t)(rowbase + 16 * (it_) + r) * D + cb; _Pragma("unroll") for (int sx = 0; sx < 4; ++sx) { \
            xn[sx][0] = *(const f32x4*)(xin + o_ + 32 * sx); xn[sx][1] = *(const f32x4*)(xin + o_ + 32 * sx + 4); pn[sx] = *(const u32x4*)(Pb + o_ + 32 * sx); } } while (0)
        P6_LOAD(0);
        __syncthreads();
#pragma unroll 1
        for (int it = 0; it < 8; ++it) {
            asm volatile("" ::: "memory");
            f32x4 v[4][2]; float ss = 0.f;
#pragma unroll
            for (int sx = 0; sx < 4; ++sx) {
                v[sx][0] = xn[sx][0] + gaa[sx][0] * (f32x4){bflo(pn[sx][0]), bfhi(pn[sx][0]), bflo(pn[sx][1]), bfhi(pn[sx][1])};
                v[sx][1] = xn[sx][1] + gaa[sx][1] * (f32x4){bflo(pn[sx][2]), bfhi(pn[sx][2]), bflo(pn[sx][3]), bfhi(pn[sx][3])}; }
            if (it < 7) P6_LOAD(it + 1);
#pragma unroll
            for (int sx = 0; sx < 4; ++sx)
                *(u32x4*)(X1B + (size_t)(rowbase + 16 * it + r) * D + cb + 32 * sx) = (u32x4){pg8::cvt_pk_bf16(v[sx][0][0], v[sx][0][1]), pg8::cvt_pk_bf16(v[sx][0][2], v[sx][0][3]), pg8::cvt_pk_bf16(v[sx][1][0], v[sx][1][1]), pg8::cvt_pk_bf16(v[sx][1][2], v[sx][1][3])};
            f32x4 acc0 = {0.f, 0.f, 0.f, 0.f}, acc1 = {0.f, 0.f, 0.f, 0.f};
#pragma unroll
            for (int sx = 0; sx < 4; ++sx) {
                ss += ((v[sx][0][0] * v[sx][0][0] + v[sx][0][1] * v[sx][0][1]) + (v[sx][0][2] * v[sx][0][2] + v[sx][0][3] * v[sx][0][3])) + ((v[sx][1][0] * v[sx][1][0] + v[sx][1][1] * v[sx][1][1]) + (v[sx][1][2] * v[sx][1][2] + v[sx][1][3] * v[sx][1][3]));
                u32x4 h, l;
#pragma unroll
                for (int e = 0; e < 4; ++e) { const float a0 = v[sx][e >> 1][2 * (e & 1)], a1 = v[sx][e >> 1][2 * (e & 1) + 1]; h[e] = pg8::cvt_pk_bf16(a0, a1); l[e] = pg8::cvt_pk_bf16(a0 - bflo(h[e]), a1 - bfhi(h[e])); }
                const bf16x8 ah = __builtin_bit_cast(bf16x8, h), al = __builtin_bit_cast(bf16x8, l);
                acc0 = __builtin_amdgcn_mfma_f32_16x16x32_bf16(ah, whi[0][sx], acc0, 0, 0, 0); acc1 = __builtin_amdgcn_mfma_f32_16x16x32_bf16(ah, whi[1][sx], acc1, 0, 0, 0);
                acc0 = __builtin_amdgcn_mfma_f32_16x16x32_bf16(al, whi[0][sx], acc0, 0, 0, 0); acc1 = __builtin_amdgcn_mfma_f32_16x16x32_bf16(al, whi[1][sx], acc1, 0, 0, 0);
                acc0 = __builtin_amdgcn_mfma_f32_16x16x32_bf16(ah, wlo[0][sx], acc0, 0, 0, 0); acc1 = __builtin_amdgcn_mfma_f32_16x16x32_bf16(ah, wlo[1][sx], acc1, 0, 0, 0); }
            ss += __shfl_xor(ss, 16); ss += __shfl_xor(ss, 32);
#pragma unroll
            for (int rg = 0; rg < 4; ++rg) { part[((wave * 2 + 0) * 16 + 4 * kg + rg) * 16 + r] = acc0[rg]; part[((wave * 2 + 1) * 16 + 4 * kg + rg) * 16 + r] = acc1[rg]; }
            if (kg == 0) ssqp[wave * 16 + r] = ss;
            NA_BAR();
            { const int tk = tid >> 5, idx = tid & 31; float sacc = 0.f;
                if (idx < 20) {
#pragma unroll
                    for (int w = 0; w < 8; ++w) sacc += part[((w * 2 + (idx >> 4)) * 16 + tk) * 16 + (idx & 15)]; }
                else if (idx == 20) {
#pragma unroll
                    for (int w = 0; w < 8; ++w) sacc += ssqp[w * 16 + tk]; }
                tot[tk * 32 + idx] = sacc; }
            NA_BAR();
            const float rstd = 1.f / sqrtf(tot[r * 32 + 20] * (1.f / D) + EPS);
#pragma unroll
            for (int sx = 0; sx < 4; ++sx) {
                const f32x4 g0 = *(const LAS f32x4*)(gscL + cb + 32 * sx), g1 = *(const LAS f32x4*)(gscL + cb + 32 * sx + 4), s0 = *(const LAS f32x4*)(shvL + cb + 32 * sx), s1 = *(const LAS f32x4*)(shvL + cb + 32 * sx + 4);
                const f32x4 y0 = v[sx][0] * rstd * g0 + s0, y1 = v[sx][1] * rstd * g1 + s1;
                *(u32x4*)(XN2 + (size_t)(rowbase + 16 * it + r) * D + cb + 32 * sx) = (u32x4){pg8::cvt_pk_bf16(y0[0], y0[1]), pg8::cvt_pk_bf16(y0[2], y0[3]), pg8::cvt_pk_bf16(y1[0], y1[1]), pg8::cvt_pk_bf16(y1[2], y1[3])}; }
            if (wave == it && lane < 16) {
                const LAS float* lgr = tot + lane * 32;
                {
                    float gl[4];
#pragma unroll
                    for (int k = 0; k < 4; ++k) gl[k] = rstd * lgr[k] + cst[k];
                    int gs = 0; float gm = gl[0];
#pragma unroll
                    for (int k = 1; k < 4; ++k) if (gl[k] > gm) { gm = gl[k]; gs = k; }
                    float den = 0.f;
#pragma unroll
                    for (int k = 0; k < 4; ++k) den += __expf(gl[k] - gm);
                    const float g_w = 1.f / den;
                    float ev[4];
#pragma unroll
                    for (int k = 0; k < 4; ++k) ev[k] = rstd * lgr[4 + gs * 4 + k] + cst[4 + gs * 4 + k];
                    int i0 = 0; float v0 = ev[0];
#pragma unroll
                    for (int k = 1; k < 4; ++k) if (ev[k] > v0) { v0 = ev[k]; i0 = k; }
                    int i1 = -1; float v1 = -INFINITY;
#pragma unroll
                    for (int k = 0; k < 4; ++k) if (k != i0 && ev[k] > v1) { v1 = ev[k]; i1 = k; }
                    if (i1 < 0) { i1 = (i0 + 1) & 3; v1 = v0; }
                    const float e1 = __expf(v1 - v0); const float w0 = g_w / (1.f + e1), w1w = g_w * e1 / (1.f + e1);
                    const int ea = gs * 4 + i0, eb = gs * 4 + i1;
                    const int ra = __hip_atomic_fetch_add(&lcnt[ea], 1, __ATOMIC_RELAXED, __HIP_MEMORY_SCOPE_WORKGROUP), rb = __hip_atomic_fetch_add(&lcnt[eb], 1, __ATOMIC_RELAXED, __HIP_MEMORY_SCOPE_WORKGROUP);
                    const int lr = (16 * it + lane) * 2;
                    tmpe[lr] = ea; tmpe[256 + lr] = ra; tmpe[512 + lr] = __builtin_bit_cast(int, w0);
                    tmpe[lr + 1] = eb; tmpe[256 + lr + 1] = rb; tmpe[512 + lr + 1] = __builtin_bit_cast(int, w1w);
                }
            }
        }
#undef P6_LOAD
        __syncthreads();
        if (tid < 16) lcnt[16 + tid] = (int)__hip_atomic_fetch_add(ctl + CW_CNT + tid, (unsigned)lcnt[tid], RLX_AGENT);
        __syncthreads();
        if (tid < 256) { const int e = tmpe[tid], pos = lcnt[16 + e] + tmpe[256 + tid]; const int tok = bx * 128 + (tid >> 1);
            ELIST[e * ECAP + pos] = tok * 2 + (tid & 1); EWT[e * ECAP + pos] = __builtin_bit_cast(float, tmpe[512 + tid]); }
        __syncthreads();
    }
    SEAM(6);

    if (IN(7) || IN(8)) {
        PHASE_PTRS
        LAS int* tp = (LAS int*)(lds + MOE_OFF);
        if (tid == 0) { int acc = 0;
            for (int e = 0; e < 16; ++e) { const int c = (int)__hip_atomic_load(ctl + CW_CNT + e, RLX_AGENT); tp[e] = acc; tp[17 + e] = c; acc += (c + 255) >> 8; }
            tp[16] = acc; }
        __syncthreads();
    }
    if (IN(7)) {
        PHASE_PTRS
        const LAS int* tp = (const LAS int*)(lds + MOE_OFF);
        const int nu = tp[16] * 4; const bool merged = IN(8);
        gu32* tc = merged ? (gu32*)(ctl + CW_TILE) : (gu32*)nullptr;
        { MoeOrder<true> S{tp, ELIST, G, bx, nu, (gu32*)nullptr};
          EpiSwiGLU E{Hb, tc};
          pg8::gemm_phase<EpiSwiGLU, MoeOrder<true>>(lds + RING_OFF, XN2, W13T, D, S, E); }
        if (merged) {
          MoeOrder<false> S{tp, ELIST, G, bx, nu, tc, nu % G};
          EpiMoeOut E{Yb, ELIST, EWT};
          pg8::gemm_phase<EpiMoeOut, MoeOrder<false>>(lds + RING_OFF, Hb, W2T, DE, S, E); }
    }
    if (IN(8) && !IN(7)) {
        PHASE_PTRS
        const LAS int* tp = (const LAS int*)(lds + MOE_OFF);
        MoeOrder<false> S{tp, ELIST, G, bx, tp[16] * 4, (gu32*)nullptr};
        EpiMoeOut E{Yb, ELIST, EWT};
        pg8::gemm_phase<EpiMoeOut, MoeOrder<false>>(lds + RING_OFF, Hb, W2T, DE, S, E);
    }
    SEAM(8);

    if (IN(9)) {
        PHASE_PTRS
        const float* norm_final = KA(20); float* outp = ({ const __attribute__((address_space(4))) Args* _p = (const __attribute__((address_space(4))) Args*)__builtin_amdgcn_kernarg_segment_ptr(); asm volatile("" : "+s"(_p)); _p->out; });
        const bf16* X1B = (const bf16*)(ws + WS_X1B);
        const int rowbase = gw * 16, mb = rowbase >> 11;
        f32x4 gaf[4], nf[4];
#pragma unroll
        for (int h2 = 0; h2 < 4; ++h2) { const int col = 8 * lane + 512 * (h2 >> 1) + 4 * (h2 & 1);
            gaf[h2] = *(const f32x4*)(MOD + mb * 6144 + 5120 + col); nf[h2] = *(const f32x4*)(norm_final + col); }
        u32x4 pn[2], y0n[2], y1n[2];
#define P9_LOAD(row_) do { _Pragma("unroll") for (int jj = 0; jj < 2; ++jj) { const size_t o_ = (size_t)(row_) * D + 8 * lane + 512 * jj; \
            pn[jj] = *(const u32x4*)(X1B + o_); \
            y0n[jj] = *(const u32x4*)(Yb + (size_t)(row_) * (2 * D) + 8 * lane + 512 * jj); y1n[jj] = *(const u32x4*)(Yb + (size_t)(row_) * (2 * D) + D + 8 * lane + 512 * jj); } } while (0)
        P9_LOAD(rowbase);
#pragma unroll 1
        for (int i = 0; i < 16; ++i) {
            const int row = rowbase + i;
            u32x4 pc[2], y0c[2], y1c[2];
#pragma unroll
            for (int k = 0; k < 2; ++k) { pc[k] = pn[k]; y0c[k] = y0n[k]; y1c[k] = y1n[k]; }
            if (i < 15) P9_LOAD(row + 1);
            f32x4 v[4]; float ssq = 0.f;
#pragma unroll
            for (int h2 = 0; h2 < 4; ++h2) { const int jj = h2 >> 1, q2 = (h2 & 1) * 2;
                const f32x4 pf = (f32x4){bflo(pc[jj][q2]), bfhi(pc[jj][q2]), bflo(pc[jj][q2 + 1]), bfhi(pc[jj][q2 + 1])};
                const f32x4 ys = (f32x4){bflo(y0c[jj][q2]) + bflo(y1c[jj][q2]), bfhi(y0c[jj][q2]) + bfhi(y1c[jj][q2]), bflo(y0c[jj][q2 + 1]) + bflo(y1c[jj][q2 + 1]), bfhi(y0c[jj][q2 + 1]) + bfhi(y1c[jj][q2 + 1])};
                v[h2] = pf + gaf[h2] * ys;
                ssq += (v[h2][0] * v[h2][0] + v[h2][1] * v[h2][1]) + (v[h2][2] * v[h2][2] + v[h2][3] * v[h2][3]); }
            const float rstd = 1.f / sqrtf(wave_sum(ssq) * (1.f / D) + EPS);
#pragma unroll
            for (int h2 = 0; h2 < 4; ++h2) *(f32x4*)(outp + (size_t)row * D + 8 * lane + 512 * (h2 >> 1) + 4 * (h2 & 1)) = v[h2] * rstd * nf[h2];
        }
#undef P9_LOAD
    }
#undef IN
#undef SEAM
}

#ifndef MK_N_LAUNCHES
#define MK_N_LAUNCHES 1
#endif
constexpr int NPHASE = 10;
extern "C" void kernel_launch(void* const* d_in, const int* in_sizes, int n_in, void* d_out, int out_size, void* d_ws, size_t ws_size, hipStream_t stream) {
    static int grid = 0;
    if (grid == 0) {
        if (n_in != 21 || in_sizes[0] != T * D || out_size != T * D || ws_size < WS_END) { fprintf(stderr, "kernel_launch: unexpected shapes (n_in %d, in0 %d, out %d, ws %zu)\n", n_in, n_in > 0 ? in_sizes[0] : -1, out_size, ws_size); grid = -1; return; }
        int dev = 0, cus = 0, per_cu = 0;
        if (hipGetDevice(&dev) != hipSuccess || hipDeviceGetAttribute(&cus, hipDeviceAttributeMultiprocessorCount, dev) != hipSuccess) { grid = -1; return; }
        if (hipFuncSetAttribute((const void*)fwd_mega, hipFuncAttributeMaxDynamicSharedMemorySize, LDS_BYTES) != hipSuccess) { fprintf(stderr, "kernel_launch: hipFuncSetAttribute failed\n"); grid = -1; return; }
        if (hipOccupancyMaxActiveBlocksPerMultiprocessor(&per_cu, (const void*)fwd_mega, NTHR, LDS_BYTES) != hipSuccess || per_cu < 1) fprintf(stderr, "kernel_launch: occupancy query reports %d\n", per_cu);
        (void)hipGetLastError();
        grid = cus;
        if (grid != 256) fprintf(stderr, "kernel_launch: %d CUs (built for 256)\n", grid);
    }
    if (grid < 0) return;
    (void)hipMemsetAsync((char*)d_ws + WS_CTL, 0, CTL_ZERO_BYTES, stream);
    Args a{};
    for (int i = 0; i < 21; ++i) a.in[i] = (const float*)d_in[i];
    a.out = (float*)d_out; a.ws = (unsigned char*)d_ws;
    if (MK_N_LAUNCHES == 1) {
        a.ph_lo = 0; a.ph_hi = NPHASE; a.li = 0;
        hipLaunchKernelGGL(fwd_mega, dim3(grid), dim3(NTHR), LDS_BYTES, stream, a);
    } else {
        for (int li = 0; li < NPHASE; ++li) { a.ph_lo = li; a.ph_hi = li + 1; a.li = 0; hipLaunchKernelGGL(fwd_mega, dim3(grid), dim3(NTHR), LDS_BYTES, stream, a);
#ifdef PROBE_DUP
            if (li == PROBE_DUP) {
#ifdef PROBE_SUB
                a.pad = PROBE_SUB;
#endif
                hipLaunchKernelGGL(fwd_mega, dim3(grid), dim3(NTHR), LDS_BYTES, stream, a); a.pad = 0; }
#endif
        }
    }
}
```

```cpp
#include <hip/hip_runtime.h>
#include <cstdio>
#include <cstdint>

#define GAS __attribute__((address_space(1)))
#define LAS __attribute__((address_space(3)))
typedef unsigned short bf16;
typedef unsigned short bf16_t;
typedef unsigned v4u __attribute__((ext_vector_type(4)));
typedef unsigned v2u __attribute__((ext_vector_type(2)));
typedef float f32x4 __attribute__((ext_vector_type(4)));
typedef float f32x2 __attribute__((ext_vector_type(2)));
typedef short bf16x8 __attribute__((ext_vector_type(8)));
typedef unsigned u32x4 __attribute__((ext_vector_type(4)));
typedef GAS unsigned gu32;
typedef unsigned bu4v __attribute__((__vector_size__(16)));
#define RLX_AGENT __ATOMIC_RELAXED, __HIP_MEMORY_SCOPE_AGENT
#define LDS_WAIT() asm volatile("s_waitcnt lgkmcnt(0)" ::: "memory")
#define VM_WAIT() asm volatile("s_waitcnt vmcnt(0)" ::: "memory")

constexpr int NB = 16, SEQ = 2048, D = 1024, T = NB * SEQ, LC = 256, TC = NB * LC, MROWS = T + TC;
constexpr int GW = 64, NROWS = SEQ / GW;
constexpr int INCOLS = 4096, SEGW = 512;
constexpr int NAH = 8, NAD = 64, HGH = 4, HGD = 128;
constexpr int KTOK = SEQ + LC;
constexpr int NE = 16, DE = 512, ECAP = T;
constexpr float EPS = 1e-6f;
constexpr int NWAVES = 8, NTHR = 512;

constexpr size_t MiB = 1u << 20;
constexpr size_t WS_CTL = 0, CTL_ZERO_BYTES = 32768;
constexpr size_t WS_MOD = 1 * MiB;
constexpr size_t WS_ROPE = WS_MOD + 512 * 1024, WS_LBT = WS_MOD + 520 * 1024;
constexpr size_t WS_ELIST = 2 * MiB, WS_EWT = 4 * MiB;
constexpr size_t WS_WINT = 8 * MiB, WS_WOUTT = 16 * MiB, WS_W13T = 18 * MiB, WS_W2T = 50 * MiB;
constexpr size_t WS_XN = 66 * MiB;
constexpr size_t WS_Q = 138 * MiB, WS_K = 170 * MiB, WS_V = 206 * MiB, WS_HQ = 242 * MiB, WS_HI = 274 * MiB, WS_LF = 310 * MiB, WS_LB = 346 * MiB, WS_G = 382 * MiB;
constexpr size_t WS_OF = 414 * MiB, WS_OB = 446 * MiB, WS_QR = 478 * MiB, WS_END = 510 * MiB;
constexpr size_t WS_MIX = WS_XN, WS_XN2 = WS_XN, WS_X1 = 138 * MiB, WS_H = 274 * MiB, WS_Y = 346 * MiB;
constexpr size_t WS_X1B = 206 * MiB;
constexpr int CW_CNT = 64;
constexpr int CW_TILE = 512;
constexpr int CW_BAR = 4096;
static_assert((CW_BAR + 3456) * 4 <= (int)CTL_ZERO_BYTES, "barrier words inside the per-call memset");

constexpr int RING_OFF = 0, RING_BYTES = 131072;
constexpr int LDSCTL_OFF = RING_BYTES, MISC_OFF = LDSCTL_OFF + 320, MOE_OFF = LDSCTL_OFF + 1024;
constexpr int TAB_OFF = LDSCTL_OFF + 2048;
constexpr int LDS_BYTES = 147456;

__device__ __forceinline__ unsigned f2bf(float f) { unsigned u = __builtin_bit_cast(unsigned, f); return (u + 0x7fffu + ((u >> 16) & 1u)) >> 16; }
__device__ __forceinline__ unsigned pk2(float lo, float hi) { return f2bf(lo) | (f2bf(hi) << 16); }
__device__ __forceinline__ float bf2f(unsigned short b) { return __builtin_bit_cast(float, (unsigned)b << 16); }
__device__ __forceinline__ float bflo(unsigned u) { return __builtin_bit_cast(float, u << 16); }
__device__ __forceinline__ float bfhi(unsigned u) { return __builtin_bit_cast(float, u & 0xffff0000u); }
__device__ __forceinline__ unsigned pkh2(float lo, float hi) { _Float16 a = (_Float16)lo, b = (_Float16)hi; return (unsigned)__builtin_bit_cast(unsigned short, a) | ((unsigned)__builtin_bit_cast(unsigned short, b) << 16); }
__device__ __forceinline__ float h2f(unsigned short h) { return (float)__builtin_bit_cast(_Float16, h); }
__device__ __forceinline__ float silu_f(float v) { return v * __builtin_amdgcn_rcpf(1.f + __expf(-v)); }
__device__ __forceinline__ float wave_sum(float v) {
#pragma unroll
    for (int o = 1; o < 64; o <<= 1) v += __shfl_xor(v, o);
    return v;
}
__device__ __forceinline__ float wave_max(float v) {
#pragma unroll
    for (int o = 1; o < 64; o <<= 1) v = fmaxf(v, __shfl_xor(v, o));
    return v;
}

namespace pg8 {
constexpr int BM = 256, BK = 64, HALF = 128, HTB = HALF * BK * 2, STAGE_BYTES = 8 * HTB, NXCD = 8, WGM = 8;
__host__ __device__ __forceinline__ int lds_byte(int r, int c) { const int st = (r >> 4) * 2 + (c >> 5), rr = r & 15, cc = c & 31, ob = rr * 64 + cc * 2; return st * 1024 + (ob ^ (((ob >> 9) & 1) << 5)); }
__host__ __device__ __forceinline__ void stage_rc(int b, int& R, int& C) { const int st = b / 1024, sb = b % 1024, swz = sb ^ (((sb >> 9) & 1) << 5); R = (st >> 1) * 16 + swz / 64; C = (st & 1) * 32 + (swz % 64) / 2; }
__host__ __device__ __forceinline__ int perm32(int rho) { const int n = rho >> 4, i = rho & 15; return 8 * (i >> 2) + 4 * n + (i & 3); }

struct Unit { int pm, pn, e, tm, cnt; };

typedef float f32x2_t __attribute__((ext_vector_type(2))); typedef __bf16 bf16x2_t __attribute__((ext_vector_type(2)));
__device__ __forceinline__ unsigned cvt_pk_bf16(float lo, float hi) { f32x2_t v = {lo, hi}; bf16x2_t b = __builtin_convertvector(v, bf16x2_t); return __builtin_bit_cast(unsigned, b); }

struct DenseOrder {
    static constexpr bool GATHER = false;
    int nM, nN, nwg, G, c; bool pf;
    __device__ void init(int M, int N, int G_, int c_, bool pf_ = false) { nM = M / BM; nN = N / BM; nwg = nM * nN; G = G_; c = c_; pf = pf_; }
    __device__ bool next(int i, Unit& u) const {
        const long L = (long)i * G + c; if (L >= nwg) return false;
        int wgid = (int)L; { const int q = nwg / NXCD, r = nwg % NXCD, xcd = wgid % NXCD, off = wgid / NXCD; wgid = (xcd < r ? xcd * (q + 1) : r * (q + 1) + (xcd - r) * q) + off; }
        const int nig = WGM * nN, gid = wgid / nig, fm = gid * WGM, gsz = (nM - fm) < WGM ? (nM - fm) : WGM;
        u.pm = fm + ((wgid % nig) % gsz); u.pn = (wgid % nig) / gsz; u.e = 0; u.tm = 0; u.cnt = 0; return true;
    }
    __device__ __forceinline__ int a_row0(const Unit& u) const { return u.pm * BM; }
    __device__ __forceinline__ int a_row(const Unit& u, int r) const { return u.pm * BM + r; }
    __device__ __forceinline__ int b_row0(const Unit& u) const { return u.pn * BM; }
    __device__ __forceinline__ bool perm(const Unit&) const { return pf; }
    __device__ __forceinline__ void a_ready(const Unit&, int) const {}
};

template <class Epi, class Sched>
__device__ __forceinline__ void gemm_phase(LAS unsigned char* lds, const bf16_t* Aptr, const bf16_t* Btptr, const int K, const Sched& S, const Epi& E) {
    const int tid = threadIdx.x, wid = __builtin_amdgcn_readfirstlane(tid >> 6), lane = tid & 63, wr = wid >> 2, wc = wid & 3, fr = lane & 15, fq = lane >> 4;
    const int nt = K / BK;
    int sR[2], sC[2];
    unsigned voffA[2], voffBn[2], voffBp[2], voffB[2], nvB[2];
#pragma unroll
    for (int i = 0; i < 2; ++i) { int R, C; stage_rc(tid * 16 + i * 8192, R, C); const int Rb = (R & ~31) + perm32(R & 31);
        sR[i] = R; sC[i] = C; voffA[i] = (unsigned)(R * K + C) * 2u; voffBn[i] = (unsigned)(R * K + C) * 2u; voffBp[i] = (unsigned)(Rb * K + C) * 2u; }
    const size_t kstep = (size_t)(BK * 2);
    const size_t hstep = (size_t)HALF * K * 2;
    const size_t rowb = (size_t)K * 2;
    const unsigned ldsw = (unsigned)wid * 1024u;
    const int aoff = lds_byte(wr * 64 + fr, fq * 8), boff = lds_byte(wc * 32 + fr, fq * 8);
    const char* Ab = (const char*)Aptr;
#define PG8_SA(b, h) (((b) * 2 + (h)) * HTB)
#define PG8_SB(b, h) ((4 + (b) * 2 + (h)) * HTB)
#define PG8_STAGE(bufoff, gbase, voff) do { _Pragma("unroll") for (int _i = 0; _i < 2; ++_i) \
        __builtin_amdgcn_global_load_lds((const unsigned*)((const char*)(gbase) + (voff)[_i]), (LAS unsigned*)(lds + (bufoff) + ldsw + _i * 8192), 16, 0, 0); } while (0)
#define PG8_LDA(dst, b, h) do { _Pragma("unroll") for (int m = 0; m < 4; ++m) _Pragma("unroll") for (int k = 0; k < 2; ++k) dst[m][k] = *(const LAS bf16x8*)(lds + PG8_SA(b, h) + aoff + m * 2048 + k * 1024); } while (0)
#define PG8_LDB(dst, b, h) do { _Pragma("unroll") for (int n = 0; n < 2; ++n) _Pragma("unroll") for (int k = 0; k < 2; ++k) dst[n][k] = *(const LAS bf16x8*)(lds + PG8_SB(b, h) + boff + n * 2048 + k * 1024); } while (0)
#define PG8_MMA(ai, bj, At, Bt) do { __builtin_amdgcn_s_setprio(1); _Pragma("unroll") for (int m = 0; m < 4; ++m) _Pragma("unroll") for (int n = 0; n < 2; ++n) _Pragma("unroll") for (int k = 0; k < 2; ++k) \
        acc[ai][bj][m][n] = __builtin_amdgcn_mfma_f32_16x16x32_bf16(Bt[n][k], At[m][k], acc[ai][bj][m][n], 0, 0, 0); __builtin_amdgcn_s_setprio(0); } while (0)
#define PG8_WAIT_V(n) asm volatile("s_waitcnt vmcnt(" #n ")" ::: "memory")
#define PG8_WAIT_L(n) asm volatile("s_waitcnt lgkmcnt(" #n ")" ::: "memory")
#define PG8_BAR __builtin_amdgcn_s_barrier()
#define PG8_SCHED __builtin_amdgcn_sched_barrier(0)
    Unit cur, nxt; int ui = 0;
    if (!S.next(0, cur)) return;
    f32x4 acc[2][2][4][2];
#pragma unroll
    for (int a = 0; a < 2; ++a)
#pragma unroll
        for (int b = 0; b < 2; ++b)
#pragma unroll
            for (int m = 0; m < 4; ++m)
#pragma unroll
                for (int n = 0; n < 2; ++n) acc[a][b][m][n] = (f32x4){0.f, 0.f, 0.f, 0.f};
    bf16x8 At[4][2], B0[2][2], B1[2][2];
    const char* cA = Ab; unsigned cG[2][2];
    if constexpr (Sched::GATHER) {
#pragma unroll
        for (int h = 0; h < 2; ++h)
#pragma unroll
            for (int i = 0; i < 2; ++i) cG[h][i] = (unsigned)((size_t)S.a_row(cur, h * HALF + sR[i]) * rowb) + (unsigned)sC[i] * 2u;
    } else { cA = Ab + (ptrdiff_t)S.a_row0(cur) * (ptrdiff_t)rowb; cG[0][0] = cG[0][1] = cG[1][0] = cG[1][1] = 0u; }
    S.a_ready(cur, wid);
    const char* cB = (const char*)Btptr + (ptrdiff_t)S.b_row0(cur) * (ptrdiff_t)rowb;
    { const bool pc = S.perm(cur); voffB[0] = pc ? voffBp[0] : voffBn[0]; voffB[1] = pc ? voffBp[1] : voffBn[1]; }
#define PG8_STAGEA(bufoff, h, dbase, goffs, kb) do { if constexpr (Sched::GATHER) { PG8_STAGE(bufoff, Ab + (kb), (goffs)[h]); } else { PG8_STAGE(bufoff, (dbase) + (h) * hstep + (kb), voffA); } } while (0)
    PG8_STAGE(PG8_SB(0, 0), cB, voffB); PG8_STAGE(PG8_SB(0, 1), cB + hstep, voffB); PG8_STAGEA(PG8_SA(0, 0), 0, cA, cG, 0); PG8_STAGEA(PG8_SA(0, 1), 1, cA, cG, 0);
    if (wr == 1) PG8_BAR;
    PG8_WAIT_V(2); PG8_BAR;
    PG8_STAGE(PG8_SB(1, 0), cB + kstep, voffB); PG8_STAGEA(PG8_SA(1, 0), 0, cA, cG, kstep); PG8_STAGE(PG8_SB(1, 1), cB + hstep + kstep, voffB);
    PG8_WAIT_V(6); PG8_BAR;
    for (;;) {
        const bool has_next = S.next(ui + 1, nxt);
        const char* nA = cA; const char* nB = cB; unsigned nG[2][2];
#pragma unroll
        for (int h = 0; h < 2; ++h)
#pragma unroll
            for (int i = 0; i < 2; ++i) nG[h][i] = cG[h][i];
        nvB[0] = voffB[0]; nvB[1] = voffB[1];
        if (has_next) {
            nB = (const char*)Btptr + (ptrdiff_t)S.b_row0(nxt) * (ptrdiff_t)rowb;
            { const bool pn_ = S.perm(nxt); nvB[0] = pn_ ? voffBp[0] : voffBn[0]; nvB[1] = pn_ ? voffBp[1] : voffBn[1]; }
            if constexpr (Sched::GATHER) {
#pragma unroll
                for (int h = 0; h < 2; ++h)
#pragma unroll
                    for (int i = 0; i < 2; ++i) nG[h][i] = (unsigned)((size_t)S.a_row(nxt, h * HALF + sR[i]) * rowb) + (unsigned)sC[i] * 2u;
            } else nA = Ab + (ptrdiff_t)S.a_row0(nxt) * (ptrdiff_t)rowb;
        }
        for (int t = 0; t < nt; t += 2) {
            const bool last = (t == nt - 2);
            if (last && has_next) S.a_ready(nxt, wid);
            const size_t kb1 = (size_t)(t + 1) * kstep;
            const size_t kb2 = last ? 0 : (size_t)(t + 2) * kstep, kb3 = kb2 + kstep;
            const char* a2 = last ? nA : cA; const char* b2 = last ? nB : cB + (size_t)(t + 2) * kstep; const char* b3 = b2 + kstep;
            unsigned vB2[2]; vB2[0] = last ? nvB[0] : voffB[0]; vB2[1] = last ? nvB[1] : voffB[1];
            unsigned g2[2][2];
#pragma unroll
            for (int h = 0; h < 2; ++h)
#pragma unroll
                for (int i = 0; i < 2; ++i) g2[h][i] = last ? nG[h][i] : cG[h][i];
            PG8_LDB(B0, 0, 0); PG8_LDB(B1, 0, 1); PG8_SCHED; PG8_LDA(At, 0, 0); PG8_STAGEA(PG8_SA(1, 1), 1, cA, cG, kb1);
            PG8_WAIT_V(8); PG8_WAIT_L(0); PG8_BAR; PG8_MMA(0, 0, At, B0); PG8_MMA(0, 1, At, B1); PG8_BAR; PG8_SCHED;
            PG8_LDA(At, 0, 1); PG8_STAGE(PG8_SB(0, 0), b2, vB2); PG8_STAGE(PG8_SB(0, 1), b2 + hstep, vB2); PG8_STAGEA(PG8_SA(0, 0), 0, a2, g2, kb2);
            PG8_WAIT_V(8); PG8_WAIT_L(0); PG8_BAR; PG8_MMA(1, 0, At, B0); PG8_MMA(1, 1, At, B1); PG8_BAR; PG8_SCHED;
            PG8_LDB(B0, 1, 0); PG8_LDB(B1, 1, 1); PG8_SCHED; PG8_LDA(At, 1, 0); PG8_STAGEA(PG8_SA(0, 1), 1, a2, g2, kb2);
            PG8_WAIT_V(8); PG8_WAIT_L(0); PG8_BAR; PG8_MMA(0, 0, At, B0); PG8_MMA(0, 1, At, B1); PG8_BAR; PG8_SCHED;
            PG8_LDA(At, 1, 1); PG8_STAGE(PG8_SB(1, 0), b3, vB2); PG8_STAGE(PG8_SB(1, 1), b3 + hstep, vB2); PG8_STAGEA(PG8_SA(1, 0), 0, a2, g2, kb3);
            PG8_WAIT_V(8); PG8_WAIT_L(0); PG8_BAR; PG8_MMA(1, 0, At, B0); PG8_MMA(1, 1, At, B1); PG8_BAR; PG8_SCHED;
        }
        if (wr == 0) PG8_BAR;
        E(acc, cur, wr, wc, fr, fq);
        if (!has_next) break;
#pragma unroll
        for (int a = 0; a < 2; ++a)
#pragma unroll
            for (int b = 0; b < 2; ++b)
#pragma unroll
                for (int m = 0; m < 4; ++m)
#pragma unroll
                    for (int n = 0; n < 2; ++n) acc[a][b][m][n] = (f32x4){0.f, 0.f, 0.f, 0.f};
        cur = nxt; cA = nA; cB = nB; ++ui; voffB[0] = nvB[0]; voffB[1] = nvB[1];
#pragma unroll
        for (int h = 0; h < 2; ++h)
#pragma unroll
            for (int i = 0; i < 2; ++i) cG[h][i] = nG[h][i];
        if (wr == 1) PG8_BAR;
    }
    PG8_WAIT_V(0);
    PG8_BAR;
#undef PG8_SA
#undef PG8_SB
#undef PG8_STAGE
#undef PG8_STAGEA
#undef PG8_LDA
#undef PG8_LDB
#undef PG8_MMA
#undef PG8_WAIT_V
#undef PG8_WAIT_L
#undef PG8_BAR
#undef PG8_SCHED
}
}

#define XB_TMO      128
#define XB_XCNT(j)  (256  + 64 * (j))
#define XB_XSUB(j)  (1280 + 64 * (j))
#define XB_XGEN(j)  (2304 + 64 * (j))
#define XB_TOP      3328
#define XB_TOPGEN   3392
#define XCD_BAR_WORDS 3456
#define XB_SPIN_CAP (1u << 18)
__device__ __forceinline__ unsigned xb_ld(unsigned* p)              { return __hip_atomic_load(p, __ATOMIC_RELAXED, __HIP_MEMORY_SCOPE_AGENT); }
__device__ __forceinline__ unsigned xb_add(unsigned* p, unsigned v) { return __hip_atomic_fetch_add(p, v, __ATOMIC_RELAXED, __HIP_MEMORY_SCOPE_AGENT); }
__device__ __forceinline__ unsigned xb_xcc_id() { return (unsigned)__builtin_amdgcn_s_getreg((3 << 11) | 20) & 0xFu; }
#define XB_SPIN(cond, bar) do { unsigned _sp = 0; while (cond) { __builtin_amdgcn_s_sleep(1); \
    if ((++_sp & 255u) == 0u) { if (xb_ld(&(bar)[XB_TMO])) break; if (_sp > XB_SPIN_CAP) { atomicAdd(&(bar)[XB_TMO], 1u); break; } } } } while (0)
struct XcdBarrier { unsigned* bar; unsigned x; volatile LAS unsigned* st; };
__device__ __forceinline__ XcdBarrier xcd_barrier_post(unsigned* bar, volatile LAS unsigned* st) {
    XcdBarrier b; b.bar = bar; b.x = xb_xcc_id(); b.st = st;
    if (threadIdx.x == 0) (void)xb_add(&bar[XB_XCNT(b.x)], 1u);
    return b;
}
__device__ __forceinline__ void xcd_barrier_complete(unsigned* bar, unsigned x, unsigned& nloc, unsigned& nx) {
    const unsigned G = gridDim.x * gridDim.y * gridDim.z;
    unsigned sum, cnt, mine, sp = 0u;
    for (;;) {
        sum = 0u; cnt = 0u; mine = 0u;
#pragma unroll
        for (unsigned j = 0; j < 16; ++j) { const unsigned c = xb_ld(&bar[XB_XCNT(j)]); sum += c; cnt += (c > 0u) ? 1u : 0u; mine = (j == x) ? c : mine; }
        if (sum == G) break;
        __builtin_amdgcn_s_sleep(1);
        if ((++sp & 255u) == 0u) { if (xb_ld(&bar[XB_TMO])) break; if (sp > XB_SPIN_CAP) { atomicAdd(&bar[XB_TMO], 1u); break; } }
    }
    nloc = mine > 0u ? mine : 1u; nx = cnt > 0u ? cnt : 1u;
}
__device__ __forceinline__ void xcd_barrier(const XcdBarrier& b) {
    asm volatile("s_waitcnt vmcnt(0)" ::: "memory");
    __syncthreads();
    if (threadIdx.x == 0) {
        unsigned* bar = b.bar;
        __builtin_amdgcn_s_waitcnt(0);
        unsigned nloc = b.st[0], nx = b.st[1];
        if (nloc == 0u) { xcd_barrier_complete(bar, b.x, nloc, nx); b.st[0] = nloc; b.st[1] = nx; }
        const unsigned old = xb_add(&bar[XB_XSUB(b.x)], 1u);
        const unsigned gen = old / nloc;
        if (old + 1u == (gen + 1u) * nloc) {
            __builtin_amdgcn_fence(__ATOMIC_RELEASE, "agent");
            asm volatile("s_waitcnt vmcnt(0)" ::: "memory");
            const unsigned og = xb_add(&bar[XB_TOP], 1u);
            const unsigned tg = og / nx;
            if (og + 1u == (tg + 1u) * nx) xb_add(&bar[XB_TOPGEN], 1u);
            else XB_SPIN(xb_ld(&bar[XB_TOPGEN]) == tg, bar);
            __builtin_amdgcn_fence(__ATOMIC_ACQUIRE, "agent");
            xb_add(&bar[XB_XGEN(b.x)], 1u);
            asm volatile("s_waitcnt vmcnt(0)" ::: "memory");
        } else {
            XB_SPIN(xb_ld(&bar[XB_XGEN(b.x)]) == gen, bar);
            __builtin_amdgcn_fence(__ATOMIC_ACQUIRE, "agent");
            asm volatile("s_waitcnt vmcnt(0)" ::: "memory");
        }
    }
    __syncthreads();
}

using pg8::Unit;
typedef f32x4 acc_t[2][2][4][2];

struct EpiProj {
    static constexpr bool PERM = false;
    unsigned char* ws; const LAS float* ropeL; const LAS float* lbtL; int skip;
    template <int KIND> __device__ __forceinline__ void swapped(const acc_t& acc, const Unit& u, int wr, int wc, int fr, int fq, bool latent) const {
        constexpr size_t so2 = KIND == 0 ? WS_V : KIND == 1 ? WS_HQ : KIND == 2 ? WS_HI : KIND == 3 ? WS_LF : WS_LB;
        bf16* dT = (bf16*)(ws + so2);
        constexpr int ldt = (KIND == 1) ? T : MROWS;
        const int wrow0 = (u.pn & 1) * 256 + wr * 64 + fr, tcol0 = u.pm * 256 + wc * 32 + 8 * fq;
        const LAS float* lbt = lbtL + (KIND == 4 ? 512 : 0);
#pragma unroll
        for (int ai = 0; ai < 2; ++ai)
#pragma unroll
            for (int m = 0; m < 4; ++m) { const int wrow = wrow0 + ai * 128 + m * 16; float lb = 0.f; if (KIND >= 3) lb = lbt[wrow];
#pragma unroll
                for (int bj = 0; bj < 2; ++bj) { float x[8]; u32x4 w;
#pragma unroll
                    for (int j = 0; j < 4; ++j) { x[j] = acc[ai][bj][m][0][j]; x[4 + j] = acc[ai][bj][m][1][j]; }
                    if (KIND >= 3) {
#pragma unroll
                        for (int j = 0; j < 8; ++j) { const float sg = __builtin_amdgcn_rcpf(1.f + __expf(-x[j])); x[j] = __log2f(lb + (1.f - lb) * sg); }
                        w = (u32x4){pkh2(x[0], x[1]), pkh2(x[2], x[3]), pkh2(x[4], x[5]), pkh2(x[6], x[7])}; }
                    else { if (KIND == 1) {
#pragma unroll
                            for (int j = 0; j < 8; ++j) x[j] = silu_f(x[j]); }
                        w = (u32x4){pg8::cvt_pk_bf16(x[0], x[1]), pg8::cvt_pk_bf16(x[2], x[3]), pg8::cvt_pk_bf16(x[4], x[5]), pg8::cvt_pk_bf16(x[6], x[7])}; }
                    size_t off = (size_t)wrow * ldt + tcol0 + bj * 128;
                    if (KIND == 0) { const int tc = tcol0 + bj * 128, bb_ = latent ? (tc >> 11) : ((tc - T) >> 8), tl = latent ? (tc & (SEQ - 1)) : (KTOK - LC + ((tc - T) & (LC - 1)));
                        off = ((((size_t)(bb_ * NAH + (wrow >> 6)) * (KTOK / 64) + (tl >> 6)) * NAD + (wrow & 63)) * 64) + (tl & 63); }
                    __builtin_nontemporal_store((u32x4)(w), (u32x4*)(dT + off)); } }
    }
    template <int SEG, bool LAT> __device__ __forceinline__ void rope(const acc_t& acc, int row0, int lcp, int wc, int fq) const {
        bf16* dK = (bf16*)(ws + (SEG == 0 ? WS_QR : WS_K)); bf16* dQ = (bf16*)(ws + WS_Q);
#pragma unroll
        for (int ai = 0; ai < 2; ++ai)
#pragma unroll
            for (int m = 0; m < 4; ++m) { const int row = row0 + ai * 128 + m * 16, sq = row & (SEQ - 1); const int pos = (wc & 1) ? (sq & 63) : (sq >> 6);
                f32x4 cs0 = (f32x4){1.f, 0.f, 1.f, 0.f}, cs1 = cs0;
                if (LAT) { cs0 = *(const LAS f32x4*)(ropeL + (pos * 16 + 4 * fq) * 2); cs1 = *(const LAS f32x4*)(ropeL + (pos * 16 + 4 * fq) * 2 + 4); }
                const float cc[4] = {cs0[0], cs0[2], cs1[0], cs1[2]}, sn[4] = {cs0[1], cs0[3], cs1[1], cs1[3]};
#pragma unroll
                for (int bj = 0; bj < 2; ++bj) { const f32x4 x1 = acc[ai][bj][m][0], x2 = acc[ai][bj][m][1]; float o1[4], o2[4];
#pragma unroll
                    for (int j = 0; j < 4; ++j) { o1[j] = LAT ? x1[j] * cc[j] - x2[j] * sn[j] : x1[j]; o2[j] = LAT ? x2[j] * cc[j] + x1[j] * sn[j] : x2[j]; }
                    size_t off = (size_t)row * SEGW + lcp + bj * 128;
                    if (SEG == 0) __builtin_nontemporal_store((u32x4)((u32x4){pg8::cvt_pk_bf16(x1[0], x1[1]), pg8::cvt_pk_bf16(x1[2], x1[3]), pg8::cvt_pk_bf16(x2[0], x2[1]), pg8::cvt_pk_bf16(x2[2], x2[3])}), (u32x4*)(dQ + off));
                    else { const int cf = lcp + bj * 128, bb_ = LAT ? (row >> 11) : ((row - T) >> 8), tl = LAT ? sq : (KTOK - LC + ((row - T) & (LC - 1)));
                        off = ((size_t)(bb_ * NAH + (cf >> 6)) * KTOK + tl) * NAD + (cf & 63); }
                    __builtin_nontemporal_store((u32x4)((u32x4){pg8::cvt_pk_bf16(o1[0], o1[1]), pg8::cvt_pk_bf16(o1[2], o1[3]), pg8::cvt_pk_bf16(o2[0], o2[1]), pg8::cvt_pk_bf16(o2[2], o2[3])}), (u32x4*)(dK + off)); } }
    }
    __device__ __forceinline__ void operator()(const acc_t& acc, const Unit& u, int wr, int wc, int fr, int fq) const {
        const int seg = u.pn >> 1; const bool latent = u.pm < (T / 256);
        if (skip) return;
        if (!latent && (seg == 0 || seg == 3 || seg == 7)) return;
        if (u.e) {
            if (seg == 2) swapped<0>(acc, u, wr, wc, fr, fq, latent);
            else if (seg == 3) swapped<1>(acc, u, wr, wc, fr, fq, latent);
            else if (seg == 4) swapped<2>(acc, u, wr, wc, fr, fq, latent);
            else if (seg == 5) swapped<3>(acc, u, wr, wc, fr, fq, latent);
            else swapped<4>(acc, u, wr, wc, fr, fq, latent);
            return;
        }
        const int row0 = u.pm * 256 + wr * 64 + fr;
        const int lcp = (u.pn & 1) * 256 + wc * 32 + 8 * fq;
        if (seg <= 1) {
            if (seg == 0) rope<0, true>(acc, row0, lcp, wc, fq);
            else if (latent) rope<1, true>(acc, row0, lcp, wc, fq);
            else rope<1, false>(acc, row0, lcp, wc, fq);
            return;
        }
        bf16* dG = (bf16*)(ws + WS_G);
#pragma unroll
        for (int ai = 0; ai < 2; ++ai)
#pragma unroll
            for (int m = 0; m < 4; ++m) { const int row = row0 + ai * 128 + m * 16;
#pragma unroll
                for (int bj = 0; bj < 2; ++bj) { float x[8];
#pragma unroll
                    for (int j = 0; j < 4; ++j) { x[j] = silu_f(acc[ai][bj][m][0][j]); x[4 + j] = silu_f(acc[ai][bj][m][1][j]); }
                    __builtin_nontemporal_store((u32x4)((u32x4){pg8::cvt_pk_bf16(x[0], x[1]), pg8::cvt_pk_bf16(x[2], x[3]), pg8::cvt_pk_bf16(x[4], x[5]), pg8::cvt_pk_bf16(x[6], x[7])}), (u32x4*)(dG + (size_t)row * SEGW + lcp + bj * 128)); } }
    }
};
struct EpiP {
    static constexpr bool PERM = true;
    bf16* P;
    __device__ __forceinline__ void operator()(const acc_t& acc, const Unit& u, int wr, int wc, int fr, int fq) const {
        const int col0 = u.pn * 256 + wc * 32 + 8 * fq; const int row0 = u.pm * 256 + wr * 64 + fr;
#pragma unroll
        for (int ai = 0; ai < 2; ++ai)
#pragma unroll
            for (int m = 0; m < 4; ++m)
#pragma unroll
                for (int bj = 0; bj < 2; ++bj) { const f32x4 v0 = acc[ai][bj][m][0], v1 = acc[ai][bj][m][1];
                    *(u32x4*)(P + (size_t)(row0 + ai * 128 + m * 16) * D + col0 + bj * 128) = (u32x4){pg8::cvt_pk_bf16(v0[0], v0[1]), pg8::cvt_pk_bf16(v0[2], v0[3]), pg8::cvt_pk_bf16(v1[0], v1[1]), pg8::cvt_pk_bf16(v1[2], v1[3])}; }
    }
};
struct EpiSwiGLU {
    static constexpr bool PERM = true;
    bf16* H; gu32* tcnt;
    __device__ __forceinline__ void operator()(const acc_t& acc, const Unit& u, int wr, int wc, int fr, int fq) const {
        const int hc = u.pn * 128 + wc * 32 + 8 * fq; const int row0 = u.pm * 256 + wr * 64 + fr;
        const __amdgpu_buffer_rsrc_t hr = __builtin_amdgcn_make_buffer_rsrc((void*)H, (short)0, 0x7ffffff0, 0x00020000);
#pragma unroll
        for (int ai = 0; ai < 2; ++ai)
#pragma unroll
            for (int m = 0; m < 4; ++m) { float h[8];
#pragma unroll
                for (int n = 0; n < 2; ++n)
#pragma unroll
                    for (int j = 0; j < 4; ++j) h[n * 4 + j] = silu_f(acc[ai][0][m][n][j]) * acc[ai][1][m][n][j];
                u32x4 w; w.x = pg8::cvt_pk_bf16(h[0], h[1]); w.y = pg8::cvt_pk_bf16(h[2], h[3]); w.z = pg8::cvt_pk_bf16(h[4], h[5]); w.w = pg8::cvt_pk_bf16(h[6], h[7]);
                const unsigned off = (unsigned)(((size_t)(row0 + ai * 128 + m * 16) * DE + hc) * 2);
                __builtin_amdgcn_raw_buffer_store_b128(__builtin_bit_cast(bu4v, w), hr, (int)off, 0, 16); }
        if (tcnt) { asm volatile("s_waitcnt vmcnt(0)" ::: "memory");
            if (fr == 0 && fq == 0) (void)__hip_atomic_fetch_add(tcnt + u.pm, 1u, RLX_AGENT); }
    }
};
struct EpiMoeOut {
    static constexpr bool PERM = true;
    bf16* Y; const int* elist; const float* ewt;
    __device__ __forceinline__ void operator()(const acc_t& acc, const Unit& u, int wr, int wc, int fr, int fq) const {
        const int col0 = u.pn * 256 + wc * 32 + 8 * fq;
#pragma unroll
        for (int ai = 0; ai < 2; ++ai)
#pragma unroll
            for (int m = 0; m < 4; ++m) { const int rank = u.tm * 256 + ai * 128 + wr * 64 + m * 16 + fr;
                if (rank < u.cnt) { const int tk = elist[u.e * ECAP + rank]; const float w = ewt[u.e * ECAP + rank];
#pragma unroll
                    for (int bj = 0; bj < 2; ++bj) { const f32x4 v0 = acc[ai][bj][m][0] * w, v1 = acc[ai][bj][m][1] * w; u32x4 o;
                        o.x = pg8::cvt_pk_bf16(v0[0], v0[1]); o.y = pg8::cvt_pk_bf16(v0[2], v0[3]); o.z = pg8::cvt_pk_bf16(v1[0], v1[1]); o.w = pg8::cvt_pk_bf16(v1[2], v1[3]);
                        *(u32x4*)(Y + (size_t)tk * D + col0 + bj * 128) = o; } } }
    }
};
template <bool GATHER_> struct MoeOrder {
    static constexpr bool GATHER = GATHER_;
    const LAS int* tp; const int* elist; int G, c, nwg; gu32* tcnt;
    int rem = -1;
    __device__ bool next(int i, Unit& u) const {
        long L;
        if (rem < 0) L = (long)i * G + c;
        else { const int Lw = G - rem; L = c >= rem ? (i < 2 ? (long)(c - rem) + (long)i * Lw : 2L * Lw + c + (long)(i - 2) * G) : 2L * Lw + c + (long)i * G; }
        if (L >= nwg) return false;
        int wgid = (int)L; { const int q = nwg / 8, r = nwg % 8, xcd = wgid % 8, off = wgid / 8; wgid = (xcd < r ? xcd * (q + 1) : r * (q + 1) + (xcd - r) * q) + off; }
        const int gt = wgid >> 2; int e = 0;
#pragma unroll
        for (int k = 1; k < 16; ++k) e = (gt >= tp[k]) ? k : e;
        u.pm = gt; u.pn = wgid & 3; u.e = e; u.tm = gt - tp[e]; u.cnt = tp[17 + e]; return true;
    }
    __device__ __forceinline__ int a_row0(const Unit& u) const { return u.pm * 256; }
    __device__ __forceinline__ int a_row(const Unit& u, int r) const {
        if constexpr (GATHER_) { int rank = u.tm * 256 + r; rank = rank < u.cnt ? rank : u.cnt - 1; return elist[u.e * ECAP + rank] >> 1; }
        else return u.pm * 256 + r;
    }
    __device__ __forceinline__ int b_row0(const Unit& u) const { return u.e * 1024 + u.pn * 256; }
    __device__ __forceinline__ bool perm(const Unit&) const { return true; }
    __device__ __forceinline__ void a_ready(const Unit& u, int wid) const {
        if constexpr (!GATHER_) {
            if (tcnt) {
                if (wid == 0) { unsigned sp = 0; while (__hip_atomic_load(tcnt + u.pm, RLX_AGENT) < 32u) { __builtin_amdgcn_s_sleep(2); if (++sp > (1u << 20)) break; }
                    __builtin_amdgcn_fence(__ATOMIC_ACQUIRE, "agent"); asm volatile("s_waitcnt vmcnt(0)" ::: "memory"); }
                __builtin_amdgcn_s_barrier();
            }
        }
    }
};


constexpr int SWMASK = 0x7C;
constexpr int W_REL_XN = (int)(((long long)WS_WINT - (long long)WS_XN) / 2048);
struct ProjOrder {
    static constexpr bool GATHER = false;
    pg8::DenseOrder d; int G, c;
    static constexpr int NCTXU = (TC / 256) * 10;
    __device__ void init(int G_, int c_) { d.init(T, INCOLS, G_, c_); G = G_; c = c_; }
    __device__ bool next(int i, Unit& u) const {
        if (d.next(i, u)) { u.e = (SWMASK >> (u.pn >> 1)) & 1; return true; }
        const long j = (long)i * G + c - d.nwg;
        if (j < 0 || j >= NCTXU) return false;
        const int x = (int)j & 7, k = (int)j >> 3, pi = k >> 1;
        u.pm = T / 256 + 2 * x + (k & 1); u.pn = pi < 4 ? 2 + pi : 4 + pi; u.tm = 0; u.cnt = 0; u.e = (SWMASK >> (u.pn >> 1)) & 1; return true;
    }
    __device__ __forceinline__ int a_row0(const Unit& u) const { return u.e ? W_REL_XN + u.pn * 256 : u.pm * 256; }
    __device__ __forceinline__ int a_row(const Unit& u, int r) const { return a_row0(u) + r; }
    __device__ __forceinline__ int b_row0(const Unit& u) const { return u.e ? -W_REL_XN + u.pm * 256 : u.pn * 256; }
    __device__ __forceinline__ bool perm(const Unit& u) const { return (u.pn >> 1) >= 2; }
    __device__ __forceinline__ void a_ready(const Unit&, int) const {}
};


__device__ __forceinline__ bf16x8 pack8(const f32x4& a, const f32x4& b) {
    u32x4 w; w.x = pg8::cvt_pk_bf16(a[0], a[1]); w.y = pg8::cvt_pk_bf16(a[2], a[3]); w.z = pg8::cvt_pk_bf16(b[0], b[1]); w.w = pg8::cvt_pk_bf16(b[2], b[3]);
    return __builtin_bit_cast(bf16x8, w);
}
typedef unsigned bu4 __attribute__((__vector_size__(16)));
__device__ __forceinline__ bf16x8 bload16(__amdgpu_buffer_rsrc_t r, unsigned voff, unsigned soff) { return __builtin_bit_cast(bf16x8, __builtin_amdgcn_raw_buffer_load_b128(r, (int)voff, (int)soff, 0)); }
#define NA_SB() __builtin_amdgcn_sched_barrier(0)
__device__ __forceinline__ bf16x8 sel8(bool c, const bf16x8 a, const bf16x8 b) { const u32x4 x = __builtin_bit_cast(u32x4, a), y = __builtin_bit_cast(u32x4, b); u32x4 r;
    r.x = c ? x.x : y.x; r.y = c ? x.y : y.y; r.z = c ? x.z : y.z; r.w = c ? x.w : y.w; return __builtin_bit_cast(bf16x8, r); }
constexpr int NA_CTXK = 0, NA_CTXV = 32768, NA_RING = 65536, NA_SLOT = 16384;
#define NA_BAR() do { asm volatile("s_waitcnt lgkmcnt(0)" ::: "memory"); __builtin_amdgcn_s_barrier(); asm volatile("" ::: "memory"); } while (0)
struct NaState { f32x4 o[2][4]; float mref[2], lsum[2]; };
template <bool LOCAL>
__device__ __forceinline__ void na_step(NaState& st, const bf16x8 (&q)[2][2], const LAS unsigned char* kb, const LAS unsigned char* vb, unsigned vsw, const LAS float* bpi,
                                        bool setref, int qi, int g, int jb) {
    constexpr float SC = 0.125f * 1.44269504f; const float NEG = -1e30f;
    const int rg = qi >> 2;
    const unsigned kx = (unsigned)((rg << 1) | ((qi >> 1) & 1)), vx = (unsigned)((qi >> 1) & 7);
    const unsigned ka0 = (unsigned)(8 * rg + (qi & 3)) * 128u + (((unsigned)g ^ kx) << 4), ka1 = ka0 ^ 64u;
    const unsigned va = (unsigned)qi * 128u + (((unsigned)g ^ vx) << 4);
#pragma unroll
    for (int j = 0; j < 2; ++j) {
        const int jj = jb + j; const int P0 = (jj == 0) ? 0 : (jj == 1) ? 1 : (jj == 2) ? 3 : 4;
        const int pk = P0 + ((rg - P0) & 3), pv = P0 + ((g - P0) & 3);
        const unsigned kh = LOCAL ? (unsigned)(pk >> 2) * 4096u : 0u, vh = LOCAL ? (unsigned)(pv >> 2) * 64u : 0u;
        const bf16x8 a00 = *(const LAS bf16x8*)(kb + (ka0 + kh)), a01 = *(const LAS bf16x8*)(kb + (ka1 + kh)), a10 = *(const LAS bf16x8*)(kb + 512 + (ka0 + kh)), a11 = *(const LAS bf16x8*)(kb + 512 + (ka1 + kh));
        bf16x8 vf[4]; const unsigned vaj = (va ^ vsw) ^ vh;
#pragma unroll
        for (int dt = 0; dt < 4; ++dt) vf[dt] = *(const LAS bf16x8*)(vb + dt * 2048 + vaj);
        f32x4 s0 = __builtin_amdgcn_mfma_f32_16x16x32_bf16(a00, q[j][0], (f32x4){0.f, 0.f, 0.f, 0.f}, 0, 0, 0); s0 = __builtin_amdgcn_mfma_f32_16x16x32_bf16(a01, q[j][1], s0, 0, 0, 0);
        f32x4 s1 = __builtin_amdgcn_mfma_f32_16x16x32_bf16(a10, q[j][0], (f32x4){0.f, 0.f, 0.f, 0.f}, 0, 0, 0); s1 = __builtin_amdgcn_mfma_f32_16x16x32_bf16(a11, q[j][1], s1, 0, 0, 0);
        if (LOCAL) {
            const int bbj = 8 * pv - (16 * jj + qi) + 31;
            const int dlo = (jj == 0) ? (qi < 8 ? 31 - qi : 23) : (jj == 3) ? (qi > 8 ? 31 - qi : 23) : 23;
            const int lo_j = dlo - bbj; const LAS float* bpj = bpi + bbj;
            { float b0 = bpj[0], b1 = bpj[1], b2 = bpj[2], b3 = bpj[3];
              asm volatile("" : "+v"(b0), "+v"(b1), "+v"(b2), "+v"(b3));
              const float bq[4] = {b0, b1, b2, b3};
#pragma unroll
              for (int e = 0; e < 4; ++e) { const float t0 = s0[e] * SC + bq[e]; s0[e] = ((unsigned)(e - lo_j) < 16u) ? t0 : NEG; } }
            { float b0 = bpj[4], b1 = bpj[5], b2 = bpj[6], b3 = bpj[7];
              asm volatile("" : "+v"(b0), "+v"(b1), "+v"(b2), "+v"(b3));
              const float bq[4] = {b0, b1, b2, b3};
#pragma unroll
              for (int e = 0; e < 4; ++e) { const float t1 = s1[e] * SC + bq[e]; s1[e] = ((unsigned)(4 + e - lo_j) < 16u) ? t1 : NEG; } }
        } else {
#pragma unroll
            for (int e = 0; e < 4; ++e) { s0[e] *= SC; s1[e] *= SC; }
        }
        if (setref) { float mx = fmaxf(fmaxf(fmaxf(s0[0], s0[1]), fmaxf(s0[2], s0[3])), fmaxf(fmaxf(s1[0], s1[1]), fmaxf(s1[2], s1[3])));
            mx = fmaxf(mx, __shfl_xor(mx, 16)); mx = fmaxf(mx, __shfl_xor(mx, 32)); st.mref[j] = mx; }
        float ps = 0.f;
#pragma unroll
        for (int e = 0; e < 4; ++e) { s0[e] = __builtin_amdgcn_exp2f(fminf(s0[e] - st.mref[j], 100.f)); s1[e] = __builtin_amdgcn_exp2f(fminf(s1[e] - st.mref[j], 100.f)); ps += s0[e] + s1[e]; }
        st.lsum[j] += ps; const bf16x8 Bp = pack8(s0, s1);
#pragma unroll
        for (int dt = 0; dt < 4; ++dt) st.o[j][dt] = __builtin_amdgcn_mfma_f32_16x16x32_bf16(vf[dt], Bp, st.o[j][dt], 0, 0, 0);
    }
}
__device__ __forceinline__ void na_wg(LAS unsigned char* lds, int bb, int h, const bf16* Q, const bf16* QR, const bf16* KH, const bf16* VH, bf16* MIX, const LAS float* rpbL, int tid) {
    const int lane = tid & 63, w = __builtin_amdgcn_readfirstlane(tid >> 6), qi = lane & 15, g = lane >> 4;
    const int jb = 2 * (w & 1);
    const size_t bh = (size_t)(bb * NAH + h);
    { const u32x4* ksrc = (const u32x4*)(KH + (bh * KTOK + SEQ) * NAD); const u32x4* vsrc = (const u32x4*)(VH + (bh * (KTOK / 64) + SEQ / 64) * (NAD * 64));
#pragma unroll
      for (int j = 0; j < 4; ++j) { const int L = tid + NTHR * j; const u32x4 kv = ksrc[L], vv = vsrc[L];
          const int key = L >> 3, ch = L & 7, fk = (((key >> 3) & 3) << 1) | ((key >> 1) & 1);
          *(LAS u32x4*)(lds + NA_CTXK + key * 128 + ((ch ^ fk) << 4)) = kv;
          const int blk = L >> 9, dd = (L >> 3) & 63;
          *(LAS u32x4*)(lds + NA_CTXV + blk * 8192 + dd * 128 + ((ch ^ ((dd >> 1) & 7)) << 4)) = vv; } }
    const int skey = tid >> 3, sch = tid & 7;
    const unsigned skoff = (unsigned)(skey * 128 + ((sch ^ ((((skey >> 3) & 3) << 1) | ((skey >> 1) & 1))) << 4)), svoff = (unsigned)(8192 + skey * 128 + ((sch ^ ((skey >> 1) & 7)) << 4));
    const u32x4* kg = (const u32x4*)(KH + bh * KTOK * NAD) + tid;
    const u32x4* vg = (const u32x4*)(VH + bh * (KTOK / 64) * (NAD * 64)) + tid;
#pragma unroll 1
    for (int item = 0; item < 8; ++item) {
        const int r0 = 4 * item, r = r0 + (w >> 1);
        int rs = r - 4; rs = rs < 0 ? 0 : (rs > NROWS - 8 ? NROWS - 8 : rs);
        int rs0 = r0 - 4; rs0 = rs0 < 0 ? 0 : (rs0 > NROWS - 8 ? NROWS - 8 : rs0);
        int rs3 = r0 - 1; rs3 = rs3 < 0 ? 0 : (rs3 > NROWS - 8 ? NROWS - 8 : rs3);
        const int nloc = rs3 + 8 - rs0, off = rs - rs0;
        const int tok0 = bb * SEQ + r * GW;
        NaState st; bf16x8 qrot[2][2], qraw[2][2];
#pragma unroll
        for (int j = 0; j < 2; ++j) { st.mref[j] = 0.f; st.lsum[j] = 0.f;
#pragma unroll
            for (int dt = 0; dt < 4; ++dt) st.o[j][dt] = (f32x4){0.f, 0.f, 0.f, 0.f};
            const size_t qo = (size_t)(tok0 + 16 * (jb + j) + qi) * SEGW + h * NAD + 8 * g;
            qrot[j][0] = *(const bf16x8*)(QR + qo); qrot[j][1] = *(const bf16x8*)(QR + qo + 32); qraw[j][0] = *(const bf16x8*)(Q + qo); qraw[j][1] = *(const bf16x8*)(Q + qo + 32); }
        u32x4 sk = kg[(size_t)rs0 * 512], sv = vg[(size_t)rs0 * 512];
        *(LAS u32x4*)(lds + NA_RING + skoff) = sk; *(LAS u32x4*)(lds + NA_RING + svoff) = sv;
        sk = kg[(size_t)(rs0 + 1) * 512]; sv = vg[(size_t)(rs0 + 1) * 512];
        NA_BAR();
        int ic = 0;
#pragma unroll 1
        for (int slot = 0; slot < 16; ++slot) {
            if (slot + 1 < nloc) { const int rsl = (slot + 1) % 3; *(LAS u32x4*)(lds + NA_RING + rsl * NA_SLOT + skoff) = sk; *(LAS u32x4*)(lds + NA_RING + rsl * NA_SLOT + svoff) = sv; }
            { const int nr = slot + 2 < nloc ? slot + 2 : nloc - 1; sk = kg[(size_t)(rs0 + nr) * 512]; sv = vg[(size_t)(rs0 + nr) * 512]; }
            const int qz = qi, gz = g;
            const int il = slot - off;
            if (il >= 0 && il < 8) {
                const LAS unsigned char* rb = lds + NA_RING + (slot % 3) * NA_SLOT;
                na_step<true>(st, qrot, rb, rb + 8192, 0u, rpbL + (rs + il - r + 7) * 64, slot == 0, qz, gz, jb);
            } else {
                na_step<false>(st, qraw, lds + NA_CTXK + ic * 4096, lds + NA_CTXV + (ic >> 1) * 8192, (unsigned)(ic & 1) << 6, rpbL, slot == 0, qz, gz, jb);
                ++ic;
            }
            NA_BAR();
        }
#pragma unroll
        for (int j = 0; j < 2; ++j) { float l = st.lsum[j]; l += __shfl_xor(l, 16); l += __shfl_xor(l, 32); const float inv = 1.f / l;
            bf16* op = MIX + (size_t)(tok0 + 16 * (jb + j) + qi) * D + h * NAD + 4 * g;
#pragma unroll
            for (int dt = 0; dt < 4; ++dt) { const f32x4 v = st.o[j][dt] * inv; *(v2u*)(op + 16 * dt) = (v2u){pg8::cvt_pk_bf16(v[0], v[1]), pg8::cvt_pk_bf16(v[2], v[3])}; } }
    }
}

typedef float f32x16 __attribute__((ext_vector_type(16)));
constexpr int SC_Q1 = 0, SC_K1 = SC_Q1 + 64 * 272, SC_K1T = SC_K1 + 64 * 272, SC_VT = SC_K1T + 128 * 144, SC_ST = SC_VT + 128 * 144, SC_TOT = SC_ST + 128 * 272, SC_CST = SC_TOT + 2 * 4 * 128 * 4, SC_END = SC_CST + 2 * 128 * 4;
static_assert(SC_END <= RING_BYTES, "scan LDS");
#define SCAN_MFMA(a, b, c) __builtin_amdgcn_mfma_f32_32x32x16_bf16(a, b, c, 0, 0, 0)
#define SCAN_BAR() do { asm volatile("s_waitcnt lgkmcnt(0)" ::: "memory"); __builtin_amdgcn_s_barrier(); asm volatile("" ::: "memory"); } while (0)
__device__ __forceinline__ void scan_unit(LAS unsigned char* lds, int b, int h, int dir, const unsigned short* LGT, const bf16* HQT, const bf16* HIT, bf16* OUT, int tid) {
    const int lane = tid & 63, w = __builtin_amdgcn_readfirstlane(tid >> 6), r = lane & 31, hh = lane >> 5;
    const int d = tid & 127, tq = tid >> 7;
    const int ti = w >> 2, ovi = w & 3;
    const int di = w >> 1, svi = 2 * (w & 1);
    f32x16 S0, S1;
#pragma unroll
    for (int i = 0; i < 16; ++i) { S0[i] = 0.f; S1[i] = 0.f; }
    const size_t chrow = (size_t)(h * HGD + d);
    constexpr int NCH = (LC + SEQ) / 64;
    auto col_of = [&](int c) -> int { return c < 4 ? (T + b * LC + 64 * (dir ? 3 - c : c)) : (b * SEQ + (dir ? SEQ - 64 * (c - 3) : 64 * (c - 4))); };
    LAS float* totb = (LAS float*)(lds + SC_TOT); LAS float* cst = (LAS float*)(lds + SC_CST);
    u32x4 lg0[2], lg1[2], vr[2], qr[2], vn[2], qn[2];
    { const int c0 = col_of(0) + 16 * tq, c1 = col_of(1) + 16 * tq;
      lg0[0] = *(const u32x4*)(LGT + chrow * MROWS + c0); lg0[1] = *(const u32x4*)(LGT + chrow * MROWS + c0 + 8);
      lg1[0] = *(const u32x4*)(LGT + chrow * MROWS + c1); lg1[1] = *(const u32x4*)(LGT + chrow * MROWS + c1 + 8);
      vr[0] = *(const u32x4*)(HIT + chrow * MROWS + c0); vr[1] = *(const u32x4*)(HIT + chrow * MROWS + c0 + 8); qr[0] = qr[1] = (u32x4){0u, 0u, 0u, 0u};
      vn[0] = *(const u32x4*)(HIT + chrow * MROWS + c1); vn[1] = *(const u32x4*)(HIT + chrow * MROWS + c1 + 8); qn[0] = qn[1] = (u32x4){0u, 0u, 0u, 0u};
      float sm = 0.f;
#pragma unroll
      for (int i = 0; i < 8; ++i) { const unsigned u2 = lg0[i >> 2][i & 3]; sm += h2f((unsigned short)(u2 & 0xffff)) + h2f((unsigned short)(u2 >> 16)); }
      totb[tq * 128 + d] = sm; }
    SCAN_BAR();
#pragma unroll 1
    for (int c = 0; c < NCH; ++c) {
        const bool lat = c >= 4; const int par = c & 1;
        LAS float* tot = totb + par * 512;
        {
            float P[16], kk[16];
#pragma unroll
            for (int i = 0; i < 8; ++i) { const unsigned u2 = lg0[i >> 2][i & 3]; P[2 * i] = h2f((unsigned short)(u2 & 0xffff)); P[2 * i + 1] = h2f((unsigned short)(u2 >> 16)); }
#pragma unroll
            for (int i = 0; i < 16; ++i) kk[i] = 1.f - __builtin_amdgcn_exp2f(P[i]);
            if (!dir) {
#pragma unroll
                for (int i = 1; i < 16; ++i) P[i] += P[i - 1];
            } else {
#pragma unroll
                for (int i = 14; i >= 0; --i) P[i] += P[i + 1];
            }
            const float t0 = tot[d], t1 = tot[128 + d], t2 = tot[256 + d], t3 = tot[384 + d];
            const float Bm = dir ? (t2 + t3) : (t0 + t1);
            float offs; if (!dir) offs = (tq > 0 ? t0 : 0.f) + (tq > 1 ? t1 : 0.f) + (tq > 2 ? t2 : 0.f); else offs = (tq < 3 ? t3 : 0.f) + (tq < 2 ? t2 : 0.f) + (tq < 1 ? t1 : 0.f);
            const float sh = offs - Bm;
            if (tq == 0) { const float be = (t0 + t1) + (t2 + t3); cst[d] = __builtin_amdgcn_exp2f(be); cst[128 + d] = __builtin_amdgcn_exp2f(be - Bm); }
            unsigned kt[8];
            LAS bf16* q1 = (LAS bf16*)(lds + SC_Q1) + (16 * tq) * 136 + d; LAS bf16* k1 = (LAS bf16*)(lds + SC_K1) + (16 * tq) * 136 + d;
#pragma unroll
            for (int i = 0; i < 16; i += 2) {
                const float x0 = fminf(fmaxf(P[i] + sh, -120.f), 120.f), x1 = fminf(fmaxf(P[i + 1] + sh, -120.f), 120.f);
                const float k0 = kk[i] * __builtin_amdgcn_exp2f(-x0), k1v = kk[i + 1] * __builtin_amdgcn_exp2f(-x1);
                kt[i >> 1] = pg8::cvt_pk_bf16(k0, k1v);
                if (lat) { const unsigned qq = (i < 8 ? qr[0] : qr[1])[(i >> 1) & 3];
                    const unsigned qp2 = pg8::cvt_pk_bf16(bflo(qq) * __builtin_amdgcn_exp2f(x0), bfhi(qq) * __builtin_amdgcn_exp2f(x1));
                    q1[i * 136] = (bf16)(qp2 & 0xffff); q1[(i + 1) * 136] = (bf16)(qp2 >> 16);
                    k1[i * 136] = (bf16)(kt[i >> 1] & 0xffff); k1[(i + 1) * 136] = (bf16)(kt[i >> 1] >> 16); }
            }
            LAS unsigned char* k1t = lds + SC_K1T + d * 144 + 32 * tq;
            *(LAS u32x4*)k1t = (u32x4){kt[0], kt[1], kt[2], kt[3]}; *(LAS u32x4*)(k1t + 16) = (u32x4){kt[4], kt[5], kt[6], kt[7]};
            LAS unsigned char* vt = lds + SC_VT + d * 144 + 32 * tq;
            *(LAS u32x4*)vt = vr[0]; *(LAS u32x4*)(vt + 16) = vr[1];
        }
        if (lat) {
#pragma unroll
            for (int rg = 0; rg < 4; ++rg) { const int dd = 32 * di + 8 * rg + 4 * hh;
                const f32x4 a0 = *(const LAS f32x4*)(tot + dd), a1 = *(const LAS f32x4*)(tot + 128 + dd), a2 = *(const LAS f32x4*)(tot + 256 + dd), a3 = *(const LAS f32x4*)(tot + 384 + dd);
                const f32x4 bm = dir ? (a2 + a3) : (a0 + a1); float eb[4];
#pragma unroll
                for (int j = 0; j < 4; ++j) eb[j] = __builtin_amdgcn_exp2f(bm[j]);
                *(LAS v2u*)(lds + SC_ST + ((32 * svi + r) * 136 + dd) * 2) = (v2u){pg8::cvt_pk_bf16(S0[4 * rg] * eb[0], S0[4 * rg + 1] * eb[1]), pg8::cvt_pk_bf16(S0[4 * rg + 2] * eb[2], S0[4 * rg + 3] * eb[3])};
                *(LAS v2u*)(lds + SC_ST + ((32 * (svi + 1) + r) * 136 + dd) * 2) = (v2u){pg8::cvt_pk_bf16(S1[4 * rg] * eb[0], S1[4 * rg + 1] * eb[1]), pg8::cvt_pk_bf16(S1[4 * rg + 2] * eb[2], S1[4 * rg + 3] * eb[3])}; }
        }
        { float sm = 0.f;
#pragma unroll
            for (int i = 0; i < 8; ++i) { const unsigned u2 = lg1[i >> 2][i & 3]; sm += h2f((unsigned short)(u2 & 0xffff)) + h2f((unsigned short)(u2 >> 16)); }
            totb[(par ^ 1) * 512 + tq * 128 + d] = sm;
            lg0[0] = lg1[0]; lg0[1] = lg1[1]; vr[0] = vn[0]; vr[1] = vn[1]; qr[0] = qn[0]; qr[1] = qn[1];
            const int cm = c + 2 < NCH ? c + 2 : NCH - 1, cq = cm < 4 ? 4 : cm;
            const int c2 = col_of(cm) + 16 * tq, c2q = col_of(cq) + 16 * tq;
            vn[0] = *(const u32x4*)(HIT + chrow * MROWS + c2); vn[1] = *(const u32x4*)(HIT + chrow * MROWS + c2 + 8);
            qn[0] = *(const u32x4*)(HQT + chrow * T + c2q); qn[1] = *(const u32x4*)(HQT + chrow * T + c2q + 8);
            lg1[0] = *(const u32x4*)(LGT + chrow * MROWS + c2); lg1[1] = *(const u32x4*)(LGT + chrow * MROWS + c2 + 8); }
        SCAN_BAR();
        f32x16 dS0, dS1, O;
#pragma unroll
        for (int i = 0; i < 16; ++i) { dS0[i] = 0.f; dS1[i] = 0.f; O[i] = 0.f; }
        {
            bf16x8 fa[4], fb0[4], fb1[4];
#pragma unroll
            for (int ks = 0; ks < 4; ++ks) { fa[ks] = *(const LAS bf16x8*)(lds + SC_K1T + ((32 * di + r) * 72 + 16 * ks + 8 * hh) * 2);
                fb0[ks] = *(const LAS bf16x8*)(lds + SC_VT + ((32 * svi + r) * 72 + 16 * ks + 8 * hh) * 2); fb1[ks] = *(const LAS bf16x8*)(lds + SC_VT + ((32 * (svi + 1) + r) * 72 + 16 * ks + 8 * hh) * 2); }
#pragma unroll
            for (int ks = 0; ks < 4; ++ks) { dS0 = SCAN_MFMA(fa[ks], fb0[ks], dS0); dS1 = SCAN_MFMA(fa[ks], fb1[ks], dS1); }
        }
        if (lat) {
            bf16x8 fq[8];
#pragma unroll
            for (int ks = 0; ks < 8; ++ks) fq[ks] = *(const LAS bf16x8*)(lds + SC_Q1 + ((32 * ti + r) * 136 + 16 * ks + 8 * hh) * 2);
            {
                bf16x8 fs[8];
#pragma unroll
                for (int ks = 0; ks < 8; ++ks) fs[ks] = *(const LAS bf16x8*)(lds + SC_ST + ((32 * ovi + r) * 136 + 16 * ks + 8 * hh) * 2);
#pragma unroll
                for (int ks = 0; ks < 8; ++ks) O = SCAN_MFMA(fs[ks], fq[ks], O);
            }
#pragma unroll
            for (int si = 0; si < 2; ++si) {
                const bool live = dir ? (si >= ti) : (si <= ti);
                if (live) {
                    f32x16 At;
#pragma unroll
                    for (int i = 0; i < 16; ++i) At[i] = 0.f;
                    bf16x8 fk[8];
#pragma unroll
                    for (int ks = 0; ks < 8; ++ks) fk[ks] = *(const LAS bf16x8*)(lds + SC_K1 + ((32 * si + r) * 136 + 16 * ks + 8 * hh) * 2);
#pragma unroll
                    for (int ks = 0; ks < 8; ++ks) At = SCAN_MFMA(fk[ks], fq[ks], At);
                    const int tt = 32 * ti + r;
                    if (si == ti) {
#pragma unroll
                        for (int i = 0; i < 16; ++i) { const int ss = 32 * si + (i & 3) + 8 * (i >> 2) + 4 * hh; const bool keep = dir ? (ss >= tt) : (ss <= tt); At[i] = keep ? At[i] : 0.f; }
                    }
#pragma unroll
                    for (int k2 = 0; k2 < 2; ++k2) {
                        u32x4 pw; pw.x = pg8::cvt_pk_bf16(At[8 * k2], At[8 * k2 + 1]); pw.y = pg8::cvt_pk_bf16(At[8 * k2 + 2], At[8 * k2 + 3]); pw.z = pg8::cvt_pk_bf16(At[8 * k2 + 4], At[8 * k2 + 5]); pw.w = pg8::cvt_pk_bf16(At[8 * k2 + 6], At[8 * k2 + 7]);
                        const LAS unsigned char* vp = lds + SC_VT + ((32 * ovi + r) * 72 + 32 * si + 16 * k2 + 4 * hh) * 2;
                        const v2u lo = *(const LAS v2u*)vp, hi2 = *(const LAS v2u*)(vp + 16);
                        O = SCAN_MFMA(__builtin_bit_cast(bf16x8, (u32x4){lo.x, lo.y, hi2.x, hi2.y}), __builtin_bit_cast(bf16x8, pw), O);
                    }
                }
            }
            bf16* op = OUT + (size_t)(col_of(c) + 32 * ti + r) * SEGW + h * HGD + 32 * ovi + 4 * hh;
#pragma unroll
            for (int rg = 0; rg < 4; ++rg) *(v2u*)(op + 8 * rg) = (v2u){pg8::cvt_pk_bf16(O[4 * rg], O[4 * rg + 1]), pg8::cvt_pk_bf16(O[4 * rg + 2], O[4 * rg + 3])};
        }
#pragma unroll
        for (int rg = 0; rg < 4; ++rg) { const int dd = 32 * di + 8 * rg + 4 * hh;
            const f32x4 ee = *(const LAS f32x4*)(cst + dd), em = *(const LAS f32x4*)(cst + 128 + dd);
#pragma unroll
            for (int j = 0; j < 4; ++j) { S0[4 * rg + j] = ee[j] * S0[4 * rg + j] + em[j] * dS0[4 * rg + j]; S1[4 * rg + j] = ee[j] * S1[4 * rg + j] + em[j] * dS1[4 * rg + j]; } }
        SCAN_BAR();
    }
}

#ifdef DBG_NAIVE
__device__ __forceinline__ void scan_naive(LAS unsigned char* lds, int b, int h, int dir, const unsigned short* LGT, const bf16* HQT, const bf16* HIT, bf16* OUT, int tid) {
    const int dv = tid & 127, kg = tid >> 7;
    float St[32];
#pragma unroll
    for (int i = 0; i < 32; ++i) St[i] = 0.f;
    LAS float* sq = (LAS float*)lds; LAS float* sk = sq + 16 * 128; LAS float* sf = sk + 16 * 128; LAS float* sv = sf + 16 * 128; LAS float* so = sv + 16 * 128;
    constexpr int NSTEP = LC + SEQ;
    for (int j0 = 0; j0 < NSTEP; j0 += 16) {
        const bool isctx = j0 < LC;
        for (int idx = tid; idx < 16 * 128; idx += NTHR) { const int st = idx >> 7, ch = idx & 127, j = j0 + st;
            int col; if (j < LC) col = T + b * LC + (dir ? (LC - 1 - j) : j); else col = b * SEQ + (dir ? (SEQ - 1 - (j - LC)) : (j - LC));
            const size_t cr = (size_t)(h * HGD + ch);
            const float f = __builtin_amdgcn_exp2f(h2f(LGT[cr * MROWS + col]));
            sf[st * 128 + ch] = f; sk[st * 128 + ch] = 1.f - f; sv[st * 128 + ch] = bf2f(HIT[cr * MROWS + col]);
            if (!isctx) sq[st * 128 + ch] = bf2f(HQT[cr * T + col]); }
        __syncthreads();
        for (int st = 0; st < 16; ++st) {
            const float vv = sv[st * 128 + dv]; float o = 0.f;
#pragma unroll
            for (int i = 0; i < 32; ++i) { St[i] = sf[st * 128 + kg * 32 + i] * St[i] + sk[st * 128 + kg * 32 + i] * vv; o += St[i] * sq[st * 128 + kg * 32 + i]; }
            so[(st * 4 + kg) * 128 + dv] = o;
        }
        __syncthreads();
        if (!isctx) {
            for (int idx = tid; idx < 16 * 128; idx += NTHR) { const int st = idx >> 7, dd = idx & 127, j = j0 + st;
                const float o = (so[(st * 4 + 0) * 128 + dd] + so[(st * 4 + 1) * 128 + dd]) + (so[(st * 4 + 2) * 128 + dd] + so[(st * 4 + 3) * 128 + dd]);
                const int row = b * SEQ + (dir ? (SEQ - 1 - (j - LC)) : (j - LC));
                OUT[(size_t)row * SEGW + h * HGD + dd] = (bf16)f2bf(o); }
        }
        __syncthreads();
    }
}
#endif

constexpr int I_IN = 16 * 128, I_OUT = 16 * 32, I_13 = 16 * 2 * 256, I_2 = 16 * 256, NIT = I_IN + I_OUT + I_13 + I_2;
constexpr int DEFER13 = 4096;
struct TrPtrs { const float* w_in; const float* w_out; const float* w1; const float* w3; const float* w2; bf16* WinT; bf16* WoutT; bf16* W13T; bf16* W2T; };
struct TrItem { const float* W; bf16* WT; int ldw, k0, n0, ldk, drow0; };
__device__ __forceinline__ TrItem tr_decode(int r, const TrPtrs& P) {
    TrItem q;
    if (r < I_IN) { const int kb = r / 128, nb = r % 128; q.W = P.w_in; q.ldw = INCOLS; q.k0 = 64 * kb; q.n0 = 32 * nb; q.WT = P.WinT; q.ldk = 1024; q.drow0 = 32 * nb; return q; } r -= I_IN;
    if (r < I_OUT) { const int kb = r / 32, nb = r % 32; q.W = P.w_out; q.ldw = 1024; q.k0 = 64 * kb; q.n0 = 32 * nb; q.WT = P.WoutT; q.ldk = 1024; q.drow0 = 32 * nb; return q; } r -= I_OUT;
    if (r < I_13) { const int e = r / 512, rem = r % 512, sx = rem / 256, r2 = rem % 256, kb = r2 / 16, nb = r2 % 16, n0 = 32 * nb;
        q.W = (sx ? P.w3 : P.w1) + (size_t)e * 1024 * 512; q.ldw = 512; q.k0 = 64 * kb; q.n0 = n0; q.WT = P.W13T; q.ldk = 1024; q.drow0 = e * 1024 + 256 * (n0 / 128) + 128 * sx + (n0 % 128); return q; } r -= I_13;
    { const int e = r / 256, r2 = r % 256, kb = r2 / 32, nb = r2 % 32; q.W = P.w2 + (size_t)e * 512 * 1024; q.ldw = 1024; q.k0 = 64 * kb; q.n0 = 32 * nb; q.WT = P.W2T; q.ldk = 512; q.drow0 = e * 1024 + 32 * nb; return q; }
}
__device__ __forceinline__ void tr_load(const TrItem& q, f32x4 (&t)[8], int lane) {
#pragma unroll
    for (int i = 0; i < 8; ++i) t[i] = *(const f32x4*)(q.W + (size_t)(q.k0 + 8 * i + (lane >> 3)) * q.ldw + q.n0 + (lane & 7) * 4);
}
__device__ __forceinline__ void tr_store(const TrItem& q, const f32x4 (&t)[8], LAS float* scr, int lane) {
#pragma unroll
    for (int i = 0; i < 8; ++i) { LAS float* p = scr + (8 * i + (lane >> 3)) * 33 + (lane & 7) * 4; p[0] = t[i][0]; p[1] = t[i][1]; p[2] = t[i][2]; p[3] = t[i][3]; }
    LDS_WAIT(); asm volatile("" ::: "memory");
    const int c = lane & 7;
#pragma unroll
    for (int j = 0; j < 4; ++j) { const int n = (lane >> 3) + 8 * j; const LAS float* sp = scr + (8 * c) * 33 + n;
        v4u o; o.x = pk2(sp[0 * 33], sp[1 * 33]); o.y = pk2(sp[2 * 33], sp[3 * 33]); o.z = pk2(sp[4 * 33], sp[5 * 33]); o.w = pk2(sp[6 * 33], sp[7 * 33]);
        *(GAS v4u*)(q.WT + (size_t)(q.drow0 + n) * q.ldk + q.k0 + 8 * c) = o; }
    LDS_WAIT(); asm volatile("" ::: "memory");
}
template <bool DEFERRED> __device__ __forceinline__ int tr_map(int j) {
    if (DEFERRED) return j < I_OUT ? I_IN + j : I_IN + I_OUT + (I_13 - DEFER13) + (j - I_OUT);
    return j < I_IN ? j : j + I_OUT;
}
template <bool DEFERRED> __device__ __forceinline__ void tr_run(int first, int stride, const TrPtrs& P, LAS float* scr, int lane) {
    constexpr int count = DEFERRED ? I_OUT + DEFER13 + I_2 : I_IN + (I_13 - DEFER13);
    if (first >= count) return;
    TrItem nx = tr_decode(tr_map<DEFERRED>(first), P); f32x4 tn[8]; tr_load(nx, tn, lane);
#pragma unroll 1
    for (int j = first; j < count; j += stride) {
        const TrItem cur = nx; f32x4 t[8];
#pragma unroll
        for (int i = 0; i < 8; ++i) t[i] = tn[i];
        if (j + stride < count) { nx = tr_decode(tr_map<DEFERRED>(j + stride), P); tr_load(nx, tn, lane); }
        tr_store(cur, t, scr, lane);
    }
}

struct Args { const float* in[21]; float* out; unsigned char* ws; int ph_lo, ph_hi, li, pad; };

__global__ void __launch_bounds__(NTHR, 2) fwd_mega(Args args) {
    extern __shared__ __attribute__((aligned(16))) unsigned char lds_raw[];
    LAS unsigned char* lds = (LAS unsigned char*)lds_raw;
    volatile LAS unsigned* MISC = (volatile LAS unsigned*)(lds + MISC_OFF);
    const int tid = threadIdx.x, lane = tid & 63, wave = __builtin_amdgcn_readfirstlane(tid >> 6);
    const int G = gridDim.x; const int bx = blockIdx.x; const int vcu = (G % 8 == 0) ? (bx % 8) * (G / 8) + bx / 8 : bx;
    gu32* ctl0 = (gu32*)(args.ws + WS_CTL);
    const int gw = vcu * NWAVES + wave, NGW = G * NWAVES;
    for (int u = tid; u < (LDS_BYTES - LDSCTL_OFF) / 4; u += NTHR) ((LAS unsigned*)(lds + LDSCTL_OFF))[u] = 0u;
    __syncthreads();
    XcdBarrier bar = xcd_barrier_post((unsigned*)(ctl0 + CW_BAR) + args.li * XCD_BAR_WORDS, MISC + 8);
    const int lo = args.ph_lo, hi = args.ph_hi;
#ifndef PHMASK
#define PHMASK 0xFFFF
#endif
#define IN(k) (((PHMASK >> (k)) & 1) && lo <= (k) && (k) < hi)
#define SEAM(k) do { if (IN(k) && IN((k) + 1)) xcd_barrier(bar); } while (0)

#define KA(i) ({ const __attribute__((address_space(4))) Args* _p = (const __attribute__((address_space(4))) Args*)__builtin_amdgcn_kernarg_segment_ptr(); asm volatile("" : "+s"(_p)); _p->in[i]; })
#define WSP() ({ const __attribute__((address_space(4))) Args* _p = (const __attribute__((address_space(4))) Args*)__builtin_amdgcn_kernarg_segment_ptr(); asm volatile("" : "+s"(_p)); _p->ws; })
#define PHASE_PTRS unsigned char* ws = WSP(); float* MOD = (float*)(ws + WS_MOD); float* ROPE = (float*)(ws + WS_ROPE); float* LBT = (float*)(ws + WS_LBT); \
    bf16* WinT = (bf16*)(ws + WS_WINT); bf16* WoutT = (bf16*)(ws + WS_WOUTT); bf16* W13T = (bf16*)(ws + WS_W13T); bf16* W2T = (bf16*)(ws + WS_W2T); \
    bf16* XN = (bf16*)(ws + WS_XN); bf16* MIX = (bf16*)(ws + WS_MIX); bf16* XN2 = (bf16*)(ws + WS_XN2); \
    float* X1 = (float*)(ws + WS_X1); bf16* Hb = (bf16*)(ws + WS_H); bf16* Yb = (bf16*)(ws + WS_Y); \
    int* ELIST = (int*)(ws + WS_ELIST); float* EWT = (float*)(ws + WS_EWT); gu32* ctl = (gu32*)(ws + WS_CTL); \
    (void)MOD; (void)ROPE; (void)LBT; (void)WinT; (void)WoutT; (void)W13T; (void)W2T; (void)XN; (void)MIX; (void)XN2; (void)X1; (void)Hb; (void)Yb; (void)ELIST; (void)EWT; (void)ctl;
    if (IN(0)) {
        PHASE_PTRS
        const float* cvec = KA(1); const float* c_ctx = KA(3); const float* w_mod = KA(4); const float* b_mod = KA(5); const float* w_in = KA(8); const float* w_out = KA(9);
        const float* hg_lb = KA(11); const float* w1 = KA(17); const float* w3 = KA(18); const float* w2 = KA(19);
        if (bx == G - 1) {
            for (int idx = tid; idx < 1024; idx += NTHR) { const int pos = idx >> 4, i = idx & 15;
                double th = 1.0; for (int k = 0; k < i; ++k) th *= 0.5623413251903491;
                const double t2 = th * th; double c = 1.0, s = th, tc = 1.0, ts = th;
                for (int n = 1; n <= 12; ++n) { tc *= -t2 / (double)((2 * n - 1) * (2 * n)); c += tc; ts *= -t2 / (double)((2 * n) * (2 * n + 1)); s += ts; }
                double cr = 1.0, ci = 0.0; for (int p = 0; p < pos; ++p) { const double nr = cr * c - ci * s; ci = cr * s + ci * c; cr = nr; }
                ROPE[idx * 2] = (float)cr; ROPE[idx * 2 + 1] = (float)ci; }
            for (int idx = tid; idx < 1024; idx += NTHR) { const float h0 = hg_lb[idx], h1 = hg_lb[1024 + idx]; LBT[idx] = 1.f / (1.f + expf(h1 - h0)); }
        }
        if (bx < 96) {
            LAS float* sc = (LAS float*)lds;
            for (int idx = tid; idx < 17 * 1024; idx += NTHR) { const int r = idx >> 10, k = idx & 1023; const float cv = r < 16 ? cvec[r * 1024 + k] : c_ctx[k]; sc[idx] = cv / (1.f + expf(-cv)); }
            __syncthreads();
            const int cg = lane & 15, kr = lane >> 4, kbase = 128 * wave + 32 * kr;
            const float* wp = w_mod + (size_t)kbase * 6144 + 64 * bx + 4 * cg;
            f32x4 acc[17];
#pragma unroll
            for (int r = 0; r < 17; ++r) acc[r] = (f32x4){0.f, 0.f, 0.f, 0.f};
#pragma unroll 1
            for (int b8 = 0; b8 < 32; b8 += 8) {
                f32x4 wv[8];
#pragma unroll
                for (int i = 0; i < 8; ++i) wv[i] = *(const f32x4*)(wp + (size_t)(b8 + i) * 6144);
#pragma unroll
                for (int r = 0; r < 17; ++r) { const f32x4 a0 = *(const LAS f32x4*)(sc + r * 1024 + kbase + b8), a1 = *(const LAS f32x4*)(sc + r * 1024 + kbase + b8 + 4);
                    acc[r] += a0[0] * wv[0] + a0[1] * wv[1] + a0[2] * wv[2] + a0[3] * wv[3] + a1[0] * wv[4] + a1[1] * wv[5] + a1[2] * wv[6] + a1[3] * wv[7]; }
            }
            LAS float* red = (LAS float*)(lds + 17 * 1024 * 4);
#pragma unroll
            for (int r = 0; r < 17; ++r) {
#pragma unroll
                for (int q = 0; q < 4; ++q) { float v = acc[r][q]; v += __shfl_xor(v, 16); v += __shfl_xor(v, 32); acc[r][q] = v; }
                if (kr == 0) *(LAS f32x4*)(red + (wave * 17 + r) * 64 + 4 * cg) = acc[r]; }
            __syncthreads();
            for (int idx = tid; idx < 17 * 64; idx += NTHR) { const int r = idx >> 6, l = idx & 63; float sacc = 0.f;
#pragma unroll
                for (int w = 0; w < 8; ++w) sacc += red[(w * 17 + r) * 64 + l];
                MOD[r * 6144 + 64 * bx + l] = sacc + b_mod[64 * bx + l]; }
            __syncthreads();
        } else {
            const TrPtrs TP{w_in, w_out, w1, w3, w2, WinT, WoutT, W13T, W2T};
            tr_run<false>((bx - 96) * NWAVES + wave, (G - 96) * NWAVES, TP, (LAS float*)(lds + wave * 16384), lane);
        }
    }
    SEAM(0);

    if (IN(1)) {
        PHASE_PTRS
        const float* x = KA(0); const float* ctx = KA(2); const float* norm_mix = KA(6);
        for (int row = gw; row < MROWS; row += NGW) {
            const float* xr = row < T ? x + (size_t)row * D : ctx + (size_t)(row - T) * D; const int mb = row < T ? (row >> 11) : 16;
            f32x4 v[4]; float s = 0.f;
#pragma unroll
            for (int j = 0; j < 4; ++j) { v[j] = *(const f32x4*)(xr + 4 * lane + 256 * j); s += (v[j][0] * v[j][0] + v[j][1] * v[j][1]) + (v[j][2] * v[j][2] + v[j][3] * v[j][3]); }
            const float rstd = 1.f / sqrtf(wave_sum(s) * (1.f / D) + EPS);
#pragma unroll
            for (int j = 0; j < 4; ++j) { const int col = 4 * lane + 256 * j; const f32x4 g = *(const f32x4*)(norm_mix + col), sh = *(const f32x4*)(MOD + mb * 6144 + col), sc = *(const f32x4*)(MOD + mb * 6144 + 1024 + col);
                const f32x4 y = v[j] * rstd * g * (1.f + sc) + sh;
                *(v2u*)(XN + (size_t)row * D + col) = (v2u){pk2(y[0], y[1]), pk2(y[2], y[3])}; }
        }
    }
    SEAM(1);

    if (IN(2)) {
        PHASE_PTRS
        ProjOrder S; S.init(G, bx);
        LAS float* ropeL = (LAS float*)(lds + TAB_OFF); LAS float* lbtL = ropeL + 2048;
        for (int i = tid; i < 2048 + 1024; i += NTHR) ropeL[i] = i < 2048 ? ROPE[i] : LBT[i - 2048];
        __syncthreads();
        EpiProj E{ws, ropeL, lbtL, 0};
#ifdef PROBE_DUP
        const int subk = ({ const __attribute__((address_space(4))) Args* _p = (const __attribute__((address_space(4))) Args*)__builtin_amdgcn_kernarg_segment_ptr(); asm volatile("" : "+s"(_p)); _p->pad; });
        pg8::gemm_phase<EpiProj, ProjOrder>(lds + RING_OFF, XN, WinT, subk ? subk : D, S, E);
#else
        pg8::gemm_phase<EpiProj, ProjOrder>(lds + RING_OFF, XN, WinT, D, S, E);
#endif
        {
            const int nun = T / 256 * 16 + ProjOrder::NCTXU, maxun = (nun + G - 1) / G; int ntw = G * maxun - nun, ti = bx - (G - ntw);
            if (ntw == 0) { ntw = G; ti = bx; }
            if (ti >= 0) { const TrPtrs TP{KA(8), KA(9), KA(17), KA(18), KA(19), WinT, WoutT, W13T, W2T};
                tr_run<true>(ti * NWAVES + wave, ntw * NWAVES, TP, (LAS float*)(lds + wave * 16384), lane); }
        }
    }
    SEAM(2);

    if (IN(3)) {
        PHASE_PTRS
        const bf16* Qb = (const bf16*)(ws + WS_Q); const bf16* Kb = (const bf16*)(ws + WS_K); const bf16* Vb = (const bf16*)(ws + WS_V);
        const float* na_rpb = KA(10);
        const int subph = ({ const __attribute__((address_space(4))) Args* _p = (const __attribute__((address_space(4))) Args*)__builtin_amdgcn_kernarg_segment_ptr(); asm volatile("" : "+s"(_p)); _p->pad; });
#ifndef NO_SCAN
        if (bx < 128) {
            const int dir = bx & 1;
#ifdef DBG_NAIVE
            if (DBG_NAIVE & (1 << dir)) scan_naive(lds, bx >> 3, (bx >> 1) & 3, dir, (const unsigned short*)(ws + (dir ? WS_LB : WS_LF)), (const bf16*)(ws + WS_HQ), (const bf16*)(ws + WS_HI), (bf16*)(ws + (dir ? WS_OB : WS_OF)), tid);
            else
#endif
            if (subph != 2) scan_unit(lds, bx >> 3, (bx >> 1) & 3, dir, (const unsigned short*)(ws + (dir ? WS_LB : WS_LF)), (const bf16*)(ws + WS_HQ), (const bf16*)(ws + WS_HI), (bf16*)(ws + (dir ? WS_OB : WS_OF)), tid);
        } else
#endif
        {
            const int hx = bx & 7, bb = (bx - 128) >> 3;
            LAS float* rpbL = (LAS float*)(lds + TAB_OFF);
            for (int t2 = tid; t2 < 15 * 64; t2 += NTHR) { const int co = (t2 & 63) - 16, ro = t2 >> 6; rpbL[t2] = (co >= 0 && co < 31) ? na_rpb[(hx * 15 + ro) * 31 + co] * 1.44269504f : 0.f; }
            if (subph != 1) na_wg(lds, bb, hx, Qb, (const bf16*)(ws + WS_QR), Kb, Vb, MIX, rpbL, tid);
        }
    }
    SEAM(3);

    if (IN(4)) {
        PHASE_PTRS
        const float* hg_norm = KA(12);
        const bf16* OF = (const bf16*)(ws + WS_OF); const bf16* OB = (const bf16*)(ws + WS_OB); const bf16* Gb = (const bf16*)(ws + WS_G);
        for (int tok = gw; tok < T; tok += NGW) {
            const size_t off = (size_t)tok * SEGW + lane * 8;
            const v4u a = *(const v4u*)(OF + off), bb = *(const v4u*)(OB + off), g = *(const v4u*)(Gb + off);
            float o[8]; float ss = 0.f;
#pragma unroll
            for (int e = 0; e < 4; ++e) { o[2 * e] = bflo(a[e]) + bflo(bb[e]); o[2 * e + 1] = bfhi(a[e]) + bfhi(bb[e]);
#ifdef DBG_SANITIZE
                if (!(fabsf(o[2 * e]) < 1e30f)) o[2 * e] = 0.f; if (!(fabsf(o[2 * e + 1]) < 1e30f)) o[2 * e + 1] = 0.f;
#endif
                ss += o[2 * e] * o[2 * e] + o[2 * e + 1] * o[2 * e + 1]; }
            ss += __shfl_xor(ss, 1); ss += __shfl_xor(ss, 2); ss += __shfl_xor(ss, 4); ss += __shfl_xor(ss, 8);
            const float rstd = 1.f / sqrtf(ss * (1.f / HGD) + EPS);
            const int dv0 = (lane & 15) * 8;
            const f32x4 g0 = *(const f32x4*)(hg_norm + dv0), g1 = *(const f32x4*)(hg_norm + dv0 + 4);
            const float gg[8] = {g0[0], g0[1], g0[2], g0[3], g1[0], g1[1], g1[2], g1[3]};
            float y[8];
#pragma unroll
            for (int e = 0; e < 4; ++e) { y[2 * e] = o[2 * e] * rstd * gg[2 * e] * bflo(g[e]); y[2 * e + 1] = o[2 * e + 1] * rstd * gg[2 * e + 1] * bfhi(g[e]); }
            *(v4u*)(MIX + (size_t)tok * D + 512 + lane * 8) = (v4u){pk2(y[0], y[1]), pk2(y[2], y[3]), pk2(y[4], y[5]), pk2(y[6], y[7])};
        }
    }
    SEAM(4);

    if (IN(5)) {
        PHASE_PTRS
        pg8::DenseOrder S; S.init(T, D, G, bx, true);
        EpiP E{(bf16*)X1};
        pg8::gemm_phase<EpiP, pg8::DenseOrder>(lds + RING_OFF, MIX, WoutT, D, S, E);
    }
    SEAM(5);

    if (IN(6)) {
        PHASE_PTRS
        const float* norm_ffn = KA(7); const float* w_grp = KA(13); const float* b_grp = KA(14); const float* w_exp = KA(15); const float* b_exp = KA(16);
        LAS float* wst = (LAS float*)lds;
        LAS float* gscL = (LAS float*)(lds + 86016); LAS float* shvL = gscL + 1024;
        LAS float* cpart = (LAS float*)(lds + 94208); LAS float* cst = (LAS float*)(lds + 96256);
        LAS float* part = (LAS float*)(lds + 98304);
        LAS float* ssqp = (LAS float*)(lds + 114688);
        LAS float* tot = (LAS float*)(lds + 115200);
        LAS int* lcnt = (LAS int*)(lds + 117248);
        LAS int* tmpe = (LAS int*)(lds + 117376);
        const int rowbase = bx * 128, mb = rowbase >> 11;
        for (int idx = tid; idx < 5 * 1024; idx += NTHR) { const int quad = idx >> 10, col = idx & 1023;
            const f32x4 w = quad == 0 ? *(const f32x4*)(w_grp + col * 4) : *(const f32x4*)(w_exp + col * 16 + (quad - 1) * 4);
#pragma unroll
            for (int c = 0; c < 4; ++c) wst[col * 21 + quad * 4 + c] = w[c]; }
        for (int col = tid; col < 1024; col += NTHR) { gscL[col] = norm_ffn[col] * (1.f + MOD[mb * 6144 + 4096 + col]); shvL[col] = MOD[mb * 6144 + 3072 + col]; }
        if (tid < 32) lcnt[tid] = 0;
        __syncthreads();
        { const int idx = tid & 31, prt = tid >> 5; float sacc = 0.f;
            if (idx < 20) for (int c = 0; c < 64; ++c) sacc += shvL[prt * 64 + c] * wst[(prt * 64 + c) * 21 + idx];
            cpart[prt * 32 + idx] = sacc; }
        __syncthreads();
        if (tid < 32) { float sacc = 0.f;
            for (int p = 0; p < 16; ++p) sacc += cpart[p * 32 + tid];
            cst[tid] = tid < 4 ? sacc + b_grp[tid] : tid < 20 ? sacc + b_exp[tid - 4] : 0.f; }
        const int r = lane & 15, kg = lane >> 4, cb = 128 * wave + 8 * kg;
        bf16x8 whi[2][4], wlo[2][4];
#pragma unroll
        for (int t = 0; t < 2; ++t)
#pragma unroll
            for (int sx = 0; sx < 4; ++sx) { float wv[8];
#pragma unroll
                for (int j = 0; j < 8; ++j) { const int col = cb + 32 * sx + j; const int n = 16 * t + r; wv[j] = n < 20 ? gscL[col] * wst[col * 21 + (n < 20 ? n : 0)] : 0.f; }
                u32x4 h, l;
#pragma unroll
                for (int e = 0; e < 4; ++e) { h[e] = pg8::cvt_pk_bf16(wv[2 * e], wv[2 * e + 1]); l[e] = pg8::cvt_pk_bf16(wv[2 * e] - bflo(h[e]), wv[2 * e + 1] - bfhi(h[e])); }
                whi[t][sx] = __builtin_bit_cast(bf16x8, h); wlo[t][sx] = __builtin_bit_cast(bf16x8, l); }
        f32x4 gaa[4][2];
#pragma unroll
        for (int sx = 0; sx < 4; ++sx) { gaa[sx][0] = *(const f32x4*)(MOD + mb * 6144 + 2048 + cb + 32 * sx); gaa[sx][1] = *(const f32x4*)(MOD + mb * 6144 + 2048 + cb + 32 * sx + 4); }
        const float* xin = KA(0); const bf16* Pb = (const bf16*)X1; bf16* X1B = (bf16*)(ws + WS_X1B);
        f32x4 xn[4][2]; u32x4 pn[4];
#define P6_LOAD(it_) do { const size_t o_ = (size_t)(rowbase + 16 * (it_) + r) * D + cb; _Pragma("unroll") for (int sx = 0; sx < 4; ++sx) { \
            xn[sx][0] = *(const f32x4*)(xin + o_ + 32 * sx); xn[sx][1] = *(const f32x4*)(xin + o_ + 32 * sx + 4); pn[sx] = *(const u32x4*)(Pb + o_ + 32 * sx); } } while (0)
        P6_LOAD(0);
        __syncthreads();
#pragma unroll 1
        for (int it = 0; it < 8; ++it) {
            asm volatile("" ::: "memory");
            f32x4 v[4][2]; float ss = 0.f;
#pragma unroll
            for (int sx = 0; sx < 4; ++sx) {
                v[sx][0] = xn[sx][0] + gaa[sx][0] * (f32x4){bflo(pn[sx][0]), bfhi(pn[sx][0]), bflo(pn[sx][1]), bfhi(pn[sx][1])};
                v[sx][1] = xn[sx][1] + gaa[sx][1] * (f32x4){bflo(pn[sx][2]), bfhi(pn[sx][2]), bflo(pn[sx][3]), bfhi(pn[sx][3])}; }
            if (it < 7) P6_LOAD(it + 1);
#pragma unroll
            for (int sx = 0; sx < 4; ++sx)
                *(u32x4*)(X1B + (size_t)(rowbase + 16 * it + r) * D + cb + 32 * sx) = (u32x4){pg8::cvt_pk_bf16(v[sx][0][0], v[sx][0][1]), pg8::cvt_pk_bf16(v[sx][0][2], v[sx][0][3]), pg8::cvt_pk_bf16(v[sx][1][0], v[sx][1][1]), pg8::cvt_pk_bf16(v[sx][1][2], v[sx][1][3])};
            f32x4 acc0 = {0.f, 0.f, 0.f, 0.f}, acc1 = {0.f, 0.f, 0.f, 0.f};
#pragma unroll
            for (int sx = 0; sx < 4; ++sx) {
                ss += ((v[sx][0][0] * v[sx][0][0] + v[sx][0][1] * v[sx][0][1]) + (v[sx][0][2] * v[sx][0][2] + v[sx][0][3] * v[sx][0][3])) + ((v[sx][1][0] * v[sx][1][0] + v[sx][1][1] * v[sx][1][1]) + (v[sx][1][2] * v[sx][1][2] + v[sx][1][3] * v[sx][1][3]));
                u32x4 h, l;
#pragma unroll
                for (int e = 0; e < 4; ++e) { const float a0 = v[sx][e >> 1][2 * (e & 1)], a1 = v[sx][e >> 1][2 * (e & 1) + 1]; h[e] = pg8::cvt_pk_bf16(a0, a1); l[e] = pg8::cvt_pk_bf16(a0 - bflo(h[e]), a1 - bfhi(h[e])); }
                const bf16x8 ah = __builtin_bit_cast(bf16x8, h), al = __builtin_bit_cast(bf16x8, l);
                acc0 = __builtin_amdgcn_mfma_f32_16x16x32_bf16(ah, whi[0][sx], acc0, 0, 0, 0); acc1 = __builtin_amdgcn_mfma_f32_16x16x32_bf16(ah, whi[1][sx], acc1, 0, 0, 0);
                acc0 = __builtin_amdgcn_mfma_f32_16x16x32_bf16(al, whi[0][sx], acc0, 0, 0, 0); acc1 = __builtin_amdgcn_mfma_f32_16x16x32_bf16(al, whi[1][sx], acc1, 0, 0, 0);
                acc0 = __builtin_amdgcn_mfma_f32_16x16x32_bf16(ah, wlo[0][sx], acc0, 0, 0, 0); acc1 = __builtin_amdgcn_mfma_f32_16x16x32_bf16(ah, wlo[1][sx], acc1, 0, 0, 0); }
            ss += __shfl_xor(ss, 16); ss += __shfl_xor(ss, 32);
#pragma unroll
            for (int rg = 0; rg < 4; ++rg) { part[((wave * 2 + 0) * 16 + 4 * kg + rg) * 16 + r] = acc0[rg]; part[((wave * 2 + 1) * 16 + 4 * kg + rg) * 16 + r] = acc1[rg]; }
            if (kg == 0) ssqp[wave * 16 + r] = ss;
            NA_BAR();
            { const int tk = tid >> 5, idx = tid & 31; float sacc = 0.f;
                if (idx < 20) {
#pragma unroll
                    for (int w = 0; w < 8; ++w) sacc += part[((w * 2 + (idx >> 4)) * 16 + tk) * 16 + (idx & 15)]; }
                else if (idx == 20) {
#pragma unroll
                    for (int w = 0; w < 8; ++w) sacc += ssqp[w * 16 + tk]; }
                tot[tk * 32 + idx] = sacc; }
            NA_BAR();
            const float rstd = 1.f / sqrtf(tot[r * 32 + 20] * (1.f / D) + EPS);
#pragma unroll
            for (int sx = 0; sx < 4; ++sx) {
                const f32x4 g0 = *(const LAS f32x4*)(gscL + cb + 32 * sx), g1 = *(const LAS f32x4*)(gscL + cb + 32 * sx + 4), s0 = *(const LAS f32x4*)(shvL + cb + 32 * sx), s1 = *(const LAS f32x4*)(shvL + cb + 32 * sx + 4);
                const f32x4 y0 = v[sx][0] * rstd * g0 + s0, y1 = v[sx][1] * rstd * g1 + s1;
                *(u32x4*)(XN2 + (size_t)(rowbase + 16 * it + r) * D + cb + 32 * sx) = (u32x4){pg8::cvt_pk_bf16(y0[0], y0[1]), pg8::cvt_pk_bf16(y0[2], y0[3]), pg8::cvt_pk_bf16(y1[0], y1[1]), pg8::cvt_pk_bf16(y1[2], y1[3])}; }
            if (wave == it && lane < 16) {
                const LAS float* lgr = tot + lane * 32;
                {
                    float gl[4];
#pragma unroll
                    for (int k = 0; k < 4; ++k) gl[k] = rstd * lgr[k] + cst[k];
                    int gs = 0; float gm = gl[0];
#pragma unroll
                    for (int k = 1; k < 4; ++k) if (gl[k] > gm) { gm = gl[k]; gs = k; }
                    float den = 0.f;
#pragma unroll
                    for (int k = 0; k < 4; ++k) den += __expf(gl[k] - gm);
                    const float g_w = 1.f / den;
                    float ev[4];
#pragma unroll
                    for (int k = 0; k < 4; ++k) ev[k] = rstd * lgr[4 + gs * 4 + k] + cst[4 + gs * 4 + k];
                    int i0 = 0; float v0 = ev[0];
#pragma unroll
                    for (int k = 1; k < 4; ++k) if (ev[k] > v0) { v0 = ev[k]; i0 = k; }
                    int i1 = -1; float v1 = -INFINITY;
#pragma unroll
                    for (int k = 0; k < 4; ++k) if (k != i0 && ev[k] > v1) { v1 = ev[k]; i1 = k; }
                    if (i1 < 0) { i1 = (i0 + 1) & 3; v1 = v0; }
                    const float e1 = __expf(v1 - v0); const float w0 = g_w / (1.f + e1), w1w = g_w * e1 / (1.f + e1);
                    const int ea = gs * 4 + i0, eb = gs * 4 + i1;
                    const int ra = __hip_atomic_fetch_add(&lcnt[ea], 1, __ATOMIC_RELAXED, __HIP_MEMORY_SCOPE_WORKGROUP), rb = __hip_atomic_fetch_add(&lcnt[eb], 1, __ATOMIC_RELAXED, __HIP_MEMORY_SCOPE_WORKGROUP);
                    const int lr = (16 * it + lane) * 2;
                    tmpe[lr] = ea; tmpe[256 + lr] = ra; tmpe[512 + lr] = __builtin_bit_cast(int, w0);
                    tmpe[lr + 1] = eb; tmpe[256 + lr + 1] = rb; tmpe[512 + lr + 1] = __builtin_bit_cast(int, w1w);
                }
            }
        }
#undef P6_LOAD
        __syncthreads();
        if (tid < 16) lcnt[16 + tid] = (int)__hip_atomic_fetch_add(ctl + CW_CNT + tid, (unsigned)lcnt[tid], RLX_AGENT);
        __syncthreads();
        if (tid < 256) { const int e = tmpe[tid], pos = lcnt[16 + e] + tmpe[256 + tid]; const int tok = bx * 128 + (tid >> 1);
            ELIST[e * ECAP + pos] = tok * 2 + (tid & 1); EWT[e * ECAP + pos] = __builtin_bit_cast(float, tmpe[512 + tid]); }
        __syncthreads();
    }
    SEAM(6);

    if (IN(7) || IN(8)) {
        PHASE_PTRS
        LAS int* tp = (LAS int*)(lds + MOE_OFF);
        if (tid == 0) { int acc = 0;
            for (int e = 0; e < 16; ++e) { const int c = (int)__hip_atomic_load(ctl + CW_CNT + e, RLX_AGENT); tp[e] = acc; tp[17 + e] = c; acc += (c + 255) >> 8; }
            tp[16] = acc; }
        __syncthreads();
    }
    if (IN(7)) {
        PHASE_PTRS
        const LAS int* tp = (const LAS int*)(lds + MOE_OFF);
        const int nu = tp[16] * 4; const bool merged = IN(8);
        gu32* tc = merged ? (gu32*)(ctl + CW_TILE) : (gu32*)nullptr;
        { MoeOrder<true> S{tp, ELIST, G, bx, nu, (gu32*)nullptr};
          EpiSwiGLU E{Hb, tc};
          pg8::gemm_phase<EpiSwiGLU, MoeOrder<true>>(lds + RING_OFF, XN2, W13T, D, S, E); }
        if (merged) {
          MoeOrder<false> S{tp, ELIST, G, bx, nu, tc, nu % G};
          EpiMoeOut E{Yb, ELIST, EWT};
          pg8::gemm_phase<EpiMoeOut, MoeOrder<false>>(lds + RING_OFF, Hb, W2T, DE, S, E); }
    }
    if (IN(8) && !IN(7)) {
        PHASE_PTRS
        const LAS int* tp = (const LAS int*)(lds + MOE_OFF);
        MoeOrder<false> S{tp, ELIST, G, bx, tp[16] * 4, (gu32*)nullptr};
        EpiMoeOut E{Yb, ELIST, EWT};
        pg8::gemm_phase<EpiMoeOut, MoeOrder<false>>(lds + RING_OFF, Hb, W2T, DE, S, E);
    }
    SEAM(8);

    if (IN(9)) {
        PHASE_PTRS
        const float* norm_final = KA(20); float* outp = ({ const __attribute__((address_space(4))) Args* _p = (const __attribute__((address_space(4))) Args*)__builtin_amdgcn_kernarg_segment_ptr(); asm volatile("" : "+s"(_p)); _p->out; });
        const bf16* X1B = (const bf16*)(ws + WS_X1B);
        const int rowbase = gw * 16, mb = rowbase >> 11;
        f32x4 gaf[4], nf[4];
#pragma unroll
        for (int h2 = 0; h2 < 4; ++h2) { const int col = 8 * lane + 512 * (h2 >> 1) + 4 * (h2 & 1);
            gaf[h2] = *(const f32x4*)(MOD + mb * 6144 + 5120 + col); nf[h2] = *(const f32x4*)(norm_final + col); }
        u32x4 pn[2], y0n[2], y1n[2];
#define P9_LOAD(row_) do { _Pragma("unroll") for (int jj = 0; jj < 2; ++jj) { const size_t o_ = (size_t)(row_) * D + 8 * lane + 512 * jj; \
            pn[jj] = *(const u32x4*)(X1B + o_); \
            y0n[jj] = *(const u32x4*)(Yb + (size_t)(row_) * (2 * D) + 8 * lane + 512 * jj); y1n[jj] = *(const u32x4*)(Yb + (size_t)(row_) * (2 * D) + D + 8 * lane + 512 * jj); } } while (0)
        P9_LOAD(rowbase);
#pragma unroll 1
        for (int i = 0; i < 16; ++i) {
            const int row = rowbase + i;
            u32x4 pc[2], y0c[2], y1c[2];
#pragma unroll
            for (int k = 0; k < 2; ++k) { pc[k] = pn[k]; y0c[k] = y0n[k]; y1c[k] = y1n[k]; }
            if (i < 15) P9_LOAD(row + 1);
            f32x4 v[4]; float ssq = 0.f;
#pragma unroll
            for (int h2 = 0; h2 < 4; ++h2) { const int jj = h2 >> 1, q2 = (h2 & 1) * 2;
                const f32x4 pf = (f32x4){bflo(pc[jj][q2]), bfhi(pc[jj][q2]), bflo(pc[jj][q2 + 1]), bfhi(pc[jj][q2 + 1])};
                const f32x4 ys = (f32x4){bflo(y0c[jj][q2]) + bflo(y1c[jj][q2]), bfhi(y0c[jj][q2]) + bfhi(y1c[jj][q2]), bflo(y0c[jj][q2 + 1]) + bflo(y1c[jj][q2 + 1]), bfhi(y0c[jj][q2 + 1]) + bfhi(y1c[jj][q2 + 1])};
                v[h2] = pf + gaf[h2] * ys;
                ssq += (v[h2][0] * v[h2][0] + v[h2][1] * v[h2][1]) + (v[h2][2] * v[h2][2] + v[h2][3] * v[h2][3]); }
            const float rstd = 1.f / sqrtf(wave_sum(ssq) * (1.f / D) + EPS);
#pragma unroll
            for (int h2 = 0; h2 < 4; ++h2) *(f32x4*)(outp + (size_t)row * D + 8 * lane + 512 * (h2 >> 1) + 4 * (h2 & 1)) = v[h2] * rstd * nf[h2];
        }
#undef P9_LOAD
    }
#undef IN
#undef SEAM
}

#ifndef MK_N_LAUNCHES
#define MK_N_LAUNCHES 1
#endif
constexpr int NPHASE = 10;
extern "C" void kernel_launch(void* const* d_in, const int* in_sizes, int n_in, void* d_out, int out_size, void* d_ws, size_t ws_size, hipStream_t stream) {
    static int grid = 0;
    if (grid == 0) {
        if (n_in != 21 || in_sizes[0] != T * D || out_size != T * D || ws_size < WS_END) { fprintf(stderr, "kernel_launch: unexpected shapes (n_in %d, in0 %d, out %d, ws %zu)\n", n_in, n_in > 0 ? in_sizes[0] : -1, out_size, ws_size); grid = -1; return; }
        int dev = 0, cus = 0, per_cu = 0;
        if (hipGetDevice(&dev) != hipSuccess || hipDeviceGetAttribute(&cus, hipDeviceAttributeMultiprocessorCount, dev) != hipSuccess) { grid = -1; return; }
        if (hipFuncSetAttribute((const void*)fwd_mega, hipFuncAttributeMaxDynamicSharedMemorySize, LDS_BYTES) != hipSuccess) { fprintf(stderr, "kernel_launch: hipFuncSetAttribute failed\n"); grid = -1; return; }
        if (hipOccupancyMaxActiveBlocksPerMultiprocessor(&per_cu, (const void*)fwd_mega, NTHR, LDS_BYTES) != hipSuccess || per_cu < 1) fprintf(stderr, "kernel_launch: occupancy query reports %d\n", per_cu);
        (void)hipGetLastError();
        grid = cus;
        if (grid != 256) fprintf(stderr, "kernel_launch: %d CUs (built for 256)\n", grid);
    }
    if (grid < 0) return;
    (void)hipMemsetAsync((char*)d_ws + WS_CTL, 0, CTL_ZERO_BYTES, stream);
    Args a{};
    for (int i = 0; i < 21; ++i) a.in[i] = (const float*)d_in[i];
    a.out = (float*)d_out; a.ws = (unsigned char*)d_ws;
    if (MK_N_LAUNCHES == 1) {
        a.ph_lo = 0; a.ph_hi = NPHASE; a.li = 0;
        hipLaunchKernelGGL(fwd_mega, dim3(grid), dim3(NTHR), LDS_BYTES, stream, a);
    } else {
        for (int li = 0; li < NPHASE; ++li) { a.ph_lo = li; a.ph_hi = li + 1; a.li = 0;
#ifdef PROBE_DUP
            if (li == PROBE_DUP) {
#ifdef PROBE_SUB
                a.pad = PROBE_SUB;
#endif
                hipLaunchKernelGGL(fwd_mega, dim3(grid), dim3(NTHR), LDS_BYTES, stream, a); a.pad = 0; }
#endif
            hipLaunchKernelGGL(fwd_mega, dim3(grid), dim3(NTHR), LDS_BYTES, stream, a);
        }
    }
}
```
